# Optimizing an MI355X kernel written in HIP

```python
import jax, jax.numpy as jnp
from jax import lax
import numpy as np

D_MODEL = 1024
BATCH = 8
SEQ = 2048
DEPTH = 2

N_MIXERS = 2
N_HEADS = 4
QK_DIM = D_MODEL // 2 // N_HEADS
V_DIM = D_MODEL // N_HEADS
QK_W = N_HEADS * QK_DIM
V_W = N_HEADS * V_DIM
CHUNK = 64
D_FF = 4 * D_MODEL
GLA_GATE_RANK = 16
GLA_TAU = 16.0
EPS = 1e-6
MLSTM_IN = 2 * QK_W + 2 * V_W + 2 * N_HEADS
GLA_IN = 2 * QK_W + 2 * V_W + GLA_GATE_RANK
N_MLSTM_LAYERS = (DEPTH + 1) // 2
N_GLA_LAYERS = DEPTH // 2

kernel_name = 'hybrid_mlstm_gla_sqrelu'


def rmsnorm(x, g):
    xf = x.astype(jnp.float32)
    y = xf * lax.rsqrt(jnp.mean(xf * xf, axis=-1, keepdims=True) + EPS)
    return (y * g.astype(jnp.float32)).astype(x.dtype)


def head_rmsnorm(h, g):
    B, S, H, dv = h.shape
    y = h * lax.rsqrt(jnp.mean(h * h, axis=-1, keepdims=True) + EPS)
    return y.reshape(B, S, H * dv) * g.astype(jnp.float32)


def to_chunks(t):
    B, S, H, d = t.shape
    return t.reshape(B, S // CHUNK, CHUNK, H, d).transpose(1, 0, 3, 2, 4)


def gate_chunks(t):
    B, S, H = t.shape
    return t.reshape(B, S // CHUNK, CHUNK, H).transpose(1, 0, 3, 2)


def from_chunks(t):
    NC, B, H, L, d = t.shape
    return t.transpose(1, 0, 3, 2, 4).reshape(B, NC * L, H, d)


def mlstm_chunkwise(q, k, v, i_pre, f_pre):
    B, S, H, dk = q.shape
    dv = v.shape[-1]
    causal = jnp.tril(jnp.ones((CHUNK, CHUNK), dtype=bool))
    xs = (to_chunks(q), to_chunks(k), to_chunks(v), gate_chunks(i_pre), gate_chunks(jax.nn.log_sigmoid(f_pre)))

    def step(carry, inp):
        C, n, m = carry
        qj, ks, vs, li, lf = inp
        b = jnp.cumsum(lf, axis=-1)
        g = b[..., -1]
        dmat = jnp.where(causal, b[..., :, None] - b[..., None, :] + li[..., None, :], -jnp.inf)
        inter = b + m[..., None]
        m_row = jnp.maximum(inter, jnp.max(dmat, axis=-1))
        w_inter = jnp.exp(inter - m_row)
        s = jnp.einsum('bhjd,bhsd->bhjs', qj, ks) * jnp.exp(dmat - m_row[..., None])
        num = w_inter[..., None] * jnp.einsum('bhjd,bhde->bhje', qj, C) + jnp.einsum('bhjs,bhse->bhje', s, vs)
        den = w_inter * jnp.einsum('bhjd,bhd->bhj', qj, n) + jnp.sum(s, axis=-1)
        h = num / jnp.maximum(jnp.abs(den), jnp.exp(-m_row))[..., None]
        a = g[..., None] - b + li
        m_new = jnp.maximum(g + m, jnp.max(a, axis=-1))
        w_s = jnp.exp(a - m_new[..., None])
        decay = jnp.exp(g + m - m_new)
        C_new = decay[..., None, None] * C + jnp.einsum('bhs,bhsd,bhse->bhde', w_s, ks, vs)
        n_new = decay[..., None] * n + jnp.einsum('bhs,bhsd->bhd', w_s, ks)
        return (C_new, n_new, m_new), h

    init = (jnp.zeros((B, H, dk, dv), jnp.float32), jnp.zeros((B, H, dk), jnp.float32), jnp.zeros((B, H), jnp.float32))
    _, h = lax.scan(step, init, xs)
    return from_chunks(h)


def gla_chunkwise(q, k, v, log_a):
    B, S, H, dk = q.shape
    dv = v.shape[-1]
    causal = jnp.tril(jnp.ones((CHUNK, CHUNK), dtype=bool))[:, :, None]
    xs = (to_chunks(q), to_chunks(k), to_chunks(v), to_chunks(log_a))

    def step(S_state, inp):
        qj, ks, vs, la = inp
        b = jnp.cumsum(la, axis=-2)
        g = b[..., -1, :]
        rel = jnp.where(causal, b[..., :, None, :] - b[..., None, :, :], -jnp.inf)
        A = jnp.einsum('bhjd,bhsd,bhjsd->bhjs', qj, ks, jnp.exp(rel))
        o = jnp.einsum('bhjs,bhse->bhje', A, vs) + jnp.einsum('bhjd,bhde->bhje', qj * jnp.exp(b), S_state)
        S_new = jnp.exp(g)[..., None] * S_state + jnp.einsum('bhsd,bhse->bhde', ks * jnp.exp(g[..., None, :] - b), vs)
        return S_new, o

    _, o = lax.scan(step, jnp.zeros((B, H, dk, dv), jnp.float32), xs)
    return from_chunks(o)


def mlstm_mixer(xn, w_in, b_gate, out_norm_g, w_out):
    B, S, _ = xn.shape
    proj = xn @ w_in
    q, k, v, o_pre, gates = jnp.split(proj, [QK_W, 2 * QK_W, 2 * QK_W + V_W, 2 * QK_W + 2 * V_W], axis=-1)
    gates = gates.astype(jnp.float32) + b_gate.astype(jnp.float32)
    i_pre, f_pre = gates[..., :N_HEADS], gates[..., N_HEADS:]
    q = q.reshape(B, S, N_HEADS, QK_DIM).astype(jnp.float32)
    k = k.reshape(B, S, N_HEADS, QK_DIM).astype(jnp.float32) * (QK_DIM ** -0.5)
    v = v.reshape(B, S, N_HEADS, V_DIM).astype(jnp.float32)
    h_tilde = mlstm_chunkwise(q, k, v, i_pre, f_pre)
    h = jax.nn.sigmoid(o_pre.astype(jnp.float32)).reshape(B, S, N_HEADS, V_DIM) * h_tilde
    return head_rmsnorm(h, out_norm_g).astype(xn.dtype) @ w_out


def gla_mixer(xn, w_in, w_gate_up, b_gate, out_norm_g, w_out):
    B, S, _ = xn.shape
    proj = xn @ w_in
    q, k, v, r, z_low = jnp.split(proj, [QK_W, 2 * QK_W, 2 * QK_W + V_W, 2 * QK_W + 2 * V_W], axis=-1)
    z = (z_low @ w_gate_up).astype(jnp.float32) + b_gate.astype(jnp.float32)
    log_a = (jax.nn.log_sigmoid(z) / GLA_TAU).reshape(B, S, N_HEADS, QK_DIM)
    q = q.reshape(B, S, N_HEADS, QK_DIM).astype(jnp.float32) * (QK_DIM ** -0.5)
    k = k.reshape(B, S, N_HEADS, QK_DIM).astype(jnp.float32)
    v = v.reshape(B, S, N_HEADS, V_DIM).astype(jnp.float32)
    o = head_rmsnorm(gla_chunkwise(q, k, v, log_a), out_norm_g)
    return (jax.nn.silu(r.astype(jnp.float32)) * o).astype(xn.dtype) @ w_out


def sq_relu_mlp(xn, w1, w2):
    hid = jnp.square(jax.nn.relu(xn @ w1))
    return hid @ w2


def setup_inputs(seed: int = 0) -> dict:
    key = jax.random.key(seed)
    ks = jax.random.split(key, 20)
    f32 = jnp.float32

    def nrm(k, shape, fan_in):
        return jax.random.normal(k, shape, f32) * (fan_in ** -0.5)

    na, nb = N_MLSTM_LAYERS, N_GLA_LAYERS
    x = jax.random.normal(ks[0], (BATCH, SEQ, D_MODEL), f32)
    norm_mix_g = 1.0 + 0.02 * jax.random.normal(ks[1], (DEPTH, D_MODEL), f32)
    norm_ffn_g = 1.0 + 0.02 * jax.random.normal(ks[2], (DEPTH, D_MODEL), f32)
    final_norm_g = 1.0 + 0.02 * jax.random.normal(ks[3], (D_MODEL,), f32)
    mlstm_w_in = nrm(ks[4], (na, D_MODEL, MLSTM_IN), D_MODEL)
    i_bias = 0.1 * jax.random.normal(ks[5], (na, N_HEADS), f32)
    f_bias = 3.0 + 3.0 * jax.random.uniform(ks[6], (na, N_HEADS), f32)
    mlstm_b_gate = jnp.concatenate([i_bias, f_bias], axis=-1)
    mlstm_out_norm_g = 1.0 + 0.02 * jax.random.normal(ks[7], (na, V_W), f32)
    mlstm_w_out = nrm(ks[8], (na, V_W, D_MODEL), V_W)
    gla_w_in = nrm(ks[9], (nb, D_MODEL, GLA_IN), D_MODEL)
    gla_w_gate_up = nrm(ks[10], (nb, GLA_GATE_RANK, QK_W), GLA_GATE_RANK)
    gla_b_gate = 0.1 * jax.random.normal(ks[11], (nb, QK_W), f32)
    gla_out_norm_g = 1.0 + 0.02 * jax.random.normal(ks[12], (nb, V_W), f32)
    gla_w_out = nrm(ks[13], (nb, V_W, D_MODEL), V_W)
    ffn_w1 = nrm(ks[14], (DEPTH, D_MODEL, D_FF), D_MODEL)
    ffn_w2 = nrm(ks[15], (DEPTH, D_FF, D_MODEL), D_FF)
    return {'x': x, 'norm_mix_g': norm_mix_g, 'norm_ffn_g': norm_ffn_g, 'final_norm_g': final_norm_g,
            'mlstm_w_in': mlstm_w_in, 'mlstm_b_gate': mlstm_b_gate, 'mlstm_out_norm_g': mlstm_out_norm_g,
            'mlstm_w_out': mlstm_w_out, 'gla_w_in': gla_w_in, 'gla_w_gate_up': gla_w_gate_up,
            'gla_b_gate': gla_b_gate, 'gla_out_norm_g': gla_out_norm_g, 'gla_w_out': gla_w_out,
            'ffn_w1': ffn_w1, 'ffn_w2': ffn_w2}


def reference(x, norm_mix_g, norm_ffn_g, final_norm_g, mlstm_w_in, mlstm_b_gate, mlstm_out_norm_g,
              mlstm_w_out, gla_w_in, gla_w_gate_up, gla_b_gate, gla_out_norm_g, gla_w_out, ffn_w1, ffn_w2):
    for i in range(DEPTH):
        j = i // N_MIXERS
        h = rmsnorm(x, norm_mix_g[i])
        if i % N_MIXERS == 0:
            x = x + mlstm_mixer(h, mlstm_w_in[j], mlstm_b_gate[j], mlstm_out_norm_g[j], mlstm_w_out[j])
        else:
            x = x + gla_mixer(h, gla_w_in[j], gla_w_gate_up[j], gla_b_gate[j], gla_out_norm_g[j], gla_w_out[j])
        h = rmsnorm(x, norm_ffn_g[i])
        x = x + sq_relu_mlp(h, ffn_w1[i], ffn_w2[i])
    return rmsnorm(x, final_norm_g)
```

```cpp
#include <hip/hip_runtime.h>
#include <cstdio>
#include <cstdint>
namespace pg8 {
#define PG8_LAS __attribute__((address_space(3)))
typedef unsigned short bf16_t;
typedef short bf16x8 __attribute__((ext_vector_type(8)));
typedef float f32x4 __attribute__((ext_vector_type(4)));
typedef unsigned u32x4 __attribute__((ext_vector_type(4)));
constexpr int BM = 256, BK = 64, HALF = 128, HTB = HALF * BK * 2  , STAGE_BYTES = 8 * HTB, NXCD = 8, WGM = 8;

__host__ __device__ __forceinline__ int lds_byte(int r, int c) { const int st = (r >> 4) * 2 + (c >> 5), rr = r & 15, cc = c & 31, ob = rr * 64 + cc * 2; return st * 1024 + (ob ^ (((ob >> 9) & 1) << 5)); }
__host__ __device__ __forceinline__ void stage_rc(int b, int& R, int& C) { const int st = b / 1024, sb = b % 1024, swz = sb ^ (((sb >> 9) & 1) << 5); R = (st >> 1) * 16 + swz / 64; C = (st & 1) * 32 + (swz % 64) / 2; }
__host__ __device__ __forceinline__ int perm32(int rho) { const int n = rho >> 4, i = rho & 15; return 8 * (i >> 2) + 4 * n + (i & 3); }

struct Unit { int pm, pn; };
struct Gemm { const bf16_t* A; const bf16_t* Bt; int M, N, K; };

struct StaticOrder {
    int nM, nN, nwg, G, c;
    __host__ __device__ void init(int M, int N, int G_, int c_) { nM = M / BM; nN = N / BM; nwg = nM * nN; G = G_; c = c_; }
    __host__ __device__ bool next(int i, Unit& u) const {
        const long L = (long)i * G + c; if (L >= nwg) return false;
        int wgid = (int)L; { const int q = nwg / NXCD, r = nwg % NXCD, xcd = wgid % NXCD, off = wgid / NXCD; wgid = (xcd < r ? xcd * (q + 1) : r * (q + 1) + (xcd - r) * q) + off; }
        const int nig = WGM * nN, gid = wgid / nig, fm = gid * WGM, gsz = (nM - fm) < WGM ? (nM - fm) : WGM;
        u.pm = fm + ((wgid % nig) % gsz); u.pn = (wgid % nig) / gsz; return true;
    }
    __device__ __forceinline__ void a_ready(const Unit&) const {}
    __device__ __forceinline__ void done(const Unit&) const {}
};

__device__ __forceinline__ unsigned cvt_pk_bf16(float lo, float hi) { unsigned r; asm volatile("v_cvt_pk_bf16_f32 %0, %1, %2" : "=v"(r) : "v"(lo), "v"(hi)); return r; }
typedef float f32x2 __attribute__((ext_vector_type(2)));
typedef __bf16 bf16x2_t __attribute__((ext_vector_type(2)));
__device__ __forceinline__ unsigned pk_bf16(float lo, float hi) { f32x2 v = {lo, hi}; bf16x2_t r = __builtin_convertvector(v, bf16x2_t); return __builtin_bit_cast(unsigned, r); }
template <int ACT  > struct EpiBf16 {
    static constexpr bool PERM = true, AFTER_DRAIN = false;
    bf16_t* O; int ldc;
    __device__ __forceinline__ void operator()(const f32x4 (&acc)[2][2][4][2], const Unit& u, int wr, int wc, int fr, int fq) const {
        const int row0 = u.pm * BM + wr * 64 + fr, col0 = u.pn * BM + wc * 32 + 8 * fq;
#pragma unroll
        for (int ai = 0; ai < 2; ++ai)
#pragma unroll
            for (int m = 0; m < 4; ++m) { bf16_t* rowp = O + (size_t)(row0 + ai * HALF + m * 16) * ldc + col0;
#pragma unroll
                for (int bj = 0; bj < 2; ++bj) { f32x4 v0 = acc[ai][bj][m][0], v1 = acc[ai][bj][m][1];
                    if (ACT == 2) { const f32x4 z = {0.f, 0.f, 0.f, 0.f}; v0 = __builtin_elementwise_max(v0, z); v1 = __builtin_elementwise_max(v1, z); v0 = v0 * v0; v1 = v1 * v1; }
                    u32x4 w; w.x = pk_bf16(v0[0], v0[1]); w.y = pk_bf16(v0[2], v0[3]); w.z = pk_bf16(v1[0], v1[1]); w.w = pk_bf16(v1[2], v1[3]);
                    *(u32x4*)(rowp + bj * HALF) = w; } }
    }
};
struct EpiResF32 {
    static constexpr bool PERM = false, AFTER_DRAIN = true;
    const float* base; float* out; int ldc;
    __device__ __forceinline__ void fused(const f32x4 (&acc)[2][2][4][2], const Unit& u, int wr, int wc, int fr, int fq, PG8_LAS unsigned char*, int, int) const {
        const int col0 = u.pn * BM + wc * 32 + 4 * fq;
#pragma unroll
        for (int ai = 0; ai < 2; ++ai)
#pragma unroll
            for (int m = 0; m < 4; ++m) { const int r = ai * HALF + wr * 64 + m * 16 + fr; const size_t off = (size_t)(u.pm * BM + r) * ldc + col0;
#pragma unroll
                for (int bj = 0; bj < 2; ++bj) { const f32x4 b0 = *(const f32x4*)(base + off + bj * HALF), b1 = *(const f32x4*)(base + off + bj * HALF + 16);
                    *(f32x4*)(out + off + bj * HALF) = b0 + acc[ai][bj][m][0]; *(f32x4*)(out + off + bj * HALF + 16) = b1 + acc[ai][bj][m][1];
                    asm volatile("" ::: "memory"); } }
    }
};
template <class Epi, class Sched, bool ALIGN_EPI = false, bool SP2 = false>
__device__ __forceinline__ void gemm_phase(PG8_LAS unsigned char* lds, const Gemm g, const Sched& S, const Epi& E) {
    const int tid = threadIdx.x, wid = __builtin_amdgcn_readfirstlane(tid >> 6), lane = tid & 63, wr = wid >> 2, wc = wid & 3, fr = lane & 15, fq = lane >> 4;
    const int K = g.K, nt = K / BK;
    unsigned voffA[2], voffB[2];
#pragma unroll
    for (int i = 0; i < 2; ++i) { int R, C; stage_rc(tid * 16 + i * 8192, R, C); const int Rb = Epi::PERM ? ((R & ~31) + perm32(R & 31)) : R;
        voffA[i] = (unsigned)(R * K + C) * 2u; voffB[i] = (unsigned)(Rb * K + C) * 2u; }
    const size_t kstep = (size_t)(BK * 2);
    const size_t hstep = (size_t)HALF * K * 2;
    const size_t tstep = 2 * hstep;
    const unsigned ldsw = (unsigned)wid * 1024u;
    const int aoff = lds_byte(wr * 64 + fr, fq * 8), boff = lds_byte(wc * 32 + fr, fq * 8);
#define PG8_SA(b, h) (((b) * 2 + (h)) * HTB)
#define PG8_SB(b, h) ((4 + (b) * 2 + (h)) * HTB)
#define PG8_STAGE(bufoff, gbase, voff) do { _Pragma("unroll") for (int _i = 0; _i < 2; ++_i) \
        __builtin_amdgcn_global_load_lds((const unsigned*)((const char*)(gbase) + (voff)[_i]), (PG8_LAS unsigned*)(lds + (bufoff) + ldsw + _i * 8192), 16, 0, 0); } while (0)
#define PG8_LDA(dst, b, h) do { _Pragma("unroll") for (int m = 0; m < 4; ++m) _Pragma("unroll") for (int k = 0; k < 2; ++k) dst[m][k] = *(const PG8_LAS bf16x8*)(lds + PG8_SA(b, h) + aoff + m * 2048 + k * 1024); } while (0)
#define PG8_LDB(dst, b, h) do { _Pragma("unroll") for (int n = 0; n < 2; ++n) _Pragma("unroll") for (int k = 0; k < 2; ++k) dst[n][k] = *(const PG8_LAS bf16x8*)(lds + PG8_SB(b, h) + boff + n * 2048 + k * 1024); } while (0)
#define PG8_MMA(ai, bj, At, Bt) do { __builtin_amdgcn_s_setprio(1); _Pragma("unroll") for (int m = 0; m < 4; ++m) _Pragma("unroll") for (int n = 0; n < 2; ++n) _Pragma("unroll") for (int k = 0; k < 2; ++k) \
        acc[ai][bj][m][n] = __builtin_amdgcn_mfma_f32_16x16x32_bf16(Bt[n][k], At[m][k], acc[ai][bj][m][n], 0, 0, 0); __builtin_amdgcn_s_setprio(0); } while (0)
#define PG8_WAIT_V(n) asm volatile("s_waitcnt vmcnt(" #n ")" ::: "memory")
#define PG8_WAIT_L(n) asm volatile("s_waitcnt lgkmcnt(" #n ")" ::: "memory")
#define PG8_BAR __builtin_amdgcn_s_barrier()
#define PG8_SCHED __builtin_amdgcn_sched_barrier(0)
    Unit cur, nxt; int ui = 0;
    if (!S.next(0, cur)) return;
    f32x4 acc[2][2][4][2];
#pragma unroll
    for (int a = 0; a < 2; ++a)
#pragma unroll
        for (int b = 0; b < 2; ++b)
#pragma unroll
            for (int m = 0; m < 4; ++m)
#pragma unroll
                for (int n = 0; n < 2; ++n) acc[a][b][m][n] = (f32x4){0.f, 0.f, 0.f, 0.f};
    bf16x8 At[4][2], B0[2][2], B1[2][2];
    const char* cA = (const char*)g.A + (size_t)cur.pm * tstep; const char* cB = (const char*)g.Bt + (size_t)cur.pn * tstep;
    S.a_ready(cur);
    if constexpr (SP2) {
        PG8_STAGE(PG8_SB(0, 0), cB, voffB); PG8_STAGE(PG8_SB(0, 1), cB + hstep, voffB); PG8_STAGE(PG8_SA(0, 0), cA, voffA); PG8_STAGE(PG8_SA(0, 1), cA + hstep, voffA);
        if (wr == 1) PG8_BAR;
        PG8_WAIT_V(2); PG8_BAR;
        PG8_STAGE(PG8_SB(1, 0), cB + kstep, voffB); PG8_STAGE(PG8_SA(1, 0), cA + kstep, voffA); PG8_STAGE(PG8_SB(1, 1), cB + hstep + kstep, voffB);
        PG8_WAIT_V(6); PG8_BAR;
    } else {
        PG8_STAGE(PG8_SB(0, 0), cB, voffB); PG8_STAGE(PG8_SA(0, 0), cA, voffA); PG8_STAGE(PG8_SB(0, 1), cB + hstep, voffB); PG8_STAGE(PG8_SA(0, 1), cA + hstep, voffA);
        if (wr == 1) PG8_BAR;
        PG8_WAIT_V(4); PG8_BAR;
        PG8_STAGE(PG8_SB(1, 0), cB + kstep, voffB); PG8_STAGE(PG8_SA(1, 0), cA + kstep, voffA); PG8_STAGE(PG8_SB(1, 1), cB + hstep + kstep, voffB);
        PG8_WAIT_V(6); PG8_BAR;
    }
    for (;;) {
        const bool has_next = S.next(ui + 1, nxt);
        const char* nA = has_next ? (const char*)g.A + (size_t)nxt.pm * tstep : cA; const char* nB = has_next ? (const char*)g.Bt + (size_t)nxt.pn * tstep : cB;
        for (int t = 0; t < nt; t += 2) {
            const bool last = (t == nt - 2);
            const char* a1 = cA + (size_t)(t + 1) * kstep;
            const char* a2 = last ? nA : cA + (size_t)(t + 2) * kstep; const char* b2 = last ? nB : cB + (size_t)(t + 2) * kstep;
            const char* a3 = a2 + kstep; const char* b3 = b2 + kstep;
            if (last && has_next) S.a_ready(nxt);
            if constexpr (SP2) {
            PG8_LDB(B0, 0, 0); PG8_LDB(B1, 0, 1); PG8_SCHED; PG8_LDA(At, 0, 0); PG8_STAGE(PG8_SA(1, 1), a1 + hstep, voffA);
            PG8_WAIT_V(8); PG8_WAIT_L(0); PG8_BAR; PG8_MMA(0, 0, At, B0); PG8_MMA(0, 1, At, B1); PG8_BAR; PG8_SCHED;
            PG8_LDA(At, 0, 1); PG8_STAGE(PG8_SB(0, 0), b2, voffB); PG8_STAGE(PG8_SB(0, 1), b2 + hstep, voffB); PG8_STAGE(PG8_SA(0, 0), a2, voffA);
            PG8_WAIT_V(8); PG8_WAIT_L(0); PG8_BAR; PG8_MMA(1, 0, At, B0); PG8_MMA(1, 1, At, B1); PG8_BAR; PG8_SCHED;
            PG8_LDB(B0, 1, 0); PG8_LDB(B1, 1, 1); PG8_SCHED; PG8_LDA(At, 1, 0); PG8_STAGE(PG8_SA(0, 1), a2 + hstep, voffA);
            PG8_WAIT_V(8); PG8_WAIT_L(0); PG8_BAR; PG8_MMA(0, 0, At, B0); PG8_MMA(0, 1, At, B1); PG8_BAR; PG8_SCHED;
            PG8_LDA(At, 1, 1); PG8_STAGE(PG8_SB(1, 0), b3, voffB); PG8_STAGE(PG8_SB(1, 1), b3 + hstep, voffB); PG8_STAGE(PG8_SA(1, 0), a3, voffA);
            PG8_WAIT_V(8); PG8_WAIT_L(0); PG8_BAR; PG8_MMA(1, 0, At, B0); PG8_MMA(1, 1, At, B1); PG8_BAR; PG8_SCHED;
            } else {
            PG8_LDB(B0, 0, 0); PG8_SCHED; PG8_LDA(At, 0, 0); PG8_STAGE(PG8_SA(1, 1), a1 + hstep, voffA);
            PG8_WAIT_L(8); PG8_BAR; PG8_WAIT_L(0); PG8_MMA(0, 0, At, B0); PG8_BAR; PG8_SCHED;
            PG8_LDB(B1, 0, 1); PG8_STAGE(PG8_SB(0, 0), b2, voffB);
            PG8_BAR; PG8_WAIT_L(0); PG8_MMA(0, 1, At, B1); PG8_BAR;
            PG8_LDA(At, 0, 1); PG8_STAGE(PG8_SA(0, 0), a2, voffA);
            PG8_BAR; PG8_WAIT_L(0); PG8_MMA(1, 0, At, B0); PG8_BAR; PG8_SCHED;
            PG8_STAGE(PG8_SB(0, 1), b2 + hstep, voffB);
            PG8_WAIT_V(6); PG8_BAR; PG8_MMA(1, 1, At, B1); PG8_BAR;
            PG8_LDB(B0, 1, 0); PG8_SCHED; PG8_LDA(At, 1, 0); PG8_STAGE(PG8_SA(0, 1), a2 + hstep, voffA);
            PG8_WAIT_L(8); PG8_BAR; PG8_WAIT_L(0); PG8_MMA(0, 0, At, B0); PG8_BAR; PG8_SCHED;
            PG8_LDB(B1, 1, 1); PG8_STAGE(PG8_SB(1, 0), b3, voffB);
            PG8_BAR; PG8_WAIT_L(0); PG8_MMA(0, 1, At, B1); PG8_BAR;
            PG8_LDA(At, 1, 1); PG8_STAGE(PG8_SA(1, 0), a3, voffA);
            PG8_BAR; PG8_WAIT_L(0); PG8_MMA(1, 0, At, B0); PG8_BAR; PG8_SCHED;
            PG8_STAGE(PG8_SB(1, 1), b3 + hstep, voffB);
            PG8_WAIT_V(6); PG8_BAR; PG8_MMA(1, 1, At, B1); PG8_BAR;
            }
        }
        if constexpr (ALIGN_EPI) { if (wr == 0) PG8_BAR; }
        if constexpr (!Epi::AFTER_DRAIN) { E(acc, cur, wr, wc, fr, fq); S.done(cur); }
        if (!has_next) break;
#pragma unroll
        for (int a = 0; a < 2; ++a)
#pragma unroll
            for (int b = 0; b < 2; ++b)
#pragma unroll
                for (int m = 0; m < 4; ++m)
#pragma unroll
                    for (int n = 0; n < 2; ++n) acc[a][b][m][n] = (f32x4){0.f, 0.f, 0.f, 0.f};
        cur = nxt; cA = nA; cB = nB; ++ui;
        if constexpr (ALIGN_EPI) { if (wr == 1) PG8_BAR; }
    }
    PG8_WAIT_V(0);
    if constexpr (!ALIGN_EPI) { if (wr == 0) PG8_BAR; }
    PG8_BAR;
    if constexpr (Epi::AFTER_DRAIN) { E.fused(acc, cur, wr, wc, fr, fq, lds, wid, lane); S.done(cur); }
#undef PG8_SA
#undef PG8_SB
#undef PG8_STAGE
#undef PG8_LDA
#undef PG8_LDB
#undef PG8_MMA
#undef PG8_WAIT_V
#undef PG8_WAIT_L
#undef PG8_BAR
#undef PG8_SCHED
}
}

constexpr int NWAVES = 8, NTHREADS = 512;
#ifndef MK_N_LAUNCHES
#define MK_N_LAUNCHES 1
#endif
constexpr int BATCH = 8, SEQ = 2048, D = 1024, FF = 4096, NH = 4, DK = 128, DV = 256, QKW = 512, VW = 1024;
constexpr int M = BATCH * SEQ, NPROJ = 3072, CH = 64, NCH = SEQ / CH;
constexpr int MLSTM_IN = 3080, GLA_IN = 3088;
constexpr float EPS = 1e-6f, QK_SCALE = 0.08838834764831845f, INV_TAU = 1.0f / 16.0f;

constexpr size_t MiB = 1u << 20;
constexpr size_t WS_CTL = 0, CTL_ZERO_BYTES = 64 * 1024;
constexpr size_t WS_GATES = 1 * MiB;
constexpr size_t WS_GDEC = 2 * MiB;
constexpr size_t WS_WIN = 4 * MiB, WS_WOUT = 10 * MiB, WS_W1 = 12 * MiB, WS_W2 = 20 * MiB;
constexpr size_t WS_AOP = 28 * MiB;
constexpr size_t WS_HUN = 60 * MiB;
constexpr size_t WS_PROJ = 92 * MiB;
constexpr size_t WS_QT = 188 * MiB, WS_KT = 204 * MiB, WS_KH = 220 * MiB;
constexpr size_t WS_HMID = 92 * MiB;
constexpr size_t WS_END = 236 * MiB;
constexpr int CW_BAR = 1024;

constexpr int RING_BYTES = 131072, LDSCTL_OFF = RING_BYTES, MISC_OFF = LDSCTL_OFF + 320, LDS_BYTES = 147456;

#define GAS __attribute__((address_space(1)))
#define LAS __attribute__((address_space(3)))
typedef unsigned short bf16;
typedef unsigned v4u __attribute__((ext_vector_type(4)));
typedef unsigned v2u __attribute__((ext_vector_type(2)));
typedef float f32x4 __attribute__((ext_vector_type(4)));
typedef float f32x16 __attribute__((ext_vector_type(16)));
typedef short bf16x8 __attribute__((ext_vector_type(8)));
typedef short s16x4 __attribute__((ext_vector_type(4)));
typedef GAS unsigned gu32;
#define RLX_AGENT __ATOMIC_RELAXED, __HIP_MEMORY_SCOPE_AGENT
#define LDS_WAIT() asm volatile("s_waitcnt lgkmcnt(0)" ::: "memory")
#define VM_WAIT() asm volatile("s_waitcnt vmcnt(0)" ::: "memory")
using pg8::pk_bf16;
__device__ __forceinline__ float bf2f(unsigned b) { return __uint_as_float(b << 16); }
__device__ __forceinline__ float bflo(unsigned w) { return __uint_as_float(w << 16); }
__device__ __forceinline__ float bfhi(unsigned w) { return __uint_as_float(w & 0xffff0000u); }
__device__ __forceinline__ unsigned short f2bf1(float f) { return (unsigned short)(pk_bf16(f, 0.f) & 0xffffu); }

#define XB_TMO      128
#define XB_XCNT(j)  (256  + 64 * (j))
#define XB_XSUB(j)  (1280 + 64 * (j))
#define XB_XGEN(j)  (2304 + 64 * (j))
#define XB_TOP      3328
#define XB_TOPGEN   3392
#define XCD_BAR_WORDS 3456
#define XB_SPIN_CAP (1u << 18)
__device__ __forceinline__ unsigned xb_ld(unsigned* p)              { return __hip_atomic_load(p, __ATOMIC_RELAXED, __HIP_MEMORY_SCOPE_AGENT); }
__device__ __forceinline__ unsigned xb_add(unsigned* p, unsigned v) { return __hip_atomic_fetch_add(p, v, __ATOMIC_RELAXED, __HIP_MEMORY_SCOPE_AGENT); }
__device__ __forceinline__ unsigned xb_xcc_id() { return (unsigned)__builtin_amdgcn_s_getreg((3 << 11) | 20) & 0xFu; }
#define XB_SPIN(cond, bar) do { unsigned _sp = 0; while (cond) { __builtin_amdgcn_s_sleep(1); \
    if ((++_sp & 255u) == 0u) { if (xb_ld(&(bar)[XB_TMO])) break; if (_sp > XB_SPIN_CAP) { atomicAdd(&(bar)[XB_TMO], 1u); break; } } } } while (0)
struct XcdBarrier { unsigned* bar; unsigned x; volatile LAS unsigned* st; };
__device__ __forceinline__ XcdBarrier xcd_barrier_post(unsigned* bar, volatile LAS unsigned* st) {
    XcdBarrier b; b.bar = bar; b.x = xb_xcc_id(); b.st = st;
    if (threadIdx.x == 0) (void)xb_add(&bar[XB_XCNT(b.x)], 1u);
    return b;
}
__device__ __forceinline__ void xcd_barrier_complete(unsigned* bar, unsigned x, unsigned& nloc, unsigned& nx) {
    const unsigned G = gridDim.x * gridDim.y * gridDim.z;
    unsigned sum, cnt, mine, sp = 0u;
    for (;;) {
        sum = 0u; cnt = 0u; mine = 0u;
#pragma unroll
        for (unsigned j = 0; j < 16; ++j) { const unsigned c = xb_ld(&bar[XB_XCNT(j)]); sum += c; cnt += (c > 0u) ? 1u : 0u; mine = (j == x) ? c : mine; }
        if (sum == G) break;
        __builtin_amdgcn_s_sleep(1);
        if ((++sp & 255u) == 0u) { if (xb_ld(&bar[XB_TMO])) break; if (sp > XB_SPIN_CAP) { atomicAdd(&bar[XB_TMO], 1u); break; } }
    }
    nloc = mine > 0u ? mine : 1u; nx = cnt > 0u ? cnt : 1u;
}
__device__ __forceinline__ void xcd_barrier(const XcdBarrier& b) {
    asm volatile("s_waitcnt vmcnt(0)" ::: "memory");
    __syncthreads();
    if (threadIdx.x == 0) {
        unsigned* bar = b.bar;
        __builtin_amdgcn_s_waitcnt(0);
        unsigned nloc = b.st[0], nx = b.st[1];
        if (nloc == 0u) { xcd_barrier_complete(bar, b.x, nloc, nx); b.st[0] = nloc; b.st[1] = nx; }
        const unsigned old = xb_add(&bar[XB_XSUB(b.x)], 1u);
        const unsigned gen = old / nloc;
        if (old + 1u == (gen + 1u) * nloc) {
            __builtin_amdgcn_fence(__ATOMIC_RELEASE, "agent");
            asm volatile("s_waitcnt vmcnt(0)" ::: "memory");
            const unsigned og = xb_add(&bar[XB_TOP], 1u);
            const unsigned tg = og / nx;
            if (og + 1u == (tg + 1u) * nx) xb_add(&bar[XB_TOPGEN], 1u);
            else XB_SPIN(xb_ld(&bar[XB_TOPGEN]) == tg, bar);
            __builtin_amdgcn_fence(__ATOMIC_ACQUIRE, "agent");
            xb_add(&bar[XB_XGEN(b.x)], 1u);
            asm volatile("s_waitcnt vmcnt(0)" ::: "memory");
        } else {
            XB_SPIN(xb_ld(&bar[XB_XGEN(b.x)]) == gen, bar);
            __builtin_amdgcn_fence(__ATOMIC_ACQUIRE, "agent");
            asm volatile("s_waitcnt vmcnt(0)" ::: "memory");
        }
    }
    __syncthreads();
}

__device__ __forceinline__ float wave_sum(float v) {
#pragma unroll
    for (int o = 1; o < 64; o <<= 1) v += __shfl_xor(v, o);
    return v;
}
__device__ __forceinline__ void transpose_item(const float* W, int K, int N, int ldw, bf16* WT, LAS float* scr, int item, int lane) {
    const int nblk = N / 32, kb = item / nblk, nb = item % nblk, k0 = 64 * kb, n0 = 32 * nb;
#pragma unroll 8
    for (int i = 0; i < 32; ++i) { const int kk = 2 * i + (lane >> 5); scr[kk * 33 + (lane & 31)] = W[(size_t)(k0 + kk) * ldw + n0 + (lane & 31)]; }
    LDS_WAIT(); asm volatile("" ::: "memory");
    const int c = lane & 7;
#pragma unroll
    for (int j = 0; j < 4; ++j) { const int n = (lane >> 3) + 8 * j; const LAS float* s = scr + (8 * c) * 33 + n;
        v4u o; o.x = pk_bf16(s[0 * 33], s[1 * 33]); o.y = pk_bf16(s[2 * 33], s[3 * 33]); o.z = pk_bf16(s[4 * 33], s[5 * 33]); o.w = pk_bf16(s[6 * 33], s[7 * 33]);
        *(GAS v4u*)(WT + (size_t)(n0 + n) * K + k0 + 8 * c) = o; }
    LDS_WAIT(); asm volatile("" ::: "memory");
}
__device__ __forceinline__ void convert_weights(LAS unsigned char* lds, int lane, int wave, int vcu, int G, const float* w_in, int ld_in, const float* w_out, const float* w1, const float* w2, unsigned char* ws) {
    LAS float* scr = (LAS float*)(lds + wave * 16384);
    const int gw = vcu * NWAVES + wave, NGW = G * NWAVES;
    constexpr int I_IN = (D / 64) * (NPROJ / 32), I_O = (D / 64) * (D / 32), I_1 = (D / 64) * (FF / 32), I_2 = (FF / 64) * (D / 32);
    constexpr int NITEMS = I_IN + I_O + I_1 + I_2;
    for (int it = gw; it < NITEMS; it += NGW) {
        int r = it;
        if (r < I_IN) { transpose_item(w_in, D, NPROJ, ld_in, (bf16*)(ws + WS_WIN), scr, r, lane); continue; } r -= I_IN;
        if (r < I_O) { transpose_item(w_out, D, D, D, (bf16*)(ws + WS_WOUT), scr, r, lane); continue; } r -= I_O;
        if (r < I_1) { transpose_item(w1, D, FF, FF, (bf16*)(ws + WS_W1), scr, r, lane); continue; } r -= I_1;
        transpose_item(w2, FF, D, D, (bf16*)(ws + WS_W2), scr, r, lane);
    }
}

template <bool GATE, bool OUT_BF16>
__device__ __forceinline__ void norm_rows(LAS unsigned char* lds, int tid, int lane, int wave, int vcu, int G, const float* xin, const float* gain, bf16* aop, float* fout,
                                          const float* wg, int ldw, int ng, float* gates) {
    LAS float* WgT = (LAS float*)lds;
    if (GATE) {
        __syncthreads();
        for (int i = tid; i < 16 * D; i += NTHREADS) { const int k = i >> 4, c = i & 15; WgT[c * D + k] = (c < ng) ? wg[(size_t)k * ldw + c] : 0.f; }
        __syncthreads();
    }
    const int gw = vcu * NWAVES + wave, NGW = G * NWAVES;
    f32x4 gn[4];
#pragma unroll
    for (int j = 0; j < 4; ++j) gn[j] = *(const f32x4*)(gain + 4 * lane + 256 * j);
    for (int m = gw; m < M; m += NGW) {
        const float* xr = xin + (size_t)m * D + 4 * lane;
        f32x4 v[4]; float s = 0.f;
#pragma unroll
        for (int j = 0; j < 4; ++j) { v[j] = *(const f32x4*)(xr + 256 * j); s += (v[j].x * v[j].x + v[j].y * v[j].y) + (v[j].z * v[j].z + v[j].w * v[j].w); }
        const float rstd = 1.0f / sqrtf(wave_sum(s) * (1.f / D) + EPS);
#pragma unroll
        for (int j = 0; j < 4; ++j) v[j] = v[j] * rstd * gn[j];
        if (OUT_BF16) {
#pragma unroll
            for (int j = 0; j < 4; ++j) { v2u o; o.x = pk_bf16(v[j].x, v[j].y); o.y = pk_bf16(v[j].z, v[j].w); *(v2u*)(aop + (size_t)m * D + 4 * lane + 256 * j) = o; }
        } else {
#pragma unroll
            for (int j = 0; j < 4; ++j) *(f32x4*)(fout + (size_t)m * D + 4 * lane + 256 * j) = v[j];
        }
        if (GATE) {
            float a[16];
#pragma unroll
            for (int c = 0; c < 16; ++c) a[c] = 0.f;
#pragma unroll
            for (int c = 0; c < 16; ++c) {
#pragma unroll
                for (int j = 0; j < 4; ++j) { const f32x4 w = *(const LAS f32x4*)(WgT + c * D + 4 * lane + 256 * j); a[c] += (v[j].x * w.x + v[j].y * w.y) + (v[j].z * w.z + v[j].w * w.w); }
                if (c & 1) asm volatile("" ::: "memory"); }
            const bool b5 = lane & 32, b4 = lane & 16, b3 = lane & 8, b2 = lane & 4;
#pragma unroll
            for (int i = 0; i < 8; ++i) { const float keep = b5 ? a[i + 8] : a[i], send = b5 ? a[i] : a[i + 8]; a[i] = keep + __shfl_xor(send, 32); }
#pragma unroll
            for (int i = 0; i < 4; ++i) { const float keep = b4 ? a[i + 4] : a[i], send = b4 ? a[i] : a[i + 4]; a[i] = keep + __shfl_xor(send, 16); }
#pragma unroll
            for (int i = 0; i < 2; ++i) { const float keep = b3 ? a[i + 2] : a[i], send = b3 ? a[i] : a[i + 2]; a[i] = keep + __shfl_xor(send, 8); }
            { const float keep = b2 ? a[1] : a[0], send = b2 ? a[0] : a[1]; a[0] = keep + __shfl_xor(send, 4); }
            a[0] += __shfl_xor(a[0], 2); a[0] += __shfl_xor(a[0], 1);
            const int c = (b5 ? 8 : 0) + (b4 ? 4 : 0) + (b3 ? 2 : 0) + (b2 ? 1 : 0);
            if ((lane & 3) == 0 && c < ng) gates[(size_t)m * 16 + c] = a[0];
        }
    }
}

__device__ __forceinline__ void head_norm_rows(int lane, int wave, int vcu, int G, const bf16* hun, const float* gout, const bf16* proj, bf16* aop, const bool GLA) {
    const int gw = vcu * NWAVES + wave, NGW = G * NWAVES;
    for (int m = gw; m < M; m += NGW) {
#pragma unroll
        for (int j = 0; j < 2; ++j) {
            const int col = 8 * lane + 512 * j;
            const v4u hv = *(const v4u*)(hun + (size_t)m * D + col);
            float f[8] = {bflo(hv.x), bfhi(hv.x), bflo(hv.y), bfhi(hv.y), bflo(hv.z), bfhi(hv.z), bflo(hv.w), bfhi(hv.w)};
            float ss = 0.f;
#pragma unroll
            for (int e = 0; e < 8; ++e) ss += f[e] * f[e];
#pragma unroll
            for (int o = 1; o < 32; o <<= 1) ss += __shfl_xor(ss, o);
            const float rs = 1.0f / sqrtf(ss * (1.f / DV) + EPS);
            const f32x4 g0 = *(const f32x4*)(gout + col), g1 = *(const f32x4*)(gout + col + 4);
            const float gg[8] = {g0.x, g0.y, g0.z, g0.w, g1.x, g1.y, g1.z, g1.w};
#pragma unroll
            for (int e = 0; e < 8; ++e) f[e] = f[e] * rs * gg[e];
            if (GLA) {
                const v4u rv = *(const v4u*)(proj + (size_t)m * NPROJ + 2048 + col);
                const float r[8] = {bflo(rv.x), bfhi(rv.x), bflo(rv.y), bfhi(rv.y), bflo(rv.z), bfhi(rv.z), bflo(rv.w), bfhi(rv.w)};
#pragma unroll
                for (int e = 0; e < 8; ++e) f[e] *= r[e] / (1.0f + __expf(-r[e]));
            }
            v4u o; o.x = pk_bf16(f[0], f[1]); o.y = pk_bf16(f[2], f[3]); o.z = pk_bf16(f[4], f[5]); o.w = pk_bf16(f[6], f[7]);
            *(v4u*)(aop + (size_t)m * D + col) = o;
        }
    }
}

__device__ __forceinline__ void gla_prep(LAS unsigned char* lds, int tid, int vcu, int G, const bf16* proj, const float* gates, const float* wup, const float* bgate,
                                         bf16* QT, bf16* KT, bf16* KH, float* gdec) {
    LAS float* zl = (LAS float*)lds;
    LAS float* tot = (LAS float*)(lds + 4096);
    const int d = tid & 127, rg = tid >> 7;
    for (int unit = vcu; unit < BATCH * NCH * NH; unit += G) {
        const int h = unit & 3, bc = unit >> 2, b = bc / NCH, c = bc % NCH, tok0 = b * SEQ + c * CH;
        float wu[16];
#pragma unroll
        for (int cc = 0; cc < 16; ++cc) wu[cc] = wup[cc * QKW + h * DK + d];
        const float bg = bgate[h * DK + d];
        __syncthreads();
        if (tid < 256) *(LAS f32x4*)(zl + 4 * tid) = *(const f32x4*)(gates + (size_t)tok0 * 16 + 4 * tid);
        __syncthreads();
        float bcum[16]; float run = 0.f;
#pragma unroll
        for (int jj = 0; jj < 16; ++jj) {
            const int j = 16 * rg + jj; float z = bg;
#pragma unroll
            for (int q4 = 0; q4 < 4; ++q4) { const f32x4 zz = *(const LAS f32x4*)(zl + j * 16 + 4 * q4); z += (zz.x * wu[4 * q4] + zz.y * wu[4 * q4 + 1]) + (zz.z * wu[4 * q4 + 2] + zz.w * wu[4 * q4 + 3]); }
            const float la = (fminf(z, 0.f) - __logf(1.0f + __expf(-fabsf(z)))) * INV_TAU;
            run += la; bcum[jj] = run;
        }
        tot[rg * 128 + d] = run;
        __syncthreads();
        float off = 0.f, g = 0.f;
#pragma unroll
        for (int r2 = 0; r2 < 4; ++r2) { const float t = tot[r2 * 128 + d]; g += t; off += (r2 < rg) ? t : 0.f; }
#pragma unroll
        for (int jj = 0; jj < 16; ++jj) {
            const int j = 16 * rg + jj; const float bb = bcum[jj] + off;
            const float q = bf2f(proj[(size_t)(tok0 + j) * NPROJ + h * DK + d]), k = bf2f(proj[(size_t)(tok0 + j) * NPROJ + QKW + h * DK + d]);
            const size_t o = (size_t)(tok0 + j) * QKW + h * DK + d;
            QT[o] = f2bf1(q * QK_SCALE * __expf(bb)); KT[o] = f2bf1(k * __expf(-bb)); KH[o] = f2bf1(k * __expf(g - bb));
        }
        if (rg == 0) gdec[(size_t)unit * DK + d] = __expf(g);
    }
    __syncthreads();
}

constexpr int MX_QS = 0, MX_KS = 16384, MX_KHS = 32768, MX_V = 49152, MX_VW = 57344, MX_PS = 65536, MX_CT = 74752, MX_GV = 92160, MX_GDEC = 96256;
constexpr int PS_PITCH = 144, CT_PITCH = 272, CT_BYTES = 32 * CT_PITCH;
__device__ __forceinline__ unsigned offb(unsigned row, unsigned ch) { return 256u * row + 16u * (ch ^ (((row & 3u) << 2) | ((row >> 2) & 3u))); }
__device__ __forceinline__ bf16x8 tr8(LAS unsigned char* p0, LAS unsigned char* p1) {
    const s16x4 lo = __builtin_amdgcn_ds_read_tr16_b64_v4i16((LAS s16x4*)p0), hi = __builtin_amdgcn_ds_read_tr16_b64_v4i16((LAS s16x4*)p1);
    return __builtin_shufflevector(lo, hi, 0, 1, 2, 3, 4, 5, 6, 7);
}
#define MFMA32(a, b, c) __builtin_amdgcn_mfma_f32_32x32x16_bf16((a), (b), (c), 0, 0, 0)
struct MixArgs { const bf16 *q, *k, *kh, *proj; int qpitch; const float *gates, *bgate, *gdec; bf16* hun; };

template <bool MLSTM>
__device__ __forceinline__ void mixer_phase(LAS unsigned char* lds, int tid, int lane, int wave, int vcu, int G, const MixArgs A) {
    const int r = lane & 31, h5 = lane >> 5, blk = (lane >> 4) & 1, q4 = (lane & 15) >> 2, p4 = lane & 3;
    LAS float* GVb = (LAS float*)(lds + MX_GV);
    LAS float* GDl = (LAS float*)(lds + MX_GDEC);
    for (int unit = vcu; unit < BATCH * NH * 8; unit += G) {
        const int slice = unit & 7, bh = unit >> 3, b = bh >> 2, hh = bh & 3;
        const bf16* Qg = A.q + hh * DK; const bf16* Kg = A.k + hh * DK; const bf16* KHg = MLSTM ? nullptr : A.kh + hh * DK;
        const bf16* Vg = A.proj + 1024 + hh * DV + 32 * slice; const bf16* Og = A.proj + 2048 + hh * DV + 32 * slice;
        bf16* Hg = A.hun + hh * DV + 32 * slice;
        float bgi = 0.f, bgf = 0.f; if (MLSTM) { bgi = A.bgate[hh]; bgf = A.bgate[4 + hh]; }
        __syncthreads();
        for (int i = tid; i < 2 * CT_BYTES / 4; i += NTHREADS) ((LAS unsigned*)(lds + MX_CT))[i] = 0u;
        if (MLSTM) { for (int i = tid; i < 1024; i += NTHREADS) { const unsigned one = ((i & 15) == 0) ? 0x3F80u : 0u; ((LAS unsigned*)(lds + MX_V + 4096))[i] = one; ((LAS unsigned*)(lds + MX_VW + 4096))[i] = 0u; } }
        f32x16 accC0, accC1;
#pragma unroll
        for (int i = 0; i < 16; ++i) { accC0[i] = 0.f; accC1[i] = 0.f; }
        float m_prev = 0.f;
        v4u pq[2], pk[2], pkh[2], pv; float gi = 0.f, gf = 0.f, pgd = 0.f;
#define MX_PREFETCH(c_) do { const int tok0_ = b * SEQ + (c_) * CH; \
            _Pragma("unroll") for (int i_ = 0; i_ < 2; ++i_) { const int p_ = tid + NTHREADS * i_, row_ = p_ >> 4, ch_ = p_ & 15; \
                pq[i_] = *(const v4u*)(Qg + (size_t)(tok0_ + row_) * A.qpitch + ch_ * 8); pk[i_] = *(const v4u*)(Kg + (size_t)(tok0_ + row_) * A.qpitch + ch_ * 8); \
                if (!MLSTM) pkh[i_] = *(const v4u*)(KHg + (size_t)(tok0_ + row_) * A.qpitch + ch_ * 8); } \
            if (tid < 256) pv = *(const v4u*)(Vg + (size_t)(tok0_ + (tid >> 2)) * NPROJ + (tid & 3) * 8); \
            if (MLSTM) { gi = A.gates[(size_t)(tok0_ + lane) * 16 + hh] + bgi; gf = A.gates[(size_t)(tok0_ + lane) * 16 + 4 + hh] + bgf; } \
            else if (tid < 128) pgd = A.gdec[(size_t)(((b * NCH + (c_)) * NH) + hh) * DK + tid]; } while (0)
        MX_PREFETCH(0);
        for (int c = 0; c < NCH; ++c) {
            const int tok0 = b * SEQ + c * CH, par = c & 1;
            LAS float* GV = GVb + par * 512;
            float ws = 1.f, decay = 1.f;
            if (MLSTM) {
                const float li = gi, lf = fminf(gf, 0.f) - __logf(1.0f + __expf(-fabsf(gf)));
                float bsum = lf;
#pragma unroll
                for (int o = 1; o < 64; o <<= 1) { const float t = __shfl_up(bsum, o); if (lane >= o) bsum += t; }
                const float gtot = __shfl(bsum, 63);
                const float wp = li - bsum;
                float pm = wp;
#pragma unroll
                for (int o = 1; o < 64; o <<= 1) { const float t = __shfl_up(pm, o); if (lane >= o) pm = fmaxf(pm, t); }
                const float pm63 = __shfl(pm, 63);
                const float mx = fmaxf(m_prev, pm);
                const float mxe = fmaxf(m_prev, pm63);
                ws = __expf(wp - mxe); decay = __expf(m_prev - mxe);
                if (wave == 0) { GV[lane] = -mx; GV[64 + lane] = wp; GV[128 + lane] = __expf(m_prev - mx); GV[192 + lane] = __expf(-bsum - mx); }
                m_prev = gtot + mxe;
            }
#pragma unroll
            for (int i = 0; i < 2; ++i) { const int p = tid + NTHREADS * i, row = p >> 4, ch = p & 15; const unsigned o = offb(row, ch);
                *(LAS v4u*)(lds + MX_QS + o) = pq[i]; *(LAS v4u*)(lds + MX_KS + o) = pk[i]; if (!MLSTM) *(LAS v4u*)(lds + MX_KHS + o) = pkh[i]; }
            if (tid < 256) { const int row = tid >> 2, pc = tid & 3;
                *(LAS v4u*)(lds + MX_V + row * 64 + pc * 16) = pv;
                if (MLSTM) { const float wr_ = __shfl(ws, row); v4u o;
                    o.x = pk_bf16(bflo(pv.x) * wr_, bfhi(pv.x) * wr_); o.y = pk_bf16(bflo(pv.y) * wr_, bfhi(pv.y) * wr_); o.z = pk_bf16(bflo(pv.z) * wr_, bfhi(pv.z) * wr_); o.w = pk_bf16(bflo(pv.w) * wr_, bfhi(pv.w) * wr_);
                    *(LAS v4u*)(lds + MX_VW + row * 64 + pc * 16) = o; } }
            if (MLSTM && wave == 0) *(LAS unsigned short*)(lds + MX_VW + 4096 + lane * 64) = f2bf1(ws);
            if (!MLSTM && tid < 128) GDl[tid] = pgd;
            if (c + 1 < NCH) MX_PREFETCH(c + 1);
            __syncthreads();
            f32x16 accO;
#pragma unroll
            for (int i = 0; i < 16; ++i) accO[i] = 0.f;
            unsigned short ov[16];
            if (wave < 4) {
                const int st = wave >> 1, jt = (wave == 1 || wave == 2) ? 1 : 0;
                f32x16 acc;
#pragma unroll
                for (int i = 0; i < 16; ++i) acc[i] = 0.f;
                if (wave != 3) {
#pragma unroll
                    for (int ks = 0; ks < 8; ++ks) { const bf16x8 a = *(const LAS bf16x8*)(lds + MX_KS + offb(32 * st + r, 2 * ks + h5)), bq = *(const LAS bf16x8*)(lds + MX_QS + offb(32 * jt + r, 2 * ks + h5)); acc = MFMA32(a, bq, acc); }
                }
                const int j = 32 * jt + r; const float uj = MLSTM ? GV[j] : 0.f;
#pragma unroll
                for (int g4 = 0; g4 < 4; ++g4) { const int s0 = 32 * st + 8 * g4 + 4 * h5; f32x4 wps = {0.f, 0.f, 0.f, 0.f}; if (MLSTM) wps = *(const LAS f32x4*)(GV + 64 + s0);
                    float v[4];
#pragma unroll
                    for (int e = 0; e < 4; ++e) { float x = acc[4 * g4 + e]; if (MLSTM) x *= __expf(uj + wps[e]); v[e] = (s0 + e <= j) ? x : 0.f; }
                    v2u o; o.x = pk_bf16(v[0], v[1]); o.y = pk_bf16(v[2], v[3]); *(LAS v2u*)(lds + MX_PS + j * PS_PITCH + s0 * 2) = o; }
            } else {
                const int g = (wave - 4) >> 1, jt = wave & 1;
                if (MLSTM || g == 0) {
                    if (MLSTM && g == 0) {
#pragma unroll
                        for (int i = 0; i < 16; ++i) ov[i] = Og[(size_t)(tok0 + 32 * jt + (i & 3) + 8 * (i >> 2) + 4 * h5) * NPROJ + r];
                    }
#pragma unroll
                    for (int ks = 0; ks < 8; ++ks) { const bf16x8 a = *(const LAS bf16x8*)(lds + MX_QS + offb(32 * jt + r, 2 * ks + h5)), bc = *(const LAS bf16x8*)(lds + MX_CT + g * CT_BYTES + r * CT_PITCH + 32 * ks + 16 * h5); accO = MFMA32(a, bc, accO); }
                    if (MLSTM) {
#pragma unroll
                        for (int g4 = 0; g4 < 4; ++g4) { const f32x4 wi = *(const LAS f32x4*)(GV + 128 + 32 * jt + 8 * g4 + 4 * h5);
#pragma unroll
                            for (int e = 0; e < 4; ++e) accO[4 * g4 + e] *= wi[e]; }
                    }
                }
            }
            __syncthreads();
            if (wave < 4) {
                if (MLSTM) { accC0 = accC0 * decay; accC1 = accC1 * decay; }
                else {
#pragma unroll
                    for (int g4 = 0; g4 < 4; ++g4) { const f32x4 dc = *(const LAS f32x4*)(GDl + 32 * wave + 8 * g4 + 4 * h5);
#pragma unroll
                        for (int e = 0; e < 4; ++e) accC0[4 * g4 + e] *= dc[e]; }
                }
                LAS unsigned char* kimg = lds + (MLSTM ? MX_KS : MX_KHS);
                LAS unsigned char* vimg = lds + (MLSTM ? MX_VW : MX_V);
#pragma unroll
                for (int ks = 0; ks < 4; ++ks) {
                    const int row0 = 16 * ks + 8 * h5 + q4;
                    const bf16x8 a = tr8(kimg + offb(row0, 4 * wave + 2 * blk + (p4 >> 1)) + 8 * (p4 & 1), kimg + offb(row0 + 4, 4 * wave + 2 * blk + (p4 >> 1)) + 8 * (p4 & 1));
                    const bf16x8 b0 = tr8(vimg + row0 * 64 + 32 * blk + 8 * p4, vimg + (row0 + 4) * 64 + 32 * blk + 8 * p4);
                    accC0 = MFMA32(a, b0, accC0);
                    if (MLSTM) { const bf16x8 b1 = tr8(vimg + 4096 + row0 * 64 + 32 * blk + 8 * p4, vimg + 4096 + (row0 + 4) * 64 + 32 * blk + 8 * p4); accC1 = MFMA32(a, b1, accC1); }
                }
#pragma unroll
                for (int g4 = 0; g4 < 4; ++g4) { const int d0 = 32 * wave + 8 * g4 + 4 * h5;
                    v2u o; o.x = pk_bf16(accC0[4 * g4], accC0[4 * g4 + 1]); o.y = pk_bf16(accC0[4 * g4 + 2], accC0[4 * g4 + 3]); *(LAS v2u*)(lds + MX_CT + r * CT_PITCH + d0 * 2) = o;
                    if (MLSTM) { v2u o1; o1.x = pk_bf16(accC1[4 * g4], accC1[4 * g4 + 1]); o1.y = pk_bf16(accC1[4 * g4 + 2], accC1[4 * g4 + 3]); *(LAS v2u*)(lds + MX_CT + CT_BYTES + r * CT_PITCH + d0 * 2) = o1; } }
            } else {
                const int g = (wave - 4) >> 1, jt = wave & 1;
                if (MLSTM || g == 0) {
                    LAS unsigned char* vimg = lds + MX_V + g * 4096;
#pragma unroll
                    for (int ks = 0; ks < 4; ++ks) { const int row0 = 16 * ks + 8 * h5 + q4;
                        const bf16x8 a = *(const LAS bf16x8*)(lds + MX_PS + (32 * jt + r) * PS_PITCH + 32 * ks + 16 * h5);
                        const bf16x8 bv = tr8(vimg + row0 * 64 + 32 * blk + 8 * p4, vimg + (row0 + 4) * 64 + 32 * blk + 8 * p4);
                        accO = MFMA32(a, bv, accO); }
                    if (MLSTM && g == 1 && r == 0) {
#pragma unroll
                        for (int i = 0; i < 16; ++i) GV[256 + 32 * jt + (i & 3) + 8 * (i >> 2) + 4 * h5] = accO[i];
                    }
                }
            }
            __syncthreads();
            if (wave == 4 || wave == 5) {
                const int jt = wave & 1;
#pragma unroll
                for (int g4 = 0; g4 < 4; ++g4) { const int j0 = 32 * jt + 8 * g4 + 4 * h5;
                    f32x4 dn = {1.f, 1.f, 1.f, 1.f}, em = {1.f, 1.f, 1.f, 1.f};
                    if (MLSTM) { dn = *(const LAS f32x4*)(GV + 256 + j0); em = *(const LAS f32x4*)(GV + 192 + j0); }
#pragma unroll
                    for (int e = 0; e < 4; ++e) { float val = accO[4 * g4 + e];
                        if (MLSTM) { const float rden = QK_SCALE / fmaxf(fabsf(dn[e]) * QK_SCALE, em[e]); const float o = bf2f(ov[4 * g4 + e]); val = val * rden / (1.0f + __expf(-o)); }
                        Hg[(size_t)(tok0 + j0 + e) * D + r] = f2bf1(val); } }
            }
        }
#undef MX_PREFETCH
    }
    __syncthreads();
}

constexpr int N_PHASES = 19;
struct Args { const float* in[15]; float* out; unsigned char* ws; int ph_lo, ph_hi; };
template <int PH>
__device__ __forceinline__ void run_phase(const Args& args, LAS unsigned char* lds, int tid, int lane, int wave, int vcu, int G, int bx) {
    unsigned char* ws = args.ws; float* out = args.out;
    constexpr int layer = (PH >= 9 && PH < 18) ? 1 : 0, k = (PH == 18) ? 9 : PH - 9 * layer;
    bf16* AOP = (bf16*)(ws + WS_AOP); bf16* PROJ = (bf16*)(ws + WS_PROJ); bf16* HUN = (bf16*)(ws + WS_HUN); bf16* HMID = (bf16*)(ws + WS_HMID);
    float* GATES = (float*)(ws + WS_GATES);
    if constexpr (k == 0) {
        const float* w_in = args.in[layer ? 8 : 4]; const int ld_in = layer ? GLA_IN : MLSTM_IN;
        convert_weights(lds, lane, wave, vcu, G, w_in, ld_in, args.in[layer ? 12 : 7], args.in[13] + (size_t)layer * D * FF, args.in[14] + (size_t)layer * D * FF, ws);
        norm_rows<true, true>(lds, tid, lane, wave, vcu, G, layer ? out : args.in[0], args.in[1] + layer * D, AOP, nullptr, w_in + NPROJ, ld_in, layer ? 16 : 8, GATES);
    } else if constexpr (k == 1) {
        pg8::Gemm g{AOP, (const bf16*)(ws + WS_WIN), M, NPROJ, D}; pg8::StaticOrder S; S.init(M, NPROJ, G, bx);
        pg8::EpiBf16<0> E{PROJ, NPROJ};
        pg8::gemm_phase<pg8::EpiBf16<0>, pg8::StaticOrder, true, true>(lds, g, S, E);
    } else if constexpr (k == 2) {
        if (layer) gla_prep(lds, tid, vcu, G, PROJ, GATES, args.in[9], args.in[10], (bf16*)(ws + WS_QT), (bf16*)(ws + WS_KT), (bf16*)(ws + WS_KH), (float*)(ws + WS_GDEC));
    } else if constexpr (k == 3) {
        if (layer == 0) { const MixArgs A{PROJ, PROJ + QKW, nullptr, PROJ, NPROJ, GATES, args.in[5], nullptr, HUN}; mixer_phase<true>(lds, tid, lane, wave, vcu, G, A); }
        else { const MixArgs A{(const bf16*)(ws + WS_QT), (const bf16*)(ws + WS_KT), (const bf16*)(ws + WS_KH), PROJ, QKW, nullptr, nullptr, (const float*)(ws + WS_GDEC), HUN}; mixer_phase<false>(lds, tid, lane, wave, vcu, G, A); }
    } else if constexpr (k == 4) {
        head_norm_rows(lane, wave, vcu, G, HUN, args.in[layer ? 11 : 6], PROJ, AOP, layer != 0);
    } else if constexpr (k == 5) {
        pg8::Gemm g{AOP, (const bf16*)(ws + WS_WOUT), M, D, D}; pg8::StaticOrder S; S.init(M, D, G, bx);
        pg8::EpiResF32 E{layer ? out : args.in[0], out, D};
        pg8::gemm_phase<pg8::EpiResF32, pg8::StaticOrder, false, true>(lds, g, S, E);
    } else if constexpr (k == 6) {
        norm_rows<false, true>(lds, tid, lane, wave, vcu, G, out, args.in[2] + layer * D, AOP, nullptr, nullptr, 0, 0, nullptr);
    } else if constexpr (k == 7) {
        pg8::Gemm g{AOP, (const bf16*)(ws + WS_W1), M, FF, D}; pg8::StaticOrder S; S.init(M, FF, G, bx);
        pg8::EpiBf16<2> E{HMID, FF};
        pg8::gemm_phase<pg8::EpiBf16<2>, pg8::StaticOrder, true, true>(lds, g, S, E);
    } else if constexpr (k == 8) {
        pg8::Gemm g{HMID, (const bf16*)(ws + WS_W2), M, D, FF}; pg8::StaticOrder S; S.init(M, D, G, bx);
        pg8::EpiResF32 E{out, out, D};
        pg8::gemm_phase<pg8::EpiResF32, pg8::StaticOrder, false, true>(lds, g, S, E);
    } else {
        norm_rows<false, false>(lds, tid, lane, wave, vcu, G, out, args.in[3], nullptr, out, nullptr, 0, 0, nullptr);
    }
}
__global__ void __launch_bounds__(NTHREADS, 2) fwd_kernel(Args args) {
    extern __shared__ __attribute__((aligned(16))) unsigned char lds_raw[];
    LAS unsigned char* lds = (LAS unsigned char*)lds_raw;
    volatile LAS unsigned* MISC = (volatile LAS unsigned*)(lds + MISC_OFF);
    const int tid = threadIdx.x, lane = tid & 63, wave = __builtin_amdgcn_readfirstlane(tid >> 6);
    const int G = gridDim.x; const int bx = blockIdx.x; const int vcu = (G % 8 == 0) ? (bx % 8) * (G / 8) + bx / 8 : bx;
    for (int u = tid; u < (LDS_BYTES - LDSCTL_OFF) / 4; u += NTHREADS) ((LAS unsigned*)(lds + LDSCTL_OFF))[u] = 0u;
    __syncthreads();
    const int lo = args.ph_lo, hi = args.ph_hi;
    XcdBarrier bar; bar.bar = (unsigned*)(args.ws + WS_CTL) + CW_BAR; bar.x = 0; bar.st = nullptr;
    if (hi - lo > 1) bar = xcd_barrier_post((unsigned*)(args.ws + WS_CTL) + CW_BAR, MISC + 8);
#define PHASE(p) if (lo <= (p) && (p) < hi) { run_phase<p>(args, lds, tid, lane, wave, vcu, G, bx); if ((p) + 1 < hi && (p) != 2) xcd_barrier(bar); }
    PHASE(0) PHASE(1) PHASE(2) PHASE(3) PHASE(4) PHASE(5) PHASE(6) PHASE(7) PHASE(8) PHASE(9) PHASE(10) PHASE(11) PHASE(12) PHASE(13) PHASE(14) PHASE(15) PHASE(16) PHASE(17) PHASE(18)
#undef PHASE
}

extern "C" void kernel_launch(void* const* d_in, const int* in_sizes, int n_in, void* d_out, int out_size, void* d_ws, size_t ws_size, hipStream_t stream) {
    static int grid = 0;
    if (grid == 0) {
        if (n_in != 15 || in_sizes[0] != M * D || out_size != M * D || ws_size < WS_END) { fprintf(stderr, "kernel_launch: unexpected shapes (n_in %d, in0 %d, out %d, ws %zu); nothing launched\n", n_in, n_in > 0 ? in_sizes[0] : -1, out_size, ws_size); grid = -1; return; }
        int dev = 0, cus = 0, per_cu = 0;
        if (hipGetDevice(&dev) != hipSuccess || hipDeviceGetAttribute(&cus, hipDeviceAttributeMultiprocessorCount, dev) != hipSuccess) { grid = -1; return; }
        if (hipFuncSetAttribute((const void*)fwd_kernel, hipFuncAttributeMaxDynamicSharedMemorySize, LDS_BYTES) != hipSuccess) { fprintf(stderr, "kernel_launch: hipFuncSetAttribute failed\n"); grid = -1; return; }
        if (hipOccupancyMaxActiveBlocksPerMultiprocessor(&per_cu, (const void*)fwd_kernel, NTHREADS, LDS_BYTES) != hipSuccess || per_cu < 1) { fprintf(stderr, "kernel_launch: occupancy query says %d blocks per CU\n", per_cu); (void)hipGetLastError(); grid = -1; return; }
        grid = cus;
    }
    if (grid < 0) return;
    (void)hipMemsetAsync((char*)d_ws + WS_CTL, 0, CTL_ZERO_BYTES, stream);
    Args a{};
    for (int i = 0; i < 15; ++i) a.in[i] = (const float*)d_in[i];
    a.out = (float*)d_out; a.ws = (unsigned char*)d_ws;
    if (MK_N_LAUNCHES == 1) {
        a.ph_lo = 0; a.ph_hi = N_PHASES;
        void* kargs[] = {&a};
        const hipError_t e = hipLaunchCooperativeKernel((const void*)fwd_kernel, dim3(grid), dim3(NTHREADS), kargs, LDS_BYTES, stream);
        if (e != hipSuccess) fprintf(stderr, "kernel_launch: cooperative launch failed: %s (grid %d)\n", hipGetErrorString(e), grid);
    } else {
        for (int p = 0; p < N_PHASES; ++p) { a.ph_lo = p; a.ph_hi = p + 1; hipLaunchKernelGGL(fwd_kernel, dim3(grid), dim3(NTHREADS), LDS_BYTES, stream, a); }
    }
}
```

```cpp
#include <hip/hip_runtime.h>
#include <cstdio>
#include <cstdint>
namespace pg8 {
#define PG8_LAS __attribute__((address_space(3)))
typedef unsigned short bf16_t;
typedef short bf16x8 __attribute__((ext_vector_type(8)));
typedef float f32x4 __attribute__((ext_vector_type(4)));
typedef unsigned u32x4 __attribute__((ext_vector_type(4)));
constexpr int BM = 256, BK = 64, HALF = 128, HTB = HALF * BK * 2  , STAGE_BYTES = 8 * HTB, NXCD = 8, WGM = 8;

__host__ __device__ __forceinline__ int lds_byte(int r, int c) { const int st = (r >> 4) * 2 + (c >> 5), rr = r & 15, cc = c & 31, ob = rr * 64 + cc * 2; return st * 1024 + (ob ^ (((ob >> 9) & 1) << 5)); }
__host__ __device__ __forceinline__ void stage_rc(int b, int& R, int& C) { const int st = b / 1024, sb = b % 1024, swz = sb ^ (((sb >> 9) & 1) << 5); R = (st >> 1) * 16 + swz / 64; C = (st & 1) * 32 + (swz % 64) / 2; }
__host__ __device__ __forceinline__ int perm32(int rho) { const int n = rho >> 4, i = rho & 15; return 8 * (i >> 2) + 4 * n + (i & 3); }

struct Unit { int pm, pn; };
struct Gemm { const bf16_t* A; const bf16_t* Bt; int M, N, K; };

struct StaticOrder {
    int nM, nN, nwg, G, c;
    __host__ __device__ void init(int M, int N, int G_, int c_) { nM = M / BM; nN = N / BM; nwg = nM * nN; G = G_; c = c_; }
    __host__ __device__ bool next(int i, Unit& u) const {
        const long L = (long)i * G + c; if (L >= nwg) return false;
        int wgid = (int)L; { const int q = nwg / NXCD, r = nwg % NXCD, xcd = wgid % NXCD, off = wgid / NXCD; wgid = (xcd < r ? xcd * (q + 1) : r * (q + 1) + (xcd - r) * q) + off; }
        const int nig = WGM * nN, gid = wgid / nig, fm = gid * WGM, gsz = (nM - fm) < WGM ? (nM - fm) : WGM;
        u.pm = fm + ((wgid % nig) % gsz); u.pn = (wgid % nig) / gsz; return true;
    }
    __device__ __forceinline__ void a_ready(const Unit&) const {}
    __device__ __forceinline__ void done(const Unit&) const {}
};

__device__ __forceinline__ unsigned cvt_pk_bf16(float lo, float hi) { unsigned r; asm volatile("v_cvt_pk_bf16_f32 %0, %1, %2" : "=v"(r) : "v"(lo), "v"(hi)); return r; }
typedef float f32x2 __attribute__((ext_vector_type(2)));
typedef __bf16 bf16x2_t __attribute__((ext_vector_type(2)));
__device__ __forceinline__ unsigned pk_bf16(float lo, float hi) { f32x2 v = {lo, hi}; bf16x2_t r = __builtin_convertvector(v, bf16x2_t); return __builtin_bit_cast(unsigned, r); }
template <int ACT  > struct EpiBf16 {
    static constexpr bool PERM = true, AFTER_DRAIN = false;
    bf16_t* O; int ldc;
    __device__ __forceinline__ void operator()(const f32x4 (&acc)[2][2][4][2], const Unit& u, int wr, int wc, int fr, int fq) const {
        const int row0 = u.pm * BM + wr * 64 + fr, col0 = u.pn * BM + wc * 32 + 8 * fq;
#pragma unroll
        for (int ai = 0; ai < 2; ++ai)
#pragma unroll
            for (int m = 0; m < 4; ++m) { bf16_t* rowp = O + (size_t)(row0 + ai * HALF + m * 16) * ldc + col0;
#pragma unroll
                for (int bj = 0; bj < 2; ++bj) { f32x4 v0 = acc[ai][bj][m][0], v1 = acc[ai][bj][m][1];
                    if (ACT == 2) { const f32x4 z = {0.f, 0.f, 0.f, 0.f}; v0 = __builtin_elementwise_max(v0, z); v1 = __builtin_elementwise_max(v1, z); v0 = v0 * v0; v1 = v1 * v1; }
                    u32x4 w; w.x = pk_bf16(v0[0], v0[1]); w.y = pk_bf16(v0[2], v0[3]); w.z = pk_bf16(v1[0], v1[1]); w.w = pk_bf16(v1[2], v1[3]);
                    *(u32x4*)(rowp + bj * HALF) = w; } }
    }
};
struct EpiResF32 {
    static constexpr bool PERM = false, AFTER_DRAIN = true;
    const float* base; float* out; int ldc;
    __device__ __forceinline__ void fused(const f32x4 (&acc)[2][2][4][2], const Unit& u, int wr, int wc, int fr, int fq, PG8_LAS unsigned char*, int, int) const {
        const int col0 = u.pn * BM + wc * 32 + 4 * fq;
#pragma unroll
        for (int ai = 0; ai < 2; ++ai)
#pragma unroll
            for (int m = 0; m < 4; ++m) { const int r = ai * HALF + wr * 64 + m * 16 + fr; const size_t off = (size_t)(u.pm * BM + r) * ldc + col0;
#pragma unroll
                for (int bj = 0; bj < 2; ++bj) { const f32x4 b0 = *(const f32x4*)(base + off + bj * HALF), b1 = *(const f32x4*)(base + off + bj * HALF + 16);
                    *(f32x4*)(out + off + bj * HALF) = b0 + acc[ai][bj][m][0]; *(f32x4*)(out + off + bj * HALF + 16) = b1 + acc[ai][bj][m][1];
                    asm volatile("" ::: "memory"); } }
    }
};
template <class Epi, class Sched, bool ALIGN_EPI = false, bool SP2 = false>
__device__ __forceinline__ void gemm_phase(PG8_LAS unsigned char* lds, const Gemm g, const Sched& S, const Epi& E) {
    const int tid = threadIdx.x, wid = __builtin_amdgcn_readfirstlane(tid >> 6), lane = tid & 63, wr = wid >> 2, wc = wid & 3, fr = lane & 15, fq = lane >> 4;
    const int K = g.K, nt = K / BK;
    unsigned voffA[2], voffB[2];
#pragma unroll
    for (int i = 0; i < 2; ++i) { int R, C; stage_rc(tid * 16 + i * 8192, R, C); const int Rb = Epi::PERM ? ((R & ~31) + perm32(R & 31)) : R;
        voffA[i] = (unsigned)(R * K + C) * 2u; voffB[i] = (unsigned)(Rb * K + C) * 2u; }
    const size_t kstep = (size_t)(BK * 2);
    const size_t hstep = (size_t)HALF * K * 2;
    const size_t tstep = 2 * hstep;
    const unsigned ldsw = (unsigned)wid * 1024u;
    const int aoff = lds_byte(wr * 64 + fr, fq * 8), boff = lds_byte(wc * 32 + fr, fq * 8);
#define PG8_SA(b, h) (((b) * 2 + (h)) * HTB)
#define PG8_SB(b, h) ((4 + (b) * 2 + (h)) * HTB)
#define PG8_STAGE(bufoff, gbase, voff) do { _Pragma("unroll") for (int _i = 0; _i < 2; ++_i) \
        __builtin_amdgcn_global_load_lds((const unsigned*)((const char*)(gbase) + (voff)[_i]), (PG8_LAS unsigned*)(lds + (bufoff) + ldsw + _i * 8192), 16, 0, 0); } while (0)
#define PG8_LDA(dst, b, h) do { _Pragma("unroll") for (int m = 0; m < 4; ++m) _Pragma("unroll") for (int k = 0; k < 2; ++k) dst[m][k] = *(const PG8_LAS bf16x8*)(lds + PG8_SA(b, h) + aoff + m * 2048 + k * 1024); } while (0)
#define PG8_LDB(dst, b, h) do { _Pragma("unroll") for (int n = 0; n < 2; ++n) _Pragma("unroll") for (int k = 0; k < 2; ++k) dst[n][k] = *(const PG8_LAS bf16x8*)(lds + PG8_SB(b, h) + boff + n * 2048 + k * 1024); } while (0)
#define PG8_MMA(ai, bj, At, Bt) do { __builtin_amdgcn_s_setprio(1); _Pragma("unroll") for (int m = 0; m < 4; ++m) _Pragma("unroll") for (int n = 0; n < 2; ++n) _Pragma("unroll") for (int k = 0; k < 2; ++k) \
        acc[ai][bj][m][n] = __builtin_amdgcn_mfma_f32_16x16x32_bf16(Bt[n][k], At[m][k], acc[ai][bj][m][n], 0, 0, 0); __builtin_amdgcn_s_setprio(0); } while (0)
#define PG8_WAIT_V(n) asm volatile("s_waitcnt vmcnt(" #n ")" ::: "memory")
#define PG8_WAIT_L(n) asm volatile("s_waitcnt lgkmcnt(" #n ")" ::: "memory")
#define PG8_BAR __builtin_amdgcn_s_barrier()
#define PG8_SCHED __builtin_amdgcn_sched_barrier(0)
    Unit cur, nxt; int ui = 0;
    if (!S.next(0, cur)) return;
    f32x4 acc[2][2][4][2];
#pragma unroll
    for (int a = 0; a < 2; ++a)
#pragma unroll
        for (int b = 0; b < 2; ++b)
#pragma unroll
            for (int m = 0; m < 4; ++m)
#pragma unroll
                for (int n = 0; n < 2; ++n) acc[a][b][m][n] = (f32x4){0.f, 0.f, 0.f, 0.f};
    bf16x8 At[4][2], B0[2][2], B1[2][2];
    const char* cA = (const char*)g.A + (size_t)cur.pm * tstep; const char* cB = (const char*)g.Bt + (size_t)cur.pn * tstep;
    S.a_ready(cur);
    if constexpr (SP2) {
        PG8_STAGE(PG8_SB(0, 0), cB, voffB); PG8_STAGE(PG8_SB(0, 1), cB + hstep, voffB); PG8_STAGE(PG8_SA(0, 0), cA, voffA); PG8_STAGE(PG8_SA(0, 1), cA + hstep, voffA);
        if (wr == 1) PG8_BAR;
        PG8_WAIT_V(2); PG8_BAR;
        PG8_STAGE(PG8_SB(1, 0), cB + kstep, voffB); PG8_STAGE(PG8_SA(1, 0), cA + kstep, voffA); PG8_STAGE(PG8_SB(1, 1), cB + hstep + kstep, voffB);
        PG8_WAIT_V(6); PG8_BAR;
    } else {
        PG8_STAGE(PG8_SB(0, 0), cB, voffB); PG8_STAGE(PG8_SA(0, 0), cA, voffA); PG8_STAGE(PG8_SB(0, 1), cB + hstep, voffB); PG8_STAGE(PG8_SA(0, 1), cA + hstep, voffA);
        if (wr == 1) PG8_BAR;
        PG8_WAIT_V(4); PG8_BAR;
        PG8_STAGE(PG8_SB(1, 0), cB + kstep, voffB); PG8_STAGE(PG8_SA(1, 0), cA + kstep, voffA); PG8_STAGE(PG8_SB(1, 1), cB + hstep + kstep, voffB);
        PG8_WAIT_V(6); PG8_BAR;
    }
    for (;;) {
        const bool has_next = S.next(ui + 1, nxt);
        const char* nA = has_next ? (const char*)g.A + (size_t)nxt.pm * tstep : cA; const char* nB = has_next ? (const char*)g.Bt + (size_t)nxt.pn * tstep : cB;
        for (int t = 0; t < nt; t += 2) {
            const bool last = (t == nt - 2);
            const char* a1 = cA + (size_t)(t + 1) * kstep;
            const char* a2 = last ? nA : cA + (size_t)(t + 2) * kstep; const char* b2 = last ? nB : cB + (size_t)(t + 2) * kstep;
            const char* a3 = a2 + kstep; const char* b3 = b2 + kstep;
            if (last && has_next) S.a_ready(nxt);
            if constexpr (SP2) {
            PG8_LDB(B0, 0, 0); PG8_LDB(B1, 0, 1); PG8_SCHED; PG8_LDA(At, 0, 0); PG8_STAGE(PG8_SA(1, 1), a1 + hstep, voffA);
            PG8_WAIT_V(8); PG8_WAIT_L(0); PG8_BAR; PG8_MMA(0, 0, At, B0); PG8_MMA(0, 1, At, B1); PG8_BAR; PG8_SCHED;
            PG8_LDA(At, 0, 1); PG8_STAGE(PG8_SB(0, 0), b2, voffB); PG8_STAGE(PG8_SB(0, 1), b2 + hstep, voffB); PG8_STAGE(PG8_SA(0, 0), a2, voffA);
            PG8_WAIT_V(8); PG8_WAIT_L(0); PG8_BAR; PG8_MMA(1, 0, At, B0); PG8_MMA(1, 1, At, B1); PG8_BAR; PG8_SCHED;
            PG8_LDB(B0, 1, 0); PG8_LDB(B1, 1, 1); PG8_SCHED; PG8_LDA(At, 1, 0); PG8_STAGE(PG8_SA(0, 1), a2 + hstep, voffA);
            PG8_WAIT_V(8); PG8_WAIT_L(0); PG8_BAR; PG8_MMA(0, 0, At, B0); PG8_MMA(0, 1, At, B1); PG8_BAR; PG8_SCHED;
            PG8_LDA(At, 1, 1); PG8_STAGE(PG8_SB(1, 0), b3, voffB); PG8_STAGE(PG8_SB(1, 1), b3 + hstep, voffB); PG8_STAGE(PG8_SA(1, 0), a3, voffA);
            PG8_WAIT_V(8); PG8_WAIT_L(0); PG8_BAR; PG8_MMA(1, 0, At, B0); PG8_MMA(1, 1, At, B1); PG8_BAR; PG8_SCHED;
            } else {
            PG8_LDB(B0, 0, 0); PG8_SCHED; PG8_LDA(At, 0, 0); PG8_STAGE(PG8_SA(1, 1), a1 + hstep, voffA);
            PG8_WAIT_L(8); PG8_BAR; PG8_WAIT_L(0); PG8_MMA(0, 0, At, B0); PG8_BAR; PG8_SCHED;
            PG8_LDB(B1, 0, 1); PG8_STAGE(PG8_SB(0, 0), b2, voffB);
            PG8_BAR; PG8_WAIT_L(0); PG8_MMA(0, 1, At, B1); PG8_BAR;
            PG8_LDA(At, 0, 1); PG8_STAGE(PG8_SA(0, 0), a2, voffA);
            PG8_BAR; PG8_WAIT_L(0); PG8_MMA(1, 0, At, B0); PG8_BAR; PG8_SCHED;
            PG8_STAGE(PG8_SB(0, 1), b2 + hstep, voffB);
            PG8_WAIT_V(6); PG8_BAR; PG8_MMA(1, 1, At, B1); PG8_BAR;
            PG8_LDB(B0, 1, 0); PG8_SCHED; PG8_LDA(At, 1, 0); PG8_STAGE(PG8_SA(0, 1), a2 + hstep, voffA);
            PG8_WAIT_L(8); PG8_BAR; PG8_WAIT_L(0); PG8_MMA(0, 0, At, B0); PG8_BAR; PG8_SCHED;
            PG8_LDB(B1, 1, 1); PG8_STAGE(PG8_SB(1, 0), b3, voffB);
            PG8_BAR; PG8_WAIT_L(0); PG8_MMA(0, 1, At, B1); PG8_BAR;
            PG8_LDA(At, 1, 1); PG8_STAGE(PG8_SA(1, 0), a3, voffA);
            PG8_BAR; PG8_WAIT_L(0); PG8_MMA(1, 0, At, B0); PG8_BAR; PG8_SCHED;
            PG8_STAGE(PG8_SB(1, 1), b3 + hstep, voffB);
            PG8_WAIT_V(6); PG8_BAR; PG8_MMA(1, 1, At, B1); PG8_BAR;
            }
        }
        if constexpr (ALIGN_EPI) { if (wr == 0) PG8_BAR; }
        if constexpr (!Epi::AFTER_DRAIN) { E(acc, cur, wr, wc, fr, fq); S.done(cur); }
        if (!has_next) break;
#pragma unroll
        for (int a = 0; a < 2; ++a)
#pragma unroll
            for (int b = 0; b < 2; ++b)
#pragma unroll
                for (int m = 0; m < 4; ++m)
#pragma unroll
                    for (int n = 0; n < 2; ++n) acc[a][b][m][n] = (f32x4){0.f, 0.f, 0.f, 0.f};
        cur = nxt; cA = nA; cB = nB; ++ui;
        if constexpr (ALIGN_EPI) { if (wr == 1) PG8_BAR; }
    }
    PG8_WAIT_V(0);
    if constexpr (!ALIGN_EPI) { if (wr == 0) PG8_BAR; }
    PG8_BAR;
    if constexpr (Epi::AFTER_DRAIN) { E.fused(acc, cur, wr, wc, fr, fq, lds, wid, lane); S.done(cur); }
#undef PG8_SA
#undef PG8_SB
#undef PG8_STAGE
#undef PG8_LDA
#undef PG8_LDB
#undef PG8_MMA
#undef PG8_WAIT_V
#undef PG8_WAIT_L
#undef PG8_BAR
#undef PG8_SCHED
}
}

constexpr int NWAVES = 8, NTHREADS = 512;
#ifndef MK_N_LAUNCHES
#define MK_N_LAUNCHES 1
#endif
constexpr int BATCH = 8, SEQ = 2048, D = 1024, FF = 4096, NH = 4, DK = 128, DV = 256, QKW = 512, VW = 1024;
constexpr int M = BATCH * SEQ, NPROJ = 3072, CH = 64, NCH = SEQ / CH;
constexpr int MLSTM_IN = 3080, GLA_IN = 3088;
constexpr float EPS = 1e-6f, QK_SCALE = 0.08838834764831845f, INV_TAU = 1.0f / 16.0f;

constexpr size_t MiB = 1u << 20;
constexpr size_t WS_CTL = 0, CTL_ZERO_BYTES = 64 * 1024;
constexpr size_t WS_GATES = 1 * MiB;
constexpr size_t WS_GDEC = 2 * MiB;
constexpr size_t WS_WIN = 4 * MiB, WS_WOUT = 10 * MiB, WS_W1 = 12 * MiB, WS_W2 = 20 * MiB;
constexpr size_t WS_AOP = 28 * MiB;
constexpr size_t WS_HUN = 60 * MiB;
constexpr size_t WS_PROJ = 92 * MiB;
constexpr size_t WS_QT = 188 * MiB, WS_KT = 204 * MiB, WS_KH = 220 * MiB;
constexpr size_t WS_HMID = 92 * MiB;
constexpr size_t WS_END = 236 * MiB;
constexpr int CW_BAR = 1024;

constexpr int RING_BYTES = 131072, LDS_BYTES = 155648, LDSCTL_OFF = LDS_BYTES - 1024, MISC_OFF = LDSCTL_OFF + 320;

#define GAS __attribute__((address_space(1)))
#define LAS __attribute__((address_space(3)))
typedef unsigned short bf16;
typedef unsigned v4u __attribute__((ext_vector_type(4)));
typedef unsigned v2u __attribute__((ext_vector_type(2)));
typedef float f32x4 __attribute__((ext_vector_type(4)));
typedef float f32x16 __attribute__((ext_vector_type(16)));
typedef short bf16x8 __attribute__((ext_vector_type(8)));
typedef short s16x4 __attribute__((ext_vector_type(4)));
typedef GAS unsigned gu32;
#define RLX_AGENT __ATOMIC_RELAXED, __HIP_MEMORY_SCOPE_AGENT
#define LDS_WAIT() asm volatile("s_waitcnt lgkmcnt(0)" ::: "memory")
#define VM_WAIT() asm volatile("s_waitcnt vmcnt(0)" ::: "memory")
using pg8::pk_bf16;
__device__ __forceinline__ float bf2f(unsigned b) { return __uint_as_float(b << 16); }
__device__ __forceinline__ float bflo(unsigned w) { return __uint_as_float(w << 16); }
__device__ __forceinline__ float bfhi(unsigned w) { return __uint_as_float(w & 0xffff0000u); }
__device__ __forceinline__ unsigned short f2bf1(float f) { return (unsigned short)(pk_bf16(f, 0.f) & 0xffffu); }

#define XB_TMO      128
#define XB_XCNT(j)  (256  + 64 * (j))
#define XB_XSUB(j)  (1280 + 64 * (j))
#define XB_XGEN(j)  (2304 + 64 * (j))
#define XB_TOP      3328
#define XB_TOPGEN   3392
#define XCD_BAR_WORDS 3456
#define XB_SPIN_CAP (1u << 18)
__device__ __forceinline__ unsigned xb_ld(unsigned* p)              { return __hip_atomic_load(p, __ATOMIC_RELAXED, __HIP_MEMORY_SCOPE_AGENT); }
__device__ __forceinline__ unsigned xb_add(unsigned* p, unsigned v) { return __hip_atomic_fetch_add(p, v, __ATOMIC_RELAXED, __HIP_MEMORY_SCOPE_AGENT); }
__device__ __forceinline__ unsigned xb_xcc_id() { return (unsigned)__builtin_amdgcn_s_getreg((3 << 11) | 20) & 0xFu; }
#define XB_SPIN(cond, bar) do { unsigned _sp = 0; while (cond) { __builtin_amdgcn_s_sleep(1); \
    if ((++_sp & 255u) == 0u) { if (xb_ld(&(bar)[XB_TMO])) break; if (_sp > XB_SPIN_CAP) { atomicAdd(&(bar)[XB_TMO], 1u); break; } } } } while (0)
struct XcdBarrier { unsigned* bar; unsigned x; volatile LAS unsigned* st; };
__device__ __forceinline__ XcdBarrier xcd_barrier_post(unsigned* bar, volatile LAS unsigned* st) {
    XcdBarrier b; b.bar = bar; b.x = xb_xcc_id(); b.st = st;
    if (threadIdx.x == 0) (void)xb_add(&bar[XB_XCNT(b.x)], 1u);
    return b;
}
__device__ __forceinline__ void xcd_barrier_complete(unsigned* bar, unsigned x, unsigned& nloc, unsigned& nx) {
    const unsigned G = gridDim.x * gridDim.y * gridDim.z;
    unsigned sum, cnt, mine, sp = 0u;
    for (;;) {
        sum = 0u; cnt = 0u; mine = 0u;
#pragma unroll
        for (unsigned j = 0; j < 16; ++j) { const unsigned c = xb_ld(&bar[XB_XCNT(j)]); sum += c; cnt += (c > 0u) ? 1u : 0u; mine = (j == x) ? c : mine; }
        if (sum == G) break;
        __builtin_amdgcn_s_sleep(1);
        if ((++sp & 255u) == 0u) { if (xb_ld(&bar[XB_TMO])) break; if (sp > XB_SPIN_CAP) { atomicAdd(&bar[XB_TMO], 1u); break; } }
    }
    nloc = mine > 0u ? mine : 1u; nx = cnt > 0u ? cnt : 1u;
}
__device__ __forceinline__ void xcd_barrier(const XcdBarrier& b) {
    asm volatile("s_waitcnt vmcnt(0)" ::: "memory");
    __syncthreads();
    if (threadIdx.x == 0) {
        unsigned* bar = b.bar;
        __builtin_amdgcn_s_waitcnt(0);
        unsigned nloc = b.st[0], nx = b.st[1];
        if (nloc == 0u) { xcd_barrier_complete(bar, b.x, nloc, nx); b.st[0] = nloc; b.st[1] = nx; }
        const unsigned old = xb_add(&bar[XB_XSUB(b.x)], 1u);
        const unsigned gen = old / nloc;
        if (old + 1u == (gen + 1u) * nloc) {
            __builtin_amdgcn_fence(__ATOMIC_RELEASE, "agent");
            asm volatile("s_waitcnt vmcnt(0)" ::: "memory");
            const unsigned og = xb_add(&bar[XB_TOP], 1u);
            const unsigned tg = og / nx;
            if (og + 1u == (tg + 1u) * nx) xb_add(&bar[XB_TOPGEN], 1u);
            else XB_SPIN(xb_ld(&bar[XB_TOPGEN]) == tg, bar);
            __builtin_amdgcn_fence(__ATOMIC_ACQUIRE, "agent");
            xb_add(&bar[XB_XGEN(b.x)], 1u);
            asm volatile("s_waitcnt vmcnt(0)" ::: "memory");
        } else {
            XB_SPIN(xb_ld(&bar[XB_XGEN(b.x)]) == gen, bar);
            __builtin_amdgcn_fence(__ATOMIC_ACQUIRE, "agent");
            asm volatile("s_waitcnt vmcnt(0)" ::: "memory");
        }
    }
    __syncthreads();
}

__device__ __forceinline__ float wave_sum(float v) {
#pragma unroll
    for (int o = 1; o < 64; o <<= 1) v += __shfl_xor(v, o);
    return v;
}
__device__ __forceinline__ void transpose_item(const float* W, int K, int N, int ldw, bf16* WT, LAS float* scr, int item, int lane) {
    const int nblk = N / 32, kb = item / nblk, nb = item % nblk, k0 = 64 * kb, n0 = 32 * nb;
#pragma unroll 8
    for (int i = 0; i < 32; ++i) { const int kk = 2 * i + (lane >> 5); scr[kk * 33 + (lane & 31)] = W[(size_t)(k0 + kk) * ldw + n0 + (lane & 31)]; }
    LDS_WAIT(); asm volatile("" ::: "memory");
    const int c = lane & 7;
#pragma unroll
    for (int j = 0; j < 4; ++j) { const int n = (lane >> 3) + 8 * j; const LAS float* s = scr + (8 * c) * 33 + n;
        v4u o; o.x = pk_bf16(s[0 * 33], s[1 * 33]); o.y = pk_bf16(s[2 * 33], s[3 * 33]); o.z = pk_bf16(s[4 * 33], s[5 * 33]); o.w = pk_bf16(s[6 * 33], s[7 * 33]);
        *(GAS v4u*)(WT + (size_t)(n0 + n) * K + k0 + 8 * c) = o; }
    LDS_WAIT(); asm volatile("" ::: "memory");
}
__device__ __forceinline__ void convert_weights(LAS unsigned char* lds, int lane, int wave, int vcu, int G, const float* w_in, int ld_in, const float* w_out, const float* w1, const float* w2, unsigned char* ws) {
    LAS float* scr = (LAS float*)(lds + wave * 16384);
    const int gw = vcu * NWAVES + wave, NGW = G * NWAVES;
    constexpr int I_IN = (D / 64) * (NPROJ / 32), I_O = (D / 64) * (D / 32), I_1 = (D / 64) * (FF / 32), I_2 = (FF / 64) * (D / 32);
    constexpr int NITEMS = I_IN + I_O + I_1 + I_2;
    for (int it = gw; it < NITEMS; it += NGW) {
        int r = it;
        if (r < I_IN) { transpose_item(w_in, D, NPROJ, ld_in, (bf16*)(ws + WS_WIN), scr, r, lane); continue; } r -= I_IN;
        if (r < I_O) { transpose_item(w_out, D, D, D, (bf16*)(ws + WS_WOUT), scr, r, lane); continue; } r -= I_O;
        if (r < I_1) { transpose_item(w1, D, FF, FF, (bf16*)(ws + WS_W1), scr, r, lane); continue; } r -= I_1;
        transpose_item(w2, FF, D, D, (bf16*)(ws + WS_W2), scr, r, lane);
    }
}

template <bool GATE, bool OUT_BF16>
__device__ __forceinline__ void norm_rows(LAS unsigned char* lds, int tid, int lane, int wave, int vcu, int G, const float* xin, const float* gain, bf16* aop, float* fout,
                                          const float* wg, int ldw, int ng, float* gates) {
    LAS float* WgT = (LAS float*)lds;
    if (GATE) {
        __syncthreads();
        for (int i = tid; i < 16 * D; i += NTHREADS) { const int k = i >> 4, c = i & 15; WgT[c * D + k] = (c < ng) ? wg[(size_t)k * ldw + c] : 0.f; }
        __syncthreads();
    }
    const int gw = vcu * NWAVES + wave, NGW = G * NWAVES;
    f32x4 gn[4];
#pragma unroll
    for (int j = 0; j < 4; ++j) gn[j] = *(const f32x4*)(gain + 4 * lane + 256 * j);
    for (int m = gw; m < M; m += NGW) {
        const float* xr = xin + (size_t)m * D + 4 * lane;
        f32x4 v[4]; float s = 0.f;
#pragma unroll
        for (int j = 0; j < 4; ++j) { v[j] = *(const f32x4*)(xr + 256 * j); s += (v[j].x * v[j].x + v[j].y * v[j].y) + (v[j].z * v[j].z + v[j].w * v[j].w); }
        const float rstd = 1.0f / sqrtf(wave_sum(s) * (1.f / D) + EPS);
#pragma unroll
        for (int j = 0; j < 4; ++j) v[j] = v[j] * rstd * gn[j];
        if (OUT_BF16) {
#pragma unroll
            for (int j = 0; j < 4; ++j) { v2u o; o.x = pk_bf16(v[j].x, v[j].y); o.y = pk_bf16(v[j].z, v[j].w); *(v2u*)(aop + (size_t)m * D + 4 * lane + 256 * j) = o; }
        } else {
#pragma unroll
            for (int j = 0; j < 4; ++j) *(f32x4*)(fout + (size_t)m * D + 4 * lane + 256 * j) = v[j];
        }
        if (GATE) {
            float a[16];
#pragma unroll
            for (int c = 0; c < 16; ++c) a[c] = 0.f;
#pragma unroll
            for (int c = 0; c < 16; ++c) {
#pragma unroll
                for (int j = 0; j < 4; ++j) { const f32x4 w = *(const LAS f32x4*)(WgT + c * D + 4 * lane + 256 * j); a[c] += (v[j].x * w.x + v[j].y * w.y) + (v[j].z * w.z + v[j].w * w.w); }
                if (c & 1) asm volatile("" ::: "memory"); }
            const bool b5 = lane & 32, b4 = lane & 16, b3 = lane & 8, b2 = lane & 4;
#pragma unroll
            for (int i = 0; i < 8; ++i) { const float keep = b5 ? a[i + 8] : a[i], send = b5 ? a[i] : a[i + 8]; a[i] = keep + __shfl_xor(send, 32); }
#pragma unroll
            for (int i = 0; i < 4; ++i) { const float keep = b4 ? a[i + 4] : a[i], send = b4 ? a[i] : a[i + 4]; a[i] = keep + __shfl_xor(send, 16); }
#pragma unroll
            for (int i = 0; i < 2; ++i) { const float keep = b3 ? a[i + 2] : a[i], send = b3 ? a[i] : a[i + 2]; a[i] = keep + __shfl_xor(send, 8); }
            { const float keep = b2 ? a[1] : a[0], send = b2 ? a[0] : a[1]; a[0] = keep + __shfl_xor(send, 4); }
            a[0] += __shfl_xor(a[0], 2); a[0] += __shfl_xor(a[0], 1);
            const int c = (b5 ? 8 : 0) + (b4 ? 4 : 0) + (b3 ? 2 : 0) + (b2 ? 1 : 0);
            if ((lane & 3) == 0 && c < ng) gates[(size_t)m * 16 + c] = a[0];
        }
    }
}

__device__ __forceinline__ void head_norm_rows(int lane, int wave, int vcu, int G, const bf16* hun, const float* gout, const bf16* proj, bf16* aop, const bool GLA) {
    const int gw = vcu * NWAVES + wave, NGW = G * NWAVES;
    for (int m = gw; m < M; m += NGW) {
#pragma unroll
        for (int j = 0; j < 2; ++j) {
            const int col = 8 * lane + 512 * j;
            const v4u hv = *(const v4u*)(hun + (size_t)m * D + col);
            float f[8] = {bflo(hv.x), bfhi(hv.x), bflo(hv.y), bfhi(hv.y), bflo(hv.z), bfhi(hv.z), bflo(hv.w), bfhi(hv.w)};
            float ss = 0.f;
#pragma unroll
            for (int e = 0; e < 8; ++e) ss += f[e] * f[e];
#pragma unroll
            for (int o = 1; o < 32; o <<= 1) ss += __shfl_xor(ss, o);
            const float rs = 1.0f / sqrtf(ss * (1.f / DV) + EPS);
            const f32x4 g0 = *(const f32x4*)(gout + col), g1 = *(const f32x4*)(gout + col + 4);
            const float gg[8] = {g0.x, g0.y, g0.z, g0.w, g1.x, g1.y, g1.z, g1.w};
#pragma unroll
            for (int e = 0; e < 8; ++e) f[e] = f[e] * rs * gg[e];
            if (GLA) {
                const v4u rv = *(const v4u*)(proj + (size_t)m * NPROJ + 2048 + col);
                const float r[8] = {bflo(rv.x), bfhi(rv.x), bflo(rv.y), bfhi(rv.y), bflo(rv.z), bfhi(rv.z), bflo(rv.w), bfhi(rv.w)};
#pragma unroll
                for (int e = 0; e < 8; ++e) f[e] *= r[e] / (1.0f + __expf(-r[e]));
            }
            v4u o; o.x = pk_bf16(f[0], f[1]); o.y = pk_bf16(f[2], f[3]); o.z = pk_bf16(f[4], f[5]); o.w = pk_bf16(f[6], f[7]);
            *(v4u*)(aop + (size_t)m * D + col) = o;
        }
    }
}

__device__ __forceinline__ void gla_prep(LAS unsigned char* lds, int tid, int vcu, int G, const bf16* proj, const float* gates, const float* wup, const float* bgate,
                                         bf16* QT, bf16* KT, bf16* KH, float* gdec) {
    LAS float* zl = (LAS float*)lds;
    LAS float* tot = (LAS float*)(lds + 4096);
    const int d = tid & 127, rg = tid >> 7;
    for (int unit = vcu; unit < BATCH * NCH * NH; unit += G) {
        const int h = unit & 3, bc = unit >> 2, b = bc / NCH, c = bc % NCH, tok0 = b * SEQ + c * CH;
        float wu[16];
#pragma unroll
        for (int cc = 0; cc < 16; ++cc) wu[cc] = wup[cc * QKW + h * DK + d];
        const float bg = bgate[h * DK + d];
        __syncthreads();
        if (tid < 256) *(LAS f32x4*)(zl + 4 * tid) = *(const f32x4*)(gates + (size_t)tok0 * 16 + 4 * tid);
        __syncthreads();
        float bcum[16]; float run = 0.f;
#pragma unroll
        for (int jj = 0; jj < 16; ++jj) {
            const int j = 16 * rg + jj; float z = bg;
#pragma unroll
            for (int q4 = 0; q4 < 4; ++q4) { const f32x4 zz = *(const LAS f32x4*)(zl + j * 16 + 4 * q4); z += (zz.x * wu[4 * q4] + zz.y * wu[4 * q4 + 1]) + (zz.z * wu[4 * q4 + 2] + zz.w * wu[4 * q4 + 3]); }
            const float la = (fminf(z, 0.f) - __logf(1.0f + __expf(-fabsf(z)))) * INV_TAU;
            run += la; bcum[jj] = run;
        }
        tot[rg * 128 + d] = run;
        __syncthreads();
        float off = 0.f, g = 0.f;
#pragma unroll
        for (int r2 = 0; r2 < 4; ++r2) { const float t = tot[r2 * 128 + d]; g += t; off += (r2 < rg) ? t : 0.f; }
#pragma unroll
        for (int jj = 0; jj < 16; ++jj) {
            const int j = 16 * rg + jj; const float bb = bcum[jj] + off;
            const float q = bf2f(proj[(size_t)(tok0 + j) * NPROJ + h * DK + d]), k = bf2f(proj[(size_t)(tok0 + j) * NPROJ + QKW + h * DK + d]);
            const size_t o = (size_t)(tok0 + j) * QKW + h * DK + d;
            QT[o] = f2bf1(q * QK_SCALE * __expf(bb)); KT[o] = f2bf1(k * __expf(-bb)); KH[o] = f2bf1(k * __expf(g - bb));
        }
        if (rg == 0) gdec[(size_t)unit * DK + d] = __expf(g);
    }
    __syncthreads();
}

template <bool MLSTM> struct MxMap;
template <> struct MxMap<true>  { static constexpr int QS = 0, KS = 17408, KHS = 17408, V = 52224, O = 60416, VW = 68608, VWAUX = 76800, VAUX = 84992, PS = 89088, CT = 98304, TB = 115712, TWP = 123904, TPM = 132096, TSC = 140288, DEN = 140800, RDEN = 141312, OUTT = 141568, GDEC = 0, END = 145664; };
template <> struct MxMap<false> { static constexpr int QS = 0, KS = 17408, KHS = 34816, V = 69632, O = 0, VW = 0, VWAUX = 0, VAUX = 0, PS = 77824, CT = 87040, TB = 0, TWP = 0, TPM = 0, TSC = 0, DEN = 0, RDEN = 0, OUTT = 105472, GDEC = 104448, END = 109568; };
constexpr int PS_PITCH = 144, CT_PITCH = 272, CT_BYTES = 32 * CT_PITCH, IMG_PITCH = 272, IMG_BYTES = 64 * IMG_PITCH;
__device__ __forceinline__ bf16x8 tr8(LAS unsigned char* p0, LAS unsigned char* p1) {
    const s16x4 lo = __builtin_amdgcn_ds_read_tr16_b64_v4i16((LAS s16x4*)p0), hi = __builtin_amdgcn_ds_read_tr16_b64_v4i16((LAS s16x4*)p1);
    return __builtin_shufflevector(lo, hi, 0, 1, 2, 3, 4, 5, 6, 7);
}
#define MFMA32(a, b, c) __builtin_amdgcn_mfma_f32_32x32x16_bf16((a), (b), (c), 0, 0, 0)
struct MixArgs { const bf16 *q, *k, *kh, *proj; int qpitch; const float *gates, *bgate, *gdec; bf16* hun; };
struct MixPF { v4u q[2], k[2], kh[2], v; float gd; };
struct MixUnit { const bf16 *Qg, *Kg, *KHg, *Vg, *Og; bf16* Hg; const float* gdec; int qpitch, b, hh; };

template <bool MLSTM>
__device__ __forceinline__ void mx_prefetch(MixPF& pf, const MixUnit& U, int c, int tid) {
    const int tok0 = U.b * SEQ + c * CH;
#pragma unroll
    for (int i = 0; i < 2; ++i) { const int p = tid + NTHREADS * i, row = p >> 4, ch = p & 15;
        pf.q[i] = *(const v4u*)(U.Qg + (size_t)(tok0 + row) * U.qpitch + ch * 8); pf.k[i] = *(const v4u*)(U.Kg + (size_t)(tok0 + row) * U.qpitch + ch * 8);
        if (!MLSTM) pf.kh[i] = *(const v4u*)(U.KHg + (size_t)(tok0 + row) * U.qpitch + ch * 8); }
    if (tid < 256) pf.v = *(const v4u*)(U.Vg + (size_t)(tok0 + (tid >> 2)) * NPROJ + (tid & 3) * 8);
    else if (MLSTM) pf.v = *(const v4u*)(U.Og + (size_t)(tok0 + ((tid - 256) >> 2)) * NPROJ + (tid & 3) * 8);
    if (!MLSTM && tid < 128) pf.gd = U.gdec[(size_t)(((U.b * NCH + c) * NH) + U.hh) * DK + tid];
}
__device__ __forceinline__ void mx_store_tile(LAS unsigned char* outt, const float (&val)[16], bf16* grow  , int lane, int r, int h5) {
#pragma unroll
    for (int i = 0; i < 16; ++i) *(LAS unsigned short*)(outt + ((i & 3) + 8 * (i >> 2) + 4 * h5) * 64 + r * 2) = f2bf1(val[i]);
#pragma unroll
    for (int i = 0; i < 2; ++i) { const int id = lane + 64 * i, row = id >> 2, pc = id & 3; const v4u w = *(const LAS v4u*)(outt + row * 64 + pc * 16); *(v4u*)(grow + (size_t)row * D + pc * 8) = w; }
}
__device__ __forceinline__ void mx_finalize_mlstm(LAS unsigned char* lds, const f32x16& accO, const MixUnit& U, int cf, int jt, int lane, int r, int h5) {
    typedef MxMap<true> MP;
    const int parf = cf & 1; const float mc = ((const LAS float*)(lds + MP::TSC))[cf];
    LAS float* rd = (LAS float*)(lds + MP::RDEN) + jt * 32;
    { const int j = 32 * jt + r; const float dn = ((const LAS float*)(lds + MP::DEN))[parf * 64 + j], bb = ((const LAS float*)(lds + MP::TB))[cf * 64 + j], pm = ((const LAS float*)(lds + MP::TPM))[cf * 64 + j];
      const float em = __expf(-bb - fmaxf(mc, pm)); rd[r] = QK_SCALE * __builtin_amdgcn_rcpf(fmaxf(fabsf(dn) * QK_SCALE, em)); }
    const LAS unsigned short* oimg = (const LAS unsigned short*)(lds + MP::O + parf * 4096) + 32 * jt * 32;
    float val[16];
#pragma unroll
    for (int g4 = 0; g4 < 4; ++g4) { const f32x4 rd4 = *(const LAS f32x4*)(rd + 8 * g4 + 4 * h5);
#pragma unroll
        for (int e = 0; e < 4; ++e) { const float o = bf2f(oimg[(8 * g4 + 4 * h5 + e) * 32 + r]); val[4 * g4 + e] = accO[4 * g4 + e] * rd4[e] * __builtin_amdgcn_rcpf(1.0f + __expf(-o)); } }
    mx_store_tile(lds + MP::OUTT + jt * 2048, val, U.Hg + (size_t)(U.b * SEQ + cf * CH + 32 * jt) * D, lane, r, h5);
}

template <bool MLSTM>
__device__ __forceinline__ void mx_step(LAS unsigned char* lds, MixPF& pf, const MixUnit& U, int c, f32x16& accC0, f32x16& accC1, f32x16& accO, int tid, int lane, int wave) {
    typedef MxMap<MLSTM> MP;
    const int r = lane & 31, h5 = lane >> 5, blk = (lane >> 4) & 1, q4 = (lane & 15) >> 2, p4 = lane & 3, par = c & 1;
    const LAS float* TSC = (const LAS float*)(lds + MP::TSC);
#pragma unroll
    for (int i = 0; i < 2; ++i) { const int p = tid + NTHREADS * i, row = p >> 4, ch = p & 15; const unsigned o = row * IMG_PITCH + ch * 16;
        *(LAS v4u*)(lds + MP::QS + o) = pf.q[i];
        if (MLSTM) *(LAS v4u*)(lds + MP::KS + par * IMG_BYTES + o) = pf.k[i];
        else { *(LAS v4u*)(lds + MP::KS + o) = pf.k[i]; *(LAS v4u*)(lds + MP::KHS + par * IMG_BYTES + o) = pf.kh[i]; } }
    if (tid < 256) { const int row = tid >> 2, pc = tid & 3;
        *(LAS v4u*)(lds + MP::V + par * 4096 + row * 64 + pc * 16) = pf.v;
        if (MLSTM) { const float wr_ = __expf(((const LAS float*)(lds + MP::TWP))[c * 64 + row] - TSC[32 + c]); v4u o; const v4u pv = pf.v;
            o.x = pk_bf16(bflo(pv.x) * wr_, bfhi(pv.x) * wr_); o.y = pk_bf16(bflo(pv.y) * wr_, bfhi(pv.y) * wr_); o.z = pk_bf16(bflo(pv.z) * wr_, bfhi(pv.z) * wr_); o.w = pk_bf16(bflo(pv.w) * wr_, bfhi(pv.w) * wr_);
            *(LAS v4u*)(lds + MP::VW + par * 4096 + row * 64 + pc * 16) = o; }
    } else if (MLSTM) { const int row = (tid - 256) >> 2, pc = tid & 3; *(LAS v4u*)(lds + MP::O + par * 4096 + row * 64 + pc * 16) = pf.v; }
    if (MLSTM && wave == 0) *(LAS unsigned short*)(lds + MP::VWAUX + par * 4096 + lane * 64) = f2bf1(__expf(((const LAS float*)(lds + MP::TWP))[c * 64 + lane] - TSC[32 + c]));
    if (!MLSTM && tid < 128) ((LAS float*)(lds + MP::GDEC))[par * 128 + tid] = pf.gd;
    if (c + 2 < NCH) mx_prefetch<MLSTM>(pf, U, c + 2, tid);
    __syncthreads();
    const float mc = MLSTM ? TSC[c] : 0.f;
    if (wave < 4) {
        const int st = wave >> 1, jt = (wave == 1 || wave == 2) ? 1 : 0;
#pragma unroll
        for (int i = 0; i < 16; ++i) accO[i] = 0.f;
        if (wave != 3) {
            LAS unsigned char* kimg = lds + MP::KS + (MLSTM ? par * IMG_BYTES : 0) + (32 * st + r) * IMG_PITCH + 16 * h5;
            LAS unsigned char* qimg = lds + MP::QS + (32 * jt + r) * IMG_PITCH + 16 * h5;
#pragma unroll
            for (int ks = 0; ks < 8; ++ks) { const bf16x8 a = *(const LAS bf16x8*)(kimg + 32 * ks), bq = *(const LAS bf16x8*)(qimg + 32 * ks); accO = MFMA32(a, bq, accO); }
        }
        const int j = 32 * jt + r; float uj = 0.f;
        if (MLSTM) uj = -fmaxf(mc, ((const LAS float*)(lds + MP::TPM))[c * 64 + j]);
#pragma unroll
        for (int g4 = 0; g4 < 4; ++g4) { const int s0 = 32 * st + 8 * g4 + 4 * h5; f32x4 wps = {0.f, 0.f, 0.f, 0.f}; if (MLSTM) wps = *(const LAS f32x4*)((const LAS float*)(lds + MP::TWP) + c * 64 + s0);
            float v[4];
#pragma unroll
            for (int e = 0; e < 4; ++e) { float x = accO[4 * g4 + e]; if (MLSTM) x *= __expf(uj + wps[e]); v[e] = (s0 + e <= j) ? x : 0.f; }
            v2u o; o.x = pk_bf16(v[0], v[1]); o.y = pk_bf16(v[2], v[3]); *(LAS v2u*)(lds + MP::PS + j * PS_PITCH + s0 * 2) = o; }
    } else {
        const int g = (wave - 4) >> 1, jt = wave & 1;
        if (MLSTM || g == 0) {
            if (MLSTM && g == 0 && c > 0) mx_finalize_mlstm(lds, accO, U, c - 1, jt, lane, r, h5);
#pragma unroll
            for (int i = 0; i < 16; ++i) accO[i] = 0.f;
#pragma unroll
            for (int ks = 0; ks < 8; ++ks) { const bf16x8 a = *(const LAS bf16x8*)(lds + MP::QS + (32 * jt + r) * IMG_PITCH + 16 * h5 + 32 * ks), bc = *(const LAS bf16x8*)(lds + MP::CT + g * CT_BYTES + r * CT_PITCH + 32 * ks + 16 * h5); accO = MFMA32(a, bc, accO); }
            if (MLSTM) {
#pragma unroll
                for (int g4 = 0; g4 < 4; ++g4) { const f32x4 pm = *(const LAS f32x4*)((const LAS float*)(lds + MP::TPM) + c * 64 + 32 * jt + 8 * g4 + 4 * h5);
#pragma unroll
                    for (int e = 0; e < 4; ++e) accO[4 * g4 + e] *= __expf(mc - fmaxf(mc, pm[e])); }
            }
        }
    }
    __syncthreads();
    if (wave < 4) {
        if (MLSTM) { const float decay = __expf(mc - TSC[32 + c]); accC0 = accC0 * decay; accC1 = accC1 * decay; }
        else {
#pragma unroll
            for (int g4 = 0; g4 < 4; ++g4) { const f32x4 dc = *(const LAS f32x4*)((const LAS float*)(lds + MP::GDEC) + par * 128 + 32 * wave + 8 * g4 + 4 * h5);
#pragma unroll
                for (int e = 0; e < 4; ++e) accC0[4 * g4 + e] *= dc[e]; }
        }
        LAS unsigned char* kimg = lds + (MLSTM ? MP::KS : MP::KHS) + par * IMG_BYTES + (8 * h5 + q4) * IMG_PITCH + 64 * wave + 32 * blk + 8 * p4;
        LAS unsigned char* vimg = lds + (MLSTM ? MP::VW : MP::V) + par * 4096;
        LAS unsigned char* vaux = lds + MP::VWAUX + par * 4096;
#pragma unroll
        for (int ks = 0; ks < 4; ++ks) {
            const int row0 = 16 * ks + 8 * h5 + q4;
            const bf16x8 a = tr8(kimg + 16 * ks * IMG_PITCH, kimg + (16 * ks + 4) * IMG_PITCH);
            const bf16x8 b0 = tr8(vimg + row0 * 64 + 32 * blk + 8 * p4, vimg + (row0 + 4) * 64 + 32 * blk + 8 * p4);
            accC0 = MFMA32(a, b0, accC0);
            if (MLSTM) { const bf16x8 b1 = tr8(vaux + row0 * 64 + 32 * blk + 8 * p4, vaux + (row0 + 4) * 64 + 32 * blk + 8 * p4); accC1 = MFMA32(a, b1, accC1); }
        }
#pragma unroll
        for (int g4 = 0; g4 < 4; ++g4) { const int d0 = 32 * wave + 8 * g4 + 4 * h5;
            v2u o; o.x = pk_bf16(accC0[4 * g4], accC0[4 * g4 + 1]); o.y = pk_bf16(accC0[4 * g4 + 2], accC0[4 * g4 + 3]); *(LAS v2u*)(lds + MP::CT + r * CT_PITCH + d0 * 2) = o;
            if (MLSTM) { v2u o1; o1.x = pk_bf16(accC1[4 * g4], accC1[4 * g4 + 1]); o1.y = pk_bf16(accC1[4 * g4 + 2], accC1[4 * g4 + 3]); *(LAS v2u*)(lds + MP::CT + CT_BYTES + r * CT_PITCH + d0 * 2) = o1; } }
    } else {
        const int g = (wave - 4) >> 1, jt = wave & 1;
        if (MLSTM || g == 0) {
            LAS unsigned char* vimg = (g == 0) ? (lds + MP::V + par * 4096) : (lds + MP::VAUX);
#pragma unroll
            for (int ks = 0; ks < 4; ++ks) { const int row0 = 16 * ks + 8 * h5 + q4;
                const bf16x8 a = *(const LAS bf16x8*)(lds + MP::PS + (32 * jt + r) * PS_PITCH + 32 * ks + 16 * h5);
                const bf16x8 bv = tr8(vimg + row0 * 64 + 32 * blk + 8 * p4, vimg + (row0 + 4) * 64 + 32 * blk + 8 * p4);
                accO = MFMA32(a, bv, accO); }
            if (MLSTM && g == 1 && r == 0) {
                LAS float* den = (LAS float*)(lds + MP::DEN) + par * 64;
#pragma unroll
                for (int i = 0; i < 16; ++i) den[32 * jt + (i & 3) + 8 * (i >> 2) + 4 * h5] = accO[i];
            }
            if (!MLSTM) {
                float val[16];
#pragma unroll
                for (int i = 0; i < 16; ++i) val[i] = accO[i];
                mx_store_tile(lds + MP::OUTT + jt * 2048, val, U.Hg + (size_t)(U.b * SEQ + c * CH + 32 * jt) * D, lane, r, h5);
            }
        }
    }
}

template <bool MLSTM>
__device__ __forceinline__ void mixer_phase(LAS unsigned char* lds, int tid, int lane, int wave, int vcu, int G, const MixArgs A) {
    typedef MxMap<MLSTM> MP;
    for (int unit = vcu; unit < BATCH * NH * 8; unit += G) {
        const int slice = unit & 7, bh = unit >> 3;
        MixUnit U; U.b = bh >> 2; U.hh = bh & 3; U.qpitch = A.qpitch; U.gdec = A.gdec;
        U.Qg = A.q + U.hh * DK; U.Kg = A.k + U.hh * DK; U.KHg = MLSTM ? A.k : A.kh + U.hh * DK;
        U.Vg = A.proj + 1024 + U.hh * DV + 32 * slice; U.Og = A.proj + 2048 + U.hh * DV + 32 * slice; U.Hg = A.hun + U.hh * DV + 32 * slice;
        MixPF pfA, pfB; pfA.gd = 0.f; pfB.gd = 0.f;
        mx_prefetch<MLSTM>(pfA, U, 0, tid); mx_prefetch<MLSTM>(pfB, U, 1, tid);
        __syncthreads();
        for (int i = tid; i < 2 * CT_BYTES / 4; i += NTHREADS) ((LAS unsigned*)(lds + MP::CT))[i] = 0u;
        if (MLSTM) {
            for (int i = tid; i < 1024; i += NTHREADS) ((LAS unsigned*)(lds + MP::VAUX))[i] = ((i & 15) == 0) ? 0x3F80u : 0u;
            for (int i = tid; i < 2048; i += NTHREADS) ((LAS unsigned*)(lds + MP::VWAUX))[i] = 0u;
            LAS float* TB = (LAS float*)(lds + MP::TB); LAS float* TWP = (LAS float*)(lds + MP::TWP); LAS float* TPM = (LAS float*)(lds + MP::TPM); LAS float* TSC = (LAS float*)(lds + MP::TSC);
            const float bgi = A.bgate[U.hh], bgf = A.bgate[4 + U.hh];
            float gi4[4], gf4[4];
#pragma unroll
            for (int cc = 0; cc < 4; ++cc) { const size_t tok = (size_t)U.b * SEQ + (wave + 8 * cc) * CH + lane; gi4[cc] = A.gates[tok * 16 + U.hh] + bgi; gf4[cc] = A.gates[tok * 16 + 4 + U.hh] + bgf; }
#pragma unroll
            for (int cc = 0; cc < 4; ++cc) { const int c = wave + 8 * cc;
                const float lf = fminf(gf4[cc], 0.f) - __logf(1.0f + __expf(-fabsf(gf4[cc])));
                float bsum = lf;
#pragma unroll
                for (int o = 1; o < 64; o <<= 1) { const float t = __shfl_up(bsum, o); if (lane >= o) bsum += t; }
                const float wp = gi4[cc] - bsum; float pm = wp;
#pragma unroll
                for (int o = 1; o < 64; o <<= 1) { const float t = __shfl_up(pm, o); if (lane >= o) pm = fmaxf(pm, t); }
                TB[c * 64 + lane] = bsum; TWP[c * 64 + lane] = wp; TPM[c * 64 + lane] = pm;
                if (lane == 63) { TSC[64 + c] = bsum; TSC[96 + c] = pm; } }
            __syncthreads();
            if (wave == 0) {
                const float gl = TSC[64 + (lane & 31)], pl = TSC[96 + (lane & 31)]; float m = 0.f, myM = 0.f, myX = 0.f;
#pragma clang loop unroll(disable)
                for (int c = 0; c < NCH; ++c) { const float gc = __uint_as_float(__builtin_amdgcn_readlane(__float_as_uint(gl), c)), pc = __uint_as_float(__builtin_amdgcn_readlane(__float_as_uint(pl), c));
                    const float mxe = fmaxf(m, pc); if (lane == c) { myM = m; myX = mxe; } m = gc + mxe; }
                if (lane < 32) { TSC[lane] = myM; TSC[32 + lane] = myX; }
            }
        }
        f32x16 accC0, accC1, accO;
#pragma unroll
        for (int i = 0; i < 16; ++i) { accC0[i] = 0.f; accC1[i] = 0.f; accO[i] = 0.f; }
        __syncthreads();
        for (int c = 0; c < NCH; c += 2) {
            mx_step<MLSTM>(lds, pfA, U, c, accC0, accC1, accO, tid, lane, wave);
            mx_step<MLSTM>(lds, pfB, U, c + 1, accC0, accC1, accO, tid, lane, wave);
        }
        if (MLSTM) { __syncthreads(); if (wave == 4 || wave == 5) mx_finalize_mlstm(lds, accO, U, NCH - 1, wave & 1, lane, lane & 31, lane >> 5); }
        __syncthreads();
    }
    __syncthreads();
}

constexpr int N_PHASES = 19;
struct Args { const float* in[15]; float* out; unsigned char* ws; int ph_lo, ph_hi; };
template <int PH>
__device__ __forceinline__ void run_phase(const Args& args, LAS unsigned char* lds, int tid, int lane, int wave, int vcu, int G, int bx) {
    unsigned char* ws = args.ws; float* out = args.out;
    constexpr int layer = (PH >= 9 && PH < 18) ? 1 : 0, k = (PH == 18) ? 9 : PH - 9 * layer;
    bf16* AOP = (bf16*)(ws + WS_AOP); bf16* PROJ = (bf16*)(ws + WS_PROJ); bf16* HUN = (bf16*)(ws + WS_HUN); bf16* HMID = (bf16*)(ws + WS_HMID);
    float* GATES = (float*)(ws + WS_GATES);
    if constexpr (k == 0) {
        const float* w_in = args.in[layer ? 8 : 4]; const int ld_in = layer ? GLA_IN : MLSTM_IN;
        convert_weights(lds, lane, wave, vcu, G, w_in, ld_in, args.in[layer ? 12 : 7], args.in[13] + (size_t)layer * D * FF, args.in[14] + (size_t)layer * D * FF, ws);
        norm_rows<true, true>(lds, tid, lane, wave, vcu, G, layer ? out : args.in[0], args.in[1] + layer * D, AOP, nullptr, w_in + NPROJ, ld_in, layer ? 16 : 8, GATES);
    } else if constexpr (k == 1) {
        pg8::Gemm g{AOP, (const bf16*)(ws + WS_WIN), M, NPROJ, D}; pg8::StaticOrder S; S.init(M, NPROJ, G, bx);
        pg8::EpiBf16<0> E{PROJ, NPROJ};
        pg8::gemm_phase<pg8::EpiBf16<0>, pg8::StaticOrder, true, true>(lds, g, S, E);
    } else if constexpr (k == 2) {
        if (layer) gla_prep(lds, tid, vcu, G, PROJ, GATES, args.in[9], args.in[10], (bf16*)(ws + WS_QT), (bf16*)(ws + WS_KT), (bf16*)(ws + WS_KH), (float*)(ws + WS_GDEC));
    } else if constexpr (k == 3) {
        if (layer == 0) { const MixArgs A{PROJ, PROJ + QKW, nullptr, PROJ, NPROJ, GATES, args.in[5], nullptr, HUN}; mixer_phase<true>(lds, tid, lane, wave, vcu, G, A); }
        else { const MixArgs A{(const bf16*)(ws + WS_QT), (const bf16*)(ws + WS_KT), (const bf16*)(ws + WS_KH), PROJ, QKW, nullptr, nullptr, (const float*)(ws + WS_GDEC), HUN}; mixer_phase<false>(lds, tid, lane, wave, vcu, G, A); }
    } else if constexpr (k == 4) {
        head_norm_rows(lane, wave, vcu, G, HUN, args.in[layer ? 11 : 6], PROJ, AOP, layer != 0);
    } else if constexpr (k == 5) {
        pg8::Gemm g{AOP, (const bf16*)(ws + WS_WOUT), M, D, D}; pg8::StaticOrder S; S.init(M, D, G, bx);
        pg8::EpiResF32 E{layer ? out : args.in[0], out, D};
        pg8::gemm_phase<pg8::EpiResF32, pg8::StaticOrder, false, true>(lds, g, S, E);
    } else if constexpr (k == 6) {
        norm_rows<false, true>(lds, tid, lane, wave, vcu, G, out, args.in[2] + layer * D, AOP, nullptr, nullptr, 0, 0, nullptr);
    } else if constexpr (k == 7) {
        pg8::Gemm g{AOP, (const bf16*)(ws + WS_W1), M, FF, D}; pg8::StaticOrder S; S.init(M, FF, G, bx);
        pg8::EpiBf16<2> E{HMID, FF};
        pg8::gemm_phase<pg8::EpiBf16<2>, pg8::StaticOrder, true, true>(lds, g, S, E);
    } else if constexpr (k == 8) {
        pg8::Gemm g{HMID, (const bf16*)(ws + WS_W2), M, D, FF}; pg8::StaticOrder S; S.init(M, D, G, bx);
        pg8::EpiResF32 E{out, out, D};
        pg8::gemm_phase<pg8::EpiResF32, pg8::StaticOrder, false, true>(lds, g, S, E);
    } else {
        norm_rows<false, false>(lds, tid, lane, wave, vcu, G, out, args.in[3], nullptr, out, nullptr, 0, 0, nullptr);
    }
}
__global__ void __launch_bounds__(NTHREADS, 2) fwd_kernel(Args args) {
    extern __shared__ __attribute__((aligned(16))) unsigned char lds_raw[];
    LAS unsigned char* lds = (LAS unsigned char*)lds_raw;
    volatile LAS unsigned* MISC = (volatile LAS unsigned*)(lds + MISC_OFF);
    const int tid = threadIdx.x, lane = tid & 63, wave = __builtin_amdgcn_readfirstlane(tid >> 6);
    const int G = gridDim.x; const int bx = blockIdx.x; const int vcu = (G % 8 == 0) ? (bx % 8) * (G / 8) + bx / 8 : bx;
    for (int u = tid; u < (LDS_BYTES - LDSCTL_OFF) / 4; u += NTHREADS) ((LAS unsigned*)(lds + LDSCTL_OFF))[u] = 0u;
    __syncthreads();
    const int lo = args.ph_lo, hi = args.ph_hi;
    XcdBarrier bar; bar.bar = (unsigned*)(args.ws + WS_CTL) + CW_BAR; bar.x = 0; bar.st = nullptr;
    if (hi - lo > 1) bar = xcd_barrier_post((unsigned*)(args.ws + WS_CTL) + CW_BAR, MISC + 8);
#define PHASE(p) if (lo <= (p) && (p) < hi) { run_phase<p>(args, lds, tid, lane, wave, vcu, G, bx); if ((p) + 1 < hi && (p) != 2) xcd_barrier(bar); }
    PHASE(0) PHASE(1) PHASE(2) PHASE(3) PHASE(4) PHASE(5) PHASE(6) PHASE(7) PHASE(8) PHASE(9) PHASE(10) PHASE(11) PHASE(12) PHASE(13) PHASE(14) PHASE(15) PHASE(16) PHASE(17) PHASE(18)
#undef PHASE
}

extern "C" void kernel_launch(void* const* d_in, const int* in_sizes, int n_in, void* d_out, int out_size, void* d_ws, size_t ws_size, hipStream_t stream) {
    static int grid = 0;
    if (grid == 0) {
        if (n_in != 15 || in_sizes[0] != M * D || out_size != M * D || ws_size < WS_END) { fprintf(stderr, "kernel_launch: unexpected shapes (n_in %d, in0 %d, out %d, ws %zu); nothing launched\n", n_in, n_in > 0 ? in_sizes[0] : -1, out_size, ws_size); grid = -1; return; }
        int dev = 0, cus = 0, per_cu = 0;
        if (hipGetDevice(&dev) != hipSuccess || hipDeviceGetAttribute(&cus, hipDeviceAttributeMultiprocessorCount, dev) != hipSuccess) { grid = -1; return; }
        if (hipFuncSetAttribute((const void*)fwd_kernel, hipFuncAttributeMaxDynamicSharedMemorySize, LDS_BYTES) != hipSuccess) { fprintf(stderr, "kernel_launch: hipFuncSetAttribute failed\n"); grid = -1; return; }
        if (hipOccupancyMaxActiveBlocksPerMultiprocessor(&per_cu, (const void*)fwd_kernel, NTHREADS, LDS_BYTES) != hipSuccess || per_cu < 1) { fprintf(stderr, "kernel_launch: occupancy query says %d blocks per CU\n", per_cu); (void)hipGetLastError(); grid = -1; return; }
        grid = cus;
    }
    if (grid < 0) return;
    (void)hipMemsetAsync((char*)d_ws + WS_CTL, 0, CTL_ZERO_BYTES, stream);
    Args a{};
    for (int i = 0; i < 15; ++i) a.in[i] = (const float*)d_in[i];
    a.out = (float*)d_out; a.ws = (unsigned char*)d_ws;
    if (MK_N_LAUNCHES == 1) {
        a.ph_lo = 0; a.ph_hi = N_PHASES;
        void* kargs[] = {&a};
        const hipError_t e = hipLaunchCooperativeKernel((const void*)fwd_kernel, dim3(grid), dim3(NTHREADS), kargs, LDS_BYTES, stream);
        if (e != hipSuccess) fprintf(stderr, "kernel_launch: cooperative launch failed: %s (grid %d)\n", hipGetErrorString(e), grid);
    } else {
        for (int p = 0; p < N_PHASES; ++p) { a.ph_lo = p; a.ph_hi = p + 1; hipLaunchKernelGGL(fwd_kernel, dim3(grid), dim3(NTHREADS), LDS_BYTES, stream, a); }
    }
}
```

```cpp
#include <hip/hip_runtime.h>
#include <cstdio>
#include <cstdint>
namespace pg8 {
#define PG8_LAS __attribute__((address_space(3)))
typedef unsigned short bf16_t;
typedef short bf16x8 __attribute__((ext_vector_type(8)));
typedef float f32x4 __attribute__((ext_vector_type(4)));
typedef unsigned u32x4 __attribute__((ext_vector_type(4)));
constexpr int BM = 256, BK = 64, HALF = 128, HTB = HALF * BK * 2  , STAGE_BYTES = 8 * HTB, NXCD = 8, WGM = 8;

__host__ __device__ __forceinline__ int lds_byte(int r, int c) { const int st = (r >> 4) * 2 + (c >> 5), rr = r & 15, cc = c & 31, ob = rr * 64 + cc * 2; return st * 1024 + (ob ^ (((ob >> 9) & 1) << 5)); }
__host__ __device__ __forceinline__ void stage_rc(int b, int& R, int& C) { const int st = b / 1024, sb = b % 1024, swz = sb ^ (((sb >> 9) & 1) << 5); R = (st >> 1) * 16 + swz / 64; C = (st & 1) * 32 + (swz % 64) / 2; }
__host__ __device__ __forceinline__ int perm32(int rho) { const int n = rho >> 4, i = rho & 15; return 8 * (i >> 2) + 4 * n + (i & 3); }

struct Unit { int pm, pn; };
struct Gemm { const bf16_t* A; const bf16_t* Bt; int M, N, K; };

struct StaticOrder {
    int nM, nN, nwg, G, c;
    __host__ __device__ void init(int M, int N, int G_, int c_) { nM = M / BM; nN = N / BM; nwg = nM * nN; G = G_; c = c_; }
    __host__ __device__ bool next(int i, Unit& u) const {
        const long L = (long)i * G + c; if (L >= nwg) return false;
        int wgid = (int)L; { const int q = nwg / NXCD, r = nwg % NXCD, xcd = wgid % NXCD, off = wgid / NXCD; wgid = (xcd < r ? xcd * (q + 1) : r * (q + 1) + (xcd - r) * q) + off; }
        const int nig = WGM * nN, gid = wgid / nig, fm = gid * WGM, gsz = (nM - fm) < WGM ? (nM - fm) : WGM;
        u.pm = fm + ((wgid % nig) % gsz); u.pn = (wgid % nig) / gsz; return true;
    }
    __device__ __forceinline__ void a_ready(const Unit&) const {}
    __device__ __forceinline__ void done(const Unit&) const {}
};

__device__ __forceinline__ unsigned cvt_pk_bf16(float lo, float hi) { unsigned r; asm volatile("v_cvt_pk_bf16_f32 %0, %1, %2" : "=v"(r) : "v"(lo), "v"(hi)); return r; }
typedef float f32x2 __attribute__((ext_vector_type(2)));
typedef __bf16 bf16x2_t __attribute__((ext_vector_type(2)));
__device__ __forceinline__ unsigned pk_bf16(float lo, float hi) { f32x2 v = {lo, hi}; bf16x2_t r = __builtin_convertvector(v, bf16x2_t); return __builtin_bit_cast(unsigned, r); }
template <int ACT  > struct EpiBf16 {
    static constexpr bool PERM = true, AFTER_DRAIN = false;
    bf16_t* O; int ldc;
    __device__ __forceinline__ void operator()(const f32x4 (&acc)[2][2][4][2], const Unit& u, int wr, int wc, int fr, int fq) const {
        const int row0 = u.pm * BM + wr * 64 + fr, col0 = u.pn * BM + wc * 32 + 8 * fq;
#pragma unroll
        for (int ai = 0; ai < 2; ++ai)
#pragma unroll
            for (int m = 0; m < 4; ++m) { bf16_t* rowp = O + (size_t)(row0 + ai * HALF + m * 16) * ldc + col0;
#pragma unroll
                for (int bj = 0; bj < 2; ++bj) { f32x4 v0 = acc[ai][bj][m][0], v1 = acc[ai][bj][m][1];
                    if (ACT == 2) { const f32x4 z = {0.f, 0.f, 0.f, 0.f}; v0 = __builtin_elementwise_max(v0, z); v1 = __builtin_elementwise_max(v1, z); v0 = v0 * v0; v1 = v1 * v1; }
                    u32x4 w; w.x = pk_bf16(v0[0], v0[1]); w.y = pk_bf16(v0[2], v0[3]); w.z = pk_bf16(v1[0], v1[1]); w.w = pk_bf16(v1[2], v1[3]);
                    *(u32x4*)(rowp + bj * HALF) = w; } }
    }
};
struct EpiResF32 {
    static constexpr bool PERM = false, AFTER_DRAIN = true;
    const float* base; float* out; int ldc;
    __device__ __forceinline__ void fused(const f32x4 (&acc)[2][2][4][2], const Unit& u, int wr, int wc, int fr, int fq, PG8_LAS unsigned char*, int, int) const {
        const int col0 = u.pn * BM + wc * 32 + 4 * fq;
#pragma unroll
        for (int ai = 0; ai < 2; ++ai)
#pragma unroll
            for (int m = 0; m < 4; ++m) { const int r = ai * HALF + wr * 64 + m * 16 + fr; const size_t off = (size_t)(u.pm * BM + r) * ldc + col0;
#pragma unroll
                for (int bj = 0; bj < 2; ++bj) { const f32x4 b0 = *(const f32x4*)(base + off + bj * HALF), b1 = *(const f32x4*)(base + off + bj * HALF + 16);
                    *(f32x4*)(out + off + bj * HALF) = b0 + acc[ai][bj][m][0]; *(f32x4*)(out + off + bj * HALF + 16) = b1 + acc[ai][bj][m][1];
                    asm volatile("" ::: "memory"); } }
    }
};
template <class Epi, class Sched, bool ALIGN_EPI = false, bool SP2 = false>
__device__ __forceinline__ void gemm_phase(PG8_LAS unsigned char* lds, const Gemm g, const Sched& S, const Epi& E) {
    const int tid = threadIdx.x, wid = __builtin_amdgcn_readfirstlane(tid >> 6), lane = tid & 63, wr = wid >> 2, wc = wid & 3, fr = lane & 15, fq = lane >> 4;
    const int K = g.K, nt = K / BK;
    unsigned voffA[2], voffB[2];
#pragma unroll
    for (int i = 0; i < 2; ++i) { int R, C; stage_rc(tid * 16 + i * 8192, R, C); const int Rb = Epi::PERM ? ((R & ~31) + perm32(R & 31)) : R;
        voffA[i] = (unsigned)(R * K + C) * 2u; voffB[i] = (unsigned)(Rb * K + C) * 2u; }
    const size_t kstep = (size_t)(BK * 2);
    const size_t hstep = (size_t)HALF * K * 2;
    const size_t tstep = 2 * hstep;
    const unsigned ldsw = (unsigned)wid * 1024u;
    const int aoff = lds_byte(wr * 64 + fr, fq * 8), boff = lds_byte(wc * 32 + fr, fq * 8);
#define PG8_SA(b, h) (((b) * 2 + (h)) * HTB)
#define PG8_SB(b, h) ((4 + (b) * 2 + (h)) * HTB)
#define PG8_STAGE(bufoff, gbase, voff) do { _Pragma("unroll") for (int _i = 0; _i < 2; ++_i) \
        __builtin_amdgcn_global_load_lds((const unsigned*)((const char*)(gbase) + (voff)[_i]), (PG8_LAS unsigned*)(lds + (bufoff) + ldsw + _i * 8192), 16, 0, 0); } while (0)
#define PG8_LDA(dst, b, h) do { _Pragma("unroll") for (int m = 0; m < 4; ++m) _Pragma("unroll") for (int k = 0; k < 2; ++k) dst[m][k] = *(const PG8_LAS bf16x8*)(lds + PG8_SA(b, h) + aoff + m * 2048 + k * 1024); } while (0)
#define PG8_LDB(dst, b, h) do { _Pragma("unroll") for (int n = 0; n < 2; ++n) _Pragma("unroll") for (int k = 0; k < 2; ++k) dst[n][k] = *(const PG8_LAS bf16x8*)(lds + PG8_SB(b, h) + boff + n * 2048 + k * 1024); } while (0)
#define PG8_MMA(ai, bj, At, Bt) do { __builtin_amdgcn_s_setprio(1); _Pragma("unroll") for (int m = 0; m < 4; ++m) _Pragma("unroll") for (int n = 0; n < 2; ++n) _Pragma("unroll") for (int k = 0; k < 2; ++k) \
        acc[ai][bj][m][n] = __builtin_amdgcn_mfma_f32_16x16x32_bf16(Bt[n][k], At[m][k], acc[ai][bj][m][n], 0, 0, 0); __builtin_amdgcn_s_setprio(0); } while (0)
#define PG8_WAIT_V(n) asm volatile("s_waitcnt vmcnt(" #n ")" ::: "memory")
#define PG8_WAIT_L(n) asm volatile("s_waitcnt lgkmcnt(" #n ")" ::: "memory")
#define PG8_BAR __builtin_amdgcn_s_barrier()
#define PG8_SCHED __builtin_amdgcn_sched_barrier(0)
    Unit cur, nxt; int ui = 0;
    if (!S.next(0, cur)) return;
    f32x4 acc[2][2][4][2];
#pragma unroll
    for (int a = 0; a < 2; ++a)
#pragma unroll
        for (int b = 0; b < 2; ++b)
#pragma unroll
            for (int m = 0; m < 4; ++m)
#pragma unroll
                for (int n = 0; n < 2; ++n) acc[a][b][m][n] = (f32x4){0.f, 0.f, 0.f, 0.f};
    bf16x8 At[4][2], B0[2][2], B1[2][2];
    const char* cA = (const char*)g.A + (size_t)cur.pm * tstep; const char* cB = (const char*)g.Bt + (size_t)cur.pn * tstep;
    S.a_ready(cur);
    if constexpr (SP2) {
        PG8_STAGE(PG8_SB(0, 0), cB, voffB); PG8_STAGE(PG8_SB(0, 1), cB + hstep, voffB); PG8_STAGE(PG8_SA(0, 0), cA, voffA); PG8_STAGE(PG8_SA(0, 1), cA + hstep, voffA);
        if (wr == 1) PG8_BAR;
        PG8_WAIT_V(2); PG8_BAR;
        PG8_STAGE(PG8_SB(1, 0), cB + kstep, voffB); PG8_STAGE(PG8_SA(1, 0), cA + kstep, voffA); PG8_STAGE(PG8_SB(1, 1), cB + hstep + kstep, voffB);
        PG8_WAIT_V(6); PG8_BAR;
    } else {
        PG8_STAGE(PG8_SB(0, 0), cB, voffB); PG8_STAGE(PG8_SA(0, 0), cA, voffA); PG8_STAGE(PG8_SB(0, 1), cB + hstep, voffB); PG8_STAGE(PG8_SA(0, 1), cA + hstep, voffA);
        if (wr == 1) PG8_BAR;
        PG8_WAIT_V(4); PG8_BAR;
        PG8_STAGE(PG8_SB(1, 0), cB + kstep, voffB); PG8_STAGE(PG8_SA(1, 0), cA + kstep, voffA); PG8_STAGE(PG8_SB(1, 1), cB + hstep + kstep, voffB);
        PG8_WAIT_V(6); PG8_BAR;
    }
    for (;;) {
        const bool has_next = S.next(ui + 1, nxt);
        const char* nA = has_next ? (const char*)g.A + (size_t)nxt.pm * tstep : cA; const char* nB = has_next ? (const char*)g.Bt + (size_t)nxt.pn * tstep : cB;
        for (int t = 0; t < nt; t += 2) {
            const bool last = (t == nt - 2);
            const char* a1 = cA + (size_t)(t + 1) * kstep;
            const char* a2 = last ? nA : cA + (size_t)(t + 2) * kstep; const char* b2 = last ? nB : cB + (size_t)(t + 2) * kstep;
            const char* a3 = a2 + kstep; const char* b3 = b2 + kstep;
            if (last && has_next) S.a_ready(nxt);
            if constexpr (SP2) {
            PG8_LDB(B0, 0, 0); PG8_LDB(B1, 0, 1); PG8_SCHED; PG8_LDA(At, 0, 0); PG8_STAGE(PG8_SA(1, 1), a1 + hstep, voffA);
            PG8_WAIT_V(8); PG8_WAIT_L(0); PG8_BAR; PG8_MMA(0, 0, At, B0); PG8_MMA(0, 1, At, B1); PG8_BAR; PG8_SCHED;
            PG8_LDA(At, 0, 1); PG8_STAGE(PG8_SB(0, 0), b2, voffB); PG8_STAGE(PG8_SB(0, 1), b2 + hstep, voffB); PG8_STAGE(PG8_SA(0, 0), a2, voffA);
            PG8_WAIT_V(8); PG8_WAIT_L(0); PG8_BAR; PG8_MMA(1, 0, At, B0); PG8_MMA(1, 1, At, B1); PG8_BAR; PG8_SCHED;
            PG8_LDB(B0, 1, 0); PG8_LDB(B1, 1, 1); PG8_SCHED; PG8_LDA(At, 1, 0); PG8_STAGE(PG8_SA(0, 1), a2 + hstep, voffA);
            PG8_WAIT_V(8); PG8_WAIT_L(0); PG8_BAR; PG8_MMA(0, 0, At, B0); PG8_MMA(0, 1, At, B1); PG8_BAR; PG8_SCHED;
            PG8_LDA(At, 1, 1); PG8_STAGE(PG8_SB(1, 0), b3, voffB); PG8_STAGE(PG8_SB(1, 1), b3 + hstep, voffB); PG8_STAGE(PG8_SA(1, 0), a3, voffA);
            PG8_WAIT_V(8); PG8_WAIT_L(0); PG8_BAR; PG8_MMA(1, 0, At, B0); PG8_MMA(1, 1, At, B1); PG8_BAR; PG8_SCHED;
            } else {
            PG8_LDB(B0, 0, 0); PG8_SCHED; PG8_LDA(At, 0, 0); PG8_STAGE(PG8_SA(1, 1), a1 + hstep, voffA);
            PG8_WAIT_L(8); PG8_BAR; PG8_WAIT_L(0); PG8_MMA(0, 0, At, B0); PG8_BAR; PG8_SCHED;
            PG8_LDB(B1, 0, 1); PG8_STAGE(PG8_SB(0, 0), b2, voffB);
            PG8_BAR; PG8_WAIT_L(0); PG8_MMA(0, 1, At, B1); PG8_BAR;
            PG8_LDA(At, 0, 1); PG8_STAGE(PG8_SA(0, 0), a2, voffA);
            PG8_BAR; PG8_WAIT_L(0); PG8_MMA(1, 0, At, B0); PG8_BAR; PG8_SCHED;
            PG8_STAGE(PG8_SB(0, 1), b2 + hstep, voffB);
            PG8_WAIT_V(6); PG8_BAR; PG8_MMA(1, 1, At, B1); PG8_BAR;
            PG8_LDB(B0, 1, 0); PG8_SCHED; PG8_LDA(At, 1, 0); PG8_STAGE(PG8_SA(0, 1), a2 + hstep, voffA);
            PG8_WAIT_L(8); PG8_BAR; PG8_WAIT_L(0); PG8_MMA(0, 0, At, B0); PG8_BAR; PG8_SCHED;
            PG8_LDB(B1, 1, 1); PG8_STAGE(PG8_SB(1, 0), b3, voffB);
            PG8_BAR; PG8_WAIT_L(0); PG8_MMA(0, 1, At, B1); PG8_BAR;
            PG8_LDA(At, 1, 1); PG8_STAGE(PG8_SA(1, 0), a3, voffA);
            PG8_BAR; PG8_WAIT_L(0); PG8_MMA(1, 0, At, B0); PG8_BAR; PG8_SCHED;
            PG8_STAGE(PG8_SB(1, 1), b3 + hstep, voffB);
            PG8_WAIT_V(6); PG8_BAR; PG8_MMA(1, 1, At, B1); PG8_BAR;
            }
        }
        if constexpr (ALIGN_EPI) { if (wr == 0) PG8_BAR; }
        if constexpr (!Epi::AFTER_DRAIN) { E(acc, cur, wr, wc, fr, fq); S.done(cur); }
        if (!has_next) break;
#pragma unroll
        for (int a = 0; a < 2; ++a)
#pragma unroll
            for (int b = 0; b < 2; ++b)
#pragma unroll
                for (int m = 0; m < 4; ++m)
#pragma unroll
                    for (int n = 0; n < 2; ++n) acc[a][b][m][n] = (f32x4){0.f, 0.f, 0.f, 0.f};
        cur = nxt; cA = nA; cB = nB; ++ui;
        if constexpr (ALIGN_EPI) { if (wr == 1) PG8_BAR; }
    }
    PG8_WAIT_V(0);
    if constexpr (!ALIGN_EPI) { if (wr == 0) PG8_BAR; }
    PG8_BAR;
    if constexpr (Epi::AFTER_DRAIN) { E.fused(acc, cur, wr, wc, fr, fq, lds, wid, lane); S.done(cur); }
#undef PG8_SA
#undef PG8_SB
#undef PG8_STAGE
#undef PG8_LDA
#undef PG8_LDB
#undef PG8_MMA
#undef PG8_WAIT_V
#undef PG8_WAIT_L
#undef PG8_BAR
#undef PG8_SCHED
}
}

constexpr int NWAVES = 8, NTHREADS = 512;
#ifndef MK_N_LAUNCHES
#define MK_N_LAUNCHES 1
#endif
constexpr int BATCH = 8, SEQ = 2048, D = 1024, FF = 4096, NH = 4, DK = 128, DV = 256, QKW = 512, VW = 1024;
constexpr int M = BATCH * SEQ, NPROJ = 3072, CH = 64, NCH = SEQ / CH;
constexpr int MLSTM_IN = 3080, GLA_IN = 3088;
constexpr float EPS = 1e-6f, QK_SCALE = 0.08838834764831845f, INV_TAU = 1.0f / 16.0f;

constexpr size_t MiB = 1u << 20;
constexpr size_t WS_CTL = 0, CTL_ZERO_BYTES = 64 * 1024;
constexpr size_t WS_GATES = 1 * MiB;
constexpr size_t WS_GDEC = 2 * MiB;
constexpr size_t WS_WIN = 4 * MiB, WS_WOUT = 10 * MiB, WS_W1 = 12 * MiB, WS_W2 = 20 * MiB;
constexpr size_t WS_AOP = 28 * MiB;
constexpr size_t WS_HUN = 60 * MiB;
constexpr size_t WS_PROJ = 92 * MiB;
constexpr size_t WS_QT = 188 * MiB, WS_KT = 204 * MiB, WS_KH = 220 * MiB;
constexpr size_t WS_HMID = 92 * MiB;
constexpr size_t WS_END = 236 * MiB;
constexpr int CW_BAR = 1024;

constexpr int RING_BYTES = 131072, LDS_BYTES = 155648, LDSCTL_OFF = LDS_BYTES - 1024, MISC_OFF = LDSCTL_OFF + 320;

#define GAS __attribute__((address_space(1)))
#define LAS __attribute__((address_space(3)))
typedef unsigned short bf16;
typedef unsigned v4u __attribute__((ext_vector_type(4)));
typedef unsigned v2u __attribute__((ext_vector_type(2)));
typedef float f32x4 __attribute__((ext_vector_type(4)));
typedef float f32x16 __attribute__((ext_vector_type(16)));
typedef short bf16x8 __attribute__((ext_vector_type(8)));
typedef short s16x4 __attribute__((ext_vector_type(4)));
typedef GAS unsigned gu32;
#define RLX_AGENT __ATOMIC_RELAXED, __HIP_MEMORY_SCOPE_AGENT
#define LDS_WAIT() asm volatile("s_waitcnt lgkmcnt(0)" ::: "memory")
#define VM_WAIT() asm volatile("s_waitcnt vmcnt(0)" ::: "memory")
using pg8::pk_bf16;
__device__ __forceinline__ float bf2f(unsigned b) { return __uint_as_float(b << 16); }
__device__ __forceinline__ float bflo(unsigned w) { return __uint_as_float(w << 16); }
__device__ __forceinline__ float bfhi(unsigned w) { return __uint_as_float(w & 0xffff0000u); }
__device__ __forceinline__ unsigned short f2bf1(float f) { return (unsigned short)(pk_bf16(f, 0.f) & 0xffffu); }

#define XB_TMO      128
#define XB_XCNT(j)  (256  + 64 * (j))
#define XB_XSUB(j)  (1280 + 64 * (j))
#define XB_XGEN(j)  (2304 + 64 * (j))
#define XB_TOP      3328
#define XB_TOPGEN   3392
#define XCD_BAR_WORDS 3456
#define XB_SPIN_CAP (1u << 18)
__device__ __forceinline__ unsigned xb_ld(unsigned* p)              { return __hip_atomic_load(p, __ATOMIC_RELAXED, __HIP_MEMORY_SCOPE_AGENT); }
__device__ __forceinline__ unsigned xb_add(unsigned* p, unsigned v) { return __hip_atomic_fetch_add(p, v, __ATOMIC_RELAXED, __HIP_MEMORY_SCOPE_AGENT); }
__device__ __forceinline__ unsigned xb_xcc_id() { return (unsigned)__builtin_amdgcn_s_getreg((3 << 11) | 20) & 0xFu; }
#define XB_SPIN(cond, bar) do { unsigned _sp = 0; while (cond) { __builtin_amdgcn_s_sleep(1); \
    if ((++_sp & 255u) == 0u) { if (xb_ld(&(bar)[XB_TMO])) break; if (_sp > XB_SPIN_CAP) { atomicAdd(&(bar)[XB_TMO], 1u); break; } } } } while (0)
struct XcdBarrier { unsigned* bar; unsigned x; volatile LAS unsigned* st; };
__device__ __forceinline__ XcdBarrier xcd_barrier_post(unsigned* bar, volatile LAS unsigned* st) {
    XcdBarrier b; b.bar = bar; b.x = xb_xcc_id(); b.st = st;
    if (threadIdx.x == 0) (void)xb_add(&bar[XB_XCNT(b.x)], 1u);
    return b;
}
__device__ __forceinline__ void xcd_barrier_complete(unsigned* bar, unsigned x, unsigned& nloc, unsigned& nx) {
    const unsigned G = gridDim.x * gridDim.y * gridDim.z;
    unsigned sum, cnt, mine, sp = 0u;
    for (;;) {
        sum = 0u; cnt = 0u; mine = 0u;
#pragma unroll
        for (unsigned j = 0; j < 16; ++j) { const unsigned c = xb_ld(&bar[XB_XCNT(j)]); sum += c; cnt += (c > 0u) ? 1u : 0u; mine = (j == x) ? c : mine; }
        if (sum == G) break;
        __builtin_amdgcn_s_sleep(1);
        if ((++sp & 255u) == 0u) { if (xb_ld(&bar[XB_TMO])) break; if (sp > XB_SPIN_CAP) { atomicAdd(&bar[XB_TMO], 1u); break; } }
    }
    nloc = mine > 0u ? mine : 1u; nx = cnt > 0u ? cnt : 1u;
}
__device__ __forceinline__ void xcd_barrier(const XcdBarrier& b) {
    asm volatile("s_waitcnt vmcnt(0)" ::: "memory");
    __syncthreads();
    if (threadIdx.x == 0) {
        unsigned* bar = b.bar;
        __builtin_amdgcn_s_waitcnt(0);
        unsigned nloc = b.st[0], nx = b.st[1];
        if (nloc == 0u) { xcd_barrier_complete(bar, b.x, nloc, nx); b.st[0] = nloc; b.st[1] = nx; }
        const unsigned old = xb_add(&bar[XB_XSUB(b.x)], 1u);
        const unsigned gen = old / nloc;
        if (old + 1u == (gen + 1u) * nloc) {
            __builtin_amdgcn_fence(__ATOMIC_RELEASE, "agent");
            asm volatile("s_waitcnt vmcnt(0)" ::: "memory");
            const unsigned og = xb_add(&bar[XB_TOP], 1u);
            const unsigned tg = og / nx;
            if (og + 1u == (tg + 1u) * nx) xb_add(&bar[XB_TOPGEN], 1u);
            else XB_SPIN(xb_ld(&bar[XB_TOPGEN]) == tg, bar);
            __builtin_amdgcn_fence(__ATOMIC_ACQUIRE, "agent");
            xb_add(&bar[XB_XGEN(b.x)], 1u);
            asm volatile("s_waitcnt vmcnt(0)" ::: "memory");
        } else {
            XB_SPIN(xb_ld(&bar[XB_XGEN(b.x)]) == gen, bar);
            __builtin_amdgcn_fence(__ATOMIC_ACQUIRE, "agent");
            asm volatile("s_waitcnt vmcnt(0)" ::: "memory");
        }
    }
    __syncthreads();
}

__device__ __forceinline__ float wave_sum(float v) {
#pragma unroll
    for (int o = 1; o < 64; o <<= 1) v += __shfl_xor(v, o);
    return v;
}
__device__ __forceinline__ void transpose_item(const float* W, int K, int N, int ldw, bf16* WT, const float* gain, LAS float* scr, int item, int lane) {
    const int nblk = N / 32, kb = item / nblk, nb = item % nblk, k0 = 64 * kb, n0 = 32 * nb;
    const int n4 = (lane & 7) * 4, krow = lane >> 3;
    f32x4 v[8];
#pragma unroll
    for (int i = 0; i < 8; ++i) v[i] = *(const f32x4*)(W + (size_t)(k0 + 8 * i + krow) * ldw + n0 + n4);
#pragma unroll
    for (int i = 0; i < 8; ++i) *(LAS f32x4*)(scr + (8 * i + krow) * 32 + (n4 ^ (i << 2))) = v[i];
    const int c = lane & 7, nl = lane >> 3;
    f32x4 g0 = {1.f, 1.f, 1.f, 1.f}, g1 = {1.f, 1.f, 1.f, 1.f};
    if (gain) { g0 = *(const f32x4*)(gain + k0 + 8 * c); g1 = *(const f32x4*)(gain + k0 + 8 * c + 4); }
    LDS_WAIT(); asm volatile("" ::: "memory");
#pragma unroll
    for (int j = 0; j < 4; ++j) { const int n = 8 * j + nl; const LAS float* sp = scr + (8 * c) * 32 + (n ^ (c << 2));
        v4u o; o.x = pk_bf16(sp[0 * 32] * g0.x, sp[1 * 32] * g0.y); o.y = pk_bf16(sp[2 * 32] * g0.z, sp[3 * 32] * g0.w); o.z = pk_bf16(sp[4 * 32] * g1.x, sp[5 * 32] * g1.y); o.w = pk_bf16(sp[6 * 32] * g1.z, sp[7 * 32] * g1.w);
        *(GAS v4u*)(WT + (size_t)(n0 + n) * K + k0 + 8 * c) = o; }
    LDS_WAIT(); asm volatile("" ::: "memory");
}
__device__ __forceinline__ void convert_weights(LAS unsigned char* lds, int lane, int wave, int vcu, int G, const float* w_in, int ld_in, const float* w_out, const float* w1, const float* w2, unsigned char* ws) {
    LAS float* scr = (LAS float*)(lds + wave * 16384);
    const int gw = vcu * NWAVES + wave, NGW = G * NWAVES;
    constexpr int I_IN = (D / 64) * (NPROJ / 32), I_O = (D / 64) * (D / 32), I_1 = (D / 64) * (FF / 32), I_2 = (FF / 64) * (D / 32);
    constexpr int NITEMS = I_IN + I_O + I_1 + I_2;
    for (int it = gw; it < NITEMS; it += NGW) {
        int r = it;
        if (r < I_IN) { transpose_item(w_in, D, NPROJ, ld_in, (bf16*)(ws + WS_WIN), nullptr, scr, r, lane); continue; } r -= I_IN;
        if (r < I_O) { transpose_item(w_out, D, D, D, (bf16*)(ws + WS_WOUT), nullptr, scr, r, lane); continue; } r -= I_O;
        if (r < I_1) { transpose_item(w1, D, FF, FF, (bf16*)(ws + WS_W1), nullptr, scr, r, lane); continue; } r -= I_1;
        transpose_item(w2, FF, D, D, (bf16*)(ws + WS_W2), nullptr, scr, r, lane);
    }
}

template <bool GATE, bool OUT_BF16>
__device__ __forceinline__ void norm_rows(LAS unsigned char* lds, int tid, int lane, int wave, int vcu, int G, const float* xin, const float* gain, bf16* aop, float* fout,
                                          const float* wg, int ldw, int ng, float* gates) {
    LAS float* WgT = (LAS float*)lds;
    if (GATE) {
        __syncthreads();
        for (int i = tid; i < 16 * D; i += NTHREADS) { const int k = i >> 4, c = i & 15; WgT[c * D + k] = (c < ng) ? wg[(size_t)k * ldw + c] : 0.f; }
        __syncthreads();
    }
    const int gw = vcu * NWAVES + wave, NGW = G * NWAVES;
    f32x4 gn[4];
#pragma unroll
    for (int j = 0; j < 4; ++j) gn[j] = *(const f32x4*)(gain + 4 * lane + 256 * j);
    for (int m = gw; m < M; m += NGW) {
        const float* xr = xin + (size_t)m * D + 4 * lane;
        f32x4 v[4]; float s = 0.f;
#pragma unroll
        for (int j = 0; j < 4; ++j) { v[j] = *(const f32x4*)(xr + 256 * j); s += (v[j].x * v[j].x + v[j].y * v[j].y) + (v[j].z * v[j].z + v[j].w * v[j].w); }
        const float rstd = 1.0f / sqrtf(wave_sum(s) * (1.f / D) + EPS);
#pragma unroll
        for (int j = 0; j < 4; ++j) v[j] = v[j] * rstd * gn[j];
        if (OUT_BF16) {
#pragma unroll
            for (int j = 0; j < 4; ++j) { v2u o; o.x = pk_bf16(v[j].x, v[j].y); o.y = pk_bf16(v[j].z, v[j].w); *(v2u*)(aop + (size_t)m * D + 4 * lane + 256 * j) = o; }
        } else {
#pragma unroll
            for (int j = 0; j < 4; ++j) *(f32x4*)(fout + (size_t)m * D + 4 * lane + 256 * j) = v[j];
        }
        if (GATE) {
            float a[16];
#pragma unroll
            for (int c = 0; c < 16; ++c) a[c] = 0.f;
#pragma unroll
            for (int c = 0; c < 16; ++c) {
#pragma unroll
                for (int j = 0; j < 4; ++j) { const f32x4 w = *(const LAS f32x4*)(WgT + c * D + 4 * lane + 256 * j); a[c] += (v[j].x * w.x + v[j].y * w.y) + (v[j].z * w.z + v[j].w * w.w); }
                if (c & 1) asm volatile("" ::: "memory"); }
            const bool b5 = lane & 32, b4 = lane & 16, b3 = lane & 8, b2 = lane & 4;
#pragma unroll
            for (int i = 0; i < 8; ++i) { const float keep = b5 ? a[i + 8] : a[i], send = b5 ? a[i] : a[i + 8]; a[i] = keep + __shfl_xor(send, 32); }
#pragma unroll
            for (int i = 0; i < 4; ++i) { const float keep = b4 ? a[i + 4] : a[i], send = b4 ? a[i] : a[i + 4]; a[i] = keep + __shfl_xor(send, 16); }
#pragma unroll
            for (int i = 0; i < 2; ++i) { const float keep = b3 ? a[i + 2] : a[i], send = b3 ? a[i] : a[i + 2]; a[i] = keep + __shfl_xor(send, 8); }
            { const float keep = b2 ? a[1] : a[0], send = b2 ? a[0] : a[1]; a[0] = keep + __shfl_xor(send, 4); }
            a[0] += __shfl_xor(a[0], 2); a[0] += __shfl_xor(a[0], 1);
            const int c = (b5 ? 8 : 0) + (b4 ? 4 : 0) + (b3 ? 2 : 0) + (b2 ? 1 : 0);
            if ((lane & 3) == 0 && c < ng) gates[(size_t)m * 16 + c] = a[0];
        }
    }
}

__device__ __forceinline__ void head_norm_rows(int lane, int wave, int vcu, int G, const bf16* hun, const float* gout, const bf16* proj, bf16* aop, const bool GLA) {
    const int gw = vcu * NWAVES + wave, NGW = G * NWAVES;
    for (int m = gw; m < M; m += NGW) {
#pragma unroll
        for (int j = 0; j < 2; ++j) {
            const int col = 8 * lane + 512 * j;
            const v4u hv = *(const v4u*)(hun + (size_t)m * D + col);
            float f[8] = {bflo(hv.x), bfhi(hv.x), bflo(hv.y), bfhi(hv.y), bflo(hv.z), bfhi(hv.z), bflo(hv.w), bfhi(hv.w)};
            float ss = 0.f;
#pragma unroll
            for (int e = 0; e < 8; ++e) ss += f[e] * f[e];
#pragma unroll
            for (int o = 1; o < 32; o <<= 1) ss += __shfl_xor(ss, o);
            const float rs = 1.0f / sqrtf(ss * (1.f / DV) + EPS);
            const f32x4 g0 = *(const f32x4*)(gout + col), g1 = *(const f32x4*)(gout + col + 4);
            const float gg[8] = {g0.x, g0.y, g0.z, g0.w, g1.x, g1.y, g1.z, g1.w};
#pragma unroll
            for (int e = 0; e < 8; ++e) f[e] = f[e] * rs * gg[e];
            if (GLA) {
                const v4u rv = *(const v4u*)(proj + (size_t)m * NPROJ + 2048 + col);
                const float r[8] = {bflo(rv.x), bfhi(rv.x), bflo(rv.y), bfhi(rv.y), bflo(rv.z), bfhi(rv.z), bflo(rv.w), bfhi(rv.w)};
#pragma unroll
                for (int e = 0; e < 8; ++e) f[e] *= r[e] / (1.0f + __expf(-r[e]));
            }
            v4u o; o.x = pk_bf16(f[0], f[1]); o.y = pk_bf16(f[2], f[3]); o.z = pk_bf16(f[4], f[5]); o.w = pk_bf16(f[6], f[7]);
            *(v4u*)(aop + (size_t)m * D + col) = o;
        }
    }
}

__device__ __forceinline__ void gla_prep(LAS unsigned char* lds, int tid, int vcu, int G, const bf16* proj, const float* gates, const float* wup, const float* bgate,
                                         bf16* QT, bf16* KT, bf16* KH, float* gdec) {
    LAS float* zl = (LAS float*)lds;
    LAS float* tot = (LAS float*)(lds + 4096);
    const int d = tid & 127, rg = tid >> 7;
    for (int unit = vcu; unit < BATCH * NCH * NH; unit += G) {
        const int h = unit & 3, bc = unit >> 2, b = bc / NCH, c = bc % NCH, tok0 = b * SEQ + c * CH;
        float wu[16];
#pragma unroll
        for (int cc = 0; cc < 16; ++cc) wu[cc] = wup[cc * QKW + h * DK + d];
        const float bg = bgate[h * DK + d];
        __syncthreads();
        if (tid < 256) *(LAS f32x4*)(zl + 4 * tid) = *(const f32x4*)(gates + (size_t)tok0 * 16 + 4 * tid);
        __syncthreads();
        float bcum[16]; float run = 0.f;
#pragma unroll
        for (int jj = 0; jj < 16; ++jj) {
            const int j = 16 * rg + jj; float z = bg;
#pragma unroll
            for (int q4 = 0; q4 < 4; ++q4) { const f32x4 zz = *(const LAS f32x4*)(zl + j * 16 + 4 * q4); z += (zz.x * wu[4 * q4] + zz.y * wu[4 * q4 + 1]) + (zz.z * wu[4 * q4 + 2] + zz.w * wu[4 * q4 + 3]); }
            const float la = (fminf(z, 0.f) - __logf(1.0f + __expf(-fabsf(z)))) * INV_TAU;
            run += la; bcum[jj] = run;
        }
        tot[rg * 128 + d] = run;
        __syncthreads();
        float off = 0.f, g = 0.f;
#pragma unroll
        for (int r2 = 0; r2 < 4; ++r2) { const float t = tot[r2 * 128 + d]; g += t; off += (r2 < rg) ? t : 0.f; }
#pragma unroll
        for (int jj = 0; jj < 16; ++jj) {
            const int j = 16 * rg + jj; const float bb = bcum[jj] + off;
            const float q = bf2f(proj[(size_t)(tok0 + j) * NPROJ + h * DK + d]), k = bf2f(proj[(size_t)(tok0 + j) * NPROJ + QKW + h * DK + d]);
            const size_t o = (size_t)(tok0 + j) * QKW + h * DK + d;
            QT[o] = f2bf1(q * QK_SCALE * __expf(bb)); KT[o] = f2bf1(k * __expf(-bb)); KH[o] = f2bf1(k * __expf(g - bb));
        }
        if (rg == 0) gdec[(size_t)unit * DK + d] = __expf(g);
    }
    __syncthreads();
}

template <bool MLSTM> struct MxMap;
template <> struct MxMap<true>  { static constexpr int QS = 0, KS = 17408, KHS = 17408, V = 52224, O = 60416, VW = 68608, VWAUX = 76800, VAUX = 84992, PS = 89088, CT = 98304, TB = 115712, TWP = 123904, TPM = 132096, TSC = 140288, DEN = 140800, RDEN = 141312, OUTT = 141568, NUM = 141568, GDEC = 0, END = 150784; };
template <> struct MxMap<false> { static constexpr int QS = 0, KS = 17408, KHS = 34816, V = 69632, O = 0, VW = 0, VWAUX = 0, VAUX = 0, PS = 77824, CT = 87040, TB = 0, TWP = 0, TPM = 0, TSC = 0, DEN = 0, RDEN = 0, OUTT = 105472, NUM = 0, GDEC = 104448, END = 109568; };
constexpr int PS_PITCH = 144, CT_PITCH = 272, CT_BYTES = 32 * CT_PITCH, IMG_PITCH = 272, IMG_BYTES = 64 * IMG_PITCH;
__device__ __forceinline__ bf16x8 tr8(LAS unsigned char* p0, LAS unsigned char* p1) {
    const s16x4 lo = __builtin_amdgcn_ds_read_tr16_b64_v4i16((LAS s16x4*)p0), hi = __builtin_amdgcn_ds_read_tr16_b64_v4i16((LAS s16x4*)p1);
    return __builtin_shufflevector(lo, hi, 0, 1, 2, 3, 4, 5, 6, 7);
}
#define MFMA32(a, b, c) __builtin_amdgcn_mfma_f32_32x32x16_bf16((a), (b), (c), 0, 0, 0)
struct MixArgs { const bf16 *q, *k, *kh, *proj; int qpitch; const float *gates, *bgate, *gdec; bf16* hun; };
struct MixPF { v4u q[2], k[2], kh[2], v; float gd; };
struct MixUnit { const bf16 *Qg, *Kg, *KHg, *Vg, *Og; bf16* Hg; const float* gdec; int qpitch, b, hh; };

template <bool MLSTM>
__device__ __forceinline__ void mx_prefetch(MixPF& pf, const MixUnit& U, int c, int tid) {
    const int tok0 = U.b * SEQ + c * CH;
#pragma unroll
    for (int i = 0; i < 2; ++i) { const int p = tid + NTHREADS * i, row = p >> 4, ch = p & 15;
        pf.q[i] = *(const v4u*)(U.Qg + (size_t)(tok0 + row) * U.qpitch + ch * 8); pf.k[i] = *(const v4u*)(U.Kg + (size_t)(tok0 + row) * U.qpitch + ch * 8);
        if (!MLSTM) pf.kh[i] = *(const v4u*)(U.KHg + (size_t)(tok0 + row) * U.qpitch + ch * 8); }
    if (tid < 256) pf.v = *(const v4u*)(U.Vg + (size_t)(tok0 + (tid >> 2)) * NPROJ + (tid & 3) * 8);
    else if (MLSTM) pf.v = *(const v4u*)(U.Og + (size_t)(tok0 + ((tid - 256) >> 2)) * NPROJ + (tid & 3) * 8);
    if (!MLSTM && tid < 128) pf.gd = U.gdec[(size_t)(((U.b * NCH + c) * NH) + U.hh) * DK + tid];
}
__device__ __forceinline__ void mx_store_tile(LAS unsigned char* outt, const float (&val)[16], bf16* grow  , int lane, int r, int h5) {
#pragma unroll
    for (int i = 0; i < 16; ++i) *(LAS unsigned short*)(outt + ((i & 3) + 8 * (i >> 2) + 4 * h5) * 64 + r * 2) = f2bf1(val[i]);
#pragma unroll
    for (int i = 0; i < 2; ++i) { const int id = lane + 64 * i, row = id >> 2, pc = id & 3; const v4u w = *(const LAS v4u*)(outt + row * 64 + pc * 16); *(v4u*)(grow + (size_t)row * D + pc * 8) = w; }
}
constexpr int NUM_PITCH = 36;
__device__ __forceinline__ void mx_finalize_mlstm(LAS unsigned char* lds, const MixUnit& U, int cf, int fl) {
    typedef MxMap<true> MP;
    const int parf = cf & 1, j = fl >> 2, sg = fl & 3; const float mc = ((const LAS float*)(lds + MP::TSC))[cf];
    const float dn = ((const LAS float*)(lds + MP::DEN))[parf * 64 + j], bb = ((const LAS float*)(lds + MP::TB))[cf * 64 + j], pm = ((const LAS float*)(lds + MP::TPM))[cf * 64 + j];
    const float rden = QK_SCALE * __builtin_amdgcn_rcpf(fmaxf(fabsf(dn) * QK_SCALE, __expf(-bb - fmaxf(mc, pm))));
    const f32x4 n0 = *(const LAS f32x4*)((const LAS float*)(lds + MP::NUM) + j * NUM_PITCH + 8 * sg), n1 = *(const LAS f32x4*)((const LAS float*)(lds + MP::NUM) + j * NUM_PITCH + 8 * sg + 4);
    const v4u ov = *(const LAS v4u*)(lds + MP::O + parf * 4096 + j * 64 + sg * 16);
    const float nn[8] = {n0.x, n0.y, n0.z, n0.w, n1.x, n1.y, n1.z, n1.w};
    const float oo[8] = {bflo(ov.x), bfhi(ov.x), bflo(ov.y), bfhi(ov.y), bflo(ov.z), bfhi(ov.z), bflo(ov.w), bfhi(ov.w)};
    float hv[8];
#pragma unroll
    for (int e = 0; e < 8; ++e) hv[e] = nn[e] * rden * __builtin_amdgcn_rcpf(1.0f + __expf(-oo[e]));
    v4u w; w.x = pk_bf16(hv[0], hv[1]); w.y = pk_bf16(hv[2], hv[3]); w.z = pk_bf16(hv[4], hv[5]); w.w = pk_bf16(hv[6], hv[7]);
    *(v4u*)(U.Hg + (size_t)(U.b * SEQ + cf * CH + j) * D + 8 * sg) = w;
}

template <bool MLSTM>
__device__ __forceinline__ void mx_step(LAS unsigned char* lds, MixPF& pf, const MixUnit& U, int c, f32x16& accC0, f32x16& accC1, f32x16& accO, int tid, int lane, int wave) {
    typedef MxMap<MLSTM> MP;
    const int r = lane & 31, h5 = lane >> 5, blk = (lane >> 4) & 1, q4 = (lane & 15) >> 2, p4 = lane & 3, par = c & 1;
    const LAS float* TSC = (const LAS float*)(lds + MP::TSC);
#pragma unroll
    for (int i = 0; i < 2; ++i) { const int p = tid + NTHREADS * i, row = p >> 4, ch = p & 15; const unsigned o = row * IMG_PITCH + ch * 16;
        *(LAS v4u*)(lds + MP::QS + o) = pf.q[i];
        if (MLSTM) *(LAS v4u*)(lds + MP::KS + par * IMG_BYTES + o) = pf.k[i];
        else { *(LAS v4u*)(lds + MP::KS + o) = pf.k[i]; *(LAS v4u*)(lds + MP::KHS + par * IMG_BYTES + o) = pf.kh[i]; } }
    if (tid < 256) { const int row = tid >> 2, pc = tid & 3;
        *(LAS v4u*)(lds + MP::V + par * 4096 + row * 64 + pc * 16) = pf.v;
        if (MLSTM) { const float wr_ = __expf(((const LAS float*)(lds + MP::TWP))[c * 64 + row] - TSC[32 + c]); v4u o; const v4u pv = pf.v;
            o.x = pk_bf16(bflo(pv.x) * wr_, bfhi(pv.x) * wr_); o.y = pk_bf16(bflo(pv.y) * wr_, bfhi(pv.y) * wr_); o.z = pk_bf16(bflo(pv.z) * wr_, bfhi(pv.z) * wr_); o.w = pk_bf16(bflo(pv.w) * wr_, bfhi(pv.w) * wr_);
            *(LAS v4u*)(lds + MP::VW + par * 4096 + row * 64 + pc * 16) = o; }
    } else if (MLSTM) { const int row = (tid - 256) >> 2, pc = tid & 3; *(LAS v4u*)(lds + MP::O + par * 4096 + row * 64 + pc * 16) = pf.v; }
    if (MLSTM && wave == 0) *(LAS unsigned short*)(lds + MP::VWAUX + par * 4096 + lane * 64) = f2bf1(__expf(((const LAS float*)(lds + MP::TWP))[c * 64 + lane] - TSC[32 + c]));
    if (!MLSTM && tid < 128) ((LAS float*)(lds + MP::GDEC))[par * 128 + tid] = pf.gd;
    if (c + 2 < NCH) mx_prefetch<MLSTM>(pf, U, c + 2, tid);
    __syncthreads();
    const float mc = MLSTM ? TSC[c] : 0.f;
    if (wave < 4) {
        const int st = wave >> 1, jt = (wave == 1 || wave == 2) ? 1 : 0;
#pragma unroll
        for (int i = 0; i < 16; ++i) accO[i] = 0.f;
        if (wave != 3) {
            LAS unsigned char* kimg = lds + MP::KS + (MLSTM ? par * IMG_BYTES : 0) + (32 * st + r) * IMG_PITCH + 16 * h5;
            LAS unsigned char* qimg = lds + MP::QS + (32 * jt + r) * IMG_PITCH + 16 * h5;
#pragma unroll
            for (int ks = 0; ks < 8; ++ks) { const bf16x8 a = *(const LAS bf16x8*)(kimg + 32 * ks), bq = *(const LAS bf16x8*)(qimg + 32 * ks); accO = MFMA32(a, bq, accO); }
        }
        const int j = 32 * jt + r; float uj = 0.f;
        if (MLSTM) uj = -fmaxf(mc, ((const LAS float*)(lds + MP::TPM))[c * 64 + j]);
#pragma unroll
        for (int g4 = 0; g4 < 4; ++g4) { const int s0 = 32 * st + 8 * g4 + 4 * h5; f32x4 wps = {0.f, 0.f, 0.f, 0.f}; if (MLSTM) wps = *(const LAS f32x4*)((const LAS float*)(lds + MP::TWP) + c * 64 + s0);
            float v[4];
#pragma unroll
            for (int e = 0; e < 4; ++e) { float x = accO[4 * g4 + e]; if (MLSTM) x *= __expf(uj + wps[e]); v[e] = (s0 + e <= j) ? x : 0.f; }
            v2u o; o.x = pk_bf16(v[0], v[1]); o.y = pk_bf16(v[2], v[3]); *(LAS v2u*)(lds + MP::PS + j * PS_PITCH + s0 * 2) = o; }
    } else {
        const int g = (wave - 4) >> 1, jt = wave & 1;
        if (MLSTM && c > 0) mx_finalize_mlstm(lds, U, c - 1, tid - 256);
        if (MLSTM || g == 0) {
#pragma unroll
            for (int i = 0; i < 16; ++i) accO[i] = 0.f;
#pragma unroll
            for (int ks = 0; ks < 8; ++ks) { const bf16x8 a = *(const LAS bf16x8*)(lds + MP::QS + (32 * jt + r) * IMG_PITCH + 16 * h5 + 32 * ks), bc = *(const LAS bf16x8*)(lds + MP::CT + g * CT_BYTES + r * CT_PITCH + 32 * ks + 16 * h5); accO = MFMA32(a, bc, accO); }
            if (MLSTM) {
#pragma unroll
                for (int g4 = 0; g4 < 4; ++g4) { const f32x4 pm = *(const LAS f32x4*)((const LAS float*)(lds + MP::TPM) + c * 64 + 32 * jt + 8 * g4 + 4 * h5);
#pragma unroll
                    for (int e = 0; e < 4; ++e) accO[4 * g4 + e] *= __expf(mc - fmaxf(mc, pm[e])); }
            }
        }
    }
    __syncthreads();
    if (wave < 4) {
        if (MLSTM) { const float decay = __expf(mc - TSC[32 + c]); accC0 = accC0 * decay; accC1 = accC1 * decay; }
        else {
#pragma unroll
            for (int g4 = 0; g4 < 4; ++g4) { const f32x4 dc = *(const LAS f32x4*)((const LAS float*)(lds + MP::GDEC) + par * 128 + 32 * wave + 8 * g4 + 4 * h5);
#pragma unroll
                for (int e = 0; e < 4; ++e) accC0[4 * g4 + e] *= dc[e]; }
        }
        LAS unsigned char* kimg = lds + (MLSTM ? MP::KS : MP::KHS) + par * IMG_BYTES + (8 * h5 + q4) * IMG_PITCH + 64 * wave + 32 * blk + 8 * p4;
        LAS unsigned char* vimg = lds + (MLSTM ? MP::VW : MP::V) + par * 4096;
        LAS unsigned char* vaux = lds + MP::VWAUX + par * 4096;
#pragma unroll
        for (int ks = 0; ks < 4; ++ks) {
            const int row0 = 16 * ks + 8 * h5 + q4;
            const bf16x8 a = tr8(kimg + 16 * ks * IMG_PITCH, kimg + (16 * ks + 4) * IMG_PITCH);
            const bf16x8 b0 = tr8(vimg + row0 * 64 + 32 * blk + 8 * p4, vimg + (row0 + 4) * 64 + 32 * blk + 8 * p4);
            accC0 = MFMA32(a, b0, accC0);
            if (MLSTM) { const bf16x8 b1 = tr8(vaux + row0 * 64 + 32 * blk + 8 * p4, vaux + (row0 + 4) * 64 + 32 * blk + 8 * p4); accC1 = MFMA32(a, b1, accC1); }
        }
#pragma unroll
        for (int g4 = 0; g4 < 4; ++g4) { const int d0 = 32 * wave + 8 * g4 + 4 * h5;
            v2u o; o.x = pk_bf16(accC0[4 * g4], accC0[4 * g4 + 1]); o.y = pk_bf16(accC0[4 * g4 + 2], accC0[4 * g4 + 3]); *(LAS v2u*)(lds + MP::CT + r * CT_PITCH + d0 * 2) = o;
            if (MLSTM) { v2u o1; o1.x = pk_bf16(accC1[4 * g4], accC1[4 * g4 + 1]); o1.y = pk_bf16(accC1[4 * g4 + 2], accC1[4 * g4 + 3]); *(LAS v2u*)(lds + MP::CT + CT_BYTES + r * CT_PITCH + d0 * 2) = o1; } }
    } else {
        const int g = (wave - 4) >> 1, jt = wave & 1;
        if (MLSTM || g == 0) {
            LAS unsigned char* vimg = (g == 0) ? (lds + MP::V + par * 4096) : (lds + MP::VAUX);
#pragma unroll
            for (int ks = 0; ks < 4; ++ks) { const int row0 = 16 * ks + 8 * h5 + q4;
                const bf16x8 a = *(const LAS bf16x8*)(lds + MP::PS + (32 * jt + r) * PS_PITCH + 32 * ks + 16 * h5);
                const bf16x8 bv = tr8(vimg + row0 * 64 + 32 * blk + 8 * p4, vimg + (row0 + 4) * 64 + 32 * blk + 8 * p4);
                accO = MFMA32(a, bv, accO); }
            if (MLSTM && g == 0) {
#pragma unroll
                for (int i = 0; i < 16; ++i) ((LAS float*)(lds + MP::NUM))[(32 * jt + (i & 3) + 8 * (i >> 2) + 4 * h5) * NUM_PITCH + r] = accO[i];
            }
            if (MLSTM && g == 1 && r == 0) {
                LAS float* den = (LAS float*)(lds + MP::DEN) + par * 64;
#pragma unroll
                for (int i = 0; i < 16; ++i) den[32 * jt + (i & 3) + 8 * (i >> 2) + 4 * h5] = accO[i];
            }
            if (!MLSTM) {
                float val[16];
#pragma unroll
                for (int i = 0; i < 16; ++i) val[i] = accO[i];
                mx_store_tile(lds + MP::OUTT + jt * 2048, val, U.Hg + (size_t)(U.b * SEQ + c * CH + 32 * jt) * D, lane, r, h5);
            }
        }
    }
}

template <bool MLSTM>
__device__ __forceinline__ void mixer_phase(LAS unsigned char* lds, int tid, int lane, int wave, int vcu, int G, const MixArgs A) {
    typedef MxMap<MLSTM> MP;
    for (int unit = vcu; unit < BATCH * NH * 8; unit += G) {
        const int slice = unit & 7, bh = unit >> 3;
        MixUnit U; U.b = bh >> 2; U.hh = bh & 3; U.qpitch = A.qpitch; U.gdec = A.gdec;
        U.Qg = A.q + U.hh * DK; U.Kg = A.k + U.hh * DK; U.KHg = MLSTM ? A.k : A.kh + U.hh * DK;
        U.Vg = A.proj + 1024 + U.hh * DV + 32 * slice; U.Og = A.proj + 2048 + U.hh * DV + 32 * slice; U.Hg = A.hun + U.hh * DV + 32 * slice;
        MixPF pfA, pfB; pfA.gd = 0.f; pfB.gd = 0.f;
        mx_prefetch<MLSTM>(pfA, U, 0, tid); mx_prefetch<MLSTM>(pfB, U, 1, tid);
        __syncthreads();
        for (int i = tid; i < 2 * CT_BYTES / 4; i += NTHREADS) ((LAS unsigned*)(lds + MP::CT))[i] = 0u;
        if (MLSTM) {
            for (int i = tid; i < 1024; i += NTHREADS) ((LAS unsigned*)(lds + MP::VAUX))[i] = ((i & 15) == 0) ? 0x3F80u : 0u;
            for (int i = tid; i < 2048; i += NTHREADS) ((LAS unsigned*)(lds + MP::VWAUX))[i] = 0u;
            LAS float* TB = (LAS float*)(lds + MP::TB); LAS float* TWP = (LAS float*)(lds + MP::TWP); LAS float* TPM = (LAS float*)(lds + MP::TPM); LAS float* TSC = (LAS float*)(lds + MP::TSC);
            const float bgi = A.bgate[U.hh], bgf = A.bgate[4 + U.hh];
            float gi4[4], gf4[4];
#pragma unroll
            for (int cc = 0; cc < 4; ++cc) { const size_t tok = (size_t)U.b * SEQ + (wave + 8 * cc) * CH + lane; gi4[cc] = A.gates[tok * 16 + U.hh] + bgi; gf4[cc] = A.gates[tok * 16 + 4 + U.hh] + bgf; }
#pragma unroll
            for (int cc = 0; cc < 4; ++cc) { const int c = wave + 8 * cc;
                const float lf = fminf(gf4[cc], 0.f) - __logf(1.0f + __expf(-fabsf(gf4[cc])));
                float bsum = lf;
#pragma unroll
                for (int o = 1; o < 64; o <<= 1) { const float t = __shfl_up(bsum, o); if (lane >= o) bsum += t; }
                const float wp = gi4[cc] - bsum; float pm = wp;
#pragma unroll
                for (int o = 1; o < 64; o <<= 1) { const float t = __shfl_up(pm, o); if (lane >= o) pm = fmaxf(pm, t); }
                TB[c * 64 + lane] = bsum; TWP[c * 64 + lane] = wp; TPM[c * 64 + lane] = pm;
                if (lane == 63) { TSC[64 + c] = bsum; TSC[96 + c] = pm; } }
            __syncthreads();
            if (wave == 0) {
                const float gl = TSC[64 + (lane & 31)], pl = TSC[96 + (lane & 31)]; float m = 0.f, myM = 0.f, myX = 0.f;
#pragma clang loop unroll(disable)
                for (int c = 0; c < NCH; ++c) { const float gc = __uint_as_float(__builtin_amdgcn_readlane(__float_as_uint(gl), c)), pc = __uint_as_float(__builtin_amdgcn_readlane(__float_as_uint(pl), c));
                    const float mxe = fmaxf(m, pc); if (lane == c) { myM = m; myX = mxe; } m = gc + mxe; }
                if (lane < 32) { TSC[lane] = myM; TSC[32 + lane] = myX; }
            }
        }
        f32x16 accC0, accC1, accO;
#pragma unroll
        for (int i = 0; i < 16; ++i) { accC0[i] = 0.f; accC1[i] = 0.f; accO[i] = 0.f; }
        __syncthreads();
        for (int c = 0; c < NCH; c += 2) {
            mx_step<MLSTM>(lds, pfA, U, c, accC0, accC1, accO, tid, lane, wave);
            mx_step<MLSTM>(lds, pfB, U, c + 1, accC0, accC1, accO, tid, lane, wave);
        }
        if (MLSTM) { __syncthreads(); if (wave >= 4) mx_finalize_mlstm(lds, U, NCH - 1, tid - 256); }
        __syncthreads();
    }
    __syncthreads();
}

constexpr int N_PHASES = 19;
struct Args { const float* in[15]; float* out; unsigned char* ws; int ph_lo, ph_hi; };
template <int PH>
__device__ __forceinline__ void run_phase(const Args& args, LAS unsigned char* lds, int tid, int lane, int wave, int vcu, int G, int bx) {
    unsigned char* ws = args.ws; float* out = args.out;
    constexpr int layer = (PH >= 9 && PH < 18) ? 1 : 0, k = (PH == 18) ? 9 : PH - 9 * layer;
    bf16* AOP = (bf16*)(ws + WS_AOP); bf16* PROJ = (bf16*)(ws + WS_PROJ); bf16* HUN = (bf16*)(ws + WS_HUN); bf16* HMID = (bf16*)(ws + WS_HMID);
    float* GATES = (float*)(ws + WS_GATES);
    if constexpr (k == 0) {
        const float* w_in = args.in[layer ? 8 : 4]; const int ld_in = layer ? GLA_IN : MLSTM_IN;
        convert_weights(lds, lane, wave, vcu, G, w_in, ld_in, args.in[layer ? 12 : 7], args.in[13] + (size_t)layer * D * FF, args.in[14] + (size_t)layer * D * FF, ws);
        norm_rows<true, true>(lds, tid, lane, wave, vcu, G, layer ? out : args.in[0], args.in[1] + layer * D, AOP, nullptr, w_in + NPROJ, ld_in, layer ? 16 : 8, GATES);
    } else if constexpr (k == 1) {
        pg8::Gemm g{AOP, (const bf16*)(ws + WS_WIN), M, NPROJ, D}; pg8::StaticOrder S; S.init(M, NPROJ, G, bx);
        pg8::EpiBf16<0> E{PROJ, NPROJ};
        pg8::gemm_phase<pg8::EpiBf16<0>, pg8::StaticOrder, true, true>(lds, g, S, E);
    } else if constexpr (k == 2) {
        if (layer) gla_prep(lds, tid, vcu, G, PROJ, GATES, args.in[9], args.in[10], (bf16*)(ws + WS_QT), (bf16*)(ws + WS_KT), (bf16*)(ws + WS_KH), (float*)(ws + WS_GDEC));
    } else if constexpr (k == 3) {
        if (layer == 0) { const MixArgs A{PROJ, PROJ + QKW, nullptr, PROJ, NPROJ, GATES, args.in[5], nullptr, HUN}; mixer_phase<true>(lds, tid, lane, wave, vcu, G, A); }
        else { const MixArgs A{(const bf16*)(ws + WS_QT), (const bf16*)(ws + WS_KT), (const bf16*)(ws + WS_KH), PROJ, QKW, nullptr, nullptr, (const float*)(ws + WS_GDEC), HUN}; mixer_phase<false>(lds, tid, lane, wave, vcu, G, A); }
    } else if constexpr (k == 4) {
        head_norm_rows(lane, wave, vcu, G, HUN, args.in[layer ? 11 : 6], PROJ, AOP, layer != 0);
    } else if constexpr (k == 5) {
        pg8::Gemm g{AOP, (const bf16*)(ws + WS_WOUT), M, D, D}; pg8::StaticOrder S; S.init(M, D, G, bx);
        pg8::EpiResF32 E{layer ? out : args.in[0], out, D};
        pg8::gemm_phase<pg8::EpiResF32, pg8::StaticOrder, false, true>(lds, g, S, E);
    } else if constexpr (k == 6) {
        norm_rows<false, true>(lds, tid, lane, wave, vcu, G, out, args.in[2] + layer * D, AOP, nullptr, nullptr, 0, 0, nullptr);
    } else if constexpr (k == 7) {
        pg8::Gemm g{AOP, (const bf16*)(ws + WS_W1), M, FF, D}; pg8::StaticOrder S; S.init(M, FF, G, bx);
        pg8::EpiBf16<2> E{HMID, FF};
        pg8::gemm_phase<pg8::EpiBf16<2>, pg8::StaticOrder, true, true>(lds, g, S, E);
    } else if constexpr (k == 8) {
        pg8::Gemm g{HMID, (const bf16*)(ws + WS_W2), M, D, FF}; pg8::StaticOrder S; S.init(M, D, G, bx);
        pg8::EpiResF32 E{out, out, D};
        pg8::gemm_phase<pg8::EpiResF32, pg8::StaticOrder, false, true>(lds, g, S, E);
    } else {
        norm_rows<false, false>(lds, tid, lane, wave, vcu, G, out, args.in[3], nullptr, out, nullptr, 0, 0, nullptr);
    }
}
__global__ void __launch_bounds__(NTHREADS, 2) fwd_kernel(Args args) {
    extern __shared__ __attribute__((aligned(16))) unsigned char lds_raw[];
    LAS unsigned char* lds = (LAS unsigned char*)lds_raw;
    volatile LAS unsigned* MISC = (volatile LAS unsigned*)(lds + MISC_OFF);
    const int tid = threadIdx.x, lane = tid & 63, wave = __builtin_amdgcn_readfirstlane(tid >> 6);
    const int G = gridDim.x; const int bx = blockIdx.x; const int vcu = (G % 8 == 0) ? (bx % 8) * (G / 8) + bx / 8 : bx;
    for (int u = tid; u < (LDS_BYTES - LDSCTL_OFF) / 4; u += NTHREADS) ((LAS unsigned*)(lds + LDSCTL_OFF))[u] = 0u;
    __syncthreads();
    const int lo = args.ph_lo, hi = args.ph_hi;
    XcdBarrier bar; bar.bar = (unsigned*)(args.ws + WS_CTL) + CW_BAR; bar.x = 0; bar.st = nullptr;
    if (hi - lo > 1) bar = xcd_barrier_post((unsigned*)(args.ws + WS_CTL) + CW_BAR, MISC + 8);
#ifndef PROBE_PH
#define PROBE_PH (-1)
#endif
#ifndef PROBE_N
#define PROBE_N 0
#endif
#define PHASE(p) if (lo <= (p) && (p) < hi) { run_phase<p>(args, lds, tid, lane, wave, vcu, G, bx); \
        if ((p) == PROBE_PH) { for (int rep_ = 0; rep_ < PROBE_N; ++rep_) { xcd_barrier(bar); if (PROBE_PH >= 0) run_phase<((p) == PROBE_PH ? (p) : 2)>(args, lds, tid, lane, wave, vcu, G, bx); } } \
        if ((p) + 1 < hi && (p) != 2) xcd_barrier(bar); }
    PHASE(0) PHASE(1) PHASE(2) PHASE(3) PHASE(4) PHASE(5) PHASE(6) PHASE(7) PHASE(8) PHASE(9) PHASE(10) PHASE(11) PHASE(12) PHASE(13) PHASE(14) PHASE(15) PHASE(16) PHASE(17) PHASE(18)
#undef PHASE
}

extern "C" void kernel_launch(void* const* d_in, const int* in_sizes, int n_in, void* d_out, int out_size, void* d_ws, size_t ws_size, hipStream_t stream) {
    static int grid = 0;
    if (grid == 0) {
        if (n_in != 15 || in_sizes[0] != M * D || out_size != M * D || ws_size < WS_END) { fprintf(stderr, "kernel_launch: unexpected shapes (n_in %d, in0 %d, out %d, ws %zu); nothing launched\n", n_in, n_in > 0 ? in_sizes[0] : -1, out_size, ws_size); grid = -1; return; }
        int dev = 0, cus = 0, per_cu = 0;
        if (hipGetDevice(&dev) != hipSuccess || hipDeviceGetAttribute(&cus, hipDeviceAttributeMultiprocessorCount, dev) != hipSuccess) { grid = -1; return; }
        if (hipFuncSetAttribute((const void*)fwd_kernel, hipFuncAttributeMaxDynamicSharedMemorySize, LDS_BYTES) != hipSuccess) { fprintf(stderr, "kernel_launch: hipFuncSetAttribute failed\n"); grid = -1; return; }
        if (hipOccupancyMaxActiveBlocksPerMultiprocessor(&per_cu, (const void*)fwd_kernel, NTHREADS, LDS_BYTES) != hipSuccess || per_cu < 1) { fprintf(stderr, "kernel_launch: occupancy query says %d blocks per CU\n", per_cu); (void)hipGetLastError(); grid = -1; return; }
        grid = cus;
    }
    if (grid < 0) return;
    (void)hipMemsetAsync((char*)d_ws + WS_CTL, 0, CTL_ZERO_BYTES, stream);
    Args a{};
    for (int i = 0; i < 15; ++i) a.in[i] = (const float*)d_in[i];
    a.out = (float*)d_out; a.ws = (unsigned char*)d_ws;
    if (MK_N_LAUNCHES == 1) {
        a.ph_lo = 0; a.ph_hi = N_PHASES;
        void* kargs[] = {&a};
        const hipError_t e = hipLaunchCooperativeKernel((const void*)fwd_kernel, dim3(grid), dim3(NTHREADS), kargs, LDS_BYTES, stream);
        if (e != hipSuccess) fprintf(stderr, "kernel_launch: cooperative launch failed: %s (grid %d)\n", hipGetErrorString(e), grid);
    } else {
        for (int p = 0; p < N_PHASES; ++p) { a.ph_lo = p; a.ph_hi = p + 1; hipLaunchKernelGGL(fwd_kernel, dim3(grid), dim3(NTHREADS), LDS_BYTES, stream, a); }
    }
}
```

```cpp
#include <hip/hip_runtime.h>
#include <cstdio>
#include <cstdint>
namespace pg8 {
#define PG8_LAS __attribute__((address_space(3)))
typedef unsigned short bf16_t;
typedef short bf16x8 __attribute__((ext_vector_type(8)));
typedef float f32x4 __attribute__((ext_vector_type(4)));
typedef unsigned u32x4 __attribute__((ext_vector_type(4)));
constexpr int BM = 256, BK = 64, HALF = 128, HTB = HALF * BK * 2  , STAGE_BYTES = 8 * HTB, NXCD = 8, WGM = 8;

__host__ __device__ __forceinline__ int lds_byte(int r, int c) { const int st = (r >> 4) * 2 + (c >> 5), rr = r & 15, cc = c & 31, ob = rr * 64 + cc * 2; return st * 1024 + (ob ^ (((ob >> 9) & 1) << 5)); }
__host__ __device__ __forceinline__ void stage_rc(int b, int& R, int& C) { const int st = b / 1024, sb = b % 1024, swz = sb ^ (((sb >> 9) & 1) << 5); R = (st >> 1) * 16 + swz / 64; C = (st & 1) * 32 + (swz % 64) / 2; }
__host__ __device__ __forceinline__ int perm32(int rho) { const int n = rho >> 4, i = rho & 15; return 8 * (i >> 2) + 4 * n + (i & 3); }

struct Unit { int pm, pn; };
struct Gemm { const bf16_t* A; const bf16_t* Bt; int M, N, K; };

struct StaticOrder {
    int nM, nN, nwg, G, c;
    __host__ __device__ void init(int M, int N, int G_, int c_) { nM = M / BM; nN = N / BM; nwg = nM * nN; G = G_; c = c_; }
    __host__ __device__ bool next(int i, Unit& u) const {
        const long L = (long)i * G + c; if (L >= nwg) return false;
        int wgid = (int)L; { const int q = nwg / NXCD, r = nwg % NXCD, xcd = wgid % NXCD, off = wgid / NXCD; wgid = (xcd < r ? xcd * (q + 1) : r * (q + 1) + (xcd - r) * q) + off; }
        const int nig = WGM * nN, gid = wgid / nig, fm = gid * WGM, gsz = (nM - fm) < WGM ? (nM - fm) : WGM;
        u.pm = fm + ((wgid % nig) % gsz); u.pn = (wgid % nig) / gsz; return true;
    }
    __device__ __forceinline__ void a_ready(const Unit&) const {}
    __device__ __forceinline__ void done(const Unit&) const {}
};

__device__ __forceinline__ unsigned cvt_pk_bf16(float lo, float hi) { unsigned r; asm volatile("v_cvt_pk_bf16_f32 %0, %1, %2" : "=v"(r) : "v"(lo), "v"(hi)); return r; }
typedef float f32x2 __attribute__((ext_vector_type(2)));
typedef __bf16 bf16x2_t __attribute__((ext_vector_type(2)));
__device__ __forceinline__ unsigned pk_bf16(float lo, float hi) { f32x2 v = {lo, hi}; bf16x2_t r = __builtin_convertvector(v, bf16x2_t); return __builtin_bit_cast(unsigned, r); }
template <int ACT  > struct EpiBf16 {
    static constexpr bool PERM = true, AFTER_DRAIN = false;
    bf16_t* O; int ldc;
    __device__ __forceinline__ void operator()(const f32x4 (&acc)[2][2][4][2], const Unit& u, int wr, int wc, int fr, int fq) const {
        const int row0 = u.pm * BM + wr * 64 + fr, col0 = u.pn * BM + wc * 32 + 8 * fq;
#pragma unroll
        for (int ai = 0; ai < 2; ++ai)
#pragma unroll
            for (int m = 0; m < 4; ++m) { bf16_t* rowp = O + (size_t)(row0 + ai * HALF + m * 16) * ldc + col0;
#pragma unroll
                for (int bj = 0; bj < 2; ++bj) { f32x4 v0 = acc[ai][bj][m][0], v1 = acc[ai][bj][m][1];
                    if (ACT == 2) { const f32x4 z = {0.f, 0.f, 0.f, 0.f}; v0 = __builtin_elementwise_max(v0, z); v1 = __builtin_elementwise_max(v1, z); v0 = v0 * v0; v1 = v1 * v1; }
                    u32x4 w; w.x = pk_bf16(v0[0], v0[1]); w.y = pk_bf16(v0[2], v0[3]); w.z = pk_bf16(v1[0], v1[1]); w.w = pk_bf16(v1[2], v1[3]);
                    *(u32x4*)(rowp + bj * HALF) = w; } }
    }
};
struct EpiResF32 {
    static constexpr bool PERM = false, AFTER_DRAIN = true;
    const float* base; float* out; int ldc;
    __device__ __forceinline__ void fused(const f32x4 (&acc)[2][2][4][2], const Unit& u, int wr, int wc, int fr, int fq, PG8_LAS unsigned char*, int, int) const {
        const int col0 = u.pn * BM + wc * 32 + 4 * fq;
#pragma unroll
        for (int ai = 0; ai < 2; ++ai)
#pragma unroll
            for (int m = 0; m < 4; ++m) { const int r = ai * HALF + wr * 64 + m * 16 + fr; const size_t off = (size_t)(u.pm * BM + r) * ldc + col0;
#pragma unroll
                for (int bj = 0; bj < 2; ++bj) { const f32x4 b0 = *(const f32x4*)(base + off + bj * HALF), b1 = *(const f32x4*)(base + off + bj * HALF + 16);
                    *(f32x4*)(out + off + bj * HALF) = b0 + acc[ai][bj][m][0]; *(f32x4*)(out + off + bj * HALF + 16) = b1 + acc[ai][bj][m][1];
                    asm volatile("" ::: "memory"); } }
    }
};
template <class Epi, class Sched, bool ALIGN_EPI = false, bool SP2 = false>
__device__ __forceinline__ void gemm_phase(PG8_LAS unsigned char* lds, const Gemm g, const Sched& S, const Epi& E) {
    const int tid = threadIdx.x, wid = __builtin_amdgcn_readfirstlane(tid >> 6), lane = tid & 63, wr = wid >> 2, wc = wid & 3, fr = lane & 15, fq = lane >> 4;
    const int K = g.K, nt = K / BK;
    unsigned voffA[2], voffB[2];
#pragma unroll
    for (int i = 0; i < 2; ++i) { int R, C; stage_rc(tid * 16 + i * 8192, R, C); const int Rb = Epi::PERM ? ((R & ~31) + perm32(R & 31)) : R;
        voffA[i] = (unsigned)(R * K + C) * 2u; voffB[i] = (unsigned)(Rb * K + C) * 2u; }
    const size_t kstep = (size_t)(BK * 2);
    const size_t hstep = (size_t)HALF * K * 2;
    const size_t tstep = 2 * hstep;
    const unsigned ldsw = (unsigned)wid * 1024u;
    const int aoff = lds_byte(wr * 64 + fr, fq * 8), boff = lds_byte(wc * 32 + fr, fq * 8);
#define PG8_SA(b, h) (((b) * 2 + (h)) * HTB)
#define PG8_SB(b, h) ((4 + (b) * 2 + (h)) * HTB)
#define PG8_STAGE(bufoff, gbase, voff) do { _Pragma("unroll") for (int _i = 0; _i < 2; ++_i) \
        __builtin_amdgcn_global_load_lds((const unsigned*)((const char*)(gbase) + (voff)[_i]), (PG8_LAS unsigned*)(lds + (bufoff) + ldsw + _i * 8192), 16, 0, 0); } while (0)
#define PG8_LDA(dst, b, h) do { _Pragma("unroll") for (int m = 0; m < 4; ++m) _Pragma("unroll") for (int k = 0; k < 2; ++k) dst[m][k] = *(const PG8_LAS bf16x8*)(lds + PG8_SA(b, h) + aoff + m * 2048 + k * 1024); } while (0)
#define PG8_LDB(dst, b, h) do { _Pragma("unroll") for (int n = 0; n < 2; ++n) _Pragma("unroll") for (int k = 0; k < 2; ++k) dst[n][k] = *(const PG8_LAS bf16x8*)(lds + PG8_SB(b, h) + boff + n * 2048 + k * 1024); } while (0)
#define PG8_MMA(ai, bj, At, Bt) do { __builtin_amdgcn_s_setprio(1); _Pragma("unroll") for (int m = 0; m < 4; ++m) _Pragma("unroll") for (int n = 0; n < 2; ++n) _Pragma("unroll") for (int k = 0; k < 2; ++k) \
        acc[ai][bj][m][n] = __builtin_amdgcn_mfma_f32_16x16x32_bf16(Bt[n][k], At[m][k], acc[ai][bj][m][n], 0, 0, 0); __builtin_amdgcn_s_setprio(0); } while (0)
#define PG8_WAIT_V(n) asm volatile("s_waitcnt vmcnt(" #n ")" ::: "memory")
#define PG8_WAIT_L(n) asm volatile("s_waitcnt lgkmcnt(" #n ")" ::: "memory")
#define PG8_BAR __builtin_amdgcn_s_barrier()
#define PG8_SCHED __builtin_amdgcn_sched_barrier(0)
    Unit cur, nxt; int ui = 0;
    if (!S.next(0, cur)) return;
    f32x4 acc[2][2][4][2];
#pragma unroll
    for (int a = 0; a < 2; ++a)
#pragma unroll
        for (int b = 0; b < 2; ++b)
#pragma unroll
            for (int m = 0; m < 4; ++m)
#pragma unroll
                for (int n = 0; n < 2; ++n) acc[a][b][m][n] = (f32x4){0.f, 0.f, 0.f, 0.f};
    bf16x8 At[4][2], B0[2][2], B1[2][2];
    const char* cA = (const char*)g.A + (size_t)cur.pm * tstep; const char* cB = (const char*)g.Bt + (size_t)cur.pn * tstep;
    S.a_ready(cur);
    if constexpr (SP2) {
        PG8_STAGE(PG8_SB(0, 0), cB, voffB); PG8_STAGE(PG8_SB(0, 1), cB + hstep, voffB); PG8_STAGE(PG8_SA(0, 0), cA, voffA); PG8_STAGE(PG8_SA(0, 1), cA + hstep, voffA);
        if (wr == 1) PG8_BAR;
        PG8_WAIT_V(2); PG8_BAR;
        PG8_STAGE(PG8_SB(1, 0), cB + kstep, voffB); PG8_STAGE(PG8_SA(1, 0), cA + kstep, voffA); PG8_STAGE(PG8_SB(1, 1), cB + hstep + kstep, voffB);
        PG8_WAIT_V(6); PG8_BAR;
    } else {
        PG8_STAGE(PG8_SB(0, 0), cB, voffB); PG8_STAGE(PG8_SA(0, 0), cA, voffA); PG8_STAGE(PG8_SB(0, 1), cB + hstep, voffB); PG8_STAGE(PG8_SA(0, 1), cA + hstep, voffA);
        if (wr == 1) PG8_BAR;
        PG8_WAIT_V(4); PG8_BAR;
        PG8_STAGE(PG8_SB(1, 0), cB + kstep, voffB); PG8_STAGE(PG8_SA(1, 0), cA + kstep, voffA); PG8_STAGE(PG8_SB(1, 1), cB + hstep + kstep, voffB);
        PG8_WAIT_V(6); PG8_BAR;
    }
    for (;;) {
        const bool has_next = S.next(ui + 1, nxt);
        const char* nA = has_next ? (const char*)g.A + (size_t)nxt.pm * tstep : cA; const char* nB = has_next ? (const char*)g.Bt + (size_t)nxt.pn * tstep : cB;
        for (int t = 0; t < nt; t += 2) {
            const bool last = (t == nt - 2);
            const char* a1 = cA + (size_t)(t + 1) * kstep;
            const char* a2 = last ? nA : cA + (size_t)(t + 2) * kstep; const char* b2 = last ? nB : cB + (size_t)(t + 2) * kstep;
            const char* a3 = a2 + kstep; const char* b3 = b2 + kstep;
            if (last && has_next) S.a_ready(nxt);
            if constexpr (SP2) {
            PG8_LDB(B0, 0, 0); PG8_LDB(B1, 0, 1); PG8_SCHED; PG8_LDA(At, 0, 0); PG8_STAGE(PG8_SA(1, 1), a1 + hstep, voffA);
            PG8_WAIT_V(8); PG8_WAIT_L(0); PG8_BAR; PG8_MMA(0, 0, At, B0); PG8_MMA(0, 1, At, B1); PG8_BAR; PG8_SCHED;
            PG8_LDA(At, 0, 1); PG8_STAGE(PG8_SB(0, 0), b2, voffB); PG8_STAGE(PG8_SB(0, 1), b2 + hstep, voffB); PG8_STAGE(PG8_SA(0, 0), a2, voffA);
            PG8_WAIT_V(8); PG8_WAIT_L(0); PG8_BAR; PG8_MMA(1, 0, At, B0); PG8_MMA(1, 1, At, B1); PG8_BAR; PG8_SCHED;
            PG8_LDB(B0, 1, 0); PG8_LDB(B1, 1, 1); PG8_SCHED; PG8_LDA(At, 1, 0); PG8_STAGE(PG8_SA(0, 1), a2 + hstep, voffA);
            PG8_WAIT_V(8); PG8_WAIT_L(0); PG8_BAR; PG8_MMA(0, 0, At, B0); PG8_MMA(0, 1, At, B1); PG8_BAR; PG8_SCHED;
            PG8_LDA(At, 1, 1); PG8_STAGE(PG8_SB(1, 0), b3, voffB); PG8_STAGE(PG8_SB(1, 1), b3 + hstep, voffB); PG8_STAGE(PG8_SA(1, 0), a3, voffA);
            PG8_WAIT_V(8); PG8_WAIT_L(0); PG8_BAR; PG8_MMA(1, 0, At, B0); PG8_MMA(1, 1, At, B1); PG8_BAR; PG8_SCHED;
            } else {
            PG8_LDB(B0, 0, 0); PG8_SCHED; PG8_LDA(At, 0, 0); PG8_STAGE(PG8_SA(1, 1), a1 + hstep, voffA);
            PG8_WAIT_L(8); PG8_BAR; PG8_WAIT_L(0); PG8_MMA(0, 0, At, B0); PG8_BAR; PG8_SCHED;
            PG8_LDB(B1, 0, 1); PG8_STAGE(PG8_SB(0, 0), b2, voffB);
            PG8_BAR; PG8_WAIT_L(0); PG8_MMA(0, 1, At, B1); PG8_BAR;
            PG8_LDA(At, 0, 1); PG8_STAGE(PG8_SA(0, 0), a2, voffA);
            PG8_BAR; PG8_WAIT_L(0); PG8_MMA(1, 0, At, B0); PG8_BAR; PG8_SCHED;
            PG8_STAGE(PG8_SB(0, 1), b2 + hstep, voffB);
            PG8_WAIT_V(6); PG8_BAR; PG8_MMA(1, 1, At, B1); PG8_BAR;
            PG8_LDB(B0, 1, 0); PG8_SCHED; PG8_LDA(At, 1, 0); PG8_STAGE(PG8_SA(0, 1), a2 + hstep, voffA);
            PG8_WAIT_L(8); PG8_BAR; PG8_WAIT_L(0); PG8_MMA(0, 0, At, B0); PG8_BAR; PG8_SCHED;
            PG8_LDB(B1, 1, 1); PG8_STAGE(PG8_SB(1, 0), b3, voffB);
            PG8_BAR; PG8_WAIT_L(0); PG8_MMA(0, 1, At, B1); PG8_BAR;
            PG8_LDA(At, 1, 1); PG8_STAGE(PG8_SA(1, 0), a3, voffA);
            PG8_BAR; PG8_WAIT_L(0); PG8_MMA(1, 0, At, B0); PG8_BAR; PG8_SCHED;
            PG8_STAGE(PG8_SB(1, 1), b3 + hstep, voffB);
            PG8_WAIT_V(6); PG8_BAR; PG8_MMA(1, 1, At, B1); PG8_BAR;
            }
        }
        if constexpr (ALIGN_EPI) { if (wr == 0) PG8_BAR; }
        if constexpr (!Epi::AFTER_DRAIN) { E(acc, cur, wr, wc, fr, fq); S.done(cur); }
        if (!has_next) break;
#pragma unroll
        for (int a = 0; a < 2; ++a)
#pragma unroll
            for (int b = 0; b < 2; ++b)
#pragma unroll
                for (int m = 0; m < 4; ++m)
#pragma unroll
                    for (int n = 0; n < 2; ++n) acc[a][b][m][n] = (f32x4){0.f, 0.f, 0.f, 0.f};
        cur = nxt; cA = nA; cB = nB; ++ui;
        if constexpr (ALIGN_EPI) { if (wr == 1) PG8_BAR; }
    }
    PG8_WAIT_V(0);
    if constexpr (!ALIGN_EPI) { if (wr == 0) PG8_BAR; }
    PG8_BAR;
    if constexpr (Epi::AFTER_DRAIN) { E.fused(acc, cur, wr, wc, fr, fq, lds, wid, lane); S.done(cur); }
#undef PG8_SA
#undef PG8_SB
#undef PG8_STAGE
#undef PG8_LDA
#undef PG8_LDB
#undef PG8_MMA
#undef PG8_WAIT_V
#undef PG8_WAIT_L
#undef PG8_BAR
#undef PG8_SCHED
}
}

constexpr int NWAVES = 8, NTHREADS = 512;
#ifndef MK_N_LAUNCHES
#define MK_N_LAUNCHES 1
#endif
constexpr int BATCH = 8, SEQ = 2048, D = 1024, FF = 4096, NH = 4, DK = 128, DV = 256, QKW = 512, VW = 1024;
constexpr int M = BATCH * SEQ, NPROJ = 3072, CH = 64, NCH = SEQ / CH;
constexpr int MLSTM_IN = 3080, GLA_IN = 3088;
constexpr float EPS = 1e-6f, QK_SCALE = 0.08838834764831845f, INV_TAU = 1.0f / 16.0f;

constexpr size_t MiB = 1u << 20;
constexpr size_t WS_CTL = 0, CTL_ZERO_BYTES = 64 * 1024;
constexpr size_t WS_GATES = 1 * MiB;
constexpr size_t WS_GDEC = 2 * MiB;
constexpr size_t WS_WIN = 4 * MiB, WS_WOUT = 10 * MiB, WS_W1 = 12 * MiB, WS_W2 = 20 * MiB;
constexpr size_t WS_AOP = 28 * MiB;
constexpr size_t WS_HUN = 60 * MiB;
constexpr size_t WS_PROJ = 92 * MiB;
constexpr size_t WS_QT = 188 * MiB, WS_KT = 204 * MiB, WS_KH = 220 * MiB;
constexpr size_t WS_HMID = 92 * MiB;
constexpr size_t WS_END = 236 * MiB;
constexpr int CW_BAR = 1024, CW_XID = 8192;

constexpr int RING_BYTES = 131072, LDS_BYTES = 155648, LDSCTL_OFF = LDS_BYTES - 1024, MISC_OFF = LDSCTL_OFF + 320;

#define GAS __attribute__((address_space(1)))
#define LAS __attribute__((address_space(3)))
typedef unsigned short bf16;
typedef unsigned v4u __attribute__((ext_vector_type(4)));
typedef unsigned v2u __attribute__((ext_vector_type(2)));
typedef float f32x4 __attribute__((ext_vector_type(4)));
typedef float f32x16 __attribute__((ext_vector_type(16)));
typedef short bf16x8 __attribute__((ext_vector_type(8)));
typedef short s16x4 __attribute__((ext_vector_type(4)));
typedef GAS unsigned gu32;
#define RLX_AGENT __ATOMIC_RELAXED, __HIP_MEMORY_SCOPE_AGENT
#define LDS_WAIT() asm volatile("s_waitcnt lgkmcnt(0)" ::: "memory")
#define VM_WAIT() asm volatile("s_waitcnt vmcnt(0)" ::: "memory")
using pg8::pk_bf16;
__device__ __forceinline__ float bf2f(unsigned b) { return __uint_as_float(b << 16); }
__device__ __forceinline__ float bflo(unsigned w) { return __uint_as_float(w << 16); }
__device__ __forceinline__ float bfhi(unsigned w) { return __uint_as_float(w & 0xffff0000u); }
__device__ __forceinline__ unsigned short f2bf1(float f) { return (unsigned short)(pk_bf16(f, 0.f) & 0xffffu); }

#define XB_TMO      128
#define XB_XCNT(j)  (256  + 64 * (j))
#define XB_XSUB(j)  (1280 + 64 * (j))
#define XB_XGEN(j)  (2304 + 64 * (j))
#define XB_TOP      3328
#define XB_TOPGEN   3392
#define XCD_BAR_WORDS 3456
#define XB_SPIN_CAP (1u << 18)
__device__ __forceinline__ unsigned xb_ld(unsigned* p)              { return __hip_atomic_load(p, __ATOMIC_RELAXED, __HIP_MEMORY_SCOPE_AGENT); }
__device__ __forceinline__ unsigned xb_add(unsigned* p, unsigned v) { return __hip_atomic_fetch_add(p, v, __ATOMIC_RELAXED, __HIP_MEMORY_SCOPE_AGENT); }
__device__ __forceinline__ unsigned xb_xcc_id() { return (unsigned)__builtin_amdgcn_s_getreg((3 << 11) | 20) & 0xFu; }
#define XB_SPIN(cond, bar) do { unsigned _sp = 0; while (cond) { __builtin_amdgcn_s_sleep(1); \
    if ((++_sp & 255u) == 0u) { if (xb_ld(&(bar)[XB_TMO])) break; if (_sp > XB_SPIN_CAP) { atomicAdd(&(bar)[XB_TMO], 1u); break; } } } } while (0)
struct XcdBarrier { unsigned* bar; unsigned x; volatile LAS unsigned* st; };
__device__ __forceinline__ XcdBarrier xcd_barrier_post(unsigned* bar, volatile LAS unsigned* st) {
    XcdBarrier b; b.bar = bar; b.x = xb_xcc_id(); b.st = st;
    if (threadIdx.x == 0) (void)xb_add(&bar[XB_XCNT(b.x)], 1u);
    return b;
}
__device__ __forceinline__ void xcd_barrier_complete(unsigned* bar, unsigned x, unsigned& nloc, unsigned& nx) {
    const unsigned G = gridDim.x * gridDim.y * gridDim.z;
    unsigned sum, cnt, mine, sp = 0u;
    for (;;) {
        sum = 0u; cnt = 0u; mine = 0u;
#pragma unroll
        for (unsigned j = 0; j < 16; ++j) { const unsigned c = xb_ld(&bar[XB_XCNT(j)]); sum += c; cnt += (c > 0u) ? 1u : 0u; mine = (j == x) ? c : mine; }
        if (sum == G) break;
        __builtin_amdgcn_s_sleep(1);
        if ((++sp & 255u) == 0u) { if (xb_ld(&bar[XB_TMO])) break; if (sp > XB_SPIN_CAP) { atomicAdd(&bar[XB_TMO], 1u); break; } }
    }
    nloc = mine > 0u ? mine : 1u; nx = cnt > 0u ? cnt : 1u;
}
__device__ __forceinline__ void xcd_barrier(const XcdBarrier& b) {
    asm volatile("s_waitcnt vmcnt(0)" ::: "memory");
    __syncthreads();
    if (threadIdx.x == 0) {
        unsigned* bar = b.bar;
        __builtin_amdgcn_s_waitcnt(0);
        unsigned nloc = b.st[0], nx = b.st[1];
        if (nloc == 0u) { xcd_barrier_complete(bar, b.x, nloc, nx); b.st[0] = nloc; b.st[1] = nx; }
        const unsigned old = xb_add(&bar[XB_XSUB(b.x)], 1u);
        const unsigned gen = old / nloc;
        if (old + 1u == (gen + 1u) * nloc) {
            __builtin_amdgcn_fence(__ATOMIC_RELEASE, "agent");
            asm volatile("s_waitcnt vmcnt(0)" ::: "memory");
            const unsigned og = xb_add(&bar[XB_TOP], 1u);
            const unsigned tg = og / nx;
            if (og + 1u == (tg + 1u) * nx) xb_add(&bar[XB_TOPGEN], 1u);
            else XB_SPIN(xb_ld(&bar[XB_TOPGEN]) == tg, bar);
            __builtin_amdgcn_fence(__ATOMIC_ACQUIRE, "agent");
            xb_add(&bar[XB_XGEN(b.x)], 1u);
            asm volatile("s_waitcnt vmcnt(0)" ::: "memory");
        } else {
            XB_SPIN(xb_ld(&bar[XB_XGEN(b.x)]) == gen, bar);
            __builtin_amdgcn_fence(__ATOMIC_ACQUIRE, "agent");
            asm volatile("s_waitcnt vmcnt(0)" ::: "memory");
        }
    }
    __syncthreads();
}

__device__ __forceinline__ float wave_sum(float v) {
#pragma unroll
    for (int o = 1; o < 64; o <<= 1) v += __shfl_xor(v, o);
    return v;
}
__device__ __forceinline__ void transpose_item(const float* W, int K, int N, int ldw, bf16* WT, const float* gain, LAS float* scr, int item, int lane) {
    const int nblk = N / 32, kb = item / nblk, nb = item % nblk, k0 = 64 * kb, n0 = 32 * nb;
    const int n4 = (lane & 7) * 4, krow = lane >> 3;
    f32x4 v[8];
#pragma unroll
    for (int i = 0; i < 8; ++i) v[i] = *(const f32x4*)(W + (size_t)(k0 + 8 * i + krow) * ldw + n0 + n4);
#pragma unroll
    for (int i = 0; i < 8; ++i) *(LAS f32x4*)(scr + (8 * i + krow) * 32 + (n4 ^ (i << 2))) = v[i];
    const int c = lane & 7, nl = lane >> 3;
    f32x4 g0 = {1.f, 1.f, 1.f, 1.f}, g1 = {1.f, 1.f, 1.f, 1.f};
    if (gain) { g0 = *(const f32x4*)(gain + k0 + 8 * c); g1 = *(const f32x4*)(gain + k0 + 8 * c + 4); }
    LDS_WAIT(); asm volatile("" ::: "memory");
#pragma unroll
    for (int j = 0; j < 4; ++j) { const int n = 8 * j + nl; const LAS float* sp = scr + (8 * c) * 32 + (n ^ (c << 2));
        v4u o; o.x = pk_bf16(sp[0 * 32] * g0.x, sp[1 * 32] * g0.y); o.y = pk_bf16(sp[2 * 32] * g0.z, sp[3 * 32] * g0.w); o.z = pk_bf16(sp[4 * 32] * g1.x, sp[5 * 32] * g1.y); o.w = pk_bf16(sp[6 * 32] * g1.z, sp[7 * 32] * g1.w);
        *(GAS v4u*)(WT + (size_t)(n0 + n) * K + k0 + 8 * c) = o; }
    LDS_WAIT(); asm volatile("" ::: "memory");
}
__device__ __forceinline__ void convert_weights(LAS unsigned char* lds, int lane, int wave, int vcu, int G, const float* w_in, int ld_in, const float* w_out, const float* w1, const float* w2, unsigned char* ws) {
    LAS float* scr = (LAS float*)(lds + wave * 16384);
    const int gw = vcu * NWAVES + wave, NGW = G * NWAVES;
    constexpr int I_IN = (D / 64) * (NPROJ / 32), I_O = (D / 64) * (D / 32), I_1 = (D / 64) * (FF / 32), I_2 = (FF / 64) * (D / 32);
    constexpr int NITEMS = I_IN + I_O + I_1 + I_2;
    for (int it = gw; it < NITEMS; it += NGW) {
        int r = it;
        if (r < I_IN) { transpose_item(w_in, D, NPROJ, ld_in, (bf16*)(ws + WS_WIN), nullptr, scr, r, lane); continue; } r -= I_IN;
        if (r < I_O) { transpose_item(w_out, D, D, D, (bf16*)(ws + WS_WOUT), nullptr, scr, r, lane); continue; } r -= I_O;
        if (r < I_1) { transpose_item(w1, D, FF, FF, (bf16*)(ws + WS_W1), nullptr, scr, r, lane); continue; } r -= I_1;
        transpose_item(w2, FF, D, D, (bf16*)(ws + WS_W2), nullptr, scr, r, lane);
    }
}

template <bool GATE, bool OUT_BF16>
__device__ __forceinline__ void norm_rows(LAS unsigned char* lds, int tid, int lane, int wave, int vcu, int G, const float* xin, const float* gain, bf16* aop, float* fout,
                                          const float* wg, int ldw, int ng, float* gates) {
    LAS float* WgT = (LAS float*)lds;
    if (GATE) {
        __syncthreads();
        for (int i = tid; i < 16 * D; i += NTHREADS) { const int k = i >> 4, c = i & 15; WgT[c * D + k] = (c < ng) ? wg[(size_t)k * ldw + c] : 0.f; }
        __syncthreads();
    }
    const int gw = vcu * NWAVES + wave, NGW = G * NWAVES;
    f32x4 gn[4];
#pragma unroll
    for (int j = 0; j < 4; ++j) gn[j] = *(const f32x4*)(gain + 4 * lane + 256 * j);
    for (int m = gw; m < M; m += NGW) {
        const float* xr = xin + (size_t)m * D + 4 * lane;
        f32x4 v[4]; float s = 0.f;
#pragma unroll
        for (int j = 0; j < 4; ++j) { v[j] = *(const f32x4*)(xr + 256 * j); s += (v[j].x * v[j].x + v[j].y * v[j].y) + (v[j].z * v[j].z + v[j].w * v[j].w); }
        const float rstd = 1.0f / sqrtf(wave_sum(s) * (1.f / D) + EPS);
#pragma unroll
        for (int j = 0; j < 4; ++j) v[j] = v[j] * rstd * gn[j];
        if (OUT_BF16) {
#pragma unroll
            for (int j = 0; j < 4; ++j) { v2u o; o.x = pk_bf16(v[j].x, v[j].y); o.y = pk_bf16(v[j].z, v[j].w); *(v2u*)(aop + (size_t)m * D + 4 * lane + 256 * j) = o; }
        } else {
#pragma unroll
            for (int j = 0; j < 4; ++j) *(f32x4*)(fout + (size_t)m * D + 4 * lane + 256 * j) = v[j];
        }
        if (GATE) {
            float a[16];
#pragma unroll
            for (int c = 0; c < 16; ++c) a[c] = 0.f;
#pragma unroll
            for (int c = 0; c < 16; ++c) {
#pragma unroll
                for (int j = 0; j < 4; ++j) { const f32x4 w = *(const LAS f32x4*)(WgT + c * D + 4 * lane + 256 * j); a[c] += (v[j].x * w.x + v[j].y * w.y) + (v[j].z * w.z + v[j].w * w.w); }
                if (c & 1) asm volatile("" ::: "memory"); }
            const bool b5 = lane & 32, b4 = lane & 16, b3 = lane & 8, b2 = lane & 4;
#pragma unroll
            for (int i = 0; i < 8; ++i) { const float keep = b5 ? a[i + 8] : a[i], send = b5 ? a[i] : a[i + 8]; a[i] = keep + __shfl_xor(send, 32); }
#pragma unroll
            for (int i = 0; i < 4; ++i) { const float keep = b4 ? a[i + 4] : a[i], send = b4 ? a[i] : a[i + 4]; a[i] = keep + __shfl_xor(send, 16); }
#pragma unroll
            for (int i = 0; i < 2; ++i) { const float keep = b3 ? a[i + 2] : a[i], send = b3 ? a[i] : a[i + 2]; a[i] = keep + __shfl_xor(send, 8); }
            { const float keep = b2 ? a[1] : a[0], send = b2 ? a[0] : a[1]; a[0] = keep + __shfl_xor(send, 4); }
            a[0] += __shfl_xor(a[0], 2); a[0] += __shfl_xor(a[0], 1);
            const int c = (b5 ? 8 : 0) + (b4 ? 4 : 0) + (b3 ? 2 : 0) + (b2 ? 1 : 0);
            if ((lane & 3) == 0 && c < ng) gates[(size_t)m * 16 + c] = a[0];
        }
    }
}

__device__ __forceinline__ void head_norm_rows(int lane, int wave, int vcu, int G, const bf16* hun, const float* gout, const bf16* proj, bf16* aop, const bool GLA) {
    const int gw = vcu * NWAVES + wave, NGW = G * NWAVES;
    for (int m = gw; m < M; m += NGW) {
#pragma unroll
        for (int j = 0; j < 2; ++j) {
            const int col = 8 * lane + 512 * j;
            const v4u hv = *(const v4u*)(hun + (size_t)m * D + col);
            const v4u rv = *(const v4u*)(proj + (size_t)m * NPROJ + 2048 + col);
            float f[8] = {bflo(hv.x), bfhi(hv.x), bflo(hv.y), bfhi(hv.y), bflo(hv.z), bfhi(hv.z), bflo(hv.w), bfhi(hv.w)};
            const float r[8] = {bflo(rv.x), bfhi(rv.x), bflo(rv.y), bfhi(rv.y), bflo(rv.z), bfhi(rv.z), bflo(rv.w), bfhi(rv.w)};
            float sg[8];
#pragma unroll
            for (int e = 0; e < 8; ++e) sg[e] = __builtin_amdgcn_rcpf(1.0f + __expf(-r[e]));
            if (!GLA) {
#pragma unroll
                for (int e = 0; e < 8; ++e) f[e] *= sg[e];
            }
            float ss = 0.f;
#pragma unroll
            for (int e = 0; e < 8; ++e) ss += f[e] * f[e];
#pragma unroll
            for (int o = 1; o < 32; o <<= 1) ss += __shfl_xor(ss, o);
            const float rs = 1.0f / sqrtf(ss * (1.f / DV) + EPS);
            const f32x4 g0 = *(const f32x4*)(gout + col), g1 = *(const f32x4*)(gout + col + 4);
            const float gg[8] = {g0.x, g0.y, g0.z, g0.w, g1.x, g1.y, g1.z, g1.w};
#pragma unroll
            for (int e = 0; e < 8; ++e) f[e] = f[e] * rs * gg[e];
            if (GLA) {
#pragma unroll
                for (int e = 0; e < 8; ++e) f[e] *= r[e] * sg[e];
            }
            v4u o; o.x = pk_bf16(f[0], f[1]); o.y = pk_bf16(f[2], f[3]); o.z = pk_bf16(f[4], f[5]); o.w = pk_bf16(f[6], f[7]);
            *(v4u*)(aop + (size_t)m * D + col) = o;
        }
    }
}

__device__ __forceinline__ void gla_prep(LAS unsigned char* lds, int tid, int vcu, int G, const bf16* proj, const float* gates, const float* wup, const float* bgate,
                                         bf16* QT, bf16* KT, float* gdec) {
    LAS float* zl = (LAS float*)lds;
    LAS float* tot = (LAS float*)(lds + 4096);
    const int d = tid & 127, rg = tid >> 7;
    for (int unit = vcu; unit < BATCH * NCH * NH; unit += G) {
        const int h = unit & 3, bc = unit >> 2, b = bc / NCH, c = bc % NCH, tok0 = b * SEQ + c * CH;
        float wu[16];
#pragma unroll
        for (int cc = 0; cc < 16; ++cc) wu[cc] = wup[cc * QKW + h * DK + d];
        const float bg = bgate[h * DK + d];
        __syncthreads();
        if (tid < 256) *(LAS f32x4*)(zl + 4 * tid) = *(const f32x4*)(gates + (size_t)tok0 * 16 + 4 * tid);
        __syncthreads();
        float bcum[16]; float run = 0.f;
#pragma unroll
        for (int jj = 0; jj < 16; ++jj) {
            const int j = 16 * rg + jj; float z = bg;
#pragma unroll
            for (int q4 = 0; q4 < 4; ++q4) { const f32x4 zz = *(const LAS f32x4*)(zl + j * 16 + 4 * q4); z += (zz.x * wu[4 * q4] + zz.y * wu[4 * q4 + 1]) + (zz.z * wu[4 * q4 + 2] + zz.w * wu[4 * q4 + 3]); }
            const float la = (fminf(z, 0.f) - __logf(1.0f + __expf(-fabsf(z)))) * INV_TAU;
            run += la; bcum[jj] = run;
        }
        tot[rg * 128 + d] = run;
        __syncthreads();
        float off = 0.f, g = 0.f;
#pragma unroll
        for (int r2 = 0; r2 < 4; ++r2) { const float t = tot[r2 * 128 + d]; g += t; off += (r2 < rg) ? t : 0.f; }
#pragma unroll
        for (int jj = 0; jj < 16; ++jj) {
            const int j = 16 * rg + jj; const float bb = bcum[jj] + off;
            const float q = bf2f(proj[(size_t)(tok0 + j) * NPROJ + h * DK + d]), k = bf2f(proj[(size_t)(tok0 + j) * NPROJ + QKW + h * DK + d]);
            const size_t o = (size_t)(tok0 + j) * QKW + h * DK + d;
            QT[o] = f2bf1(q * QK_SCALE * __expf(bb)); KT[o] = f2bf1(k * __expf(-bb));
        }
        if (rg == 0) gdec[(size_t)unit * DK + d] = __expf(g);
    }
    __syncthreads();
}

#ifndef PROBE_T
#define PROBE_T 0
#endif
#ifndef PROBE_T_MLSTM
#define PROBE_T_MLSTM 0
#endif
#ifndef PROBE_T_WAVE
#define PROBE_T_WAVE 0
#endif
#ifndef PROBE_T_A
#define PROBE_T_A 5
#endif
#ifndef PROBE_T_B
#define PROBE_T_B 0
#endif
constexpr int CW_PROBE = 12288;
__device__ __forceinline__ unsigned long long pt_now() { unsigned long long t; __builtin_amdgcn_sched_barrier(0); asm volatile("s_memrealtime %0\n\ts_waitcnt lgkmcnt(0)" : "=s"(t) :: "memory"); __builtin_amdgcn_sched_barrier(0); return t; }
#define PT_NOW() pt_now()
#define PT_ACC(i, t0) do { if (PROBE_T) { const unsigned long long t1_ = PT_NOW(); pt[i] += (unsigned)(t1_ - (t0)); (t0) = t1_; } } while (0)
constexpr int PS_PITCH = 144, CT_PITCH = 272, CT_BYTES = 32 * CT_PITCH, IMG_PITCH = 272, IMG_BYTES = 64 * IMG_PITCH, NUM_PITCH = 36;
template <bool MLSTM> struct MxMap;
template <> struct MxMap<true>  { static constexpr int QS = 0, KS = 34816, V = 69632, VW = 77824, VWAUX = 81920, PS = 86016, CT = 95232, TB = 112640, TWP = 120832, TPM = 129024, TSC = 137216, DEN = 137728, NUM = 138240, OUTT = 0, GDEC = 0, END = 147456; };
template <> struct MxMap<false> { static constexpr int QS = 0, KS = 34816, V = 69632, VW = 0, VWAUX = 0, PS = 77824, CT = 87040, TB = 0, TWP = 0, TPM = 0, TSC = 0, DEN = 0, NUM = 0, OUTT = 104448, GDEC = 108544, END = 109568; };
#define LDSA(p) ((unsigned)(size_t)(p))
__device__ __forceinline__ bf16x8 mk8(v2u lo, v2u hi) { v4u w; w.x = lo.x; w.y = lo.y; w.z = hi.x; w.w = hi.y; return __builtin_bit_cast(bf16x8, w); }
__device__ __forceinline__ void tr_read2(bf16x8& f0, bf16x8& f1, unsigned a0, unsigned a1, unsigned b0, unsigned b1) {
    v2u l0, h0, l1, h1;
    asm volatile("ds_read_b64_tr_b16 %0, %4\n\tds_read_b64_tr_b16 %1, %5\n\tds_read_b64_tr_b16 %2, %6\n\tds_read_b64_tr_b16 %3, %7\n\ts_waitcnt lgkmcnt(0)"
                 : "=&v"(l0), "=&v"(h0), "=&v"(l1), "=&v"(h1) : "v"(a0), "v"(a1), "v"(b0), "v"(b1) : "memory");
    f0 = mk8(l0, h0); f1 = mk8(l1, h1);
}
__device__ __forceinline__ void tr_read3(bf16x8& f0, bf16x8& f1, bf16x8& f2, unsigned a0, unsigned a1, unsigned b0, unsigned b1, unsigned c0, unsigned c1) {
    v2u l0, h0, l1, h1, l2, h2;
    asm volatile("ds_read_b64_tr_b16 %0, %6\n\tds_read_b64_tr_b16 %1, %7\n\tds_read_b64_tr_b16 %2, %8\n\tds_read_b64_tr_b16 %3, %9\n\tds_read_b64_tr_b16 %4, %10\n\tds_read_b64_tr_b16 %5, %11\n\ts_waitcnt lgkmcnt(0)"
                 : "=&v"(l0), "=&v"(h0), "=&v"(l1), "=&v"(h1), "=&v"(l2), "=&v"(h2) : "v"(a0), "v"(a1), "v"(b0), "v"(b1), "v"(c0), "v"(c1) : "memory");
    f0 = mk8(l0, h0); f1 = mk8(l1, h1); f2 = mk8(l2, h2);
}
__device__ __forceinline__ bf16x8 tr_read1(unsigned a0, unsigned a1) {
    v2u l0, h0;
    asm volatile("ds_read_b64_tr_b16 %0, %2\n\tds_read_b64_tr_b16 %1, %3\n\ts_waitcnt lgkmcnt(0)" : "=&v"(l0), "=&v"(h0) : "v"(a0), "v"(a1) : "memory");
    return mk8(l0, h0);
}
#define MFMA32(a, b, c) __builtin_amdgcn_mfma_f32_32x32x16_bf16((a), (b), (c), 0, 0, 0)
#define MX_BAR() do { asm volatile("s_waitcnt lgkmcnt(0)" ::: "memory"); __builtin_amdgcn_s_barrier(); asm volatile("" ::: "memory"); } while (0)
#define MX_BAR_VM() do { asm volatile("s_waitcnt vmcnt(0) lgkmcnt(0)" ::: "memory"); __builtin_amdgcn_s_barrier(); asm volatile("" ::: "memory"); } while (0)
struct MixArgs { const bf16 *q, *k, *proj; int qpitch; const float *gates, *bgate, *gdec; bf16* hun; void* probe; };
struct MixUnit { const bf16 *Qg, *Kg, *Vg; bf16* Hg; const float* gdec; int qpitch, b, hh; };
constexpr int MX_NPIECE = 38, MX_PPW = 5;
struct MixDma { unsigned voff[MX_PPW]; };

__device__ __forceinline__ void mx_dma_setup(MixDma& dm, int wave, int lane, int qpitch) {
#pragma unroll
    for (int i = 0; i < MX_PPW; ++i) { const int pi = wave + 8 * i; unsigned v = 0;
        if (pi < 34) { const int ob = (pi < 17 ? pi : pi - 17) * 1024 + lane * 16, row = ob / IMG_PITCH; int cb = ob - row * IMG_PITCH; cb = cb < 256 ? cb : 240; v = (unsigned)(row * qpitch * 2 + cb); }
        else { const int ob = (pi - 34) * 1024 + lane * 16, row = ob >> 6, cb = ob & 63; v = (unsigned)(row * NPROJ * 2 + cb); }
        dm.voff[i] = v; }
}
template <bool MLSTM>
__device__ __forceinline__ void mx_dma_issue(LAS unsigned char* lds, const MixDma& dm, const MixUnit& U, int c, int wave, int tid) {
    typedef MxMap<MLSTM> MP;
    const int par = c & 1; const size_t tok0 = (size_t)U.b * SEQ + c * CH;
    const char* qb = (const char*)(U.Qg + tok0 * U.qpitch); const char* kb = (const char*)(U.Kg + tok0 * U.qpitch); const char* vb = (const char*)(U.Vg + tok0 * NPROJ);
#pragma unroll
    for (int i = 0; i < MX_PPW; ++i) { const int pi = wave + 8 * i;
        if (pi < MX_NPIECE) {
            const char* src; int dst;
            if (pi < 17) { src = qb; dst = MP::QS + par * IMG_BYTES + pi * 1024; }
            else if (pi < 34) { src = kb; dst = MP::KS + par * IMG_BYTES + (pi - 17) * 1024; }
            else { src = vb; dst = MP::V + par * 4096 + (pi - 34) * 1024; }
            __builtin_amdgcn_global_load_lds((const unsigned*)(src + dm.voff[i]), (LAS unsigned*)(lds + dst), 16, 0, 0);
        } }
    if (!MLSTM && wave == 7) {
        const float* gd = U.gdec + (size_t)(((U.b * NCH + c) * NH) + U.hh) * DK + (tid & 63);
        __builtin_amdgcn_global_load_lds((const unsigned*)gd, (LAS unsigned*)(lds + MP::GDEC + par * 512), 4, 0, 0);
        __builtin_amdgcn_global_load_lds((const unsigned*)(gd + 64), (LAS unsigned*)(lds + MP::GDEC + par * 512 + 256), 4, 0, 0);
    }
}
__device__ __forceinline__ void mx_store_tile(LAS unsigned char* outt, const f32x16& val, bf16* grow  , int lane, int r, int h5) {
#pragma unroll
    for (int i = 0; i < 16; ++i) *(LAS unsigned short*)(outt + ((i & 3) + 8 * (i >> 2) + 4 * h5) * 64 + r * 2) = f2bf1(val[i]);
#pragma unroll
    for (int i = 0; i < 2; ++i) { const int id = lane + 64 * i, row = id >> 2, pc = id & 3; const v4u w = *(const LAS v4u*)(outt + row * 64 + pc * 16); *(v4u*)(grow + (size_t)row * D + pc * 8) = w; }
}
__device__ __forceinline__ void mx_finalize_mlstm(LAS unsigned char* lds, const MixUnit& U, int cf, int fl) {
    typedef MxMap<true> MP;
    const int j = fl >> 2, sg = fl & 3; const float mc = ((const LAS float*)(lds + MP::TSC))[cf];
    const float dn = ((const LAS float*)(lds + MP::DEN))[j], bb = ((const LAS float*)(lds + MP::TB))[cf * 64 + j], pm = ((const LAS float*)(lds + MP::TPM))[cf * 64 + j];
    const float rden = QK_SCALE * __builtin_amdgcn_rcpf(fmaxf(fabsf(dn) * QK_SCALE, __expf(-bb - fmaxf(mc, pm))));
    const f32x4 n0 = *(const LAS f32x4*)((const LAS float*)(lds + MP::NUM) + j * NUM_PITCH + 8 * sg) * rden, n1 = *(const LAS f32x4*)((const LAS float*)(lds + MP::NUM) + j * NUM_PITCH + 8 * sg + 4) * rden;
    v4u w; w.x = pk_bf16(n0.x, n0.y); w.y = pk_bf16(n0.z, n0.w); w.z = pk_bf16(n1.x, n1.y); w.w = pk_bf16(n1.z, n1.w);
    *(v4u*)(U.Hg + (size_t)(U.b * SEQ + cf * CH + j) * D + 8 * sg) = w;
}

template <bool MLSTM>
__device__ __forceinline__ void mx_step(LAS unsigned char* lds, const MixDma& dm, const MixUnit& U, int c, f32x16& accC0, f32x16& accC1, f32x16& accO, int tid, int lane, int wave, unsigned (&pt)[8]) {
    typedef MxMap<MLSTM> MP;
    unsigned long long tp = PROBE_T ? PT_NOW() : 0ull;
    const int r = lane & 31, h5 = lane >> 5, blk = (lane >> 4) & 1, q4 = (lane & 15) >> 2, p4 = lane & 3, par = c & 1;
    const LAS float* TSC = (const LAS float*)(lds + MP::TSC);
    LAS unsigned char* qimg0 = lds + MP::QS + par * IMG_BYTES; LAS unsigned char* kimg0 = lds + MP::KS + par * IMG_BYTES; LAS unsigned char* vimg0 = lds + MP::V + par * 4096;
    if (c + 1 < NCH) mx_dma_issue<MLSTM>(lds, dm, U, c + 1, wave, tid);
    PT_ACC(6, tp);
    const float mc = MLSTM ? TSC[c] : 0.f;
    if (wave < 4) {
        const int st = wave >> 1, jt = (wave == 1 || wave == 2) ? 1 : 0;
#pragma unroll
        for (int i = 0; i < 16; ++i) accO[i] = 0.f;
        if (wave != 3) {
            LAS unsigned char* kimg = kimg0 + (32 * st + r) * IMG_PITCH + 16 * h5;
            LAS unsigned char* qimg = qimg0 + (32 * jt + r) * IMG_PITCH + 16 * h5;
#pragma unroll
            for (int ks = 0; ks < 8; ++ks) { const bf16x8 a = *(const LAS bf16x8*)(kimg + 32 * ks), bq = *(const LAS bf16x8*)(qimg + 32 * ks); accO = MFMA32(a, bq, accO); }
        }
        const int j = 32 * jt + r; float uj = 0.f;
        if (MLSTM) uj = -fmaxf(mc, ((const LAS float*)(lds + MP::TPM))[c * 64 + j]);
#pragma unroll
        for (int g4 = 0; g4 < 4; ++g4) { const int s0 = 32 * st + 8 * g4 + 4 * h5; f32x4 wps = {0.f, 0.f, 0.f, 0.f}; if (MLSTM) wps = *(const LAS f32x4*)((const LAS float*)(lds + MP::TWP) + c * 64 + s0);
            float v[4];
#pragma unroll
            for (int e = 0; e < 4; ++e) { float x = accO[4 * g4 + e]; if (MLSTM) x *= __expf(uj + wps[e]); v[e] = (s0 + e <= j) ? x : 0.f; }
            v2u o; o.x = pk_bf16(v[0], v[1]); o.y = pk_bf16(v[2], v[3]); *(LAS v2u*)(lds + MP::PS + j * PS_PITCH + s0 * 2) = o; }
    } else {
        const int g = (wave - 4) >> 1, jt = wave & 1;
        if (MLSTM) {
            if (c > 0) mx_finalize_mlstm(lds, U, c - 1, tid - 256);
            { const int fl = tid - 256, row = fl >> 2, pc = fl & 3;
              const float wr_ = __expf(((const LAS float*)(lds + MP::TWP))[c * 64 + row] - TSC[32 + c]); const v4u pv = *(const LAS v4u*)(vimg0 + row * 64 + pc * 16); v4u o;
              o.x = pk_bf16(bflo(pv.x) * wr_, bfhi(pv.x) * wr_); o.y = pk_bf16(bflo(pv.y) * wr_, bfhi(pv.y) * wr_); o.z = pk_bf16(bflo(pv.z) * wr_, bfhi(pv.z) * wr_); o.w = pk_bf16(bflo(pv.w) * wr_, bfhi(pv.w) * wr_);
              *(LAS v4u*)(lds + MP::VW + row * 64 + pc * 16) = o;
              if (pc == 0) *(LAS unsigned short*)(lds + MP::VWAUX + row * 64) = f2bf1(wr_); }
        }
        if (MLSTM || g == 0) {
#pragma unroll
            for (int i = 0; i < 16; ++i) accO[i] = 0.f;
#pragma unroll
            for (int ks = 0; ks < 8; ++ks) { const bf16x8 a = *(const LAS bf16x8*)(qimg0 + (32 * jt + r) * IMG_PITCH + 16 * h5 + 32 * ks), bc = *(const LAS bf16x8*)(lds + MP::CT + g * CT_BYTES + r * CT_PITCH + 32 * ks + 16 * h5); accO = MFMA32(a, bc, accO); }
            if (MLSTM) {
#pragma unroll
                for (int g4 = 0; g4 < 4; ++g4) { const f32x4 pm = *(const LAS f32x4*)((const LAS float*)(lds + MP::TPM) + c * 64 + 32 * jt + 8 * g4 + 4 * h5);
#pragma unroll
                    for (int e = 0; e < 4; ++e) accO[4 * g4 + e] *= __expf(mc - fmaxf(mc, pm[e])); }
            }
        }
    }
    PT_ACC(2, tp);
    MX_BAR();
    PT_ACC(3, tp);
    if (wave < 4) {
        if (MLSTM) { const float decay = __expf(mc - TSC[32 + c]); accC0 = accC0 * decay; accC1 = accC1 * decay; }
        LAS unsigned char* kimg = kimg0 + (8 * h5 + q4) * IMG_PITCH + 64 * wave + 32 * blk + 8 * p4;
        LAS unsigned char* vimg = (MLSTM ? lds + MP::VW : vimg0) + (8 * h5 + q4) * 64 + 32 * blk + 8 * p4;
        LAS unsigned char* vaux = lds + MP::VWAUX + (8 * h5 + q4) * 64 + 32 * blk + 8 * p4;
#pragma unroll
        for (int ks = 0; ks < 4; ++ks) {
            bf16x8 a, b0, b1;
            if (MLSTM) tr_read3(a, b0, b1, LDSA(kimg + 16 * ks * IMG_PITCH), LDSA(kimg + (16 * ks + 4) * IMG_PITCH), LDSA(vimg + 16 * ks * 64), LDSA(vimg + (16 * ks + 4) * 64), LDSA(vaux + 16 * ks * 64), LDSA(vaux + (16 * ks + 4) * 64));
            else tr_read2(a, b0, LDSA(kimg + 16 * ks * IMG_PITCH), LDSA(kimg + (16 * ks + 4) * IMG_PITCH), LDSA(vimg + 16 * ks * 64), LDSA(vimg + (16 * ks + 4) * 64));
            __builtin_amdgcn_sched_barrier(0);
            accC0 = MFMA32(a, b0, accC0);
            if (MLSTM) accC1 = MFMA32(a, b1, accC1);
        }
        if (!MLSTM) {
#pragma unroll
            for (int g4 = 0; g4 < 4; ++g4) { const f32x4 dc = *(const LAS f32x4*)((const LAS float*)(lds + MP::GDEC) + par * 128 + 32 * wave + 8 * g4 + 4 * h5);
#pragma unroll
                for (int e = 0; e < 4; ++e) accC0[4 * g4 + e] *= dc[e]; }
        }
#pragma unroll
        for (int g4 = 0; g4 < 4; ++g4) { const int d0 = 32 * wave + 8 * g4 + 4 * h5;
            v2u o; o.x = pk_bf16(accC0[4 * g4], accC0[4 * g4 + 1]); o.y = pk_bf16(accC0[4 * g4 + 2], accC0[4 * g4 + 3]); *(LAS v2u*)(lds + MP::CT + r * CT_PITCH + d0 * 2) = o;
            if (MLSTM) { v2u o1; o1.x = pk_bf16(accC1[4 * g4], accC1[4 * g4 + 1]); o1.y = pk_bf16(accC1[4 * g4 + 2], accC1[4 * g4 + 3]); *(LAS v2u*)(lds + MP::CT + CT_BYTES + r * CT_PITCH + d0 * 2) = o1; } }
    } else {
        const int g = (wave - 4) >> 1, jt = wave & 1;
        if (MLSTM || g == 0) {
            const bf16x8 ones = (r == 0) ? (bf16x8){0x3F80, 0x3F80, 0x3F80, 0x3F80, 0x3F80, 0x3F80, 0x3F80, 0x3F80} : (bf16x8){0, 0, 0, 0, 0, 0, 0, 0};
            LAS unsigned char* vimg = vimg0 + (8 * h5 + q4) * 64 + 32 * blk + 8 * p4;
#pragma unroll
            for (int ks = 0; ks < 4; ++ks) {
                const bf16x8 a = *(const LAS bf16x8*)(lds + MP::PS + (32 * jt + r) * PS_PITCH + 32 * ks + 16 * h5);
                if (g == 0) { const bf16x8 bv = tr_read1(LDSA(vimg + 16 * ks * 64), LDSA(vimg + (16 * ks + 4) * 64)); __builtin_amdgcn_sched_barrier(0); accO = MFMA32(a, bv, accO); }
                else accO = MFMA32(a, ones, accO); }
            if (MLSTM && g == 0) {
#pragma unroll
                for (int i = 0; i < 16; ++i) ((LAS float*)(lds + MP::NUM))[(32 * jt + (i & 3) + 8 * (i >> 2) + 4 * h5) * NUM_PITCH + r] = accO[i];
            }
            if (MLSTM && g == 1 && r == 0) {
#pragma unroll
                for (int i = 0; i < 16; ++i) ((LAS float*)(lds + MP::DEN))[32 * jt + (i & 3) + 8 * (i >> 2) + 4 * h5] = accO[i];
            }
            if (!MLSTM) mx_store_tile(lds + MP::OUTT + jt * 2048, accO, U.Hg + (size_t)(U.b * SEQ + c * CH + 32 * jt) * D, lane, r, h5);
        }
    }
    PT_ACC(4, tp);
    MX_BAR_VM();
    PT_ACC(5, tp);
}

template <bool MLSTM>
__device__ __forceinline__ void mixer_phase(LAS unsigned char* lds, int tid, int lane, int wave, int vcu, int G, const MixArgs A) {
    typedef MxMap<MLSTM> MP;
    MixDma dm; mx_dma_setup(dm, wave, lane, A.qpitch);
    unsigned pt[8] = {0u, 0u, 0u, 0u, 0u, 0u, 0u, 0u}; unsigned long long tph = PROBE_T ? PT_NOW() : 0ull; unsigned long long tin = tph;
    for (int unit = vcu; unit < BATCH * NH * 8; unit += G) {
        const int slice = unit & 7, bh = unit >> 3;
        MixUnit U; U.b = bh >> 2; U.hh = bh & 3; U.qpitch = A.qpitch; U.gdec = A.gdec;
        U.Qg = A.q + U.hh * DK; U.Kg = A.k + U.hh * DK; U.Vg = A.proj + 1024 + U.hh * DV + 32 * slice; U.Hg = A.hun + U.hh * DV + 32 * slice;
        MX_BAR_VM();
        mx_dma_issue<MLSTM>(lds, dm, U, 0, wave, tid);
        for (int i = tid; i < 2 * CT_BYTES / 4; i += NTHREADS) ((LAS unsigned*)(lds + MP::CT))[i] = 0u;
        if (MLSTM) {
            for (int i = tid; i < 1024; i += NTHREADS) ((LAS unsigned*)(lds + MP::VWAUX))[i] = 0u;
            LAS float* TB = (LAS float*)(lds + MP::TB); LAS float* TWP = (LAS float*)(lds + MP::TWP); LAS float* TPM = (LAS float*)(lds + MP::TPM); LAS float* TSC = (LAS float*)(lds + MP::TSC);
            const float bgi = A.bgate[U.hh], bgf = A.bgate[4 + U.hh];
            float gi4[4], gf4[4];
#pragma unroll
            for (int cc = 0; cc < 4; ++cc) { const size_t tok = (size_t)U.b * SEQ + (wave + 8 * cc) * CH + lane; gi4[cc] = A.gates[tok * 16 + U.hh] + bgi; gf4[cc] = A.gates[tok * 16 + 4 + U.hh] + bgf; }
#pragma unroll
            for (int cc = 0; cc < 4; ++cc) { const int c = wave + 8 * cc;
                const float lf = fminf(gf4[cc], 0.f) - __logf(1.0f + __expf(-fabsf(gf4[cc])));
                float bsum = lf;
#pragma unroll
                for (int o = 1; o < 64; o <<= 1) { const float t = __shfl_up(bsum, o); if (lane >= o) bsum += t; }
                const float wp = gi4[cc] - bsum; float pm = wp;
#pragma unroll
                for (int o = 1; o < 64; o <<= 1) { const float t = __shfl_up(pm, o); if (lane >= o) pm = fmaxf(pm, t); }
                TB[c * 64 + lane] = bsum; TWP[c * 64 + lane] = wp; TPM[c * 64 + lane] = pm;
                if (lane == 63) { TSC[64 + c] = bsum; TSC[96 + c] = pm; } }
            MX_BAR();
            if (wave == 0) {
                const float gl = TSC[64 + (lane & 31)], pl = TSC[96 + (lane & 31)]; float m = 0.f, myM = 0.f, myX = 0.f;
#pragma clang loop unroll(disable)
                for (int c = 0; c < NCH; ++c) { const float gc = __uint_as_float(__builtin_amdgcn_readlane(__float_as_uint(gl), c)), pc = __uint_as_float(__builtin_amdgcn_readlane(__float_as_uint(pl), c));
                    const float mxe = fmaxf(m, pc); if (lane == c) { myM = m; myX = mxe; } m = gc + mxe; }
                if (lane < 32) { TSC[lane] = myM; TSC[32 + lane] = myX; }
            }
        }
        f32x16 accC0, accC1, accO;
#pragma unroll
        for (int i = 0; i < 16; ++i) { accC0[i] = 0.f; accC1[i] = 0.f; accO[i] = 0.f; }
        MX_BAR_VM();
        PT_ACC(1, tin);
#pragma clang loop unroll(disable)
        for (int c = 0; c < NCH; ++c) mx_step<MLSTM>(lds, dm, U, c, accC0, accC1, accO, tid, lane, wave, pt);
        if (MLSTM && wave >= 4) mx_finalize_mlstm(lds, U, NCH - 1, tid - 256);
    }
    MX_BAR_VM();
    if (PROBE_T && (PROBE_T_MLSTM != 0) == MLSTM && vcu == 0 && wave == PROBE_T_WAVE && lane == 0) { PT_ACC(0, tph); unsigned* pw = (unsigned*)A.probe; pw[0] = pt[PROBE_T_A]; pw[1] = pt[PROBE_T_B]; }
}

constexpr int N_PHASES = 19;
struct Args { const float* in[15]; float* out; unsigned char* ws; int ph_lo, ph_hi; };
template <int PH>
__device__ __forceinline__ void run_phase(const Args& args, LAS unsigned char* lds, int tid, int lane, int wave, int vcu, int G, int bx) {
    unsigned char* ws = args.ws; float* out = args.out;
    constexpr int layer = (PH >= 9 && PH < 18) ? 1 : 0, k = (PH == 18) ? 9 : PH - 9 * layer;
    bf16* AOP = (bf16*)(ws + WS_AOP); bf16* PROJ = (bf16*)(ws + WS_PROJ); bf16* HUN = (bf16*)(ws + WS_HUN); bf16* HMID = (bf16*)(ws + WS_HMID);
    float* GATES = (float*)(ws + WS_GATES);
    if constexpr (k == 0) {
        const float* w_in = args.in[layer ? 8 : 4]; const int ld_in = layer ? GLA_IN : MLSTM_IN;
        convert_weights(lds, lane, wave, vcu, G, w_in, ld_in, args.in[layer ? 12 : 7], args.in[13] + (size_t)layer * D * FF, args.in[14] + (size_t)layer * D * FF, ws);
        norm_rows<true, true>(lds, tid, lane, wave, vcu, G, layer ? out : args.in[0], args.in[1] + layer * D, AOP, nullptr, w_in + NPROJ, ld_in, layer ? 16 : 8, GATES);
    } else if constexpr (k == 1) {
        pg8::Gemm g{AOP, (const bf16*)(ws + WS_WIN), M, NPROJ, D}; pg8::StaticOrder S; S.init(M, NPROJ, G, bx);
        pg8::EpiBf16<0> E{PROJ, NPROJ};
        pg8::gemm_phase<pg8::EpiBf16<0>, pg8::StaticOrder, true, true>(lds, g, S, E);
    } else if constexpr (k == 2) {
        if (layer) gla_prep(lds, tid, vcu, G, PROJ, GATES, args.in[9], args.in[10], (bf16*)(ws + WS_QT), (bf16*)(ws + WS_KT), (float*)(ws + WS_GDEC));
    } else if constexpr (k == 3) {
        if (layer == 0) { const MixArgs A{PROJ, PROJ + QKW, PROJ, NPROJ, GATES, args.in[5], nullptr, HUN, ws + WS_CTL + 4 * CW_PROBE}; mixer_phase<true>(lds, tid, lane, wave, vcu, G, A); }
        else { const MixArgs A{(const bf16*)(ws + WS_QT), (const bf16*)(ws + WS_KT), PROJ, QKW, nullptr, nullptr, (const float*)(ws + WS_GDEC), HUN, ws + WS_CTL + 4 * CW_PROBE}; mixer_phase<false>(lds, tid, lane, wave, vcu, G, A); }
    } else if constexpr (k == 4) {
        head_norm_rows(lane, wave, vcu, G, HUN, args.in[layer ? 11 : 6], PROJ, AOP, layer != 0);
    } else if constexpr (k == 5) {
        pg8::Gemm g{AOP, (const bf16*)(ws + WS_WOUT), M, D, D}; pg8::StaticOrder S; S.init(M, D, G, bx);
        pg8::EpiResF32 E{layer ? out : args.in[0], out, D};
        pg8::gemm_phase<pg8::EpiResF32, pg8::StaticOrder, false, true>(lds, g, S, E);
    } else if constexpr (k == 6) {
        norm_rows<false, true>(lds, tid, lane, wave, vcu, G, out, args.in[2] + layer * D, AOP, nullptr, nullptr, 0, 0, nullptr);
    } else if constexpr (k == 7) {
        pg8::Gemm g{AOP, (const bf16*)(ws + WS_W1), M, FF, D}; pg8::StaticOrder S; S.init(M, FF, G, bx);
        pg8::EpiBf16<2> E{HMID, FF};
        pg8::gemm_phase<pg8::EpiBf16<2>, pg8::StaticOrder, true, true>(lds, g, S, E);
    } else if constexpr (k == 8) {
        pg8::Gemm g{HMID, (const bf16*)(ws + WS_W2), M, D, FF}; pg8::StaticOrder S; S.init(M, D, G, bx);
        pg8::EpiResF32 E{out, out, D};
        pg8::gemm_phase<pg8::EpiResF32, pg8::StaticOrder, false, true>(lds, g, S, E);
    } else {
        norm_rows<false, false>(lds, tid, lane, wave, vcu, G, out, args.in[3], nullptr, out, nullptr, 0, 0, nullptr);
    }
}
__global__ void __launch_bounds__(NTHREADS, 2) fwd_kernel(Args args) {
    extern __shared__ __attribute__((aligned(16))) unsigned char lds_raw[];
    LAS unsigned char* lds = (LAS unsigned char*)lds_raw;
    volatile LAS unsigned* MISC = (volatile LAS unsigned*)(lds + MISC_OFF);
    const int tid = threadIdx.x, lane = tid & 63, wave = __builtin_amdgcn_readfirstlane(tid >> 6);
    const int G = gridDim.x; int bx = blockIdx.x; int vcu = (G % 8 == 0) ? (bx % 8) * (G / 8) + bx / 8 : bx;
    for (int u = tid; u < (LDS_BYTES - LDSCTL_OFF) / 4; u += NTHREADS) ((LAS unsigned*)(lds + LDSCTL_OFF))[u] = 0u;
    __syncthreads();
    const int lo = args.ph_lo, hi = args.ph_hi;
    XcdBarrier bar; bar.bar = (unsigned*)(args.ws + WS_CTL) + CW_BAR; bar.x = 0; bar.st = nullptr;
    if (hi - lo > 1) { bar = xcd_barrier_post((unsigned*)(args.ws + WS_CTL) + CW_BAR, MISC + 8);
        if (tid == 0) { const unsigned xcc = xb_xcc_id(); MISC[16] = xcc; MISC[17] = xb_add((unsigned*)(args.ws + WS_CTL) + CW_XID + 64 * xcc, 1u); } }
#ifndef PROBE_PH
#define PROBE_PH (-1)
#endif
#ifndef PROBE_N
#define PROBE_N 0
#endif
#define PHASE(p) if (lo <= (p) && (p) < hi) { run_phase<p>(args, lds, tid, lane, wave, vcu, G, bx); \
        if ((p) == PROBE_PH) { for (int rep_ = 0; rep_ < PROBE_N; ++rep_) { xcd_barrier(bar); if (PROBE_PH >= 0) run_phase<((p) == PROBE_PH ? (p) : 2)>(args, lds, tid, lane, wave, vcu, G, bx); } } \
        if ((p) + 1 < hi && (p) != 2) xcd_barrier(bar); }
    PHASE(0)
    if (lo == 0 && hi > 1) {
        bool ok = (G == 256);
#pragma unroll
        for (unsigned j = 0; j < 16; ++j) { const unsigned cnt = xb_ld(&bar.bar[XB_XCNT(j)]); ok = ok && (cnt == (j < 8 ? 32u : 0u)); }
        const unsigned xcc = MISC[16], idx = MISC[17];
        if (ok && xcc < 8 && idx < 32) { vcu = (int)(xcc * 32 + idx); bx = (int)(idx * 8 + xcc); }
    }
    PHASE(1) PHASE(2) PHASE(3) PHASE(4) PHASE(5) PHASE(6) PHASE(7) PHASE(8) PHASE(9) PHASE(10) PHASE(11) PHASE(12) PHASE(13) PHASE(14) PHASE(15) PHASE(16) PHASE(17) PHASE(18)
#undef PHASE
    if (PROBE_T && hi == N_PHASES && vcu == 0 && tid == 0) {
        const unsigned a = xb_ld((unsigned*)(args.ws + WS_CTL) + CW_PROBE), b = xb_ld((unsigned*)(args.ws + WS_CTL) + CW_PROBE + 1);
        const unsigned long long ticks = (unsigned long long)a * 5ull + (unsigned long long)(b / 50u) * 50000ull;
        const unsigned long long t0 = PT_NOW(); while (PT_NOW() - t0 < ticks) __builtin_amdgcn_s_sleep(8);
    }
}

extern "C" void kernel_launch(void* const* d_in, const int* in_sizes, int n_in, void* d_out, int out_size, void* d_ws, size_t ws_size, hipStream_t stream) {
    static int grid = 0;
    if (grid == 0) {
        if (n_in != 15 || in_sizes[0] != M * D || out_size != M * D || ws_size < WS_END) { fprintf(stderr, "kernel_launch: unexpected shapes (n_in %d, in0 %d, out %d, ws %zu); nothing launched\n", n_in, n_in > 0 ? in_sizes[0] : -1, out_size, ws_size); grid = -1; return; }
        int dev = 0, cus = 0, per_cu = 0;
        if (hipGetDevice(&dev) != hipSuccess || hipDeviceGetAttribute(&cus, hipDeviceAttributeMultiprocessorCount, dev) != hipSuccess) { grid = -1; return; }
        if (hipFuncSetAttribute((const void*)fwd_kernel, hipFuncAttributeMaxDynamicSharedMemorySize, LDS_BYTES) != hipSuccess) { fprintf(stderr, "kernel_launch: hipFuncSetAttribute failed\n"); grid = -1; return; }
        if (hipOccupancyMaxActiveBlocksPerMultiprocessor(&per_cu, (const void*)fwd_kernel, NTHREADS, LDS_BYTES) != hipSuccess || per_cu < 1) { fprintf(stderr, "kernel_launch: occupancy query says %d blocks per CU\n", per_cu); (void)hipGetLastError(); grid = -1; return; }
        grid = cus;
    }
    if (grid < 0) return;
    (void)hipMemsetAsync((char*)d_ws + WS_CTL, 0, CTL_ZERO_BYTES, stream);
    Args a{};
    for (int i = 0; i < 15; ++i) a.in[i] = (const float*)d_in[i];
    a.out = (float*)d_out; a.ws = (unsigned char*)d_ws;
    if (MK_N_LAUNCHES == 1) {
        a.ph_lo = 0; a.ph_hi = N_PHASES;
        void* kargs[] = {&a};
        const hipError_t e = hipLaunchCooperativeKernel((const void*)fwd_kernel, dim3(grid), dim3(NTHREADS), kargs, LDS_BYTES, stream);
        if (e != hipSuccess) fprintf(stderr, "kernel_launch: cooperative launch failed: %s (grid %d)\n", hipGetErrorString(e), grid);
    } else {
        for (int p = 0; p < N_PHASES; ++p) { a.ph_lo = p; a.ph_hi = p + 1; hipLaunchKernelGGL(fwd_kernel, dim3(grid), dim3(NTHREADS), LDS_BYTES, stream, a); }
    }
}
```

```cpp
#include <hip/hip_runtime.h>
#include <cstdio>
#include <cstdint>
namespace pg8 {
#define PG8_LAS __attribute__((address_space(3)))
typedef unsigned short bf16_t;
typedef short bf16x8 __attribute__((ext_vector_type(8)));
typedef float f32x4 __attribute__((ext_vector_type(4)));
typedef unsigned u32x4 __attribute__((ext_vector_type(4)));
constexpr int BM = 256, BK = 64, HALF = 128, HTB = HALF * BK * 2  , STAGE_BYTES = 8 * HTB, NXCD = 8, WGM = 8;

__host__ __device__ __forceinline__ int lds_byte(int r, int c) { const int st = (r >> 4) * 2 + (c >> 5), rr = r & 15, cc = c & 31, ob = rr * 64 + cc * 2; return st * 1024 + (ob ^ (((ob >> 9) & 1) << 5)); }
__host__ __device__ __forceinline__ void stage_rc(int b, int& R, int& C) { const int st = b / 1024, sb = b % 1024, swz = sb ^ (((sb >> 9) & 1) << 5); R = (st >> 1) * 16 + swz / 64; C = (st & 1) * 32 + (swz % 64) / 2; }
__host__ __device__ __forceinline__ int perm32(int rho) { const int n = rho >> 4, i = rho & 15; return 8 * (i >> 2) + 4 * n + (i & 3); }

struct Unit { int pm, pn; };
struct Gemm { const bf16_t* A; const bf16_t* Bt; int M, N, K; };

struct StaticOrder {
    int nM, nN, nwg, G, c;
    __host__ __device__ void init(int M, int N, int G_, int c_) { nM = M / BM; nN = N / BM; nwg = nM * nN; G = G_; c = c_; }
    __host__ __device__ bool next(int i, Unit& u) const {
        const long L = (long)i * G + c; if (L >= nwg) return false;
        int wgid = (int)L; { const int q = nwg / NXCD, r = nwg % NXCD, xcd = wgid % NXCD, off = wgid / NXCD; wgid = (xcd < r ? xcd * (q + 1) : r * (q + 1) + (xcd - r) * q) + off; }
        const int nig = WGM * nN, gid = wgid / nig, fm = gid * WGM, gsz = (nM - fm) < WGM ? (nM - fm) : WGM;
        u.pm = fm + ((wgid % nig) % gsz); u.pn = (wgid % nig) / gsz; return true;
    }
    __device__ __forceinline__ void a_ready(const Unit&) const {}
    __device__ __forceinline__ void done(const Unit&) const {}
};

__device__ __forceinline__ unsigned cvt_pk_bf16(float lo, float hi) { unsigned r; asm volatile("v_cvt_pk_bf16_f32 %0, %1, %2" : "=v"(r) : "v"(lo), "v"(hi)); return r; }
typedef float f32x2 __attribute__((ext_vector_type(2)));
typedef __bf16 bf16x2_t __attribute__((ext_vector_type(2)));
__device__ __forceinline__ unsigned pk_bf16(float lo, float hi) { f32x2 v = {lo, hi}; bf16x2_t r = __builtin_convertvector(v, bf16x2_t); return __builtin_bit_cast(unsigned, r); }
template <int ACT  > struct EpiBf16 {
    static constexpr bool PERM = true, AFTER_DRAIN = false;
    bf16_t* O; int ldc;
    __device__ __forceinline__ void operator()(const f32x4 (&acc)[2][2][4][2], const Unit& u, int wr, int wc, int fr, int fq) const {
        const int row0 = u.pm * BM + wr * 64 + fr, col0 = u.pn * BM + wc * 32 + 8 * fq;
#pragma unroll
        for (int ai = 0; ai < 2; ++ai)
#pragma unroll
            for (int m = 0; m < 4; ++m) { bf16_t* rowp = O + (size_t)(row0 + ai * HALF + m * 16) * ldc + col0;
#pragma unroll
                for (int bj = 0; bj < 2; ++bj) { f32x4 v0 = acc[ai][bj][m][0], v1 = acc[ai][bj][m][1];
                    if (ACT == 2) { const f32x4 z = {0.f, 0.f, 0.f, 0.f}; v0 = __builtin_elementwise_max(v0, z); v1 = __builtin_elementwise_max(v1, z); v0 = v0 * v0; v1 = v1 * v1; }
                    u32x4 w; w.x = pk_bf16(v0[0], v0[1]); w.y = pk_bf16(v0[2], v0[3]); w.z = pk_bf16(v1[0], v1[1]); w.w = pk_bf16(v1[2], v1[3]);
                    *(u32x4*)(rowp + bj * HALF) = w; } }
    }
};
struct EpiResF32 {
    static constexpr bool PERM = false, AFTER_DRAIN = true;
    const float* base; float* out; int ldc;
    __device__ __forceinline__ void fused(const f32x4 (&acc)[2][2][4][2], const Unit& u, int wr, int wc, int fr, int fq, PG8_LAS unsigned char*, int, int) const {
        const int col0 = u.pn * BM + wc * 32 + 4 * fq;
#pragma unroll
        for (int ai = 0; ai < 2; ++ai)
#pragma unroll
            for (int m = 0; m < 4; ++m) { const int r = ai * HALF + wr * 64 + m * 16 + fr; const size_t off = (size_t)(u.pm * BM + r) * ldc + col0;
#pragma unroll
                for (int bj = 0; bj < 2; ++bj) { const f32x4 b0 = *(const f32x4*)(base + off + bj * HALF), b1 = *(const f32x4*)(base + off + bj * HALF + 16);
                    *(f32x4*)(out + off + bj * HALF) = b0 + acc[ai][bj][m][0]; *(f32x4*)(out + off + bj * HALF + 16) = b1 + acc[ai][bj][m][1];
                    asm volatile("" ::: "memory"); } }
    }
};
typedef unsigned u32x2 __attribute__((ext_vector_type(2)));
__device__ __forceinline__ float bf_lo(unsigned w) { return __builtin_bit_cast(float, w << 16); }
__device__ __forceinline__ float bf_hi(unsigned w) { return __builtin_bit_cast(float, w & 0xffff0000u); }
template <int ACT  > struct EpiBf16S {
    static constexpr bool PERM = true, AFTER_DRAIN = false;
    bf16_t* O; int ldc; const PG8_LAS float* rt; int pm1, pm2, pm3;
    __device__ __forceinline__ void operator()(const f32x4 (&acc)[2][2][4][2], const Unit& u, int wr, int wc, int fr, int fq) const {
        const int col0 = u.pn * BM + wc * 32 + 8 * fq;
        const PG8_LAS float* rtp = rt + ((u.pm == pm1) ? 256 : (u.pm == pm2) ? 512 : (u.pm == pm3) ? 768 : 0) + wr * 64 + fr;
#pragma unroll
        for (int ai = 0; ai < 2; ++ai)
#pragma unroll
            for (int m = 0; m < 4; ++m) { const float rs = rtp[ai * HALF + m * 16];
                bf16_t* rowp = O + (size_t)(u.pm * BM + ai * HALF + wr * 64 + m * 16 + fr) * ldc + col0;
#pragma unroll
                for (int bj = 0; bj < 2; ++bj) { f32x4 v0 = acc[ai][bj][m][0] * rs, v1 = acc[ai][bj][m][1] * rs;
                    if (ACT == 2) { const f32x4 z = {0.f, 0.f, 0.f, 0.f}; v0 = __builtin_elementwise_max(v0, z); v1 = __builtin_elementwise_max(v1, z); v0 = v0 * v0; v1 = v1 * v1; }
                    u32x4 w; w.x = pk_bf16(v0[0], v0[1]); w.y = pk_bf16(v0[2], v0[3]); w.z = pk_bf16(v1[0], v1[1]); w.w = pk_bf16(v1[2], v1[3]);
                    *(u32x4*)(rowp + bj * HALF) = w; } }
    }
};
struct EpiResBf16Sq {
    static constexpr bool PERM = false, AFTER_DRAIN = true;
    bf16_t* xres; float* sumsq; int ldc;
    __device__ __forceinline__ void fused(f32x4 (&acc)[2][2][4][2], const Unit& u, int wr, int wc, int fr, int fq, PG8_LAS unsigned char* lds, int wid, int lane) const {
        PG8_LAS float* P = (PG8_LAS float*)lds;
        const int col0 = u.pn * BM + wc * 32 + 4 * fq;
#pragma unroll
        for (int ai = 0; ai < 2; ++ai)
#pragma unroll
            for (int m = 0; m < 4; ++m) { const int r = ai * HALF + wr * 64 + m * 16 + fr; bf16_t* xp = xres + (size_t)(u.pm * BM + r) * ldc + col0; float ss = 0.f;
#pragma unroll
                for (int bj = 0; bj < 2; ++bj)
#pragma unroll
                    for (int n = 0; n < 2; ++n) { const u32x2 xb = *(const u32x2*)(xp + bj * HALF + n * 16); const f32x4 a = acc[ai][bj][m][n];
                        u32x2 w; w.x = pk_bf16(bf_lo(xb.x) + a[0], bf_hi(xb.x) + a[1]); w.y = pk_bf16(bf_lo(xb.y) + a[2], bf_hi(xb.y) + a[3]);
                        *(u32x2*)(xp + bj * HALF + n * 16) = w;
                        const float y0 = bf_lo(w.x), y1 = bf_hi(w.x), y2 = bf_lo(w.y), y3 = bf_hi(w.y); ss += (y0 * y0 + y1 * y1) + (y2 * y2 + y3 * y3); }
                ss += __shfl_xor(ss, 16); ss += __shfl_xor(ss, 32);
                if (fq == 0) P[r * 4 + wc] = ss;
                asm volatile("" ::: "memory"); }
        asm volatile("s_waitcnt lgkmcnt(0)" ::: "memory"); __builtin_amdgcn_s_barrier(); asm volatile("" ::: "memory");
        const int t = wid * 64 + lane;
        if (t < 256) { const f32x4 p = *(const PG8_LAS f32x4*)(P + t * 4); sumsq[(size_t)(u.pm * BM + t) * 4 + u.pn] = (p[0] + p[1]) + (p[2] + p[3]); }
    }
};
template <class Epi, class Sched, bool ALIGN_EPI = false, bool SP2 = false>
__device__ __forceinline__ void gemm_phase(PG8_LAS unsigned char* lds, const Gemm g, const Sched& S, const Epi& E) {
    const int tid = threadIdx.x, wid = __builtin_amdgcn_readfirstlane(tid >> 6), lane = tid & 63, wr = wid >> 2, wc = wid & 3, fr = lane & 15, fq = lane >> 4;
    const int K = g.K, nt = K / BK;
    unsigned voffA[2], voffB[2];
#pragma unroll
    for (int i = 0; i < 2; ++i) { int R, C; stage_rc(tid * 16 + i * 8192, R, C); const int Rb = Epi::PERM ? ((R & ~31) + perm32(R & 31)) : R;
        voffA[i] = (unsigned)(R * K + C) * 2u; voffB[i] = (unsigned)(Rb * K + C) * 2u; }
    const size_t kstep = (size_t)(BK * 2);
    const size_t hstep = (size_t)HALF * K * 2;
    const size_t tstep = 2 * hstep;
    const unsigned ldsw = (unsigned)wid * 1024u;
    const int aoff = lds_byte(wr * 64 + fr, fq * 8), boff = lds_byte(wc * 32 + fr, fq * 8);
#define PG8_SA(b, h) (((b) * 2 + (h)) * HTB)
#define PG8_SB(b, h) ((4 + (b) * 2 + (h)) * HTB)
#define PG8_STAGE(bufoff, gbase, voff) do { _Pragma("unroll") for (int _i = 0; _i < 2; ++_i) \
        __builtin_amdgcn_global_load_lds((const unsigned*)((const char*)(gbase) + (voff)[_i]), (PG8_LAS unsigned*)(lds + (bufoff) + ldsw + _i * 8192), 16, 0, 0); } while (0)
#define PG8_LDA(dst, b, h) do { _Pragma("unroll") for (int m = 0; m < 4; ++m) _Pragma("unroll") for (int k = 0; k < 2; ++k) dst[m][k] = *(const PG8_LAS bf16x8*)(lds + PG8_SA(b, h) + aoff + m * 2048 + k * 1024); } while (0)
#define PG8_LDB(dst, b, h) do { _Pragma("unroll") for (int n = 0; n < 2; ++n) _Pragma("unroll") for (int k = 0; k < 2; ++k) dst[n][k] = *(const PG8_LAS bf16x8*)(lds + PG8_SB(b, h) + boff + n * 2048 + k * 1024); } while (0)
#define PG8_MMA(ai, bj, At, Bt) do { __builtin_amdgcn_s_setprio(1); _Pragma("unroll") for (int m = 0; m < 4; ++m) _Pragma("unroll") for (int n = 0; n < 2; ++n) _Pragma("unroll") for (int k = 0; k < 2; ++k) \
        acc[ai][bj][m][n] = __builtin_amdgcn_mfma_f32_16x16x32_bf16(Bt[n][k], At[m][k], acc[ai][bj][m][n], 0, 0, 0); __builtin_amdgcn_s_setprio(0); } while (0)
#define PG8_WAIT_V(n) asm volatile("s_waitcnt vmcnt(" #n ")" ::: "memory")
#define PG8_WAIT_L(n) asm volatile("s_waitcnt lgkmcnt(" #n ")" ::: "memory")
#define PG8_BAR __builtin_amdgcn_s_barrier()
#define PG8_SCHED __builtin_amdgcn_sched_barrier(0)
    Unit cur, nxt; int ui = 0;
    if (!S.next(0, cur)) return;
    f32x4 acc[2][2][4][2];
#pragma unroll
    for (int a = 0; a < 2; ++a)
#pragma unroll
        for (int b = 0; b < 2; ++b)
#pragma unroll
            for (int m = 0; m < 4; ++m)
#pragma unroll
                for (int n = 0; n < 2; ++n) acc[a][b][m][n] = (f32x4){0.f, 0.f, 0.f, 0.f};
    bf16x8 At[4][2], B0[2][2], B1[2][2];
    const char* cA = (const char*)g.A + (size_t)cur.pm * tstep; const char* cB = (const char*)g.Bt + (size_t)cur.pn * tstep;
    S.a_ready(cur);
    if constexpr (SP2) {
        PG8_STAGE(PG8_SB(0, 0), cB, voffB); PG8_STAGE(PG8_SB(0, 1), cB + hstep, voffB); PG8_STAGE(PG8_SA(0, 0), cA, voffA); PG8_STAGE(PG8_SA(0, 1), cA + hstep, voffA);
        if (wr == 1) PG8_BAR;
        PG8_WAIT_V(2); PG8_BAR;
        PG8_STAGE(PG8_SB(1, 0), cB + kstep, voffB); PG8_STAGE(PG8_SA(1, 0), cA + kstep, voffA); PG8_STAGE(PG8_SB(1, 1), cB + hstep + kstep, voffB);
        PG8_WAIT_V(6); PG8_BAR;
    } else {
        PG8_STAGE(PG8_SB(0, 0), cB, voffB); PG8_STAGE(PG8_SA(0, 0), cA, voffA); PG8_STAGE(PG8_SB(0, 1), cB + hstep, voffB); PG8_STAGE(PG8_SA(0, 1), cA + hstep, voffA);
        if (wr == 1) PG8_BAR;
        PG8_WAIT_V(4); PG8_BAR;
        PG8_STAGE(PG8_SB(1, 0), cB + kstep, voffB); PG8_STAGE(PG8_SA(1, 0), cA + kstep, voffA); PG8_STAGE(PG8_SB(1, 1), cB + hstep + kstep, voffB);
        PG8_WAIT_V(6); PG8_BAR;
    }
    for (;;) {
        const bool has_next = S.next(ui + 1, nxt);
        const char* nA = has_next ? (const char*)g.A + (size_t)nxt.pm * tstep : cA; const char* nB = has_next ? (const char*)g.Bt + (size_t)nxt.pn * tstep : cB;
        for (int t = 0; t < nt; t += 2) {
            const bool last = (t == nt - 2);
            const char* a1 = cA + (size_t)(t + 1) * kstep;
            const char* a2 = last ? nA : cA + (size_t)(t + 2) * kstep; const char* b2 = last ? nB : cB + (size_t)(t + 2) * kstep;
            const char* a3 = a2 + kstep; const char* b3 = b2 + kstep;
            if (last && has_next) S.a_ready(nxt);
            if constexpr (SP2) {
            PG8_LDB(B0, 0, 0); PG8_LDB(B1, 0, 1); PG8_SCHED; PG8_LDA(At, 0, 0); PG8_STAGE(PG8_SA(1, 1), a1 + hstep, voffA);
            PG8_WAIT_V(8); PG8_WAIT_L(0); PG8_BAR; PG8_MMA(0, 0, At, B0); PG8_MMA(0, 1, At, B1); PG8_BAR; PG8_SCHED;
            PG8_LDA(At, 0, 1); PG8_STAGE(PG8_SB(0, 0), b2, voffB); PG8_STAGE(PG8_SB(0, 1), b2 + hstep, voffB); PG8_STAGE(PG8_SA(0, 0), a2, voffA);
            PG8_WAIT_V(8); PG8_WAIT_L(0); PG8_BAR; PG8_MMA(1, 0, At, B0); PG8_MMA(1, 1, At, B1); PG8_BAR; PG8_SCHED;
            PG8_LDB(B0, 1, 0); PG8_LDB(B1, 1, 1); PG8_SCHED; PG8_LDA(At, 1, 0); PG8_STAGE(PG8_SA(0, 1), a2 + hstep, voffA);
            PG8_WAIT_V(8); PG8_WAIT_L(0); PG8_BAR; PG8_MMA(0, 0, At, B0); PG8_MMA(0, 1, At, B1); PG8_BAR; PG8_SCHED;
            PG8_LDA(At, 1, 1); PG8_STAGE(PG8_SB(1, 0), b3, voffB); PG8_STAGE(PG8_SB(1, 1), b3 + hstep, voffB); PG8_STAGE(PG8_SA(1, 0), a3, voffA);
            PG8_WAIT_V(8); PG8_WAIT_L(0); PG8_BAR; PG8_MMA(1, 0, At, B0); PG8_MMA(1, 1, At, B1); PG8_BAR; PG8_SCHED;
            } else {
            PG8_LDB(B0, 0, 0); PG8_SCHED; PG8_LDA(At, 0, 0); PG8_STAGE(PG8_SA(1, 1), a1 + hstep, voffA);
            PG8_WAIT_L(8); PG8_BAR; PG8_WAIT_L(0); PG8_MMA(0, 0, At, B0); PG8_BAR; PG8_SCHED;
            PG8_LDB(B1, 0, 1); PG8_STAGE(PG8_SB(0, 0), b2, voffB);
            PG8_BAR; PG8_WAIT_L(0); PG8_MMA(0, 1, At, B1); PG8_BAR;
            PG8_LDA(At, 0, 1); PG8_STAGE(PG8_SA(0, 0), a2, voffA);
            PG8_BAR; PG8_WAIT_L(0); PG8_MMA(1, 0, At, B0); PG8_BAR; PG8_SCHED;
            PG8_STAGE(PG8_SB(0, 1), b2 + hstep, voffB);
            PG8_WAIT_V(6); PG8_BAR; PG8_MMA(1, 1, At, B1); PG8_BAR;
            PG8_LDB(B0, 1, 0); PG8_SCHED; PG8_LDA(At, 1, 0); PG8_STAGE(PG8_SA(0, 1), a2 + hstep, voffA);
            PG8_WAIT_L(8); PG8_BAR; PG8_WAIT_L(0); PG8_MMA(0, 0, At, B0); PG8_BAR; PG8_SCHED;
            PG8_LDB(B1, 1, 1); PG8_STAGE(PG8_SB(1, 0), b3, voffB);
            PG8_BAR; PG8_WAIT_L(0); PG8_MMA(0, 1, At, B1); PG8_BAR;
            PG8_LDA(At, 1, 1); PG8_STAGE(PG8_SA(1, 0), a3, voffA);
            PG8_BAR; PG8_WAIT_L(0); PG8_MMA(1, 0, At, B0); PG8_BAR; PG8_SCHED;
            PG8_STAGE(PG8_SB(1, 1), b3 + hstep, voffB);
            PG8_WAIT_V(6); PG8_BAR; PG8_MMA(1, 1, At, B1); PG8_BAR;
            }
        }
        if constexpr (ALIGN_EPI) { if (wr == 0) PG8_BAR; }
        if constexpr (!Epi::AFTER_DRAIN) { E(acc, cur, wr, wc, fr, fq); S.done(cur); }
        if (!has_next) break;
#pragma unroll
        for (int a = 0; a < 2; ++a)
#pragma unroll
            for (int b = 0; b < 2; ++b)
#pragma unroll
                for (int m = 0; m < 4; ++m)
#pragma unroll
                    for (int n = 0; n < 2; ++n) acc[a][b][m][n] = (f32x4){0.f, 0.f, 0.f, 0.f};
        cur = nxt; cA = nA; cB = nB; ++ui;
        if constexpr (ALIGN_EPI) { if (wr == 1) PG8_BAR; }
    }
    PG8_WAIT_V(0);
    if constexpr (!ALIGN_EPI) { if (wr == 0) PG8_BAR; }
    PG8_BAR;
    if constexpr (Epi::AFTER_DRAIN) { E.fused(acc, cur, wr, wc, fr, fq, lds, wid, lane); S.done(cur); }
#undef PG8_SA
#undef PG8_SB
#undef PG8_STAGE
#undef PG8_LDA
#undef PG8_LDB
#undef PG8_MMA
#undef PG8_WAIT_V
#undef PG8_WAIT_L
#undef PG8_BAR
#undef PG8_SCHED
}
}

constexpr int NWAVES = 8, NTHREADS = 512;
#ifndef MK_N_LAUNCHES
#define MK_N_LAUNCHES 1
#endif
constexpr int BATCH = 8, SEQ = 2048, D = 1024, FF = 4096, NH = 4, DK = 128, DV = 256, QKW = 512, VW = 1024;
constexpr int M = BATCH * SEQ, NPROJ = 3072, CH = 64, NCH = SEQ / CH;
constexpr int MLSTM_IN = 3080, GLA_IN = 3088;
constexpr float EPS = 1e-6f, QK_SCALE = 0.08838834764831845f, INV_TAU = 1.0f / 16.0f;

constexpr size_t MiB = 1u << 20;
constexpr size_t WS_CTL = 0, CTL_ZERO_BYTES = 64 * 1024;
constexpr size_t WS_GATES = 1 * MiB;
constexpr size_t WS_GDEC = 2 * MiB;
constexpr size_t WS_SUMSQ = 2 * MiB + 512 * 1024;
constexpr size_t WS_WIN = 4 * MiB, WS_WOUT = 10 * MiB, WS_W1 = 12 * MiB, WS_W2 = 20 * MiB, WS_WLAYER = 56 * MiB;
constexpr size_t WS_AOP = 28 * MiB;
constexpr size_t WS_PROJ = 92 * MiB;
constexpr size_t WS_QT = 188 * MiB, WS_KT = 204 * MiB;
constexpr size_t WS_HMID = 92 * MiB;
constexpr size_t WS_XRES = 220 * MiB;
constexpr size_t WS_END = 252 * MiB;
constexpr int CW_BAR = 1024, CW_XID = 8192;

constexpr int RING_BYTES = 131072, LDS_BYTES = 155648, LDSCTL_OFF = LDS_BYTES - 1024, MISC_OFF = LDSCTL_OFF + 320;

#define GAS __attribute__((address_space(1)))
#define LAS __attribute__((address_space(3)))
typedef unsigned short bf16;
typedef unsigned v4u __attribute__((ext_vector_type(4)));
typedef unsigned v2u __attribute__((ext_vector_type(2)));
typedef float f32x4 __attribute__((ext_vector_type(4)));
typedef float f32x16 __attribute__((ext_vector_type(16)));
typedef short bf16x8 __attribute__((ext_vector_type(8)));
typedef short s16x4 __attribute__((ext_vector_type(4)));
typedef GAS unsigned gu32;
#define RLX_AGENT __ATOMIC_RELAXED, __HIP_MEMORY_SCOPE_AGENT
#define LDS_WAIT() asm volatile("s_waitcnt lgkmcnt(0)" ::: "memory")
#define VM_WAIT() asm volatile("s_waitcnt vmcnt(0)" ::: "memory")
using pg8::pk_bf16;
__device__ __forceinline__ float bf2f(unsigned b) { return __uint_as_float(b << 16); }
__device__ __forceinline__ float bflo(unsigned w) { return __uint_as_float(w << 16); }
__device__ __forceinline__ float bfhi(unsigned w) { return __uint_as_float(w & 0xffff0000u); }
__device__ __forceinline__ unsigned short f2bf1(float f) { return (unsigned short)(pk_bf16(f, 0.f) & 0xffffu); }

struct Args { const float* in[15]; float* out; unsigned char* ws; int ph_lo, ph_hi; };
#define XB_TMO      128
#define XB_XCNT(j)  (256  + 64 * (j))
#define XB_XSUB(j)  (1280 + 64 * (j))
#define XB_XGEN(j)  (2304 + 64 * (j))
#define XB_TOP      3328
#define XB_TOPGEN   3392
#define XCD_BAR_WORDS 3456
#define XB_SPIN_CAP (1u << 18)
__device__ __forceinline__ unsigned xb_ld(unsigned* p)              { return __hip_atomic_load(p, __ATOMIC_RELAXED, __HIP_MEMORY_SCOPE_AGENT); }
__device__ __forceinline__ unsigned xb_add(unsigned* p, unsigned v) { return __hip_atomic_fetch_add(p, v, __ATOMIC_RELAXED, __HIP_MEMORY_SCOPE_AGENT); }
__device__ __forceinline__ unsigned xb_xcc_id() { return (unsigned)__builtin_amdgcn_s_getreg((3 << 11) | 20) & 0xFu; }
#define XB_SPIN(cond, bar) do { unsigned _sp = 0; while (cond) { __builtin_amdgcn_s_sleep(1); \
    if ((++_sp & 255u) == 0u) { if (xb_ld(&(bar)[XB_TMO])) break; if (_sp > XB_SPIN_CAP) { atomicAdd(&(bar)[XB_TMO], 1u); break; } } } } while (0)
struct XcdBarrier { unsigned* bar; unsigned x; volatile LAS unsigned* st; };
__device__ __forceinline__ XcdBarrier xcd_barrier_post(unsigned* bar, volatile LAS unsigned* st) {
    XcdBarrier b; b.bar = bar; b.x = xb_xcc_id(); b.st = st;
    if (threadIdx.x == 0) (void)xb_add(&bar[XB_XCNT(b.x)], 1u);
    return b;
}
__device__ __forceinline__ void xcd_barrier_complete(unsigned* bar, unsigned x, unsigned& nloc, unsigned& nx) {
    const unsigned G = gridDim.x * gridDim.y * gridDim.z;
    unsigned sum, cnt, mine, sp = 0u;
    for (;;) {
        sum = 0u; cnt = 0u; mine = 0u;
#pragma unroll
        for (unsigned j = 0; j < 16; ++j) { const unsigned c = xb_ld(&bar[XB_XCNT(j)]); sum += c; cnt += (c > 0u) ? 1u : 0u; mine = (j == x) ? c : mine; }
        if (sum == G) break;
        __builtin_amdgcn_s_sleep(1);
        if ((++sp & 255u) == 0u) { if (xb_ld(&bar[XB_TMO])) break; if (sp > XB_SPIN_CAP) { atomicAdd(&bar[XB_TMO], 1u); break; } }
    }
    nloc = mine > 0u ? mine : 1u; nx = cnt > 0u ? cnt : 1u;
}
__device__ __forceinline__ void xcd_barrier(const XcdBarrier& b) {
    asm volatile("s_waitcnt vmcnt(0)" ::: "memory");
    __syncthreads();
    if (threadIdx.x == 0) {
        unsigned* bar = b.bar;
        __builtin_amdgcn_s_waitcnt(0);
        unsigned nloc = b.st[0], nx = b.st[1];
        if (nloc == 0u) { xcd_barrier_complete(bar, b.x, nloc, nx); b.st[0] = nloc; b.st[1] = nx; }
        const unsigned old = xb_add(&bar[XB_XSUB(b.x)], 1u);
        const unsigned gen = old / nloc;
        if (old + 1u == (gen + 1u) * nloc) {
            __builtin_amdgcn_fence(__ATOMIC_RELEASE, "agent");
            asm volatile("s_waitcnt vmcnt(0)" ::: "memory");
            const unsigned og = xb_add(&bar[XB_TOP], 1u);
            const unsigned tg = og / nx;
            if (og + 1u == (tg + 1u) * nx) xb_add(&bar[XB_TOPGEN], 1u);
            else XB_SPIN(xb_ld(&bar[XB_TOPGEN]) == tg, bar);
            __builtin_amdgcn_fence(__ATOMIC_ACQUIRE, "agent");
            xb_add(&bar[XB_XGEN(b.x)], 1u);
            asm volatile("s_waitcnt vmcnt(0)" ::: "memory");
        } else {
            XB_SPIN(xb_ld(&bar[XB_XGEN(b.x)]) == gen, bar);
            __builtin_amdgcn_fence(__ATOMIC_ACQUIRE, "agent");
            asm volatile("s_waitcnt vmcnt(0)" ::: "memory");
        }
    }
    __syncthreads();
}

__device__ __forceinline__ float wave_sum(float v) {
#pragma unroll
    for (int o = 1; o < 64; o <<= 1) v += __shfl_xor(v, o);
    return v;
}
__device__ __forceinline__ void transpose_item(const float* W, int K, int N, int ldw, bf16* WT, const float* gain, LAS float* scr, int item, int lane) {
    const int nblk = N / 32, kb = item / nblk, nb = item % nblk, k0 = 64 * kb, n0 = 32 * nb;
    const int n4 = (lane & 7) * 4, krow = lane >> 3;
    f32x4 v[8];
#pragma unroll
    for (int i = 0; i < 8; ++i) v[i] = *(const f32x4*)(W + (size_t)(k0 + 8 * i + krow) * ldw + n0 + n4);
#pragma unroll
    for (int i = 0; i < 8; ++i) *(LAS f32x4*)(scr + (8 * i + krow) * 32 + (n4 ^ (i << 2))) = v[i];
    const int c = lane & 7, nl = lane >> 3;
    f32x4 g0 = {1.f, 1.f, 1.f, 1.f}, g1 = {1.f, 1.f, 1.f, 1.f};
    if (gain) { g0 = *(const f32x4*)(gain + k0 + 8 * c); g1 = *(const f32x4*)(gain + k0 + 8 * c + 4); }
    LDS_WAIT(); asm volatile("" ::: "memory");
#pragma unroll
    for (int j = 0; j < 4; ++j) { const int n = 8 * j + nl; const LAS float* sp = scr + (8 * c) * 32 + (n ^ (c << 2));
        v4u o; o.x = pk_bf16(sp[0 * 32] * g0.x, sp[1 * 32] * g0.y); o.y = pk_bf16(sp[2 * 32] * g0.z, sp[3 * 32] * g0.w); o.z = pk_bf16(sp[4 * 32] * g1.x, sp[5 * 32] * g1.y); o.w = pk_bf16(sp[6 * 32] * g1.z, sp[7 * 32] * g1.w);
        *(GAS v4u*)(WT + (size_t)(n0 + n) * K + k0 + 8 * c) = o; }
    LDS_WAIT(); asm volatile("" ::: "memory");
}
__device__ __forceinline__ void convert_weights(LAS unsigned char* lds, int lane, int wave, int vcu, int G, const Args& args, unsigned char* ws) {
    LAS float* scr = (LAS float*)(lds + wave * 16384);
    const int gw = vcu * NWAVES + wave, NGW = G * NWAVES;
    constexpr int I_IN = (D / 64) * (NPROJ / 32), I_O = (D / 64) * (D / 32), I_1 = (D / 64) * (FF / 32), I_2 = (FF / 64) * (D / 32);
    constexpr int NITEMS = I_IN + I_O + I_1 + I_2;
    for (int it = gw; it < 2 * NITEMS; it += NGW) {
        const int layer = it >= NITEMS; int r = it - layer * NITEMS;
        unsigned char* wl = ws + (size_t)layer * WS_WLAYER;
        if (r < I_IN) { transpose_item(args.in[layer ? 8 : 4], D, NPROJ, layer ? GLA_IN : MLSTM_IN, (bf16*)(wl + WS_WIN), args.in[1] + layer * D, scr, r, lane); continue; } r -= I_IN;
        if (r < I_O) { transpose_item(args.in[layer ? 12 : 7], D, D, D, (bf16*)(wl + WS_WOUT), nullptr, scr, r, lane); continue; } r -= I_O;
        if (r < I_1) { transpose_item(args.in[13] + (size_t)layer * D * FF, D, FF, FF, (bf16*)(wl + WS_W1), args.in[2] + layer * D, scr, r, lane); continue; } r -= I_1;
        transpose_item(args.in[14] + (size_t)layer * D * FF, FF, D, D, (bf16*)(wl + WS_W2), nullptr, scr, r, lane);
    }
}

__device__ __forceinline__ void rows_first(LAS unsigned char* lds, int tid, int lane, int wave, int vcu, int G, const float* xin, const float* gain, bf16* xres, float* sumsq,
                                           const float* wg, int ldw, int ng, float* gates) {
    LAS float* WgT = (LAS float*)lds;
    __syncthreads();
    for (int i = tid; i < 16 * D; i += NTHREADS) { const int k = i >> 4, c = i & 15; WgT[c * D + k] = (c < ng) ? wg[(size_t)k * ldw + c] : 0.f; }
    __syncthreads();
    const int gw = vcu * NWAVES + wave, NGW = G * NWAVES;
    f32x4 gn[4];
#pragma unroll
    for (int j = 0; j < 4; ++j) gn[j] = *(const f32x4*)(gain + 4 * lane + 256 * j);
    for (int m = gw; m < M; m += NGW) {
        const float* xr = xin + (size_t)m * D + 4 * lane;
        f32x4 v[4]; float s = 0.f;
#pragma unroll
        for (int j = 0; j < 4; ++j) { v[j] = *(const f32x4*)(xr + 256 * j); s += (v[j].x * v[j].x + v[j].y * v[j].y) + (v[j].z * v[j].z + v[j].w * v[j].w); }
#pragma unroll
        for (int j = 0; j < 4; ++j) { v2u o; o.x = pk_bf16(v[j].x, v[j].y); o.y = pk_bf16(v[j].z, v[j].w); *(v2u*)(xres + (size_t)m * D + 4 * lane + 256 * j) = o; }
        const float ssum = wave_sum(s);
        if (lane == 0) *(f32x4*)(sumsq + (size_t)m * 4) = (f32x4){ssum, 0.f, 0.f, 0.f};
        const float rstd = 1.0f / sqrtf(ssum * (1.f / D) + EPS);
#pragma unroll
        for (int j = 0; j < 4; ++j) v[j] = v[j] * rstd * gn[j];
        float a[16];
#pragma unroll
        for (int c = 0; c < 16; ++c) a[c] = 0.f;
#pragma unroll
        for (int c = 0; c < 16; ++c) {
#pragma unroll
            for (int j = 0; j < 4; ++j) { const f32x4 w = *(const LAS f32x4*)(WgT + c * D + 4 * lane + 256 * j); a[c] += (v[j].x * w.x + v[j].y * w.y) + (v[j].z * w.z + v[j].w * w.w); }
            if (c & 1) asm volatile("" ::: "memory"); }
        const bool b5 = lane & 32, b4 = lane & 16, b3 = lane & 8, b2 = lane & 4;
#pragma unroll
        for (int i = 0; i < 8; ++i) { const float keep = b5 ? a[i + 8] : a[i], send = b5 ? a[i] : a[i + 8]; a[i] = keep + __shfl_xor(send, 32); }
#pragma unroll
        for (int i = 0; i < 4; ++i) { const float keep = b4 ? a[i + 4] : a[i], send = b4 ? a[i] : a[i + 4]; a[i] = keep + __shfl_xor(send, 16); }
#pragma unroll
        for (int i = 0; i < 2; ++i) { const float keep = b3 ? a[i + 2] : a[i], send = b3 ? a[i] : a[i + 2]; a[i] = keep + __shfl_xor(send, 8); }
        { const float keep = b2 ? a[1] : a[0], send = b2 ? a[0] : a[1]; a[0] = keep + __shfl_xor(send, 4); }
        a[0] += __shfl_xor(a[0], 2); a[0] += __shfl_xor(a[0], 1);
        const int c = (b5 ? 8 : 0) + (b4 ? 4 : 0) + (b3 ? 2 : 0) + (b2 ? 1 : 0);
        if ((lane & 3) == 0 && c < ng) gates[(size_t)m * 16 + c] = a[0];
    }
}
__device__ __forceinline__ void rows_final(int lane, int wave, int vcu, int G, const bf16* xres, const float* gain, float* out) {
    const int gw = vcu * NWAVES + wave, NGW = G * NWAVES;
    for (int m = gw; m < M; m += NGW) {
        float f[2][8]; float ss = 0.f;
#pragma unroll
        for (int j = 0; j < 2; ++j) { const v4u hv = *(const v4u*)(xres + (size_t)m * D + 8 * lane + 512 * j);
            f[j][0] = bflo(hv.x); f[j][1] = bfhi(hv.x); f[j][2] = bflo(hv.y); f[j][3] = bfhi(hv.y); f[j][4] = bflo(hv.z); f[j][5] = bfhi(hv.z); f[j][6] = bflo(hv.w); f[j][7] = bfhi(hv.w);
#pragma unroll
            for (int e = 0; e < 8; ++e) ss += f[j][e] * f[j][e]; }
        const float rstd = 1.0f / sqrtf(wave_sum(ss) * (1.f / D) + EPS);
#pragma unroll
        for (int j = 0; j < 2; ++j) { const int col = 8 * lane + 512 * j; const f32x4 g0 = *(const f32x4*)(gain + col), g1 = *(const f32x4*)(gain + col + 4);
            *(f32x4*)(out + (size_t)m * D + col) = (f32x4){f[j][0] * rstd * g0.x, f[j][1] * rstd * g0.y, f[j][2] * rstd * g0.z, f[j][3] * rstd * g0.w};
            *(f32x4*)(out + (size_t)m * D + col + 4) = (f32x4){f[j][4] * rstd * g1.x, f[j][5] * rstd * g1.y, f[j][6] * rstd * g1.z, f[j][7] * rstd * g1.w}; }
    }
}
struct RstdSlots { int pm0, pm1, pm2, pm3; };
__device__ __forceinline__ RstdSlots rstd_table(LAS float* rt, const float* sumsq, const pg8::StaticOrder& S, int tid) {
    int pmv[4] = {-1, -1, -1, -1}; int ns = 0;
    pg8::Unit u;
    for (int i = 0; S.next(i, u); ++i) { if (u.pm != pmv[0] && u.pm != pmv[1] && u.pm != pmv[2] && u.pm != pmv[3] && ns < 4) { if (ns == 0) pmv[0] = u.pm; else if (ns == 1) pmv[1] = u.pm; else if (ns == 2) pmv[2] = u.pm; else pmv[3] = u.pm; ++ns; } }
#pragma unroll
    for (int sl = 0; sl < 4; ++sl) { const int pm = sl == 0 ? pmv[0] : sl == 1 ? pmv[1] : sl == 2 ? pmv[2] : pmv[3];
        if (pm >= 0 && tid < 256) { const f32x4 s4 = *(const f32x4*)(sumsq + (size_t)(pm * 256 + tid) * 4); rt[sl * 256 + tid] = 1.0f / sqrtf(((s4.x + s4.y) + (s4.z + s4.w)) * (1.f / D) + EPS); } }
    __syncthreads();
    return RstdSlots{pmv[0], pmv[1], pmv[2], pmv[3]};
}

__device__ __forceinline__ void head_norm_rows(int lane, int wave, int vcu, int G, const bf16* hun, const float* gout, const bf16* proj, bf16* aop, const bool GLA) {
    const int gw = vcu * NWAVES + wave, NGW = G * NWAVES;
    for (int m = gw; m < M; m += NGW) {
#pragma unroll
        for (int j = 0; j < 2; ++j) {
            const int col = 8 * lane + 512 * j;
            const v4u hv = *(const v4u*)(hun + (size_t)m * D + col);
            const v4u rv = *(const v4u*)(proj + (size_t)m * NPROJ + 2048 + col);
            float f[8] = {bflo(hv.x), bfhi(hv.x), bflo(hv.y), bfhi(hv.y), bflo(hv.z), bfhi(hv.z), bflo(hv.w), bfhi(hv.w)};
            const float r[8] = {bflo(rv.x), bfhi(rv.x), bflo(rv.y), bfhi(rv.y), bflo(rv.z), bfhi(rv.z), bflo(rv.w), bfhi(rv.w)};
            float sg[8];
#pragma unroll
            for (int e = 0; e < 8; ++e) sg[e] = __builtin_amdgcn_rcpf(1.0f + __expf(-r[e]));
            if (!GLA) {
#pragma unroll
                for (int e = 0; e < 8; ++e) f[e] *= sg[e];
            }
            float ss = 0.f;
#pragma unroll
            for (int e = 0; e < 8; ++e) ss += f[e] * f[e];
#pragma unroll
            for (int o = 1; o < 32; o <<= 1) ss += __shfl_xor(ss, o);
            const float rs = 1.0f / sqrtf(ss * (1.f / DV) + EPS);
            const f32x4 g0 = *(const f32x4*)(gout + col), g1 = *(const f32x4*)(gout + col + 4);
            const float gg[8] = {g0.x, g0.y, g0.z, g0.w, g1.x, g1.y, g1.z, g1.w};
#pragma unroll
            for (int e = 0; e < 8; ++e) f[e] = f[e] * rs * gg[e];
            if (GLA) {
#pragma unroll
                for (int e = 0; e < 8; ++e) f[e] *= r[e] * sg[e];
            }
            v4u o; o.x = pk_bf16(f[0], f[1]); o.y = pk_bf16(f[2], f[3]); o.z = pk_bf16(f[4], f[5]); o.w = pk_bf16(f[6], f[7]);
            *(v4u*)(aop + (size_t)m * D + col) = o;
        }
    }
}

constexpr int WGL_FLOATS = 1024 * 16 + 128 * 4;
__device__ __forceinline__ void gla_prep(LAS unsigned char* lds, int tid, int vcu, int G, const bf16* proj, const bf16* xres, const float* sumsq, const float* w_in, const float* gmix,
                                         const float* wup, const float* bgate, bf16* QT, bf16* KT, float* gdec) {
    LAS float* wgl = (LAS float*)lds;
    LAS float* zl = (LAS float*)(lds + WGL_FLOATS * 4);
    LAS float* tot = zl + 1024;
    __syncthreads();
    for (int i = tid; i < 16 * D; i += NTHREADS) { const int k = i >> 4, c = i & 15; wgl[k * 16 + (k >> 3) * 4 + c] = gmix[k] * w_in[(size_t)k * GLA_IN + NPROJ + c]; }
    const int d = tid & 127, rg = tid >> 7;
    for (int unit = vcu; unit < BATCH * NCH; unit += G) {
        const int b = unit / NCH, c = unit % NCH, tok0 = b * SEQ + c * CH;
        __syncthreads();
        {
            const int row = tid >> 3, p = tid & 7; float a[16];
#pragma unroll
            for (int cc = 0; cc < 16; ++cc) a[cc] = 0.f;
            const bf16* xr = xres + (size_t)(tok0 + row) * D;
#pragma unroll 2
            for (int i = 0; i < 16; ++i) { const int kb = 8 * (p + 8 * i); const v4u xv = *(const v4u*)(xr + kb);
                const float xf[8] = {bflo(xv.x), bfhi(xv.x), bflo(xv.y), bfhi(xv.y), bflo(xv.z), bfhi(xv.z), bflo(xv.w), bfhi(xv.w)};
                const LAS float* wp = wgl + kb * 16 + (kb >> 3) * 4;
#pragma unroll
                for (int e = 0; e < 8; ++e)
#pragma unroll
                    for (int q4 = 0; q4 < 4; ++q4) { const f32x4 w = *(const LAS f32x4*)(wp + e * 16 + 4 * q4); a[4 * q4] += xf[e] * w.x; a[4 * q4 + 1] += xf[e] * w.y; a[4 * q4 + 2] += xf[e] * w.z; a[4 * q4 + 3] += xf[e] * w.w; } }
#pragma unroll
            for (int cc = 0; cc < 16; ++cc) { a[cc] += __shfl_xor(a[cc], 1); a[cc] += __shfl_xor(a[cc], 2); a[cc] += __shfl_xor(a[cc], 4); }
            const f32x4 s4 = *(const f32x4*)(sumsq + (size_t)(tok0 + row) * 4); const float rstd = 1.0f / sqrtf(((s4.x + s4.y) + (s4.z + s4.w)) * (1.f / D) + EPS);
            if (p < 4) *(LAS f32x4*)(zl + row * 16 + 4 * p) = (f32x4){a[4 * p] * rstd, a[4 * p + 1] * rstd, a[4 * p + 2] * rstd, a[4 * p + 3] * rstd};
        }
        __syncthreads();
#pragma clang loop unroll(disable)
        for (int h = 0; h < NH; ++h) {
            float wu[16];
#pragma unroll
            for (int cc = 0; cc < 16; ++cc) wu[cc] = wup[cc * QKW + h * DK + d];
            const float bg = bgate[h * DK + d];
            float bcum[16]; float run = 0.f;
#pragma unroll
            for (int jj = 0; jj < 16; ++jj) {
                const int j = 16 * rg + jj; float z = bg;
#pragma unroll
                for (int q4 = 0; q4 < 4; ++q4) { const f32x4 zz = *(const LAS f32x4*)(zl + j * 16 + 4 * q4); z += (zz.x * wu[4 * q4] + zz.y * wu[4 * q4 + 1]) + (zz.z * wu[4 * q4 + 2] + zz.w * wu[4 * q4 + 3]); }
                const float la = (fminf(z, 0.f) - __logf(1.0f + __expf(-fabsf(z)))) * INV_TAU;
                run += la; bcum[jj] = run;
            }
            tot[rg * 128 + d] = run;
            __syncthreads();
            float off = 0.f, g = 0.f;
#pragma unroll
            for (int r2 = 0; r2 < 4; ++r2) { const float t = tot[r2 * 128 + d]; g += t; off += (r2 < rg) ? t : 0.f; }
#pragma unroll
            for (int jj = 0; jj < 16; ++jj) {
                const int j = 16 * rg + jj; const float eb = __expf(bcum[jj] + off);
                const float q = bf2f(proj[(size_t)(tok0 + j) * NPROJ + h * DK + d]), k = bf2f(proj[(size_t)(tok0 + j) * NPROJ + QKW + h * DK + d]);
                const size_t o = (size_t)(tok0 + j) * QKW + h * DK + d;
                QT[o] = f2bf1(q * QK_SCALE * eb); KT[o] = f2bf1(k * __builtin_amdgcn_rcpf(eb));
            }
            if (rg == 0) gdec[(size_t)(unit * NH + h) * DK + d] = __expf(g);
            __syncthreads();
        }
    }
    __syncthreads();
}

#ifndef PROBE_T
#define PROBE_T 0
#endif
#ifndef PROBE_T_MLSTM
#define PROBE_T_MLSTM 0
#endif
#ifndef PROBE_T_WAVE
#define PROBE_T_WAVE 0
#endif
#ifndef PROBE_T_A
#define PROBE_T_A 5
#endif
#ifndef PROBE_T_B
#define PROBE_T_B 0
#endif
constexpr int CW_PROBE = 12288;
__device__ __forceinline__ unsigned long long pt_now() { unsigned long long t; __builtin_amdgcn_sched_barrier(0); asm volatile("s_memrealtime %0\n\ts_waitcnt lgkmcnt(0)" : "=s"(t) :: "memory"); __builtin_amdgcn_sched_barrier(0); return t; }
#define PT_NOW() pt_now()
#define PT_ACC(i, t0) do { if (PROBE_T) { const unsigned long long t1_ = PT_NOW(); pt[i] += (unsigned)(t1_ - (t0)); (t0) = t1_; } } while (0)
constexpr int PS_PITCH = 144, CT_PITCH = 272, CT_BYTES = 32 * CT_PITCH, IMG_PITCH = 272, IMG_BYTES = 64 * IMG_PITCH, NUM_PITCH = 36;
template <bool MLSTM> struct MxMap;
template <> struct MxMap<true>  { static constexpr int QS = 0, KS = 34816, V = 69632, VW = 77824, VWAUX = 81920, PS = 86016, CT = 95232, TB = 112640, TWP = 120832, TPM = 129024, TSC = 137216, DEN = 137728, NUM = 138240, OUTT = 0, GDEC = 0, END = 147456; };
template <> struct MxMap<false> { static constexpr int QS = 0, KS = 34816, V = 69632, VW = 0, VWAUX = 0, PS = 77824, CT = 87040, TB = 0, TWP = 0, TPM = 0, TSC = 0, DEN = 0, NUM = 0, OUTT = 104448, GDEC = 108544, END = 109568; };
#define LDSA(p) ((unsigned)(size_t)(p))
__device__ __forceinline__ bf16x8 mk8(v2u lo, v2u hi) { v4u w; w.x = lo.x; w.y = lo.y; w.z = hi.x; w.w = hi.y; return __builtin_bit_cast(bf16x8, w); }
__device__ __forceinline__ void tr_read2(bf16x8& f0, bf16x8& f1, unsigned a0, unsigned a1, unsigned b0, unsigned b1) {
    v2u l0, h0, l1, h1;
    asm volatile("ds_read_b64_tr_b16 %0, %4\n\tds_read_b64_tr_b16 %1, %5\n\tds_read_b64_tr_b16 %2, %6\n\tds_read_b64_tr_b16 %3, %7\n\ts_waitcnt lgkmcnt(0)"
                 : "=&v"(l0), "=&v"(h0), "=&v"(l1), "=&v"(h1) : "v"(a0), "v"(a1), "v"(b0), "v"(b1) : "memory");
    f0 = mk8(l0, h0); f1 = mk8(l1, h1);
}
__device__ __forceinline__ void tr_read3(bf16x8& f0, bf16x8& f1, bf16x8& f2, unsigned a0, unsigned a1, unsigned b0, unsigned b1, unsigned c0, unsigned c1) {
    v2u l0, h0, l1, h1, l2, h2;
    asm volatile("ds_read_b64_tr_b16 %0, %6\n\tds_read_b64_tr_b16 %1, %7\n\tds_read_b64_tr_b16 %2, %8\n\tds_read_b64_tr_b16 %3, %9\n\tds_read_b64_tr_b16 %4, %10\n\tds_read_b64_tr_b16 %5, %11\n\ts_waitcnt lgkmcnt(0)"
                 : "=&v"(l0), "=&v"(h0), "=&v"(l1), "=&v"(h1), "=&v"(l2), "=&v"(h2) : "v"(a0), "v"(a1), "v"(b0), "v"(b1), "v"(c0), "v"(c1) : "memory");
    f0 = mk8(l0, h0); f1 = mk8(l1, h1); f2 = mk8(l2, h2);
}
__device__ __forceinline__ bf16x8 tr_read1(unsigned a0, unsigned a1) {
    v2u l0, h0;
    asm volatile("ds_read_b64_tr_b16 %0, %2\n\tds_read_b64_tr_b16 %1, %3\n\ts_waitcnt lgkmcnt(0)" : "=&v"(l0), "=&v"(h0) : "v"(a0), "v"(a1) : "memory");
    return mk8(l0, h0);
}
#define MFMA32(a, b, c) __builtin_amdgcn_mfma_f32_32x32x16_bf16((a), (b), (c), 0, 0, 0)
#define MX_BAR() do { asm volatile("s_waitcnt lgkmcnt(0)" ::: "memory"); __builtin_amdgcn_s_barrier(); asm volatile("" ::: "memory"); } while (0)
#define MX_BAR_VM() do { asm volatile("s_waitcnt vmcnt(0) lgkmcnt(0)" ::: "memory"); __builtin_amdgcn_s_barrier(); asm volatile("" ::: "memory"); } while (0)
struct MixArgs { const bf16 *q, *k, *proj; int qpitch; const float *gates, *bgate, *gdec; bf16* hun; void* probe; };
struct MixUnit { const bf16 *Qg, *Kg, *Vg; bf16* Hg; const float* gdec; int qpitch, b, hh; };
constexpr int MX_NPIECE = 38, MX_PPW = 5;
struct MixDma { unsigned voff[MX_PPW]; };

__device__ __forceinline__ void mx_dma_setup(MixDma& dm, int wave, int lane, int qpitch) {
#pragma unroll
    for (int i = 0; i < MX_PPW; ++i) { const int pi = wave + 8 * i; unsigned v = 0;
        if (pi < 34) { const int ob = (pi < 17 ? pi : pi - 17) * 1024 + lane * 16, row = ob / IMG_PITCH; int cb = ob - row * IMG_PITCH; cb = cb < 256 ? cb : 240; v = (unsigned)(row * qpitch * 2 + cb); }
        else { const int ob = (pi - 34) * 1024 + lane * 16, row = ob >> 6, cb = ob & 63; v = (unsigned)(row * NPROJ * 2 + cb); }
        dm.voff[i] = v; }
}
template <bool MLSTM>
__device__ __forceinline__ void mx_dma_issue(LAS unsigned char* lds, const MixDma& dm, const MixUnit& U, int c, int wave, int tid) {
    typedef MxMap<MLSTM> MP;
    const int par = c & 1; const size_t tok0 = (size_t)U.b * SEQ + c * CH;
    const char* qb = (const char*)(U.Qg + tok0 * U.qpitch); const char* kb = (const char*)(U.Kg + tok0 * U.qpitch); const char* vb = (const char*)(U.Vg + tok0 * NPROJ);
#pragma unroll
    for (int i = 0; i < MX_PPW; ++i) { const int pi = wave + 8 * i;
        if (pi < MX_NPIECE) {
            const char* src; int dst;
            if (pi < 17) { src = qb; dst = MP::QS + par * IMG_BYTES + pi * 1024; }
            else if (pi < 34) { src = kb; dst = MP::KS + par * IMG_BYTES + (pi - 17) * 1024; }
            else { src = vb; dst = MP::V + par * 4096 + (pi - 34) * 1024; }
            __builtin_amdgcn_global_load_lds((const unsigned*)(src + dm.voff[i]), (LAS unsigned*)(lds + dst), 16, 0, 0);
        } }
    if (!MLSTM && wave == 7) {
        const float* gd = U.gdec + (size_t)(((U.b * NCH + c) * NH) + U.hh) * DK + (tid & 63);
        __builtin_amdgcn_global_load_lds((const unsigned*)gd, (LAS unsigned*)(lds + MP::GDEC + par * 512), 4, 0, 0);
        __builtin_amdgcn_global_load_lds((const unsigned*)(gd + 64), (LAS unsigned*)(lds + MP::GDEC + par * 512 + 256), 4, 0, 0);
    }
}
__device__ __forceinline__ void mx_store_tile(LAS unsigned char* outt, const f32x16& val, bf16* grow  , int lane, int r, int h5) {
#pragma unroll
    for (int i = 0; i < 16; ++i) *(LAS unsigned short*)(outt + ((i & 3) + 8 * (i >> 2) + 4 * h5) * 64 + r * 2) = f2bf1(val[i]);
#pragma unroll
    for (int i = 0; i < 2; ++i) { const int id = lane + 64 * i, row = id >> 2, pc = id & 3; const v4u w = *(const LAS v4u*)(outt + row * 64 + pc * 16); *(v4u*)(grow + (size_t)row * D + pc * 8) = w; }
}
__device__ __forceinline__ void mx_finalize_mlstm(LAS unsigned char* lds, const MixUnit& U, int cf, int fl) {
    typedef MxMap<true> MP;
    const int j = fl >> 2, sg = fl & 3; const float mc = ((const LAS float*)(lds + MP::TSC))[cf];
    const float dn = ((const LAS float*)(lds + MP::DEN))[j], bb = ((const LAS float*)(lds + MP::TB))[cf * 64 + j], pm = ((const LAS float*)(lds + MP::TPM))[cf * 64 + j];
    const float rden = QK_SCALE * __builtin_amdgcn_rcpf(fmaxf(fabsf(dn) * QK_SCALE, __expf(-bb - fmaxf(mc, pm))));
    const f32x4 n0 = *(const LAS f32x4*)((const LAS float*)(lds + MP::NUM) + j * NUM_PITCH + 8 * sg) * rden, n1 = *(const LAS f32x4*)((const LAS float*)(lds + MP::NUM) + j * NUM_PITCH + 8 * sg + 4) * rden;
    v4u w; w.x = pk_bf16(n0.x, n0.y); w.y = pk_bf16(n0.z, n0.w); w.z = pk_bf16(n1.x, n1.y); w.w = pk_bf16(n1.z, n1.w);
    *(v4u*)(U.Hg + (size_t)(U.b * SEQ + cf * CH + j) * D + 8 * sg) = w;
}

template <bool MLSTM>
__device__ __forceinline__ void mx_step(LAS unsigned char* lds, const MixDma& dm, const MixUnit& U, int c, f32x16& accC0, f32x16& accC1, f32x16& accO, int tid, int lane, int wave, unsigned (&pt)[8]) {
    typedef MxMap<MLSTM> MP;
    unsigned long long tp = PROBE_T ? PT_NOW() : 0ull;
    const int r = lane & 31, h5 = lane >> 5, blk = (lane >> 4) & 1, q4 = (lane & 15) >> 2, p4 = lane & 3, par = c & 1;
    const LAS float* TSC = (const LAS float*)(lds + MP::TSC);
    LAS unsigned char* qimg0 = lds + MP::QS + par * IMG_BYTES; LAS unsigned char* kimg0 = lds + MP::KS + par * IMG_BYTES; LAS unsigned char* vimg0 = lds + MP::V + par * 4096;
    if (c + 1 < NCH) mx_dma_issue<MLSTM>(lds, dm, U, c + 1, wave, tid);
    PT_ACC(6, tp);
    const float mc = MLSTM ? TSC[c] : 0.f;
    if (wave < 4) {
        const int st = wave >> 1, jt = (wave == 1 || wave == 2) ? 1 : 0;
#pragma unroll
        for (int i = 0; i < 16; ++i) accO[i] = 0.f;
        if (wave != 3) {
            LAS unsigned char* kimg = kimg0 + (32 * st + r) * IMG_PITCH + 16 * h5;
            LAS unsigned char* qimg = qimg0 + (32 * jt + r) * IMG_PITCH + 16 * h5;
#pragma unroll
            for (int ks = 0; ks < 8; ++ks) { const bf16x8 a = *(const LAS bf16x8*)(kimg + 32 * ks), bq = *(const LAS bf16x8*)(qimg + 32 * ks); accO = MFMA32(a, bq, accO); }
        }
        const int j = 32 * jt + r; float uj = 0.f;
        if (MLSTM) uj = -fmaxf(mc, ((const LAS float*)(lds + MP::TPM))[c * 64 + j]);
#pragma unroll
        for (int g4 = 0; g4 < 4; ++g4) { const int s0 = 32 * st + 8 * g4 + 4 * h5; f32x4 wps = {0.f, 0.f, 0.f, 0.f}; if (MLSTM) wps = *(const LAS f32x4*)((const LAS float*)(lds + MP::TWP) + c * 64 + s0);
            float v[4];
#pragma unroll
            for (int e = 0; e < 4; ++e) { float x = accO[4 * g4 + e]; if (MLSTM) x *= __expf(uj + wps[e]); v[e] = (s0 + e <= j) ? x : 0.f; }
            v2u o; o.x = pk_bf16(v[0], v[1]); o.y = pk_bf16(v[2], v[3]); *(LAS v2u*)(lds + MP::PS + j * PS_PITCH + s0 * 2) = o; }
    } else {
        const int g = (wave - 4) >> 1, jt = wave & 1;
        if (MLSTM) {
            if (c > 0) mx_finalize_mlstm(lds, U, c - 1, tid - 256);
            { const int fl = tid - 256, row = fl >> 2, pc = fl & 3;
              const float wr_ = __expf(((const LAS float*)(lds + MP::TWP))[c * 64 + row] - TSC[32 + c]); const v4u pv = *(const LAS v4u*)(vimg0 + row * 64 + pc * 16); v4u o;
              o.x = pk_bf16(bflo(pv.x) * wr_, bfhi(pv.x) * wr_); o.y = pk_bf16(bflo(pv.y) * wr_, bfhi(pv.y) * wr_); o.z = pk_bf16(bflo(pv.z) * wr_, bfhi(pv.z) * wr_); o.w = pk_bf16(bflo(pv.w) * wr_, bfhi(pv.w) * wr_);
              *(LAS v4u*)(lds + MP::VW + row * 64 + pc * 16) = o;
              if (pc == 0) *(LAS unsigned short*)(lds + MP::VWAUX + row * 64) = f2bf1(wr_); }
        }
        if (MLSTM || g == 0) {
#pragma unroll
            for (int i = 0; i < 16; ++i) accO[i] = 0.f;
#pragma unroll
            for (int ks = 0; ks < 8; ++ks) { const bf16x8 a = *(const LAS bf16x8*)(qimg0 + (32 * jt + r) * IMG_PITCH + 16 * h5 + 32 * ks), bc = *(const LAS bf16x8*)(lds + MP::CT + g * CT_BYTES + r * CT_PITCH + 32 * ks + 16 * h5); accO = MFMA32(a, bc, accO); }
            if (MLSTM) {
#pragma unroll
                for (int g4 = 0; g4 < 4; ++g4) { const f32x4 pm = *(const LAS f32x4*)((const LAS float*)(lds + MP::TPM) + c * 64 + 32 * jt + 8 * g4 + 4 * h5);
#pragma unroll
                    for (int e = 0; e < 4; ++e) accO[4 * g4 + e] *= __expf(mc - fmaxf(mc, pm[e])); }
            }
        }
    }
    PT_ACC(2, tp);
    MX_BAR();
    PT_ACC(3, tp);
    if (wave < 4) {
        if (MLSTM) { const float decay = __expf(mc - TSC[32 + c]); accC0 = accC0 * decay; accC1 = accC1 * decay; }
        LAS unsigned char* kimg = kimg0 + (8 * h5 + q4) * IMG_PITCH + 64 * wave + 32 * blk + 8 * p4;
        LAS unsigned char* vimg = (MLSTM ? lds + MP::VW : vimg0) + (8 * h5 + q4) * 64 + 32 * blk + 8 * p4;
        LAS unsigned char* vaux = lds + MP::VWAUX + (8 * h5 + q4) * 64 + 32 * blk + 8 * p4;
#pragma unroll
        for (int ks = 0; ks < 4; ++ks) {
            bf16x8 a, b0, b1;
            if (MLSTM) tr_read3(a, b0, b1, LDSA(kimg + 16 * ks * IMG_PITCH), LDSA(kimg + (16 * ks + 4) * IMG_PITCH), LDSA(vimg + 16 * ks * 64), LDSA(vimg + (16 * ks + 4) * 64), LDSA(vaux + 16 * ks * 64), LDSA(vaux + (16 * ks + 4) * 64));
            else tr_read2(a, b0, LDSA(kimg + 16 * ks * IMG_PITCH), LDSA(kimg + (16 * ks + 4) * IMG_PITCH), LDSA(vimg + 16 * ks * 64), LDSA(vimg + (16 * ks + 4) * 64));
            __builtin_amdgcn_sched_barrier(0);
            accC0 = MFMA32(a, b0, accC0);
            if (MLSTM) accC1 = MFMA32(a, b1, accC1);
        }
        if (!MLSTM) {
#pragma unroll
            for (int g4 = 0; g4 < 4; ++g4) { const f32x4 dc = *(const LAS f32x4*)((const LAS float*)(lds + MP::GDEC) + par * 128 + 32 * wave + 8 * g4 + 4 * h5);
#pragma unroll
                for (int e = 0; e < 4; ++e) accC0[4 * g4 + e] *= dc[e]; }
        }
#pragma unroll
        for (int g4 = 0; g4 < 4; ++g4) { const int d0 = 32 * wave + 8 * g4 + 4 * h5;
            v2u o; o.x = pk_bf16(accC0[4 * g4], accC0[4 * g4 + 1]); o.y = pk_bf16(accC0[4 * g4 + 2], accC0[4 * g4 + 3]); *(LAS v2u*)(lds + MP::CT + r * CT_PITCH + d0 * 2) = o;
            if (MLSTM) { v2u o1; o1.x = pk_bf16(accC1[4 * g4], accC1[4 * g4 + 1]); o1.y = pk_bf16(accC1[4 * g4 + 2], accC1[4 * g4 + 3]); *(LAS v2u*)(lds + MP::CT + CT_BYTES + r * CT_PITCH + d0 * 2) = o1; } }
    } else {
        const int g = (wave - 4) >> 1, jt = wave & 1;
        if (MLSTM || g == 0) {
            const bf16x8 ones = (r == 0) ? (bf16x8){0x3F80, 0x3F80, 0x3F80, 0x3F80, 0x3F80, 0x3F80, 0x3F80, 0x3F80} : (bf16x8){0, 0, 0, 0, 0, 0, 0, 0};
            LAS unsigned char* vimg = vimg0 + (8 * h5 + q4) * 64 + 32 * blk + 8 * p4;
#pragma unroll
            for (int ks = 0; ks < 4; ++ks) {
                const bf16x8 a = *(const LAS bf16x8*)(lds + MP::PS + (32 * jt + r) * PS_PITCH + 32 * ks + 16 * h5);
                if (g == 0) { const bf16x8 bv = tr_read1(LDSA(vimg + 16 * ks * 64), LDSA(vimg + (16 * ks + 4) * 64)); __builtin_amdgcn_sched_barrier(0); accO = MFMA32(a, bv, accO); }
                else accO = MFMA32(a, ones, accO); }
            if (MLSTM && g == 0) {
#pragma unroll
                for (int i = 0; i < 16; ++i) ((LAS float*)(lds + MP::NUM))[(32 * jt + (i & 3) + 8 * (i >> 2) + 4 * h5) * NUM_PITCH + r] = accO[i];
            }
            if (MLSTM && g == 1 && r == 0) {
#pragma unroll
                for (int i = 0; i < 16; ++i) ((LAS float*)(lds + MP::DEN))[32 * jt + (i & 3) + 8 * (i >> 2) + 4 * h5] = accO[i];
            }
            if (!MLSTM) mx_store_tile(lds + MP::OUTT + jt * 2048, accO, U.Hg + (size_t)(U.b * SEQ + c * CH + 32 * jt) * D, lane, r, h5);
        }
    }
    PT_ACC(4, tp);
    MX_BAR_VM();
    PT_ACC(5, tp);
}

template <bool MLSTM>
__device__ __forceinline__ void mixer_phase(LAS unsigned char* lds, int tid, int lane, int wave, int vcu, int G, const MixArgs A) {
    typedef MxMap<MLSTM> MP;
    MixDma dm; mx_dma_setup(dm, wave, lane, A.qpitch);
    unsigned pt[8] = {0u, 0u, 0u, 0u, 0u, 0u, 0u, 0u}; unsigned long long tph = PROBE_T ? PT_NOW() : 0ull; unsigned long long tin = tph;
    for (int unit = vcu; unit < BATCH * NH * 8; unit += G) {
        const int slice = unit & 7, bh = unit >> 3;
        MixUnit U; U.b = bh >> 2; U.hh = bh & 3; U.qpitch = A.qpitch; U.gdec = A.gdec;
        U.Qg = A.q + U.hh * DK; U.Kg = A.k + U.hh * DK; U.Vg = A.proj + 1024 + U.hh * DV + 32 * slice; U.Hg = A.hun + U.hh * DV + 32 * slice;
        MX_BAR_VM();
        mx_dma_issue<MLSTM>(lds, dm, U, 0, wave, tid);
        for (int i = tid; i < 2 * CT_BYTES / 4; i += NTHREADS) ((LAS unsigned*)(lds + MP::CT))[i] = 0u;
        if (MLSTM) {
            for (int i = tid; i < 1024; i += NTHREADS) ((LAS unsigned*)(lds + MP::VWAUX))[i] = 0u;
            LAS float* TB = (LAS float*)(lds + MP::TB); LAS float* TWP = (LAS float*)(lds + MP::TWP); LAS float* TPM = (LAS float*)(lds + MP::TPM); LAS float* TSC = (LAS float*)(lds + MP::TSC);
            const float bgi = A.bgate[U.hh], bgf = A.bgate[4 + U.hh];
            float gi4[4], gf4[4];
#pragma unroll
            for (int cc = 0; cc < 4; ++cc) { const size_t tok = (size_t)U.b * SEQ + (wave + 8 * cc) * CH + lane; gi4[cc] = A.gates[tok * 16 + U.hh] + bgi; gf4[cc] = A.gates[tok * 16 + 4 + U.hh] + bgf; }
#pragma unroll
            for (int cc = 0; cc < 4; ++cc) { const int c = wave + 8 * cc;
                const float lf = fminf(gf4[cc], 0.f) - __logf(1.0f + __expf(-fabsf(gf4[cc])));
                float bsum = lf;
#pragma unroll
                for (int o = 1; o < 64; o <<= 1) { const float t = __shfl_up(bsum, o); if (lane >= o) bsum += t; }
                const float wp = gi4[cc] - bsum; float pm = wp;
#pragma unroll
                for (int o = 1; o < 64; o <<= 1) { const float t = __shfl_up(pm, o); if (lane >= o) pm = fmaxf(pm, t); }
                TB[c * 64 + lane] = bsum; TWP[c * 64 + lane] = wp; TPM[c * 64 + lane] = pm;
                if (lane == 63) { TSC[64 + c] = bsum; TSC[96 + c] = pm; } }
            MX_BAR();
            if (wave == 0) {
                const float gl = TSC[64 + (lane & 31)], pl = TSC[96 + (lane & 31)]; float m = 0.f, myM = 0.f, myX = 0.f;
#pragma clang loop unroll(disable)
                for (int c = 0; c < NCH; ++c) { const float gc = __uint_as_float(__builtin_amdgcn_readlane(__float_as_uint(gl), c)), pc = __uint_as_float(__builtin_amdgcn_readlane(__float_as_uint(pl), c));
                    const float mxe = fmaxf(m, pc); if (lane == c) { myM = m; myX = mxe; } m = gc + mxe; }
                if (lane < 32) { TSC[lane] = myM; TSC[32 + lane] = myX; }
            }
        }
        f32x16 accC0, accC1, accO;
#pragma unroll
        for (int i = 0; i < 16; ++i) { accC0[i] = 0.f; accC1[i] = 0.f; accO[i] = 0.f; }
        MX_BAR_VM();
        PT_ACC(1, tin);
#pragma clang loop unroll(disable)
        for (int c = 0; c < NCH; ++c) mx_step<MLSTM>(lds, dm, U, c, accC0, accC1, accO, tid, lane, wave, pt);
        if (MLSTM && wave >= 4) mx_finalize_mlstm(lds, U, NCH - 1, tid - 256);
    }
    MX_BAR_VM();
    if (PROBE_T && (PROBE_T_MLSTM != 0) == MLSTM && vcu == 0 && wave == PROBE_T_WAVE && lane == 0) { PT_ACC(0, tph); unsigned* pw = (unsigned*)A.probe; pw[0] = pt[PROBE_T_A]; pw[1] = pt[PROBE_T_B]; }
}

constexpr int N_PHASES = 16, RT_OFF = RING_BYTES;
template <int PH>
__device__ __forceinline__ void run_phase(const Args& args, LAS unsigned char* lds, int tid, int lane, int wave, int vcu, int G, int bx) {
    unsigned char* ws = args.ws;
    constexpr int layer = (PH >= 8 && PH < 15) ? 1 : 0, k = (PH == 0) ? -1 : (PH == 15) ? 7 : PH - 1 - 7 * layer;
    unsigned char* wl = ws + (size_t)layer * WS_WLAYER;
    bf16* AOP = (bf16*)(ws + WS_AOP); bf16* PROJ = (bf16*)(ws + WS_PROJ); bf16* HMID = (bf16*)(ws + WS_HMID); bf16* XRES = (bf16*)(ws + WS_XRES);
    float* GATES = (float*)(ws + WS_GATES); float* SUMSQ = (float*)(ws + WS_SUMSQ);
    LAS float* RT = (LAS float*)(lds + RT_OFF);
    if constexpr (k == -1) {
        convert_weights(lds, lane, wave, vcu, G, args, ws);
        rows_first(lds, tid, lane, wave, vcu, G, args.in[0], args.in[1], XRES, SUMSQ, args.in[4] + NPROJ, MLSTM_IN, 8, GATES);
    } else if constexpr (k == 0) {
        pg8::Gemm g{XRES, (const bf16*)(wl + WS_WIN), M, NPROJ, D}; pg8::StaticOrder S; S.init(M, NPROJ, G, bx);
        const RstdSlots rs = rstd_table(RT, SUMSQ, S, tid);
        pg8::EpiBf16S<0> E{PROJ, NPROJ, (const LAS float*)RT, rs.pm1, rs.pm2, rs.pm3};
        pg8::gemm_phase<pg8::EpiBf16S<0>, pg8::StaticOrder, true, true>(lds, g, S, E);
    } else if constexpr (k == 1) {
        if (layer) gla_prep(lds, tid, vcu, G, PROJ, XRES, SUMSQ, args.in[8], args.in[1] + D, args.in[9], args.in[10], (bf16*)(ws + WS_QT), (bf16*)(ws + WS_KT), (float*)(ws + WS_GDEC));
    } else if constexpr (k == 2) {
        if (layer == 0) { const MixArgs A{PROJ, PROJ + QKW, PROJ, NPROJ, GATES, args.in[5], nullptr, AOP, ws + WS_CTL + 4 * CW_PROBE}; mixer_phase<true>(lds, tid, lane, wave, vcu, G, A); }
        else { const MixArgs A{(const bf16*)(ws + WS_QT), (const bf16*)(ws + WS_KT), PROJ, QKW, nullptr, nullptr, (const float*)(ws + WS_GDEC), AOP, ws + WS_CTL + 4 * CW_PROBE}; mixer_phase<false>(lds, tid, lane, wave, vcu, G, A); }
    } else if constexpr (k == 3) {
        head_norm_rows(lane, wave, vcu, G, AOP, args.in[layer ? 11 : 6], PROJ, AOP, layer != 0);
    } else if constexpr (k == 4) {
        pg8::Gemm g{AOP, (const bf16*)(wl + WS_WOUT), M, D, D}; pg8::StaticOrder S; S.init(M, D, G, bx);
        pg8::EpiResBf16Sq E{XRES, SUMSQ, D};
        pg8::gemm_phase<pg8::EpiResBf16Sq, pg8::StaticOrder, false, true>(lds, g, S, E);
    } else if constexpr (k == 5) {
        pg8::Gemm g{XRES, (const bf16*)(wl + WS_W1), M, FF, D}; pg8::StaticOrder S; S.init(M, FF, G, bx);
        const RstdSlots rs = rstd_table(RT, SUMSQ, S, tid);
        pg8::EpiBf16S<2> E{HMID, FF, (const LAS float*)RT, rs.pm1, rs.pm2, rs.pm3};
        pg8::gemm_phase<pg8::EpiBf16S<2>, pg8::StaticOrder, true, true>(lds, g, S, E);
    } else if constexpr (k == 6) {
        pg8::Gemm g{HMID, (const bf16*)(wl + WS_W2), M, D, FF}; pg8::StaticOrder S; S.init(M, D, G, bx);
        pg8::EpiResBf16Sq E{XRES, SUMSQ, D};
        pg8::gemm_phase<pg8::EpiResBf16Sq, pg8::StaticOrder, false, true>(lds, g, S, E);
    } else {
        rows_final(lane, wave, vcu, G, XRES, args.in[3], args.out);
    }
}
__global__ void __launch_bounds__(NTHREADS, 2) fwd_kernel(Args args) {
    extern __shared__ __attribute__((aligned(16))) unsigned char lds_raw[];
    LAS unsigned char* lds = (LAS unsigned char*)lds_raw;
    volatile LAS unsigned* MISC = (volatile LAS unsigned*)(lds + MISC_OFF);
    const int tid = threadIdx.x, lane = tid & 63, wave = __builtin_amdgcn_readfirstlane(tid >> 6);
    const int G = gridDim.x; int bx = blockIdx.x; int vcu = (G % 8 == 0) ? (bx % 8) * (G / 8) + bx / 8 : bx;
    for (int u = tid; u < (LDS_BYTES - LDSCTL_OFF) / 4; u += NTHREADS) ((LAS unsigned*)(lds + LDSCTL_OFF))[u] = 0u;
    __syncthreads();
    const int lo = args.ph_lo, hi = args.ph_hi;
    XcdBarrier bar; bar.bar = (unsigned*)(args.ws + WS_CTL) + CW_BAR; bar.x = 0; bar.st = nullptr;
    if (hi - lo > 1) { bar = xcd_barrier_post((unsigned*)(args.ws + WS_CTL) + CW_BAR, MISC + 8);
        if (tid == 0) { const unsigned xcc = xb_xcc_id(); MISC[16] = xcc; MISC[17] = xb_add((unsigned*)(args.ws + WS_CTL) + CW_XID + 64 * xcc, 1u); } }
#ifndef PROBE_PH
#define PROBE_PH (-1)
#endif
#ifndef PROBE_N
#define PROBE_N 0
#endif
#define PHASE(p) if (lo <= (p) && (p) < hi) { run_phase<p>(args, lds, tid, lane, wave, vcu, G, bx); \
        if ((p) == PROBE_PH) { for (int rep_ = 0; rep_ < PROBE_N; ++rep_) { xcd_barrier(bar); if (PROBE_PH >= 0) run_phase<((p) == PROBE_PH ? (p) : 2)>(args, lds, tid, lane, wave, vcu, G, bx); } } \
        if ((p) + 1 < hi && (p) != 2) xcd_barrier(bar); }
    PHASE(0)
    if (lo == 0 && hi > 1) {
        bool ok = (G == 256);
#pragma unroll
        for (unsigned j = 0; j < 16; ++j) { const unsigned cnt = xb_ld(&bar.bar[XB_XCNT(j)]); ok = ok && (cnt == (j < 8 ? 32u : 0u)); }
        const unsigned xcc = MISC[16], idx = MISC[17];
        if (ok && xcc < 8 && idx < 32) { vcu = (int)(xcc * 32 + idx); bx = (int)(idx * 8 + xcc); }
    }
    PHASE(1) PHASE(2) PHASE(3) PHASE(4) PHASE(5) PHASE(6) PHASE(7) PHASE(8) PHASE(9) PHASE(10) PHASE(11) PHASE(12) PHASE(13) PHASE(14) PHASE(15)
#undef PHASE
    if (PROBE_T && hi == N_PHASES && vcu == 0 && tid == 0) {
        const unsigned a = xb_ld((unsigned*)(args.ws + WS_CTL) + CW_PROBE), b = xb_ld((unsigned*)(args.ws + WS_CTL) + CW_PROBE + 1);
        const unsigned long long ticks = (unsigned long long)a * 5ull + (unsigned long long)(b / 50u) * 50000ull;
        const unsigned long long t0 = PT_NOW(); while (PT_NOW() - t0 < ticks) __builtin_amdgcn_s_sleep(8);
    }
}

extern "C" void kernel_launch(void* const* d_in, const int* in_sizes, int n_in, void* d_out, int out_size, void* d_ws, size_t ws_size, hipStream_t stream) {
    static int grid = 0;
    if (grid == 0) {
        if (n_in != 15 || in_sizes[0] != M * D || out_size != M * D || ws_size < WS_END) { fprintf(stderr, "kernel_launch: unexpected shapes (n_in %d, in0 %d, out %d, ws %zu); nothing launched\n", n_in, n_in > 0 ? in_sizes[0] : -1, out_size, ws_size); grid = -1; return; }
        int dev = 0, cus = 0, per_cu = 0;
        if (hipGetDevice(&dev) != hipSuccess || hipDeviceGetAttribute(&cus, hipDeviceAttributeMultiprocessorCount, dev) != hipSuccess) { grid = -1; return; }
        if (hipFuncSetAttribute((const void*)fwd_kernel, hipFuncAttributeMaxDynamicSharedMemorySize, LDS_BYTES) != hipSuccess) { fprintf(stderr, "kernel_launch: hipFuncSetAttribute failed\n"); grid = -1; return; }
        if (hipOccupancyMaxActiveBlocksPerMultiprocessor(&per_cu, (const void*)fwd_kernel, NTHREADS, LDS_BYTES) != hipSuccess || per_cu < 1) { fprintf(stderr, "kernel_launch: occupancy query says %d blocks per CU\n", per_cu); (void)hipGetLastError(); grid = -1; return; }
        grid = cus;
    }
    if (grid < 0) return;
    (void)hipMemsetAsync((char*)d_ws + WS_CTL, 0, CTL_ZERO_BYTES, stream);
    Args a{};
    for (int i = 0; i < 15; ++i) a.in[i] = (const float*)d_in[i];
    a.out = (float*)d_out; a.ws = (unsigned char*)d_ws;
    if (MK_N_LAUNCHES == 1) {
        a.ph_lo = 0; a.ph_hi = N_PHASES;
        void* kargs[] = {&a};
        const hipError_t e = hipLaunchCooperativeKernel((const void*)fwd_kernel, dim3(grid), dim3(NTHREADS), kargs, LDS_BYTES, stream);
        if (e != hipSuccess) fprintf(stderr, "kernel_launch: cooperative launch failed: %s (grid %d)\n", hipGetErrorString(e), grid);
    } else {
        for (int p = 0; p < N_PHASES; ++p) { a.ph_lo = p; a.ph_hi = p + 1; hipLaunchKernelGGL(fwd_kernel, dim3(grid), dim3(NTHREADS), LDS_BYTES, stream, a); }
    }
}
```

```cpp
#include <hip/hip_runtime.h>
#include <cstdio>
#include <cstdint>
namespace pg8 {
#define PG8_LAS __attribute__((address_space(3)))
typedef unsigned short bf16_t;
typedef short bf16x8 __attribute__((ext_vector_type(8)));
typedef float f32x4 __attribute__((ext_vector_type(4)));
typedef unsigned u32x4 __attribute__((ext_vector_type(4)));
constexpr int BM = 256, BK = 64, HALF = 128, HTB = HALF * BK * 2  , STAGE_BYTES = 8 * HTB, NXCD = 8, WGM = 8;

__host__ __device__ __forceinline__ int lds_byte(int r, int c) { const int st = (r >> 4) * 2 + (c >> 5), rr = r & 15, cc = c & 31, ob = rr * 64 + cc * 2; return st * 1024 + (ob ^ (((ob >> 9) & 1) << 5)); }
__host__ __device__ __forceinline__ void stage_rc(int b, int& R, int& C) { const int st = b / 1024, sb = b % 1024, swz = sb ^ (((sb >> 9) & 1) << 5); R = (st >> 1) * 16 + swz / 64; C = (st & 1) * 32 + (swz % 64) / 2; }
__host__ __device__ __forceinline__ int perm32(int rho) { const int n = rho >> 4, i = rho & 15; return 8 * (i >> 2) + 4 * n + (i & 3); }

struct Unit { int pm, pn; };
struct Gemm { const bf16_t* A; const bf16_t* Bt; int M, N, K; };

struct StaticOrder {
    int nM, nN, nwg, G, c;
    __host__ __device__ void init(int M, int N, int G_, int c_) { nM = M / BM; nN = N / BM; nwg = nM * nN; G = G_; c = c_; }
    __host__ __device__ bool next(int i, Unit& u) const {
        const long L = (long)i * G + c; if (L >= nwg) return false;
        int wgid = (int)L; { const int q = nwg / NXCD, r = nwg % NXCD, xcd = wgid % NXCD, off = wgid / NXCD; wgid = (xcd < r ? xcd * (q + 1) : r * (q + 1) + (xcd - r) * q) + off; }
        const int nig = WGM * nN, gid = wgid / nig, fm = gid * WGM, gsz = (nM - fm) < WGM ? (nM - fm) : WGM;
        u.pm = fm + ((wgid % nig) % gsz); u.pn = (wgid % nig) / gsz; return true;
    }
    __device__ __forceinline__ void a_ready(const Unit&) const {}
    __device__ __forceinline__ void done(const Unit&) const {}
};

__device__ __forceinline__ unsigned cvt_pk_bf16(float lo, float hi) { unsigned r; asm volatile("v_cvt_pk_bf16_f32 %0, %1, %2" : "=v"(r) : "v"(lo), "v"(hi)); return r; }
typedef float f32x2 __attribute__((ext_vector_type(2)));
typedef __bf16 bf16x2_t __attribute__((ext_vector_type(2)));
__device__ __forceinline__ unsigned pk_bf16(float lo, float hi) { f32x2 v = {lo, hi}; bf16x2_t r = __builtin_convertvector(v, bf16x2_t); return __builtin_bit_cast(unsigned, r); }
template <int ACT  > struct EpiBf16 {
    static constexpr bool PERM = true, AFTER_DRAIN = false;
    bf16_t* O; int ldc;
    __device__ __forceinline__ void operator()(const f32x4 (&acc)[2][2][4][2], const Unit& u, int wr, int wc, int fr, int fq) const {
        const int row0 = u.pm * BM + wr * 64 + fr, col0 = u.pn * BM + wc * 32 + 8 * fq;
#pragma unroll
        for (int ai = 0; ai < 2; ++ai)
#pragma unroll
            for (int m = 0; m < 4; ++m) { bf16_t* rowp = O + (size_t)(row0 + ai * HALF + m * 16) * ldc + col0;
#pragma unroll
                for (int bj = 0; bj < 2; ++bj) { f32x4 v0 = acc[ai][bj][m][0], v1 = acc[ai][bj][m][1];
                    if (ACT == 2) { const f32x4 z = {0.f, 0.f, 0.f, 0.f}; v0 = __builtin_elementwise_max(v0, z); v1 = __builtin_elementwise_max(v1, z); v0 = v0 * v0; v1 = v1 * v1; }
                    u32x4 w; w.x = pk_bf16(v0[0], v0[1]); w.y = pk_bf16(v0[2], v0[3]); w.z = pk_bf16(v1[0], v1[1]); w.w = pk_bf16(v1[2], v1[3]);
                    *(u32x4*)(rowp + bj * HALF) = w; } }
    }
};
struct EpiResF32 {
    static constexpr bool PERM = false, AFTER_DRAIN = true;
    const float* base; float* out; int ldc;
    __device__ __forceinline__ void fused(const f32x4 (&acc)[2][2][4][2], const Unit& u, int wr, int wc, int fr, int fq, PG8_LAS unsigned char*, int, int) const {
        const int col0 = u.pn * BM + wc * 32 + 4 * fq;
#pragma unroll
        for (int ai = 0; ai < 2; ++ai)
#pragma unroll
            for (int m = 0; m < 4; ++m) { const int r = ai * HALF + wr * 64 + m * 16 + fr; const size_t off = (size_t)(u.pm * BM + r) * ldc + col0;
#pragma unroll
                for (int bj = 0; bj < 2; ++bj) { const f32x4 b0 = *(const f32x4*)(base + off + bj * HALF), b1 = *(const f32x4*)(base + off + bj * HALF + 16);
                    *(f32x4*)(out + off + bj * HALF) = b0 + acc[ai][bj][m][0]; *(f32x4*)(out + off + bj * HALF + 16) = b1 + acc[ai][bj][m][1];
                    asm volatile("" ::: "memory"); } }
    }
};
typedef unsigned u32x2 __attribute__((ext_vector_type(2)));
__device__ __forceinline__ float bf_lo(unsigned w) { return __builtin_bit_cast(float, w << 16); }
__device__ __forceinline__ float bf_hi(unsigned w) { return __builtin_bit_cast(float, w & 0xffff0000u); }
template <int ACT  > struct EpiBf16S {
    static constexpr bool PERM = true, AFTER_DRAIN = false;
    bf16_t* O; int ldc; const PG8_LAS float* rt; int pm1, pm2, pm3;
    __device__ __forceinline__ void operator()(const f32x4 (&acc)[2][2][4][2], const Unit& u, int wr, int wc, int fr, int fq) const {
        const int col0 = u.pn * BM + wc * 32 + 8 * fq;
        const PG8_LAS float* rtp = rt + ((u.pm == pm1) ? 256 : (u.pm == pm2) ? 512 : (u.pm == pm3) ? 768 : 0) + wr * 64 + fr;
#pragma unroll
        for (int ai = 0; ai < 2; ++ai)
#pragma unroll
            for (int m = 0; m < 4; ++m) { const float rs = rtp[ai * HALF + m * 16];
                bf16_t* rowp = O + (size_t)(u.pm * BM + ai * HALF + wr * 64 + m * 16 + fr) * ldc + col0;
#pragma unroll
                for (int bj = 0; bj < 2; ++bj) { f32x4 v0 = acc[ai][bj][m][0] * rs, v1 = acc[ai][bj][m][1] * rs;
                    if (ACT == 2) { const f32x4 z = {0.f, 0.f, 0.f, 0.f}; v0 = __builtin_elementwise_max(v0, z); v1 = __builtin_elementwise_max(v1, z); v0 = v0 * v0; v1 = v1 * v1; }
                    u32x4 w; w.x = pk_bf16(v0[0], v0[1]); w.y = pk_bf16(v0[2], v0[3]); w.z = pk_bf16(v1[0], v1[1]); w.w = pk_bf16(v1[2], v1[3]);
                    *(u32x4*)(rowp + bj * HALF) = w; } }
    }
};
struct EpiResBf16Sq {
    static constexpr bool PERM = false, AFTER_DRAIN = true;
    bf16_t* xres; float* sumsq; int ldc;
    __device__ __forceinline__ void fused(f32x4 (&acc)[2][2][4][2], const Unit& u, int wr, int wc, int fr, int fq, PG8_LAS unsigned char* lds, int wid, int lane) const {
        PG8_LAS float* P = (PG8_LAS float*)lds;
        const int col0 = u.pn * BM + wc * 32 + 4 * fq;
#pragma unroll
        for (int ai = 0; ai < 2; ++ai)
#pragma unroll
            for (int m = 0; m < 4; ++m) { const int r = ai * HALF + wr * 64 + m * 16 + fr; bf16_t* xp = xres + (size_t)(u.pm * BM + r) * ldc + col0; float ss = 0.f;
#pragma unroll
                for (int bj = 0; bj < 2; ++bj)
#pragma unroll
                    for (int n = 0; n < 2; ++n) { const u32x2 xb = *(const u32x2*)(xp + bj * HALF + n * 16); const f32x4 a = acc[ai][bj][m][n];
                        u32x2 w; w.x = pk_bf16(bf_lo(xb.x) + a[0], bf_hi(xb.x) + a[1]); w.y = pk_bf16(bf_lo(xb.y) + a[2], bf_hi(xb.y) + a[3]);
                        *(u32x2*)(xp + bj * HALF + n * 16) = w;
                        const float y0 = bf_lo(w.x), y1 = bf_hi(w.x), y2 = bf_lo(w.y), y3 = bf_hi(w.y); ss += (y0 * y0 + y1 * y1) + (y2 * y2 + y3 * y3); }
                ss += __shfl_xor(ss, 16); ss += __shfl_xor(ss, 32);
                if (fq == 0) P[r * 4 + wc] = ss;
                asm volatile("" ::: "memory"); }
        asm volatile("s_waitcnt lgkmcnt(0)" ::: "memory"); __builtin_amdgcn_s_barrier(); asm volatile("" ::: "memory");
        const int t = wid * 64 + lane;
        if (t < 256) { const f32x4 p = *(const PG8_LAS f32x4*)(P + t * 4); sumsq[(size_t)(u.pm * BM + t) * 4 + u.pn] = (p[0] + p[1]) + (p[2] + p[3]); }
    }
};
template <class Epi, class Sched, bool ALIGN_EPI = false, bool SP2 = false>
__device__ __forceinline__ void gemm_phase(PG8_LAS unsigned char* lds, const Gemm g, const Sched& S, const Epi& E) {
    const int tid = threadIdx.x, wid = __builtin_amdgcn_readfirstlane(tid >> 6), lane = tid & 63, wr = wid >> 2, wc = wid & 3, fr = lane & 15, fq = lane >> 4;
    const int K = g.K, nt = K / BK;
    unsigned voffA[2], voffB[2];
#pragma unroll
    for (int i = 0; i < 2; ++i) { int R, C; stage_rc(tid * 16 + i * 8192, R, C); const int Rb = Epi::PERM ? ((R & ~31) + perm32(R & 31)) : R;
        voffA[i] = (unsigned)(R * K + C) * 2u; voffB[i] = (unsigned)(Rb * K + C) * 2u; }
    const size_t kstep = (size_t)(BK * 2);
    const size_t hstep = (size_t)HALF * K * 2;
    const size_t tstep = 2 * hstep;
    const unsigned ldsw = (unsigned)wid * 1024u;
    const int aoff = lds_byte(wr * 64 + fr, fq * 8), boff = lds_byte(wc * 32 + fr, fq * 8);
#define PG8_SA(b, h) (((b) * 2 + (h)) * HTB)
#define PG8_SB(b, h) ((4 + (b) * 2 + (h)) * HTB)
#define PG8_STAGE(bufoff, gbase, voff) do { _Pragma("unroll") for (int _i = 0; _i < 2; ++_i) \
        __builtin_amdgcn_global_load_lds((const unsigned*)((const char*)(gbase) + (voff)[_i]), (PG8_LAS unsigned*)(lds + (bufoff) + ldsw + _i * 8192), 16, 0, 0); } while (0)
#define PG8_LDA(dst, b, h) do { _Pragma("unroll") for (int m = 0; m < 4; ++m) _Pragma("unroll") for (int k = 0; k < 2; ++k) dst[m][k] = *(const PG8_LAS bf16x8*)(lds + PG8_SA(b, h) + aoff + m * 2048 + k * 1024); } while (0)
#define PG8_LDB(dst, b, h) do { _Pragma("unroll") for (int n = 0; n < 2; ++n) _Pragma("unroll") for (int k = 0; k < 2; ++k) dst[n][k] = *(const PG8_LAS bf16x8*)(lds + PG8_SB(b, h) + boff + n * 2048 + k * 1024); } while (0)
#define PG8_MMA(ai, bj, At, Bt) do { __builtin_amdgcn_s_setprio(1); _Pragma("unroll") for (int m = 0; m < 4; ++m) _Pragma("unroll") for (int n = 0; n < 2; ++n) _Pragma("unroll") for (int k = 0; k < 2; ++k) \
        acc[ai][bj][m][n] = __builtin_amdgcn_mfma_f32_16x16x32_bf16(Bt[n][k], At[m][k], acc[ai][bj][m][n], 0, 0, 0); __builtin_amdgcn_s_setprio(0); } while (0)
#define PG8_WAIT_V(n) asm volatile("s_waitcnt vmcnt(" #n ")" ::: "memory")
#define PG8_WAIT_L(n) asm volatile("s_waitcnt lgkmcnt(" #n ")" ::: "memory")
#define PG8_BAR __builtin_amdgcn_s_barrier()
#define PG8_SCHED __builtin_amdgcn_sched_barrier(0)
    Unit cur, nxt; int ui = 0;
    if (!S.next(0, cur)) return;
    f32x4 acc[2][2][4][2];
#pragma unroll
    for (int a = 0; a < 2; ++a)
#pragma unroll
        for (int b = 0; b < 2; ++b)
#pragma unroll
            for (int m = 0; m < 4; ++m)
#pragma unroll
                for (int n = 0; n < 2; ++n) acc[a][b][m][n] = (f32x4){0.f, 0.f, 0.f, 0.f};
    bf16x8 At[4][2], B0[2][2], B1[2][2];
    const char* cA = (const char*)g.A + (size_t)cur.pm * tstep; const char* cB = (const char*)g.Bt + (size_t)cur.pn * tstep;
    S.a_ready(cur);
    if constexpr (SP2) {
        PG8_STAGE(PG8_SB(0, 0), cB, voffB); PG8_STAGE(PG8_SB(0, 1), cB + hstep, voffB); PG8_STAGE(PG8_SA(0, 0), cA, voffA); PG8_STAGE(PG8_SA(0, 1), cA + hstep, voffA);
        if (wr == 1) PG8_BAR;
        PG8_WAIT_V(2); PG8_BAR;
        PG8_STAGE(PG8_SB(1, 0), cB + kstep, voffB); PG8_STAGE(PG8_SA(1, 0), cA + kstep, voffA); PG8_STAGE(PG8_SB(1, 1), cB + hstep + kstep, voffB);
        PG8_WAIT_V(6); PG8_BAR;
    } else {
        PG8_STAGE(PG8_SB(0, 0), cB, voffB); PG8_STAGE(PG8_SA(0, 0), cA, voffA); PG8_STAGE(PG8_SB(0, 1), cB + hstep, voffB); PG8_STAGE(PG8_SA(0, 1), cA + hstep, voffA);
        if (wr == 1) PG8_BAR;
        PG8_WAIT_V(4); PG8_BAR;
        PG8_STAGE(PG8_SB(1, 0), cB + kstep, voffB); PG8_STAGE(PG8_SA(1, 0), cA + kstep, voffA); PG8_STAGE(PG8_SB(1, 1), cB + hstep + kstep, voffB);
        PG8_WAIT_V(6); PG8_BAR;
    }
    for (;;) {
        const bool has_next = S.next(ui + 1, nxt);
        const char* nA = has_next ? (const char*)g.A + (size_t)nxt.pm * tstep : cA; const char* nB = has_next ? (const char*)g.Bt + (size_t)nxt.pn * tstep : cB;
        for (int t = 0; t < nt; t += 2) {
            const bool last = (t == nt - 2);
            const char* a1 = cA + (size_t)(t + 1) * kstep;
            const char* a2 = last ? nA : cA + (size_t)(t + 2) * kstep; const char* b2 = last ? nB : cB + (size_t)(t + 2) * kstep;
            const char* a3 = a2 + kstep; const char* b3 = b2 + kstep;
            if (last && has_next) S.a_ready(nxt);
            if constexpr (SP2) {
            PG8_LDB(B0, 0, 0); PG8_LDB(B1, 0, 1); PG8_SCHED; PG8_LDA(At, 0, 0); PG8_STAGE(PG8_SA(1, 1), a1 + hstep, voffA);
            PG8_WAIT_V(8); PG8_WAIT_L(0); PG8_BAR; PG8_MMA(0, 0, At, B0); PG8_MMA(0, 1, At, B1); PG8_BAR; PG8_SCHED;
            PG8_LDA(At, 0, 1); PG8_STAGE(PG8_SB(0, 0), b2, voffB); PG8_STAGE(PG8_SB(0, 1), b2 + hstep, voffB); PG8_STAGE(PG8_SA(0, 0), a2, voffA);
            PG8_WAIT_V(8); PG8_WAIT_L(0); PG8_BAR; PG8_MMA(1, 0, At, B0); PG8_MMA(1, 1, At, B1); PG8_BAR; PG8_SCHED;
            PG8_LDB(B0, 1, 0); PG8_LDB(B1, 1, 1); PG8_SCHED; PG8_LDA(At, 1, 0); PG8_STAGE(PG8_SA(0, 1), a2 + hstep, voffA);
            PG8_WAIT_V(8); PG8_WAIT_L(0); PG8_BAR; PG8_MMA(0, 0, At, B0); PG8_MMA(0, 1, At, B1); PG8_BAR; PG8_SCHED;
            PG8_LDA(At, 1, 1); PG8_STAGE(PG8_SB(1, 0), b3, voffB); PG8_STAGE(PG8_SB(1, 1), b3 + hstep, voffB); PG8_STAGE(PG8_SA(1, 0), a3, voffA);
            PG8_WAIT_V(8); PG8_WAIT_L(0); PG8_BAR; PG8_MMA(1, 0, At, B0); PG8_MMA(1, 1, At, B1); PG8_BAR; PG8_SCHED;
            } else {
            PG8_LDB(B0, 0, 0); PG8_SCHED; PG8_LDA(At, 0, 0); PG8_STAGE(PG8_SA(1, 1), a1 + hstep, voffA);
            PG8_WAIT_L(8); PG8_BAR; PG8_WAIT_L(0); PG8_MMA(0, 0, At, B0); PG8_BAR; PG8_SCHED;
            PG8_LDB(B1, 0, 1); PG8_STAGE(PG8_SB(0, 0), b2, voffB);
            PG8_BAR; PG8_WAIT_L(0); PG8_MMA(0, 1, At, B1); PG8_BAR;
            PG8_LDA(At, 0, 1); PG8_STAGE(PG8_SA(0, 0), a2, voffA);
            PG8_BAR; PG8_WAIT_L(0); PG8_MMA(1, 0, At, B0); PG8_BAR; PG8_SCHED;
            PG8_STAGE(PG8_SB(0, 1), b2 + hstep, voffB);
            PG8_WAIT_V(6); PG8_BAR; PG8_MMA(1, 1, At, B1); PG8_BAR;
            PG8_LDB(B0, 1, 0); PG8_SCHED; PG8_LDA(At, 1, 0); PG8_STAGE(PG8_SA(0, 1), a2 + hstep, voffA);
            PG8_WAIT_L(8); PG8_BAR; PG8_WAIT_L(0); PG8_MMA(0, 0, At, B0); PG8_BAR; PG8_SCHED;
            PG8_LDB(B1, 1, 1); PG8_STAGE(PG8_SB(1, 0), b3, voffB);
            PG8_BAR; PG8_WAIT_L(0); PG8_MMA(0, 1, At, B1); PG8_BAR;
            PG8_LDA(At, 1, 1); PG8_STAGE(PG8_SA(1, 0), a3, voffA);
            PG8_BAR; PG8_WAIT_L(0); PG8_MMA(1, 0, At, B0); PG8_BAR; PG8_SCHED;
            PG8_STAGE(PG8_SB(1, 1), b3 + hstep, voffB);
            PG8_WAIT_V(6); PG8_BAR; PG8_MMA(1, 1, At, B1); PG8_BAR;
            }
        }
        if constexpr (ALIGN_EPI) { if (wr == 0) PG8_BAR; }
        if constexpr (!Epi::AFTER_DRAIN) { E(acc, cur, wr, wc, fr, fq); S.done(cur); }
        if (!has_next) break;
#pragma unroll
        for (int a = 0; a < 2; ++a)
#pragma unroll
            for (int b = 0; b < 2; ++b)
#pragma unroll
                for (int m = 0; m < 4; ++m)
#pragma unroll
                    for (int n = 0; n < 2; ++n) acc[a][b][m][n] = (f32x4){0.f, 0.f, 0.f, 0.f};
        cur = nxt; cA = nA; cB = nB; ++ui;
        if constexpr (ALIGN_EPI) { if (wr == 1) PG8_BAR; }
    }
    PG8_WAIT_V(0);
    if constexpr (!ALIGN_EPI) { if (wr == 0) PG8_BAR; }
    PG8_BAR;
    if constexpr (Epi::AFTER_DRAIN) { E.fused(acc, cur, wr, wc, fr, fq, lds, wid, lane); S.done(cur); }
#undef PG8_SA
#undef PG8_SB
#undef PG8_STAGE
#undef PG8_LDA
#undef PG8_LDB
#undef PG8_MMA
#undef PG8_WAIT_V
#undef PG8_WAIT_L
#undef PG8_BAR
#undef PG8_SCHED
}
}

constexpr int NWAVES = 8, NTHREADS = 512;
#ifndef MK_N_LAUNCHES
#define MK_N_LAUNCHES 1
#endif
constexpr int BATCH = 8, SEQ = 2048, D = 1024, FF = 4096, NH = 4, DK = 128, DV = 256, QKW = 512, VW = 1024;
constexpr int M = BATCH * SEQ, NPROJ = 3072, CH = 64, NCH = SEQ / CH;
constexpr int MLSTM_IN = 3080, GLA_IN = 3088;
constexpr float EPS = 1e-6f, QK_SCALE = 0.08838834764831845f, INV_TAU = 1.0f / 16.0f;

constexpr size_t MiB = 1u << 20;
constexpr size_t WS_CTL = 0, CTL_ZERO_BYTES = 64 * 1024;
constexpr size_t WS_GATES = 1 * MiB;
constexpr size_t WS_GDEC = 2 * MiB;
constexpr size_t WS_SUMSQ = 2 * MiB + 512 * 1024;
constexpr size_t WS_WIN = 4 * MiB, WS_WOUT = 10 * MiB, WS_W1 = 12 * MiB, WS_W2 = 20 * MiB, WS_WLAYER = 56 * MiB;
constexpr size_t WS_AOP = 28 * MiB;
constexpr size_t WS_PROJ = 92 * MiB;
constexpr size_t WS_QT = 188 * MiB, WS_KT = 204 * MiB;
constexpr size_t WS_HMID = 92 * MiB;
constexpr size_t WS_XRES = 220 * MiB;
constexpr size_t WS_END = 252 * MiB;
constexpr int CW_BAR = 1024, CW_XID = 8192;

constexpr int RING_BYTES = 131072, LDS_BYTES = 155648, LDSCTL_OFF = LDS_BYTES - 1024, MISC_OFF = LDSCTL_OFF + 320;

#define GAS __attribute__((address_space(1)))
#define LAS __attribute__((address_space(3)))
typedef unsigned short bf16;
typedef unsigned v4u __attribute__((ext_vector_type(4)));
typedef unsigned v2u __attribute__((ext_vector_type(2)));
typedef float f32x4 __attribute__((ext_vector_type(4)));
typedef float f32x16 __attribute__((ext_vector_type(16)));
typedef short bf16x8 __attribute__((ext_vector_type(8)));
typedef short s16x4 __attribute__((ext_vector_type(4)));
typedef GAS unsigned gu32;
#define RLX_AGENT __ATOMIC_RELAXED, __HIP_MEMORY_SCOPE_AGENT
#define LDS_WAIT() asm volatile("s_waitcnt lgkmcnt(0)" ::: "memory")
#define VM_WAIT() asm volatile("s_waitcnt vmcnt(0)" ::: "memory")
using pg8::pk_bf16;
__device__ __forceinline__ float bf2f(unsigned b) { return __uint_as_float(b << 16); }
__device__ __forceinline__ float bflo(unsigned w) { return __uint_as_float(w << 16); }
__device__ __forceinline__ float bfhi(unsigned w) { return __uint_as_float(w & 0xffff0000u); }
__device__ __forceinline__ unsigned short f2bf1(float f) { return (unsigned short)(pk_bf16(f, 0.f) & 0xffffu); }

struct Args { const float* in[15]; float* out; unsigned char* ws; int ph_lo, ph_hi; };
#define XB_TMO      128
#define XB_XCNT(j)  (256  + 64 * (j))
#define XB_XSUB(j)  (1280 + 64 * (j))
#define XB_XGEN(j)  (2304 + 64 * (j))
#define XB_TOP      3328
#define XB_TOPGEN   3392
#define XCD_BAR_WORDS 3456
#define XB_SPIN_CAP (1u << 18)
__device__ __forceinline__ unsigned xb_ld(unsigned* p)              { return __hip_atomic_load(p, __ATOMIC_RELAXED, __HIP_MEMORY_SCOPE_AGENT); }
__device__ __forceinline__ unsigned xb_add(unsigned* p, unsigned v) { return __hip_atomic_fetch_add(p, v, __ATOMIC_RELAXED, __HIP_MEMORY_SCOPE_AGENT); }
__device__ __forceinline__ unsigned xb_xcc_id() { return (unsigned)__builtin_amdgcn_s_getreg((3 << 11) | 20) & 0xFu; }
#define XB_SPIN(cond, bar) do { unsigned _sp = 0; while (cond) { __builtin_amdgcn_s_sleep(1); \
    if ((++_sp & 255u) == 0u) { if (xb_ld(&(bar)[XB_TMO])) break; if (_sp > XB_SPIN_CAP) { atomicAdd(&(bar)[XB_TMO], 1u); break; } } } } while (0)
struct XcdBarrier { unsigned* bar; unsigned x; volatile LAS unsigned* st; };
__device__ __forceinline__ XcdBarrier xcd_barrier_post(unsigned* bar, volatile LAS unsigned* st) {
    XcdBarrier b; b.bar = bar; b.x = xb_xcc_id(); b.st = st;
    if (threadIdx.x == 0) (void)xb_add(&bar[XB_XCNT(b.x)], 1u);
    return b;
}
__device__ __forceinline__ void xcd_barrier_complete(unsigned* bar, unsigned x, unsigned& nloc, unsigned& nx) {
    const unsigned G = gridDim.x * gridDim.y * gridDim.z;
    unsigned sum, cnt, mine, sp = 0u;
    for (;;) {
        sum = 0u; cnt = 0u; mine = 0u;
#pragma unroll
        for (unsigned j = 0; j < 16; ++j) { const unsigned c = xb_ld(&bar[XB_XCNT(j)]); sum += c; cnt += (c > 0u) ? 1u : 0u; mine = (j == x) ? c : mine; }
        if (sum == G) break;
        __builtin_amdgcn_s_sleep(1);
        if ((++sp & 255u) == 0u) { if (xb_ld(&bar[XB_TMO])) break; if (sp > XB_SPIN_CAP) { atomicAdd(&bar[XB_TMO], 1u); break; } }
    }
    nloc = mine > 0u ? mine : 1u; nx = cnt > 0u ? cnt : 1u;
}
__device__ __forceinline__ void xcd_barrier(const XcdBarrier& b) {
    asm volatile("s_waitcnt vmcnt(0)" ::: "memory");
    __syncthreads();
    if (threadIdx.x == 0) {
        unsigned* bar = b.bar;
        __builtin_amdgcn_s_waitcnt(0);
        unsigned nloc = b.st[0], nx = b.st[1];
        if (nloc == 0u) { xcd_barrier_complete(bar, b.x, nloc, nx); b.st[0] = nloc; b.st[1] = nx; }
        const unsigned old = xb_add(&bar[XB_XSUB(b.x)], 1u);
        const unsigned gen = old / nloc;
        if (old + 1u == (gen + 1u) * nloc) {
            __builtin_amdgcn_fence(__ATOMIC_RELEASE, "agent");
            asm volatile("s_waitcnt vmcnt(0)" ::: "memory");
            const unsigned og = xb_add(&bar[XB_TOP], 1u);
            const unsigned tg = og / nx;
            if (og + 1u == (tg + 1u) * nx) xb_add(&bar[XB_TOPGEN], 1u);
            else XB_SPIN(xb_ld(&bar[XB_TOPGEN]) == tg, bar);
            __builtin_amdgcn_fence(__ATOMIC_ACQUIRE, "agent");
            xb_add(&bar[XB_XGEN(b.x)], 1u);
            asm volatile("s_waitcnt vmcnt(0)" ::: "memory");
        } else {
            XB_SPIN(xb_ld(&bar[XB_XGEN(b.x)]) == gen, bar);
            __builtin_amdgcn_fence(__ATOMIC_ACQUIRE, "agent");
            asm volatile("s_waitcnt vmcnt(0)" ::: "memory");
        }
    }
    __syncthreads();
}

__device__ __forceinline__ float wave_sum(float v) {
#pragma unroll
    for (int o = 1; o < 64; o <<= 1) v += __shfl_xor(v, o);
    return v;
}
__device__ __forceinline__ void transpose_item(const float* W, int K, int N, int ldw, bf16* WT, const float* gain, LAS float* scr, int item, int lane) {
    const int nblk = N / 32, kb = item / nblk, nb = item % nblk, k0 = 64 * kb, n0 = 32 * nb;
    const int n4 = (lane & 7) * 4, krow = lane >> 3;
    f32x4 v[8];
#pragma unroll
    for (int i = 0; i < 8; ++i) v[i] = *(const f32x4*)(W + (size_t)(k0 + 8 * i + krow) * ldw + n0 + n4);
#pragma unroll
    for (int i = 0; i < 8; ++i) *(LAS f32x4*)(scr + (8 * i + krow) * 32 + (n4 ^ (i << 2))) = v[i];
    const int c = lane & 7, nl = lane >> 3;
    f32x4 g0 = {1.f, 1.f, 1.f, 1.f}, g1 = {1.f, 1.f, 1.f, 1.f};
    if (gain) { g0 = *(const f32x4*)(gain + k0 + 8 * c); g1 = *(const f32x4*)(gain + k0 + 8 * c + 4); }
    LDS_WAIT(); asm volatile("" ::: "memory");
#pragma unroll
    for (int j = 0; j < 4; ++j) { const int n = 8 * j + nl; const LAS float* sp = scr + (8 * c) * 32 + (n ^ (c << 2));
        v4u o; o.x = pk_bf16(sp[0 * 32] * g0.x, sp[1 * 32] * g0.y); o.y = pk_bf16(sp[2 * 32] * g0.z, sp[3 * 32] * g0.w); o.z = pk_bf16(sp[4 * 32] * g1.x, sp[5 * 32] * g1.y); o.w = pk_bf16(sp[6 * 32] * g1.z, sp[7 * 32] * g1.w);
        *(GAS v4u*)(WT + (size_t)(n0 + n) * K + k0 + 8 * c) = o; }
    LDS_WAIT(); asm volatile("" ::: "memory");
}
__device__ __forceinline__ void convert_weights(LAS unsigned char* lds, int lane, int wave, int vcu, int G, const Args& args, unsigned char* ws) {
    LAS float* scr = (LAS float*)(lds + wave * 16384);
    const int gw = vcu * NWAVES + wave, NGW = G * NWAVES;
    constexpr int I_IN = (D / 64) * (NPROJ / 32), I_O = (D / 64) * (D / 32), I_1 = (D / 64) * (FF / 32), I_2 = (FF / 64) * (D / 32);
    constexpr int NITEMS = I_IN + I_O + I_1 + I_2;
    for (int it = gw; it < 2 * NITEMS; it += NGW) {
        const int layer = it >= NITEMS; int r = it - layer * NITEMS;
        unsigned char* wl = ws + (size_t)layer * WS_WLAYER;
        if (r < I_IN) { transpose_item(args.in[layer ? 8 : 4], D, NPROJ, layer ? GLA_IN : MLSTM_IN, (bf16*)(wl + WS_WIN), args.in[1] + layer * D, scr, r, lane); continue; } r -= I_IN;
        if (r < I_O) { transpose_item(args.in[layer ? 12 : 7], D, D, D, (bf16*)(wl + WS_WOUT), nullptr, scr, r, lane); continue; } r -= I_O;
        if (r < I_1) { transpose_item(args.in[13] + (size_t)layer * D * FF, D, FF, FF, (bf16*)(wl + WS_W1), args.in[2] + layer * D, scr, r, lane); continue; } r -= I_1;
        transpose_item(args.in[14] + (size_t)layer * D * FF, FF, D, D, (bf16*)(wl + WS_W2), nullptr, scr, r, lane);
    }
}

__device__ __forceinline__ void rows_first(LAS unsigned char* lds, int tid, int lane, int wave, int vcu, int G, const float* xin, const float* gain, bf16* xres, float* sumsq,
                                           const float* wg, int ldw, int ng, float* gates) {
    LAS float* WgT = (LAS float*)lds;
    __syncthreads();
    for (int i = tid; i < 16 * D; i += NTHREADS) { const int k = i >> 4, c = i & 15; WgT[c * D + k] = (c < ng) ? wg[(size_t)k * ldw + c] : 0.f; }
    __syncthreads();
    const int gw = vcu * NWAVES + wave, NGW = G * NWAVES;
    f32x4 gn[4];
#pragma unroll
    for (int j = 0; j < 4; ++j) gn[j] = *(const f32x4*)(gain + 4 * lane + 256 * j);
    for (int m = gw; m < M; m += NGW) {
        const float* xr = xin + (size_t)m * D + 4 * lane;
        f32x4 v[4]; float s = 0.f;
#pragma unroll
        for (int j = 0; j < 4; ++j) { v[j] = *(const f32x4*)(xr + 256 * j); s += (v[j].x * v[j].x + v[j].y * v[j].y) + (v[j].z * v[j].z + v[j].w * v[j].w); }
#pragma unroll
        for (int j = 0; j < 4; ++j) { v2u o; o.x = pk_bf16(v[j].x, v[j].y); o.y = pk_bf16(v[j].z, v[j].w); *(v2u*)(xres + (size_t)m * D + 4 * lane + 256 * j) = o; }
        const float ssum = wave_sum(s);
        if (lane == 0) *(f32x4*)(sumsq + (size_t)m * 4) = (f32x4){ssum, 0.f, 0.f, 0.f};
        const float rstd = 1.0f / sqrtf(ssum * (1.f / D) + EPS);
#pragma unroll
        for (int j = 0; j < 4; ++j) v[j] = v[j] * rstd * gn[j];
        float a[16];
#pragma unroll
        for (int c = 0; c < 16; ++c) a[c] = 0.f;
#pragma unroll
        for (int c = 0; c < 16; ++c) {
#pragma unroll
            for (int j = 0; j < 4; ++j) { const f32x4 w = *(const LAS f32x4*)(WgT + c * D + 4 * lane + 256 * j); a[c] += (v[j].x * w.x + v[j].y * w.y) + (v[j].z * w.z + v[j].w * w.w); }
            if (c & 1) asm volatile("" ::: "memory"); }
        const bool b5 = lane & 32, b4 = lane & 16, b3 = lane & 8, b2 = lane & 4;
#pragma unroll
        for (int i = 0; i < 8; ++i) { const float keep = b5 ? a[i + 8] : a[i], send = b5 ? a[i] : a[i + 8]; a[i] = keep + __shfl_xor(send, 32); }
#pragma unroll
        for (int i = 0; i < 4; ++i) { const float keep = b4 ? a[i + 4] : a[i], send = b4 ? a[i] : a[i + 4]; a[i] = keep + __shfl_xor(send, 16); }
#pragma unroll
        for (int i = 0; i < 2; ++i) { const float keep = b3 ? a[i + 2] : a[i], send = b3 ? a[i] : a[i + 2]; a[i] = keep + __shfl_xor(send, 8); }
        { const float keep = b2 ? a[1] : a[0], send = b2 ? a[0] : a[1]; a[0] = keep + __shfl_xor(send, 4); }
        a[0] += __shfl_xor(a[0], 2); a[0] += __shfl_xor(a[0], 1);
        const int c = (b5 ? 8 : 0) + (b4 ? 4 : 0) + (b3 ? 2 : 0) + (b2 ? 1 : 0);
        if ((lane & 3) == 0 && c < ng) gates[(size_t)m * 16 + c] = a[0];
    }
}
__device__ __forceinline__ void rows_final(int lane, int wave, int vcu, int G, const bf16* xres, const float* gain, float* out) {
    const int gw = vcu * NWAVES + wave, NGW = G * NWAVES;
    for (int m = gw; m < M; m += NGW) {
        float f[2][8]; float ss = 0.f;
#pragma unroll
        for (int j = 0; j < 2; ++j) { const v4u hv = *(const v4u*)(xres + (size_t)m * D + 8 * lane + 512 * j);
            f[j][0] = bflo(hv.x); f[j][1] = bfhi(hv.x); f[j][2] = bflo(hv.y); f[j][3] = bfhi(hv.y); f[j][4] = bflo(hv.z); f[j][5] = bfhi(hv.z); f[j][6] = bflo(hv.w); f[j][7] = bfhi(hv.w);
#pragma unroll
            for (int e = 0; e < 8; ++e) ss += f[j][e] * f[j][e]; }
        const float rstd = 1.0f / sqrtf(wave_sum(ss) * (1.f / D) + EPS);
#pragma unroll
        for (int j = 0; j < 2; ++j) { const int col = 8 * lane + 512 * j; const f32x4 g0 = *(const f32x4*)(gain + col), g1 = *(const f32x4*)(gain + col + 4);
            *(f32x4*)(out + (size_t)m * D + col) = (f32x4){f[j][0] * rstd * g0.x, f[j][1] * rstd * g0.y, f[j][2] * rstd * g0.z, f[j][3] * rstd * g0.w};
            *(f32x4*)(out + (size_t)m * D + col + 4) = (f32x4){f[j][4] * rstd * g1.x, f[j][5] * rstd * g1.y, f[j][6] * rstd * g1.z, f[j][7] * rstd * g1.w}; }
    }
}
struct RstdSlots { int pm0, pm1, pm2, pm3; };
__device__ __forceinline__ RstdSlots rstd_table(LAS float* rt, const float* sumsq, const pg8::StaticOrder& S, int tid) {
    int pmv[4] = {-1, -1, -1, -1}; int ns = 0;
    pg8::Unit u;
    for (int i = 0; S.next(i, u); ++i) { if (u.pm != pmv[0] && u.pm != pmv[1] && u.pm != pmv[2] && u.pm != pmv[3] && ns < 4) { if (ns == 0) pmv[0] = u.pm; else if (ns == 1) pmv[1] = u.pm; else if (ns == 2) pmv[2] = u.pm; else pmv[3] = u.pm; ++ns; } }
#pragma unroll
    for (int sl = 0; sl < 4; ++sl) { const int pm = sl == 0 ? pmv[0] : sl == 1 ? pmv[1] : sl == 2 ? pmv[2] : pmv[3];
        if (pm >= 0 && tid < 256) { const f32x4 s4 = *(const f32x4*)(sumsq + (size_t)(pm * 256 + tid) * 4); rt[sl * 256 + tid] = 1.0f / sqrtf(((s4.x + s4.y) + (s4.z + s4.w)) * (1.f / D) + EPS); } }
    __syncthreads();
    return RstdSlots{pmv[0], pmv[1], pmv[2], pmv[3]};
}

__device__ __forceinline__ void head_norm_rows(int lane, int wave, int vcu, int G, const bf16* hun, const float* gout, const bf16* proj, bf16* aop, const bool GLA) {
    const int gw = vcu * NWAVES + wave, NGW = G * NWAVES;
    for (int m = gw; m < M; m += NGW) {
#pragma unroll
        for (int j = 0; j < 2; ++j) {
            const int col = 8 * lane + 512 * j;
            const v4u hv = *(const v4u*)(hun + (size_t)m * D + col);
            const v4u rv = *(const v4u*)(proj + (size_t)m * NPROJ + 2048 + col);
            float f[8] = {bflo(hv.x), bfhi(hv.x), bflo(hv.y), bfhi(hv.y), bflo(hv.z), bfhi(hv.z), bflo(hv.w), bfhi(hv.w)};
            const float r[8] = {bflo(rv.x), bfhi(rv.x), bflo(rv.y), bfhi(rv.y), bflo(rv.z), bfhi(rv.z), bflo(rv.w), bfhi(rv.w)};
            float sg[8];
#pragma unroll
            for (int e = 0; e < 8; ++e) sg[e] = __builtin_amdgcn_rcpf(1.0f + __expf(-r[e]));
            if (!GLA) {
#pragma unroll
                for (int e = 0; e < 8; ++e) f[e] *= sg[e];
            }
            float ss = 0.f;
#pragma unroll
            for (int e = 0; e < 8; ++e) ss += f[e] * f[e];
#pragma unroll
            for (int o = 1; o < 32; o <<= 1) ss += __shfl_xor(ss, o);
            const float rs = 1.0f / sqrtf(ss * (1.f / DV) + EPS);
            const f32x4 g0 = *(const f32x4*)(gout + col), g1 = *(const f32x4*)(gout + col + 4);
            const float gg[8] = {g0.x, g0.y, g0.z, g0.w, g1.x, g1.y, g1.z, g1.w};
#pragma unroll
            for (int e = 0; e < 8; ++e) f[e] = f[e] * rs * gg[e];
            if (GLA) {
#pragma unroll
                for (int e = 0; e < 8; ++e) f[e] *= r[e] * sg[e];
            }
            v4u o; o.x = pk_bf16(f[0], f[1]); o.y = pk_bf16(f[2], f[3]); o.z = pk_bf16(f[4], f[5]); o.w = pk_bf16(f[6], f[7]);
            *(v4u*)(aop + (size_t)m * D + col) = o;
        }
    }
}

constexpr int GP_WGT = 0, GP_WGT_PITCH = 2064, GP_ZL = 33024, GP_TOT = 41216, GP_Q = 43264, GP_K = 59648;
__device__ __forceinline__ void gla_prep(LAS unsigned char* lds, int tid, int lane, int wave, int vcu, int G, const bf16* proj, const bf16* xres, const float* sumsq, const float* w_in, const float* gmix,
                                         const float* wup, const float* bgate, bf16* QT, bf16* KT, float* gdec) {
    LAS float* zl = (LAS float*)(lds + GP_ZL);
    LAS float* tot = (LAS float*)(lds + GP_TOT);
    LAS unsigned short* tq = (LAS unsigned short*)(lds + GP_Q);
    LAS unsigned short* tk = (LAS unsigned short*)(lds + GP_K);
    __syncthreads();
    for (int i = tid; i < 16 * D; i += NTHREADS) { const int k = i >> 4, c = i & 15; *(LAS unsigned short*)(lds + GP_WGT + c * GP_WGT_PITCH + k * 2) = f2bf1(gmix[k] * w_in[(size_t)k * GLA_IN + NPROJ + c]); }
    const int d = tid & 127, rg = tid >> 7;
    for (int unit = vcu; unit < BATCH * NCH; unit += G) {
        const int b = unit / NCH, c = unit % NCH, tok0 = b * SEQ + c * CH;
        v4u pq[2], pk[2]; float wu[16]; float bg;
#define GP_LOAD(h_) do { _Pragma("unroll") for (int i_ = 0; i_ < 2; ++i_) { const int p_ = tid + NTHREADS * i_, row_ = p_ >> 4, ch_ = p_ & 15; \
            pq[i_] = *(const v4u*)(proj + (size_t)(tok0 + row_) * NPROJ + (h_) * DK + ch_ * 8); pk[i_] = *(const v4u*)(proj + (size_t)(tok0 + row_) * NPROJ + QKW + (h_) * DK + ch_ * 8); } \
            _Pragma("unroll") for (int cc_ = 0; cc_ < 16; ++cc_) wu[cc_] = wup[cc_ * QKW + (h_) * DK + d]; bg = bgate[(h_) * DK + d]; } while (0)
        GP_LOAD(0);
        __syncthreads();
        {
            const int rt = wave & 3, kh = wave >> 2, r16 = lane & 15, kq = lane >> 4;
            pg8::f32x4 acc = {0.f, 0.f, 0.f, 0.f};
            const bf16* xr = xres + (size_t)(tok0 + 16 * rt + r16) * D + kh * 512 + 8 * kq;
            LAS unsigned char* wr_ = lds + GP_WGT + r16 * GP_WGT_PITCH + (kh * 512 + 8 * kq) * 2;
#pragma unroll
            for (int ks = 0; ks < 16; ++ks) { const bf16x8 av = *(const bf16x8*)(xr + 32 * ks), bv = *(const LAS bf16x8*)(wr_ + 64 * ks); acc = __builtin_amdgcn_mfma_f32_16x16x32_bf16(av, bv, acc, 0, 0, 0); }
#pragma unroll
            for (int i = 0; i < 4; ++i) zl[kh * 1024 + (16 * rt + 4 * kq + i) * 16 + r16] = acc[i];
        }
        __syncthreads();
        { const int row = tid >> 3, c2 = (tid & 7) * 2;
          const f32x4 s4 = *(const f32x4*)(sumsq + (size_t)(tok0 + row) * 4); const float rstd = 1.0f / sqrtf(((s4.x + s4.y) + (s4.z + s4.w)) * (1.f / D) + EPS);
          const float z0 = (zl[row * 16 + c2] + zl[1024 + row * 16 + c2]) * rstd, z1 = (zl[row * 16 + c2 + 1] + zl[1024 + row * 16 + c2 + 1]) * rstd;
          __syncthreads();
          zl[row * 16 + c2] = z0; zl[row * 16 + c2 + 1] = z1; }
        __syncthreads();
#pragma unroll
        for (int h = 0; h < NH; ++h) {
#pragma unroll
            for (int i = 0; i < 2; ++i) { const int p = tid + NTHREADS * i; *(LAS v4u*)(lds + GP_Q + p * 16) = pq[i]; *(LAS v4u*)(lds + GP_K + p * 16) = pk[i]; }
            float wuh[16]; const float bgh = bg;
#pragma unroll
            for (int cc = 0; cc < 16; ++cc) wuh[cc] = wu[cc];
            if (h + 1 < NH) GP_LOAD(h + 1);
            float bcum[16]; float run = 0.f;
#pragma unroll
            for (int jj = 0; jj < 16; ++jj) {
                const int j = 16 * rg + jj; float z = bgh;
#pragma unroll
                for (int q4 = 0; q4 < 4; ++q4) { const f32x4 zz = *(const LAS f32x4*)(zl + j * 16 + 4 * q4); z += (zz.x * wuh[4 * q4] + zz.y * wuh[4 * q4 + 1]) + (zz.z * wuh[4 * q4 + 2] + zz.w * wuh[4 * q4 + 3]); }
                const float la = (fminf(z, 0.f) - __logf(1.0f + __expf(-fabsf(z)))) * INV_TAU;
                run += la; bcum[jj] = run;
            }
            tot[rg * 128 + d] = run;
            __syncthreads();
            float off = 0.f, g = 0.f;
#pragma unroll
            for (int r2 = 0; r2 < 4; ++r2) { const float t = tot[r2 * 128 + d]; g += t; off += (r2 < rg) ? t : 0.f; }
#pragma unroll
            for (int jj = 0; jj < 16; ++jj) {
                const int j = 16 * rg + jj; const float eb = __expf(bcum[jj] + off);
                const float q = bf2f(tq[j * 128 + d]), k = bf2f(tk[j * 128 + d]);
                tq[j * 128 + d] = f2bf1(q * QK_SCALE * eb); tk[j * 128 + d] = f2bf1(k * __builtin_amdgcn_rcpf(eb));
            }
            if (rg == 0) gdec[(size_t)(unit * NH + h) * DK + d] = __expf(g);
            __syncthreads();
#pragma unroll
            for (int i = 0; i < 2; ++i) { const int p = tid + NTHREADS * i, row = p >> 4, ch = p & 15;
                *(v4u*)(QT + (size_t)(tok0 + row) * QKW + h * DK + ch * 8) = *(const LAS v4u*)(lds + GP_Q + p * 16);
                *(v4u*)(KT + (size_t)(tok0 + row) * QKW + h * DK + ch * 8) = *(const LAS v4u*)(lds + GP_K + p * 16); }
            __syncthreads();
        }
#undef GP_LOAD
    }
    __syncthreads();
}

#ifndef PROBE_T
#define PROBE_T 0
#endif
#ifndef PROBE_T_MLSTM
#define PROBE_T_MLSTM 0
#endif
#ifndef PROBE_T_WAVE
#define PROBE_T_WAVE 0
#endif
#ifndef PROBE_T_A
#define PROBE_T_A 5
#endif
#ifndef PROBE_T_B
#define PROBE_T_B 0
#endif
constexpr int CW_PROBE = 12288;
__device__ __forceinline__ unsigned long long pt_now() { unsigned long long t; __builtin_amdgcn_sched_barrier(0); asm volatile("s_memrealtime %0\n\ts_waitcnt lgkmcnt(0)" : "=s"(t) :: "memory"); __builtin_amdgcn_sched_barrier(0); return t; }
#define PT_NOW() pt_now()
#define PT_ACC(i, t0) do { if (PROBE_T) { const unsigned long long t1_ = PT_NOW(); pt[i] += (unsigned)(t1_ - (t0)); (t0) = t1_; } } while (0)
constexpr int PS_PITCH = 144, CT_PITCH = 272, CT_BYTES = 32 * CT_PITCH, IMG_PITCH = 272, IMG_BYTES = 64 * IMG_PITCH, NUM_PITCH = 36;
template <bool MLSTM> struct MxMap;
template <> struct MxMap<true>  { static constexpr int QS = 0, KS = 34816, V = 69632, VW = 77824, VWAUX = 81920, PS = 86016, CT = 95232, TB = 112640, TWP = 120832, TPM = 129024, TSC = 137216, DEN = 137728, NUM = 138240, OUTT = 0, GDEC = 0, END = 147456; };
template <> struct MxMap<false> { static constexpr int QS = 0, KS = 34816, V = 69632, VW = 0, VWAUX = 0, PS = 77824, CT = 87040, TB = 0, TWP = 0, TPM = 0, TSC = 0, DEN = 0, NUM = 0, OUTT = 104448, GDEC = 108544, END = 109568; };
#define LDSA(p) ((unsigned)(size_t)(p))
__device__ __forceinline__ bf16x8 mk8(v2u lo, v2u hi) { v4u w; w.x = lo.x; w.y = lo.y; w.z = hi.x; w.w = hi.y; return __builtin_bit_cast(bf16x8, w); }
__device__ __forceinline__ void tr_read2(bf16x8& f0, bf16x8& f1, unsigned a0, unsigned a1, unsigned b0, unsigned b1) {
    v2u l0, h0, l1, h1;
    asm volatile("ds_read_b64_tr_b16 %0, %4\n\tds_read_b64_tr_b16 %1, %5\n\tds_read_b64_tr_b16 %2, %6\n\tds_read_b64_tr_b16 %3, %7\n\ts_waitcnt lgkmcnt(0)"
                 : "=&v"(l0), "=&v"(h0), "=&v"(l1), "=&v"(h1) : "v"(a0), "v"(a1), "v"(b0), "v"(b1) : "memory");
    f0 = mk8(l0, h0); f1 = mk8(l1, h1);
}
__device__ __forceinline__ void tr_read3(bf16x8& f0, bf16x8& f1, bf16x8& f2, unsigned a0, unsigned a1, unsigned b0, unsigned b1, unsigned c0, unsigned c1) {
    v2u l0, h0, l1, h1, l2, h2;
    asm volatile("ds_read_b64_tr_b16 %0, %6\n\tds_read_b64_tr_b16 %1, %7\n\tds_read_b64_tr_b16 %2, %8\n\tds_read_b64_tr_b16 %3, %9\n\tds_read_b64_tr_b16 %4, %10\n\tds_read_b64_tr_b16 %5, %11\n\ts_waitcnt lgkmcnt(0)"
                 : "=&v"(l0), "=&v"(h0), "=&v"(l1), "=&v"(h1), "=&v"(l2), "=&v"(h2) : "v"(a0), "v"(a1), "v"(b0), "v"(b1), "v"(c0), "v"(c1) : "memory");
    f0 = mk8(l0, h0); f1 = mk8(l1, h1); f2 = mk8(l2, h2);
}
__device__ __forceinline__ bf16x8 tr_read1(unsigned a0, unsigned a1) {
    v2u l0, h0;
    asm volatile("ds_read_b64_tr_b16 %0, %2\n\tds_read_b64_tr_b16 %1, %3\n\ts_waitcnt lgkmcnt(0)" : "=&v"(l0), "=&v"(h0) : "v"(a0), "v"(a1) : "memory");
    return mk8(l0, h0);
}
#define MFMA32(a, b, c) __builtin_amdgcn_mfma_f32_32x32x16_bf16((a), (b), (c), 0, 0, 0)
#define MX_BAR() do { asm volatile("s_waitcnt lgkmcnt(0)" ::: "memory"); __builtin_amdgcn_s_barrier(); asm volatile("" ::: "memory"); } while (0)
#define MX_BAR_VM() do { asm volatile("s_waitcnt vmcnt(0) lgkmcnt(0)" ::: "memory"); __builtin_amdgcn_s_barrier(); asm volatile("" ::: "memory"); } while (0)
struct MixArgs { const bf16 *q, *k, *proj; int qpitch; const float *gates, *bgate, *gdec; bf16* hun; void* probe; };
struct MixUnit { const bf16 *Qg, *Kg, *Vg; bf16* Hg; const float* gdec; int qpitch, b, hh; };
constexpr int MX_NPIECE = 38, MX_PPW = 5;
struct MixDma { unsigned voff[MX_PPW]; };

__device__ __forceinline__ void mx_dma_setup(MixDma& dm, int wave, int lane, int qpitch) {
#pragma unroll
    for (int i = 0; i < MX_PPW; ++i) { const int pi = wave + 8 * i; unsigned v = 0;
        if (pi < 34) { const int ob = (pi < 17 ? pi : pi - 17) * 1024 + lane * 16, row = ob / IMG_PITCH; int cb = ob - row * IMG_PITCH; cb = cb < 256 ? cb : 240; v = (unsigned)(row * qpitch * 2 + cb); }
        else { const int ob = (pi - 34) * 1024 + lane * 16, row = ob >> 6, cb = ob & 63; v = (unsigned)(row * NPROJ * 2 + cb); }
        dm.voff[i] = v; }
}
template <bool MLSTM>
__device__ __forceinline__ void mx_dma_issue(LAS unsigned char* lds, const MixDma& dm, const MixUnit& U, int c, int wave, int tid) {
    typedef MxMap<MLSTM> MP;
    const int par = c & 1; const size_t tok0 = (size_t)U.b * SEQ + c * CH;
    const char* qb = (const char*)(U.Qg + tok0 * U.qpitch); const char* kb = (const char*)(U.Kg + tok0 * U.qpitch); const char* vb = (const char*)(U.Vg + tok0 * NPROJ);
#pragma unroll
    for (int i = 0; i < MX_PPW; ++i) { const int pi = wave + 8 * i;
        if (pi < MX_NPIECE) {
            const char* src; int dst;
            if (pi < 17) { src = qb; dst = MP::QS + par * IMG_BYTES + pi * 1024; }
            else if (pi < 34) { src = kb; dst = MP::KS + par * IMG_BYTES + (pi - 17) * 1024; }
            else { src = vb; dst = MP::V + par * 4096 + (pi - 34) * 1024; }
            __builtin_amdgcn_global_load_lds((const unsigned*)(src + dm.voff[i]), (LAS unsigned*)(lds + dst), 16, 0, 0);
        } }
    if (!MLSTM && wave == 7) {
        const float* gd = U.gdec + (size_t)(((U.b * NCH + c) * NH) + U.hh) * DK + (tid & 63);
        __builtin_amdgcn_global_load_lds((const unsigned*)gd, (LAS unsigned*)(lds + MP::GDEC + par * 512), 4, 0, 0);
        __builtin_amdgcn_global_load_lds((const unsigned*)(gd + 64), (LAS unsigned*)(lds + MP::GDEC + par * 512 + 256), 4, 0, 0);
    }
}
__device__ __forceinline__ void mx_store_tile(LAS unsigned char* outt, const f32x16& val, bf16* grow  , int lane, int r, int h5) {
#pragma unroll
    for (int i = 0; i < 16; ++i) *(LAS unsigned short*)(outt + ((i & 3) + 8 * (i >> 2) + 4 * h5) * 64 + r * 2) = f2bf1(val[i]);
#pragma unroll
    for (int i = 0; i < 2; ++i) { const int id = lane + 64 * i, row = id >> 2, pc = id & 3; const v4u w = *(const LAS v4u*)(outt + row * 64 + pc * 16); *(v4u*)(grow + (size_t)row * D + pc * 8) = w; }
}
__device__ __forceinline__ void mx_finalize_mlstm(LAS unsigned char* lds, const MixUnit& U, int cf, int fl) {
    typedef MxMap<true> MP;
    const int j = fl >> 2, sg = fl & 3; const float mc = ((const LAS float*)(lds + MP::TSC))[cf];
    const float dn = ((const LAS float*)(lds + MP::DEN))[j], bb = ((const LAS float*)(lds + MP::TB))[cf * 64 + j], pm = ((const LAS float*)(lds + MP::TPM))[cf * 64 + j];
    const float rden = QK_SCALE * __builtin_amdgcn_rcpf(fmaxf(fabsf(dn) * QK_SCALE, __expf(-bb - fmaxf(mc, pm))));
    const f32x4 n0 = *(const LAS f32x4*)((const LAS float*)(lds + MP::NUM) + j * NUM_PITCH + 8 * sg) * rden, n1 = *(const LAS f32x4*)((const LAS float*)(lds + MP::NUM) + j * NUM_PITCH + 8 * sg + 4) * rden;
    v4u w; w.x = pk_bf16(n0.x, n0.y); w.y = pk_bf16(n0.z, n0.w); w.z = pk_bf16(n1.x, n1.y); w.w = pk_bf16(n1.z, n1.w);
    *(v4u*)(U.Hg + (size_t)(U.b * SEQ + cf * CH + j) * D + 8 * sg) = w;
}

template <bool MLSTM>
__device__ __forceinline__ void mx_step(LAS unsigned char* lds, const MixDma& dm, const MixUnit& U, int c, f32x16& accC0, f32x16& accC1, f32x16& accO, int tid, int lane, int wave, unsigned (&pt)[8]) {
    typedef MxMap<MLSTM> MP;
    unsigned long long tp = PROBE_T ? PT_NOW() : 0ull;
    const int r = lane & 31, h5 = lane >> 5, blk = (lane >> 4) & 1, q4 = (lane & 15) >> 2, p4 = lane & 3, par = c & 1;
    const LAS float* TSC = (const LAS float*)(lds + MP::TSC);
    LAS unsigned char* qimg0 = lds + MP::QS + par * IMG_BYTES; LAS unsigned char* kimg0 = lds + MP::KS + par * IMG_BYTES; LAS unsigned char* vimg0 = lds + MP::V + par * 4096;
    if (c + 1 < NCH) mx_dma_issue<MLSTM>(lds, dm, U, c + 1, wave, tid);
    PT_ACC(6, tp);
    const float mc = MLSTM ? TSC[c] : 0.f;
    if (wave < 4) {
        const int st = wave >> 1, jt = (wave == 1 || wave == 2) ? 1 : 0;
#pragma unroll
        for (int i = 0; i < 16; ++i) accO[i] = 0.f;
        if (wave != 3) {
            LAS unsigned char* kimg = kimg0 + (32 * st + r) * IMG_PITCH + 16 * h5;
            LAS unsigned char* qimg = qimg0 + (32 * jt + r) * IMG_PITCH + 16 * h5;
#pragma unroll
            for (int ks = 0; ks < 8; ++ks) { const bf16x8 a = *(const LAS bf16x8*)(kimg + 32 * ks), bq = *(const LAS bf16x8*)(qimg + 32 * ks); accO = MFMA32(a, bq, accO); }
        }
        const int j = 32 * jt + r; float uj = 0.f;
        if (MLSTM) uj = -fmaxf(mc, ((const LAS float*)(lds + MP::TPM))[c * 64 + j]);
#pragma unroll
        for (int g4 = 0; g4 < 4; ++g4) { const int s0 = 32 * st + 8 * g4 + 4 * h5; f32x4 wps = {0.f, 0.f, 0.f, 0.f}; if (MLSTM) wps = *(const LAS f32x4*)((const LAS float*)(lds + MP::TWP) + c * 64 + s0);
            float v[4];
#pragma unroll
            for (int e = 0; e < 4; ++e) { float x = accO[4 * g4 + e]; if (MLSTM) x *= __expf(uj + wps[e]); v[e] = (s0 + e <= j) ? x : 0.f; }
            v2u o; o.x = pk_bf16(v[0], v[1]); o.y = pk_bf16(v[2], v[3]); *(LAS v2u*)(lds + MP::PS + j * PS_PITCH + s0 * 2) = o; }
    } else {
        const int g = (wave - 4) >> 1, jt = wave & 1;
        if (MLSTM) {
            if (c > 0) mx_finalize_mlstm(lds, U, c - 1, tid - 256);
            { const int fl = tid - 256, row = fl >> 2, pc = fl & 3;
              const float wr_ = __expf(((const LAS float*)(lds + MP::TWP))[c * 64 + row] - TSC[32 + c]); const v4u pv = *(const LAS v4u*)(vimg0 + row * 64 + pc * 16); v4u o;
              o.x = pk_bf16(bflo(pv.x) * wr_, bfhi(pv.x) * wr_); o.y = pk_bf16(bflo(pv.y) * wr_, bfhi(pv.y) * wr_); o.z = pk_bf16(bflo(pv.z) * wr_, bfhi(pv.z) * wr_); o.w = pk_bf16(bflo(pv.w) * wr_, bfhi(pv.w) * wr_);
              *(LAS v4u*)(lds + MP::VW + row * 64 + pc * 16) = o;
              if (pc == 0) *(LAS unsigned short*)(lds + MP::VWAUX + row * 64) = f2bf1(wr_); }
        }
        if (MLSTM || g == 0) {
#pragma unroll
            for (int i = 0; i < 16; ++i) accO[i] = 0.f;
#pragma unroll
            for (int ks = 0; ks < 8; ++ks) { const bf16x8 a = *(const LAS bf16x8*)(qimg0 + (32 * jt + r) * IMG_PITCH + 16 * h5 + 32 * ks), bc = *(const LAS bf16x8*)(lds + MP::CT + g * CT_BYTES + r * CT_PITCH + 32 * ks + 16 * h5); accO = MFMA32(a, bc, accO); }
            if (MLSTM) {
#pragma unroll
                for (int g4 = 0; g4 < 4; ++g4) { const f32x4 pm = *(const LAS f32x4*)((const LAS float*)(lds + MP::TPM) + c * 64 + 32 * jt + 8 * g4 + 4 * h5);
#pragma unroll
                    for (int e = 0; e < 4; ++e) accO[4 * g4 + e] *= __expf(mc - fmaxf(mc, pm[e])); }
            }
        }
    }
    PT_ACC(2, tp);
    MX_BAR();
    PT_ACC(3, tp);
    if (wave < 4) {
        if (MLSTM) { const float decay = __expf(mc - TSC[32 + c]); accC0 = accC0 * decay; accC1 = accC1 * decay; }
        LAS unsigned char* kimg = kimg0 + (8 * h5 + q4) * IMG_PITCH + 64 * wave + 32 * blk + 8 * p4;
        LAS unsigned char* vimg = (MLSTM ? lds + MP::VW : vimg0) + (8 * h5 + q4) * 64 + 32 * blk + 8 * p4;
        LAS unsigned char* vaux = lds + MP::VWAUX + (8 * h5 + q4) * 64 + 32 * blk + 8 * p4;
#pragma unroll
        for (int ks = 0; ks < 4; ++ks) {
            bf16x8 a, b0, b1;
            if (MLSTM) tr_read3(a, b0, b1, LDSA(kimg + 16 * ks * IMG_PITCH), LDSA(kimg + (16 * ks + 4) * IMG_PITCH), LDSA(vimg + 16 * ks * 64), LDSA(vimg + (16 * ks + 4) * 64), LDSA(vaux + 16 * ks * 64), LDSA(vaux + (16 * ks + 4) * 64));
            else tr_read2(a, b0, LDSA(kimg + 16 * ks * IMG_PITCH), LDSA(kimg + (16 * ks + 4) * IMG_PITCH), LDSA(vimg + 16 * ks * 64), LDSA(vimg + (16 * ks + 4) * 64));
            __builtin_amdgcn_sched_barrier(0);
            accC0 = MFMA32(a, b0, accC0);
            if (MLSTM) accC1 = MFMA32(a, b1, accC1);
        }
        if (!MLSTM) {
#pragma unroll
            for (int g4 = 0; g4 < 4; ++g4) { const f32x4 dc = *(const LAS f32x4*)((const LAS float*)(lds + MP::GDEC) + par * 128 + 32 * wave + 8 * g4 + 4 * h5);
#pragma unroll
                for (int e = 0; e < 4; ++e) accC0[4 * g4 + e] *= dc[e]; }
        }
#pragma unroll
        for (int g4 = 0; g4 < 4; ++g4) { const int d0 = 32 * wave + 8 * g4 + 4 * h5;
            v2u o; o.x = pk_bf16(accC0[4 * g4], accC0[4 * g4 + 1]); o.y = pk_bf16(accC0[4 * g4 + 2], accC0[4 * g4 + 3]); *(LAS v2u*)(lds + MP::CT + r * CT_PITCH + d0 * 2) = o;
            if (MLSTM) { v2u o1; o1.x = pk_bf16(accC1[4 * g4], accC1[4 * g4 + 1]); o1.y = pk_bf16(accC1[4 * g4 + 2], accC1[4 * g4 + 3]); *(LAS v2u*)(lds + MP::CT + CT_BYTES + r * CT_PITCH + d0 * 2) = o1; } }
    } else {
        const int g = (wave - 4) >> 1, jt = wave & 1;
        if (MLSTM || g == 0) {
            const bf16x8 ones = (r == 0) ? (bf16x8){0x3F80, 0x3F80, 0x3F80, 0x3F80, 0x3F80, 0x3F80, 0x3F80, 0x3F80} : (bf16x8){0, 0, 0, 0, 0, 0, 0, 0};
            LAS unsigned char* vimg = vimg0 + (8 * h5 + q4) * 64 + 32 * blk + 8 * p4;
#pragma unroll
            for (int ks = 0; ks < 4; ++ks) {
                const bf16x8 a = *(const LAS bf16x8*)(lds + MP::PS + (32 * jt + r) * PS_PITCH + 32 * ks + 16 * h5);
                if (g == 0) { const bf16x8 bv = tr_read1(LDSA(vimg + 16 * ks * 64), LDSA(vimg + (16 * ks + 4) * 64)); __builtin_amdgcn_sched_barrier(0); accO = MFMA32(a, bv, accO); }
                else accO = MFMA32(a, ones, accO); }
            if (MLSTM && g == 0) {
#pragma unroll
                for (int i = 0; i < 16; ++i) ((LAS float*)(lds + MP::NUM))[(32 * jt + (i & 3) + 8 * (i >> 2) + 4 * h5) * NUM_PITCH + r] = accO[i];
            }
            if (MLSTM && g == 1 && r == 0) {
#pragma unroll
                for (int i = 0; i < 16; ++i) ((LAS float*)(lds + MP::DEN))[32 * jt + (i & 3) + 8 * (i >> 2) + 4 * h5] = accO[i];
            }
            if (!MLSTM) mx_store_tile(lds + MP::OUTT + jt * 2048, accO, U.Hg + (size_t)(U.b * SEQ + c * CH + 32 * jt) * D, lane, r, h5);
        }
    }
    PT_ACC(4, tp);
    MX_BAR_VM();
    PT_ACC(5, tp);
}

template <bool MLSTM>
__device__ __forceinline__ void mixer_phase(LAS unsigned char* lds, int tid, int lane, int wave, int vcu, int G, const MixArgs A) {
    typedef MxMap<MLSTM> MP;
    MixDma dm; mx_dma_setup(dm, wave, lane, A.qpitch);
    unsigned pt[8] = {0u, 0u, 0u, 0u, 0u, 0u, 0u, 0u}; unsigned long long tph = PROBE_T ? PT_NOW() : 0ull; unsigned long long tin = tph;
    for (int unit = vcu; unit < BATCH * NH * 8; unit += G) {
        const int slice = unit & 7, bh = unit >> 3;
        MixUnit U; U.b = bh >> 2; U.hh = bh & 3; U.qpitch = A.qpitch; U.gdec = A.gdec;
        U.Qg = A.q + U.hh * DK; U.Kg = A.k + U.hh * DK; U.Vg = A.proj + 1024 + U.hh * DV + 32 * slice; U.Hg = A.hun + U.hh * DV + 32 * slice;
        MX_BAR_VM();
        mx_dma_issue<MLSTM>(lds, dm, U, 0, wave, tid);
        for (int i = tid; i < 2 * CT_BYTES / 4; i += NTHREADS) ((LAS unsigned*)(lds + MP::CT))[i] = 0u;
        if (MLSTM) {
            for (int i = tid; i < 1024; i += NTHREADS) ((LAS unsigned*)(lds + MP::VWAUX))[i] = 0u;
            LAS float* TB = (LAS float*)(lds + MP::TB); LAS float* TWP = (LAS float*)(lds + MP::TWP); LAS float* TPM = (LAS float*)(lds + MP::TPM); LAS float* TSC = (LAS float*)(lds + MP::TSC);
            const float bgi = A.bgate[U.hh], bgf = A.bgate[4 + U.hh];
            float gi4[4], gf4[4];
#pragma unroll
            for (int cc = 0; cc < 4; ++cc) { const size_t tok = (size_t)U.b * SEQ + (wave + 8 * cc) * CH + lane; gi4[cc] = A.gates[tok * 16 + U.hh] + bgi; gf4[cc] = A.gates[tok * 16 + 4 + U.hh] + bgf; }
#pragma unroll
            for (int cc = 0; cc < 4; ++cc) { const int c = wave + 8 * cc;
                const float lf = fminf(gf4[cc], 0.f) - __logf(1.0f + __expf(-fabsf(gf4[cc])));
                float bsum = lf;
#pragma unroll
                for (int o = 1; o < 64; o <<= 1) { const float t = __shfl_up(bsum, o); if (lane >= o) bsum += t; }
                const float wp = gi4[cc] - bsum; float pm = wp;
#pragma unroll
                for (int o = 1; o < 64; o <<= 1) { const float t = __shfl_up(pm, o); if (lane >= o) pm = fmaxf(pm, t); }
                TB[c * 64 + lane] = bsum; TWP[c * 64 + lane] = wp; TPM[c * 64 + lane] = pm;
                if (lane == 63) { TSC[64 + c] = bsum; TSC[96 + c] = pm; } }
            MX_BAR();
            if (wave == 0) {
                const float gl = TSC[64 + (lane & 31)], pl = TSC[96 + (lane & 31)]; float m = 0.f, myM = 0.f, myX = 0.f;
#pragma clang loop unroll(disable)
                for (int c = 0; c < NCH; ++c) { const float gc = __uint_as_float(__builtin_amdgcn_readlane(__float_as_uint(gl), c)), pc = __uint_as_float(__builtin_amdgcn_readlane(__float_as_uint(pl), c));
                    const float mxe = fmaxf(m, pc); if (lane == c) { myM = m; myX = mxe; } m = gc + mxe; }
                if (lane < 32) { TSC[lane] = myM; TSC[32 + lane] = myX; }
            }
        }
        f32x16 accC0, accC1, accO;
#pragma unroll
        for (int i = 0; i < 16; ++i) { accC0[i] = 0.f; accC1[i] = 0.f; accO[i] = 0.f; }
        MX_BAR_VM();
        PT_ACC(1, tin);
#pragma clang loop unroll(disable)
        for (int c = 0; c < NCH; ++c) mx_step<MLSTM>(lds, dm, U, c, accC0, accC1, accO, tid, lane, wave, pt);
        if (MLSTM && wave >= 4) mx_finalize_mlstm(lds, U, NCH - 1, tid - 256);
    }
    MX_BAR_VM();
    if (PROBE_T && (PROBE_T_MLSTM != 0) == MLSTM && vcu == 0 && wave == PROBE_T_WAVE && lane == 0) { PT_ACC(0, tph); unsigned* pw = (unsigned*)A.probe; pw[0] = pt[PROBE_T_A]; pw[1] = pt[PROBE_T_B]; }
}

constexpr int N_PHASES = 16, RT_OFF = RING_BYTES;
template <int PH>
__device__ __forceinline__ void run_phase(const Args& args, LAS unsigned char* lds, int tid, int lane, int wave, int vcu, int G, int bx) {
    unsigned char* ws = args.ws;
    constexpr int layer = (PH >= 8 && PH < 15) ? 1 : 0, k = (PH == 0) ? -1 : (PH == 15) ? 7 : PH - 1 - 7 * layer;
    unsigned char* wl = ws + (size_t)layer * WS_WLAYER;
    bf16* AOP = (bf16*)(ws + WS_AOP); bf16* PROJ = (bf16*)(ws + WS_PROJ); bf16* HMID = (bf16*)(ws + WS_HMID); bf16* XRES = (bf16*)(ws + WS_XRES);
    float* GATES = (float*)(ws + WS_GATES); float* SUMSQ = (float*)(ws + WS_SUMSQ);
    LAS float* RT = (LAS float*)(lds + RT_OFF);
    if constexpr (k == -1) {
        convert_weights(lds, lane, wave, vcu, G, args, ws);
        rows_first(lds, tid, lane, wave, vcu, G, args.in[0], args.in[1], XRES, SUMSQ, args.in[4] + NPROJ, MLSTM_IN, 8, GATES);
    } else if constexpr (k == 0) {
        pg8::Gemm g{XRES, (const bf16*)(wl + WS_WIN), M, NPROJ, D}; pg8::StaticOrder S; S.init(M, NPROJ, G, bx);
        const RstdSlots rs = rstd_table(RT, SUMSQ, S, tid);
        pg8::EpiBf16S<0> E{PROJ, NPROJ, (const LAS float*)RT, rs.pm1, rs.pm2, rs.pm3};
        pg8::gemm_phase<pg8::EpiBf16S<0>, pg8::StaticOrder, true, true>(lds, g, S, E);
    } else if constexpr (k == 1) {
        if (layer) gla_prep(lds, tid, lane, wave, vcu, G, PROJ, XRES, SUMSQ, args.in[8], args.in[1] + D, args.in[9], args.in[10], (bf16*)(ws + WS_QT), (bf16*)(ws + WS_KT), (float*)(ws + WS_GDEC));
    } else if constexpr (k == 2) {
        if (layer == 0) { const MixArgs A{PROJ, PROJ + QKW, PROJ, NPROJ, GATES, args.in[5], nullptr, AOP, ws + WS_CTL + 4 * CW_PROBE}; mixer_phase<true>(lds, tid, lane, wave, vcu, G, A); }
        else { const MixArgs A{(const bf16*)(ws + WS_QT), (const bf16*)(ws + WS_KT), PROJ, QKW, nullptr, nullptr, (const float*)(ws + WS_GDEC), AOP, ws + WS_CTL + 4 * CW_PROBE}; mixer_phase<false>(lds, tid, lane, wave, vcu, G, A); }
    } else if constexpr (k == 3) {
        head_norm_rows(lane, wave, vcu, G, AOP, args.in[layer ? 11 : 6], PROJ, AOP, layer != 0);
    } else if constexpr (k == 4) {
        pg8::Gemm g{AOP, (const bf16*)(wl + WS_WOUT), M, D, D}; pg8::StaticOrder S; S.init(M, D, G, bx);
        pg8::EpiResBf16Sq E{XRES, SUMSQ, D};
        pg8::gemm_phase<pg8::EpiResBf16Sq, pg8::StaticOrder, false, true>(lds, g, S, E);
    } else if constexpr (k == 5) {
        pg8::Gemm g{XRES, (const bf16*)(wl + WS_W1), M, FF, D}; pg8::StaticOrder S; S.init(M, FF, G, bx);
        const RstdSlots rs = rstd_table(RT, SUMSQ, S, tid);
        pg8::EpiBf16S<2> E{HMID, FF, (const LAS float*)RT, rs.pm1, rs.pm2, rs.pm3};
        pg8::gemm_phase<pg8::EpiBf16S<2>, pg8::StaticOrder, true, true>(lds, g, S, E);
    } else if constexpr (k == 6) {
        pg8::Gemm g{HMID, (const bf16*)(wl + WS_W2), M, D, FF}; pg8::StaticOrder S; S.init(M, D, G, bx);
        pg8::EpiResBf16Sq E{XRES, SUMSQ, D};
        pg8::gemm_phase<pg8::EpiResBf16Sq, pg8::StaticOrder, false, true>(lds, g, S, E);
    } else {
        rows_final(lane, wave, vcu, G, XRES, args.in[3], args.out);
    }
}
__global__ void __launch_bounds__(NTHREADS, 2) fwd_kernel(Args args) {
    extern __shared__ __attribute__((aligned(16))) unsigned char lds_raw[];
    LAS unsigned char* lds = (LAS unsigned char*)lds_raw;
    volatile LAS unsigned* MISC = (volatile LAS unsigned*)(lds + MISC_OFF);
    const int tid = threadIdx.x, lane = tid & 63, wave = __builtin_amdgcn_readfirstlane(tid >> 6);
    const int G = gridDim.x; int bx = blockIdx.x; int vcu = (G % 8 == 0) ? (bx % 8) * (G / 8) + bx / 8 : bx;
    for (int u = tid; u < (LDS_BYTES - LDSCTL_OFF) / 4; u += NTHREADS) ((LAS unsigned*)(lds + LDSCTL_OFF))[u] = 0u;
    __syncthreads();
    const int lo = args.ph_lo, hi = args.ph_hi;
    XcdBarrier bar; bar.bar = (unsigned*)(args.ws + WS_CTL) + CW_BAR; bar.x = 0; bar.st = nullptr;
    if (hi - lo > 1) { bar = xcd_barrier_post((unsigned*)(args.ws + WS_CTL) + CW_BAR, MISC + 8);
        if (tid == 0) { const unsigned xcc = xb_xcc_id(); MISC[16] = xcc; MISC[17] = xb_add((unsigned*)(args.ws + WS_CTL) + CW_XID + 64 * xcc, 1u); } }
#ifndef PROBE_PH
#define PROBE_PH (-1)
#endif
#ifndef PROBE_N
#define PROBE_N 0
#endif
#define PHASE(p) if (lo <= (p) && (p) < hi) { run_phase<p>(args, lds, tid, lane, wave, vcu, G, bx); \
        if ((p) == PROBE_PH) { for (int rep_ = 0; rep_ < PROBE_N; ++rep_) { xcd_barrier(bar); if (PROBE_PH >= 0) run_phase<((p) == PROBE_PH ? (p) : 2)>(args, lds, tid, lane, wave, vcu, G, bx); } } \
        if ((p) + 1 < hi && (p) != 2) xcd_barrier(bar); }
    PHASE(0)
    if (lo == 0 && hi > 1) {
        bool ok = (G == 256);
#pragma unroll
        for (unsigned j = 0; j < 16; ++j) { const unsigned cnt = xb_ld(&bar.bar[XB_XCNT(j)]); ok = ok && (cnt == (j < 8 ? 32u : 0u)); }
        const unsigned xcc = MISC[16], idx = MISC[17];
        if (ok && xcc < 8 && idx < 32) { vcu = (int)(xcc * 32 + idx); bx = (int)(idx * 8 + xcc); }
    }
    PHASE(1) PHASE(2) PHASE(3) PHASE(4) PHASE(5) PHASE(6) PHASE(7) PHASE(8) PHASE(9) PHASE(10) PHASE(11) PHASE(12) PHASE(13) PHASE(14) PHASE(15)
#undef PHASE
    if (PROBE_T && hi == N_PHASES && vcu == 0 && tid == 0) {
        const unsigned a = xb_ld((unsigned*)(args.ws + WS_CTL) + CW_PROBE), b = xb_ld((unsigned*)(args.ws + WS_CTL) + CW_PROBE + 1);
        const unsigned long long ticks = (unsigned long long)a * 5ull + (unsigned long long)(b / 50u) * 50000ull;
        const unsigned long long t0 = PT_NOW(); while (PT_NOW() - t0 < ticks) __builtin_amdgcn_s_sleep(8);
    }
}

extern "C" void kernel_launch(void* const* d_in, const int* in_sizes, int n_in, void* d_out, int out_size, void* d_ws, size_t ws_size, hipStream_t stream) {
    static int grid = 0;
    if (grid == 0) {
        if (n_in != 15 || in_sizes[0] != M * D || out_size != M * D || ws_size < WS_END) { fprintf(stderr, "kernel_launch: unexpected shapes (n_in %d, in0 %d, out %d, ws %zu); nothing launched\n", n_in, n_in > 0 ? in_sizes[0] : -1, out_size, ws_size); grid = -1; return; }
        int dev = 0, cus = 0, per_cu = 0;
        if (hipGetDevice(&dev) != hipSuccess || hipDeviceGetAttribute(&cus, hipDeviceAttributeMultiprocessorCount, dev) != hipSuccess) { grid = -1; return; }
        if (hipFuncSetAttribute((const void*)fwd_kernel, hipFuncAttributeMaxDynamicSharedMemorySize, LDS_BYTES) != hipSuccess) { fprintf(stderr, "kernel_launch: hipFuncSetAttribute failed\n"); grid = -1; return; }
        if (hipOccupancyMaxActiveBlocksPerMultiprocessor(&per_cu, (const void*)fwd_kernel, NTHREADS, LDS_BYTES) != hipSuccess || per_cu < 1) { fprintf(stderr, "kernel_launch: occupancy query says %d blocks per CU\n", per_cu); (void)hipGetLastError(); grid = -1; return; }
        grid = cus;
    }
    if (grid < 0) return;
    (void)hipMemsetAsync((char*)d_ws + WS_CTL, 0, CTL_ZERO_BYTES, stream);
    Args a{};
    for (int i = 0; i < 15; ++i) a.in[i] = (const float*)d_in[i];
    a.out = (float*)d_out; a.ws = (unsigned char*)d_ws;
    if (MK_N_LAUNCHES == 1) {
        a.ph_lo = 0; a.ph_hi = N_PHASES;
        void* kargs[] = {&a};
        const hipError_t e = hipLaunchCooperativeKernel((const void*)fwd_kernel, dim3(grid), dim3(NTHREADS), kargs, LDS_BYTES, stream);
        if (e != hipSuccess) fprintf(stderr, "kernel_launch: cooperative launch failed: %s (grid %d)\n", hipGetErrorString(e), grid);
    } else {
        for (int p = 0; p < N_PHASES; ++p) { a.ph_lo = p; a.ph_hi = p + 1; hipLaunchKernelGGL(fwd_kernel, dim3(grid), dim3(NTHREADS), LDS_BYTES, stream, a); }
    }
}
```

```cpp
#include <hip/hip_runtime.h>
#include <cstdio>
#include <cstdint>
namespace pg8 {
#define PG8_LAS __attribute__((address_space(3)))
typedef unsigned short bf16_t;
typedef short bf16x8 __attribute__((ext_vector_type(8)));
typedef float f32x4 __attribute__((ext_vector_type(4)));
typedef unsigned u32x4 __attribute__((ext_vector_type(4)));
constexpr int BM = 256, BK = 64, HALF = 128, HTB = HALF * BK * 2  , STAGE_BYTES = 8 * HTB, NXCD = 8, WGM = 8;

__host__ __device__ __forceinline__ int lds_byte(int r, int c) { const int st = (r >> 4) * 2 + (c >> 5), rr = r & 15, cc = c & 31, ob = rr * 64 + cc * 2; return st * 1024 + (ob ^ (((ob >> 9) & 1) << 5)); }
__host__ __device__ __forceinline__ void stage_rc(int b, int& R, int& C) { const int st = b / 1024, sb = b % 1024, swz = sb ^ (((sb >> 9) & 1) << 5); R = (st >> 1) * 16 + swz / 64; C = (st & 1) * 32 + (swz % 64) / 2; }
__host__ __device__ __forceinline__ int perm32(int rho) { const int n = rho >> 4, i = rho & 15; return 8 * (i >> 2) + 4 * n + (i & 3); }

struct Unit { int pm, pn; };
struct Gemm { const bf16_t* A; const bf16_t* Bt; int M, N, K; };

struct StaticOrder {
    int nM, nN, nwg, G, c;
    __host__ __device__ void init(int M, int N, int G_, int c_) { nM = M / BM; nN = N / BM; nwg = nM * nN; G = G_; c = c_; }
    __host__ __device__ bool next(int i, Unit& u) const {
        const long L = (long)i * G + c; if (L >= nwg) return false;
        int wgid = (int)L; { const int q = nwg / NXCD, r = nwg % NXCD, xcd = wgid % NXCD, off = wgid / NXCD; wgid = (xcd < r ? xcd * (q + 1) : r * (q + 1) + (xcd - r) * q) + off; }
        const int nig = WGM * nN, gid = wgid / nig, fm = gid * WGM, gsz = (nM - fm) < WGM ? (nM - fm) : WGM;
        u.pm = fm + ((wgid % nig) % gsz); u.pn = (wgid % nig) / gsz; return true;
    }
    __device__ __forceinline__ void a_ready(const Unit&) const {}
    __device__ __forceinline__ void done(const Unit&) const {}
};

__device__ __forceinline__ unsigned cvt_pk_bf16(float lo, float hi) { unsigned r; asm volatile("v_cvt_pk_bf16_f32 %0, %1, %2" : "=v"(r) : "v"(lo), "v"(hi)); return r; }
typedef float f32x2 __attribute__((ext_vector_type(2)));
typedef __bf16 bf16x2_t __attribute__((ext_vector_type(2)));
__device__ __forceinline__ unsigned pk_bf16(float lo, float hi) { f32x2 v = {lo, hi}; bf16x2_t r = __builtin_convertvector(v, bf16x2_t); return __builtin_bit_cast(unsigned, r); }
template <int ACT  > struct EpiBf16 {
    static constexpr bool PERM = true, AFTER_DRAIN = false;
    bf16_t* O; int ldc;
    __device__ __forceinline__ void operator()(const f32x4 (&acc)[2][2][4][2], const Unit& u, int wr, int wc, int fr, int fq) const {
        const int row0 = u.pm * BM + wr * 64 + fr, col0 = u.pn * BM + wc * 32 + 8 * fq;
#pragma unroll
        for (int ai = 0; ai < 2; ++ai)
#pragma unroll
            for (int m = 0; m < 4; ++m) { bf16_t* rowp = O + (size_t)(row0 + ai * HALF + m * 16) * ldc + col0;
#pragma unroll
                for (int bj = 0; bj < 2; ++bj) { f32x4 v0 = acc[ai][bj][m][0], v1 = acc[ai][bj][m][1];
                    if (ACT == 2) { const f32x4 z = {0.f, 0.f, 0.f, 0.f}; v0 = __builtin_elementwise_max(v0, z); v1 = __builtin_elementwise_max(v1, z); v0 = v0 * v0; v1 = v1 * v1; }
                    u32x4 w; w.x = pk_bf16(v0[0], v0[1]); w.y = pk_bf16(v0[2], v0[3]); w.z = pk_bf16(v1[0], v1[1]); w.w = pk_bf16(v1[2], v1[3]);
                    *(u32x4*)(rowp + bj * HALF) = w; } }
    }
};
struct EpiResF32 {
    static constexpr bool PERM = false, AFTER_DRAIN = true;
    const float* base; float* out; int ldc;
    __device__ __forceinline__ void fused(const f32x4 (&acc)[2][2][4][2], const Unit& u, int wr, int wc, int fr, int fq, PG8_LAS unsigned char*, int, int) const {
        const int col0 = u.pn * BM + wc * 32 + 4 * fq;
#pragma unroll
        for (int ai = 0; ai < 2; ++ai)
#pragma unroll
            for (int m = 0; m < 4; ++m) { const int r = ai * HALF + wr * 64 + m * 16 + fr; const size_t off = (size_t)(u.pm * BM + r) * ldc + col0;
#pragma unroll
                for (int bj = 0; bj < 2; ++bj) { const f32x4 b0 = *(const f32x4*)(base + off + bj * HALF), b1 = *(const f32x4*)(base + off + bj * HALF + 16);
                    *(f32x4*)(out + off + bj * HALF) = b0 + acc[ai][bj][m][0]; *(f32x4*)(out + off + bj * HALF + 16) = b1 + acc[ai][bj][m][1];
                    asm volatile("" ::: "memory"); } }
    }
};
typedef unsigned u32x2 __attribute__((ext_vector_type(2)));
__device__ __forceinline__ float bf_lo(unsigned w) { return __builtin_bit_cast(float, w << 16); }
__device__ __forceinline__ float bf_hi(unsigned w) { return __builtin_bit_cast(float, w & 0xffff0000u); }
template <int ACT  > struct EpiBf16S {
    static constexpr bool PERM = true, AFTER_DRAIN = false;
    bf16_t* O; int ldc; const PG8_LAS float* rt; int pm1, pm2, pm3;
    __device__ __forceinline__ void operator()(const f32x4 (&acc)[2][2][4][2], const Unit& u, int wr, int wc, int fr, int fq) const {
        const int col0 = u.pn * BM + wc * 32 + 8 * fq;
        const PG8_LAS float* rtp = rt + ((u.pm == pm1) ? 256 : (u.pm == pm2) ? 512 : (u.pm == pm3) ? 768 : 0) + wr * 64 + fr;
#pragma unroll
        for (int ai = 0; ai < 2; ++ai)
#pragma unroll
            for (int m = 0; m < 4; ++m) { const float rs = rtp[ai * HALF + m * 16];
                bf16_t* rowp = O + (size_t)(u.pm * BM + ai * HALF + wr * 64 + m * 16 + fr) * ldc + col0;
#pragma unroll
                for (int bj = 0; bj < 2; ++bj) { f32x4 v0 = acc[ai][bj][m][0] * rs, v1 = acc[ai][bj][m][1] * rs;
                    if (ACT == 2) { const f32x4 z = {0.f, 0.f, 0.f, 0.f}; v0 = __builtin_elementwise_max(v0, z); v1 = __builtin_elementwise_max(v1, z); v0 = v0 * v0; v1 = v1 * v1; }
                    u32x4 w; w.x = pk_bf16(v0[0], v0[1]); w.y = pk_bf16(v0[2], v0[3]); w.z = pk_bf16(v1[0], v1[1]); w.w = pk_bf16(v1[2], v1[3]);
                    *(u32x4*)(rowp + bj * HALF) = w; } }
    }
};
struct EpiResBf16Sq {
    static constexpr bool PERM = false, AFTER_DRAIN = true;
    bf16_t* xres; float* sumsq; int ldc;
    __device__ __forceinline__ void fused(f32x4 (&acc)[2][2][4][2], const Unit& u, int wr, int wc, int fr, int fq, PG8_LAS unsigned char* lds, int wid, int lane) const {
        PG8_LAS float* P = (PG8_LAS float*)lds;
        const int col0 = u.pn * BM + wc * 32 + 4 * fq;
#pragma unroll
        for (int ai = 0; ai < 2; ++ai)
#pragma unroll
            for (int m = 0; m < 4; ++m) { const int r = ai * HALF + wr * 64 + m * 16 + fr; bf16_t* xp = xres + (size_t)(u.pm * BM + r) * ldc + col0; float ss = 0.f;
#pragma unroll
                for (int bj = 0; bj < 2; ++bj)
#pragma unroll
                    for (int n = 0; n < 2; ++n) { const u32x2 xb = *(const u32x2*)(xp + bj * HALF + n * 16); const f32x4 a = acc[ai][bj][m][n];
                        u32x2 w; w.x = pk_bf16(bf_lo(xb.x) + a[0], bf_hi(xb.x) + a[1]); w.y = pk_bf16(bf_lo(xb.y) + a[2], bf_hi(xb.y) + a[3]);
                        *(u32x2*)(xp + bj * HALF + n * 16) = w;
                        const float y0 = bf_lo(w.x), y1 = bf_hi(w.x), y2 = bf_lo(w.y), y3 = bf_hi(w.y); ss += (y0 * y0 + y1 * y1) + (y2 * y2 + y3 * y3); }
                ss += __shfl_xor(ss, 16); ss += __shfl_xor(ss, 32);
                if (fq == 0) P[r * 4 + wc] = ss;
                asm volatile("" ::: "memory"); }
        asm volatile("s_waitcnt lgkmcnt(0)" ::: "memory"); __builtin_amdgcn_s_barrier(); asm volatile("" ::: "memory");
        const int t = wid * 64 + lane;
        if (t < 256) { const f32x4 p = *(const PG8_LAS f32x4*)(P + t * 4); sumsq[(size_t)(u.pm * BM + t) * 4 + u.pn] = (p[0] + p[1]) + (p[2] + p[3]); }
    }
};
template <class Epi, class Sched, bool ALIGN_EPI = false, bool SP2 = false>
__device__ __forceinline__ void gemm_phase(PG8_LAS unsigned char* lds, const Gemm g, const Sched& S, const Epi& E) {
    const int tid = threadIdx.x, wid = __builtin_amdgcn_readfirstlane(tid >> 6), lane = tid & 63, wr = wid >> 2, wc = wid & 3, fr = lane & 15, fq = lane >> 4;
    const int K = g.K, nt = K / BK;
    unsigned voffA[2], voffB[2];
#pragma unroll
    for (int i = 0; i < 2; ++i) { int R, C; stage_rc(tid * 16 + i * 8192, R, C); const int Rb = Epi::PERM ? ((R & ~31) + perm32(R & 31)) : R;
        voffA[i] = (unsigned)(R * K + C) * 2u; voffB[i] = (unsigned)(Rb * K + C) * 2u; }
    const size_t kstep = (size_t)(BK * 2);
    const size_t hstep = (size_t)HALF * K * 2;
    const size_t tstep = 2 * hstep;
    const unsigned ldsw = (unsigned)wid * 1024u;
    const int aoff = lds_byte(wr * 64 + fr, fq * 8), boff = lds_byte(wc * 32 + fr, fq * 8);
#define PG8_SA(b, h) (((b) * 2 + (h)) * HTB)
#define PG8_SB(b, h) ((4 + (b) * 2 + (h)) * HTB)
#define PG8_STAGE(bufoff, gbase, voff) do { _Pragma("unroll") for (int _i = 0; _i < 2; ++_i) \
        __builtin_amdgcn_global_load_lds((const unsigned*)((const char*)(gbase) + (voff)[_i]), (PG8_LAS unsigned*)(lds + (bufoff) + ldsw + _i * 8192), 16, 0, 0); } while (0)
#define PG8_LDA(dst, b, h) do { _Pragma("unroll") for (int m = 0; m < 4; ++m) _Pragma("unroll") for (int k = 0; k < 2; ++k) dst[m][k] = *(const PG8_LAS bf16x8*)(lds + PG8_SA(b, h) + aoff + m * 2048 + k * 1024); } while (0)
#define PG8_LDB(dst, b, h) do { _Pragma("unroll") for (int n = 0; n < 2; ++n) _Pragma("unroll") for (int k = 0; k < 2; ++k) dst[n][k] = *(const PG8_LAS bf16x8*)(lds + PG8_SB(b, h) + boff + n * 2048 + k * 1024); } while (0)
#define PG8_MMA(ai, bj, At, Bt) do { __builtin_amdgcn_s_setprio(1); _Pragma("unroll") for (int m = 0; m < 4; ++m) _Pragma("unroll") for (int n = 0; n < 2; ++n) _Pragma("unroll") for (int k = 0; k < 2; ++k) \
        acc[ai][bj][m][n] = __builtin_amdgcn_mfma_f32_16x16x32_bf16(Bt[n][k], At[m][k], acc[ai][bj][m][n], 0, 0, 0); __builtin_amdgcn_s_setprio(0); } while (0)
#define PG8_WAIT_V(n) asm volatile("s_waitcnt vmcnt(" #n ")" ::: "memory")
#define PG8_WAIT_L(n) asm volatile("s_waitcnt lgkmcnt(" #n ")" ::: "memory")
#define PG8_BAR __builtin_amdgcn_s_barrier()
#define PG8_SCHED __builtin_amdgcn_sched_barrier(0)
    Unit cur, nxt; int ui = 0;
    if (!S.next(0, cur)) return;
    f32x4 acc[2][2][4][2];
#pragma unroll
    for (int a = 0; a < 2; ++a)
#pragma unroll
        for (int b = 0; b < 2; ++b)
#pragma unroll
            for (int m = 0; m < 4; ++m)
#pragma unroll
                for (int n = 0; n < 2; ++n) acc[a][b][m][n] = (f32x4){0.f, 0.f, 0.f, 0.f};
    bf16x8 At[4][2], B0[2][2], B1[2][2];
    const char* cA = (const char*)g.A + (size_t)cur.pm * tstep; const char* cB = (const char*)g.Bt + (size_t)cur.pn * tstep;
    S.a_ready(cur);
    if constexpr (SP2) {
        PG8_STAGE(PG8_SB(0, 0), cB, voffB); PG8_STAGE(PG8_SB(0, 1), cB + hstep, voffB); PG8_STAGE(PG8_SA(0, 0), cA, voffA); PG8_STAGE(PG8_SA(0, 1), cA + hstep, voffA);
        if (wr == 1) PG8_BAR;
        PG8_WAIT_V(2); PG8_BAR;
        PG8_STAGE(PG8_SB(1, 0), cB + kstep, voffB); PG8_STAGE(PG8_SA(1, 0), cA + kstep, voffA); PG8_STAGE(PG8_SB(1, 1), cB + hstep + kstep, voffB);
        PG8_WAIT_V(6); PG8_BAR;
    } else {
        PG8_STAGE(PG8_SB(0, 0), cB, voffB); PG8_STAGE(PG8_SA(0, 0), cA, voffA); PG8_STAGE(PG8_SB(0, 1), cB + hstep, voffB); PG8_STAGE(PG8_SA(0, 1), cA + hstep, voffA);
        if (wr == 1) PG8_BAR;
        PG8_WAIT_V(4); PG8_BAR;
        PG8_STAGE(PG8_SB(1, 0), cB + kstep, voffB); PG8_STAGE(PG8_SA(1, 0), cA + kstep, voffA); PG8_STAGE(PG8_SB(1, 1), cB + hstep + kstep, voffB);
        PG8_WAIT_V(6); PG8_BAR;
    }
    for (;;) {
        const bool has_next = S.next(ui + 1, nxt);
        const char* nA = has_next ? (const char*)g.A + (size_t)nxt.pm * tstep : cA; const char* nB = has_next ? (const char*)g.Bt + (size_t)nxt.pn * tstep : cB;
        for (int t = 0; t < nt; t += 2) {
            const bool last = (t == nt - 2);
            const char* a1 = cA + (size_t)(t + 1) * kstep;
            const char* a2 = last ? nA : cA + (size_t)(t + 2) * kstep; const char* b2 = last ? nB : cB + (size_t)(t + 2) * kstep;
            const char* a3 = a2 + kstep; const char* b3 = b2 + kstep;
            if (last && has_next) S.a_ready(nxt);
            if constexpr (SP2) {
            PG8_LDB(B0, 0, 0); PG8_LDB(B1, 0, 1); PG8_SCHED; PG8_LDA(At, 0, 0); PG8_STAGE(PG8_SA(1, 1), a1 + hstep, voffA);
            PG8_WAIT_V(8); PG8_WAIT_L(0); PG8_BAR; PG8_MMA(0, 0, At, B0); PG8_MMA(0, 1, At, B1); PG8_BAR; PG8_SCHED;
            PG8_LDA(At, 0, 1); PG8_STAGE(PG8_SB(0, 0), b2, voffB); PG8_STAGE(PG8_SB(0, 1), b2 + hstep, voffB); PG8_STAGE(PG8_SA(0, 0), a2, voffA);
            PG8_WAIT_V(8); PG8_WAIT_L(0); PG8_BAR; PG8_MMA(1, 0, At, B0); PG8_MMA(1, 1, At, B1); PG8_BAR; PG8_SCHED;
            PG8_LDB(B0, 1, 0); PG8_LDB(B1, 1, 1); PG8_SCHED; PG8_LDA(At, 1, 0); PG8_STAGE(PG8_SA(0, 1), a2 + hstep, voffA);
            PG8_WAIT_V(8); PG8_WAIT_L(0); PG8_BAR; PG8_MMA(0, 0, At, B0); PG8_MMA(0, 1, At, B1); PG8_BAR; PG8_SCHED;
            PG8_LDA(At, 1, 1); PG8_STAGE(PG8_SB(1, 0), b3, voffB); PG8_STAGE(PG8_SB(1, 1), b3 + hstep, voffB); PG8_STAGE(PG8_SA(1, 0), a3, voffA);
            PG8_WAIT_V(8); PG8_WAIT_L(0); PG8_BAR; PG8_MMA(1, 0, At, B0); PG8_MMA(1, 1, At, B1); PG8_BAR; PG8_SCHED;
            } else {
            PG8_LDB(B0, 0, 0); PG8_SCHED; PG8_LDA(At, 0, 0); PG8_STAGE(PG8_SA(1, 1), a1 + hstep, voffA);
            PG8_WAIT_L(8); PG8_BAR; PG8_WAIT_L(0); PG8_MMA(0, 0, At, B0); PG8_BAR; PG8_SCHED;
            PG8_LDB(B1, 0, 1); PG8_STAGE(PG8_SB(0, 0), b2, voffB);
            PG8_BAR; PG8_WAIT_L(0); PG8_MMA(0, 1, At, B1); PG8_BAR;
            PG8_LDA(At, 0, 1); PG8_STAGE(PG8_SA(0, 0), a2, voffA);
            PG8_BAR; PG8_WAIT_L(0); PG8_MMA(1, 0, At, B0); PG8_BAR; PG8_SCHED;
            PG8_STAGE(PG8_SB(0, 1), b2 + hstep, voffB);
            PG8_WAIT_V(6); PG8_BAR; PG8_MMA(1, 1, At, B1); PG8_BAR;
            PG8_LDB(B0, 1, 0); PG8_SCHED; PG8_LDA(At, 1, 0); PG8_STAGE(PG8_SA(0, 1), a2 + hstep, voffA);
            PG8_WAIT_L(8); PG8_BAR; PG8_WAIT_L(0); PG8_MMA(0, 0, At, B0); PG8_BAR; PG8_SCHED;
            PG8_LDB(B1, 1, 1); PG8_STAGE(PG8_SB(1, 0), b3, voffB);
            PG8_BAR; PG8_WAIT_L(0); PG8_MMA(0, 1, At, B1); PG8_BAR;
            PG8_LDA(At, 1, 1); PG8_STAGE(PG8_SA(1, 0), a3, voffA);
            PG8_BAR; PG8_WAIT_L(0); PG8_MMA(1, 0, At, B0); PG8_BAR; PG8_SCHED;
            PG8_STAGE(PG8_SB(1, 1), b3 + hstep, voffB);
            PG8_WAIT_V(6); PG8_BAR; PG8_MMA(1, 1, At, B1); PG8_BAR;
            }
        }
        if constexpr (ALIGN_EPI) { if (wr == 0) PG8_BAR; }
        if constexpr (!Epi::AFTER_DRAIN) { E(acc, cur, wr, wc, fr, fq); S.done(cur); }
        if (!has_next) break;
#pragma unroll
        for (int a = 0; a < 2; ++a)
#pragma unroll
            for (int b = 0; b < 2; ++b)
#pragma unroll
                for (int m = 0; m < 4; ++m)
#pragma unroll
                    for (int n = 0; n < 2; ++n) acc[a][b][m][n] = (f32x4){0.f, 0.f, 0.f, 0.f};
        cur = nxt; cA = nA; cB = nB; ++ui;
        if constexpr (ALIGN_EPI) { if (wr == 1) PG8_BAR; }
    }
    PG8_WAIT_V(0);
    if constexpr (!ALIGN_EPI) { if (wr == 0) PG8_BAR; }
    PG8_BAR;
    if constexpr (Epi::AFTER_DRAIN) { E.fused(acc, cur, wr, wc, fr, fq, lds, wid, lane); S.done(cur); }
#undef PG8_SA
#undef PG8_SB
#undef PG8_STAGE
#undef PG8_LDA
#undef PG8_LDB
#undef PG8_MMA
#undef PG8_WAIT_V
#undef PG8_WAIT_L
#undef PG8_BAR
#undef PG8_SCHED
}
}

constexpr int NWAVES = 8, NTHREADS = 512;
#ifndef MK_N_LAUNCHES
#define MK_N_LAUNCHES 1
#endif
constexpr int BATCH = 8, SEQ = 2048, D = 1024, FF = 4096, NH = 4, DK = 128, DV = 256, QKW = 512, VW = 1024;
constexpr int M = BATCH * SEQ, NPROJ = 3072, CH = 64, NCH = SEQ / CH;
constexpr int MLSTM_IN = 3080, GLA_IN = 3088;
constexpr float EPS = 1e-6f, QK_SCALE = 0.08838834764831845f, INV_TAU = 1.0f / 16.0f;

constexpr size_t MiB = 1u << 20;
constexpr size_t WS_CTL = 0, CTL_ZERO_BYTES = 64 * 1024;
constexpr size_t WS_GATES = 1 * MiB;
constexpr size_t WS_GDEC = 2 * MiB;
constexpr size_t WS_SUMSQ = 2 * MiB + 512 * 1024;
constexpr size_t WS_WIN = 4 * MiB, WS_WOUT = 10 * MiB, WS_W1 = 12 * MiB, WS_W2 = 20 * MiB, WS_WLAYER = 56 * MiB;
constexpr size_t WS_AOP = 28 * MiB;
constexpr size_t WS_PROJ = 92 * MiB;
constexpr size_t WS_QT = 188 * MiB, WS_KT = 204 * MiB;
constexpr size_t WS_HMID = 92 * MiB;
constexpr size_t WS_XRES = 220 * MiB;
constexpr size_t WS_END = 252 * MiB;
constexpr int CW_BAR = 1024, CW_XID = 8192;

constexpr int RING_BYTES = 131072, LDS_BYTES = 155648, LDSCTL_OFF = LDS_BYTES - 1024, MISC_OFF = LDSCTL_OFF + 320;

#define GAS __attribute__((address_space(1)))
#define LAS __attribute__((address_space(3)))
typedef unsigned short bf16;
typedef unsigned v4u __attribute__((ext_vector_type(4)));
typedef unsigned v2u __attribute__((ext_vector_type(2)));
typedef float f32x4 __attribute__((ext_vector_type(4)));
typedef float f32x16 __attribute__((ext_vector_type(16)));
typedef short bf16x8 __attribute__((ext_vector_type(8)));
typedef short s16x4 __attribute__((ext_vector_type(4)));
typedef GAS unsigned gu32;
#define RLX_AGENT __ATOMIC_RELAXED, __HIP_MEMORY_SCOPE_AGENT
#define LDS_WAIT() asm volatile("s_waitcnt lgkmcnt(0)" ::: "memory")
#define VM_WAIT() asm volatile("s_waitcnt vmcnt(0)" ::: "memory")
using pg8::pk_bf16;
__device__ __forceinline__ float bf2f(unsigned b) { return __uint_as_float(b << 16); }
__device__ __forceinline__ float bflo(unsigned w) { return __uint_as_float(w << 16); }
__device__ __forceinline__ float bfhi(unsigned w) { return __uint_as_float(w & 0xffff0000u); }
__device__ __forceinline__ unsigned short f2bf1(float f) { return (unsigned short)(pk_bf16(f, 0.f) & 0xffffu); }

struct Args { const float* in[15]; float* out; unsigned char* ws; int ph_lo, ph_hi; };
#define XB_TMO      128
#define XB_XCNT(j)  (256  + 64 * (j))
#define XB_XSUB(j)  (1280 + 64 * (j))
#define XB_XGEN(j)  (2304 + 64 * (j))
#define XB_TOP      3328
#define XB_TOPGEN   3392
#define XCD_BAR_WORDS 3456
#define XB_SPIN_CAP (1u << 18)
__device__ __forceinline__ unsigned xb_ld(unsigned* p)              { return __hip_atomic_load(p, __ATOMIC_RELAXED, __HIP_MEMORY_SCOPE_AGENT); }
__device__ __forceinline__ unsigned xb_add(unsigned* p, unsigned v) { return __hip_atomic_fetch_add(p, v, __ATOMIC_RELAXED, __HIP_MEMORY_SCOPE_AGENT); }
__device__ __forceinline__ unsigned xb_xcc_id() { return (unsigned)__builtin_amdgcn_s_getreg((3 << 11) | 20) & 0xFu; }
#define XB_SPIN(cond, bar) do { unsigned _sp = 0; while (cond) { __builtin_amdgcn_s_sleep(1); \
    if ((++_sp & 255u) == 0u) { if (xb_ld(&(bar)[XB_TMO])) break; if (_sp > XB_SPIN_CAP) { atomicAdd(&(bar)[XB_TMO], 1u); break; } } } } while (0)
struct XcdBarrier { unsigned* bar; unsigned x; volatile LAS unsigned* st; };
__device__ __forceinline__ XcdBarrier xcd_barrier_post(unsigned* bar, volatile LAS unsigned* st) {
    XcdBarrier b; b.bar = bar; b.x = xb_xcc_id(); b.st = st;
    if (threadIdx.x == 0) (void)xb_add(&bar[XB_XCNT(b.x)], 1u);
    return b;
}
__device__ __forceinline__ void xcd_barrier_complete(unsigned* bar, unsigned x, unsigned& nloc, unsigned& nx) {
    const unsigned G = gridDim.x * gridDim.y * gridDim.z;
    unsigned sum, cnt, mine, sp = 0u;
    for (;;) {
        sum = 0u; cnt = 0u; mine = 0u;
#pragma unroll
        for (unsigned j = 0; j < 16; ++j) { const unsigned c = xb_ld(&bar[XB_XCNT(j)]); sum += c; cnt += (c > 0u) ? 1u : 0u; mine = (j == x) ? c : mine; }
        if (sum == G) break;
        __builtin_amdgcn_s_sleep(1);
        if ((++sp & 255u) == 0u) { if (xb_ld(&bar[XB_TMO])) break; if (sp > XB_SPIN_CAP) { atomicAdd(&bar[XB_TMO], 1u); break; } }
    }
    nloc = mine > 0u ? mine : 1u; nx = cnt > 0u ? cnt : 1u;
}
__device__ __forceinline__ void xcd_barrier(const XcdBarrier& b) {
    asm volatile("s_waitcnt vmcnt(0)" ::: "memory");
    __syncthreads();
    if (threadIdx.x == 0) {
        unsigned* bar = b.bar;
        __builtin_amdgcn_s_waitcnt(0);
        unsigned nloc = b.st[0], nx = b.st[1];
        if (nloc == 0u) { xcd_barrier_complete(bar, b.x, nloc, nx); b.st[0] = nloc; b.st[1] = nx; }
        const unsigned old = xb_add(&bar[XB_XSUB(b.x)], 1u);
        const unsigned gen = old / nloc;
        if (old + 1u == (gen + 1u) * nloc) {
            __builtin_amdgcn_fence(__ATOMIC_RELEASE, "agent");
            asm volatile("s_waitcnt vmcnt(0)" ::: "memory");
            const unsigned og = xb_add(&bar[XB_TOP], 1u);
            const unsigned tg = og / nx;
            if (og + 1u == (tg + 1u) * nx) xb_add(&bar[XB_TOPGEN], 1u);
            else XB_SPIN(xb_ld(&bar[XB_TOPGEN]) == tg, bar);
            __builtin_amdgcn_fence(__ATOMIC_ACQUIRE, "agent");
            xb_add(&bar[XB_XGEN(b.x)], 1u);
            asm volatile("s_waitcnt vmcnt(0)" ::: "memory");
        } else {
            XB_SPIN(xb_ld(&bar[XB_XGEN(b.x)]) == gen, bar);
            __builtin_amdgcn_fence(__ATOMIC_ACQUIRE, "agent");
            asm volatile("s_waitcnt vmcnt(0)" ::: "memory");
        }
    }
    __syncthreads();
}

__device__ __forceinline__ float wave_sum(float v) {
#pragma unroll
    for (int o = 1; o < 64; o <<= 1) v += __shfl_xor(v, o);
    return v;
}
__device__ __forceinline__ void transpose_item(const float* W, int K, int N, int ldw, bf16* WT, const float* gain, LAS float* scr, int item, int lane) {
    const int nblk = N / 32, kb = item / nblk, nb = item % nblk, k0 = 64 * kb, n0 = 32 * nb;
    const int n4 = (lane & 7) * 4, krow = lane >> 3;
    f32x4 v[8];
#pragma unroll
    for (int i = 0; i < 8; ++i) v[i] = *(const f32x4*)(W + (size_t)(k0 + 8 * i + krow) * ldw + n0 + n4);
#pragma unroll
    for (int i = 0; i < 8; ++i) *(LAS f32x4*)(scr + (8 * i + krow) * 32 + (n4 ^ (i << 2))) = v[i];
    const int c = lane & 7, nl = lane >> 3;
    f32x4 g0 = {1.f, 1.f, 1.f, 1.f}, g1 = {1.f, 1.f, 1.f, 1.f};
    if (gain) { g0 = *(const f32x4*)(gain + k0 + 8 * c); g1 = *(const f32x4*)(gain + k0 + 8 * c + 4); }
    LDS_WAIT(); asm volatile("" ::: "memory");
#pragma unroll
    for (int j = 0; j < 4; ++j) { const int n = 8 * j + nl; const LAS float* sp = scr + (8 * c) * 32 + (n ^ (c << 2));
        v4u o; o.x = pk_bf16(sp[0 * 32] * g0.x, sp[1 * 32] * g0.y); o.y = pk_bf16(sp[2 * 32] * g0.z, sp[3 * 32] * g0.w); o.z = pk_bf16(sp[4 * 32] * g1.x, sp[5 * 32] * g1.y); o.w = pk_bf16(sp[6 * 32] * g1.z, sp[7 * 32] * g1.w);
        *(GAS v4u*)(WT + (size_t)(n0 + n) * K + k0 + 8 * c) = o; }
    LDS_WAIT(); asm volatile("" ::: "memory");
}
__device__ __forceinline__ void convert_weights(LAS unsigned char* lds, int lane, int wave, int vcu, int G, const Args& args, unsigned char* ws) {
    LAS float* scr = (LAS float*)(lds + wave * 16384);
    const int gw = vcu * NWAVES + wave, NGW = G * NWAVES;
    constexpr int I_IN = (D / 64) * (NPROJ / 32), I_O = (D / 64) * (D / 32), I_1 = (D / 64) * (FF / 32), I_2 = (FF / 64) * (D / 32);
    constexpr int NITEMS = I_IN + I_O + I_1 + I_2;
    for (int it = gw; it < 2 * NITEMS; it += NGW) {
        const int layer = it >= NITEMS; int r = it - layer * NITEMS;
        unsigned char* wl = ws + (size_t)layer * WS_WLAYER;
        if (r < I_IN) { transpose_item(args.in[layer ? 8 : 4], D, NPROJ, layer ? GLA_IN : MLSTM_IN, (bf16*)(wl + WS_WIN), args.in[1] + layer * D, scr, r, lane); continue; } r -= I_IN;
        if (r < I_O) { transpose_item(args.in[layer ? 12 : 7], D, D, D, (bf16*)(wl + WS_WOUT), nullptr, scr, r, lane); continue; } r -= I_O;
        if (r < I_1) { transpose_item(args.in[13] + (size_t)layer * D * FF, D, FF, FF, (bf16*)(wl + WS_W1), args.in[2] + layer * D, scr, r, lane); continue; } r -= I_1;
        transpose_item(args.in[14] + (size_t)layer * D * FF, FF, D, D, (bf16*)(wl + WS_W2), nullptr, scr, r, lane);
    }
}

__device__ __forceinline__ void rows_first(LAS unsigned char* lds, int tid, int lane, int wave, int vcu, int G, const float* xin, const float* gain, bf16* xres, float* sumsq,
                                           const float* wg, int ldw, int ng, float* gates) {
    LAS float* WgT = (LAS float*)lds;
    __syncthreads();
    { float wv[32];
#pragma unroll
      for (int n = 0; n < 32; ++n) { const int i = tid + NTHREADS * n, k = i >> 4, c = i & 15; wv[n] = (c < ng) ? wg[(size_t)k * ldw + c] : 0.f; }
#pragma unroll
      for (int n = 0; n < 32; ++n) { const int i = tid + NTHREADS * n, k = i >> 4, c = i & 15; WgT[c * D + k] = wv[n]; } }
    __syncthreads();
    const int gw = vcu * NWAVES + wave, NGW = G * NWAVES;
    f32x4 gn[4];
#pragma unroll
    for (int j = 0; j < 4; ++j) gn[j] = *(const f32x4*)(gain + 4 * lane + 256 * j);
    for (int m = gw; m < M; m += NGW) {
        const float* xr = xin + (size_t)m * D + 4 * lane;
        f32x4 v[4]; float s = 0.f;
#pragma unroll
        for (int j = 0; j < 4; ++j) { v[j] = *(const f32x4*)(xr + 256 * j); s += (v[j].x * v[j].x + v[j].y * v[j].y) + (v[j].z * v[j].z + v[j].w * v[j].w); }
#pragma unroll
        for (int j = 0; j < 4; ++j) { v2u o; o.x = pk_bf16(v[j].x, v[j].y); o.y = pk_bf16(v[j].z, v[j].w); *(v2u*)(xres + (size_t)m * D + 4 * lane + 256 * j) = o; }
        const float ssum = wave_sum(s);
        if (lane == 0) *(f32x4*)(sumsq + (size_t)m * 4) = (f32x4){ssum, 0.f, 0.f, 0.f};
        const float rstd = 1.0f / sqrtf(ssum * (1.f / D) + EPS);
#pragma unroll
        for (int j = 0; j < 4; ++j) v[j] = v[j] * rstd * gn[j];
        float a[16];
#pragma unroll
        for (int c = 0; c < 16; ++c) a[c] = 0.f;
#pragma unroll
        for (int c = 0; c < 16; ++c) {
#pragma unroll
            for (int j = 0; j < 4; ++j) { const f32x4 w = *(const LAS f32x4*)(WgT + c * D + 4 * lane + 256 * j); a[c] += (v[j].x * w.x + v[j].y * w.y) + (v[j].z * w.z + v[j].w * w.w); }
            if (c & 1) asm volatile("" ::: "memory"); }
        const bool b5 = lane & 32, b4 = lane & 16, b3 = lane & 8, b2 = lane & 4;
#pragma unroll
        for (int i = 0; i < 8; ++i) { const float keep = b5 ? a[i + 8] : a[i], send = b5 ? a[i] : a[i + 8]; a[i] = keep + __shfl_xor(send, 32); }
#pragma unroll
        for (int i = 0; i < 4; ++i) { const float keep = b4 ? a[i + 4] : a[i], send = b4 ? a[i] : a[i + 4]; a[i] = keep + __shfl_xor(send, 16); }
#pragma unroll
        for (int i = 0; i < 2; ++i) { const float keep = b3 ? a[i + 2] : a[i], send = b3 ? a[i] : a[i + 2]; a[i] = keep + __shfl_xor(send, 8); }
        { const float keep = b2 ? a[1] : a[0], send = b2 ? a[0] : a[1]; a[0] = keep + __shfl_xor(send, 4); }
        a[0] += __shfl_xor(a[0], 2); a[0] += __shfl_xor(a[0], 1);
        const int c = (b5 ? 8 : 0) + (b4 ? 4 : 0) + (b3 ? 2 : 0) + (b2 ? 1 : 0);
        if ((lane & 3) == 0 && c < ng) gates[(size_t)m * 16 + c] = a[0];
    }
}
__device__ __forceinline__ void rows_final(int lane, int wave, int vcu, int G, const bf16* xres, const float* gain, float* out) {
    const int gw = vcu * NWAVES + wave, NGW = G * NWAVES;
    for (int m = gw; m < M; m += NGW) {
        float f[2][8]; float ss = 0.f;
#pragma unroll
        for (int j = 0; j < 2; ++j) { const v4u hv = *(const v4u*)(xres + (size_t)m * D + 8 * lane + 512 * j);
            f[j][0] = bflo(hv.x); f[j][1] = bfhi(hv.x); f[j][2] = bflo(hv.y); f[j][3] = bfhi(hv.y); f[j][4] = bflo(hv.z); f[j][5] = bfhi(hv.z); f[j][6] = bflo(hv.w); f[j][7] = bfhi(hv.w);
#pragma unroll
            for (int e = 0; e < 8; ++e) ss += f[j][e] * f[j][e]; }
        const float rstd = 1.0f / sqrtf(wave_sum(ss) * (1.f / D) + EPS);
#pragma unroll
        for (int j = 0; j < 2; ++j) { const int col = 8 * lane + 512 * j; const f32x4 g0 = *(const f32x4*)(gain + col), g1 = *(const f32x4*)(gain + col + 4);
            *(f32x4*)(out + (size_t)m * D + col) = (f32x4){f[j][0] * rstd * g0.x, f[j][1] * rstd * g0.y, f[j][2] * rstd * g0.z, f[j][3] * rstd * g0.w};
            *(f32x4*)(out + (size_t)m * D + col + 4) = (f32x4){f[j][4] * rstd * g1.x, f[j][5] * rstd * g1.y, f[j][6] * rstd * g1.z, f[j][7] * rstd * g1.w}; }
    }
}
struct RstdSlots { int pm0, pm1, pm2, pm3; };
__device__ __forceinline__ RstdSlots rstd_table(LAS float* rt, const float* sumsq, const pg8::StaticOrder& S, int tid) {
    int pmv[4] = {-1, -1, -1, -1}; int ns = 0;
    pg8::Unit u;
    for (int i = 0; S.next(i, u); ++i) { if (u.pm != pmv[0] && u.pm != pmv[1] && u.pm != pmv[2] && u.pm != pmv[3] && ns < 4) { if (ns == 0) pmv[0] = u.pm; else if (ns == 1) pmv[1] = u.pm; else if (ns == 2) pmv[2] = u.pm; else pmv[3] = u.pm; ++ns; } }
#pragma unroll
    for (int sl = 0; sl < 4; ++sl) { const int pm = sl == 0 ? pmv[0] : sl == 1 ? pmv[1] : sl == 2 ? pmv[2] : pmv[3];
        if (pm >= 0 && tid < 256) { const f32x4 s4 = *(const f32x4*)(sumsq + (size_t)(pm * 256 + tid) * 4); rt[sl * 256 + tid] = 1.0f / sqrtf(((s4.x + s4.y) + (s4.z + s4.w)) * (1.f / D) + EPS); } }
    __syncthreads();
    return RstdSlots{pmv[0], pmv[1], pmv[2], pmv[3]};
}

__device__ __forceinline__ void head_norm_rows(int lane, int wave, int vcu, int G, const bf16* hun, const float* gout, const bf16* proj, bf16* aop, const bool GLA) {
    const int gw = vcu * NWAVES + wave, NGW = G * NWAVES;
    for (int m = gw; m < M; m += NGW) {
#pragma unroll
        for (int j = 0; j < 2; ++j) {
            const int col = 8 * lane + 512 * j;
            const v4u hv = *(const v4u*)(hun + (size_t)m * D + col);
            const v4u rv = *(const v4u*)(proj + (size_t)m * NPROJ + 2048 + col);
            float f[8] = {bflo(hv.x), bfhi(hv.x), bflo(hv.y), bfhi(hv.y), bflo(hv.z), bfhi(hv.z), bflo(hv.w), bfhi(hv.w)};
            const float r[8] = {bflo(rv.x), bfhi(rv.x), bflo(rv.y), bfhi(rv.y), bflo(rv.z), bfhi(rv.z), bflo(rv.w), bfhi(rv.w)};
            float sg[8];
#pragma unroll
            for (int e = 0; e < 8; ++e) sg[e] = __builtin_amdgcn_rcpf(1.0f + __expf(-r[e]));
            if (!GLA) {
#pragma unroll
                for (int e = 0; e < 8; ++e) f[e] *= sg[e];
            }
            float ss = 0.f;
#pragma unroll
            for (int e = 0; e < 8; ++e) ss += f[e] * f[e];
#pragma unroll
            for (int o = 1; o < 32; o <<= 1) ss += __shfl_xor(ss, o);
            const float rs = 1.0f / sqrtf(ss * (1.f / DV) + EPS);
            const f32x4 g0 = *(const f32x4*)(gout + col), g1 = *(const f32x4*)(gout + col + 4);
            const float gg[8] = {g0.x, g0.y, g0.z, g0.w, g1.x, g1.y, g1.z, g1.w};
#pragma unroll
            for (int e = 0; e < 8; ++e) f[e] = f[e] * rs * gg[e];
            if (GLA) {
#pragma unroll
                for (int e = 0; e < 8; ++e) f[e] *= r[e] * sg[e];
            }
            v4u o; o.x = pk_bf16(f[0], f[1]); o.y = pk_bf16(f[2], f[3]); o.z = pk_bf16(f[4], f[5]); o.w = pk_bf16(f[6], f[7]);
            *(v4u*)(aop + (size_t)m * D + col) = o;
        }
    }
}

constexpr int GP_WGT = 0, GP_WGT_PITCH = 2064, GP_ZL = 33024, GP_TOT = 41216, GP_Q = 43264, GP_K = 59648;
__device__ __forceinline__ void gla_prep(LAS unsigned char* lds, int tid, int lane, int wave, int vcu, int G, const bf16* proj, const bf16* xres, const float* sumsq, const float* w_in, const float* gmix,
                                         const float* wup, const float* bgate, bf16* QT, bf16* KT, float* gdec) {
    LAS float* zl = (LAS float*)(lds + GP_ZL);
    LAS float* tot = (LAS float*)(lds + GP_TOT);
    LAS unsigned short* tq = (LAS unsigned short*)(lds + GP_Q);
    LAS unsigned short* tk = (LAS unsigned short*)(lds + GP_K);
    __syncthreads();
    { float wv[32];
#pragma unroll
      for (int n = 0; n < 32; ++n) { const int i = tid + NTHREADS * n, k = i >> 4, c = i & 15; wv[n] = gmix[k] * w_in[(size_t)k * GLA_IN + NPROJ + c]; }
#pragma unroll
      for (int n = 0; n < 32; ++n) { const int i = tid + NTHREADS * n, k = i >> 4, c = i & 15; *(LAS unsigned short*)(lds + GP_WGT + c * GP_WGT_PITCH + k * 2) = f2bf1(wv[n]); } }
    const int d = tid & 127, rg = tid >> 7;
    for (int unit = vcu; unit < BATCH * NCH; unit += G) {
        const int b = unit / NCH, c = unit % NCH, tok0 = b * SEQ + c * CH;
        v4u pq[2], pk[2]; float wu[16]; float bg;
#define GP_LOAD(h_) do { _Pragma("unroll") for (int i_ = 0; i_ < 2; ++i_) { const int p_ = tid + NTHREADS * i_, row_ = p_ >> 4, ch_ = p_ & 15; \
            pq[i_] = *(const v4u*)(proj + (size_t)(tok0 + row_) * NPROJ + (h_) * DK + ch_ * 8); pk[i_] = *(const v4u*)(proj + (size_t)(tok0 + row_) * NPROJ + QKW + (h_) * DK + ch_ * 8); } \
            _Pragma("unroll") for (int cc_ = 0; cc_ < 16; ++cc_) wu[cc_] = wup[cc_ * QKW + (h_) * DK + d]; bg = bgate[(h_) * DK + d]; } while (0)
        GP_LOAD(0);
        __syncthreads();
        {
            const int rt = wave & 3, kh = wave >> 2, r16 = lane & 15, kq = lane >> 4;
            pg8::f32x4 acc = {0.f, 0.f, 0.f, 0.f};
            const bf16* xr = xres + (size_t)(tok0 + 16 * rt + r16) * D + kh * 512 + 8 * kq;
            LAS unsigned char* wr_ = lds + GP_WGT + r16 * GP_WGT_PITCH + (kh * 512 + 8 * kq) * 2;
#pragma unroll
            for (int ks = 0; ks < 16; ++ks) { const bf16x8 av = *(const bf16x8*)(xr + 32 * ks), bv = *(const LAS bf16x8*)(wr_ + 64 * ks); acc = __builtin_amdgcn_mfma_f32_16x16x32_bf16(av, bv, acc, 0, 0, 0); }
#pragma unroll
            for (int i = 0; i < 4; ++i) zl[kh * 1024 + (16 * rt + 4 * kq + i) * 16 + r16] = acc[i];
        }
        __syncthreads();
        { const int row = tid >> 3, c2 = (tid & 7) * 2;
          const f32x4 s4 = *(const f32x4*)(sumsq + (size_t)(tok0 + row) * 4); const float rstd = 1.0f / sqrtf(((s4.x + s4.y) + (s4.z + s4.w)) * (1.f / D) + EPS);
          const float z0 = (zl[row * 16 + c2] + zl[1024 + row * 16 + c2]) * rstd, z1 = (zl[row * 16 + c2 + 1] + zl[1024 + row * 16 + c2 + 1]) * rstd;
          __syncthreads();
          zl[row * 16 + c2] = z0; zl[row * 16 + c2 + 1] = z1; }
        __syncthreads();
#pragma unroll
        for (int h = 0; h < NH; ++h) {
#pragma unroll
            for (int i = 0; i < 2; ++i) { const int p = tid + NTHREADS * i; *(LAS v4u*)(lds + GP_Q + p * 16) = pq[i]; *(LAS v4u*)(lds + GP_K + p * 16) = pk[i]; }
            float wuh[16]; const float bgh = bg;
#pragma unroll
            for (int cc = 0; cc < 16; ++cc) wuh[cc] = wu[cc];
            if (h + 1 < NH) GP_LOAD(h + 1);
            float bcum[16]; float run = 0.f;
#pragma unroll
            for (int jj = 0; jj < 16; ++jj) {
                const int j = 16 * rg + jj; float z = bgh;
#pragma unroll
                for (int q4 = 0; q4 < 4; ++q4) { const f32x4 zz = *(const LAS f32x4*)(zl + j * 16 + 4 * q4); z += (zz.x * wuh[4 * q4] + zz.y * wuh[4 * q4 + 1]) + (zz.z * wuh[4 * q4 + 2] + zz.w * wuh[4 * q4 + 3]); }
                const float la = (fminf(z, 0.f) - __logf(1.0f + __expf(-fabsf(z)))) * INV_TAU;
                run += la; bcum[jj] = run;
            }
            tot[rg * 128 + d] = run;
            __syncthreads();
            float off = 0.f, g = 0.f;
#pragma unroll
            for (int r2 = 0; r2 < 4; ++r2) { const float t = tot[r2 * 128 + d]; g += t; off += (r2 < rg) ? t : 0.f; }
#pragma unroll
            for (int jj = 0; jj < 16; ++jj) {
                const int j = 16 * rg + jj; const float eb = __expf(bcum[jj] + off);
                const float q = bf2f(tq[j * 128 + d]), k = bf2f(tk[j * 128 + d]);
                tq[j * 128 + d] = f2bf1(q * QK_SCALE * eb); tk[j * 128 + d] = f2bf1(k * __builtin_amdgcn_rcpf(eb));
            }
            if (rg == 0) gdec[(size_t)(unit * NH + h) * DK + d] = __expf(g);
            __syncthreads();
#pragma unroll
            for (int i = 0; i < 2; ++i) { const int p = tid + NTHREADS * i, row = p >> 4, ch = p & 15;
                *(v4u*)(QT + (size_t)(tok0 + row) * QKW + h * DK + ch * 8) = *(const LAS v4u*)(lds + GP_Q + p * 16);
                *(v4u*)(KT + (size_t)(tok0 + row) * QKW + h * DK + ch * 8) = *(const LAS v4u*)(lds + GP_K + p * 16); }
            __syncthreads();
        }
#undef GP_LOAD
    }
    __syncthreads();
}

#ifndef PROBE_T
#define PROBE_T 0
#endif
#ifndef PROBE_T_MLSTM
#define PROBE_T_MLSTM 0
#endif
#ifndef PROBE_T_WAVE
#define PROBE_T_WAVE 0
#endif
#ifndef PROBE_T_A
#define PROBE_T_A 5
#endif
#ifndef PROBE_T_B
#define PROBE_T_B 0
#endif
constexpr int CW_PROBE = 12288;
__device__ __forceinline__ unsigned long long pt_now() { unsigned long long t; __builtin_amdgcn_sched_barrier(0); asm volatile("s_memrealtime %0\n\ts_waitcnt lgkmcnt(0)" : "=s"(t) :: "memory"); __builtin_amdgcn_sched_barrier(0); return t; }
#define PT_NOW() pt_now()
#define PT_ACC(i, t0) do { if (PROBE_T) { const unsigned long long t1_ = PT_NOW(); pt[i] += (unsigned)(t1_ - (t0)); (t0) = t1_; } } while (0)
constexpr int PS_PITCH = 144, CT_PITCH = 272, CT_BYTES = 32 * CT_PITCH, IMG_PITCH = 272, IMG_BYTES = 64 * IMG_PITCH, NUM_PITCH = 36;
template <bool MLSTM> struct MxMap;
template <> struct MxMap<true>  { static constexpr int QS = 0, KS = 34816, V = 69632, VW = 77824, VWAUX = 81920, PS = 86016, CT = 95232, TB = 112640, TWP = 120832, TPM = 129024, TSC = 137216, DEN = 137728, NUM = 138240, OUTT = 0, GDEC = 0, END = 147456; };
template <> struct MxMap<false> { static constexpr int QS = 0, KS = 34816, V = 69632, VW = 0, VWAUX = 0, PS = 77824, CT = 87040, TB = 0, TWP = 0, TPM = 0, TSC = 0, DEN = 0, NUM = 0, OUTT = 104448, GDEC = 108544, END = 109568; };
#define LDSA(p) ((unsigned)(size_t)(p))
__device__ __forceinline__ bf16x8 mk8(v2u lo, v2u hi) { v4u w; w.x = lo.x; w.y = lo.y; w.z = hi.x; w.w = hi.y; return __builtin_bit_cast(bf16x8, w); }
__device__ __forceinline__ void tr_read2(bf16x8& f0, bf16x8& f1, unsigned a0, unsigned a1, unsigned b0, unsigned b1) {
    v2u l0, h0, l1, h1;
    asm volatile("ds_read_b64_tr_b16 %0, %4\n\tds_read_b64_tr_b16 %1, %5\n\tds_read_b64_tr_b16 %2, %6\n\tds_read_b64_tr_b16 %3, %7\n\ts_waitcnt lgkmcnt(0)"
                 : "=&v"(l0), "=&v"(h0), "=&v"(l1), "=&v"(h1) : "v"(a0), "v"(a1), "v"(b0), "v"(b1) : "memory");
    f0 = mk8(l0, h0); f1 = mk8(l1, h1);
}
__device__ __forceinline__ void tr_read3(bf16x8& f0, bf16x8& f1, bf16x8& f2, unsigned a0, unsigned a1, unsigned b0, unsigned b1, unsigned c0, unsigned c1) {
    v2u l0, h0, l1, h1, l2, h2;
    asm volatile("ds_read_b64_tr_b16 %0, %6\n\tds_read_b64_tr_b16 %1, %7\n\tds_read_b64_tr_b16 %2, %8\n\tds_read_b64_tr_b16 %3, %9\n\tds_read_b64_tr_b16 %4, %10\n\tds_read_b64_tr_b16 %5, %11\n\ts_waitcnt lgkmcnt(0)"
                 : "=&v"(l0), "=&v"(h0), "=&v"(l1), "=&v"(h1), "=&v"(l2), "=&v"(h2) : "v"(a0), "v"(a1), "v"(b0), "v"(b1), "v"(c0), "v"(c1) : "memory");
    f0 = mk8(l0, h0); f1 = mk8(l1, h1); f2 = mk8(l2, h2);
}
template <int P> __device__ __forceinline__ void tr_issue4(v2u (&x)[8], unsigned base) {
    asm volatile("ds_read_b64_tr_b16 %0, %8 offset:%9\n\tds_read_b64_tr_b16 %1, %8 offset:%10\n\tds_read_b64_tr_b16 %2, %8 offset:%11\n\tds_read_b64_tr_b16 %3, %8 offset:%12\n\t"
                 "ds_read_b64_tr_b16 %4, %8 offset:%13\n\tds_read_b64_tr_b16 %5, %8 offset:%14\n\tds_read_b64_tr_b16 %6, %8 offset:%15\n\tds_read_b64_tr_b16 %7, %8 offset:%16"
                 : "=&v"(x[0]), "=&v"(x[1]), "=&v"(x[2]), "=&v"(x[3]), "=&v"(x[4]), "=&v"(x[5]), "=&v"(x[6]), "=&v"(x[7])
                 : "v"(base), "i"(0), "i"(4 * P), "i"(16 * P), "i"(20 * P), "i"(32 * P), "i"(36 * P), "i"(48 * P), "i"(52 * P) : "memory");
}
__device__ __forceinline__ void tr_wait8(v2u (&x)[8]) { asm volatile("s_waitcnt lgkmcnt(0)" : "+v"(x[0]), "+v"(x[1]), "+v"(x[2]), "+v"(x[3]), "+v"(x[4]), "+v"(x[5]), "+v"(x[6]), "+v"(x[7]) :: "memory"); }
__device__ __forceinline__ void tr_pin8(v2u (&x)[8]) { asm volatile("" : "+v"(x[0]), "+v"(x[1]), "+v"(x[2]), "+v"(x[3]), "+v"(x[4]), "+v"(x[5]), "+v"(x[6]), "+v"(x[7])); }
__device__ __forceinline__ bf16x8 tr_read1(unsigned a0, unsigned a1) {
    v2u l0, h0;
    asm volatile("ds_read_b64_tr_b16 %0, %2\n\tds_read_b64_tr_b16 %1, %3\n\ts_waitcnt lgkmcnt(0)" : "=&v"(l0), "=&v"(h0) : "v"(a0), "v"(a1) : "memory");
    return mk8(l0, h0);
}
#define MFMA32(a, b, c) __builtin_amdgcn_mfma_f32_32x32x16_bf16((a), (b), (c), 0, 0, 0)
#define MX_BAR() do { asm volatile("s_waitcnt lgkmcnt(0)" ::: "memory"); __builtin_amdgcn_s_barrier(); asm volatile("" ::: "memory"); } while (0)
#define MX_BAR_VM() do { asm volatile("s_waitcnt vmcnt(0) lgkmcnt(0)" ::: "memory"); __builtin_amdgcn_s_barrier(); asm volatile("" ::: "memory"); } while (0)
struct MixArgs { const bf16 *q, *k, *proj; int qpitch; const float *gates, *bgate, *gdec; bf16* hun; void* probe; };
struct MixUnit { const bf16 *Qg, *Kg, *Vg; bf16* Hg; const float* gdec; int qpitch, b, hh; };
constexpr int MX_NPIECE = 38;
template <bool MLSTM> struct MixDma { static constexpr int PPW = 5; unsigned voff[PPW]; };
template <bool MLSTM> __device__ __forceinline__ int mx_piece(int wave, int i) { return wave + 8 * i; }

template <bool MLSTM>
__device__ __forceinline__ void mx_dma_setup(MixDma<MLSTM>& dm, int wave, int lane, int qpitch) {
#pragma unroll
    for (int i = 0; i < MixDma<MLSTM>::PPW; ++i) { const int pi = mx_piece<MLSTM>(wave, i); unsigned v = 0;
        if (pi < 34) { const int ob = (pi < 17 ? pi : pi - 17) * 1024 + lane * 16, row = ob / IMG_PITCH; int cb = ob - row * IMG_PITCH; cb = cb < 256 ? cb : 240; v = (unsigned)(row * qpitch * 2 + cb); }
        else { const int ob = (pi - 34) * 1024 + lane * 16, row = ob >> 6, cb = ob & 63; v = (unsigned)(row * NPROJ * 2 + cb); }
        dm.voff[i] = v; }
}
template <bool MLSTM>
__device__ __forceinline__ void mx_dma_issue(LAS unsigned char* lds, const MixDma<MLSTM>& dm, const MixUnit& U, int c, int wave, int tid) {
    typedef MxMap<MLSTM> MP;
    const int par = c & 1; const size_t tok0 = (size_t)U.b * SEQ + c * CH;
    const char* qb = (const char*)(U.Qg + tok0 * U.qpitch); const char* kb = (const char*)(U.Kg + tok0 * U.qpitch); const char* vb = (const char*)(U.Vg + tok0 * NPROJ);
#pragma unroll
    for (int i = 0; i < MixDma<MLSTM>::PPW; ++i) { const int pi = mx_piece<MLSTM>(wave, i);
        if (pi < MX_NPIECE) {
            const char* src; int dst;
            if (pi < 17) { src = qb; dst = MP::QS + par * IMG_BYTES + pi * 1024; }
            else if (pi < 34) { src = kb; dst = MP::KS + par * IMG_BYTES + (pi - 17) * 1024; }
            else { src = vb; dst = MP::V + par * 4096 + (pi - 34) * 1024; }
            __builtin_amdgcn_global_load_lds((const unsigned*)(src + dm.voff[i]), (LAS unsigned*)(lds + dst), 16, 0, 0);
        } }
    if (!MLSTM && wave == 7) {
        const float* gd = U.gdec + (size_t)(((U.b * NCH + c) * NH) + U.hh) * DK + (tid & 63);
        __builtin_amdgcn_global_load_lds((const unsigned*)gd, (LAS unsigned*)(lds + MP::GDEC + par * 512), 4, 0, 0);
        __builtin_amdgcn_global_load_lds((const unsigned*)(gd + 64), (LAS unsigned*)(lds + MP::GDEC + par * 512 + 256), 4, 0, 0);
    }
}
__device__ __forceinline__ void mx_store_tile(LAS unsigned char* outt, const f32x16& val, bf16* grow  , int lane, int r, int h5) {
#pragma unroll
    for (int i = 0; i < 16; ++i) *(LAS unsigned short*)(outt + ((i & 3) + 8 * (i >> 2) + 4 * h5) * 64 + r * 2) = f2bf1(val[i]);
#pragma unroll
    for (int i = 0; i < 2; ++i) { const int id = lane + 64 * i, row = id >> 2, pc = id & 3; const v4u w = *(const LAS v4u*)(outt + row * 64 + pc * 16); *(v4u*)(grow + (size_t)row * D + pc * 8) = w; }
}
__device__ __forceinline__ void mx_finalize_mlstm(LAS unsigned char* lds, const MixUnit& U, int cf, int fl) {
    typedef MxMap<true> MP;
    const int j = fl >> 2, sg = fl & 3; const float mc = ((const LAS float*)(lds + MP::TSC))[cf];
    const float dn = ((const LAS float*)(lds + MP::DEN))[j], bb = ((const LAS float*)(lds + MP::TB))[cf * 64 + j], pm = ((const LAS float*)(lds + MP::TPM))[cf * 64 + j];
    const float rden = QK_SCALE * __builtin_amdgcn_rcpf(fmaxf(fabsf(dn) * QK_SCALE, __expf(-bb - fmaxf(mc, pm))));
    const f32x4 n0 = *(const LAS f32x4*)((const LAS float*)(lds + MP::NUM) + j * NUM_PITCH + 8 * sg) * rden, n1 = *(const LAS f32x4*)((const LAS float*)(lds + MP::NUM) + j * NUM_PITCH + 8 * sg + 4) * rden;
    v4u w; w.x = pk_bf16(n0.x, n0.y); w.y = pk_bf16(n0.z, n0.w); w.z = pk_bf16(n1.x, n1.y); w.w = pk_bf16(n1.z, n1.w);
    *(v4u*)(U.Hg + (size_t)(U.b * SEQ + cf * CH + j) * D + 8 * sg) = w;
}

template <bool MLSTM>
__device__ __forceinline__ void mx_step(LAS unsigned char* lds, const MixDma<MLSTM>& dm, const MixUnit& U, int c, f32x16& accC0, f32x16& accC1, f32x16& accO, int tid, int lane, int wave, unsigned (&pt)[8]) {
    typedef MxMap<MLSTM> MP;
    unsigned long long tp = PROBE_T ? PT_NOW() : 0ull;
    const int r = lane & 31, h5 = lane >> 5, blk = (lane >> 4) & 1, q4 = (lane & 15) >> 2, p4 = lane & 3, par = c & 1;
    const LAS float* TSC = (const LAS float*)(lds + MP::TSC);
    LAS unsigned char* qimg0 = lds + MP::QS + par * IMG_BYTES; LAS unsigned char* kimg0 = lds + MP::KS + par * IMG_BYTES; LAS unsigned char* vimg0 = lds + MP::V + par * 4096;
    if (c + 1 < NCH) mx_dma_issue<MLSTM>(lds, dm, U, c + 1, wave, tid);
    PT_ACC(6, tp);
    const float mc = MLSTM ? TSC[c] : 0.f;
    if (wave < 4) {
        const int st = wave >> 1, jt = (wave == 1 || wave == 2) ? 1 : 0;
#pragma unroll
        for (int i = 0; i < 16; ++i) accO[i] = 0.f;
        if (wave != 3) {
            LAS unsigned char* kimg = kimg0 + (32 * st + r) * IMG_PITCH + 16 * h5;
            LAS unsigned char* qimg = qimg0 + (32 * jt + r) * IMG_PITCH + 16 * h5;
#pragma unroll
            for (int ks = 0; ks < 8; ++ks) { const bf16x8 a = *(const LAS bf16x8*)(kimg + 32 * ks), bq = *(const LAS bf16x8*)(qimg + 32 * ks); accO = MFMA32(a, bq, accO); }
        }
        const int j = 32 * jt + r; float uj = 0.f;
        if (MLSTM) uj = -fmaxf(mc, ((const LAS float*)(lds + MP::TPM))[c * 64 + j]);
#pragma unroll
        for (int g4 = 0; g4 < 4; ++g4) { const int s0 = 32 * st + 8 * g4 + 4 * h5; f32x4 wps = {0.f, 0.f, 0.f, 0.f}; if (MLSTM) wps = *(const LAS f32x4*)((const LAS float*)(lds + MP::TWP) + c * 64 + s0);
            float v[4];
#pragma unroll
            for (int e = 0; e < 4; ++e) { float x = accO[4 * g4 + e]; if (MLSTM) x *= __expf(uj + wps[e]); v[e] = (s0 + e <= j) ? x : 0.f; }
            v2u o; o.x = pk_bf16(v[0], v[1]); o.y = pk_bf16(v[2], v[3]); *(LAS v2u*)(lds + MP::PS + j * PS_PITCH + s0 * 2) = o; }
    } else {
        const int g = (wave - 4) >> 1, jt = wave & 1;
        if (MLSTM) {
            if (c > 0) mx_finalize_mlstm(lds, U, c - 1, tid - 256);
            { const int fl = tid - 256, row = fl >> 2, pc = fl & 3;
              const float wr_ = __expf(((const LAS float*)(lds + MP::TWP))[c * 64 + row] - TSC[32 + c]); const v4u pv = *(const LAS v4u*)(vimg0 + row * 64 + pc * 16); v4u o;
              o.x = pk_bf16(bflo(pv.x) * wr_, bfhi(pv.x) * wr_); o.y = pk_bf16(bflo(pv.y) * wr_, bfhi(pv.y) * wr_); o.z = pk_bf16(bflo(pv.z) * wr_, bfhi(pv.z) * wr_); o.w = pk_bf16(bflo(pv.w) * wr_, bfhi(pv.w) * wr_);
              *(LAS v4u*)(lds + MP::VW + row * 64 + pc * 16) = o;
              if (pc == 0) *(LAS unsigned short*)(lds + MP::VWAUX + row * 64) = f2bf1(wr_); }
        }
        if (MLSTM || g == 0) {
#pragma unroll
            for (int i = 0; i < 16; ++i) accO[i] = 0.f;
#pragma unroll
            for (int ks = 0; ks < 8; ++ks) { const bf16x8 a = *(const LAS bf16x8*)(qimg0 + (32 * jt + r) * IMG_PITCH + 16 * h5 + 32 * ks), bc = *(const LAS bf16x8*)(lds + MP::CT + g * CT_BYTES + r * CT_PITCH + 32 * ks + 16 * h5); accO = MFMA32(a, bc, accO); }
            if (MLSTM) {
#pragma unroll
                for (int g4 = 0; g4 < 4; ++g4) { const f32x4 pm = *(const LAS f32x4*)((const LAS float*)(lds + MP::TPM) + c * 64 + 32 * jt + 8 * g4 + 4 * h5);
#pragma unroll
                    for (int e = 0; e < 4; ++e) accO[4 * g4 + e] *= __expf(mc - fmaxf(mc, pm[e])); }
            }
        }
    }
    PT_ACC(2, tp);
    MX_BAR();
    PT_ACC(3, tp);
    if (wave < 4) {
        if (MLSTM) { const float decay = __expf(mc - TSC[32 + c]); accC0 = accC0 * decay; accC1 = accC1 * decay; }
        LAS unsigned char* kimg = kimg0 + (8 * h5 + q4) * IMG_PITCH + 64 * wave + 32 * blk + 8 * p4;
        LAS unsigned char* vimg = (MLSTM ? lds + MP::VW : vimg0) + (8 * h5 + q4) * 64 + 32 * blk + 8 * p4;
        LAS unsigned char* vaux = lds + MP::VWAUX + (8 * h5 + q4) * 64 + 32 * blk + 8 * p4;
        { v2u xk[8], xv[8], xa[8];
          tr_issue4<IMG_PITCH>(xk, LDSA(kimg)); tr_issue4<64>(xv, LDSA(vimg)); if (MLSTM) tr_issue4<64>(xa, LDSA(vaux));
          tr_wait8(xk); tr_pin8(xv); if (MLSTM) tr_pin8(xa);
          __builtin_amdgcn_sched_barrier(0);
#pragma unroll
          for (int ks = 0; ks < 4; ++ks) { const bf16x8 a = mk8(xk[2 * ks], xk[2 * ks + 1]);
              accC0 = MFMA32(a, mk8(xv[2 * ks], xv[2 * ks + 1]), accC0);
              if (MLSTM) accC1 = MFMA32(a, mk8(xa[2 * ks], xa[2 * ks + 1]), accC1); } }
        if (!MLSTM) {
#pragma unroll
            for (int g4 = 0; g4 < 4; ++g4) { const f32x4 dc = *(const LAS f32x4*)((const LAS float*)(lds + MP::GDEC) + par * 128 + 32 * wave + 8 * g4 + 4 * h5);
#pragma unroll
                for (int e = 0; e < 4; ++e) accC0[4 * g4 + e] *= dc[e]; }
        }
#pragma unroll
        for (int g4 = 0; g4 < 4; ++g4) { const int d0 = 32 * wave + 8 * g4 + 4 * h5;
            v2u o; o.x = pk_bf16(accC0[4 * g4], accC0[4 * g4 + 1]); o.y = pk_bf16(accC0[4 * g4 + 2], accC0[4 * g4 + 3]); *(LAS v2u*)(lds + MP::CT + r * CT_PITCH + d0 * 2) = o;
            if (MLSTM) { v2u o1; o1.x = pk_bf16(accC1[4 * g4], accC1[4 * g4 + 1]); o1.y = pk_bf16(accC1[4 * g4 + 2], accC1[4 * g4 + 3]); *(LAS v2u*)(lds + MP::CT + CT_BYTES + r * CT_PITCH + d0 * 2) = o1; } }
    } else {
        const int g = (wave - 4) >> 1, jt = wave & 1;
        if (MLSTM || g == 0) {
            const bf16x8 ones = (r == 0) ? (bf16x8){0x3F80, 0x3F80, 0x3F80, 0x3F80, 0x3F80, 0x3F80, 0x3F80, 0x3F80} : (bf16x8){0, 0, 0, 0, 0, 0, 0, 0};
            LAS unsigned char* vimg = vimg0 + (8 * h5 + q4) * 64 + 32 * blk + 8 * p4;
            bf16x8 pa[4];
#pragma unroll
            for (int ks = 0; ks < 4; ++ks) pa[ks] = *(const LAS bf16x8*)(lds + MP::PS + (32 * jt + r) * PS_PITCH + 32 * ks + 16 * h5);
            if (g == 0) { v2u xv[8]; tr_issue4<64>(xv, LDSA(vimg)); tr_wait8(xv); __builtin_amdgcn_sched_barrier(0);
#pragma unroll
                for (int ks = 0; ks < 4; ++ks) accO = MFMA32(pa[ks], mk8(xv[2 * ks], xv[2 * ks + 1]), accO);
            } else {
#pragma unroll
                for (int ks = 0; ks < 4; ++ks) accO = MFMA32(pa[ks], ones, accO); }
            if (MLSTM && g == 0) {
#pragma unroll
                for (int i = 0; i < 16; ++i) ((LAS float*)(lds + MP::NUM))[(32 * jt + (i & 3) + 8 * (i >> 2) + 4 * h5) * NUM_PITCH + r] = accO[i];
            }
            if (MLSTM && g == 1 && r == 0) {
#pragma unroll
                for (int i = 0; i < 16; ++i) ((LAS float*)(lds + MP::DEN))[32 * jt + (i & 3) + 8 * (i >> 2) + 4 * h5] = accO[i];
            }
            if (!MLSTM) mx_store_tile(lds + MP::OUTT + jt * 2048, accO, U.Hg + (size_t)(U.b * SEQ + c * CH + 32 * jt) * D, lane, r, h5);
        }
    }
    PT_ACC(4, tp);
    MX_BAR_VM();
    PT_ACC(5, tp);
}

template <bool MLSTM>
__device__ __forceinline__ void mixer_phase(LAS unsigned char* lds, int tid, int lane, int wave, int vcu, int G, const MixArgs A) {
    typedef MxMap<MLSTM> MP;
    MixDma<MLSTM> dm; mx_dma_setup<MLSTM>(dm, wave, lane, A.qpitch);
    unsigned pt[8] = {0u, 0u, 0u, 0u, 0u, 0u, 0u, 0u}; unsigned long long tph = PROBE_T ? PT_NOW() : 0ull; unsigned long long tin = tph;
    for (int unit = vcu; unit < BATCH * NH * 8; unit += G) {
        const int slice = unit & 7, bh = unit >> 3;
        MixUnit U; U.b = bh >> 2; U.hh = bh & 3; U.qpitch = A.qpitch; U.gdec = A.gdec;
        U.Qg = A.q + U.hh * DK; U.Kg = A.k + U.hh * DK; U.Vg = A.proj + 1024 + U.hh * DV + 32 * slice; U.Hg = A.hun + U.hh * DV + 32 * slice;
        MX_BAR_VM();
        mx_dma_issue<MLSTM>(lds, dm, U, 0, wave, tid);
        for (int i = tid; i < 2 * CT_BYTES / 4; i += NTHREADS) ((LAS unsigned*)(lds + MP::CT))[i] = 0u;
        if (MLSTM) {
            for (int i = tid; i < 1024; i += NTHREADS) ((LAS unsigned*)(lds + MP::VWAUX))[i] = 0u;
            LAS float* TB = (LAS float*)(lds + MP::TB); LAS float* TWP = (LAS float*)(lds + MP::TWP); LAS float* TPM = (LAS float*)(lds + MP::TPM); LAS float* TSC = (LAS float*)(lds + MP::TSC);
            const float bgi = A.bgate[U.hh], bgf = A.bgate[4 + U.hh];
            float gi4[4], gf4[4];
#pragma unroll
            for (int cc = 0; cc < 4; ++cc) { const size_t tok = (size_t)U.b * SEQ + (wave + 8 * cc) * CH + lane; gi4[cc] = A.gates[tok * 16 + U.hh] + bgi; gf4[cc] = A.gates[tok * 16 + 4 + U.hh] + bgf; }
#pragma unroll
            for (int cc = 0; cc < 4; ++cc) { const int c = wave + 8 * cc;
                const float lf = fminf(gf4[cc], 0.f) - __logf(1.0f + __expf(-fabsf(gf4[cc])));
                float bsum = lf;
#pragma unroll
                for (int o = 1; o < 64; o <<= 1) { const float t = __shfl_up(bsum, o); if (lane >= o) bsum += t; }
                const float wp = gi4[cc] - bsum; float pm = wp;
#pragma unroll
                for (int o = 1; o < 64; o <<= 1) { const float t = __shfl_up(pm, o); if (lane >= o) pm = fmaxf(pm, t); }
                TB[c * 64 + lane] = bsum; TWP[c * 64 + lane] = wp; TPM[c * 64 + lane] = pm;
                if (lane == 63) { TSC[64 + c] = bsum; TSC[96 + c] = pm; } }
            MX_BAR();
            if (wave == 0) {
                const float gl = TSC[64 + (lane & 31)], pl = TSC[96 + (lane & 31)]; float m = 0.f, myM = 0.f, myX = 0.f;
#pragma clang loop unroll(disable)
                for (int c = 0; c < NCH; ++c) { const float gc = __uint_as_float(__builtin_amdgcn_readlane(__float_as_uint(gl), c)), pc = __uint_as_float(__builtin_amdgcn_readlane(__float_as_uint(pl), c));
                    const float mxe = fmaxf(m, pc); if (lane == c) { myM = m; myX = mxe; } m = gc + mxe; }
                if (lane < 32) { TSC[lane] = myM; TSC[32 + lane] = myX; }
            }
        }
        f32x16 accC0, accC1, accO;
#pragma unroll
        for (int i = 0; i < 16; ++i) { accC0[i] = 0.f; accC1[i] = 0.f; accO[i] = 0.f; }
        MX_BAR_VM();
        PT_ACC(1, tin);
#pragma clang loop unroll(disable)
        for (int c = 0; c < NCH; ++c) mx_step<MLSTM>(lds, dm, U, c, accC0, accC1, accO, tid, lane, wave, pt);
        if (MLSTM && wave >= 4) mx_finalize_mlstm(lds, U, NCH - 1, tid - 256);
    }
    MX_BAR_VM();
    if (PROBE_T && (PROBE_T_MLSTM != 0) == MLSTM && vcu == 0 && wave == PROBE_T_WAVE && lane == 0) { PT_ACC(0, tph); unsigned* pw = (unsigned*)A.probe; pw[0] = pt[PROBE_T_A]; pw[1] = pt[PROBE_T_B]; }
}

constexpr int N_PHASES = 16, RT_OFF = RING_BYTES;
template <int PH>
__device__ __forceinline__ void run_phase(const Args& args, LAS unsigned char* lds, int tid, int lane, int wave, int vcu, int G, int bx) {
    unsigned char* ws = args.ws;
    constexpr int layer = (PH >= 8 && PH < 15) ? 1 : 0, k = (PH == 0) ? -1 : (PH == 15) ? 7 : PH - 1 - 7 * layer;
    unsigned char* wl = ws + (size_t)layer * WS_WLAYER;
    bf16* AOP = (bf16*)(ws + WS_AOP); bf16* PROJ = (bf16*)(ws + WS_PROJ); bf16* HMID = (bf16*)(ws + WS_HMID); bf16* XRES = (bf16*)(ws + WS_XRES);
    float* GATES = (float*)(ws + WS_GATES); float* SUMSQ = (float*)(ws + WS_SUMSQ);
    LAS float* RT = (LAS float*)(lds + RT_OFF);
    if constexpr (k == -1) {
        convert_weights(lds, lane, wave, vcu, G, args, ws);
        rows_first(lds, tid, lane, wave, vcu, G, args.in[0], args.in[1], XRES, SUMSQ, args.in[4] + NPROJ, MLSTM_IN, 8, GATES);
    } else if constexpr (k == 0) {
        pg8::Gemm g{XRES, (const bf16*)(wl + WS_WIN), M, NPROJ, D}; pg8::StaticOrder S; S.init(M, NPROJ, G, bx);
        const RstdSlots rs = rstd_table(RT, SUMSQ, S, tid);
        pg8::EpiBf16S<0> E{PROJ, NPROJ, (const LAS float*)RT, rs.pm1, rs.pm2, rs.pm3};
        pg8::gemm_phase<pg8::EpiBf16S<0>, pg8::StaticOrder, true, true>(lds, g, S, E);
    } else if constexpr (k == 1) {
        if (layer) gla_prep(lds, tid, lane, wave, vcu, G, PROJ, XRES, SUMSQ, args.in[8], args.in[1] + D, args.in[9], args.in[10], (bf16*)(ws + WS_QT), (bf16*)(ws + WS_KT), (float*)(ws + WS_GDEC));
    } else if constexpr (k == 2) {
        if (layer == 0) { const MixArgs A{PROJ, PROJ + QKW, PROJ, NPROJ, GATES, args.in[5], nullptr, AOP, ws + WS_CTL + 4 * CW_PROBE}; mixer_phase<true>(lds, tid, lane, wave, vcu, G, A); }
        else { const MixArgs A{(const bf16*)(ws + WS_QT), (const bf16*)(ws + WS_KT), PROJ, QKW, nullptr, nullptr, (const float*)(ws + WS_GDEC), AOP, ws + WS_CTL + 4 * CW_PROBE}; mixer_phase<false>(lds, tid, lane, wave, vcu, G, A); }
    } else if constexpr (k == 3) {
        head_norm_rows(lane, wave, vcu, G, AOP, args.in[layer ? 11 : 6], PROJ, AOP, layer != 0);
    } else if constexpr (k == 4) {
        pg8::Gemm g{AOP, (const bf16*)(wl + WS_WOUT), M, D, D}; pg8::StaticOrder S; S.init(M, D, G, bx);
        pg8::EpiResBf16Sq E{XRES, SUMSQ, D};
        pg8::gemm_phase<pg8::EpiResBf16Sq, pg8::StaticOrder, false, true>(lds, g, S, E);
    } else if constexpr (k == 5) {
        pg8::Gemm g{XRES, (const bf16*)(wl + WS_W1), M, FF, D}; pg8::StaticOrder S; S.init(M, FF, G, bx);
        const RstdSlots rs = rstd_table(RT, SUMSQ, S, tid);
        pg8::EpiBf16S<2> E{HMID, FF, (const LAS float*)RT, rs.pm1, rs.pm2, rs.pm3};
        pg8::gemm_phase<pg8::EpiBf16S<2>, pg8::StaticOrder, true, true>(lds, g, S, E);
    } else if constexpr (k == 6) {
        pg8::Gemm g{HMID, (const bf16*)(wl + WS_W2), M, D, FF}; pg8::StaticOrder S; S.init(M, D, G, bx);
        pg8::EpiResBf16Sq E{XRES, SUMSQ, D};
        pg8::gemm_phase<pg8::EpiResBf16Sq, pg8::StaticOrder, false, true>(lds, g, S, E);
    } else {
        rows_final(lane, wave, vcu, G, XRES, args.in[3], args.out);
    }
}
__global__ void __launch_bounds__(NTHREADS, 2) fwd_kernel(Args args) {
    extern __shared__ __attribute__((aligned(16))) unsigned char lds_raw[];
    LAS unsigned char* lds = (LAS unsigned char*)lds_raw;
    volatile LAS unsigned* MISC = (volatile LAS unsigned*)(lds + MISC_OFF);
    const int tid = threadIdx.x, lane = tid & 63, wave = __builtin_amdgcn_readfirstlane(tid >> 6);
    const int G = gridDim.x; int bx = blockIdx.x; int vcu = (G % 8 == 0) ? (bx % 8) * (G / 8) + bx / 8 : bx;
    for (int u = tid; u < (LDS_BYTES - LDSCTL_OFF) / 4; u += NTHREADS) ((LAS unsigned*)(lds + LDSCTL_OFF))[u] = 0u;
    __syncthreads();
    const int lo = args.ph_lo, hi = args.ph_hi;
    XcdBarrier bar; bar.bar = (unsigned*)(args.ws + WS_CTL) + CW_BAR; bar.x = 0; bar.st = nullptr;
    if (hi - lo > 1) { bar = xcd_barrier_post((unsigned*)(args.ws + WS_CTL) + CW_BAR, MISC + 8);
        if (tid == 0) { const unsigned xcc = xb_xcc_id(); MISC[16] = xcc; MISC[17] = xb_add((unsigned*)(args.ws + WS_CTL) + CW_XID + 64 * xcc, 1u); } }
#ifndef PROBE_PH
#define PROBE_PH (-1)
#endif
#ifndef PROBE_N
#define PROBE_N 0
#endif
#define PHASE(p) if (lo <= (p) && (p) < hi) { run_phase<p>(args, lds, tid, lane, wave, vcu, G, bx); \
        if ((p) == PROBE_PH) { for (int rep_ = 0; rep_ < PROBE_N; ++rep_) { xcd_barrier(bar); if (PROBE_PH >= 0) run_phase<((p) == PROBE_PH ? (p) : 2)>(args, lds, tid, lane, wave, vcu, G, bx); } } \
        if ((p) + 1 < hi && (p) != 2) xcd_barrier(bar); }
    PHASE(0)
    if (lo == 0 && hi > 1) {
        bool ok = (G == 256);
#pragma unroll
        for (unsigned j = 0; j < 16; ++j) { const unsigned cnt = xb_ld(&bar.bar[XB_XCNT(j)]); ok = ok && (cnt == (j < 8 ? 32u : 0u)); }
        const unsigned xcc = MISC[16], idx = MISC[17];
        if (ok && xcc < 8 && idx < 32) { vcu = (int)(xcc * 32 + idx); bx = (int)(idx * 8 + xcc); }
    }
    PHASE(1) PHASE(2) PHASE(3) PHASE(4) PHASE(5) PHASE(6) PHASE(7) PHASE(8) PHASE(9) PHASE(10) PHASE(11) PHASE(12) PHASE(13) PHASE(14) PHASE(15)
#undef PHASE
    if (PROBE_T && hi == N_PHASES && vcu == 0 && tid == 0) {
        const unsigned a = xb_ld((unsigned*)(args.ws + WS_CTL) + CW_PROBE), b = xb_ld((unsigned*)(args.ws + WS_CTL) + CW_PROBE + 1);
        const unsigned long long ticks = (unsigned long long)a * 5ull + (unsigned long long)(b / 50u) * 50000ull;
        const unsigned long long t0 = PT_NOW(); while (PT_NOW() - t0 < ticks) __builtin_amdgcn_s_sleep(8);
    }
}

extern "C" void kernel_launch(void* const* d_in, const int* in_sizes, int n_in, void* d_out, int out_size, void* d_ws, size_t ws_size, hipStream_t stream) {
    static int grid = 0;
    if (grid == 0) {
        if (n_in != 15 || in_sizes[0] != M * D || out_size != M * D || ws_size < WS_END) { fprintf(stderr, "kernel_launch: unexpected shapes (n_in %d, in0 %d, out %d, ws %zu); nothing launched\n", n_in, n_in > 0 ? in_sizes[0] : -1, out_size, ws_size); grid = -1; return; }
        int dev = 0, cus = 0, per_cu = 0;
        if (hipGetDevice(&dev) != hipSuccess || hipDeviceGetAttribute(&cus, hipDeviceAttributeMultiprocessorCount, dev) != hipSuccess) { grid = -1; return; }
        if (hipFuncSetAttribute((const void*)fwd_kernel, hipFuncAttributeMaxDynamicSharedMemorySize, LDS_BYTES) != hipSuccess) { fprintf(stderr, "kernel_launch: hipFuncSetAttribute failed\n"); grid = -1; return; }
        if (hipOccupancyMaxActiveBlocksPerMultiprocessor(&per_cu, (const void*)fwd_kernel, NTHREADS, LDS_BYTES) != hipSuccess || per_cu < 1) { fprintf(stderr, "kernel_launch: occupancy query says %d blocks per CU\n", per_cu); (void)hipGetLastError(); grid = -1; return; }
        grid = cus;
    }
    if (grid < 0) return;
    (void)hipMemsetAsync((char*)d_ws + WS_CTL, 0, CTL_ZERO_BYTES, stream);
    Args a{};
    for (int i = 0; i < 15; ++i) a.in[i] = (const float*)d_in[i];
    a.out = (float*)d_out; a.ws = (unsigned char*)d_ws;
    if (MK_N_LAUNCHES == 1) {
        a.ph_lo = 0; a.ph_hi = N_PHASES;
        void* kargs[] = {&a};
        const hipError_t e = hipLaunchCooperativeKernel((const void*)fwd_kernel, dim3(grid), dim3(NTHREADS), kargs, LDS_BYTES, stream);
        if (e != hipSuccess) fprintf(stderr, "kernel_launch: cooperative launch failed: %s (grid %d)\n", hipGetErrorString(e), grid);
    } else {
        for (int p = 0; p < N_PHASES; ++p) { a.ph_lo = p; a.ph_hi = p + 1; hipLaunchKernelGGL(fwd_kernel, dim3(grid), dim3(NTHREADS), LDS_BYTES, stream, a); }
    }
}
```

```cpp
#include <hip/hip_runtime.h>
#include <cstdio>
#include <cstdint>
namespace pg8 {
#define PG8_LAS __attribute__((address_space(3)))
typedef unsigned short bf16_t;
typedef short bf16x8 __attribute__((ext_vector_type(8)));
typedef float f32x4 __attribute__((ext_vector_type(4)));
typedef unsigned u32x4 __attribute__((ext_vector_type(4)));
constexpr int BM = 256, BK = 64, HALF = 128, HTB = HALF * BK * 2  , STAGE_BYTES = 8 * HTB, NXCD = 8, WGM = 8;

__host__ __device__ __forceinline__ int lds_byte(int r, int c) { const int st = (r >> 4) * 2 + (c >> 5), rr = r & 15, cc = c & 31, ob = rr * 64 + cc * 2; return st * 1024 + (ob ^ (((ob >> 9) & 1) << 5)); }
__host__ __device__ __forceinline__ void stage_rc(int b, int& R, int& C) { const int st = b / 1024, sb = b % 1024, swz = sb ^ (((sb >> 9) & 1) << 5); R = (st >> 1) * 16 + swz / 64; C = (st & 1) * 32 + (swz % 64) / 2; }
__host__ __device__ __forceinline__ int perm32(int rho) { const int n = rho >> 4, i = rho & 15; return 8 * (i >> 2) + 4 * n + (i & 3); }

struct Unit { int pm, pn; };
struct Gemm { const bf16_t* A; const bf16_t* Bt; int M, N, K; };

struct StaticOrder {
    int nM, nN, nwg, G, c;
    __host__ __device__ void init(int M, int N, int G_, int c_) { nM = M / BM; nN = N / BM; nwg = nM * nN; G = G_; c = c_; }
    __host__ __device__ bool next(int i, Unit& u) const {
        const long L = (long)i * G + c; if (L >= nwg) return false;
        int wgid = (int)L; { const int q = nwg / NXCD, r = nwg % NXCD, xcd = wgid % NXCD, off = wgid / NXCD; wgid = (xcd < r ? xcd * (q + 1) : r * (q + 1) + (xcd - r) * q) + off; }
        const int nig = WGM * nN, gid = wgid / nig, fm = gid * WGM, gsz = (nM - fm) < WGM ? (nM - fm) : WGM;
        u.pm = fm + ((wgid % nig) % gsz); u.pn = (wgid % nig) / gsz; return true;
    }
    __device__ __forceinline__ void a_ready(const Unit&) const {}
    __device__ __forceinline__ void done(const Unit&) const {}
};

__device__ __forceinline__ unsigned cvt_pk_bf16(float lo, float hi) { unsigned r; asm volatile("v_cvt_pk_bf16_f32 %0, %1, %2" : "=v"(r) : "v"(lo), "v"(hi)); return r; }
typedef float f32x2 __attribute__((ext_vector_type(2)));
typedef __bf16 bf16x2_t __attribute__((ext_vector_type(2)));
__device__ __forceinline__ unsigned pk_bf16(float lo, float hi) { f32x2 v = {lo, hi}; bf16x2_t r = __builtin_convertvector(v, bf16x2_t); return __builtin_bit_cast(unsigned, r); }
template <int ACT  > struct EpiBf16 {
    static constexpr bool PERM = true, AFTER_DRAIN = false;
    bf16_t* O; int ldc;
    __device__ __forceinline__ void operator()(const f32x4 (&acc)[2][2][4][2], const Unit& u, int wr, int wc, int fr, int fq) const {
        const int row0 = u.pm * BM + wr * 64 + fr, col0 = u.pn * BM + wc * 32 + 8 * fq;
#pragma unroll
        for (int ai = 0; ai < 2; ++ai)
#pragma unroll
            for (int m = 0; m < 4; ++m) { bf16_t* rowp = O + (size_t)(row0 + ai * HALF + m * 16) * ldc + col0;
#pragma unroll
                for (int bj = 0; bj < 2; ++bj) { f32x4 v0 = acc[ai][bj][m][0], v1 = acc[ai][bj][m][1];
                    if (ACT == 2) { const f32x4 z = {0.f, 0.f, 0.f, 0.f}; v0 = __builtin_elementwise_max(v0, z); v1 = __builtin_elementwise_max(v1, z); v0 = v0 * v0; v1 = v1 * v1; }
                    u32x4 w; w.x = pk_bf16(v0[0], v0[1]); w.y = pk_bf16(v0[2], v0[3]); w.z = pk_bf16(v1[0], v1[1]); w.w = pk_bf16(v1[2], v1[3]);
                    *(u32x4*)(rowp + bj * HALF) = w; } }
    }
};
struct EpiResF32 {
    static constexpr bool PERM = false, AFTER_DRAIN = true;
    const float* base; float* out; int ldc;
    __device__ __forceinline__ void fused(const f32x4 (&acc)[2][2][4][2], const Unit& u, int wr, int wc, int fr, int fq, PG8_LAS unsigned char*, int, int) const {
        const int col0 = u.pn * BM + wc * 32 + 4 * fq;
#pragma unroll
        for (int ai = 0; ai < 2; ++ai)
#pragma unroll
            for (int m = 0; m < 4; ++m) { const int r = ai * HALF + wr * 64 + m * 16 + fr; const size_t off = (size_t)(u.pm * BM + r) * ldc + col0;
#pragma unroll
                for (int bj = 0; bj < 2; ++bj) { const f32x4 b0 = *(const f32x4*)(base + off + bj * HALF), b1 = *(const f32x4*)(base + off + bj * HALF + 16);
                    *(f32x4*)(out + off + bj * HALF) = b0 + acc[ai][bj][m][0]; *(f32x4*)(out + off + bj * HALF + 16) = b1 + acc[ai][bj][m][1];
                    asm volatile("" ::: "memory"); } }
    }
};
typedef unsigned u32x2 __attribute__((ext_vector_type(2)));
__device__ __forceinline__ float bf_lo(unsigned w) { return __builtin_bit_cast(float, w << 16); }
__device__ __forceinline__ float bf_hi(unsigned w) { return __builtin_bit_cast(float, w & 0xffff0000u); }
template <int ACT  > struct EpiBf16S {
    static constexpr bool PERM = true, AFTER_DRAIN = false;
    bf16_t* O; int ldc; const PG8_LAS float* rt; int pm1, pm2, pm3;
    __device__ __forceinline__ void operator()(const f32x4 (&acc)[2][2][4][2], const Unit& u, int wr, int wc, int fr, int fq) const {
        const int col0 = u.pn * BM + wc * 32 + 8 * fq;
        const PG8_LAS float* rtp = rt + ((u.pm == pm1) ? 256 : (u.pm == pm2) ? 512 : (u.pm == pm3) ? 768 : 0) + wr * 64 + fr;
#pragma unroll
        for (int ai = 0; ai < 2; ++ai)
#pragma unroll
            for (int m = 0; m < 4; ++m) { const float rs = rtp[ai * HALF + m * 16];
                bf16_t* rowp = O + (size_t)(u.pm * BM + ai * HALF + wr * 64 + m * 16 + fr) * ldc + col0;
#pragma unroll
                for (int bj = 0; bj < 2; ++bj) { f32x4 v0 = acc[ai][bj][m][0] * rs, v1 = acc[ai][bj][m][1] * rs;
                    if (ACT == 2) { const f32x4 z = {0.f, 0.f, 0.f, 0.f}; v0 = __builtin_elementwise_max(v0, z); v1 = __builtin_elementwise_max(v1, z); v0 = v0 * v0; v1 = v1 * v1; }
                    u32x4 w; w.x = pk_bf16(v0[0], v0[1]); w.y = pk_bf16(v0[2], v0[3]); w.z = pk_bf16(v1[0], v1[1]); w.w = pk_bf16(v1[2], v1[3]);
                    *(u32x4*)(rowp + bj * HALF) = w; } }
    }
};
struct EpiResBf16Sq {
    static constexpr bool PERM = false, AFTER_DRAIN = true;
    bf16_t* xres; float* sumsq; int ldc;
    __device__ __forceinline__ void fused(f32x4 (&acc)[2][2][4][2], const Unit& u, int wr, int wc, int fr, int fq, PG8_LAS unsigned char* lds, int wid, int lane) const {
        PG8_LAS float* P = (PG8_LAS float*)lds;
        const int col0 = u.pn * BM + wc * 32 + 4 * fq;
#pragma unroll
        for (int ai = 0; ai < 2; ++ai)
#pragma unroll
            for (int m = 0; m < 4; ++m) { const int r = ai * HALF + wr * 64 + m * 16 + fr; bf16_t* xp = xres + (size_t)(u.pm * BM + r) * ldc + col0; float ss = 0.f;
#pragma unroll
                for (int bj = 0; bj < 2; ++bj)
#pragma unroll
                    for (int n = 0; n < 2; ++n) { const u32x2 xb = *(const u32x2*)(xp + bj * HALF + n * 16); const f32x4 a = acc[ai][bj][m][n];
                        u32x2 w; w.x = pk_bf16(bf_lo(xb.x) + a[0], bf_hi(xb.x) + a[1]); w.y = pk_bf16(bf_lo(xb.y) + a[2], bf_hi(xb.y) + a[3]);
                        *(u32x2*)(xp + bj * HALF + n * 16) = w;
                        const float y0 = bf_lo(w.x), y1 = bf_hi(w.x), y2 = bf_lo(w.y), y3 = bf_hi(w.y); ss += (y0 * y0 + y1 * y1) + (y2 * y2 + y3 * y3); }
                ss += __shfl_xor(ss, 16); ss += __shfl_xor(ss, 32);
                if (fq == 0) P[r * 4 + wc] = ss;
                asm volatile("" ::: "memory"); }
        asm volatile("s_waitcnt lgkmcnt(0)" ::: "memory"); __builtin_amdgcn_s_barrier(); asm volatile("" ::: "memory");
        const int t = wid * 64 + lane;
        if (t < 256) { const f32x4 p = *(const PG8_LAS f32x4*)(P + t * 4); sumsq[(size_t)(u.pm * BM + t) * 4 + u.pn] = (p[0] + p[1]) + (p[2] + p[3]); }
    }
};
struct EpiFinalNorm {
    static constexpr bool PERM = false, AFTER_DRAIN = true;
    const bf16_t* xres; float* out; float* sumsq; unsigned* cnt; const float* gain; int ldc; float eps;
    __device__ __forceinline__ void fused(f32x4 (&acc)[2][2][4][2], const Unit& u, int wr, int wc, int fr, int fq, PG8_LAS unsigned char* lds, int wid, int lane) const {
        PG8_LAS float* P = (PG8_LAS float*)lds;
        PG8_LAS float* S = (PG8_LAS float*)(lds + 4096);
        const int col0 = u.pn * BM + wc * 32 + 4 * fq, t = wid * 64 + lane;
#pragma unroll
        for (int ai = 0; ai < 2; ++ai)
#pragma unroll
            for (int m = 0; m < 4; ++m) { const int r = ai * HALF + wr * 64 + m * 16 + fr; const bf16_t* xp = xres + (size_t)(u.pm * BM + r) * ldc + col0; float ss = 0.f;
#pragma unroll
                for (int bj = 0; bj < 2; ++bj)
#pragma unroll
                    for (int n = 0; n < 2; ++n) { const u32x2 xb = *(const u32x2*)(xp + bj * HALF + n * 16); f32x4 y = acc[ai][bj][m][n];
                        y[0] += bf_lo(xb.x); y[1] += bf_hi(xb.x); y[2] += bf_lo(xb.y); y[3] += bf_hi(xb.y); acc[ai][bj][m][n] = y; ss += (y[0] * y[0] + y[1] * y[1]) + (y[2] * y[2] + y[3] * y[3]); }
                ss += __shfl_xor(ss, 16); ss += __shfl_xor(ss, 32);
                if (fq == 0) P[r * 4 + wc] = ss;
                asm volatile("" ::: "memory"); }
        asm volatile("s_waitcnt lgkmcnt(0)" ::: "memory"); __builtin_amdgcn_s_barrier(); asm volatile("" ::: "memory");
        if (t < 256) { const f32x4 p = *(const PG8_LAS f32x4*)(P + t * 4); __hip_atomic_store(sumsq + (size_t)(u.pm * BM + t) * 4 + u.pn, (p[0] + p[1]) + (p[2] + p[3]), __ATOMIC_RELAXED, __HIP_MEMORY_SCOPE_AGENT); }
        asm volatile("s_waitcnt vmcnt(0)" ::: "memory"); __builtin_amdgcn_s_barrier(); asm volatile("" ::: "memory");
        if (t == 0) {
            __hip_atomic_fetch_add(cnt + 16 * u.pm, 1u, __ATOMIC_RELAXED, __HIP_MEMORY_SCOPE_AGENT);
            unsigned sp = 0;
            while (__hip_atomic_load(cnt + 16 * u.pm, __ATOMIC_RELAXED, __HIP_MEMORY_SCOPE_AGENT) < 4u && ++sp < (1u << 22)) __builtin_amdgcn_s_sleep(2);
            __builtin_amdgcn_fence(__ATOMIC_ACQUIRE, "agent");
        }
        asm volatile("s_waitcnt vmcnt(0) lgkmcnt(0)" ::: "memory"); __builtin_amdgcn_s_barrier(); asm volatile("" ::: "memory");
        if (t < 256) { float s4 = 0.f;
#pragma unroll
            for (int q = 0; q < 4; ++q) s4 += __hip_atomic_load(sumsq + (size_t)(u.pm * BM + t) * 4 + q, __ATOMIC_RELAXED, __HIP_MEMORY_SCOPE_AGENT);
            S[t] = 1.0f / sqrtf(s4 / (float)ldc + eps); }
        asm volatile("s_waitcnt lgkmcnt(0)" ::: "memory"); __builtin_amdgcn_s_barrier(); asm volatile("" ::: "memory");
        f32x4 gv[2][2];
#pragma unroll
        for (int bj = 0; bj < 2; ++bj)
#pragma unroll
            for (int n = 0; n < 2; ++n) gv[bj][n] = *(const f32x4*)(gain + col0 + bj * HALF + n * 16);
#pragma unroll
        for (int ai = 0; ai < 2; ++ai)
#pragma unroll
            for (int m = 0; m < 4; ++m) { const int r = ai * HALF + wr * 64 + m * 16 + fr; const float rs = S[r]; float* op = out + (size_t)(u.pm * BM + r) * ldc + col0;
#pragma unroll
                for (int bj = 0; bj < 2; ++bj)
#pragma unroll
                    for (int n = 0; n < 2; ++n) *(f32x4*)(op + bj * HALF + n * 16) = acc[ai][bj][m][n] * rs * gv[bj][n]; }
    }
};
template <class Epi, class Sched, bool ALIGN_EPI = false, bool SP2 = false>
__device__ __forceinline__ void gemm_phase(PG8_LAS unsigned char* lds, const Gemm g, const Sched& S, const Epi& E) {
    const int tid = threadIdx.x, wid = __builtin_amdgcn_readfirstlane(tid >> 6), lane = tid & 63, wr = wid >> 2, wc = wid & 3, fr = lane & 15, fq = lane >> 4;
    const int K = g.K, nt = K / BK;
    unsigned voffA[2], voffB[2];
#pragma unroll
    for (int i = 0; i < 2; ++i) { int R, C; stage_rc(tid * 16 + i * 8192, R, C); const int Rb = Epi::PERM ? ((R & ~31) + perm32(R & 31)) : R;
        voffA[i] = (unsigned)(R * K + C) * 2u; voffB[i] = (unsigned)(Rb * K + C) * 2u; }
    const size_t kstep = (size_t)(BK * 2);
    const size_t hstep = (size_t)HALF * K * 2;
    const size_t tstep = 2 * hstep;
    const unsigned ldsw = (unsigned)wid * 1024u;
    const int aoff = lds_byte(wr * 64 + fr, fq * 8), boff = lds_byte(wc * 32 + fr, fq * 8);
#define PG8_SA(b, h) (((b) * 2 + (h)) * HTB)
#define PG8_SB(b, h) ((4 + (b) * 2 + (h)) * HTB)
#define PG8_STAGE(bufoff, gbase, voff) do { _Pragma("unroll") for (int _i = 0; _i < 2; ++_i) \
        __builtin_amdgcn_global_load_lds((const unsigned*)((const char*)(gbase) + (voff)[_i]), (PG8_LAS unsigned*)(lds + (bufoff) + ldsw + _i * 8192), 16, 0, 0); } while (0)
#define PG8_LDA(dst, b, h) do { _Pragma("unroll") for (int m = 0; m < 4; ++m) _Pragma("unroll") for (int k = 0; k < 2; ++k) dst[m][k] = *(const PG8_LAS bf16x8*)(lds + PG8_SA(b, h) + aoff + m * 2048 + k * 1024); } while (0)
#define PG8_LDB(dst, b, h) do { _Pragma("unroll") for (int n = 0; n < 2; ++n) _Pragma("unroll") for (int k = 0; k < 2; ++k) dst[n][k] = *(const PG8_LAS bf16x8*)(lds + PG8_SB(b, h) + boff + n * 2048 + k * 1024); } while (0)
#define PG8_MMA(ai, bj, At, Bt) do { __builtin_amdgcn_s_setprio(1); _Pragma("unroll") for (int m = 0; m < 4; ++m) _Pragma("unroll") for (int n = 0; n < 2; ++n) _Pragma("unroll") for (int k = 0; k < 2; ++k) \
        acc[ai][bj][m][n] = __builtin_amdgcn_mfma_f32_16x16x32_bf16(Bt[n][k], At[m][k], acc[ai][bj][m][n], 0, 0, 0); __builtin_amdgcn_s_setprio(0); } while (0)
#define PG8_WAIT_V(n) asm volatile("s_waitcnt vmcnt(" #n ")" ::: "memory")
#define PG8_WAIT_L(n) asm volatile("s_waitcnt lgkmcnt(" #n ")" ::: "memory")
#define PG8_BAR __builtin_amdgcn_s_barrier()
#define PG8_SCHED __builtin_amdgcn_sched_barrier(0)
    Unit cur, nxt; int ui = 0;
    if (!S.next(0, cur)) return;
    f32x4 acc[2][2][4][2];
#pragma unroll
    for (int a = 0; a < 2; ++a)
#pragma unroll
        for (int b = 0; b < 2; ++b)
#pragma unroll
            for (int m = 0; m < 4; ++m)
#pragma unroll
                for (int n = 0; n < 2; ++n) acc[a][b][m][n] = (f32x4){0.f, 0.f, 0.f, 0.f};
    bf16x8 At[4][2], B0[2][2], B1[2][2];
    const char* cA = (const char*)g.A + (size_t)cur.pm * tstep; const char* cB = (const char*)g.Bt + (size_t)cur.pn * tstep;
    S.a_ready(cur);
    if constexpr (SP2) {
        PG8_STAGE(PG8_SB(0, 0), cB, voffB); PG8_STAGE(PG8_SB(0, 1), cB + hstep, voffB); PG8_STAGE(PG8_SA(0, 0), cA, voffA); PG8_STAGE(PG8_SA(0, 1), cA + hstep, voffA);
        if (wr == 1) PG8_BAR;
        PG8_WAIT_V(2); PG8_BAR;
        PG8_STAGE(PG8_SB(1, 0), cB + kstep, voffB); PG8_STAGE(PG8_SA(1, 0), cA + kstep, voffA); PG8_STAGE(PG8_SB(1, 1), cB + hstep + kstep, voffB);
        PG8_WAIT_V(6); PG8_BAR;
    } else {
        PG8_STAGE(PG8_SB(0, 0), cB, voffB); PG8_STAGE(PG8_SA(0, 0), cA, voffA); PG8_STAGE(PG8_SB(0, 1), cB + hstep, voffB); PG8_STAGE(PG8_SA(0, 1), cA + hstep, voffA);
        if (wr == 1) PG8_BAR;
        PG8_WAIT_V(4); PG8_BAR;
        PG8_STAGE(PG8_SB(1, 0), cB + kstep, voffB); PG8_STAGE(PG8_SA(1, 0), cA + kstep, voffA); PG8_STAGE(PG8_SB(1, 1), cB + hstep + kstep, voffB);
        PG8_WAIT_V(6); PG8_BAR;
    }
    for (;;) {
        const bool has_next = S.next(ui + 1, nxt);
        const char* nA = has_next ? (const char*)g.A + (size_t)nxt.pm * tstep : cA; const char* nB = has_next ? (const char*)g.Bt + (size_t)nxt.pn * tstep : cB;
        for (int t = 0; t < nt; t += 2) {
            const bool last = (t == nt - 2);
            const char* a1 = cA + (size_t)(t + 1) * kstep;
            const char* a2 = last ? nA : cA + (size_t)(t + 2) * kstep; const char* b2 = last ? nB : cB + (size_t)(t + 2) * kstep;
            const char* a3 = a2 + kstep; const char* b3 = b2 + kstep;
            if (last && has_next) S.a_ready(nxt);
            if constexpr (SP2) {
            PG8_LDB(B0, 0, 0); PG8_LDB(B1, 0, 1); PG8_SCHED; PG8_LDA(At, 0, 0); PG8_STAGE(PG8_SA(1, 1), a1 + hstep, voffA);
            PG8_WAIT_V(8); PG8_WAIT_L(0); PG8_BAR; PG8_MMA(0, 0, At, B0); PG8_MMA(0, 1, At, B1); PG8_BAR; PG8_SCHED;
            PG8_LDA(At, 0, 1); PG8_STAGE(PG8_SB(0, 0), b2, voffB); PG8_STAGE(PG8_SB(0, 1), b2 + hstep, voffB); PG8_STAGE(PG8_SA(0, 0), a2, voffA);
            PG8_WAIT_V(8); PG8_WAIT_L(0); PG8_BAR; PG8_MMA(1, 0, At, B0); PG8_MMA(1, 1, At, B1); PG8_BAR; PG8_SCHED;
            PG8_LDB(B0, 1, 0); PG8_LDB(B1, 1, 1); PG8_SCHED; PG8_LDA(At, 1, 0); PG8_STAGE(PG8_SA(0, 1), a2 + hstep, voffA);
            PG8_WAIT_V(8); PG8_WAIT_L(0); PG8_BAR; PG8_MMA(0, 0, At, B0); PG8_MMA(0, 1, At, B1); PG8_BAR; PG8_SCHED;
            PG8_LDA(At, 1, 1); PG8_STAGE(PG8_SB(1, 0), b3, voffB); PG8_STAGE(PG8_SB(1, 1), b3 + hstep, voffB); PG8_STAGE(PG8_SA(1, 0), a3, voffA);
            PG8_WAIT_V(8); PG8_WAIT_L(0); PG8_BAR; PG8_MMA(1, 0, At, B0); PG8_MMA(1, 1, At, B1); PG8_BAR; PG8_SCHED;
            } else {
            PG8_LDB(B0, 0, 0); PG8_SCHED; PG8_LDA(At, 0, 0); PG8_STAGE(PG8_SA(1, 1), a1 + hstep, voffA);
            PG8_WAIT_L(8); PG8_BAR; PG8_WAIT_L(0); PG8_MMA(0, 0, At, B0); PG8_BAR; PG8_SCHED;
            PG8_LDB(B1, 0, 1); PG8_STAGE(PG8_SB(0, 0), b2, voffB);
            PG8_BAR; PG8_WAIT_L(0); PG8_MMA(0, 1, At, B1); PG8_BAR;
            PG8_LDA(At, 0, 1); PG8_STAGE(PG8_SA(0, 0), a2, voffA);
            PG8_BAR; PG8_WAIT_L(0); PG8_MMA(1, 0, At, B0); PG8_BAR; PG8_SCHED;
            PG8_STAGE(PG8_SB(0, 1), b2 + hstep, voffB);
            PG8_WAIT_V(6); PG8_BAR; PG8_MMA(1, 1, At, B1); PG8_BAR;
            PG8_LDB(B0, 1, 0); PG8_SCHED; PG8_LDA(At, 1, 0); PG8_STAGE(PG8_SA(0, 1), a2 + hstep, voffA);
            PG8_WAIT_L(8); PG8_BAR; PG8_WAIT_L(0); PG8_MMA(0, 0, At, B0); PG8_BAR; PG8_SCHED;
            PG8_LDB(B1, 1, 1); PG8_STAGE(PG8_SB(1, 0), b3, voffB);
            PG8_BAR; PG8_WAIT_L(0); PG8_MMA(0, 1, At, B1); PG8_BAR;
            PG8_LDA(At, 1, 1); PG8_STAGE(PG8_SA(1, 0), a3, voffA);
            PG8_BAR; PG8_WAIT_L(0); PG8_MMA(1, 0, At, B0); PG8_BAR; PG8_SCHED;
            PG8_STAGE(PG8_SB(1, 1), b3 + hstep, voffB);
            PG8_WAIT_V(6); PG8_BAR; PG8_MMA(1, 1, At, B1); PG8_BAR;
            }
        }
        if constexpr (ALIGN_EPI) { if (wr == 0) PG8_BAR; }
        if constexpr (!Epi::AFTER_DRAIN) { E(acc, cur, wr, wc, fr, fq); S.done(cur); }
        if (!has_next) break;
#pragma unroll
        for (int a = 0; a < 2; ++a)
#pragma unroll
            for (int b = 0; b < 2; ++b)
#pragma unroll
                for (int m = 0; m < 4; ++m)
#pragma unroll
                    for (int n = 0; n < 2; ++n) acc[a][b][m][n] = (f32x4){0.f, 0.f, 0.f, 0.f};
        cur = nxt; cA = nA; cB = nB; ++ui;
        if constexpr (ALIGN_EPI) { if (wr == 1) PG8_BAR; }
    }
    PG8_WAIT_V(0);
    if constexpr (!ALIGN_EPI) { if (wr == 0) PG8_BAR; }
    PG8_BAR;
    if constexpr (Epi::AFTER_DRAIN) { E.fused(acc, cur, wr, wc, fr, fq, lds, wid, lane); S.done(cur); }
#undef PG8_SA
#undef PG8_SB
#undef PG8_STAGE
#undef PG8_LDA
#undef PG8_LDB
#undef PG8_MMA
#undef PG8_WAIT_V
#undef PG8_WAIT_L
#undef PG8_BAR
#undef PG8_SCHED
}
}

constexpr int NWAVES = 8, NTHREADS = 512;
#ifndef MK_N_LAUNCHES
#define MK_N_LAUNCHES 1
#endif
constexpr int BATCH = 8, SEQ = 2048, D = 1024, FF = 4096, NH = 4, DK = 128, DV = 256, QKW = 512, VW = 1024;
constexpr int M = BATCH * SEQ, NPROJ = 3072, CH = 64, NCH = SEQ / CH;
constexpr int MLSTM_IN = 3080, GLA_IN = 3088;
constexpr float EPS = 1e-6f, QK_SCALE = 0.08838834764831845f, INV_TAU = 1.0f / 16.0f;

constexpr size_t MiB = 1u << 20;
constexpr size_t WS_CTL = 0, CTL_ZERO_BYTES = 64 * 1024;
constexpr size_t WS_GATES = 1 * MiB;
constexpr size_t WS_GDEC = 2 * MiB;
constexpr size_t WS_SUMSQ = 2 * MiB + 512 * 1024;
constexpr size_t WS_WIN = 4 * MiB, WS_WOUT = 10 * MiB, WS_W1 = 12 * MiB, WS_W2 = 20 * MiB, WS_WLAYER = 56 * MiB;
constexpr size_t WS_AOP = 28 * MiB;
constexpr size_t WS_PROJ = 92 * MiB;
constexpr size_t WS_QT = 188 * MiB, WS_KT = 204 * MiB;
constexpr size_t WS_HMID = 92 * MiB;
constexpr size_t WS_XRES = 220 * MiB;
constexpr size_t WS_END = 252 * MiB;
constexpr int CW_BAR = 1024, CW_XID = 8192, CW_FIN = 14336;

constexpr int RING_BYTES = 131072, LDS_BYTES = 155648, LDSCTL_OFF = LDS_BYTES - 1024, MISC_OFF = LDSCTL_OFF + 320;

#define GAS __attribute__((address_space(1)))
#define LAS __attribute__((address_space(3)))
typedef unsigned short bf16;
typedef unsigned v4u __attribute__((ext_vector_type(4)));
typedef unsigned v2u __attribute__((ext_vector_type(2)));
typedef float f32x4 __attribute__((ext_vector_type(4)));
typedef float f32x16 __attribute__((ext_vector_type(16)));
typedef short bf16x8 __attribute__((ext_vector_type(8)));
typedef short s16x4 __attribute__((ext_vector_type(4)));
typedef GAS unsigned gu32;
#define RLX_AGENT __ATOMIC_RELAXED, __HIP_MEMORY_SCOPE_AGENT
#define LDS_WAIT() asm volatile("s_waitcnt lgkmcnt(0)" ::: "memory")
#define VM_WAIT() asm volatile("s_waitcnt vmcnt(0)" ::: "memory")
using pg8::pk_bf16;
__device__ __forceinline__ float bf2f(unsigned b) { return __uint_as_float(b << 16); }
__device__ __forceinline__ float bflo(unsigned w) { return __uint_as_float(w << 16); }
__device__ __forceinline__ float bfhi(unsigned w) { return __uint_as_float(w & 0xffff0000u); }
__device__ __forceinline__ unsigned short f2bf1(float f) { return (unsigned short)(pk_bf16(f, 0.f) & 0xffffu); }

struct Args { const float* in[15]; float* out; unsigned char* ws; int ph_lo, ph_hi; };
#define XB_TMO      128
#define XB_XCNT(j)  (256  + 64 * (j))
#define XB_XSUB(j)  (1280 + 64 * (j))
#define XB_XGEN(j)  (2304 + 64 * (j))
#define XB_TOP      3328
#define XB_TOPGEN   3392
#define XCD_BAR_WORDS 3456
#define XB_SPIN_CAP (1u << 18)
__device__ __forceinline__ unsigned xb_ld(unsigned* p)              { return __hip_atomic_load(p, __ATOMIC_RELAXED, __HIP_MEMORY_SCOPE_AGENT); }
__device__ __forceinline__ unsigned xb_add(unsigned* p, unsigned v) { return __hip_atomic_fetch_add(p, v, __ATOMIC_RELAXED, __HIP_MEMORY_SCOPE_AGENT); }
__device__ __forceinline__ unsigned xb_xcc_id() { return (unsigned)__builtin_amdgcn_s_getreg((3 << 11) | 20) & 0xFu; }
#define XB_SPIN(cond, bar) do { unsigned _sp = 0; while (cond) { __builtin_amdgcn_s_sleep(1); \
    if ((++_sp & 255u) == 0u) { if (xb_ld(&(bar)[XB_TMO])) break; if (_sp > XB_SPIN_CAP) { atomicAdd(&(bar)[XB_TMO], 1u); break; } } } } while (0)
struct XcdBarrier { unsigned* bar; unsigned x; volatile LAS unsigned* st; };
__device__ __forceinline__ XcdBarrier xcd_barrier_post(unsigned* bar, volatile LAS unsigned* st) {
    XcdBarrier b; b.bar = bar; b.x = xb_xcc_id(); b.st = st;
    if (threadIdx.x == 0) (void)xb_add(&bar[XB_XCNT(b.x)], 1u);
    return b;
}
__device__ __forceinline__ void xcd_barrier_complete(unsigned* bar, unsigned x, unsigned& nloc, unsigned& nx) {
    const unsigned G = gridDim.x * gridDim.y * gridDim.z;
    unsigned sum, cnt, mine, sp = 0u;
    for (;;) {
        sum = 0u; cnt = 0u; mine = 0u;
#pragma unroll
        for (unsigned j = 0; j < 16; ++j) { const unsigned c = xb_ld(&bar[XB_XCNT(j)]); sum += c; cnt += (c > 0u) ? 1u : 0u; mine = (j == x) ? c : mine; }
        if (sum == G) break;
        __builtin_amdgcn_s_sleep(1);
        if ((++sp & 255u) == 0u) { if (xb_ld(&bar[XB_TMO])) break; if (sp > XB_SPIN_CAP) { atomicAdd(&bar[XB_TMO], 1u); break; } }
    }
    nloc = mine > 0u ? mine : 1u; nx = cnt > 0u ? cnt : 1u;
}
__device__ __forceinline__ void xcd_barrier(const XcdBarrier& b) {
    asm volatile("s_waitcnt vmcnt(0)" ::: "memory");
    __syncthreads();
    if (threadIdx.x == 0) {
        unsigned* bar = b.bar;
        __builtin_amdgcn_s_waitcnt(0);
        unsigned nloc = b.st[0], nx = b.st[1];
        if (nloc == 0u) { xcd_barrier_complete(bar, b.x, nloc, nx); b.st[0] = nloc; b.st[1] = nx; }
        const unsigned old = xb_add(&bar[XB_XSUB(b.x)], 1u);
        const unsigned gen = old / nloc;
        if (old + 1u == (gen + 1u) * nloc) {
            __builtin_amdgcn_fence(__ATOMIC_RELEASE, "agent");
            asm volatile("s_waitcnt vmcnt(0)" ::: "memory");
            const unsigned og = xb_add(&bar[XB_TOP], 1u);
            const unsigned tg = og / nx;
            if (og + 1u == (tg + 1u) * nx) xb_add(&bar[XB_TOPGEN], 1u);
            else XB_SPIN(xb_ld(&bar[XB_TOPGEN]) == tg, bar);
            __builtin_amdgcn_fence(__ATOMIC_ACQUIRE, "agent");
            xb_add(&bar[XB_XGEN(b.x)], 1u);
            asm volatile("s_waitcnt vmcnt(0)" ::: "memory");
        } else {
            XB_SPIN(xb_ld(&bar[XB_XGEN(b.x)]) == gen, bar);
            __builtin_amdgcn_fence(__ATOMIC_ACQUIRE, "agent");
            asm volatile("s_waitcnt vmcnt(0)" ::: "memory");
        }
    }
    __syncthreads();
}

__device__ __forceinline__ float wave_sum(float v) {
#pragma unroll
    for (int o = 1; o < 64; o <<= 1) v += __shfl_xor(v, o);
    return v;
}
__device__ __forceinline__ void transpose_item(const float* W, int K, int N, int ldw, bf16* WT, const float* gain, LAS float* scr, int item, int lane) {
    const int nblk = N / 32, kb = item / nblk, nb = item % nblk, k0 = 64 * kb, n0 = 32 * nb;
    const int n4 = (lane & 7) * 4, krow = lane >> 3;
    f32x4 v[8];
#pragma unroll
    for (int i = 0; i < 8; ++i) v[i] = *(const f32x4*)(W + (size_t)(k0 + 8 * i + krow) * ldw + n0 + n4);
#pragma unroll
    for (int i = 0; i < 8; ++i) *(LAS f32x4*)(scr + (8 * i + krow) * 32 + (n4 ^ (i << 2))) = v[i];
    const int c = lane & 7, nl = lane >> 3;
    f32x4 g0 = {1.f, 1.f, 1.f, 1.f}, g1 = {1.f, 1.f, 1.f, 1.f};
    if (gain) { g0 = *(const f32x4*)(gain + k0 + 8 * c); g1 = *(const f32x4*)(gain + k0 + 8 * c + 4); }
    LDS_WAIT(); asm volatile("" ::: "memory");
#pragma unroll
    for (int j = 0; j < 4; ++j) { const int n = 8 * j + nl; const LAS float* sp = scr + (8 * c) * 32 + (n ^ (c << 2));
        v4u o; o.x = pk_bf16(sp[0 * 32] * g0.x, sp[1 * 32] * g0.y); o.y = pk_bf16(sp[2 * 32] * g0.z, sp[3 * 32] * g0.w); o.z = pk_bf16(sp[4 * 32] * g1.x, sp[5 * 32] * g1.y); o.w = pk_bf16(sp[6 * 32] * g1.z, sp[7 * 32] * g1.w);
        *(GAS v4u*)(WT + (size_t)(n0 + n) * K + k0 + 8 * c) = o; }
    LDS_WAIT(); asm volatile("" ::: "memory");
}
__device__ __forceinline__ void convert_weights(LAS unsigned char* lds, int lane, int wave, int vcu, int G, const Args& args, unsigned char* ws) {
    LAS float* scr = (LAS float*)(lds + wave * 16384);
    const int gw = vcu * NWAVES + wave, NGW = G * NWAVES;
    constexpr int I_IN = (D / 64) * (NPROJ / 32), I_O = (D / 64) * (D / 32), I_1 = (D / 64) * (FF / 32), I_2 = (FF / 64) * (D / 32);
    constexpr int NITEMS = I_IN + I_O + I_1 + I_2;
    for (int it = gw; it < 2 * NITEMS; it += NGW) {
        const int layer = it >= NITEMS; int r = it - layer * NITEMS;
        unsigned char* wl = ws + (size_t)layer * WS_WLAYER;
        if (r < I_IN) { transpose_item(args.in[layer ? 8 : 4], D, NPROJ, layer ? GLA_IN : MLSTM_IN, (bf16*)(wl + WS_WIN), args.in[1] + layer * D, scr, r, lane); continue; } r -= I_IN;
        if (r < I_O) { transpose_item(args.in[layer ? 12 : 7], D, D, D, (bf16*)(wl + WS_WOUT), nullptr, scr, r, lane); continue; } r -= I_O;
        if (r < I_1) { transpose_item(args.in[13] + (size_t)layer * D * FF, D, FF, FF, (bf16*)(wl + WS_W1), args.in[2] + layer * D, scr, r, lane); continue; } r -= I_1;
        transpose_item(args.in[14] + (size_t)layer * D * FF, FF, D, D, (bf16*)(wl + WS_W2), nullptr, scr, r, lane);
    }
}

__device__ __forceinline__ void rows_first(LAS unsigned char* lds, int tid, int lane, int wave, int vcu, int G, const float* xin, const float* gain, bf16* xres, float* sumsq,
                                           const float* wg, int ldw, int ng, float* gates) {
    LAS float* WgT = (LAS float*)lds;
    __syncthreads();
    { float wv[32];
#pragma unroll
      for (int n = 0; n < 32; ++n) { const int i = tid + NTHREADS * n, k = i >> 4, c = i & 15; wv[n] = (c < ng) ? wg[(size_t)k * ldw + c] : 0.f; }
#pragma unroll
      for (int n = 0; n < 32; ++n) { const int i = tid + NTHREADS * n, k = i >> 4, c = i & 15; WgT[c * D + k] = wv[n]; } }
    __syncthreads();
    const int gw = vcu * NWAVES + wave, NGW = G * NWAVES;
    f32x4 gn[4];
#pragma unroll
    for (int j = 0; j < 4; ++j) gn[j] = *(const f32x4*)(gain + 4 * lane + 256 * j);
    for (int m = gw; m < M; m += NGW) {
        const float* xr = xin + (size_t)m * D + 4 * lane;
        f32x4 v[4]; float s = 0.f;
#pragma unroll
        for (int j = 0; j < 4; ++j) { v[j] = *(const f32x4*)(xr + 256 * j); s += (v[j].x * v[j].x + v[j].y * v[j].y) + (v[j].z * v[j].z + v[j].w * v[j].w); }
#pragma unroll
        for (int j = 0; j < 4; ++j) { v2u o; o.x = pk_bf16(v[j].x, v[j].y); o.y = pk_bf16(v[j].z, v[j].w); *(v2u*)(xres + (size_t)m * D + 4 * lane + 256 * j) = o; }
        const float ssum = wave_sum(s);
        if (lane == 0) *(f32x4*)(sumsq + (size_t)m * 4) = (f32x4){ssum, 0.f, 0.f, 0.f};
        const float rstd = 1.0f / sqrtf(ssum * (1.f / D) + EPS);
#pragma unroll
        for (int j = 0; j < 4; ++j) v[j] = v[j] * rstd * gn[j];
        float a[16];
#pragma unroll
        for (int c = 0; c < 16; ++c) a[c] = 0.f;
#pragma unroll
        for (int c = 0; c < 16; ++c) {
#pragma unroll
            for (int j = 0; j < 4; ++j) { const f32x4 w = *(const LAS f32x4*)(WgT + c * D + 4 * lane + 256 * j); a[c] += (v[j].x * w.x + v[j].y * w.y) + (v[j].z * w.z + v[j].w * w.w); }
            if (c & 1) asm volatile("" ::: "memory"); }
        const bool b5 = lane & 32, b4 = lane & 16, b3 = lane & 8, b2 = lane & 4;
#pragma unroll
        for (int i = 0; i < 8; ++i) { const float keep = b5 ? a[i + 8] : a[i], send = b5 ? a[i] : a[i + 8]; a[i] = keep + __shfl_xor(send, 32); }
#pragma unroll
        for (int i = 0; i < 4; ++i) { const float keep = b4 ? a[i + 4] : a[i], send = b4 ? a[i] : a[i + 4]; a[i] = keep + __shfl_xor(send, 16); }
#pragma unroll
        for (int i = 0; i < 2; ++i) { const float keep = b3 ? a[i + 2] : a[i], send = b3 ? a[i] : a[i + 2]; a[i] = keep + __shfl_xor(send, 8); }
        { const float keep = b2 ? a[1] : a[0], send = b2 ? a[0] : a[1]; a[0] = keep + __shfl_xor(send, 4); }
        a[0] += __shfl_xor(a[0], 2); a[0] += __shfl_xor(a[0], 1);
        const int c = (b5 ? 8 : 0) + (b4 ? 4 : 0) + (b3 ? 2 : 0) + (b2 ? 1 : 0);
        if ((lane & 3) == 0 && c < ng) gates[(size_t)m * 16 + c] = a[0];
    }
}
__device__ __forceinline__ void rows_final(int lane, int wave, int vcu, int G, const bf16* xres, const float* gain, float* out) {
    const int gw = vcu * NWAVES + wave, NGW = G * NWAVES;
    for (int m = gw; m < M; m += NGW) {
        float f[2][8]; float ss = 0.f;
#pragma unroll
        for (int j = 0; j < 2; ++j) { const v4u hv = *(const v4u*)(xres + (size_t)m * D + 8 * lane + 512 * j);
            f[j][0] = bflo(hv.x); f[j][1] = bfhi(hv.x); f[j][2] = bflo(hv.y); f[j][3] = bfhi(hv.y); f[j][4] = bflo(hv.z); f[j][5] = bfhi(hv.z); f[j][6] = bflo(hv.w); f[j][7] = bfhi(hv.w);
#pragma unroll
            for (int e = 0; e < 8; ++e) ss += f[j][e] * f[j][e]; }
        const float rstd = 1.0f / sqrtf(wave_sum(ss) * (1.f / D) + EPS);
#pragma unroll
        for (int j = 0; j < 2; ++j) { const int col = 8 * lane + 512 * j; const f32x4 g0 = *(const f32x4*)(gain + col), g1 = *(const f32x4*)(gain + col + 4);
            *(f32x4*)(out + (size_t)m * D + col) = (f32x4){f[j][0] * rstd * g0.x, f[j][1] * rstd * g0.y, f[j][2] * rstd * g0.z, f[j][3] * rstd * g0.w};
            *(f32x4*)(out + (size_t)m * D + col + 4) = (f32x4){f[j][4] * rstd * g1.x, f[j][5] * rstd * g1.y, f[j][6] * rstd * g1.z, f[j][7] * rstd * g1.w}; }
    }
}
struct RstdSlots { int pm0, pm1, pm2, pm3; };
__device__ __forceinline__ RstdSlots rstd_table(LAS float* rt, const float* sumsq, const pg8::StaticOrder& S, int tid) {
    int pmv[4] = {-1, -1, -1, -1}; int ns = 0;
    pg8::Unit u;
    for (int i = 0; S.next(i, u); ++i) { if (u.pm != pmv[0] && u.pm != pmv[1] && u.pm != pmv[2] && u.pm != pmv[3] && ns < 4) { if (ns == 0) pmv[0] = u.pm; else if (ns == 1) pmv[1] = u.pm; else if (ns == 2) pmv[2] = u.pm; else pmv[3] = u.pm; ++ns; } }
#pragma unroll
    for (int sl = 0; sl < 4; ++sl) { const int pm = sl == 0 ? pmv[0] : sl == 1 ? pmv[1] : sl == 2 ? pmv[2] : pmv[3];
        if (pm >= 0 && tid < 256) { const f32x4 s4 = *(const f32x4*)(sumsq + (size_t)(pm * 256 + tid) * 4); rt[sl * 256 + tid] = 1.0f / sqrtf(((s4.x + s4.y) + (s4.z + s4.w)) * (1.f / D) + EPS); } }
    __syncthreads();
    return RstdSlots{pmv[0], pmv[1], pmv[2], pmv[3]};
}

__device__ __forceinline__ void head_norm_rows(int lane, int wave, int vcu, int G, const bf16* hun, const float* gout, const bf16* proj, bf16* aop, const bool GLA) {
    const int gw = vcu * NWAVES + wave, NGW = G * NWAVES;
    for (int m = gw; m < M; m += NGW) {
#pragma unroll
        for (int j = 0; j < 2; ++j) {
            const int col = 8 * lane + 512 * j;
            const v4u hv = *(const v4u*)(hun + (size_t)m * D + col);
            const v4u rv = *(const v4u*)(proj + (size_t)m * NPROJ + 2048 + col);
            float f[8] = {bflo(hv.x), bfhi(hv.x), bflo(hv.y), bfhi(hv.y), bflo(hv.z), bfhi(hv.z), bflo(hv.w), bfhi(hv.w)};
            const float r[8] = {bflo(rv.x), bfhi(rv.x), bflo(rv.y), bfhi(rv.y), bflo(rv.z), bfhi(rv.z), bflo(rv.w), bfhi(rv.w)};
            float sg[8];
#pragma unroll
            for (int e = 0; e < 8; ++e) sg[e] = __builtin_amdgcn_rcpf(1.0f + __expf(-r[e]));
            if (!GLA) {
#pragma unroll
                for (int e = 0; e < 8; ++e) f[e] *= sg[e];
            }
            float ss = 0.f;
#pragma unroll
            for (int e = 0; e < 8; ++e) ss += f[e] * f[e];
#pragma unroll
            for (int o = 1; o < 32; o <<= 1) ss += __shfl_xor(ss, o);
            const float rs = 1.0f / sqrtf(ss * (1.f / DV) + EPS);
            const f32x4 g0 = *(const f32x4*)(gout + col), g1 = *(const f32x4*)(gout + col + 4);
            const float gg[8] = {g0.x, g0.y, g0.z, g0.w, g1.x, g1.y, g1.z, g1.w};
#pragma unroll
            for (int e = 0; e < 8; ++e) f[e] = f[e] * rs * gg[e];
            if (GLA) {
#pragma unroll
                for (int e = 0; e < 8; ++e) f[e] *= r[e] * sg[e];
            }
            v4u o; o.x = pk_bf16(f[0], f[1]); o.y = pk_bf16(f[2], f[3]); o.z = pk_bf16(f[4], f[5]); o.w = pk_bf16(f[6], f[7]);
            *(v4u*)(aop + (size_t)m * D + col) = o;
        }
    }
}

constexpr int GP_WGT = 0, GP_WGT_PITCH = 2064, GP_ZL = 33024, GP_TOT = 41216, GP_Q = 43264, GP_K = 59648;
__device__ __forceinline__ void gla_prep(LAS unsigned char* lds, int tid, int lane, int wave, int vcu, int G, const bf16* proj, const bf16* xres, const float* sumsq, const float* w_in, const float* gmix,
                                         const float* wup, const float* bgate, bf16* QT, bf16* KT, float* gdec) {
    LAS float* zl = (LAS float*)(lds + GP_ZL);
    LAS float* tot = (LAS float*)(lds + GP_TOT);
    LAS unsigned short* tq = (LAS unsigned short*)(lds + GP_Q);
    LAS unsigned short* tk = (LAS unsigned short*)(lds + GP_K);
    __syncthreads();
    { float wv[32];
#pragma unroll
      for (int n = 0; n < 32; ++n) { const int i = tid + NTHREADS * n, k = i >> 4, c = i & 15; wv[n] = gmix[k] * w_in[(size_t)k * GLA_IN + NPROJ + c]; }
#pragma unroll
      for (int n = 0; n < 32; ++n) { const int i = tid + NTHREADS * n, k = i >> 4, c = i & 15; *(LAS unsigned short*)(lds + GP_WGT + c * GP_WGT_PITCH + k * 2) = f2bf1(wv[n]); } }
    const int d = tid & 127, rg = tid >> 7;
    for (int unit = vcu; unit < BATCH * NCH; unit += G) {
        const int b = unit / NCH, c = unit % NCH, tok0 = b * SEQ + c * CH;
        v4u pq[2], pk[2]; float wu[16]; float bg;
#define GP_LOAD(h_) do { _Pragma("unroll") for (int i_ = 0; i_ < 2; ++i_) { const int p_ = tid + NTHREADS * i_, row_ = p_ >> 4, ch_ = p_ & 15; \
            pq[i_] = *(const v4u*)(proj + (size_t)(tok0 + row_) * NPROJ + (h_) * DK + ch_ * 8); pk[i_] = *(const v4u*)(proj + (size_t)(tok0 + row_) * NPROJ + QKW + (h_) * DK + ch_ * 8); } \
            _Pragma("unroll") for (int cc_ = 0; cc_ < 16; ++cc_) wu[cc_] = wup[cc_ * QKW + (h_) * DK + d]; bg = bgate[(h_) * DK + d]; } while (0)
        GP_LOAD(0);
        __syncthreads();
        {
            const int rt = wave & 3, kh = wave >> 2, r16 = lane & 15, kq = lane >> 4;
            pg8::f32x4 acc = {0.f, 0.f, 0.f, 0.f};
            const bf16* xr = xres + (size_t)(tok0 + 16 * rt + r16) * D + kh * 512 + 8 * kq;
            LAS unsigned char* wr_ = lds + GP_WGT + r16 * GP_WGT_PITCH + (kh * 512 + 8 * kq) * 2;
#pragma unroll
            for (int ks = 0; ks < 16; ++ks) { const bf16x8 av = *(const bf16x8*)(xr + 32 * ks), bv = *(const LAS bf16x8*)(wr_ + 64 * ks); acc = __builtin_amdgcn_mfma_f32_16x16x32_bf16(av, bv, acc, 0, 0, 0); }
#pragma unroll
            for (int i = 0; i < 4; ++i) zl[kh * 1024 + (16 * rt + 4 * kq + i) * 16 + r16] = acc[i];
        }
        __syncthreads();
        { const int row = tid >> 3, c2 = (tid & 7) * 2;
          const f32x4 s4 = *(const f32x4*)(sumsq + (size_t)(tok0 + row) * 4); const float rstd = 1.0f / sqrtf(((s4.x + s4.y) + (s4.z + s4.w)) * (1.f / D) + EPS);
          const float z0 = (zl[row * 16 + c2] + zl[1024 + row * 16 + c2]) * rstd, z1 = (zl[row * 16 + c2 + 1] + zl[1024 + row * 16 + c2 + 1]) * rstd;
          __syncthreads();
          zl[row * 16 + c2] = z0; zl[row * 16 + c2 + 1] = z1; }
        __syncthreads();
#pragma unroll
        for (int h = 0; h < NH; ++h) {
#pragma unroll
            for (int i = 0; i < 2; ++i) { const int p = tid + NTHREADS * i; *(LAS v4u*)(lds + GP_Q + p * 16) = pq[i]; *(LAS v4u*)(lds + GP_K + p * 16) = pk[i]; }
            float wuh[16]; const float bgh = bg;
#pragma unroll
            for (int cc = 0; cc < 16; ++cc) wuh[cc] = wu[cc];
            if (h + 1 < NH) GP_LOAD(h + 1);
            float bcum[16]; float run = 0.f;
#pragma unroll
            for (int jj = 0; jj < 16; ++jj) {
                const int j = 16 * rg + jj; float z = bgh;
#pragma unroll
                for (int q4 = 0; q4 < 4; ++q4) { const f32x4 zz = *(const LAS f32x4*)(zl + j * 16 + 4 * q4); z += (zz.x * wuh[4 * q4] + zz.y * wuh[4 * q4 + 1]) + (zz.z * wuh[4 * q4 + 2] + zz.w * wuh[4 * q4 + 3]); }
                const float la = (fminf(z, 0.f) - __logf(1.0f + __expf(-fabsf(z)))) * INV_TAU;
                run += la; bcum[jj] = run;
            }
            tot[rg * 128 + d] = run;
            __syncthreads();
            float off = 0.f, g = 0.f;
#pragma unroll
            for (int r2 = 0; r2 < 4; ++r2) { const float t = tot[r2 * 128 + d]; g += t; off += (r2 < rg) ? t : 0.f; }
#pragma unroll
            for (int jj = 0; jj < 16; ++jj) {
                const int j = 16 * rg + jj; const float eb = __expf(bcum[jj] + off);
                const float q = bf2f(tq[j * 128 + d]), k = bf2f(tk[j * 128 + d]);
                tq[j * 128 + d] = f2bf1(q * QK_SCALE * eb); tk[j * 128 + d] = f2bf1(k * __builtin_amdgcn_rcpf(eb));
            }
            if (rg == 0) gdec[(size_t)(unit * NH + h) * DK + d] = __expf(g);
            __syncthreads();
#pragma unroll
            for (int i = 0; i < 2; ++i) { const int p = tid + NTHREADS * i, row = p >> 4, ch = p & 15;
                *(v4u*)(QT + (size_t)(tok0 + row) * QKW + h * DK + ch * 8) = *(const LAS v4u*)(lds + GP_Q + p * 16);
                *(v4u*)(KT + (size_t)(tok0 + row) * QKW + h * DK + ch * 8) = *(const LAS v4u*)(lds + GP_K + p * 16); }
            __syncthreads();
        }
#undef GP_LOAD
    }
    __syncthreads();
}

#ifndef PROBE_T
#define PROBE_T 0
#endif
#ifndef PROBE_T_MLSTM
#define PROBE_T_MLSTM 0
#endif
#ifndef PROBE_T_WAVE
#define PROBE_T_WAVE 0
#endif
#ifndef PROBE_T_A
#define PROBE_T_A 5
#endif
#ifndef PROBE_T_B
#define PROBE_T_B 0
#endif
constexpr int CW_PROBE = 12288;
__device__ __forceinline__ unsigned long long pt_now() { unsigned long long t; __builtin_amdgcn_sched_barrier(0); asm volatile("s_memrealtime %0\n\ts_waitcnt lgkmcnt(0)" : "=s"(t) :: "memory"); __builtin_amdgcn_sched_barrier(0); return t; }
#define PT_NOW() pt_now()
#define PT_ACC(i, t0) do { if (PROBE_T) { const unsigned long long t1_ = PT_NOW(); pt[i] += (unsigned)(t1_ - (t0)); (t0) = t1_; } } while (0)
constexpr int PS_PITCH = 144, CT_PITCH = 272, CT_BYTES = 32 * CT_PITCH, IMG_PITCH = 272, IMG_BYTES = 64 * IMG_PITCH, NUM_PITCH = 36;
template <bool MLSTM> struct MxMap;
template <> struct MxMap<true>  { static constexpr int QS = 0, KS = 34816, V = 69632, VW = 77824, VWAUX = 81920, PS = 86016, CT = 95232, TB = 112640, TWP = 120832, TPM = 129024, TSC = 137216, DEN = 137728, NUM = 138240, OUTT = 0, GDEC = 0, END = 147456; };
template <> struct MxMap<false> { static constexpr int QS = 0, KS = 34816, V = 69632, VW = 0, VWAUX = 0, PS = 77824, CT = 87040, TB = 0, TWP = 0, TPM = 0, TSC = 0, DEN = 0, NUM = 0, OUTT = 104448, GDEC = 108544, END = 109568; };
#define LDSA(p) ((unsigned)(size_t)(p))
__device__ __forceinline__ bf16x8 mk8(v2u lo, v2u hi) { v4u w; w.x = lo.x; w.y = lo.y; w.z = hi.x; w.w = hi.y; return __builtin_bit_cast(bf16x8, w); }
__device__ __forceinline__ void tr_read2(bf16x8& f0, bf16x8& f1, unsigned a0, unsigned a1, unsigned b0, unsigned b1) {
    v2u l0, h0, l1, h1;
    asm volatile("ds_read_b64_tr_b16 %0, %4\n\tds_read_b64_tr_b16 %1, %5\n\tds_read_b64_tr_b16 %2, %6\n\tds_read_b64_tr_b16 %3, %7\n\ts_waitcnt lgkmcnt(0)"
                 : "=&v"(l0), "=&v"(h0), "=&v"(l1), "=&v"(h1) : "v"(a0), "v"(a1), "v"(b0), "v"(b1) : "memory");
    f0 = mk8(l0, h0); f1 = mk8(l1, h1);
}
__device__ __forceinline__ void tr_read3(bf16x8& f0, bf16x8& f1, bf16x8& f2, unsigned a0, unsigned a1, unsigned b0, unsigned b1, unsigned c0, unsigned c1) {
    v2u l0, h0, l1, h1, l2, h2;
    asm volatile("ds_read_b64_tr_b16 %0, %6\n\tds_read_b64_tr_b16 %1, %7\n\tds_read_b64_tr_b16 %2, %8\n\tds_read_b64_tr_b16 %3, %9\n\tds_read_b64_tr_b16 %4, %10\n\tds_read_b64_tr_b16 %5, %11\n\ts_waitcnt lgkmcnt(0)"
                 : "=&v"(l0), "=&v"(h0), "=&v"(l1), "=&v"(h1), "=&v"(l2), "=&v"(h2) : "v"(a0), "v"(a1), "v"(b0), "v"(b1), "v"(c0), "v"(c1) : "memory");
    f0 = mk8(l0, h0); f1 = mk8(l1, h1); f2 = mk8(l2, h2);
}
template <int P> __device__ __forceinline__ void tr_issue4(v2u (&x)[8], unsigned base) {
    asm volatile("ds_read_b64_tr_b16 %0, %8 offset:%9\n\tds_read_b64_tr_b16 %1, %8 offset:%10\n\tds_read_b64_tr_b16 %2, %8 offset:%11\n\tds_read_b64_tr_b16 %3, %8 offset:%12\n\t"
                 "ds_read_b64_tr_b16 %4, %8 offset:%13\n\tds_read_b64_tr_b16 %5, %8 offset:%14\n\tds_read_b64_tr_b16 %6, %8 offset:%15\n\tds_read_b64_tr_b16 %7, %8 offset:%16"
                 : "=&v"(x[0]), "=&v"(x[1]), "=&v"(x[2]), "=&v"(x[3]), "=&v"(x[4]), "=&v"(x[5]), "=&v"(x[6]), "=&v"(x[7])
                 : "v"(base), "i"(0), "i"(4 * P), "i"(16 * P), "i"(20 * P), "i"(32 * P), "i"(36 * P), "i"(48 * P), "i"(52 * P) : "memory");
}
__device__ __forceinline__ void tr_wait8(v2u (&x)[8]) { asm volatile("s_waitcnt lgkmcnt(0)" : "+v"(x[0]), "+v"(x[1]), "+v"(x[2]), "+v"(x[3]), "+v"(x[4]), "+v"(x[5]), "+v"(x[6]), "+v"(x[7]) :: "memory"); }
__device__ __forceinline__ void tr_pin8(v2u (&x)[8]) { asm volatile("" : "+v"(x[0]), "+v"(x[1]), "+v"(x[2]), "+v"(x[3]), "+v"(x[4]), "+v"(x[5]), "+v"(x[6]), "+v"(x[7])); }
__device__ __forceinline__ bf16x8 tr_read1(unsigned a0, unsigned a1) {
    v2u l0, h0;
    asm volatile("ds_read_b64_tr_b16 %0, %2\n\tds_read_b64_tr_b16 %1, %3\n\ts_waitcnt lgkmcnt(0)" : "=&v"(l0), "=&v"(h0) : "v"(a0), "v"(a1) : "memory");
    return mk8(l0, h0);
}
#define MFMA32(a, b, c) __builtin_amdgcn_mfma_f32_32x32x16_bf16((a), (b), (c), 0, 0, 0)
#define MX_BAR() do { asm volatile("s_waitcnt lgkmcnt(0)" ::: "memory"); __builtin_amdgcn_s_barrier(); asm volatile("" ::: "memory"); } while (0)
#define MX_BAR_VM() do { asm volatile("s_waitcnt vmcnt(0) lgkmcnt(0)" ::: "memory"); __builtin_amdgcn_s_barrier(); asm volatile("" ::: "memory"); } while (0)
struct MixArgs { const bf16 *q, *k, *proj; int qpitch; const float *gates, *bgate, *gdec; bf16* hun; void* probe; };
struct MixUnit { const bf16 *Qg, *Kg, *Vg; bf16* Hg; const float* gdec; int qpitch, b, hh; };
constexpr int MX_NPIECE = 38, MX_PPW = 5;
template <bool MLSTM> struct MixDma { static constexpr int PPW = MX_PPW; unsigned voff[PPW]; };
template <bool MLSTM> __device__ __forceinline__ int mx_piece(int wave, int i) { return wave + 8 * i; }

template <bool MLSTM>
__device__ __forceinline__ void mx_dma_setup(MixDma<MLSTM>& dm, int wave, int lane, int qpitch) {
#pragma unroll
    for (int i = 0; i < MixDma<MLSTM>::PPW; ++i) { const int pi = mx_piece<MLSTM>(wave, i); unsigned v = 0;
        if (pi < 34) { const int ob = (pi < 17 ? pi : pi - 17) * 1024 + lane * 16, row = ob / IMG_PITCH; int cb = ob - row * IMG_PITCH; cb = cb < 256 ? cb : 240; v = (unsigned)(row * qpitch * 2 + cb); }
        else { const int ob = (pi - 34) * 1024 + lane * 16, row = ob >> 6, cb = ob & 63; v = (unsigned)(row * NPROJ * 2 + cb); }
        dm.voff[i] = v; }
}
template <bool MLSTM>
__device__ __forceinline__ void mx_dma_issue(LAS unsigned char* lds, const MixDma<MLSTM>& dm, const MixUnit& U, int c, int wave, int tid) {
    typedef MxMap<MLSTM> MP;
    const int par = c & 1; const size_t tok0 = (size_t)U.b * SEQ + c * CH;
    const char* qb = (const char*)(U.Qg + tok0 * U.qpitch); const char* kb = (const char*)(U.Kg + tok0 * U.qpitch); const char* vb = (const char*)(U.Vg + tok0 * NPROJ);
#pragma unroll
    for (int i = 0; i < MixDma<MLSTM>::PPW; ++i) { const int pi = mx_piece<MLSTM>(wave, i);
        if (pi < MX_NPIECE) {
            const char* src; int dst;
            if (pi < 17) { src = qb; dst = MP::QS + par * IMG_BYTES + pi * 1024; }
            else if (pi < 34) { src = kb; dst = MP::KS + par * IMG_BYTES + (pi - 17) * 1024; }
            else { src = vb; dst = MP::V + par * 4096 + (pi - 34) * 1024; }
            __builtin_amdgcn_global_load_lds((const unsigned*)(src + dm.voff[i]), (LAS unsigned*)(lds + dst), 16, 0, 0);
        } }
    if (!MLSTM && wave == 7) {
        const float* gd = U.gdec + (size_t)(((U.b * NCH + c) * NH) + U.hh) * DK + (tid & 63);
        __builtin_amdgcn_global_load_lds((const unsigned*)gd, (LAS unsigned*)(lds + MP::GDEC + par * 512), 4, 0, 0);
        __builtin_amdgcn_global_load_lds((const unsigned*)(gd + 64), (LAS unsigned*)(lds + MP::GDEC + par * 512 + 256), 4, 0, 0);
    }
}
__device__ __forceinline__ void mx_store_tile(LAS unsigned char* outt, const f32x16& val, bf16* grow  , int lane, int r, int h5) {
#pragma unroll
    for (int i = 0; i < 16; ++i) *(LAS unsigned short*)(outt + ((i & 3) + 8 * (i >> 2) + 4 * h5) * 64 + r * 2) = f2bf1(val[i]);
#pragma unroll
    for (int i = 0; i < 2; ++i) { const int id = lane + 64 * i, row = id >> 2, pc = id & 3; const v4u w = *(const LAS v4u*)(outt + row * 64 + pc * 16); *(v4u*)(grow + (size_t)row * D + pc * 8) = w; }
}
__device__ __forceinline__ void mx_finalize_mlstm(LAS unsigned char* lds, const MixUnit& U, int cf, int fl) {
    typedef MxMap<true> MP;
    const int j = fl >> 2, sg = fl & 3; const float mc = ((const LAS float*)(lds + MP::TSC))[cf];
    const float dn = ((const LAS float*)(lds + MP::DEN))[j], bb = ((const LAS float*)(lds + MP::TB))[cf * 64 + j], pm = ((const LAS float*)(lds + MP::TPM))[cf * 64 + j];
    const float rden = QK_SCALE * __builtin_amdgcn_rcpf(fmaxf(fabsf(dn) * QK_SCALE, __expf(-bb - fmaxf(mc, pm))));
    const f32x4 n0 = *(const LAS f32x4*)((const LAS float*)(lds + MP::NUM) + j * NUM_PITCH + 8 * sg) * rden, n1 = *(const LAS f32x4*)((const LAS float*)(lds + MP::NUM) + j * NUM_PITCH + 8 * sg + 4) * rden;
    v4u w; w.x = pk_bf16(n0.x, n0.y); w.y = pk_bf16(n0.z, n0.w); w.z = pk_bf16(n1.x, n1.y); w.w = pk_bf16(n1.z, n1.w);
    *(v4u*)(U.Hg + (size_t)(U.b * SEQ + cf * CH + j) * D + 8 * sg) = w;
}

template <bool MLSTM>
__device__ __forceinline__ void mx_step(LAS unsigned char* lds, const MixDma<MLSTM>& dm, const MixUnit& U, int c, f32x16& accC0, f32x16& accC1, f32x16& accO, int tid, int lane, int wave, unsigned (&pt)[8]) {
    typedef MxMap<MLSTM> MP;
    unsigned long long tp = PROBE_T ? PT_NOW() : 0ull;
    const int r = lane & 31, h5 = lane >> 5, blk = (lane >> 4) & 1, q4 = (lane & 15) >> 2, p4 = lane & 3, par = c & 1;
    const LAS float* TSC = (const LAS float*)(lds + MP::TSC);
    LAS unsigned char* qimg0 = lds + MP::QS + par * IMG_BYTES; LAS unsigned char* kimg0 = lds + MP::KS + par * IMG_BYTES; LAS unsigned char* vimg0 = lds + MP::V + par * 4096;
    if (c + 1 < NCH) mx_dma_issue<MLSTM>(lds, dm, U, c + 1, wave, tid);
    PT_ACC(6, tp);
    const float mc = MLSTM ? TSC[c] : 0.f;
    if (wave < 4) {
        const int st = wave >> 1, jt = (wave == 1 || wave == 2) ? 1 : 0;
#pragma unroll
        for (int i = 0; i < 16; ++i) accO[i] = 0.f;
        if (MLSTM && wave == 3) {
#pragma unroll
            for (int i = 0; i < 4; ++i) { const int id = lane + 64 * i, row = id >> 2, pc = id & 3;
                const float wr_ = __expf(((const LAS float*)(lds + MP::TWP))[c * 64 + row] - TSC[32 + c]); const v4u pv = *(const LAS v4u*)(vimg0 + row * 64 + pc * 16); v4u o;
                o.x = pk_bf16(bflo(pv.x) * wr_, bfhi(pv.x) * wr_); o.y = pk_bf16(bflo(pv.y) * wr_, bfhi(pv.y) * wr_); o.z = pk_bf16(bflo(pv.z) * wr_, bfhi(pv.z) * wr_); o.w = pk_bf16(bflo(pv.w) * wr_, bfhi(pv.w) * wr_);
                *(LAS v4u*)(lds + MP::VW + row * 64 + pc * 16) = o;
                if (pc == 0) *(LAS unsigned short*)(lds + MP::VWAUX + row * 64) = f2bf1(wr_); }
        }
        if (wave != 3) {
            LAS unsigned char* kimg = kimg0 + (32 * st + r) * IMG_PITCH + 16 * h5;
            LAS unsigned char* qimg = qimg0 + (32 * jt + r) * IMG_PITCH + 16 * h5;
#pragma unroll
            for (int ks = 0; ks < 8; ++ks) { const bf16x8 a = *(const LAS bf16x8*)(kimg + 32 * ks), bq = *(const LAS bf16x8*)(qimg + 32 * ks); accO = MFMA32(a, bq, accO); }
        }
        const int j = 32 * jt + r;
        if (wave == 3) {
#pragma unroll
            for (int g4 = 0; g4 < 4; ++g4) *(LAS v2u*)(lds + MP::PS + j * PS_PITCH + (32 * st + 8 * g4 + 4 * h5) * 2) = (v2u){0u, 0u};
        } else {
            float uj = 0.f;
            if (MLSTM) uj = -fmaxf(mc, ((const LAS float*)(lds + MP::TPM))[c * 64 + j]);
#pragma unroll
            for (int g4 = 0; g4 < 4; ++g4) { const int s0 = 32 * st + 8 * g4 + 4 * h5; f32x4 wps = {0.f, 0.f, 0.f, 0.f}; if (MLSTM) wps = *(const LAS f32x4*)((const LAS float*)(lds + MP::TWP) + c * 64 + s0);
                float v[4];
#pragma unroll
                for (int e = 0; e < 4; ++e) { float x = accO[4 * g4 + e]; if (MLSTM) x *= __expf(uj + wps[e]); v[e] = (s0 + e <= j) ? x : 0.f; }
                v2u o; o.x = pk_bf16(v[0], v[1]); o.y = pk_bf16(v[2], v[3]); *(LAS v2u*)(lds + MP::PS + j * PS_PITCH + s0 * 2) = o; }
        }
    } else {
        const int g = (wave - 4) >> 1, jt = wave & 1;
        if (MLSTM) {
            if (c > 0) mx_finalize_mlstm(lds, U, c - 1, tid - 256);
        }
        if (MLSTM || g == 0) {
#pragma unroll
            for (int i = 0; i < 16; ++i) accO[i] = 0.f;
#pragma unroll
            for (int ks = 0; ks < 8; ++ks) { const bf16x8 a = *(const LAS bf16x8*)(qimg0 + (32 * jt + r) * IMG_PITCH + 16 * h5 + 32 * ks), bc = *(const LAS bf16x8*)(lds + MP::CT + g * CT_BYTES + r * CT_PITCH + 32 * ks + 16 * h5); accO = MFMA32(a, bc, accO); }
            if (MLSTM) {
#pragma unroll
                for (int g4 = 0; g4 < 4; ++g4) { const f32x4 pm = *(const LAS f32x4*)((const LAS float*)(lds + MP::TPM) + c * 64 + 32 * jt + 8 * g4 + 4 * h5);
#pragma unroll
                    for (int e = 0; e < 4; ++e) accO[4 * g4 + e] *= __expf(mc - fmaxf(mc, pm[e])); }
            }
        }
    }
    PT_ACC(2, tp);
    MX_BAR();
    PT_ACC(3, tp);
    if (wave < 4) {
        if (MLSTM) { const float decay = __expf(mc - TSC[32 + c]); accC0 = accC0 * decay; accC1 = accC1 * decay; }
        LAS unsigned char* kimg = kimg0 + (8 * h5 + q4) * IMG_PITCH + 64 * wave + 32 * blk + 8 * p4;
        LAS unsigned char* vimg = (MLSTM ? lds + MP::VW : vimg0) + (8 * h5 + q4) * 64 + 32 * blk + 8 * p4;
        LAS unsigned char* vaux = lds + MP::VWAUX + (8 * h5 + q4) * 64 + 32 * blk + 8 * p4;
        { v2u xk[8], xv[8], xa[8];
          tr_issue4<IMG_PITCH>(xk, LDSA(kimg)); tr_issue4<64>(xv, LDSA(vimg)); if (MLSTM) tr_issue4<64>(xa, LDSA(vaux));
          tr_wait8(xk); tr_pin8(xv); if (MLSTM) tr_pin8(xa);
          __builtin_amdgcn_sched_barrier(0);
#pragma unroll
          for (int ks = 0; ks < 4; ++ks) { const bf16x8 a = mk8(xk[2 * ks], xk[2 * ks + 1]);
              accC0 = MFMA32(a, mk8(xv[2 * ks], xv[2 * ks + 1]), accC0);
              if (MLSTM) accC1 = MFMA32(a, mk8(xa[2 * ks], xa[2 * ks + 1]), accC1); } }
        if (!MLSTM) {
#pragma unroll
            for (int g4 = 0; g4 < 4; ++g4) { const f32x4 dc = *(const LAS f32x4*)((const LAS float*)(lds + MP::GDEC) + par * 128 + 32 * wave + 8 * g4 + 4 * h5);
#pragma unroll
                for (int e = 0; e < 4; ++e) accC0[4 * g4 + e] *= dc[e]; }
        }
#pragma unroll
        for (int g4 = 0; g4 < 4; ++g4) { const int d0 = 32 * wave + 8 * g4 + 4 * h5;
            v2u o; o.x = pk_bf16(accC0[4 * g4], accC0[4 * g4 + 1]); o.y = pk_bf16(accC0[4 * g4 + 2], accC0[4 * g4 + 3]); *(LAS v2u*)(lds + MP::CT + r * CT_PITCH + d0 * 2) = o;
            if (MLSTM) { v2u o1; o1.x = pk_bf16(accC1[4 * g4], accC1[4 * g4 + 1]); o1.y = pk_bf16(accC1[4 * g4 + 2], accC1[4 * g4 + 3]); *(LAS v2u*)(lds + MP::CT + CT_BYTES + r * CT_PITCH + d0 * 2) = o1; } }
    } else {
        const int g = (wave - 4) >> 1, jt = wave & 1;
        if (MLSTM || g == 0) {
            const bf16x8 ones = (r == 0) ? (bf16x8){0x3F80, 0x3F80, 0x3F80, 0x3F80, 0x3F80, 0x3F80, 0x3F80, 0x3F80} : (bf16x8){0, 0, 0, 0, 0, 0, 0, 0};
            LAS unsigned char* vimg = vimg0 + (8 * h5 + q4) * 64 + 32 * blk + 8 * p4;
            bf16x8 pa[4];
#pragma unroll
            for (int ks = 0; ks < 4; ++ks) pa[ks] = *(const LAS bf16x8*)(lds + MP::PS + (32 * jt + r) * PS_PITCH + 32 * ks + 16 * h5);
            if (g == 0) { v2u xv[8]; tr_issue4<64>(xv, LDSA(vimg)); tr_wait8(xv); __builtin_amdgcn_sched_barrier(0);
#pragma unroll
                for (int ks = 0; ks < 4; ++ks) accO = MFMA32(pa[ks], mk8(xv[2 * ks], xv[2 * ks + 1]), accO);
            } else {
#pragma unroll
                for (int ks = 0; ks < 4; ++ks) accO = MFMA32(pa[ks], ones, accO); }
            if (MLSTM && g == 0) {
#pragma unroll
                for (int i = 0; i < 16; ++i) ((LAS float*)(lds + MP::NUM))[(32 * jt + (i & 3) + 8 * (i >> 2) + 4 * h5) * NUM_PITCH + r] = accO[i];
            }
            if (MLSTM && g == 1 && r == 0) {
#pragma unroll
                for (int i = 0; i < 16; ++i) ((LAS float*)(lds + MP::DEN))[32 * jt + (i & 3) + 8 * (i >> 2) + 4 * h5] = accO[i];
            }
            if (!MLSTM) mx_store_tile(lds + MP::OUTT + jt * 2048, accO, U.Hg + (size_t)(U.b * SEQ + c * CH + 32 * jt) * D, lane, r, h5);
        }
    }
    PT_ACC(4, tp);
    MX_BAR_VM();
    PT_ACC(5, tp);
}

template <bool MLSTM>
__device__ __forceinline__ void mixer_phase(LAS unsigned char* lds, int tid, int lane, int wave, int vcu, int G, const MixArgs A) {
    typedef MxMap<MLSTM> MP;
    MixDma<MLSTM> dm; mx_dma_setup<MLSTM>(dm, wave, lane, A.qpitch);
    unsigned pt[8] = {0u, 0u, 0u, 0u, 0u, 0u, 0u, 0u}; unsigned long long tph = PROBE_T ? PT_NOW() : 0ull; unsigned long long tin = tph;
    for (int unit = vcu; unit < BATCH * NH * 8; unit += G) {
        const int slice = unit & 7, bh = unit >> 3;
        MixUnit U; U.b = bh >> 2; U.hh = bh & 3; U.qpitch = A.qpitch; U.gdec = A.gdec;
        U.Qg = A.q + U.hh * DK; U.Kg = A.k + U.hh * DK; U.Vg = A.proj + 1024 + U.hh * DV + 32 * slice; U.Hg = A.hun + U.hh * DV + 32 * slice;
        MX_BAR_VM();
        mx_dma_issue<MLSTM>(lds, dm, U, 0, wave, tid);
        for (int i = tid; i < 2 * CT_BYTES / 4; i += NTHREADS) ((LAS unsigned*)(lds + MP::CT))[i] = 0u;
        if (MLSTM) {
            for (int i = tid; i < 1024; i += NTHREADS) ((LAS unsigned*)(lds + MP::VWAUX))[i] = 0u;
            LAS float* TB = (LAS float*)(lds + MP::TB); LAS float* TWP = (LAS float*)(lds + MP::TWP); LAS float* TPM = (LAS float*)(lds + MP::TPM); LAS float* TSC = (LAS float*)(lds + MP::TSC);
            const float bgi = A.bgate[U.hh], bgf = A.bgate[4 + U.hh];
            float gi4[4], gf4[4];
#pragma unroll
            for (int cc = 0; cc < 4; ++cc) { const size_t tok = (size_t)U.b * SEQ + (wave + 8 * cc) * CH + lane; gi4[cc] = A.gates[tok * 16 + U.hh] + bgi; gf4[cc] = A.gates[tok * 16 + 4 + U.hh] + bgf; }
#pragma unroll
            for (int cc = 0; cc < 4; ++cc) { const int c = wave + 8 * cc;
                const float lf = fminf(gf4[cc], 0.f) - __logf(1.0f + __expf(-fabsf(gf4[cc])));
                float bsum = lf;
#pragma unroll
                for (int o = 1; o < 64; o <<= 1) { const float t = __shfl_up(bsum, o); if (lane >= o) bsum += t; }
                const float wp = gi4[cc] - bsum; float pm = wp;
#pragma unroll
                for (int o = 1; o < 64; o <<= 1) { const float t = __shfl_up(pm, o); if (lane >= o) pm = fmaxf(pm, t); }
                TB[c * 64 + lane] = bsum; TWP[c * 64 + lane] = wp; TPM[c * 64 + lane] = pm;
                if (lane == 63) { TSC[64 + c] = bsum; TSC[96 + c] = pm; } }
            MX_BAR();
            if (wave == 0) {
                const float gl = TSC[64 + (lane & 31)], pl = TSC[96 + (lane & 31)]; float m = 0.f, myM = 0.f, myX = 0.f;
#pragma clang loop unroll(disable)
                for (int c = 0; c < NCH; ++c) { const float gc = __uint_as_float(__builtin_amdgcn_readlane(__float_as_uint(gl), c)), pc = __uint_as_float(__builtin_amdgcn_readlane(__float_as_uint(pl), c));
                    const float mxe = fmaxf(m, pc); if (lane == c) { myM = m; myX = mxe; } m = gc + mxe; }
                if (lane < 32) { TSC[lane] = myM; TSC[32 + lane] = myX; }
            }
        }
        f32x16 accC0, accC1, accO;
#pragma unroll
        for (int i = 0; i < 16; ++i) { accC0[i] = 0.f; accC1[i] = 0.f; accO[i] = 0.f; }
        MX_BAR_VM();
        PT_ACC(1, tin);
#pragma clang loop unroll(disable)
        for (int c = 0; c < NCH; ++c) mx_step<MLSTM>(lds, dm, U, c, accC0, accC1, accO, tid, lane, wave, pt);
        if (MLSTM && wave >= 4) mx_finalize_mlstm(lds, U, NCH - 1, tid - 256);
    }
    MX_BAR_VM();
    if (PROBE_T && (PROBE_T_MLSTM != 0) == MLSTM && vcu == 0 && wave == PROBE_T_WAVE && lane == 0) { PT_ACC(0, tph); unsigned* pw = (unsigned*)A.probe; pw[0] = pt[PROBE_T_A]; pw[1] = pt[PROBE_T_B]; }
}

constexpr int N_PHASES = 15, RT_OFF = RING_BYTES;
template <int PH>
__device__ __forceinline__ void run_phase(const Args& args, LAS unsigned char* lds, int tid, int lane, int wave, int vcu, int G, int bx) {
    unsigned char* ws = args.ws;
    constexpr int layer = (PH >= 8) ? 1 : 0, k = (PH == 0) ? -1 : PH - 1 - 7 * layer;
    unsigned char* wl = ws + (size_t)layer * WS_WLAYER;
    bf16* AOP = (bf16*)(ws + WS_AOP); bf16* PROJ = (bf16*)(ws + WS_PROJ); bf16* HMID = (bf16*)(ws + WS_HMID); bf16* XRES = (bf16*)(ws + WS_XRES);
    float* GATES = (float*)(ws + WS_GATES); float* SUMSQ = (float*)(ws + WS_SUMSQ);
    LAS float* RT = (LAS float*)(lds + RT_OFF);
    if constexpr (k == -1) {
        convert_weights(lds, lane, wave, vcu, G, args, ws);
        rows_first(lds, tid, lane, wave, vcu, G, args.in[0], args.in[1], XRES, SUMSQ, args.in[4] + NPROJ, MLSTM_IN, 8, GATES);
    } else if constexpr (k == 0) {
        pg8::Gemm g{XRES, (const bf16*)(wl + WS_WIN), M, NPROJ, D}; pg8::StaticOrder S; S.init(M, NPROJ, G, bx);
        const RstdSlots rs = rstd_table(RT, SUMSQ, S, tid);
        pg8::EpiBf16S<0> E{PROJ, NPROJ, (const LAS float*)RT, rs.pm1, rs.pm2, rs.pm3};
        pg8::gemm_phase<pg8::EpiBf16S<0>, pg8::StaticOrder, true, true>(lds, g, S, E);
    } else if constexpr (k == 1) {
        if (layer) gla_prep(lds, tid, lane, wave, vcu, G, PROJ, XRES, SUMSQ, args.in[8], args.in[1] + D, args.in[9], args.in[10], (bf16*)(ws + WS_QT), (bf16*)(ws + WS_KT), (float*)(ws + WS_GDEC));
    } else if constexpr (k == 2) {
        if (layer == 0) { const MixArgs A{PROJ, PROJ + QKW, PROJ, NPROJ, GATES, args.in[5], nullptr, AOP, ws + WS_CTL + 4 * CW_PROBE}; mixer_phase<true>(lds, tid, lane, wave, vcu, G, A); }
        else { const MixArgs A{(const bf16*)(ws + WS_QT), (const bf16*)(ws + WS_KT), PROJ, QKW, nullptr, nullptr, (const float*)(ws + WS_GDEC), AOP, ws + WS_CTL + 4 * CW_PROBE}; mixer_phase<false>(lds, tid, lane, wave, vcu, G, A); }
    } else if constexpr (k == 3) {
        head_norm_rows(lane, wave, vcu, G, AOP, args.in[layer ? 11 : 6], PROJ, AOP, layer != 0);
    } else if constexpr (k == 4) {
        pg8::Gemm g{AOP, (const bf16*)(wl + WS_WOUT), M, D, D}; pg8::StaticOrder S; S.init(M, D, G, bx);
        pg8::EpiResBf16Sq E{XRES, SUMSQ, D};
        pg8::gemm_phase<pg8::EpiResBf16Sq, pg8::StaticOrder, false, true>(lds, g, S, E);
    } else if constexpr (k == 5) {
        pg8::Gemm g{XRES, (const bf16*)(wl + WS_W1), M, FF, D}; pg8::StaticOrder S; S.init(M, FF, G, bx);
        const RstdSlots rs = rstd_table(RT, SUMSQ, S, tid);
        pg8::EpiBf16S<2> E{HMID, FF, (const LAS float*)RT, rs.pm1, rs.pm2, rs.pm3};
        pg8::gemm_phase<pg8::EpiBf16S<2>, pg8::StaticOrder, true, true>(lds, g, S, E);
    } else if constexpr (k == 6 && layer == 0) {
        pg8::Gemm g{HMID, (const bf16*)(wl + WS_W2), M, D, FF}; pg8::StaticOrder S; S.init(M, D, G, bx);
        pg8::EpiResBf16Sq E{XRES, SUMSQ, D};
        pg8::gemm_phase<pg8::EpiResBf16Sq, pg8::StaticOrder, false, true>(lds, g, S, E);
    } else if constexpr (k == 6) {
        pg8::Gemm g{HMID, (const bf16*)(wl + WS_W2), M, D, FF}; pg8::StaticOrder S; S.init(M, D, G, bx);
        pg8::EpiFinalNorm E{XRES, args.out, SUMSQ, (unsigned*)(ws + WS_CTL) + CW_FIN, args.in[3], D, EPS};
        pg8::gemm_phase<pg8::EpiFinalNorm, pg8::StaticOrder, false, true>(lds, g, S, E);
    }
}
__global__ void __launch_bounds__(NTHREADS, 2) fwd_kernel(Args args) {
    extern __shared__ __attribute__((aligned(16))) unsigned char lds_raw[];
    LAS unsigned char* lds = (LAS unsigned char*)lds_raw;
    volatile LAS unsigned* MISC = (volatile LAS unsigned*)(lds + MISC_OFF);
    const int tid = threadIdx.x, lane = tid & 63, wave = __builtin_amdgcn_readfirstlane(tid >> 6);
    const int G = gridDim.x; int bx = blockIdx.x; int vcu = (G % 8 == 0) ? (bx % 8) * (G / 8) + bx / 8 : bx;
    for (int u = tid; u < (LDS_BYTES - LDSCTL_OFF) / 4; u += NTHREADS) ((LAS unsigned*)(lds + LDSCTL_OFF))[u] = 0u;
    __syncthreads();
    const int lo = args.ph_lo, hi = args.ph_hi;
    XcdBarrier bar; bar.bar = (unsigned*)(args.ws + WS_CTL) + CW_BAR; bar.x = 0; bar.st = nullptr;
    if (hi - lo > 1) { bar = xcd_barrier_post((unsigned*)(args.ws + WS_CTL) + CW_BAR, MISC + 8);
        if (tid == 0) { const unsigned xcc = xb_xcc_id(); MISC[16] = xcc; MISC[17] = xb_add((unsigned*)(args.ws + WS_CTL) + CW_XID + 64 * xcc, 1u); } }
#ifndef PROBE_PH
#define PROBE_PH (-1)
#endif
#ifndef PROBE_N
#define PROBE_N 0
#endif
#define PHASE(p) if (lo <= (p) && (p) < hi) { run_phase<p>(args, lds, tid, lane, wave, vcu, G, bx); \
        if ((p) == PROBE_PH) { for (int rep_ = 0; rep_ < PROBE_N; ++rep_) { xcd_barrier(bar); if (PROBE_PH >= 0) run_phase<((p) == PROBE_PH ? (p) : 2)>(args, lds, tid, lane, wave, vcu, G, bx); } } \
        if ((p) + 1 < hi && (p) != 2) xcd_barrier(bar); }
    PHASE(0)
    if (lo == 0 && hi > 1) {
        bool ok = (G == 256);
#pragma unroll
        for (unsigned j = 0; j < 16; ++j) { const unsigned cnt = xb_ld(&bar.bar[XB_XCNT(j)]); ok = ok && (cnt == (j < 8 ? 32u : 0u)); }
        const unsigned xcc = MISC[16], idx = MISC[17];
        if (ok && xcc < 8 && idx < 32) { vcu = (int)(xcc * 32 + idx); bx = (int)(idx * 8 + xcc); }
    }
    PHASE(1) PHASE(2) PHASE(3) PHASE(4) PHASE(5) PHASE(6) PHASE(7) PHASE(8) PHASE(9) PHASE(10) PHASE(11) PHASE(12) PHASE(13) PHASE(14)
#undef PHASE
    if (PROBE_T && hi == N_PHASES && vcu == 0 && tid == 0) {
        const unsigned a = xb_ld((unsigned*)(args.ws + WS_CTL) + CW_PROBE), b = xb_ld((unsigned*)(args.ws + WS_CTL) + CW_PROBE + 1);
        const unsigned long long ticks = (unsigned long long)a * 5ull + (unsigned long long)(b / 50u) * 50000ull;
        const unsigned long long t0 = PT_NOW(); while (PT_NOW() - t0 < ticks) __builtin_amdgcn_s_sleep(8);
    }
}

extern "C" void kernel_launch(void* const* d_in, const int* in_sizes, int n_in, void* d_out, int out_size, void* d_ws, size_t ws_size, hipStream_t stream) {
    static int grid = 0;
    if (grid == 0) {
        if (n_in != 15 || in_sizes[0] != M * D || out_size != M * D || ws_size < WS_END) { fprintf(stderr, "kernel_launch: unexpected shapes (n_in %d, in0 %d, out %d, ws %zu); nothing launched\n", n_in, n_in > 0 ? in_sizes[0] : -1, out_size, ws_size); grid = -1; return; }
        int dev = 0, cus = 0, per_cu = 0;
        if (hipGetDevice(&dev) != hipSuccess || hipDeviceGetAttribute(&cus, hipDeviceAttributeMultiprocessorCount, dev) != hipSuccess) { grid = -1; return; }
        if (hipFuncSetAttribute((const void*)fwd_kernel, hipFuncAttributeMaxDynamicSharedMemorySize, LDS_BYTES) != hipSuccess) { fprintf(stderr, "kernel_launch: hipFuncSetAttribute failed\n"); grid = -1; return; }
        if (hipOccupancyMaxActiveBlocksPerMultiprocessor(&per_cu, (const void*)fwd_kernel, NTHREADS, LDS_BYTES) != hipSuccess || per_cu < 1) { fprintf(stderr, "kernel_launch: occupancy query says %d blocks per CU\n", per_cu); (void)hipGetLastError(); grid = -1; return; }
        grid = cus;
    }
    if (grid < 0) return;
    (void)hipMemsetAsync((char*)d_ws + WS_CTL, 0, CTL_ZERO_BYTES, stream);
    Args a{};
    for (int i = 0; i < 15; ++i) a.in[i] = (const float*)d_in[i];
    a.out = (float*)d_out; a.ws = (unsigned char*)d_ws;
    if (MK_N_LAUNCHES == 1) {
        a.ph_lo = 0; a.ph_hi = N_PHASES;
        void* kargs[] = {&a};
        const hipError_t e = hipLaunchCooperativeKernel((const void*)fwd_kernel, dim3(grid), dim3(NTHREADS), kargs, LDS_BYTES, stream);
        if (e != hipSuccess) fprintf(stderr, "kernel_launch: cooperative launch failed: %s (grid %d)\n", hipGetErrorString(e), grid);
    } else {
        for (int p = 0; p < N_PHASES; ++p) { a.ph_lo = p; a.ph_hi = p + 1; hipLaunchKernelGGL(fwd_kernel, dim3(grid), dim3(NTHREADS), LDS_BYTES, stream, a); }
    }
}
```

```cpp
#include <hip/hip_runtime.h>
#include <cstdio>
#include <cstdint>
namespace pg8 {
#define PG8_LAS __attribute__((address_space(3)))
typedef unsigned short bf16_t;
typedef short bf16x8 __attribute__((ext_vector_type(8)));
typedef float f32x4 __attribute__((ext_vector_type(4)));
typedef unsigned u32x4 __attribute__((ext_vector_type(4)));
constexpr int BM = 256, BK = 64, HALF = 128, HTB = HALF * BK * 2  , STAGE_BYTES = 8 * HTB, NXCD = 8, WGM = 8;

__host__ __device__ __forceinline__ int lds_byte(int r, int c) { const int st = (r >> 4) * 2 + (c >> 5), rr = r & 15, cc = c & 31, ob = rr * 64 + cc * 2; return st * 1024 + (ob ^ (((ob >> 9) & 1) << 5)); }
__host__ __device__ __forceinline__ void stage_rc(int b, int& R, int& C) { const int st = b / 1024, sb = b % 1024, swz = sb ^ (((sb >> 9) & 1) << 5); R = (st >> 1) * 16 + swz / 64; C = (st & 1) * 32 + (swz % 64) / 2; }
__host__ __device__ __forceinline__ int perm32(int rho) { const int n = rho >> 4, i = rho & 15; return 8 * (i >> 2) + 4 * n + (i & 3); }

struct Unit { int pm, pn; };
struct Gemm { const bf16_t* A; const bf16_t* Bt; int M, N, K; };

struct StaticOrder {
    int nM, nN, nwg, G, c;
    __host__ __device__ void init(int M, int N, int G_, int c_) { nM = M / BM; nN = N / BM; nwg = nM * nN; G = G_; c = c_; }
    __host__ __device__ bool next(int i, Unit& u) const {
        const long L = (long)i * G + c; if (L >= nwg) return false;
        int wgid = (int)L; { const int q = nwg / NXCD, r = nwg % NXCD, xcd = wgid % NXCD, off = wgid / NXCD; wgid = (xcd < r ? xcd * (q + 1) : r * (q + 1) + (xcd - r) * q) + off; }
        const int nig = WGM * nN, gid = wgid / nig, fm = gid * WGM, gsz = (nM - fm) < WGM ? (nM - fm) : WGM;
        u.pm = fm + ((wgid % nig) % gsz); u.pn = (wgid % nig) / gsz; return true;
    }
    __device__ __forceinline__ void a_ready(const Unit&) const {}
    __device__ __forceinline__ void done(const Unit&) const {}
};

__device__ __forceinline__ unsigned cvt_pk_bf16(float lo, float hi) { unsigned r; asm volatile("v_cvt_pk_bf16_f32 %0, %1, %2" : "=v"(r) : "v"(lo), "v"(hi)); return r; }
typedef float f32x2 __attribute__((ext_vector_type(2)));
typedef __bf16 bf16x2_t __attribute__((ext_vector_type(2)));
__device__ __forceinline__ unsigned pk_bf16(float lo, float hi) { f32x2 v = {lo, hi}; bf16x2_t r = __builtin_convertvector(v, bf16x2_t); return __builtin_bit_cast(unsigned, r); }
template <int ACT  > struct EpiBf16 {
    static constexpr bool PERM = true, AFTER_DRAIN = false;
    bf16_t* O; int ldc;
    __device__ __forceinline__ void operator()(const f32x4 (&acc)[2][2][4][2], const Unit& u, int wr, int wc, int fr, int fq) const {
        const int row0 = u.pm * BM + wr * 64 + fr, col0 = u.pn * BM + wc * 32 + 8 * fq;
#pragma unroll
        for (int ai = 0; ai < 2; ++ai)
#pragma unroll
            for (int m = 0; m < 4; ++m) { bf16_t* rowp = O + (size_t)(row0 + ai * HALF + m * 16) * ldc + col0;
#pragma unroll
                for (int bj = 0; bj < 2; ++bj) { f32x4 v0 = acc[ai][bj][m][0], v1 = acc[ai][bj][m][1];
                    if (ACT == 2) { const f32x4 z = {0.f, 0.f, 0.f, 0.f}; v0 = __builtin_elementwise_max(v0, z); v1 = __builtin_elementwise_max(v1, z); v0 = v0 * v0; v1 = v1 * v1; }
                    u32x4 w; w.x = pk_bf16(v0[0], v0[1]); w.y = pk_bf16(v0[2], v0[3]); w.z = pk_bf16(v1[0], v1[1]); w.w = pk_bf16(v1[2], v1[3]);
                    *(u32x4*)(rowp + bj * HALF) = w; } }
    }
};
struct EpiResF32 {
    static constexpr bool PERM = false, AFTER_DRAIN = true;
    const float* base; float* out; int ldc;
    __device__ __forceinline__ void fused(const f32x4 (&acc)[2][2][4][2], const Unit& u, int wr, int wc, int fr, int fq, PG8_LAS unsigned char*, int, int) const {
        const int col0 = u.pn * BM + wc * 32 + 4 * fq;
#pragma unroll
        for (int ai = 0; ai < 2; ++ai)
#pragma unroll
            for (int m = 0; m < 4; ++m) { const int r = ai * HALF + wr * 64 + m * 16 + fr; const size_t off = (size_t)(u.pm * BM + r) * ldc + col0;
#pragma unroll
                for (int bj = 0; bj < 2; ++bj) { const f32x4 b0 = *(const f32x4*)(base + off + bj * HALF), b1 = *(const f32x4*)(base + off + bj * HALF + 16);
                    *(f32x4*)(out + off + bj * HALF) = b0 + acc[ai][bj][m][0]; *(f32x4*)(out + off + bj * HALF + 16) = b1 + acc[ai][bj][m][1];
                    asm volatile("" ::: "memory"); } }
    }
};
typedef unsigned u32x2 __attribute__((ext_vector_type(2)));
__device__ __forceinline__ float bf_lo(unsigned w) { return __builtin_bit_cast(float, w << 16); }
__device__ __forceinline__ float bf_hi(unsigned w) { return __builtin_bit_cast(float, w & 0xffff0000u); }
template <int ACT  > struct EpiBf16S {
    static constexpr bool PERM = true, AFTER_DRAIN = false;
    bf16_t* O; int ldc; const PG8_LAS float* rt; int pm1, pm2, pm3;
    __device__ __forceinline__ void operator()(const f32x4 (&acc)[2][2][4][2], const Unit& u, int wr, int wc, int fr, int fq) const {
        const int col0 = u.pn * BM + wc * 32 + 8 * fq;
        const PG8_LAS float* rtp = rt + ((u.pm == pm1) ? 256 : (u.pm == pm2) ? 512 : (u.pm == pm3) ? 768 : 0) + wr * 64 + fr;
#pragma unroll
        for (int ai = 0; ai < 2; ++ai)
#pragma unroll
            for (int m = 0; m < 4; ++m) { const float rs = rtp[ai * HALF + m * 16];
                bf16_t* rowp = O + (size_t)(u.pm * BM + ai * HALF + wr * 64 + m * 16 + fr) * ldc + col0;
#pragma unroll
                for (int bj = 0; bj < 2; ++bj) { f32x4 v0 = acc[ai][bj][m][0] * rs, v1 = acc[ai][bj][m][1] * rs;
                    if (ACT == 2) { const f32x4 z = {0.f, 0.f, 0.f, 0.f}; v0 = __builtin_elementwise_max(v0, z); v1 = __builtin_elementwise_max(v1, z); v0 = v0 * v0; v1 = v1 * v1; }
                    u32x4 w; w.x = pk_bf16(v0[0], v0[1]); w.y = pk_bf16(v0[2], v0[3]); w.z = pk_bf16(v1[0], v1[1]); w.w = pk_bf16(v1[2], v1[3]);
                    *(u32x4*)(rowp + bj * HALF) = w; } }
    }
};
struct EpiResBf16Sq {
    static constexpr bool PERM = false, AFTER_DRAIN = true;
    bf16_t* xres; float* sumsq; int ldc;
    __device__ __forceinline__ void fused(f32x4 (&acc)[2][2][4][2], const Unit& u, int wr, int wc, int fr, int fq, PG8_LAS unsigned char* lds, int wid, int lane) const {
        PG8_LAS float* P = (PG8_LAS float*)lds;
        const int col0 = u.pn * BM + wc * 32 + 4 * fq;
#pragma unroll
        for (int ai = 0; ai < 2; ++ai)
#pragma unroll
            for (int m = 0; m < 4; ++m) { const int r = ai * HALF + wr * 64 + m * 16 + fr; bf16_t* xp = xres + (size_t)(u.pm * BM + r) * ldc + col0; float ss = 0.f;
#pragma unroll
                for (int bj = 0; bj < 2; ++bj)
#pragma unroll
                    for (int n = 0; n < 2; ++n) { const u32x2 xb = *(const u32x2*)(xp + bj * HALF + n * 16); const f32x4 a = acc[ai][bj][m][n];
                        u32x2 w; w.x = pk_bf16(bf_lo(xb.x) + a[0], bf_hi(xb.x) + a[1]); w.y = pk_bf16(bf_lo(xb.y) + a[2], bf_hi(xb.y) + a[3]);
                        *(u32x2*)(xp + bj * HALF + n * 16) = w;
                        const float y0 = bf_lo(w.x), y1 = bf_hi(w.x), y2 = bf_lo(w.y), y3 = bf_hi(w.y); ss += (y0 * y0 + y1 * y1) + (y2 * y2 + y3 * y3); }
                ss += __shfl_xor(ss, 16); ss += __shfl_xor(ss, 32);
                if (fq == 0) P[r * 4 + wc] = ss;
                asm volatile("" ::: "memory"); }
        asm volatile("s_waitcnt lgkmcnt(0)" ::: "memory"); __builtin_amdgcn_s_barrier(); asm volatile("" ::: "memory");
        const int t = wid * 64 + lane;
        if (t < 256) { const f32x4 p = *(const PG8_LAS f32x4*)(P + t * 4); sumsq[(size_t)(u.pm * BM + t) * 4 + u.pn] = (p[0] + p[1]) + (p[2] + p[3]); }
    }
};
struct EpiFinalNorm {
    static constexpr bool PERM = false, AFTER_DRAIN = true;
    const bf16_t* xres; float* out; float* sumsq; unsigned* cnt; const float* gain; int ldc; float eps;
    __device__ __forceinline__ void fused(f32x4 (&acc)[2][2][4][2], const Unit& u, int wr, int wc, int fr, int fq, PG8_LAS unsigned char* lds, int wid, int lane) const {
        PG8_LAS float* P = (PG8_LAS float*)lds;
        PG8_LAS float* S = (PG8_LAS float*)(lds + 4096);
        const int col0 = u.pn * BM + wc * 32 + 4 * fq, t = wid * 64 + lane;
#pragma unroll
        for (int ai = 0; ai < 2; ++ai)
#pragma unroll
            for (int m = 0; m < 4; ++m) { const int r = ai * HALF + wr * 64 + m * 16 + fr; const bf16_t* xp = xres + (size_t)(u.pm * BM + r) * ldc + col0; float ss = 0.f;
#pragma unroll
                for (int bj = 0; bj < 2; ++bj)
#pragma unroll
                    for (int n = 0; n < 2; ++n) { const u32x2 xb = *(const u32x2*)(xp + bj * HALF + n * 16); f32x4 y = acc[ai][bj][m][n];
                        y[0] += bf_lo(xb.x); y[1] += bf_hi(xb.x); y[2] += bf_lo(xb.y); y[3] += bf_hi(xb.y); acc[ai][bj][m][n] = y; ss += (y[0] * y[0] + y[1] * y[1]) + (y[2] * y[2] + y[3] * y[3]); }
                ss += __shfl_xor(ss, 16); ss += __shfl_xor(ss, 32);
                if (fq == 0) P[r * 4 + wc] = ss;
                asm volatile("" ::: "memory"); }
        asm volatile("s_waitcnt lgkmcnt(0)" ::: "memory"); __builtin_amdgcn_s_barrier(); asm volatile("" ::: "memory");
        if (t < 256) { const f32x4 p = *(const PG8_LAS f32x4*)(P + t * 4); __hip_atomic_store(sumsq + (size_t)(u.pm * BM + t) * 4 + u.pn, (p[0] + p[1]) + (p[2] + p[3]), __ATOMIC_RELAXED, __HIP_MEMORY_SCOPE_AGENT); }
        asm volatile("s_waitcnt vmcnt(0)" ::: "memory"); __builtin_amdgcn_s_barrier(); asm volatile("" ::: "memory");
        if (t == 0) {
            __hip_atomic_fetch_add(cnt + 16 * u.pm, 1u, __ATOMIC_RELAXED, __HIP_MEMORY_SCOPE_AGENT);
            unsigned sp = 0;
            while (__hip_atomic_load(cnt + 16 * u.pm, __ATOMIC_RELAXED, __HIP_MEMORY_SCOPE_AGENT) < 4u && ++sp < (1u << 22)) __builtin_amdgcn_s_sleep(2);
            __builtin_amdgcn_fence(__ATOMIC_ACQUIRE, "agent");
        }
        asm volatile("s_waitcnt vmcnt(0) lgkmcnt(0)" ::: "memory"); __builtin_amdgcn_s_barrier(); asm volatile("" ::: "memory");
        if (t < 256) { float s4 = 0.f;
#pragma unroll
            for (int q = 0; q < 4; ++q) s4 += __hip_atomic_load(sumsq + (size_t)(u.pm * BM + t) * 4 + q, __ATOMIC_RELAXED, __HIP_MEMORY_SCOPE_AGENT);
            S[t] = 1.0f / sqrtf(s4 / (float)ldc + eps); }
        asm volatile("s_waitcnt lgkmcnt(0)" ::: "memory"); __builtin_amdgcn_s_barrier(); asm volatile("" ::: "memory");
        f32x4 gv[2][2];
#pragma unroll
        for (int bj = 0; bj < 2; ++bj)
#pragma unroll
            for (int n = 0; n < 2; ++n) gv[bj][n] = *(const f32x4*)(gain + col0 + bj * HALF + n * 16);
#pragma unroll
        for (int ai = 0; ai < 2; ++ai)
#pragma unroll
            for (int m = 0; m < 4; ++m) { const int r = ai * HALF + wr * 64 + m * 16 + fr; const float rs = S[r]; float* op = out + (size_t)(u.pm * BM + r) * ldc + col0;
#pragma unroll
                for (int bj = 0; bj < 2; ++bj)
#pragma unroll
                    for (int n = 0; n < 2; ++n) *(f32x4*)(op + bj * HALF + n * 16) = acc[ai][bj][m][n] * rs * gv[bj][n]; }
    }
};
template <class Epi, class Sched, bool ALIGN_EPI = false, bool SP2 = false>
__device__ __forceinline__ void gemm_phase(PG8_LAS unsigned char* lds, const Gemm g, const Sched& S, const Epi& E) {
    const int tid = threadIdx.x, wid = __builtin_amdgcn_readfirstlane(tid >> 6), lane = tid & 63, wr = wid >> 2, wc = wid & 3, fr = lane & 15, fq = lane >> 4;
    const int K = g.K, nt = K / BK;
    unsigned voffA[2], voffB[2];
#pragma unroll
    for (int i = 0; i < 2; ++i) { int R, C; stage_rc(tid * 16 + i * 8192, R, C); const int Rb = Epi::PERM ? ((R & ~31) + perm32(R & 31)) : R;
        voffA[i] = (unsigned)(R * K + C) * 2u; voffB[i] = (unsigned)(Rb * K + C) * 2u; }
    const size_t kstep = (size_t)(BK * 2);
    const size_t hstep = (size_t)HALF * K * 2;
    const size_t tstep = 2 * hstep;
    const unsigned ldsw = (unsigned)wid * 1024u;
    const int aoff = lds_byte(wr * 64 + fr, fq * 8), boff = lds_byte(wc * 32 + fr, fq * 8);
#define PG8_SA(b, h) (((b) * 2 + (h)) * HTB)
#define PG8_SB(b, h) ((4 + (b) * 2 + (h)) * HTB)
#define PG8_STAGE(bufoff, gbase, voff) do { _Pragma("unroll") for (int _i = 0; _i < 2; ++_i) \
        __builtin_amdgcn_global_load_lds((const unsigned*)((const char*)(gbase) + (voff)[_i]), (PG8_LAS unsigned*)(lds + (bufoff) + ldsw + _i * 8192), 16, 0, 0); } while (0)
#define PG8_LDA(dst, b, h) do { _Pragma("unroll") for (int m = 0; m < 4; ++m) _Pragma("unroll") for (int k = 0; k < 2; ++k) dst[m][k] = *(const PG8_LAS bf16x8*)(lds + PG8_SA(b, h) + aoff + m * 2048 + k * 1024); } while (0)
#define PG8_LDB(dst, b, h) do { _Pragma("unroll") for (int n = 0; n < 2; ++n) _Pragma("unroll") for (int k = 0; k < 2; ++k) dst[n][k] = *(const PG8_LAS bf16x8*)(lds + PG8_SB(b, h) + boff + n * 2048 + k * 1024); } while (0)
#define PG8_MMA(ai, bj, At, Bt) do { __builtin_amdgcn_s_setprio(1); _Pragma("unroll") for (int m = 0; m < 4; ++m) _Pragma("unroll") for (int n = 0; n < 2; ++n) _Pragma("unroll") for (int k = 0; k < 2; ++k) \
        acc[ai][bj][m][n] = __builtin_amdgcn_mfma_f32_16x16x32_bf16(Bt[n][k], At[m][k], acc[ai][bj][m][n], 0, 0, 0); __builtin_amdgcn_s_setprio(0); } while (0)
#define PG8_WAIT_V(n) asm volatile("s_waitcnt vmcnt(" #n ")" ::: "memory")
#define PG8_WAIT_L(n) asm volatile("s_waitcnt lgkmcnt(" #n ")" ::: "memory")
#define PG8_BAR __builtin_amdgcn_s_barrier()
#define PG8_SCHED __builtin_amdgcn_sched_barrier(0)
    Unit cur, nxt; int ui = 0;
    if (!S.next(0, cur)) return;
    f32x4 acc[2][2][4][2];
#pragma unroll
    for (int a = 0; a < 2; ++a)
#pragma unroll
        for (int b = 0; b < 2; ++b)
#pragma unroll
            for (int m = 0; m < 4; ++m)
#pragma unroll
                for (int n = 0; n < 2; ++n) acc[a][b][m][n] = (f32x4){0.f, 0.f, 0.f, 0.f};
    bf16x8 At[4][2], B0[2][2], B1[2][2];
    const char* cA = (const char*)g.A + (size_t)cur.pm * tstep; const char* cB = (const char*)g.Bt + (size_t)cur.pn * tstep;
    S.a_ready(cur);
    if constexpr (SP2) {
        PG8_STAGE(PG8_SB(0, 0), cB, voffB); PG8_STAGE(PG8_SB(0, 1), cB + hstep, voffB); PG8_STAGE(PG8_SA(0, 0), cA, voffA); PG8_STAGE(PG8_SA(0, 1), cA + hstep, voffA);
        if (wr == 1) PG8_BAR;
        PG8_WAIT_V(2); PG8_BAR;
        PG8_STAGE(PG8_SB(1, 0), cB + kstep, voffB); PG8_STAGE(PG8_SA(1, 0), cA + kstep, voffA); PG8_STAGE(PG8_SB(1, 1), cB + hstep + kstep, voffB);
        PG8_WAIT_V(6); PG8_BAR;
    } else {
        PG8_STAGE(PG8_SB(0, 0), cB, voffB); PG8_STAGE(PG8_SA(0, 0), cA, voffA); PG8_STAGE(PG8_SB(0, 1), cB + hstep, voffB); PG8_STAGE(PG8_SA(0, 1), cA + hstep, voffA);
        if (wr == 1) PG8_BAR;
        PG8_WAIT_V(4); PG8_BAR;
        PG8_STAGE(PG8_SB(1, 0), cB + kstep, voffB); PG8_STAGE(PG8_SA(1, 0), cA + kstep, voffA); PG8_STAGE(PG8_SB(1, 1), cB + hstep + kstep, voffB);
        PG8_WAIT_V(6); PG8_BAR;
    }
    for (;;) {
        const bool has_next = S.next(ui + 1, nxt);
        const char* nA = has_next ? (const char*)g.A + (size_t)nxt.pm * tstep : cA; const char* nB = has_next ? (const char*)g.Bt + (size_t)nxt.pn * tstep : cB;
        for (int t = 0; t < nt; t += 2) {
            const bool last = (t == nt - 2);
            const char* a1 = cA + (size_t)(t + 1) * kstep;
            const char* a2 = last ? nA : cA + (size_t)(t + 2) * kstep; const char* b2 = last ? nB : cB + (size_t)(t + 2) * kstep;
            const char* a3 = a2 + kstep; const char* b3 = b2 + kstep;
            if (last && has_next) S.a_ready(nxt);
            if constexpr (SP2) {
            PG8_LDB(B0, 0, 0); PG8_LDB(B1, 0, 1); PG8_SCHED; PG8_LDA(At, 0, 0); PG8_STAGE(PG8_SA(1, 1), a1 + hstep, voffA);
            PG8_WAIT_V(8); PG8_WAIT_L(0); PG8_BAR; PG8_MMA(0, 0, At, B0); PG8_MMA(0, 1, At, B1); PG8_BAR; PG8_SCHED;
            PG8_LDA(At, 0, 1); PG8_STAGE(PG8_SB(0, 0), b2, voffB); PG8_STAGE(PG8_SB(0, 1), b2 + hstep, voffB); PG8_STAGE(PG8_SA(0, 0), a2, voffA);
            PG8_WAIT_V(8); PG8_WAIT_L(0); PG8_BAR; PG8_MMA(1, 0, At, B0); PG8_MMA(1, 1, At, B1); PG8_BAR; PG8_SCHED;
            PG8_LDB(B0, 1, 0); PG8_LDB(B1, 1, 1); PG8_SCHED; PG8_LDA(At, 1, 0); PG8_STAGE(PG8_SA(0, 1), a2 + hstep, voffA);
            PG8_WAIT_V(8); PG8_WAIT_L(0); PG8_BAR; PG8_MMA(0, 0, At, B0); PG8_MMA(0, 1, At, B1); PG8_BAR; PG8_SCHED;
            PG8_LDA(At, 1, 1); PG8_STAGE(PG8_SB(1, 0), b3, voffB); PG8_STAGE(PG8_SB(1, 1), b3 + hstep, voffB); PG8_STAGE(PG8_SA(1, 0), a3, voffA);
            PG8_WAIT_V(8); PG8_WAIT_L(0); PG8_BAR; PG8_MMA(1, 0, At, B0); PG8_MMA(1, 1, At, B1); PG8_BAR; PG8_SCHED;
            } else {
            PG8_LDB(B0, 0, 0); PG8_SCHED; PG8_LDA(At, 0, 0); PG8_STAGE(PG8_SA(1, 1), a1 + hstep, voffA);
            PG8_WAIT_L(8); PG8_BAR; PG8_WAIT_L(0); PG8_MMA(0, 0, At, B0); PG8_BAR; PG8_SCHED;
            PG8_LDB(B1, 0, 1); PG8_STAGE(PG8_SB(0, 0), b2, voffB);
            PG8_BAR; PG8_WAIT_L(0); PG8_MMA(0, 1, At, B1); PG8_BAR;
            PG8_LDA(At, 0, 1); PG8_STAGE(PG8_SA(0, 0), a2, voffA);
            PG8_BAR; PG8_WAIT_L(0); PG8_MMA(1, 0, At, B0); PG8_BAR; PG8_SCHED;
            PG8_STAGE(PG8_SB(0, 1), b2 + hstep, voffB);
            PG8_WAIT_V(6); PG8_BAR; PG8_MMA(1, 1, At, B1); PG8_BAR;
            PG8_LDB(B0, 1, 0); PG8_SCHED; PG8_LDA(At, 1, 0); PG8_STAGE(PG8_SA(0, 1), a2 + hstep, voffA);
            PG8_WAIT_L(8); PG8_BAR; PG8_WAIT_L(0); PG8_MMA(0, 0, At, B0); PG8_BAR; PG8_SCHED;
            PG8_LDB(B1, 1, 1); PG8_STAGE(PG8_SB(1, 0), b3, voffB);
            PG8_BAR; PG8_WAIT_L(0); PG8_MMA(0, 1, At, B1); PG8_BAR;
            PG8_LDA(At, 1, 1); PG8_STAGE(PG8_SA(1, 0), a3, voffA);
            PG8_BAR; PG8_WAIT_L(0); PG8_MMA(1, 0, At, B0); PG8_BAR; PG8_SCHED;
            PG8_STAGE(PG8_SB(1, 1), b3 + hstep, voffB);
            PG8_WAIT_V(6); PG8_BAR; PG8_MMA(1, 1, At, B1); PG8_BAR;
            }
        }
        if constexpr (ALIGN_EPI) { if (wr == 0) PG8_BAR; }
        if constexpr (!Epi::AFTER_DRAIN) { E(acc, cur, wr, wc, fr, fq); S.done(cur); }
        if (!has_next) break;
#pragma unroll
        for (int a = 0; a < 2; ++a)
#pragma unroll
            for (int b = 0; b < 2; ++b)
#pragma unroll
                for (int m = 0; m < 4; ++m)
#pragma unroll
                    for (int n = 0; n < 2; ++n) acc[a][b][m][n] = (f32x4){0.f, 0.f, 0.f, 0.f};
        cur = nxt; cA = nA; cB = nB; ++ui;
        if constexpr (ALIGN_EPI) { if (wr == 1) PG8_BAR; }
    }
    PG8_WAIT_V(0);
    if constexpr (!ALIGN_EPI) { if (wr == 0) PG8_BAR; }
    PG8_BAR;
    if constexpr (Epi::AFTER_DRAIN) { E.fused(acc, cur, wr, wc, fr, fq, lds, wid, lane); S.done(cur); }
#undef PG8_SA
#undef PG8_SB
#undef PG8_STAGE
#undef PG8_LDA
#undef PG8_LDB
#undef PG8_MMA
#undef PG8_WAIT_V
#undef PG8_WAIT_L
#undef PG8_BAR
#undef PG8_SCHED
}
}

constexpr int NWAVES = 8, NTHREADS = 512;
#ifndef MK_N_LAUNCHES
#define MK_N_LAUNCHES 1
#endif
constexpr int BATCH = 8, SEQ = 2048, D = 1024, FF = 4096, NH = 4, DK = 128, DV = 256, QKW = 512, VW = 1024;
constexpr int M = BATCH * SEQ, NPROJ = 3072, CH = 64, NCH = SEQ / CH;
constexpr int MLSTM_IN = 3080, GLA_IN = 3088;
constexpr float EPS = 1e-6f, QK_SCALE = 0.08838834764831845f, INV_TAU = 1.0f / 16.0f;

constexpr size_t MiB = 1u << 20;
constexpr size_t WS_CTL = 0, CTL_ZERO_BYTES = 64 * 1024;
constexpr size_t WS_GATES = 1 * MiB;
constexpr size_t WS_GDEC = 2 * MiB;
constexpr size_t WS_SUMSQ = 2 * MiB + 512 * 1024;
constexpr size_t WS_WIN = 4 * MiB, WS_WOUT = 10 * MiB, WS_W1 = 12 * MiB, WS_W2 = 20 * MiB, WS_WLAYER = 56 * MiB;
constexpr size_t WS_AOP = 28 * MiB;
constexpr size_t WS_PROJ = 92 * MiB;
constexpr size_t WS_QT = 188 * MiB, WS_KT = 204 * MiB;
constexpr size_t WS_HMID = 92 * MiB;
constexpr size_t WS_XRES = 220 * MiB;
constexpr size_t WS_END = 252 * MiB;
constexpr int CW_BAR = 1024, CW_XID = 8192, CW_FIN = 14336, CW_GRP = 15360;

constexpr int RING_BYTES = 131072, LDS_BYTES = 155648, LDSCTL_OFF = LDS_BYTES - 1024, MISC_OFF = LDSCTL_OFF + 320;

#define GAS __attribute__((address_space(1)))
#define LAS __attribute__((address_space(3)))
typedef unsigned short bf16;
typedef unsigned v4u __attribute__((ext_vector_type(4)));
typedef unsigned v2u __attribute__((ext_vector_type(2)));
typedef float f32x4 __attribute__((ext_vector_type(4)));
typedef float f32x16 __attribute__((ext_vector_type(16)));
typedef short bf16x8 __attribute__((ext_vector_type(8)));
typedef short s16x4 __attribute__((ext_vector_type(4)));
typedef GAS unsigned gu32;
#define RLX_AGENT __ATOMIC_RELAXED, __HIP_MEMORY_SCOPE_AGENT
#define LDS_WAIT() asm volatile("s_waitcnt lgkmcnt(0)" ::: "memory")
#define VM_WAIT() asm volatile("s_waitcnt vmcnt(0)" ::: "memory")
using pg8::pk_bf16;
__device__ __forceinline__ float bf2f(unsigned b) { return __uint_as_float(b << 16); }
__device__ __forceinline__ float bflo(unsigned w) { return __uint_as_float(w << 16); }
__device__ __forceinline__ float bfhi(unsigned w) { return __uint_as_float(w & 0xffff0000u); }
__device__ __forceinline__ unsigned short f2bf1(float f) { return (unsigned short)(pk_bf16(f, 0.f) & 0xffffu); }

struct Args { const float* in[15]; float* out; unsigned char* ws; int ph_lo, ph_hi; };
#define XB_TMO      128
#define XB_XCNT(j)  (256  + 64 * (j))
#define XB_XSUB(j)  (1280 + 64 * (j))
#define XB_XGEN(j)  (2304 + 64 * (j))
#define XB_TOP      3328
#define XB_TOPGEN   3392
#define XCD_BAR_WORDS 3456
#define XB_SPIN_CAP (1u << 18)
__device__ __forceinline__ unsigned xb_ld(unsigned* p)              { return __hip_atomic_load(p, __ATOMIC_RELAXED, __HIP_MEMORY_SCOPE_AGENT); }
__device__ __forceinline__ unsigned xb_add(unsigned* p, unsigned v) { return __hip_atomic_fetch_add(p, v, __ATOMIC_RELAXED, __HIP_MEMORY_SCOPE_AGENT); }
__device__ __forceinline__ unsigned xb_xcc_id() { return (unsigned)__builtin_amdgcn_s_getreg((3 << 11) | 20) & 0xFu; }
#define XB_SPIN(cond, bar) do { unsigned _sp = 0; while (cond) { __builtin_amdgcn_s_sleep(1); \
    if ((++_sp & 255u) == 0u) { if (xb_ld(&(bar)[XB_TMO])) break; if (_sp > XB_SPIN_CAP) { atomicAdd(&(bar)[XB_TMO], 1u); break; } } } } while (0)
struct XcdBarrier { unsigned* bar; unsigned x; volatile LAS unsigned* st; };
__device__ __forceinline__ XcdBarrier xcd_barrier_post(unsigned* bar, volatile LAS unsigned* st) {
    XcdBarrier b; b.bar = bar; b.x = xb_xcc_id(); b.st = st;
    if (threadIdx.x == 0) (void)xb_add(&bar[XB_XCNT(b.x)], 1u);
    return b;
}
__device__ __forceinline__ void xcd_barrier_complete(unsigned* bar, unsigned x, unsigned& nloc, unsigned& nx) {
    const unsigned G = gridDim.x * gridDim.y * gridDim.z;
    unsigned sum, cnt, mine, sp = 0u;
    for (;;) {
        sum = 0u; cnt = 0u; mine = 0u;
#pragma unroll
        for (unsigned j = 0; j < 16; ++j) { const unsigned c = xb_ld(&bar[XB_XCNT(j)]); sum += c; cnt += (c > 0u) ? 1u : 0u; mine = (j == x) ? c : mine; }
        if (sum == G) break;
        __builtin_amdgcn_s_sleep(1);
        if ((++sp & 255u) == 0u) { if (xb_ld(&bar[XB_TMO])) break; if (sp > XB_SPIN_CAP) { atomicAdd(&bar[XB_TMO], 1u); break; } }
    }
    nloc = mine > 0u ? mine : 1u; nx = cnt > 0u ? cnt : 1u;
}
__device__ __forceinline__ void xcd_barrier(const XcdBarrier& b) {
    asm volatile("s_waitcnt vmcnt(0)" ::: "memory");
    __syncthreads();
    if (threadIdx.x == 0) {
        unsigned* bar = b.bar;
        __builtin_amdgcn_s_waitcnt(0);
        unsigned nloc = b.st[0], nx = b.st[1];
        if (nloc == 0u) { xcd_barrier_complete(bar, b.x, nloc, nx); b.st[0] = nloc; b.st[1] = nx; }
        const unsigned old = xb_add(&bar[XB_XSUB(b.x)], 1u);
        const unsigned gen = old / nloc;
        if (old + 1u == (gen + 1u) * nloc) {
            __builtin_amdgcn_fence(__ATOMIC_RELEASE, "agent");
            asm volatile("s_waitcnt vmcnt(0)" ::: "memory");
            const unsigned og = xb_add(&bar[XB_TOP], 1u);
            const unsigned tg = og / nx;
            if (og + 1u == (tg + 1u) * nx) xb_add(&bar[XB_TOPGEN], 1u);
            else XB_SPIN(xb_ld(&bar[XB_TOPGEN]) == tg, bar);
            __builtin_amdgcn_fence(__ATOMIC_ACQUIRE, "agent");
            xb_add(&bar[XB_XGEN(b.x)], 1u);
            asm volatile("s_waitcnt vmcnt(0)" ::: "memory");
        } else {
            XB_SPIN(xb_ld(&bar[XB_XGEN(b.x)]) == gen, bar);
            __builtin_amdgcn_fence(__ATOMIC_ACQUIRE, "agent");
            asm volatile("s_waitcnt vmcnt(0)" ::: "memory");
        }
    }
    __syncthreads();
}

__device__ __forceinline__ float wave_sum(float v) {
#pragma unroll
    for (int o = 1; o < 64; o <<= 1) v += __shfl_xor(v, o);
    return v;
}
struct CvItem { const float* W; bf16* WT; const float* gain; int K, ldw, k0, n0; };
__device__ __forceinline__ CvItem cv_item(const Args& args, unsigned char* ws, int it) {
    constexpr int I_IN = (D / 64) * (NPROJ / 64), I_O = (D / 64) * (D / 64), I_1 = (D / 64) * (FF / 64), I_2 = (FF / 64) * (D / 64), NITEMS = I_IN + I_O + I_1 + I_2;
    const int layer = it >= NITEMS; int r = it - layer * NITEMS; unsigned char* wl = ws + (size_t)layer * WS_WLAYER;
    CvItem c; int N;
    if (r < I_IN) { c.W = args.in[layer ? 8 : 4]; c.K = D; N = NPROJ; c.ldw = layer ? GLA_IN : MLSTM_IN; c.WT = (bf16*)(wl + WS_WIN); c.gain = args.in[1] + layer * D; }
    else if ((r -= I_IN) < I_O) { c.W = args.in[layer ? 12 : 7]; c.K = D; N = D; c.ldw = D; c.WT = (bf16*)(wl + WS_WOUT); c.gain = nullptr; }
    else if ((r -= I_O) < I_1) { c.W = args.in[13] + (size_t)layer * D * FF; c.K = D; N = FF; c.ldw = FF; c.WT = (bf16*)(wl + WS_W1); c.gain = args.in[2] + layer * D; }
    else { r -= I_1; c.W = args.in[14] + (size_t)layer * D * FF; c.K = FF; N = D; c.ldw = D; c.WT = (bf16*)(wl + WS_W2); c.gain = nullptr; }
    const int nblk = N / 64; c.k0 = 64 * (r / nblk); c.n0 = 64 * (r % nblk);
    return c;
}
__device__ __forceinline__ void cv_load(f32x4 (&v)[16], const CvItem& c, int lane) {
    const int n4 = (lane & 15) * 4, krow = lane >> 4;
#pragma unroll
    for (int i = 0; i < 16; ++i) v[i] = *(const f32x4*)(c.W + (size_t)(c.k0 + 4 * i + krow) * c.ldw + c.n0 + n4);
}
__device__ __forceinline__ void cv_store(const f32x4 (&v)[16], const CvItem& c, LAS float* scr, int lane) {
    const int n4 = (lane & 15) * 4, krow = lane >> 4;
#pragma unroll
    for (int i = 0; i < 16; ++i) *(LAS f32x4*)(scr + (4 * i + krow) * 64 + (n4 ^ (((i >> 1) & 7) << 2))) = v[i];
    const int cc = lane & 7, nl = lane >> 3;
    f32x4 g0 = {1.f, 1.f, 1.f, 1.f}, g1 = {1.f, 1.f, 1.f, 1.f};
    if (c.gain) { g0 = *(const f32x4*)(c.gain + c.k0 + 8 * cc); g1 = *(const f32x4*)(c.gain + c.k0 + 8 * cc + 4); }
    LDS_WAIT(); asm volatile("" ::: "memory");
#pragma unroll
    for (int j = 0; j < 8; ++j) { const int n = 8 * j + nl; const LAS float* sp = scr + (8 * cc) * 64 + (n ^ (cc << 2));
        v4u o; o.x = pk_bf16(sp[0 * 64] * g0.x, sp[1 * 64] * g0.y); o.y = pk_bf16(sp[2 * 64] * g0.z, sp[3 * 64] * g0.w); o.z = pk_bf16(sp[4 * 64] * g1.x, sp[5 * 64] * g1.y); o.w = pk_bf16(sp[6 * 64] * g1.z, sp[7 * 64] * g1.w);
        *(GAS v4u*)(c.WT + (size_t)(c.n0 + n) * c.K + c.k0 + 8 * cc) = o; }
    LDS_WAIT(); asm volatile("" ::: "memory");
}
__device__ __forceinline__ void convert_weights(LAS unsigned char* lds, int lane, int wave, int vcu, int G, const Args& args, unsigned char* ws) {
    LAS float* scr = (LAS float*)(lds + wave * 16384);
    const int gw = vcu * NWAVES + wave, NGW = G * NWAVES;
    constexpr int NITEMS2 = 2 * ((D / 64) * (NPROJ / 64) + (D / 64) * (D / 64) + (D / 64) * (FF / 64) + (FF / 64) * (D / 64));
    f32x4 va[16], vb[16];
    int it = gw;
    if (it < NITEMS2) { const CvItem c0 = cv_item(args, ws, it); cv_load(va, c0, lane); }
    while (it < NITEMS2) {
        { const CvItem c = cv_item(args, ws, it); const int nx = it + NGW; if (nx < NITEMS2) { const CvItem cn = cv_item(args, ws, nx); cv_load(vb, cn, lane); } cv_store(va, c, scr, lane); it = nx; }
        if (it >= NITEMS2) break;
        { const CvItem c = cv_item(args, ws, it); const int nx = it + NGW; if (nx < NITEMS2) { const CvItem cn = cv_item(args, ws, nx); cv_load(va, cn, lane); } cv_store(vb, c, scr, lane); it = nx; }
    }
}

__device__ __forceinline__ void rows_first(LAS unsigned char* lds, int tid, int lane, int wave, int vcu, int G, const float* xin, const float* gain, bf16* xres, float* sumsq,
                                           const float* wg, int ldw, int ng, float* gates) {
    LAS float* WgT = (LAS float*)lds;
    __syncthreads();
    { float wv[32];
#pragma unroll
      for (int n = 0; n < 32; ++n) { const int i = tid + NTHREADS * n, k = i >> 4, c = i & 15; wv[n] = (c < ng) ? wg[(size_t)k * ldw + c] : 0.f; }
#pragma unroll
      for (int n = 0; n < 32; ++n) { const int i = tid + NTHREADS * n, k = i >> 4, c = i & 15; WgT[c * D + k] = wv[n]; } }
    __syncthreads();
    const int gw = vcu * NWAVES + wave, NGW = G * NWAVES;
    f32x4 gn[4];
#pragma unroll
    for (int j = 0; j < 4; ++j) gn[j] = *(const f32x4*)(gain + 4 * lane + 256 * j);
    f32x4 vn[4];
    if (gw < M) {
#pragma unroll
        for (int j = 0; j < 4; ++j) vn[j] = *(const f32x4*)(xin + (size_t)gw * D + 4 * lane + 256 * j); }
    for (int m = gw; m < M; m += NGW) {
        f32x4 v[4]; float s = 0.f;
#pragma unroll
        for (int j = 0; j < 4; ++j) { v[j] = vn[j]; s += (v[j].x * v[j].x + v[j].y * v[j].y) + (v[j].z * v[j].z + v[j].w * v[j].w); }
        if (m + NGW < M) {
#pragma unroll
            for (int j = 0; j < 4; ++j) vn[j] = *(const f32x4*)(xin + (size_t)(m + NGW) * D + 4 * lane + 256 * j); }
#pragma unroll
        for (int j = 0; j < 4; ++j) { v2u o; o.x = pk_bf16(v[j].x, v[j].y); o.y = pk_bf16(v[j].z, v[j].w); *(v2u*)(xres + (size_t)m * D + 4 * lane + 256 * j) = o; }
        const float ssum = wave_sum(s);
        if (lane == 0) *(f32x4*)(sumsq + (size_t)m * 4) = (f32x4){ssum, 0.f, 0.f, 0.f};
        const float rstd = 1.0f / sqrtf(ssum * (1.f / D) + EPS);
#pragma unroll
        for (int j = 0; j < 4; ++j) v[j] = v[j] * rstd * gn[j];
        float a[16];
#pragma unroll
        for (int c = 0; c < 16; ++c) a[c] = 0.f;
#pragma unroll
        for (int c = 0; c < 16; ++c) {
#pragma unroll
            for (int j = 0; j < 4; ++j) { const f32x4 w = *(const LAS f32x4*)(WgT + c * D + 4 * lane + 256 * j); a[c] += (v[j].x * w.x + v[j].y * w.y) + (v[j].z * w.z + v[j].w * w.w); }
            if (c & 1) asm volatile("" ::: "memory"); }
        const bool b5 = lane & 32, b4 = lane & 16, b3 = lane & 8, b2 = lane & 4;
#pragma unroll
        for (int i = 0; i < 8; ++i) { const float keep = b5 ? a[i + 8] : a[i], send = b5 ? a[i] : a[i + 8]; a[i] = keep + __shfl_xor(send, 32); }
#pragma unroll
        for (int i = 0; i < 4; ++i) { const float keep = b4 ? a[i + 4] : a[i], send = b4 ? a[i] : a[i + 4]; a[i] = keep + __shfl_xor(send, 16); }
#pragma unroll
        for (int i = 0; i < 2; ++i) { const float keep = b3 ? a[i + 2] : a[i], send = b3 ? a[i] : a[i + 2]; a[i] = keep + __shfl_xor(send, 8); }
        { const float keep = b2 ? a[1] : a[0], send = b2 ? a[0] : a[1]; a[0] = keep + __shfl_xor(send, 4); }
        a[0] += __shfl_xor(a[0], 2); a[0] += __shfl_xor(a[0], 1);
        const int c = (b5 ? 8 : 0) + (b4 ? 4 : 0) + (b3 ? 2 : 0) + (b2 ? 1 : 0);
        if ((lane & 3) == 0 && c < ng) gates[(size_t)m * 16 + c] = a[0];
    }
}
__device__ __forceinline__ void rows_final(int lane, int wave, int vcu, int G, const bf16* xres, const float* gain, float* out) {
    const int gw = vcu * NWAVES + wave, NGW = G * NWAVES;
    for (int m = gw; m < M; m += NGW) {
        float f[2][8]; float ss = 0.f;
#pragma unroll
        for (int j = 0; j < 2; ++j) { const v4u hv = *(const v4u*)(xres + (size_t)m * D + 8 * lane + 512 * j);
            f[j][0] = bflo(hv.x); f[j][1] = bfhi(hv.x); f[j][2] = bflo(hv.y); f[j][3] = bfhi(hv.y); f[j][4] = bflo(hv.z); f[j][5] = bfhi(hv.z); f[j][6] = bflo(hv.w); f[j][7] = bfhi(hv.w);
#pragma unroll
            for (int e = 0; e < 8; ++e) ss += f[j][e] * f[j][e]; }
        const float rstd = 1.0f / sqrtf(wave_sum(ss) * (1.f / D) + EPS);
#pragma unroll
        for (int j = 0; j < 2; ++j) { const int col = 8 * lane + 512 * j; const f32x4 g0 = *(const f32x4*)(gain + col), g1 = *(const f32x4*)(gain + col + 4);
            *(f32x4*)(out + (size_t)m * D + col) = (f32x4){f[j][0] * rstd * g0.x, f[j][1] * rstd * g0.y, f[j][2] * rstd * g0.z, f[j][3] * rstd * g0.w};
            *(f32x4*)(out + (size_t)m * D + col + 4) = (f32x4){f[j][4] * rstd * g1.x, f[j][5] * rstd * g1.y, f[j][6] * rstd * g1.z, f[j][7] * rstd * g1.w}; }
    }
}
struct RstdSlots { int pm0, pm1, pm2, pm3; };
__device__ __forceinline__ RstdSlots rstd_table(LAS float* rt, const float* sumsq, const pg8::StaticOrder& S, int tid) {
    int pmv[4] = {-1, -1, -1, -1}; int ns = 0;
    pg8::Unit u;
    for (int i = 0; S.next(i, u); ++i) { if (u.pm != pmv[0] && u.pm != pmv[1] && u.pm != pmv[2] && u.pm != pmv[3] && ns < 4) { if (ns == 0) pmv[0] = u.pm; else if (ns == 1) pmv[1] = u.pm; else if (ns == 2) pmv[2] = u.pm; else pmv[3] = u.pm; ++ns; } }
#pragma unroll
    for (int sl = 0; sl < 4; ++sl) { const int pm = sl == 0 ? pmv[0] : sl == 1 ? pmv[1] : sl == 2 ? pmv[2] : pmv[3];
        if (pm >= 0 && tid < 256) { const f32x4 s4 = *(const f32x4*)(sumsq + (size_t)(pm * 256 + tid) * 4); rt[sl * 256 + tid] = 1.0f / sqrtf(((s4.x + s4.y) + (s4.z + s4.w)) * (1.f / D) + EPS); } }
    __syncthreads();
    return RstdSlots{pmv[0], pmv[1], pmv[2], pmv[3]};
}

__device__ __forceinline__ void head_norm_rows(int lane, int wave, int vcu, int G, const bf16* hun, const float* gout, const bf16* proj, bf16* aop, const bool GLA) {
    const int gw = vcu * NWAVES + wave, NGW = G * NWAVES;
    for (int m = gw; m < M; m += NGW) {
#pragma unroll
        for (int j = 0; j < 2; ++j) {
            const int col = 8 * lane + 512 * j;
            const v4u hv = *(const v4u*)(hun + (size_t)m * D + col);
            const v4u rv = *(const v4u*)(proj + (size_t)m * NPROJ + 2048 + col);
            float f[8] = {bflo(hv.x), bfhi(hv.x), bflo(hv.y), bfhi(hv.y), bflo(hv.z), bfhi(hv.z), bflo(hv.w), bfhi(hv.w)};
            const float r[8] = {bflo(rv.x), bfhi(rv.x), bflo(rv.y), bfhi(rv.y), bflo(rv.z), bfhi(rv.z), bflo(rv.w), bfhi(rv.w)};
            float sg[8];
#pragma unroll
            for (int e = 0; e < 8; ++e) sg[e] = __builtin_amdgcn_rcpf(1.0f + __expf(-r[e]));
            if (!GLA) {
#pragma unroll
                for (int e = 0; e < 8; ++e) f[e] *= sg[e];
            }
            float ss = 0.f;
#pragma unroll
            for (int e = 0; e < 8; ++e) ss += f[e] * f[e];
#pragma unroll
            for (int o = 1; o < 32; o <<= 1) ss += __shfl_xor(ss, o);
            const float rs = 1.0f / sqrtf(ss * (1.f / DV) + EPS);
            const f32x4 g0 = *(const f32x4*)(gout + col), g1 = *(const f32x4*)(gout + col + 4);
            const float gg[8] = {g0.x, g0.y, g0.z, g0.w, g1.x, g1.y, g1.z, g1.w};
#pragma unroll
            for (int e = 0; e < 8; ++e) f[e] = f[e] * rs * gg[e];
            if (GLA) {
#pragma unroll
                for (int e = 0; e < 8; ++e) f[e] *= r[e] * sg[e];
            }
            v4u o; o.x = pk_bf16(f[0], f[1]); o.y = pk_bf16(f[2], f[3]); o.z = pk_bf16(f[4], f[5]); o.w = pk_bf16(f[6], f[7]);
            *(v4u*)(aop + (size_t)m * D + col) = o;
        }
    }
}

constexpr int GP_WGT = 0, GP_WGT_PITCH = 2064, GP_ZL = 33024, GP_TOT = 41216, GP_Q = 43264, GP_K = 59648;
__device__ __forceinline__ void gla_prep(LAS unsigned char* lds, int tid, int lane, int wave, int vcu, int G, const bf16* proj, const bf16* xres, const float* sumsq, const float* w_in, const float* gmix,
                                         const float* wup, const float* bgate, bf16* QT, bf16* KT, float* gdec) {
    LAS float* zl = (LAS float*)(lds + GP_ZL);
    LAS float* tot = (LAS float*)(lds + GP_TOT);
    LAS unsigned short* tq = (LAS unsigned short*)(lds + GP_Q);
    LAS unsigned short* tk = (LAS unsigned short*)(lds + GP_K);
    __syncthreads();
    { float wv[32];
#pragma unroll
      for (int n = 0; n < 32; ++n) { const int i = tid + NTHREADS * n, k = i >> 4, c = i & 15; wv[n] = gmix[k] * w_in[(size_t)k * GLA_IN + NPROJ + c]; }
#pragma unroll
      for (int n = 0; n < 32; ++n) { const int i = tid + NTHREADS * n, k = i >> 4, c = i & 15; *(LAS unsigned short*)(lds + GP_WGT + c * GP_WGT_PITCH + k * 2) = f2bf1(wv[n]); } }
    const int d = tid & 127, rg = tid >> 7;
    for (int unit = vcu; unit < BATCH * NCH; unit += G) {
        const int b = unit / NCH, c = unit % NCH, tok0 = b * SEQ + c * CH;
        v4u pq[2], pk[2]; float wu[16]; float bg;
#define GP_LOAD(h_) do { _Pragma("unroll") for (int i_ = 0; i_ < 2; ++i_) { const int p_ = tid + NTHREADS * i_, row_ = p_ >> 4, ch_ = p_ & 15; \
            pq[i_] = *(const v4u*)(proj + (size_t)(tok0 + row_) * NPROJ + (h_) * DK + ch_ * 8); pk[i_] = *(const v4u*)(proj + (size_t)(tok0 + row_) * NPROJ + QKW + (h_) * DK + ch_ * 8); } \
            _Pragma("unroll") for (int cc_ = 0; cc_ < 16; ++cc_) wu[cc_] = wup[cc_ * QKW + (h_) * DK + d]; bg = bgate[(h_) * DK + d]; } while (0)
        GP_LOAD(0);
        __syncthreads();
        {
            const int rt = wave & 3, kh = wave >> 2, r16 = lane & 15, kq = lane >> 4;
            pg8::f32x4 acc = {0.f, 0.f, 0.f, 0.f};
            const bf16* xr = xres + (size_t)(tok0 + 16 * rt + r16) * D + kh * 512 + 8 * kq;
            LAS unsigned char* wr_ = lds + GP_WGT + r16 * GP_WGT_PITCH + (kh * 512 + 8 * kq) * 2;
#pragma unroll
            for (int ks = 0; ks < 16; ++ks) { const bf16x8 av = *(const bf16x8*)(xr + 32 * ks), bv = *(const LAS bf16x8*)(wr_ + 64 * ks); acc = __builtin_amdgcn_mfma_f32_16x16x32_bf16(av, bv, acc, 0, 0, 0); }
#pragma unroll
            for (int i = 0; i < 4; ++i) zl[kh * 1024 + (16 * rt + 4 * kq + i) * 16 + r16] = acc[i];
        }
        __syncthreads();
        { const int row = tid >> 3, c2 = (tid & 7) * 2;
          const f32x4 s4 = *(const f32x4*)(sumsq + (size_t)(tok0 + row) * 4); const float rstd = 1.0f / sqrtf(((s4.x + s4.y) + (s4.z + s4.w)) * (1.f / D) + EPS);
          const float z0 = (zl[row * 16 + c2] + zl[1024 + row * 16 + c2]) * rstd, z1 = (zl[row * 16 + c2 + 1] + zl[1024 + row * 16 + c2 + 1]) * rstd;
          __syncthreads();
          zl[row * 16 + c2] = z0; zl[row * 16 + c2 + 1] = z1; }
        __syncthreads();
#pragma unroll
        for (int h = 0; h < NH; ++h) {
#pragma unroll
            for (int i = 0; i < 2; ++i) { const int p = tid + NTHREADS * i; *(LAS v4u*)(lds + GP_Q + p * 16) = pq[i]; *(LAS v4u*)(lds + GP_K + p * 16) = pk[i]; }
            float wuh[16]; const float bgh = bg;
#pragma unroll
            for (int cc = 0; cc < 16; ++cc) wuh[cc] = wu[cc];
            if (h + 1 < NH) GP_LOAD(h + 1);
            float bcum[16]; float run = 0.f;
#pragma unroll
            for (int jj = 0; jj < 16; ++jj) {
                const int j = 16 * rg + jj; float z = bgh;
#pragma unroll
                for (int q4 = 0; q4 < 4; ++q4) { const f32x4 zz = *(const LAS f32x4*)(zl + j * 16 + 4 * q4); z += (zz.x * wuh[4 * q4] + zz.y * wuh[4 * q4 + 1]) + (zz.z * wuh[4 * q4 + 2] + zz.w * wuh[4 * q4 + 3]); }
                const float la = (fminf(z, 0.f) - __logf(1.0f + __expf(-fabsf(z)))) * INV_TAU;
                run += la; bcum[jj] = run;
            }
            tot[rg * 128 + d] = run;
            __syncthreads();
            float off = 0.f, g = 0.f;
#pragma unroll
            for (int r2 = 0; r2 < 4; ++r2) { const float t = tot[r2 * 128 + d]; g += t; off += (r2 < rg) ? t : 0.f; }
#pragma unroll
            for (int jj = 0; jj < 16; ++jj) {
                const int j = 16 * rg + jj; const float eb = __expf(bcum[jj] + off);
                const float q = bf2f(tq[j * 128 + d]), k = bf2f(tk[j * 128 + d]);
                tq[j * 128 + d] = f2bf1(q * QK_SCALE * eb); tk[j * 128 + d] = f2bf1(k * __builtin_amdgcn_rcpf(eb));
            }
            if (rg == 0) gdec[(size_t)(unit * NH + h) * DK + d] = __expf(g);
            __syncthreads();
#pragma unroll
            for (int i = 0; i < 2; ++i) { const int p = tid + NTHREADS * i, row = p >> 4, ch = p & 15;
                *(v4u*)(QT + (size_t)(tok0 + row) * QKW + h * DK + ch * 8) = *(const LAS v4u*)(lds + GP_Q + p * 16);
                *(v4u*)(KT + (size_t)(tok0 + row) * QKW + h * DK + ch * 8) = *(const LAS v4u*)(lds + GP_K + p * 16); }
            __syncthreads();
        }
#undef GP_LOAD
    }
    __syncthreads();
}

#ifndef PROBE_P
#define PROBE_P 0
#endif
#ifndef PROBE_P_A
#define PROBE_P_A 0
#endif
#ifndef PROBE_P_B
#define PROBE_P_B 1
#endif
#define PP_STAMP(i) do { if (PROBE_P && ((i) / 2 == PROBE_P_A || (i) / 2 == PROBE_P_B) && tid == 0) ((volatile LAS unsigned*)(lds + LDSCTL_OFF + 512))[i] = (unsigned)__builtin_amdgcn_s_memrealtime(); } while (0)
#ifndef PROBE_T
#define PROBE_T 0
#endif
#ifndef PROBE_T_MLSTM
#define PROBE_T_MLSTM 0
#endif
#ifndef PROBE_T_WAVE
#define PROBE_T_WAVE 0
#endif
#ifndef PROBE_T_A
#define PROBE_T_A 5
#endif
#ifndef PROBE_T_B
#define PROBE_T_B 0
#endif
constexpr int CW_PROBE = 12288;
__device__ __forceinline__ unsigned long long pt_now() { unsigned long long t; __builtin_amdgcn_sched_barrier(0); asm volatile("s_memrealtime %0\n\ts_waitcnt lgkmcnt(0)" : "=s"(t) :: "memory"); __builtin_amdgcn_sched_barrier(0); return t; }
#define PT_NOW() pt_now()
#define PT_ACC(i, t0) do { if (PROBE_T) { const unsigned long long t1_ = PT_NOW(); pt[i] += (unsigned)(t1_ - (t0)); (t0) = t1_; } } while (0)
constexpr int PS_PITCH = 144, CT_PITCH = 272, CT_BYTES = 32 * CT_PITCH, IMG_PITCH = 272, IMG_BYTES = 64 * IMG_PITCH, NUM_PITCH = 36;
template <bool MLSTM> struct MxMap;
template <> struct MxMap<true>  { static constexpr int QS = 0, KS = 34816, V = 69632, VW = 77824, VWAUX = 81920, PS = 86016, CT = 95232, TB = 112640, TWP = 120832, TPM = 129024, TSC = 137216, DEN = 137728, NUM = 138240, OUTT = 0, GDEC = 0, END = 147456; };
template <> struct MxMap<false> { static constexpr int QS = 0, KS = 34816, V = 69632, VW = 0, VWAUX = 0, PS = 77824, CT = 87040, TB = 0, TWP = 0, TPM = 0, TSC = 0, DEN = 0, NUM = 0, OUTT = 104448, GDEC = 108544, END = 109568; };
#define LDSA(p) ((unsigned)(size_t)(p))
__device__ __forceinline__ bf16x8 mk8(v2u lo, v2u hi) { v4u w; w.x = lo.x; w.y = lo.y; w.z = hi.x; w.w = hi.y; return __builtin_bit_cast(bf16x8, w); }
__device__ __forceinline__ void tr_read2(bf16x8& f0, bf16x8& f1, unsigned a0, unsigned a1, unsigned b0, unsigned b1) {
    v2u l0, h0, l1, h1;
    asm volatile("ds_read_b64_tr_b16 %0, %4\n\tds_read_b64_tr_b16 %1, %5\n\tds_read_b64_tr_b16 %2, %6\n\tds_read_b64_tr_b16 %3, %7\n\ts_waitcnt lgkmcnt(0)"
                 : "=&v"(l0), "=&v"(h0), "=&v"(l1), "=&v"(h1) : "v"(a0), "v"(a1), "v"(b0), "v"(b1) : "memory");
    f0 = mk8(l0, h0); f1 = mk8(l1, h1);
}
__device__ __forceinline__ void tr_read3(bf16x8& f0, bf16x8& f1, bf16x8& f2, unsigned a0, unsigned a1, unsigned b0, unsigned b1, unsigned c0, unsigned c1) {
    v2u l0, h0, l1, h1, l2, h2;
    asm volatile("ds_read_b64_tr_b16 %0, %6\n\tds_read_b64_tr_b16 %1, %7\n\tds_read_b64_tr_b16 %2, %8\n\tds_read_b64_tr_b16 %3, %9\n\tds_read_b64_tr_b16 %4, %10\n\tds_read_b64_tr_b16 %5, %11\n\ts_waitcnt lgkmcnt(0)"
                 : "=&v"(l0), "=&v"(h0), "=&v"(l1), "=&v"(h1), "=&v"(l2), "=&v"(h2) : "v"(a0), "v"(a1), "v"(b0), "v"(b1), "v"(c0), "v"(c1) : "memory");
    f0 = mk8(l0, h0); f1 = mk8(l1, h1); f2 = mk8(l2, h2);
}
template <int P> __device__ __forceinline__ void tr_issue4(v2u (&x)[8], unsigned base) {
    asm volatile("ds_read_b64_tr_b16 %0, %8 offset:%9\n\tds_read_b64_tr_b16 %1, %8 offset:%10\n\tds_read_b64_tr_b16 %2, %8 offset:%11\n\tds_read_b64_tr_b16 %3, %8 offset:%12\n\t"
                 "ds_read_b64_tr_b16 %4, %8 offset:%13\n\tds_read_b64_tr_b16 %5, %8 offset:%14\n\tds_read_b64_tr_b16 %6, %8 offset:%15\n\tds_read_b64_tr_b16 %7, %8 offset:%16"
                 : "=&v"(x[0]), "=&v"(x[1]), "=&v"(x[2]), "=&v"(x[3]), "=&v"(x[4]), "=&v"(x[5]), "=&v"(x[6]), "=&v"(x[7])
                 : "v"(base), "i"(0), "i"(4 * P), "i"(16 * P), "i"(20 * P), "i"(32 * P), "i"(36 * P), "i"(48 * P), "i"(52 * P) : "memory");
}
__device__ __forceinline__ void tr_wait8(v2u (&x)[8]) { asm volatile("s_waitcnt lgkmcnt(0)" : "+v"(x[0]), "+v"(x[1]), "+v"(x[2]), "+v"(x[3]), "+v"(x[4]), "+v"(x[5]), "+v"(x[6]), "+v"(x[7]) :: "memory"); }
__device__ __forceinline__ void tr_pin8(v2u (&x)[8]) { asm volatile("" : "+v"(x[0]), "+v"(x[1]), "+v"(x[2]), "+v"(x[3]), "+v"(x[4]), "+v"(x[5]), "+v"(x[6]), "+v"(x[7])); }
__device__ __forceinline__ bf16x8 tr_read1(unsigned a0, unsigned a1) {
    v2u l0, h0;
    asm volatile("ds_read_b64_tr_b16 %0, %2\n\tds_read_b64_tr_b16 %1, %3\n\ts_waitcnt lgkmcnt(0)" : "=&v"(l0), "=&v"(h0) : "v"(a0), "v"(a1) : "memory");
    return mk8(l0, h0);
}
#define MFMA32(a, b, c) __builtin_amdgcn_mfma_f32_32x32x16_bf16((a), (b), (c), 0, 0, 0)
#define MX_BAR() do { asm volatile("s_waitcnt lgkmcnt(0)" ::: "memory"); __builtin_amdgcn_s_barrier(); asm volatile("" ::: "memory"); } while (0)
#define MX_BAR_VM() do { asm volatile("s_waitcnt vmcnt(0) lgkmcnt(0)" ::: "memory"); __builtin_amdgcn_s_barrier(); asm volatile("" ::: "memory"); } while (0)
struct MixArgs { const bf16 *q, *k, *proj; int qpitch; const float *gates, *bgate, *gdec; bf16* hun; void* probe; };
struct MixUnit { const bf16 *Qg, *Kg, *Vg; bf16* Hg; const float* gdec; int qpitch, b, hh; };
constexpr int MX_NPIECE = 38, MX_PPW = 5;
template <bool MLSTM> struct MixDma { static constexpr int PPW = MX_PPW; unsigned voff[PPW]; };
template <bool MLSTM> __device__ __forceinline__ int mx_piece(int wave, int i) { return wave + 8 * i; }

template <bool MLSTM>
__device__ __forceinline__ void mx_dma_setup(MixDma<MLSTM>& dm, int wave, int lane, int qpitch) {
#pragma unroll
    for (int i = 0; i < MixDma<MLSTM>::PPW; ++i) { const int pi = mx_piece<MLSTM>(wave, i); unsigned v = 0;
        if (pi < 34) { const int ob = (pi < 17 ? pi : pi - 17) * 1024 + lane * 16, row = ob / IMG_PITCH; int cb = ob - row * IMG_PITCH; cb = cb < 256 ? cb : 240; v = (unsigned)(row * qpitch * 2 + cb); }
        else { const int ob = (pi - 34) * 1024 + lane * 16, row = ob >> 6, cb = ob & 63; v = (unsigned)(row * NPROJ * 2 + cb); }
        dm.voff[i] = v; }
}
template <bool MLSTM>
__device__ __forceinline__ void mx_dma_issue(LAS unsigned char* lds, const MixDma<MLSTM>& dm, const MixUnit& U, int c, int wave, int tid) {
    typedef MxMap<MLSTM> MP;
    const int par = c & 1; const size_t tok0 = (size_t)U.b * SEQ + c * CH;
    const char* qb = (const char*)(U.Qg + tok0 * U.qpitch); const char* kb = (const char*)(U.Kg + tok0 * U.qpitch); const char* vb = (const char*)(U.Vg + tok0 * NPROJ);
#pragma unroll
    for (int i = 0; i < MixDma<MLSTM>::PPW; ++i) { const int pi = mx_piece<MLSTM>(wave, i);
        if (pi < MX_NPIECE) {
            const char* src; int dst;
            if (pi < 17) { src = qb; dst = MP::QS + par * IMG_BYTES + pi * 1024; }
            else if (pi < 34) { src = kb; dst = MP::KS + par * IMG_BYTES + (pi - 17) * 1024; }
            else { src = vb; dst = MP::V + par * 4096 + (pi - 34) * 1024; }
            __builtin_amdgcn_global_load_lds((const unsigned*)(src + dm.voff[i]), (LAS unsigned*)(lds + dst), 16, 0, 0);
        } }
    if (!MLSTM && wave == 7) {
        const float* gd = U.gdec + (size_t)(((U.b * NCH + c) * NH) + U.hh) * DK + (tid & 63);
        __builtin_amdgcn_global_load_lds((const unsigned*)gd, (LAS unsigned*)(lds + MP::GDEC + par * 512), 4, 0, 0);
        __builtin_amdgcn_global_load_lds((const unsigned*)(gd + 64), (LAS unsigned*)(lds + MP::GDEC + par * 512 + 256), 4, 0, 0);
    }
}
__device__ __forceinline__ void mx_store_tile(LAS unsigned char* outt, const f32x16& val, bf16* grow  , int lane, int r, int h5) {
#pragma unroll
    for (int i = 0; i < 16; ++i) *(LAS unsigned short*)(outt + ((i & 3) + 8 * (i >> 2) + 4 * h5) * 64 + r * 2) = f2bf1(val[i]);
#pragma unroll
    for (int i = 0; i < 2; ++i) { const int id = lane + 64 * i, row = id >> 2, pc = id & 3; const v4u w = *(const LAS v4u*)(outt + row * 64 + pc * 16); *(v4u*)(grow + (size_t)row * D + pc * 8) = w; }
}
__device__ __forceinline__ void mx_finalize_mlstm(LAS unsigned char* lds, const MixUnit& U, int cf, int fl) {
    typedef MxMap<true> MP;
    const int j = fl >> 2, sg = fl & 3; const float mc = ((const LAS float*)(lds + MP::TSC))[cf];
    const float dn = ((const LAS float*)(lds + MP::DEN))[j], bb = ((const LAS float*)(lds + MP::TB))[cf * 64 + j], pm = ((const LAS float*)(lds + MP::TPM))[cf * 64 + j];
    const float rden = QK_SCALE * __builtin_amdgcn_rcpf(fmaxf(fabsf(dn) * QK_SCALE, __expf(-bb - fmaxf(mc, pm))));
    const f32x4 n0 = *(const LAS f32x4*)((const LAS float*)(lds + MP::NUM) + j * NUM_PITCH + 8 * sg) * rden, n1 = *(const LAS f32x4*)((const LAS float*)(lds + MP::NUM) + j * NUM_PITCH + 8 * sg + 4) * rden;
    v4u w; w.x = pk_bf16(n0.x, n0.y); w.y = pk_bf16(n0.z, n0.w); w.z = pk_bf16(n1.x, n1.y); w.w = pk_bf16(n1.z, n1.w);
    *(v4u*)(U.Hg + (size_t)(U.b * SEQ + cf * CH + j) * D + 8 * sg) = w;
}

template <bool MLSTM>
__device__ __forceinline__ void mx_step(LAS unsigned char* lds, const MixDma<MLSTM>& dm, const MixUnit& U, int c, f32x16& accC0, f32x16& accC1, f32x16& accO, int tid, int lane, int wave, unsigned (&pt)[8]) {
    typedef MxMap<MLSTM> MP;
    unsigned long long tp = PROBE_T ? PT_NOW() : 0ull;
    const int r = lane & 31, h5 = lane >> 5, blk = (lane >> 4) & 1, q4 = (lane & 15) >> 2, p4 = lane & 3, par = c & 1;
    const LAS float* TSC = (const LAS float*)(lds + MP::TSC);
    LAS unsigned char* qimg0 = lds + MP::QS + par * IMG_BYTES; LAS unsigned char* kimg0 = lds + MP::KS + par * IMG_BYTES; LAS unsigned char* vimg0 = lds + MP::V + par * 4096;
    if (c + 1 < NCH) mx_dma_issue<MLSTM>(lds, dm, U, c + 1, wave, tid);
    PT_ACC(6, tp);
    const float mc = MLSTM ? TSC[c] : 0.f;
    if (wave < 4) {
        const int st = wave >> 1, jt = (wave == 1 || wave == 2) ? 1 : 0;
#pragma unroll
        for (int i = 0; i < 16; ++i) accO[i] = 0.f;
        if (MLSTM && wave == 3) {
#pragma unroll
            for (int i = 0; i < 4; ++i) { const int id = lane + 64 * i, row = id >> 2, pc = id & 3;
                const float wr_ = __expf(((const LAS float*)(lds + MP::TWP))[c * 64 + row] - TSC[32 + c]); const v4u pv = *(const LAS v4u*)(vimg0 + row * 64 + pc * 16); v4u o;
                o.x = pk_bf16(bflo(pv.x) * wr_, bfhi(pv.x) * wr_); o.y = pk_bf16(bflo(pv.y) * wr_, bfhi(pv.y) * wr_); o.z = pk_bf16(bflo(pv.z) * wr_, bfhi(pv.z) * wr_); o.w = pk_bf16(bflo(pv.w) * wr_, bfhi(pv.w) * wr_);
                *(LAS v4u*)(lds + MP::VW + row * 64 + pc * 16) = o;
                if (pc == 0) *(LAS unsigned short*)(lds + MP::VWAUX + row * 64) = f2bf1(wr_); }
        }
        if (wave != 3) {
            LAS unsigned char* kimg = kimg0 + (32 * st + r) * IMG_PITCH + 16 * h5;
            LAS unsigned char* qimg = qimg0 + (32 * jt + r) * IMG_PITCH + 16 * h5;
#pragma unroll
            for (int ks = 0; ks < 8; ++ks) { const bf16x8 a = *(const LAS bf16x8*)(kimg + 32 * ks), bq = *(const LAS bf16x8*)(qimg + 32 * ks); accO = MFMA32(a, bq, accO); }
        }
        const int j = 32 * jt + r;
        if (wave == 3) {
#pragma unroll
            for (int g4 = 0; g4 < 4; ++g4) *(LAS v2u*)(lds + MP::PS + j * PS_PITCH + (32 * st + 8 * g4 + 4 * h5) * 2) = (v2u){0u, 0u};
        } else {
            float uj = 0.f;
            if (MLSTM) uj = -fmaxf(mc, ((const LAS float*)(lds + MP::TPM))[c * 64 + j]);
#pragma unroll
            for (int g4 = 0; g4 < 4; ++g4) { const int s0 = 32 * st + 8 * g4 + 4 * h5; f32x4 wps = {0.f, 0.f, 0.f, 0.f}; if (MLSTM) wps = *(const LAS f32x4*)((const LAS float*)(lds + MP::TWP) + c * 64 + s0);
                float v[4];
#pragma unroll
                for (int e = 0; e < 4; ++e) { float x = accO[4 * g4 + e]; if (MLSTM) x *= __expf(uj + wps[e]); v[e] = (s0 + e <= j) ? x : 0.f; }
                v2u o; o.x = pk_bf16(v[0], v[1]); o.y = pk_bf16(v[2], v[3]); *(LAS v2u*)(lds + MP::PS + j * PS_PITCH + s0 * 2) = o; }
        }
    } else {
        const int g = (wave - 4) >> 1, jt = wave & 1;
        if (MLSTM) {
            if (c > 0) mx_finalize_mlstm(lds, U, c - 1, tid - 256);
        }
        if (MLSTM || g == 0) {
#pragma unroll
            for (int i = 0; i < 16; ++i) accO[i] = 0.f;
#pragma unroll
            for (int ks = 0; ks < 8; ++ks) { const bf16x8 a = *(const LAS bf16x8*)(qimg0 + (32 * jt + r) * IMG_PITCH + 16 * h5 + 32 * ks), bc = *(const LAS bf16x8*)(lds + MP::CT + g * CT_BYTES + r * CT_PITCH + 32 * ks + 16 * h5); accO = MFMA32(a, bc, accO); }
            if (MLSTM) {
#pragma unroll
                for (int g4 = 0; g4 < 4; ++g4) { const f32x4 pm = *(const LAS f32x4*)((const LAS float*)(lds + MP::TPM) + c * 64 + 32 * jt + 8 * g4 + 4 * h5);
#pragma unroll
                    for (int e = 0; e < 4; ++e) accO[4 * g4 + e] *= __expf(mc - fmaxf(mc, pm[e])); }
            }
        }
    }
    PT_ACC(2, tp);
    MX_BAR();
    PT_ACC(3, tp);
    if (wave < 4) {
        if (MLSTM) { const float decay = __expf(mc - TSC[32 + c]); accC0 = accC0 * decay; accC1 = accC1 * decay; }
        LAS unsigned char* kimg = kimg0 + (8 * h5 + q4) * IMG_PITCH + 64 * wave + 32 * blk + 8 * p4;
        LAS unsigned char* vimg = (MLSTM ? lds + MP::VW : vimg0) + (8 * h5 + q4) * 64 + 32 * blk + 8 * p4;
        LAS unsigned char* vaux = lds + MP::VWAUX + (8 * h5 + q4) * 64 + 32 * blk + 8 * p4;
        { v2u xk[8], xv[8], xa[8];
          tr_issue4<IMG_PITCH>(xk, LDSA(kimg)); tr_issue4<64>(xv, LDSA(vimg)); if (MLSTM) tr_issue4<64>(xa, LDSA(vaux));
          tr_wait8(xk); tr_pin8(xv); if (MLSTM) tr_pin8(xa);
          __builtin_amdgcn_sched_barrier(0);
#pragma unroll
          for (int ks = 0; ks < 4; ++ks) { const bf16x8 a = mk8(xk[2 * ks], xk[2 * ks + 1]);
              accC0 = MFMA32(a, mk8(xv[2 * ks], xv[2 * ks + 1]), accC0);
              if (MLSTM) accC1 = MFMA32(a, mk8(xa[2 * ks], xa[2 * ks + 1]), accC1); } }
        if (!MLSTM) {
#pragma unroll
            for (int g4 = 0; g4 < 4; ++g4) { const f32x4 dc = *(const LAS f32x4*)((const LAS float*)(lds + MP::GDEC) + par * 128 + 32 * wave + 8 * g4 + 4 * h5);
#pragma unroll
                for (int e = 0; e < 4; ++e) accC0[4 * g4 + e] *= dc[e]; }
        }
#pragma unroll
        for (int g4 = 0; g4 < 4; ++g4) { const int d0 = 32 * wave + 8 * g4 + 4 * h5;
            v2u o; o.x = pk_bf16(accC0[4 * g4], accC0[4 * g4 + 1]); o.y = pk_bf16(accC0[4 * g4 + 2], accC0[4 * g4 + 3]); *(LAS v2u*)(lds + MP::CT + r * CT_PITCH + d0 * 2) = o;
            if (MLSTM) { v2u o1; o1.x = pk_bf16(accC1[4 * g4], accC1[4 * g4 + 1]); o1.y = pk_bf16(accC1[4 * g4 + 2], accC1[4 * g4 + 3]); *(LAS v2u*)(lds + MP::CT + CT_BYTES + r * CT_PITCH + d0 * 2) = o1; } }
    } else {
        const int g = (wave - 4) >> 1, jt = wave & 1;
        if (MLSTM || g == 0) {
            const bf16x8 ones = (r == 0) ? (bf16x8){0x3F80, 0x3F80, 0x3F80, 0x3F80, 0x3F80, 0x3F80, 0x3F80, 0x3F80} : (bf16x8){0, 0, 0, 0, 0, 0, 0, 0};
            LAS unsigned char* vimg = vimg0 + (8 * h5 + q4) * 64 + 32 * blk + 8 * p4;
            bf16x8 pa[4];
#pragma unroll
            for (int ks = 0; ks < 4; ++ks) pa[ks] = *(const LAS bf16x8*)(lds + MP::PS + (32 * jt + r) * PS_PITCH + 32 * ks + 16 * h5);
            if (g == 0) { v2u xv[8]; tr_issue4<64>(xv, LDSA(vimg)); tr_wait8(xv); __builtin_amdgcn_sched_barrier(0);
#pragma unroll
                for (int ks = 0; ks < 4; ++ks) accO = MFMA32(pa[ks], mk8(xv[2 * ks], xv[2 * ks + 1]), accO);
            } else {
#pragma unroll
                for (int ks = 0; ks < 4; ++ks) accO = MFMA32(pa[ks], ones, accO); }
            if (MLSTM && g == 0) {
#pragma unroll
                for (int i = 0; i < 16; ++i) ((LAS float*)(lds + MP::NUM))[(32 * jt + (i & 3) + 8 * (i >> 2) + 4 * h5) * NUM_PITCH + r] = accO[i];
            }
            if (MLSTM && g == 1 && r == 0) {
#pragma unroll
                for (int i = 0; i < 16; ++i) ((LAS float*)(lds + MP::DEN))[32 * jt + (i & 3) + 8 * (i >> 2) + 4 * h5] = accO[i];
            }
            if (!MLSTM) mx_store_tile(lds + MP::OUTT + jt * 2048, accO, U.Hg + (size_t)(U.b * SEQ + c * CH + 32 * jt) * D, lane, r, h5);
        }
    }
    PT_ACC(4, tp);
    MX_BAR_VM();
    PT_ACC(5, tp);
}

template <bool MLSTM>
__device__ __forceinline__ void mixer_phase(LAS unsigned char* lds, int tid, int lane, int wave, int vcu, int G, const MixArgs A) {
    typedef MxMap<MLSTM> MP;
    MixDma<MLSTM> dm; mx_dma_setup<MLSTM>(dm, wave, lane, A.qpitch);
    unsigned pt[8] = {0u, 0u, 0u, 0u, 0u, 0u, 0u, 0u}; unsigned long long tph = PROBE_T ? PT_NOW() : 0ull; unsigned long long tin = tph;
    for (int unit = vcu; unit < BATCH * NH * 8; unit += G) {
        const int slice = unit & 7, bh = unit >> 3;
        MixUnit U; U.b = bh >> 2; U.hh = bh & 3; U.qpitch = A.qpitch; U.gdec = A.gdec;
        U.Qg = A.q + U.hh * DK; U.Kg = A.k + U.hh * DK; U.Vg = A.proj + 1024 + U.hh * DV + 32 * slice; U.Hg = A.hun + U.hh * DV + 32 * slice;
        MX_BAR_VM();
        mx_dma_issue<MLSTM>(lds, dm, U, 0, wave, tid);
        for (int i = tid; i < 2 * CT_BYTES / 4; i += NTHREADS) ((LAS unsigned*)(lds + MP::CT))[i] = 0u;
        if (MLSTM) {
            for (int i = tid; i < 1024; i += NTHREADS) ((LAS unsigned*)(lds + MP::VWAUX))[i] = 0u;
            LAS float* TB = (LAS float*)(lds + MP::TB); LAS float* TWP = (LAS float*)(lds + MP::TWP); LAS float* TPM = (LAS float*)(lds + MP::TPM); LAS float* TSC = (LAS float*)(lds + MP::TSC);
            const float bgi = A.bgate[U.hh], bgf = A.bgate[4 + U.hh];
            float gi4[4], gf4[4];
#pragma unroll
            for (int cc = 0; cc < 4; ++cc) { const size_t tok = (size_t)U.b * SEQ + (wave + 8 * cc) * CH + lane; gi4[cc] = A.gates[tok * 16 + U.hh] + bgi; gf4[cc] = A.gates[tok * 16 + 4 + U.hh] + bgf; }
#pragma unroll
            for (int cc = 0; cc < 4; ++cc) { const int c = wave + 8 * cc;
                const float lf = fminf(gf4[cc], 0.f) - __logf(1.0f + __expf(-fabsf(gf4[cc])));
                float bsum = lf;
#pragma unroll
                for (int o = 1; o < 64; o <<= 1) { const float t = __shfl_up(bsum, o); if (lane >= o) bsum += t; }
                const float wp = gi4[cc] - bsum; float pm = wp;
#pragma unroll
                for (int o = 1; o < 64; o <<= 1) { const float t = __shfl_up(pm, o); if (lane >= o) pm = fmaxf(pm, t); }
                TB[c * 64 + lane] = bsum; TWP[c * 64 + lane] = wp; TPM[c * 64 + lane] = pm;
                if (lane == 63) { TSC[64 + c] = bsum; TSC[96 + c] = pm; } }
            MX_BAR();
            if (wave == 0) {
                const float gl = TSC[64 + (lane & 31)], pl = TSC[96 + (lane & 31)]; float m = 0.f, myM = 0.f, myX = 0.f;
#pragma clang loop unroll(disable)
                for (int c = 0; c < NCH; ++c) { const float gc = __uint_as_float(__builtin_amdgcn_readlane(__float_as_uint(gl), c)), pc = __uint_as_float(__builtin_amdgcn_readlane(__float_as_uint(pl), c));
                    const float mxe = fmaxf(m, pc); if (lane == c) { myM = m; myX = mxe; } m = gc + mxe; }
                if (lane < 32) { TSC[lane] = myM; TSC[32 + lane] = myX; }
            }
        }
        f32x16 accC0, accC1, accO;
#pragma unroll
        for (int i = 0; i < 16; ++i) { accC0[i] = 0.f; accC1[i] = 0.f; accO[i] = 0.f; }
        MX_BAR_VM();
        PT_ACC(1, tin);
#pragma clang loop unroll(disable)
        for (int c = 0; c < NCH; ++c) mx_step<MLSTM>(lds, dm, U, c, accC0, accC1, accO, tid, lane, wave, pt);
        if (MLSTM && wave >= 4) mx_finalize_mlstm(lds, U, NCH - 1, tid - 256);
    }
    MX_BAR_VM();
    if (PROBE_T && (PROBE_T_MLSTM != 0) == MLSTM && vcu == 0 && wave == PROBE_T_WAVE && lane == 0) { PT_ACC(0, tph); unsigned* pw = (unsigned*)A.probe; pw[0] = pt[PROBE_T_A]; pw[1] = pt[PROBE_T_B]; }
}

constexpr int N_PHASES = 15, RT_OFF = RING_BYTES;
template <int PH>
__device__ __forceinline__ void run_phase(const Args& args, LAS unsigned char* lds, int tid, int lane, int wave, int vcu, int G, int bx) {
    unsigned char* ws = args.ws;
    constexpr int layer = (PH >= 8) ? 1 : 0, k = (PH == 0) ? -1 : PH - 1 - 7 * layer;
    unsigned char* wl = ws + (size_t)layer * WS_WLAYER;
    bf16* AOP = (bf16*)(ws + WS_AOP); bf16* PROJ = (bf16*)(ws + WS_PROJ); bf16* HMID = (bf16*)(ws + WS_HMID); bf16* XRES = (bf16*)(ws + WS_XRES);
    float* GATES = (float*)(ws + WS_GATES); float* SUMSQ = (float*)(ws + WS_SUMSQ);
    LAS float* RT = (LAS float*)(lds + RT_OFF);
    if constexpr (k == -1) {
        PP_STAMP(30); convert_weights(lds, lane, wave, vcu, G, args, ws); PP_STAMP(31);
        rows_first(lds, tid, lane, wave, vcu, G, args.in[0], args.in[1], XRES, SUMSQ, args.in[4] + NPROJ, MLSTM_IN, 8, GATES);
    } else if constexpr (k == 0) {
        pg8::Gemm g{XRES, (const bf16*)(wl + WS_WIN), M, NPROJ, D}; pg8::StaticOrder S; S.init(M, NPROJ, G, bx);
        const RstdSlots rs = rstd_table(RT, SUMSQ, S, tid);
        pg8::EpiBf16S<0> E{PROJ, NPROJ, (const LAS float*)RT, rs.pm1, rs.pm2, rs.pm3};
        pg8::gemm_phase<pg8::EpiBf16S<0>, pg8::StaticOrder, true, true>(lds, g, S, E);
    } else if constexpr (k == 1) {
        if (layer) gla_prep(lds, tid, lane, wave, vcu, G, PROJ, XRES, SUMSQ, args.in[8], args.in[1] + D, args.in[9], args.in[10], (bf16*)(ws + WS_QT), (bf16*)(ws + WS_KT), (float*)(ws + WS_GDEC));
    } else if constexpr (k == 2) {
        if (layer == 0) { const MixArgs A{PROJ, PROJ + QKW, PROJ, NPROJ, GATES, args.in[5], nullptr, AOP, ws + WS_CTL + 4 * CW_PROBE}; mixer_phase<true>(lds, tid, lane, wave, vcu, G, A); }
        else { const MixArgs A{(const bf16*)(ws + WS_QT), (const bf16*)(ws + WS_KT), PROJ, QKW, nullptr, nullptr, (const float*)(ws + WS_GDEC), AOP, ws + WS_CTL + 4 * CW_PROBE}; mixer_phase<false>(lds, tid, lane, wave, vcu, G, A); }
    } else if constexpr (k == 3) {
        head_norm_rows(lane, wave, vcu, G, AOP, args.in[layer ? 11 : 6], PROJ, AOP, layer != 0);
    } else if constexpr (k == 4) {
        pg8::Gemm g{AOP, (const bf16*)(wl + WS_WOUT), M, D, D}; pg8::StaticOrder S; S.init(M, D, G, bx);
        pg8::EpiResBf16Sq E{XRES, SUMSQ, D};
        pg8::gemm_phase<pg8::EpiResBf16Sq, pg8::StaticOrder, false, true>(lds, g, S, E);
    } else if constexpr (k == 5) {
        pg8::Gemm g{XRES, (const bf16*)(wl + WS_W1), M, FF, D}; pg8::StaticOrder S; S.init(M, FF, G, bx);
        const RstdSlots rs = rstd_table(RT, SUMSQ, S, tid);
        pg8::EpiBf16S<2> E{HMID, FF, (const LAS float*)RT, rs.pm1, rs.pm2, rs.pm3};
        pg8::gemm_phase<pg8::EpiBf16S<2>, pg8::StaticOrder, true, true>(lds, g, S, E);
    } else if constexpr (k == 6 && layer == 0) {
        pg8::Gemm g{HMID, (const bf16*)(wl + WS_W2), M, D, FF}; pg8::StaticOrder S; S.init(M, D, G, bx);
        pg8::EpiResBf16Sq E{XRES, SUMSQ, D};
        pg8::gemm_phase<pg8::EpiResBf16Sq, pg8::StaticOrder, false, true>(lds, g, S, E);
    } else if constexpr (k == 6) {
        pg8::Gemm g{HMID, (const bf16*)(wl + WS_W2), M, D, FF}; pg8::StaticOrder S; S.init(M, D, G, bx);
        pg8::EpiFinalNorm E{XRES, args.out, SUMSQ, (unsigned*)(ws + WS_CTL) + CW_FIN, args.in[3], D, EPS};
        pg8::gemm_phase<pg8::EpiFinalNorm, pg8::StaticOrder, false, true>(lds, g, S, E);
    }
}
__device__ __forceinline__ void group_sync(unsigned* cnt, unsigned target) {
    asm volatile("s_waitcnt vmcnt(0)" ::: "memory");
    __syncthreads();
    if (threadIdx.x == 0) {
        xb_add(cnt, 1u);
        unsigned sp = 0; while (xb_ld(cnt) < target && ++sp < (1u << 22)) __builtin_amdgcn_s_sleep(1);
        __builtin_amdgcn_fence(__ATOMIC_ACQUIRE, "agent");
        asm volatile("s_waitcnt vmcnt(0)" ::: "memory");
    }
    __syncthreads();
}
__global__ void __launch_bounds__(NTHREADS, 2) fwd_kernel(Args args) {
    extern __shared__ __attribute__((aligned(16))) unsigned char lds_raw[];
    LAS unsigned char* lds = (LAS unsigned char*)lds_raw;
    volatile LAS unsigned* MISC = (volatile LAS unsigned*)(lds + MISC_OFF);
    const int tid = threadIdx.x, lane = tid & 63, wave = __builtin_amdgcn_readfirstlane(tid >> 6);
    const int G = gridDim.x; int bx = blockIdx.x; int vcu = (G % 8 == 0) ? (bx % 8) * (G / 8) + bx / 8 : bx;
    for (int u = tid; u < (LDS_BYTES - LDSCTL_OFF) / 4; u += NTHREADS) ((LAS unsigned*)(lds + LDSCTL_OFF))[u] = 0u;
    __syncthreads();
    const int lo = args.ph_lo, hi = args.ph_hi;
    XcdBarrier bar; bar.bar = (unsigned*)(args.ws + WS_CTL) + CW_BAR; bar.x = 0; bar.st = nullptr;
    if (hi - lo > 1) { bar = xcd_barrier_post((unsigned*)(args.ws + WS_CTL) + CW_BAR, MISC + 8);
        if (tid == 0) { const unsigned xcc = xb_xcc_id(); MISC[16] = xcc; MISC[17] = xb_add((unsigned*)(args.ws + WS_CTL) + CW_XID + 64 * xcc, 1u); } }
#ifndef PROBE_PH
#define PROBE_PH (-1)
#endif
#ifndef PROBE_N
#define PROBE_N 0
#endif
#define PHASE(p) if (lo <= (p) && (p) < hi) { PP_STAMP(2 * (p)); run_phase<p>(args, lds, tid, lane, wave, vcu, G, bx); PP_STAMP(2 * (p) + 1); \
        if ((p) == PROBE_PH) { for (int rep_ = 0; rep_ < PROBE_N; ++rep_) { xcd_barrier(bar); if (PROBE_PH >= 0) run_phase<((p) == PROBE_PH ? (p) : 2)>(args, lds, tid, lane, wave, vcu, G, bx); } } \
        if ((p) + 1 < hi && (p) != 2) { if (grp_ok && ((p) == 5 || (p) == 6 || (p) == 12 || (p) == 13)) { group_sync(grp_cnt, 4u * (++grp_epoch)); } else xcd_barrier(bar); } }
    bool grp_ok = false; unsigned grp_epoch = 0; unsigned* grp_cnt = (unsigned*)(args.ws + WS_CTL) + CW_GRP;
    PHASE(0)
    if (lo == 0 && hi > 1) {
        bool ok = (G == 256);
#pragma unroll
        for (unsigned j = 0; j < 16; ++j) { const unsigned cnt = xb_ld(&bar.bar[XB_XCNT(j)]); ok = ok && (cnt == (j < 8 ? 32u : 0u)); }
        const unsigned xcc = MISC[16], idx = MISC[17];
        if (ok && xcc < 8 && idx < 32) { vcu = (int)(xcc * 32 + idx); bx = (int)(idx * 8 + xcc);
            pg8::StaticOrder So, Su; pg8::Unit uo, uu; So.init(M, D, G, bx); Su.init(M, FF, G, bx); So.next(0, uo); Su.next(0, uu);
            grp_ok = ok && (uo.pm == uu.pm); grp_cnt += 16 * uo.pm; }
    }
    PHASE(1) PHASE(2) PHASE(3) PHASE(4) PHASE(5) PHASE(6) PHASE(7) PHASE(8) PHASE(9) PHASE(10) PHASE(11) PHASE(12) PHASE(13) PHASE(14)
#undef PHASE
    if (PROBE_P && hi == N_PHASES && blockIdx.x == 0 && tid == 0) {
        const volatile LAS unsigned* w = (const volatile LAS unsigned*)(lds + LDSCTL_OFF + 512);
        const unsigned va = w[2 * PROBE_P_A + 1] - w[2 * PROBE_P_A];
        const unsigned vb = w[2 * PROBE_P_B + 1] - w[2 * PROBE_P_B];
        const unsigned long long ticks = (unsigned long long)(va / 100u) * 1000ull + (unsigned long long)(vb / 100u) * 100000ull;
        const unsigned long long t0 = PT_NOW(); while (PT_NOW() - t0 < ticks) __builtin_amdgcn_s_sleep(8);
    }
    if (PROBE_T && hi == N_PHASES && vcu == 0 && tid == 0) {
        const unsigned a = xb_ld((unsigned*)(args.ws + WS_CTL) + CW_PROBE), b = xb_ld((unsigned*)(args.ws + WS_CTL) + CW_PROBE + 1);
        const unsigned long long ticks = (unsigned long long)a * 5ull + (unsigned long long)(b / 50u) * 50000ull;
        const unsigned long long t0 = PT_NOW(); while (PT_NOW() - t0 < ticks) __builtin_amdgcn_s_sleep(8);
    }
}

extern "C" void kernel_launch(void* const* d_in, const int* in_sizes, int n_in, void* d_out, int out_size, void* d_ws, size_t ws_size, hipStream_t stream) {
    static int grid = 0;
    if (grid == 0) {
        if (n_in != 15 || in_sizes[0] != M * D || out_size != M * D || ws_size < WS_END) { fprintf(stderr, "kernel_launch: unexpected shapes (n_in %d, in0 %d, out %d, ws %zu); nothing launched\n", n_in, n_in > 0 ? in_sizes[0] : -1, out_size, ws_size); grid = -1; return; }
        int dev = 0, cus = 0, per_cu = 0;
        if (hipGetDevice(&dev) != hipSuccess || hipDeviceGetAttribute(&cus, hipDeviceAttributeMultiprocessorCount, dev) != hipSuccess) { grid = -1; return; }
        if (hipFuncSetAttribute((const void*)fwd_kernel, hipFuncAttributeMaxDynamicSharedMemorySize, LDS_BYTES) != hipSuccess) { fprintf(stderr, "kernel_launch: hipFuncSetAttribute failed\n"); grid = -1; return; }
        if (hipOccupancyMaxActiveBlocksPerMultiprocessor(&per_cu, (const void*)fwd_kernel, NTHREADS, LDS_BYTES) != hipSuccess || per_cu < 1) { fprintf(stderr, "kernel_launch: occupancy query says %d blocks per CU\n", per_cu); (void)hipGetLastError(); grid = -1; return; }
        grid = cus;
    }
    if (grid < 0) return;
    (void)hipMemsetAsync((char*)d_ws + WS_CTL, 0, CTL_ZERO_BYTES, stream);
    Args a{};
    for (int i = 0; i < 15; ++i) a.in[i] = (const float*)d_in[i];
    a.out = (float*)d_out; a.ws = (unsigned char*)d_ws;
    if (MK_N_LAUNCHES == 1) {
        a.ph_lo = 0; a.ph_hi = N_PHASES;
        void* kargs[] = {&a};
        const hipError_t e = hipLaunchCooperativeKernel((const void*)fwd_kernel, dim3(grid), dim3(NTHREADS), kargs, LDS_BYTES, stream);
        if (e != hipSuccess) fprintf(stderr, "kernel_launch: cooperative launch failed: %s (grid %d)\n", hipGetErrorString(e), grid);
    } else {
        for (int p = 0; p < N_PHASES; ++p) { a.ph_lo = p; a.ph_hi = p + 1; hipLaunchKernelGGL(fwd_kernel, dim3(grid), dim3(NTHREADS), LDS_BYTES, stream, a); }
    }
}
```

```cpp
#include <hip/hip_runtime.h>
#include <cstdio>
#include <cstdint>
namespace pg8 {
#define PG8_LAS __attribute__((address_space(3)))
typedef unsigned short bf16_t;
typedef short bf16x8 __attribute__((ext_vector_type(8)));
typedef float f32x4 __attribute__((ext_vector_type(4)));
typedef unsigned u32x4 __attribute__((ext_vector_type(4)));
constexpr int BM = 256, BK = 64, HALF = 128, HTB = HALF * BK * 2  , STAGE_BYTES = 8 * HTB, NXCD = 8, WGM = 8;

__host__ __device__ __forceinline__ int lds_byte(int r, int c) { const int st = (r >> 4) * 2 + (c >> 5), rr = r & 15, cc = c & 31, ob = rr * 64 + cc * 2; return st * 1024 + (ob ^ (((ob >> 9) & 1) << 5)); }
__host__ __device__ __forceinline__ void stage_rc(int b, int& R, int& C) { const int st = b / 1024, sb = b % 1024, swz = sb ^ (((sb >> 9) & 1) << 5); R = (st >> 1) * 16 + swz / 64; C = (st & 1) * 32 + (swz % 64) / 2; }
__host__ __device__ __forceinline__ int perm32(int rho) { const int n = rho >> 4, i = rho & 15; return 8 * (i >> 2) + 4 * n + (i & 3); }

struct Unit { int pm, pn; };
struct Gemm { const bf16_t* A; const bf16_t* Bt; int M, N, K; };

struct StaticOrder {
    int nM, nN, nwg, G, c;
    __host__ __device__ __forceinline__ void init(int M, int N, int G_, int c_) { nM = M / BM; nN = N / BM; nwg = nM * nN; G = G_; c = c_; }
    __host__ __device__ __forceinline__ bool next(int i, Unit& u) const {
        const long L = (long)i * G + c; if (L >= nwg) return false;
        int wgid = (int)L; { const int q = nwg / NXCD, r = nwg % NXCD, xcd = wgid % NXCD, off = wgid / NXCD; wgid = (xcd < r ? xcd * (q + 1) : r * (q + 1) + (xcd - r) * q) + off; }
        const int nig = WGM * nN, gid = wgid / nig, fm = gid * WGM, gsz = (nM - fm) < WGM ? (nM - fm) : WGM;
        u.pm = fm + ((wgid % nig) % gsz); u.pn = (wgid % nig) / gsz; return true;
    }
    __device__ __forceinline__ void a_ready(const Unit&) const {}
    __device__ __forceinline__ void done(const Unit&) const {}
};

__device__ __forceinline__ unsigned cvt_pk_bf16(float lo, float hi) { unsigned r; asm volatile("v_cvt_pk_bf16_f32 %0, %1, %2" : "=v"(r) : "v"(lo), "v"(hi)); return r; }
typedef float f32x2 __attribute__((ext_vector_type(2)));
typedef __bf16 bf16x2_t __attribute__((ext_vector_type(2)));
__device__ __forceinline__ unsigned pk_bf16(float lo, float hi) { f32x2 v = {lo, hi}; bf16x2_t r = __builtin_convertvector(v, bf16x2_t); return __builtin_bit_cast(unsigned, r); }
template <int ACT  > struct EpiBf16 {
    static constexpr bool PERM = true, AFTER_DRAIN = false;
    bf16_t* O; int ldc;
    __device__ __forceinline__ void operator()(const f32x4 (&acc)[2][2][4][2], const Unit& u, int wr, int wc, int fr, int fq) const {
        const int row0 = u.pm * BM + wr * 64 + fr, col0 = u.pn * BM + wc * 32 + 8 * fq;
#pragma unroll
        for (int ai = 0; ai < 2; ++ai)
#pragma unroll
            for (int m = 0; m < 4; ++m) { bf16_t* rowp = O + (size_t)(row0 + ai * HALF + m * 16) * ldc + col0;
#pragma unroll
                for (int bj = 0; bj < 2; ++bj) { f32x4 v0 = acc[ai][bj][m][0], v1 = acc[ai][bj][m][1];
                    if (ACT == 2) { const f32x4 z = {0.f, 0.f, 0.f, 0.f}; v0 = __builtin_elementwise_max(v0, z); v1 = __builtin_elementwise_max(v1, z); v0 = v0 * v0; v1 = v1 * v1; }
                    u32x4 w; w.x = pk_bf16(v0[0], v0[1]); w.y = pk_bf16(v0[2], v0[3]); w.z = pk_bf16(v1[0], v1[1]); w.w = pk_bf16(v1[2], v1[3]);
                    *(u32x4*)(rowp + bj * HALF) = w; } }
    }
};
struct EpiResF32 {
    static constexpr bool PERM = false, AFTER_DRAIN = true;
    const float* base; float* out; int ldc;
    __device__ __forceinline__ void fused(const f32x4 (&acc)[2][2][4][2], const Unit& u, int wr, int wc, int fr, int fq, PG8_LAS unsigned char*, int, int) const {
        const int col0 = u.pn * BM + wc * 32 + 4 * fq;
#pragma unroll
        for (int ai = 0; ai < 2; ++ai)
#pragma unroll
            for (int m = 0; m < 4; ++m) { const int r = ai * HALF + wr * 64 + m * 16 + fr; const size_t off = (size_t)(u.pm * BM + r) * ldc + col0;
#pragma unroll
                for (int bj = 0; bj < 2; ++bj) { const f32x4 b0 = *(const f32x4*)(base + off + bj * HALF), b1 = *(const f32x4*)(base + off + bj * HALF + 16);
                    *(f32x4*)(out + off + bj * HALF) = b0 + acc[ai][bj][m][0]; *(f32x4*)(out + off + bj * HALF + 16) = b1 + acc[ai][bj][m][1];
                    asm volatile("" ::: "memory"); } }
    }
};
typedef unsigned u32x2 __attribute__((ext_vector_type(2)));
__device__ __forceinline__ float bf_lo(unsigned w) { return __builtin_bit_cast(float, w << 16); }
__device__ __forceinline__ float bf_hi(unsigned w) { return __builtin_bit_cast(float, w & 0xffff0000u); }
template <int ACT  > struct EpiBf16S {
    static constexpr bool PERM = true, AFTER_DRAIN = false;
    bf16_t* O; int ldc; const PG8_LAS float* rt; int pm1, pm2, pm3; size_t bstride;
    __device__ __forceinline__ void operator()(const f32x4 (&acc)[2][2][4][2], const Unit& u, int wr, int wc, int fr, int fq) const {
        const int col0 = u.pn * BM + wc * 32 + 8 * fq;
        const PG8_LAS float* rtp = rt + ((u.pm == pm1) ? 256 : (u.pm == pm2) ? 512 : (u.pm == pm3) ? 768 : 0) + wr * 64 + fr;
#pragma unroll
        for (int ai = 0; ai < 2; ++ai)
#pragma unroll
            for (int m = 0; m < 4; ++m) { const float rs = rtp[ai * HALF + m * 16];
                bf16_t* rowp = O + (size_t)(u.pm >> 3) * bstride + (size_t)((u.pm & 7) * BM + ai * HALF + wr * 64 + m * 16 + fr) * ldc + col0;
#pragma unroll
                for (int bj = 0; bj < 2; ++bj) { f32x4 v0 = acc[ai][bj][m][0] * rs, v1 = acc[ai][bj][m][1] * rs;
                    if (ACT == 2) { const f32x4 z = {0.f, 0.f, 0.f, 0.f}; v0 = __builtin_elementwise_max(v0, z); v1 = __builtin_elementwise_max(v1, z); v0 = v0 * v0; v1 = v1 * v1; }
                    u32x4 w; w.x = pk_bf16(v0[0], v0[1]); w.y = pk_bf16(v0[2], v0[3]); w.z = pk_bf16(v1[0], v1[1]); w.w = pk_bf16(v1[2], v1[3]);
                    *(u32x4*)(rowp + bj * HALF) = w; } }
    }
};
struct EpiResBf16Sq {
    static constexpr bool PERM = false, AFTER_DRAIN = true;
    bf16_t* xres; float* sumsq; int ldc;
    __device__ __forceinline__ void fused(f32x4 (&acc)[2][2][4][2], const Unit& u, int wr, int wc, int fr, int fq, PG8_LAS unsigned char* lds, int wid, int lane) const {
        PG8_LAS float* P = (PG8_LAS float*)lds;
        const int col0 = u.pn * BM + wc * 32 + 4 * fq;
#pragma unroll
        for (int ai = 0; ai < 2; ++ai)
#pragma unroll
            for (int m = 0; m < 4; ++m) { const int r = ai * HALF + wr * 64 + m * 16 + fr; bf16_t* xp = xres + (size_t)(u.pm * BM + r) * ldc + col0; float ss = 0.f;
#pragma unroll
                for (int bj = 0; bj < 2; ++bj)
#pragma unroll
                    for (int n = 0; n < 2; ++n) { const u32x2 xb = *(const u32x2*)(xp + bj * HALF + n * 16); const f32x4 a = acc[ai][bj][m][n];
                        u32x2 w; w.x = pk_bf16(bf_lo(xb.x) + a[0], bf_hi(xb.x) + a[1]); w.y = pk_bf16(bf_lo(xb.y) + a[2], bf_hi(xb.y) + a[3]);
                        *(u32x2*)(xp + bj * HALF + n * 16) = w;
                        const float y0 = bf_lo(w.x), y1 = bf_hi(w.x), y2 = bf_lo(w.y), y3 = bf_hi(w.y); ss += (y0 * y0 + y1 * y1) + (y2 * y2 + y3 * y3); }
                ss += __shfl_xor(ss, 16); ss += __shfl_xor(ss, 32);
                if (fq == 0) P[r * 4 + wc] = ss;
                asm volatile("" ::: "memory"); }
        asm volatile("s_waitcnt lgkmcnt(0)" ::: "memory"); __builtin_amdgcn_s_barrier(); asm volatile("" ::: "memory");
        const int t = wid * 64 + lane;
        if (t < 256) { const f32x4 p = *(const PG8_LAS f32x4*)(P + t * 4); sumsq[(size_t)(u.pm * BM + t) * 4 + u.pn] = (p[0] + p[1]) + (p[2] + p[3]); }
    }
};
struct EpiFinalNorm {
    static constexpr bool PERM = false, AFTER_DRAIN = true;
    const bf16_t* xres; float* out; float* sumsq; unsigned* cnt; const float* gain; int ldc; float eps;
    __device__ __forceinline__ void fused(f32x4 (&acc)[2][2][4][2], const Unit& u, int wr, int wc, int fr, int fq, PG8_LAS unsigned char* lds, int wid, int lane) const {
        PG8_LAS float* P = (PG8_LAS float*)lds;
        PG8_LAS float* S = (PG8_LAS float*)(lds + 4096);
        const int col0 = u.pn * BM + wc * 32 + 4 * fq, t = wid * 64 + lane;
#pragma unroll
        for (int ai = 0; ai < 2; ++ai)
#pragma unroll
            for (int m = 0; m < 4; ++m) { const int r = ai * HALF + wr * 64 + m * 16 + fr; const bf16_t* xp = xres + (size_t)(u.pm * BM + r) * ldc + col0; float ss = 0.f;
#pragma unroll
                for (int bj = 0; bj < 2; ++bj)
#pragma unroll
                    for (int n = 0; n < 2; ++n) { const u32x2 xb = *(const u32x2*)(xp + bj * HALF + n * 16); f32x4 y = acc[ai][bj][m][n];
                        y[0] += bf_lo(xb.x); y[1] += bf_hi(xb.x); y[2] += bf_lo(xb.y); y[3] += bf_hi(xb.y); acc[ai][bj][m][n] = y; ss += (y[0] * y[0] + y[1] * y[1]) + (y[2] * y[2] + y[3] * y[3]); }
                ss += __shfl_xor(ss, 16); ss += __shfl_xor(ss, 32);
                if (fq == 0) P[r * 4 + wc] = ss;
                asm volatile("" ::: "memory"); }
        asm volatile("s_waitcnt lgkmcnt(0)" ::: "memory"); __builtin_amdgcn_s_barrier(); asm volatile("" ::: "memory");
        if (t < 256) { const f32x4 p = *(const PG8_LAS f32x4*)(P + t * 4); __hip_atomic_store(sumsq + (size_t)(u.pm * BM + t) * 4 + u.pn, (p[0] + p[1]) + (p[2] + p[3]), __ATOMIC_RELAXED, __HIP_MEMORY_SCOPE_AGENT); }
        asm volatile("s_waitcnt vmcnt(0)" ::: "memory"); __builtin_amdgcn_s_barrier(); asm volatile("" ::: "memory");
        if (t == 0) {
            __hip_atomic_fetch_add(cnt + 16 * u.pm, 1u, __ATOMIC_RELAXED, __HIP_MEMORY_SCOPE_AGENT);
            unsigned sp = 0;
            while (__hip_atomic_load(cnt + 16 * u.pm, __ATOMIC_RELAXED, __HIP_MEMORY_SCOPE_AGENT) < 4u && ++sp < (1u << 22)) __builtin_amdgcn_s_sleep(2);
            __builtin_amdgcn_fence(__ATOMIC_ACQUIRE, "agent");
        }
        asm volatile("s_waitcnt vmcnt(0) lgkmcnt(0)" ::: "memory"); __builtin_amdgcn_s_barrier(); asm volatile("" ::: "memory");
        if (t < 256) { float s4 = 0.f;
#pragma unroll
            for (int q = 0; q < 4; ++q) s4 += __hip_atomic_load(sumsq + (size_t)(u.pm * BM + t) * 4 + q, __ATOMIC_RELAXED, __HIP_MEMORY_SCOPE_AGENT);
            S[t] = 1.0f / sqrtf(s4 / (float)ldc + eps); }
        asm volatile("s_waitcnt lgkmcnt(0)" ::: "memory"); __builtin_amdgcn_s_barrier(); asm volatile("" ::: "memory");
        f32x4 gv[2][2];
#pragma unroll
        for (int bj = 0; bj < 2; ++bj)
#pragma unroll
            for (int n = 0; n < 2; ++n) gv[bj][n] = *(const f32x4*)(gain + col0 + bj * HALF + n * 16);
#pragma unroll
        for (int ai = 0; ai < 2; ++ai)
#pragma unroll
            for (int m = 0; m < 4; ++m) { const int r = ai * HALF + wr * 64 + m * 16 + fr; const float rs = S[r]; float* op = out + (size_t)(u.pm * BM + r) * ldc + col0;
#pragma unroll
                for (int bj = 0; bj < 2; ++bj)
#pragma unroll
                    for (int n = 0; n < 2; ++n) *(f32x4*)(op + bj * HALF + n * 16) = acc[ai][bj][m][n] * rs * gv[bj][n]; }
    }
};
template <class Epi, class Sched, bool ALIGN_EPI = false, bool SP2 = false>
__device__ __forceinline__ void gemm_phase(PG8_LAS unsigned char* lds, const Gemm g, const Sched& S, const Epi& E) {
    const int tid = threadIdx.x, wid = __builtin_amdgcn_readfirstlane(tid >> 6), lane = tid & 63, wr = wid >> 2, wc = wid & 3, fr = lane & 15, fq = lane >> 4;
    const int K = g.K, nt = K / BK;
    unsigned voffA[2], voffB[2];
#pragma unroll
    for (int i = 0; i < 2; ++i) { int R, C; stage_rc(tid * 16 + i * 8192, R, C); const int Rb = Epi::PERM ? ((R & ~31) + perm32(R & 31)) : R;
        voffA[i] = (unsigned)(R * K + C) * 2u; voffB[i] = (unsigned)(Rb * K + C) * 2u; }
    const size_t kstep = (size_t)(BK * 2);
    const size_t hstep = (size_t)HALF * K * 2;
    const size_t tstep = 2 * hstep;
    const unsigned ldsw = (unsigned)wid * 1024u;
    const int aoff = lds_byte(wr * 64 + fr, fq * 8), boff = lds_byte(wc * 32 + fr, fq * 8);
#define PG8_SA(b, h) (((b) * 2 + (h)) * HTB)
#define PG8_SB(b, h) ((4 + (b) * 2 + (h)) * HTB)
#define PG8_STAGE(bufoff, gbase, voff) do { _Pragma("unroll") for (int _i = 0; _i < 2; ++_i) \
        __builtin_amdgcn_global_load_lds((const unsigned*)((const char*)(gbase) + (voff)[_i]), (PG8_LAS unsigned*)(lds + (bufoff) + ldsw + _i * 8192), 16, 0, 0); } while (0)
#define PG8_LDA(dst, b, h) do { _Pragma("unroll") for (int m = 0; m < 4; ++m) _Pragma("unroll") for (int k = 0; k < 2; ++k) dst[m][k] = *(const PG8_LAS bf16x8*)(lds + PG8_SA(b, h) + aoff + m * 2048 + k * 1024); } while (0)
#define PG8_LDB(dst, b, h) do { _Pragma("unroll") for (int n = 0; n < 2; ++n) _Pragma("unroll") for (int k = 0; k < 2; ++k) dst[n][k] = *(const PG8_LAS bf16x8*)(lds + PG8_SB(b, h) + boff + n * 2048 + k * 1024); } while (0)
#define PG8_MMA(ai, bj, At, Bt) do { __builtin_amdgcn_s_setprio(1); _Pragma("unroll") for (int m = 0; m < 4; ++m) _Pragma("unroll") for (int n = 0; n < 2; ++n) _Pragma("unroll") for (int k = 0; k < 2; ++k) \
        acc[ai][bj][m][n] = __builtin_amdgcn_mfma_f32_16x16x32_bf16(Bt[n][k], At[m][k], acc[ai][bj][m][n], 0, 0, 0); __builtin_amdgcn_s_setprio(0); } while (0)
#define PG8_WAIT_V(n) asm volatile("s_waitcnt vmcnt(" #n ")" ::: "memory")
#define PG8_WAIT_L(n) asm volatile("s_waitcnt lgkmcnt(" #n ")" ::: "memory")
#define PG8_BAR __builtin_amdgcn_s_barrier()
#define PG8_SCHED __builtin_amdgcn_sched_barrier(0)
    Unit cur, nxt; int ui = 0;
    if (!S.next(0, cur)) return;
    f32x4 acc[2][2][4][2];
#pragma unroll
    for (int a = 0; a < 2; ++a)
#pragma unroll
        for (int b = 0; b < 2; ++b)
#pragma unroll
            for (int m = 0; m < 4; ++m)
#pragma unroll
                for (int n = 0; n < 2; ++n) acc[a][b][m][n] = (f32x4){0.f, 0.f, 0.f, 0.f};
    bf16x8 At[4][2], B0[2][2], B1[2][2];
    const char* cA = (const char*)g.A + (size_t)cur.pm * tstep; const char* cB = (const char*)g.Bt + (size_t)cur.pn * tstep;
    S.a_ready(cur);
    if constexpr (SP2) {
        PG8_STAGE(PG8_SB(0, 0), cB, voffB); PG8_STAGE(PG8_SB(0, 1), cB + hstep, voffB); PG8_STAGE(PG8_SA(0, 0), cA, voffA); PG8_STAGE(PG8_SA(0, 1), cA + hstep, voffA);
        if (wr == 1) PG8_BAR;
        PG8_WAIT_V(2); PG8_BAR;
        PG8_STAGE(PG8_SB(1, 0), cB + kstep, voffB); PG8_STAGE(PG8_SA(1, 0), cA + kstep, voffA); PG8_STAGE(PG8_SB(1, 1), cB + hstep + kstep, voffB);
        PG8_WAIT_V(6); PG8_BAR;
    } else {
        PG8_STAGE(PG8_SB(0, 0), cB, voffB); PG8_STAGE(PG8_SA(0, 0), cA, voffA); PG8_STAGE(PG8_SB(0, 1), cB + hstep, voffB); PG8_STAGE(PG8_SA(0, 1), cA + hstep, voffA);
        if (wr == 1) PG8_BAR;
        PG8_WAIT_V(4); PG8_BAR;
        PG8_STAGE(PG8_SB(1, 0), cB + kstep, voffB); PG8_STAGE(PG8_SA(1, 0), cA + kstep, voffA); PG8_STAGE(PG8_SB(1, 1), cB + hstep + kstep, voffB);
        PG8_WAIT_V(6); PG8_BAR;
    }
    for (;;) {
        const bool has_next = S.next(ui + 1, nxt);
        const char* nA = has_next ? (const char*)g.A + (size_t)nxt.pm * tstep : cA; const char* nB = has_next ? (const char*)g.Bt + (size_t)nxt.pn * tstep : cB;
        for (int t = 0; t < nt; t += 2) {
            const bool last = (t == nt - 2);
            const char* a1 = cA + (size_t)(t + 1) * kstep;
            const char* a2 = last ? nA : cA + (size_t)(t + 2) * kstep; const char* b2 = last ? nB : cB + (size_t)(t + 2) * kstep;
            const char* a3 = a2 + kstep; const char* b3 = b2 + kstep;
            if (last && has_next) S.a_ready(nxt);
            if constexpr (SP2) {
            PG8_LDB(B0, 0, 0); PG8_LDB(B1, 0, 1); PG8_SCHED; PG8_LDA(At, 0, 0); PG8_STAGE(PG8_SA(1, 1), a1 + hstep, voffA);
            PG8_WAIT_V(8); PG8_WAIT_L(0); PG8_BAR; PG8_MMA(0, 0, At, B0); PG8_MMA(0, 1, At, B1); PG8_BAR; PG8_SCHED;
            PG8_LDA(At, 0, 1); PG8_STAGE(PG8_SB(0, 0), b2, voffB); PG8_STAGE(PG8_SB(0, 1), b2 + hstep, voffB); PG8_STAGE(PG8_SA(0, 0), a2, voffA);
            PG8_WAIT_V(8); PG8_WAIT_L(0); PG8_BAR; PG8_MMA(1, 0, At, B0); PG8_MMA(1, 1, At, B1); PG8_BAR; PG8_SCHED;
            PG8_LDB(B0, 1, 0); PG8_LDB(B1, 1, 1); PG8_SCHED; PG8_LDA(At, 1, 0); PG8_STAGE(PG8_SA(0, 1), a2 + hstep, voffA);
            PG8_WAIT_V(8); PG8_WAIT_L(0); PG8_BAR; PG8_MMA(0, 0, At, B0); PG8_MMA(0, 1, At, B1); PG8_BAR; PG8_SCHED;
            PG8_LDA(At, 1, 1); PG8_STAGE(PG8_SB(1, 0), b3, voffB); PG8_STAGE(PG8_SB(1, 1), b3 + hstep, voffB); PG8_STAGE(PG8_SA(1, 0), a3, voffA);
            PG8_WAIT_V(8); PG8_WAIT_L(0); PG8_BAR; PG8_MMA(1, 0, At, B0); PG8_MMA(1, 1, At, B1); PG8_BAR; PG8_SCHED;
            } else {
            PG8_LDB(B0, 0, 0); PG8_SCHED; PG8_LDA(At, 0, 0); PG8_STAGE(PG8_SA(1, 1), a1 + hstep, voffA);
            PG8_WAIT_L(8); PG8_BAR; PG8_WAIT_L(0); PG8_MMA(0, 0, At, B0); PG8_BAR; PG8_SCHED;
            PG8_LDB(B1, 0, 1); PG8_STAGE(PG8_SB(0, 0), b2, voffB);
            PG8_BAR; PG8_WAIT_L(0); PG8_MMA(0, 1, At, B1); PG8_BAR;
            PG8_LDA(At, 0, 1); PG8_STAGE(PG8_SA(0, 0), a2, voffA);
            PG8_BAR; PG8_WAIT_L(0); PG8_MMA(1, 0, At, B0); PG8_BAR; PG8_SCHED;
            PG8_STAGE(PG8_SB(0, 1), b2 + hstep, voffB);
            PG8_WAIT_V(6); PG8_BAR; PG8_MMA(1, 1, At, B1); PG8_BAR;
            PG8_LDB(B0, 1, 0); PG8_SCHED; PG8_LDA(At, 1, 0); PG8_STAGE(PG8_SA(0, 1), a2 + hstep, voffA);
            PG8_WAIT_L(8); PG8_BAR; PG8_WAIT_L(0); PG8_MMA(0, 0, At, B0); PG8_BAR; PG8_SCHED;
            PG8_LDB(B1, 1, 1); PG8_STAGE(PG8_SB(1, 0), b3, voffB);
            PG8_BAR; PG8_WAIT_L(0); PG8_MMA(0, 1, At, B1); PG8_BAR;
            PG8_LDA(At, 1, 1); PG8_STAGE(PG8_SA(1, 0), a3, voffA);
            PG8_BAR; PG8_WAIT_L(0); PG8_MMA(1, 0, At, B0); PG8_BAR; PG8_SCHED;
            PG8_STAGE(PG8_SB(1, 1), b3 + hstep, voffB);
            PG8_WAIT_V(6); PG8_BAR; PG8_MMA(1, 1, At, B1); PG8_BAR;
            }
        }
        if constexpr (ALIGN_EPI) { if (wr == 0) PG8_BAR; }
        if constexpr (!Epi::AFTER_DRAIN) { E(acc, cur, wr, wc, fr, fq); S.done(cur); }
        if (!has_next) break;
#pragma unroll
        for (int a = 0; a < 2; ++a)
#pragma unroll
            for (int b = 0; b < 2; ++b)
#pragma unroll
                for (int m = 0; m < 4; ++m)
#pragma unroll
                    for (int n = 0; n < 2; ++n) acc[a][b][m][n] = (f32x4){0.f, 0.f, 0.f, 0.f};
        cur = nxt; cA = nA; cB = nB; ++ui;
        if constexpr (ALIGN_EPI) { if (wr == 1) PG8_BAR; }
    }
    PG8_WAIT_V(0);
    if constexpr (!ALIGN_EPI) { if (wr == 0) PG8_BAR; }
    PG8_BAR;
    if constexpr (Epi::AFTER_DRAIN) { E.fused(acc, cur, wr, wc, fr, fq, lds, wid, lane); S.done(cur); }
#undef PG8_SA
#undef PG8_SB
#undef PG8_STAGE
#undef PG8_LDA
#undef PG8_LDB
#undef PG8_MMA
#undef PG8_WAIT_V
#undef PG8_WAIT_L
#undef PG8_BAR
#undef PG8_SCHED
}
}

constexpr int NWAVES = 8, NTHREADS = 512;
#ifndef MK_N_LAUNCHES
#define MK_N_LAUNCHES 1
#endif
constexpr int BATCH = 8, SEQ = 2048, D = 1024, FF = 4096, NH = 4, DK = 128, DV = 256, QKW = 512, VW = 1024;
constexpr int M = BATCH * SEQ, NPROJ = 3072, CH = 64, NCH = SEQ / CH;
constexpr int MLSTM_IN = 3080, GLA_IN = 3088;
constexpr float EPS = 1e-6f, QK_SCALE = 0.08838834764831845f, INV_TAU = 1.0f / 16.0f;

constexpr size_t MiB = 1u << 20;
constexpr size_t WS_CTL = 0, CTL_ZERO_BYTES = 64 * 1024;
constexpr size_t WS_GATES = 1 * MiB;
constexpr size_t WS_GDEC = 2 * MiB;
constexpr size_t WS_SUMSQ = 2 * MiB + 512 * 1024;
constexpr size_t WS_WIN = 4 * MiB, WS_WOUT = 10 * MiB, WS_W1 = 12 * MiB, WS_W2 = 20 * MiB, WS_WLAYER = 56 * MiB;
constexpr size_t WS_AOP = 28 * MiB;
constexpr size_t WS_PROJ = 92 * MiB, WS_BBLK = 16 * MiB, WS_QT_OFF = 12 * MiB, WS_KT_OFF = 14 * MiB;
constexpr size_t BBLK_E = WS_BBLK / 2;
constexpr size_t WS_HMID = 92 * MiB;
constexpr size_t WS_XRES = 220 * MiB;
constexpr size_t WS_END = 252 * MiB;
constexpr int CW_BAR = 1024, CW_XID = 8192, CW_XCL = 9216, CW_FIN = 14336, CW_GRP = 15360;

constexpr int RING_BYTES = 131072, LDS_BYTES = 155648, LDSCTL_OFF = LDS_BYTES - 1024, MISC_OFF = LDSCTL_OFF + 320;

#define GAS __attribute__((address_space(1)))
#define LAS __attribute__((address_space(3)))
typedef unsigned short bf16;
typedef unsigned v4u __attribute__((ext_vector_type(4)));
typedef unsigned v2u __attribute__((ext_vector_type(2)));
typedef float f32x4 __attribute__((ext_vector_type(4)));
typedef float f32x16 __attribute__((ext_vector_type(16)));
typedef short bf16x8 __attribute__((ext_vector_type(8)));
typedef short s16x4 __attribute__((ext_vector_type(4)));
typedef GAS unsigned gu32;
#define RLX_AGENT __ATOMIC_RELAXED, __HIP_MEMORY_SCOPE_AGENT
#define LDS_WAIT() asm volatile("s_waitcnt lgkmcnt(0)" ::: "memory")
#define VM_WAIT() asm volatile("s_waitcnt vmcnt(0)" ::: "memory")
using pg8::pk_bf16;
__device__ __forceinline__ float bf2f(unsigned b) { return __uint_as_float(b << 16); }
__device__ __forceinline__ float bflo(unsigned w) { return __uint_as_float(w << 16); }
__device__ __forceinline__ float bfhi(unsigned w) { return __uint_as_float(w & 0xffff0000u); }
__device__ __forceinline__ unsigned short f2bf1(float f) { return (unsigned short)(pk_bf16(f, 0.f) & 0xffffu); }

struct Args { const float* in[15]; float* out; unsigned char* ws; int ph_lo, ph_hi; };
#define XB_TMO      128
#define XB_XCNT(j)  (256  + 64 * (j))
#define XB_XSUB(j)  (1280 + 64 * (j))
#define XB_XGEN(j)  (2304 + 64 * (j))
#define XB_TOP      3328
#define XB_TOPGEN   3392
#define XCD_BAR_WORDS 3456
#define XB_SPIN_CAP (1u << 18)
__device__ __forceinline__ unsigned xb_ld(unsigned* p)              { return __hip_atomic_load(p, __ATOMIC_RELAXED, __HIP_MEMORY_SCOPE_AGENT); }
__device__ __forceinline__ unsigned xb_add(unsigned* p, unsigned v) { return __hip_atomic_fetch_add(p, v, __ATOMIC_RELAXED, __HIP_MEMORY_SCOPE_AGENT); }
__device__ __forceinline__ unsigned xb_xcc_id() { return (unsigned)__builtin_amdgcn_s_getreg((3 << 11) | 20) & 0xFu; }
#define XB_SPIN(cond, bar) do { unsigned _sp = 0; while (cond) { __builtin_amdgcn_s_sleep(1); \
    if ((++_sp & 255u) == 0u) { if (xb_ld(&(bar)[XB_TMO])) break; if (_sp > XB_SPIN_CAP) { atomicAdd(&(bar)[XB_TMO], 1u); break; } } } } while (0)
struct XcdBarrier { unsigned* bar; unsigned x; volatile LAS unsigned* st; };
__device__ __forceinline__ XcdBarrier xcd_barrier_post(unsigned* bar, volatile LAS unsigned* st) {
    XcdBarrier b; b.bar = bar; b.x = xb_xcc_id(); b.st = st;
    if (threadIdx.x == 0) (void)xb_add(&bar[XB_XCNT(b.x)], 1u);
    return b;
}
__device__ __forceinline__ void xcd_barrier_complete(unsigned* bar, unsigned x, unsigned& nloc, unsigned& nx) {
    const unsigned G = gridDim.x * gridDim.y * gridDim.z;
    unsigned sum, cnt, mine, sp = 0u;
    for (;;) {
        sum = 0u; cnt = 0u; mine = 0u;
#pragma unroll
        for (unsigned j = 0; j < 16; ++j) { const unsigned c = xb_ld(&bar[XB_XCNT(j)]); sum += c; cnt += (c > 0u) ? 1u : 0u; mine = (j == x) ? c : mine; }
        if (sum == G) break;
        __builtin_amdgcn_s_sleep(1);
        if ((++sp & 255u) == 0u) { if (xb_ld(&bar[XB_TMO])) break; if (sp > XB_SPIN_CAP) { atomicAdd(&bar[XB_TMO], 1u); break; } }
    }
    nloc = mine > 0u ? mine : 1u; nx = cnt > 0u ? cnt : 1u;
}
__device__ __forceinline__ void xcd_barrier(const XcdBarrier& b) {
    asm volatile("s_waitcnt vmcnt(0)" ::: "memory");
    __syncthreads();
    if (threadIdx.x == 0) {
        unsigned* bar = b.bar;
        __builtin_amdgcn_s_waitcnt(0);
        unsigned nloc = b.st[0], nx = b.st[1];
        if (nloc == 0u) { xcd_barrier_complete(bar, b.x, nloc, nx); b.st[0] = nloc; b.st[1] = nx; }
        const unsigned old = xb_add(&bar[XB_XSUB(b.x)], 1u);
        const unsigned gen = old / nloc;
        if (old + 1u == (gen + 1u) * nloc) {
            __builtin_amdgcn_fence(__ATOMIC_RELEASE, "agent");
            asm volatile("s_waitcnt vmcnt(0)" ::: "memory");
            const unsigned og = xb_add(&bar[XB_TOP], 1u);
            const unsigned tg = og / nx;
            if (og + 1u == (tg + 1u) * nx) xb_add(&bar[XB_TOPGEN], 1u);
            else XB_SPIN(xb_ld(&bar[XB_TOPGEN]) == tg, bar);
            __builtin_amdgcn_fence(__ATOMIC_ACQUIRE, "agent");
            xb_add(&bar[XB_XGEN(b.x)], 1u);
            asm volatile("s_waitcnt vmcnt(0)" ::: "memory");
        } else {
            XB_SPIN(xb_ld(&bar[XB_XGEN(b.x)]) == gen, bar);
            __builtin_amdgcn_fence(__ATOMIC_ACQUIRE, "agent");
            asm volatile("s_waitcnt vmcnt(0)" ::: "memory");
        }
    }
    __syncthreads();
}

__device__ __forceinline__ float wave_sum(float v) {
#pragma unroll
    for (int o = 1; o < 64; o <<= 1) v += __shfl_xor(v, o);
    return v;
}
struct CvItem { const float* W; bf16* WT; const float* gain; int K, ldw, k0, n0; };
__device__ __forceinline__ CvItem cv_item(const Args& args, unsigned char* ws, int it) {
    constexpr int I_IN = (D / 64) * (NPROJ / 64), I_O = (D / 64) * (D / 64), I_1 = (D / 64) * (FF / 64), I_2 = (FF / 64) * (D / 64), NITEMS = I_IN + I_O + I_1 + I_2;
    const int layer = it >= NITEMS; int r = it - layer * NITEMS; unsigned char* wl = ws + (size_t)layer * WS_WLAYER;
    CvItem c; int N;
    if (r < I_IN) { c.W = args.in[layer ? 8 : 4]; c.K = D; N = NPROJ; c.ldw = layer ? GLA_IN : MLSTM_IN; c.WT = (bf16*)(wl + WS_WIN); c.gain = args.in[1] + layer * D; }
    else if ((r -= I_IN) < I_O) { c.W = args.in[layer ? 12 : 7]; c.K = D; N = D; c.ldw = D; c.WT = (bf16*)(wl + WS_WOUT); c.gain = nullptr; }
    else if ((r -= I_O) < I_1) { c.W = args.in[13] + (size_t)layer * D * FF; c.K = D; N = FF; c.ldw = FF; c.WT = (bf16*)(wl + WS_W1); c.gain = args.in[2] + layer * D; }
    else { r -= I_1; c.W = args.in[14] + (size_t)layer * D * FF; c.K = FF; N = D; c.ldw = D; c.WT = (bf16*)(wl + WS_W2); c.gain = nullptr; }
    const int nblk = N / 64; c.k0 = 64 * (r / nblk); c.n0 = 64 * (r % nblk);
    return c;
}
__device__ __forceinline__ void cv_load(f32x4 (&v)[16], const CvItem& c, int lane) {
    const int n4 = (lane & 15) * 4, krow = lane >> 4;
#pragma unroll
    for (int i = 0; i < 16; ++i) v[i] = *(const f32x4*)(c.W + (size_t)(c.k0 + 4 * i + krow) * c.ldw + c.n0 + n4);
}
__device__ __forceinline__ void cv_store(const f32x4 (&v)[16], const CvItem& c, LAS float* scr, int lane) {
    const int n4 = (lane & 15) * 4, krow = lane >> 4;
#pragma unroll
    for (int i = 0; i < 16; ++i) *(LAS f32x4*)(scr + (4 * i + krow) * 64 + (n4 ^ (((i >> 1) & 7) << 2))) = v[i];
    const int cc = lane & 7, nl = lane >> 3;
    f32x4 g0 = {1.f, 1.f, 1.f, 1.f}, g1 = {1.f, 1.f, 1.f, 1.f};
    if (c.gain) { g0 = *(const f32x4*)(c.gain + c.k0 + 8 * cc); g1 = *(const f32x4*)(c.gain + c.k0 + 8 * cc + 4); }
    LDS_WAIT(); asm volatile("" ::: "memory");
#pragma unroll
    for (int j = 0; j < 8; ++j) { const int n = 8 * j + nl; const LAS float* sp = scr + (8 * cc) * 64 + (n ^ (cc << 2));
        v4u o; o.x = pk_bf16(sp[0 * 64] * g0.x, sp[1 * 64] * g0.y); o.y = pk_bf16(sp[2 * 64] * g0.z, sp[3 * 64] * g0.w); o.z = pk_bf16(sp[4 * 64] * g1.x, sp[5 * 64] * g1.y); o.w = pk_bf16(sp[6 * 64] * g1.z, sp[7 * 64] * g1.w);
        *(GAS v4u*)(c.WT + (size_t)(c.n0 + n) * c.K + c.k0 + 8 * cc) = o; }
    LDS_WAIT(); asm volatile("" ::: "memory");
}
__device__ __forceinline__ void convert_weights(LAS unsigned char* lds, int lane, int wave, int vcu, int G, const Args& args, unsigned char* ws) {
    LAS float* scr = (LAS float*)(lds + wave * 16384);
    const int gw = vcu * NWAVES + wave, NGW = G * NWAVES;
    constexpr int NITEMS2 = 2 * ((D / 64) * (NPROJ / 64) + (D / 64) * (D / 64) + (D / 64) * (FF / 64) + (FF / 64) * (D / 64));
    f32x4 va[16], vb[16];
    int it = gw;
    if (it < NITEMS2) { const CvItem c0 = cv_item(args, ws, it); cv_load(va, c0, lane); }
    while (it < NITEMS2) {
        { const CvItem c = cv_item(args, ws, it); const int nx = it + NGW; if (nx < NITEMS2) { const CvItem cn = cv_item(args, ws, nx); cv_load(vb, cn, lane); } cv_store(va, c, scr, lane); it = nx; }
        if (it >= NITEMS2) break;
        { const CvItem c = cv_item(args, ws, it); const int nx = it + NGW; if (nx < NITEMS2) { const CvItem cn = cv_item(args, ws, nx); cv_load(va, cn, lane); } cv_store(vb, c, scr, lane); it = nx; }
    }
}

__device__ __forceinline__ void rows_first(LAS unsigned char* lds, int tid, int lane, int wave, int vcu, int G, const float* xin, const float* gain, bf16* xres, float* sumsq,
                                           const float* wg, int ldw, int ng, float* gates) {
    LAS float* WgT = (LAS float*)lds;
    __syncthreads();
    { float wv[32];
#pragma unroll
      for (int n = 0; n < 32; ++n) { const int i = tid + NTHREADS * n, k = i >> 4, c = i & 15; wv[n] = (c < ng) ? wg[(size_t)k * ldw + c] : 0.f; }
#pragma unroll
      for (int n = 0; n < 32; ++n) { const int i = tid + NTHREADS * n, k = i >> 4, c = i & 15; WgT[c * D + k] = wv[n]; } }
    __syncthreads();
    const int gw = vcu * NWAVES + wave, NGW = G * NWAVES;
    f32x4 gn[4];
#pragma unroll
    for (int j = 0; j < 4; ++j) gn[j] = *(const f32x4*)(gain + 4 * lane + 256 * j);
    f32x4 vn[4];
    if (gw < M) {
#pragma unroll
        for (int j = 0; j < 4; ++j) vn[j] = *(const f32x4*)(xin + (size_t)gw * D + 4 * lane + 256 * j); }
    for (int m = gw; m < M; m += NGW) {
        f32x4 v[4]; float s = 0.f;
#pragma unroll
        for (int j = 0; j < 4; ++j) { v[j] = vn[j]; s += (v[j].x * v[j].x + v[j].y * v[j].y) + (v[j].z * v[j].z + v[j].w * v[j].w); }
        if (m + NGW < M) {
#pragma unroll
            for (int j = 0; j < 4; ++j) vn[j] = *(const f32x4*)(xin + (size_t)(m + NGW) * D + 4 * lane + 256 * j); }
#pragma unroll
        for (int j = 0; j < 4; ++j) { v2u o; o.x = pk_bf16(v[j].x, v[j].y); o.y = pk_bf16(v[j].z, v[j].w); *(v2u*)(xres + (size_t)m * D + 4 * lane + 256 * j) = o; }
        const float ssum = wave_sum(s);
        if (lane == 0) *(f32x4*)(sumsq + (size_t)m * 4) = (f32x4){ssum, 0.f, 0.f, 0.f};
        const float rstd = 1.0f / sqrtf(ssum * (1.f / D) + EPS);
#pragma unroll
        for (int j = 0; j < 4; ++j) v[j] = v[j] * rstd * gn[j];
        float a[16];
#pragma unroll
        for (int c = 0; c < 16; ++c) a[c] = 0.f;
#pragma unroll
        for (int c = 0; c < 16; ++c) {
#pragma unroll
            for (int j = 0; j < 4; ++j) { const f32x4 w = *(const LAS f32x4*)(WgT + c * D + 4 * lane + 256 * j); a[c] += (v[j].x * w.x + v[j].y * w.y) + (v[j].z * w.z + v[j].w * w.w); }
            if (c & 1) asm volatile("" ::: "memory"); }
        const bool b5 = lane & 32, b4 = lane & 16, b3 = lane & 8, b2 = lane & 4;
#pragma unroll
        for (int i = 0; i < 8; ++i) { const float keep = b5 ? a[i + 8] : a[i], send = b5 ? a[i] : a[i + 8]; a[i] = keep + __shfl_xor(send, 32); }
#pragma unroll
        for (int i = 0; i < 4; ++i) { const float keep = b4 ? a[i + 4] : a[i], send = b4 ? a[i] : a[i + 4]; a[i] = keep + __shfl_xor(send, 16); }
#pragma unroll
        for (int i = 0; i < 2; ++i) { const float keep = b3 ? a[i + 2] : a[i], send = b3 ? a[i] : a[i + 2]; a[i] = keep + __shfl_xor(send, 8); }
        { const float keep = b2 ? a[1] : a[0], send = b2 ? a[0] : a[1]; a[0] = keep + __shfl_xor(send, 4); }
        a[0] += __shfl_xor(a[0], 2); a[0] += __shfl_xor(a[0], 1);
        const int c = (b5 ? 8 : 0) + (b4 ? 4 : 0) + (b3 ? 2 : 0) + (b2 ? 1 : 0);
        if ((lane & 3) == 0 && c < ng) gates[(size_t)m * 16 + c] = a[0];
    }
}
__device__ __forceinline__ void rows_final(int lane, int wave, int vcu, int G, const bf16* xres, const float* gain, float* out) {
    const int gw = vcu * NWAVES + wave, NGW = G * NWAVES;
    for (int m = gw; m < M; m += NGW) {
        float f[2][8]; float ss = 0.f;
#pragma unroll
        for (int j = 0; j < 2; ++j) { const v4u hv = *(const v4u*)(xres + (size_t)m * D + 8 * lane + 512 * j);
            f[j][0] = bflo(hv.x); f[j][1] = bfhi(hv.x); f[j][2] = bflo(hv.y); f[j][3] = bfhi(hv.y); f[j][4] = bflo(hv.z); f[j][5] = bfhi(hv.z); f[j][6] = bflo(hv.w); f[j][7] = bfhi(hv.w);
#pragma unroll
            for (int e = 0; e < 8; ++e) ss += f[j][e] * f[j][e]; }
        const float rstd = 1.0f / sqrtf(wave_sum(ss) * (1.f / D) + EPS);
#pragma unroll
        for (int j = 0; j < 2; ++j) { const int col = 8 * lane + 512 * j; const f32x4 g0 = *(const f32x4*)(gain + col), g1 = *(const f32x4*)(gain + col + 4);
            *(f32x4*)(out + (size_t)m * D + col) = (f32x4){f[j][0] * rstd * g0.x, f[j][1] * rstd * g0.y, f[j][2] * rstd * g0.z, f[j][3] * rstd * g0.w};
            *(f32x4*)(out + (size_t)m * D + col + 4) = (f32x4){f[j][4] * rstd * g1.x, f[j][5] * rstd * g1.y, f[j][6] * rstd * g1.z, f[j][7] * rstd * g1.w}; }
    }
}
struct RstdSlots { int pm0, pm1, pm2, pm3; };
__device__ __forceinline__ RstdSlots rstd_table(LAS float* rt, const float* sumsq, const pg8::StaticOrder& S, int tid) {
    int pmv[4] = {-1, -1, -1, -1}; int ns = 0;
    pg8::Unit u;
    for (int i = 0; S.next(i, u); ++i) { if (u.pm != pmv[0] && u.pm != pmv[1] && u.pm != pmv[2] && u.pm != pmv[3] && ns < 4) { if (ns == 0) pmv[0] = u.pm; else if (ns == 1) pmv[1] = u.pm; else if (ns == 2) pmv[2] = u.pm; else pmv[3] = u.pm; ++ns; } }
#pragma unroll
    for (int sl = 0; sl < 4; ++sl) { const int pm = sl == 0 ? pmv[0] : sl == 1 ? pmv[1] : sl == 2 ? pmv[2] : pmv[3];
        if (pm >= 0 && tid < 256) { const f32x4 s4 = *(const f32x4*)(sumsq + (size_t)(pm * 256 + tid) * 4); rt[sl * 256 + tid] = 1.0f / sqrtf(((s4.x + s4.y) + (s4.z + s4.w)) * (1.f / D) + EPS); } }
    __syncthreads();
    return RstdSlots{pmv[0], pmv[1], pmv[2], pmv[3]};
}

__device__ __forceinline__ void head_norm_rows(int lane, int wave, int vcu, int G, const bf16* hun, const float* gout, const bf16* proj, bf16* aop, const bool GLA) {
    const int rows_wg = M / G, rows_w = rows_wg / NWAVES;
    for (int i = 0; i < rows_w; ++i) {
        const int m = vcu * rows_wg + wave * rows_w + i;
#pragma unroll
        for (int j = 0; j < 2; ++j) {
            const int col = 8 * lane + 512 * j;
            const v4u hv = *(const v4u*)(hun + (size_t)m * D + col);
            const v4u rv = *(const v4u*)(proj + (size_t)(m >> 11) * BBLK_E + (size_t)(m & 2047) * NPROJ + 2048 + col);
            float f[8] = {bflo(hv.x), bfhi(hv.x), bflo(hv.y), bfhi(hv.y), bflo(hv.z), bfhi(hv.z), bflo(hv.w), bfhi(hv.w)};
            const float r[8] = {bflo(rv.x), bfhi(rv.x), bflo(rv.y), bfhi(rv.y), bflo(rv.z), bfhi(rv.z), bflo(rv.w), bfhi(rv.w)};
            float sg[8];
#pragma unroll
            for (int e = 0; e < 8; ++e) sg[e] = __builtin_amdgcn_rcpf(1.0f + __expf(-r[e]));
            if (!GLA) {
#pragma unroll
                for (int e = 0; e < 8; ++e) f[e] *= sg[e];
            }
            float ss = 0.f;
#pragma unroll
            for (int e = 0; e < 8; ++e) ss += f[e] * f[e];
#pragma unroll
            for (int o = 1; o < 32; o <<= 1) ss += __shfl_xor(ss, o);
            const float rs = 1.0f / sqrtf(ss * (1.f / DV) + EPS);
            const f32x4 g0 = *(const f32x4*)(gout + col), g1 = *(const f32x4*)(gout + col + 4);
            const float gg[8] = {g0.x, g0.y, g0.z, g0.w, g1.x, g1.y, g1.z, g1.w};
#pragma unroll
            for (int e = 0; e < 8; ++e) f[e] = f[e] * rs * gg[e];
            if (GLA) {
#pragma unroll
                for (int e = 0; e < 8; ++e) f[e] *= r[e] * sg[e];
            }
            v4u o; o.x = pk_bf16(f[0], f[1]); o.y = pk_bf16(f[2], f[3]); o.z = pk_bf16(f[4], f[5]); o.w = pk_bf16(f[6], f[7]);
            *(v4u*)(aop + (size_t)m * D + col) = o;
        }
    }
}

constexpr int GP_WGT = 0, GP_WGT_PITCH = 2064, GP_ZL = 33024, GP_TOT = 41216, GP_Q = 43264, GP_K = 59648;
__device__ __forceinline__ void gla_prep(LAS unsigned char* lds, int tid, int lane, int wave, int vcu, int G, const bf16* proj, const bf16* xres, const float* sumsq, const float* w_in, const float* gmix,
                                         const float* wup, const float* bgate, bf16* QT, bf16* KT, float* gdec) {
    LAS float* zl = (LAS float*)(lds + GP_ZL);
    LAS float* tot = (LAS float*)(lds + GP_TOT);
    LAS unsigned short* tq = (LAS unsigned short*)(lds + GP_Q);
    LAS unsigned short* tk = (LAS unsigned short*)(lds + GP_K);
    __syncthreads();
    { float wv[32];
#pragma unroll
      for (int n = 0; n < 32; ++n) { const int i = tid + NTHREADS * n, k = i >> 4, c = i & 15; wv[n] = gmix[k] * w_in[(size_t)k * GLA_IN + NPROJ + c]; }
#pragma unroll
      for (int n = 0; n < 32; ++n) { const int i = tid + NTHREADS * n, k = i >> 4, c = i & 15; *(LAS unsigned short*)(lds + GP_WGT + c * GP_WGT_PITCH + k * 2) = f2bf1(wv[n]); } }
    const int d = tid & 127, rg = tid >> 7;
    for (int unit = vcu; unit < BATCH * NCH; unit += G) {
        const int b = unit / NCH, c = unit % NCH, tok0 = b * SEQ + c * CH;
        const bf16* projb = proj + (size_t)b * BBLK_E + (size_t)(c * CH) * NPROJ; bf16* QTb = QT + (size_t)b * BBLK_E + (size_t)(c * CH) * QKW; bf16* KTb = KT + (size_t)b * BBLK_E + (size_t)(c * CH) * QKW;
        v4u pq[2], pk[2]; float wu[16]; float bg;
#define GP_LOAD(h_) do { _Pragma("unroll") for (int i_ = 0; i_ < 2; ++i_) { const int p_ = tid + NTHREADS * i_, row_ = p_ >> 4, ch_ = p_ & 15; \
            pq[i_] = *(const v4u*)(projb + (size_t)row_ * NPROJ + (h_) * DK + ch_ * 8); pk[i_] = *(const v4u*)(projb + (size_t)row_ * NPROJ + QKW + (h_) * DK + ch_ * 8); } \
            _Pragma("unroll") for (int cc_ = 0; cc_ < 16; ++cc_) wu[cc_] = wup[cc_ * QKW + (h_) * DK + d]; bg = bgate[(h_) * DK + d]; } while (0)
        GP_LOAD(0);
        __syncthreads();
        {
            const int rt = wave & 3, kh = wave >> 2, r16 = lane & 15, kq = lane >> 4;
            pg8::f32x4 acc = {0.f, 0.f, 0.f, 0.f};
            const bf16* xr = xres + (size_t)(tok0 + 16 * rt + r16) * D + kh * 512 + 8 * kq;
            LAS unsigned char* wr_ = lds + GP_WGT + r16 * GP_WGT_PITCH + (kh * 512 + 8 * kq) * 2;
#pragma unroll
            for (int ks = 0; ks < 16; ++ks) { const bf16x8 av = *(const bf16x8*)(xr + 32 * ks), bv = *(const LAS bf16x8*)(wr_ + 64 * ks); acc = __builtin_amdgcn_mfma_f32_16x16x32_bf16(av, bv, acc, 0, 0, 0); }
#pragma unroll
            for (int i = 0; i < 4; ++i) zl[kh * 1024 + (16 * rt + 4 * kq + i) * 16 + r16] = acc[i];
        }
        __syncthreads();
        { const int row = tid >> 3, c2 = (tid & 7) * 2;
          const f32x4 s4 = *(const f32x4*)(sumsq + (size_t)(tok0 + row) * 4); const float rstd = 1.0f / sqrtf(((s4.x + s4.y) + (s4.z + s4.w)) * (1.f / D) + EPS);
          const float z0 = (zl[row * 16 + c2] + zl[1024 + row * 16 + c2]) * rstd, z1 = (zl[row * 16 + c2 + 1] + zl[1024 + row * 16 + c2 + 1]) * rstd;
          __syncthreads();
          zl[row * 16 + c2] = z0; zl[row * 16 + c2 + 1] = z1; }
        __syncthreads();
#pragma unroll
        for (int h = 0; h < NH; ++h) {
#pragma unroll
            for (int i = 0; i < 2; ++i) { const int p = tid + NTHREADS * i; *(LAS v4u*)(lds + GP_Q + p * 16) = pq[i]; *(LAS v4u*)(lds + GP_K + p * 16) = pk[i]; }
            float wuh[16]; const float bgh = bg;
#pragma unroll
            for (int cc = 0; cc < 16; ++cc) wuh[cc] = wu[cc];
            if (h + 1 < NH) GP_LOAD(h + 1);
            float bcum[16]; float run = 0.f;
#pragma unroll
            for (int jj = 0; jj < 16; ++jj) {
                const int j = 16 * rg + jj; float z = bgh;
#pragma unroll
                for (int q4 = 0; q4 < 4; ++q4) { const f32x4 zz = *(const LAS f32x4*)(zl + j * 16 + 4 * q4); z += (zz.x * wuh[4 * q4] + zz.y * wuh[4 * q4 + 1]) + (zz.z * wuh[4 * q4 + 2] + zz.w * wuh[4 * q4 + 3]); }
                const float la = (fminf(z, 0.f) - __logf(1.0f + __expf(-fabsf(z)))) * INV_TAU;
                run += la; bcum[jj] = run;
            }
            tot[rg * 128 + d] = run;
            __syncthreads();
            float off = 0.f, g = 0.f;
#pragma unroll
            for (int r2 = 0; r2 < 4; ++r2) { const float t = tot[r2 * 128 + d]; g += t; off += (r2 < rg) ? t : 0.f; }
#pragma unroll
            for (int jj = 0; jj < 16; ++jj) {
                const int j = 16 * rg + jj; const float eb = __expf(bcum[jj] + off);
                const float q = bf2f(tq[j * 128 + d]), k = bf2f(tk[j * 128 + d]);
                tq[j * 128 + d] = f2bf1(q * QK_SCALE * eb); tk[j * 128 + d] = f2bf1(k * __builtin_amdgcn_rcpf(eb));
            }
            if (rg == 0) gdec[(size_t)(unit * NH + h) * DK + d] = __expf(g);
            __syncthreads();
#pragma unroll
            for (int i = 0; i < 2; ++i) { const int p = tid + NTHREADS * i, row = p >> 4, ch = p & 15;
                *(v4u*)(QTb + (size_t)row * QKW + h * DK + ch * 8) = *(const LAS v4u*)(lds + GP_Q + p * 16);
                *(v4u*)(KTb + (size_t)row * QKW + h * DK + ch * 8) = *(const LAS v4u*)(lds + GP_K + p * 16); }
            __syncthreads();
        }
#undef GP_LOAD
    }
    __syncthreads();
}

#ifndef PROBE_P
#define PROBE_P 0
#endif
#ifndef PROBE_P_A
#define PROBE_P_A 0
#endif
#ifndef PROBE_P_B
#define PROBE_P_B 1
#endif
#define PP_STAMP(i) do { if (PROBE_P && ((i) / 2 == PROBE_P_A || (i) / 2 == PROBE_P_B) && tid == 0) ((volatile LAS unsigned*)(lds + LDSCTL_OFF + 512))[i] = (unsigned)__builtin_amdgcn_s_memrealtime(); } while (0)
#ifndef PROBE_T
#define PROBE_T 0
#endif
#ifndef PROBE_T_MLSTM
#define PROBE_T_MLSTM 0
#endif
#ifndef PROBE_T_WAVE
#define PROBE_T_WAVE 0
#endif
#ifndef PROBE_T_A
#define PROBE_T_A 5
#endif
#ifndef PROBE_T_B
#define PROBE_T_B 0
#endif
constexpr int CW_PROBE = 12288;
__device__ __forceinline__ unsigned long long pt_now() { unsigned long long t; __builtin_amdgcn_sched_barrier(0); asm volatile("s_memrealtime %0\n\ts_waitcnt lgkmcnt(0)" : "=s"(t) :: "memory"); __builtin_amdgcn_sched_barrier(0); return t; }
#define PT_NOW() pt_now()
#define PT_ACC(i, t0) do { if (PROBE_T) { const unsigned long long t1_ = PT_NOW(); pt[i] += (unsigned)(t1_ - (t0)); (t0) = t1_; } } while (0)
constexpr int PS_PITCH = 144, CT_PITCH = 272, CT_BYTES = 32 * CT_PITCH, IMG_PITCH = 272, IMG_BYTES = 64 * IMG_PITCH, NUM_PITCH = 36;
template <bool MLSTM> struct MxMap;
template <> struct MxMap<true>  { static constexpr int QS = 0, KS = 34816, V = 69632, VW = 77824, VWAUX = 81920, PS = 86016, CT = 95232, TB = 112640, TWP = 120832, TPM = 129024, TSC = 137216, DEN = 137728, NUM = 138240, OUTT = 0, GDEC = 0, END = 147456; };
template <> struct MxMap<false> { static constexpr int QS = 0, KS = 34816, V = 69632, VW = 0, VWAUX = 0, PS = 77824, CT = 87040, TB = 0, TWP = 0, TPM = 0, TSC = 0, DEN = 0, NUM = 0, OUTT = 104448, GDEC = 108544, END = 109568; };
#define LDSA(p) ((unsigned)(size_t)(p))
__device__ __forceinline__ bf16x8 mk8(v2u lo, v2u hi) { v4u w; w.x = lo.x; w.y = lo.y; w.z = hi.x; w.w = hi.y; return __builtin_bit_cast(bf16x8, w); }
__device__ __forceinline__ void tr_read2(bf16x8& f0, bf16x8& f1, unsigned a0, unsigned a1, unsigned b0, unsigned b1) {
    v2u l0, h0, l1, h1;
    asm volatile("ds_read_b64_tr_b16 %0, %4\n\tds_read_b64_tr_b16 %1, %5\n\tds_read_b64_tr_b16 %2, %6\n\tds_read_b64_tr_b16 %3, %7\n\ts_waitcnt lgkmcnt(0)"
                 : "=&v"(l0), "=&v"(h0), "=&v"(l1), "=&v"(h1) : "v"(a0), "v"(a1), "v"(b0), "v"(b1) : "memory");
    f0 = mk8(l0, h0); f1 = mk8(l1, h1);
}
__device__ __forceinline__ void tr_read3(bf16x8& f0, bf16x8& f1, bf16x8& f2, unsigned a0, unsigned a1, unsigned b0, unsigned b1, unsigned c0, unsigned c1) {
    v2u l0, h0, l1, h1, l2, h2;
    asm volatile("ds_read_b64_tr_b16 %0, %6\n\tds_read_b64_tr_b16 %1, %7\n\tds_read_b64_tr_b16 %2, %8\n\tds_read_b64_tr_b16 %3, %9\n\tds_read_b64_tr_b16 %4, %10\n\tds_read_b64_tr_b16 %5, %11\n\ts_waitcnt lgkmcnt(0)"
                 : "=&v"(l0), "=&v"(h0), "=&v"(l1), "=&v"(h1), "=&v"(l2), "=&v"(h2) : "v"(a0), "v"(a1), "v"(b0), "v"(b1), "v"(c0), "v"(c1) : "memory");
    f0 = mk8(l0, h0); f1 = mk8(l1, h1); f2 = mk8(l2, h2);
}
template <int P> __device__ __forceinline__ void tr_issue4(v2u (&x)[8], unsigned base) {
    asm volatile("ds_read_b64_tr_b16 %0, %8 offset:%9\n\tds_read_b64_tr_b16 %1, %8 offset:%10\n\tds_read_b64_tr_b16 %2, %8 offset:%11\n\tds_read_b64_tr_b16 %3, %8 offset:%12\n\t"
                 "ds_read_b64_tr_b16 %4, %8 offset:%13\n\tds_read_b64_tr_b16 %5, %8 offset:%14\n\tds_read_b64_tr_b16 %6, %8 offset:%15\n\tds_read_b64_tr_b16 %7, %8 offset:%16"
                 : "=&v"(x[0]), "=&v"(x[1]), "=&v"(x[2]), "=&v"(x[3]), "=&v"(x[4]), "=&v"(x[5]), "=&v"(x[6]), "=&v"(x[7])
                 : "v"(base), "i"(0), "i"(4 * P), "i"(16 * P), "i"(20 * P), "i"(32 * P), "i"(36 * P), "i"(48 * P), "i"(52 * P) : "memory");
}
__device__ __forceinline__ void tr_wait8(v2u (&x)[8]) { asm volatile("s_waitcnt lgkmcnt(0)" : "+v"(x[0]), "+v"(x[1]), "+v"(x[2]), "+v"(x[3]), "+v"(x[4]), "+v"(x[5]), "+v"(x[6]), "+v"(x[7]) :: "memory"); }
__device__ __forceinline__ void tr_pin8(v2u (&x)[8]) { asm volatile("" : "+v"(x[0]), "+v"(x[1]), "+v"(x[2]), "+v"(x[3]), "+v"(x[4]), "+v"(x[5]), "+v"(x[6]), "+v"(x[7])); }
__device__ __forceinline__ bf16x8 tr_read1(unsigned a0, unsigned a1) {
    v2u l0, h0;
    asm volatile("ds_read_b64_tr_b16 %0, %2\n\tds_read_b64_tr_b16 %1, %3\n\ts_waitcnt lgkmcnt(0)" : "=&v"(l0), "=&v"(h0) : "v"(a0), "v"(a1) : "memory");
    return mk8(l0, h0);
}
#define MFMA32(a, b, c) __builtin_amdgcn_mfma_f32_32x32x16_bf16((a), (b), (c), 0, 0, 0)
#define MX_BAR() do { asm volatile("s_waitcnt lgkmcnt(0)" ::: "memory"); __builtin_amdgcn_s_barrier(); asm volatile("" ::: "memory"); } while (0)
#define MX_BAR_VM() do { asm volatile("s_waitcnt vmcnt(0) lgkmcnt(0)" ::: "memory"); __builtin_amdgcn_s_barrier(); asm volatile("" ::: "memory"); } while (0)
struct MixArgs { const bf16 *q, *k, *proj; int qpitch; const float *gates, *bgate, *gdec; bf16* hun; void* probe; };
struct MixUnit { const bf16 *Qg, *Kg, *Vg; bf16* Hg; const float* gdec; int qpitch, b, hh; };
constexpr int MX_NPIECE = 38, MX_PPW = 5;
template <bool MLSTM> struct MixDma { static constexpr int PPW = MX_PPW; unsigned voff[PPW]; };
template <bool MLSTM> __device__ __forceinline__ int mx_piece(int wave, int i) { return wave + 8 * i; }

template <bool MLSTM>
__device__ __forceinline__ void mx_dma_setup(MixDma<MLSTM>& dm, int wave, int lane, int qpitch) {
#pragma unroll
    for (int i = 0; i < MixDma<MLSTM>::PPW; ++i) { const int pi = mx_piece<MLSTM>(wave, i); unsigned v = 0;
        if (pi < 34) { const int ob = (pi < 17 ? pi : pi - 17) * 1024 + lane * 16, row = ob / IMG_PITCH; int cb = ob - row * IMG_PITCH; cb = cb < 256 ? cb : 240; v = (unsigned)(row * qpitch * 2 + cb); }
        else { const int ob = (pi - 34) * 1024 + lane * 16, row = ob >> 6, cb = ob & 63; v = (unsigned)(row * NPROJ * 2 + cb); }
        dm.voff[i] = v; }
}
template <bool MLSTM>
__device__ __forceinline__ void mx_dma_issue(LAS unsigned char* lds, const MixDma<MLSTM>& dm, const MixUnit& U, int c, int wave, int tid) {
    typedef MxMap<MLSTM> MP;
    const int par = c & 1; const size_t tok0 = (size_t)c * CH;
    const char* qb = (const char*)(U.Qg + tok0 * U.qpitch); const char* kb = (const char*)(U.Kg + tok0 * U.qpitch); const char* vb = (const char*)(U.Vg + tok0 * NPROJ);
#pragma unroll
    for (int i = 0; i < MixDma<MLSTM>::PPW; ++i) { const int pi = mx_piece<MLSTM>(wave, i);
        if (pi < MX_NPIECE) {
            const char* src; int dst;
            if (pi < 17) { src = qb; dst = MP::QS + par * IMG_BYTES + pi * 1024; }
            else if (pi < 34) { src = kb; dst = MP::KS + par * IMG_BYTES + (pi - 17) * 1024; }
            else { src = vb; dst = MP::V + par * 4096 + (pi - 34) * 1024; }
            __builtin_amdgcn_global_load_lds((const unsigned*)(src + dm.voff[i]), (LAS unsigned*)(lds + dst), 16, 0, 0);
        } }
    if (!MLSTM && wave == 7) {
        const float* gd = U.gdec + (size_t)(((U.b * NCH + c) * NH) + U.hh) * DK + (tid & 63);
        __builtin_amdgcn_global_load_lds((const unsigned*)gd, (LAS unsigned*)(lds + MP::GDEC + par * 512), 4, 0, 0);
        __builtin_amdgcn_global_load_lds((const unsigned*)(gd + 64), (LAS unsigned*)(lds + MP::GDEC + par * 512 + 256), 4, 0, 0);
    }
}
__device__ __forceinline__ void mx_store_tile(LAS unsigned char* outt, const f32x16& val, bf16* grow  , int lane, int r, int h5) {
#pragma unroll
    for (int i = 0; i < 16; ++i) *(LAS unsigned short*)(outt + ((i & 3) + 8 * (i >> 2) + 4 * h5) * 64 + r * 2) = f2bf1(val[i]);
#pragma unroll
    for (int i = 0; i < 2; ++i) { const int id = lane + 64 * i, row = id >> 2, pc = id & 3; const v4u w = *(const LAS v4u*)(outt + row * 64 + pc * 16); *(v4u*)(grow + (size_t)row * D + pc * 8) = w; }
}
__device__ __forceinline__ void mx_finalize_mlstm(LAS unsigned char* lds, const MixUnit& U, int cf, int fl) {
    typedef MxMap<true> MP;
    const int j = fl >> 2, sg = fl & 3; const float mc = ((const LAS float*)(lds + MP::TSC))[cf];
    const float dn = ((const LAS float*)(lds + MP::DEN))[j], bb = ((const LAS float*)(lds + MP::TB))[cf * 64 + j], pm = ((const LAS float*)(lds + MP::TPM))[cf * 64 + j];
    const float rden = QK_SCALE * __builtin_amdgcn_rcpf(fmaxf(fabsf(dn) * QK_SCALE, __expf(-bb - fmaxf(mc, pm))));
    const f32x4 n0 = *(const LAS f32x4*)((const LAS float*)(lds + MP::NUM) + j * NUM_PITCH + 8 * sg) * rden, n1 = *(const LAS f32x4*)((const LAS float*)(lds + MP::NUM) + j * NUM_PITCH + 8 * sg + 4) * rden;
    v4u w; w.x = pk_bf16(n0.x, n0.y); w.y = pk_bf16(n0.z, n0.w); w.z = pk_bf16(n1.x, n1.y); w.w = pk_bf16(n1.z, n1.w);
    *(v4u*)(U.Hg + (size_t)(U.b * SEQ + cf * CH + j) * D + 8 * sg) = w;
}

template <bool MLSTM>
__device__ __forceinline__ void mx_step(LAS unsigned char* lds, const MixDma<MLSTM>& dm, const MixUnit& U, int c, f32x16& accC0, f32x16& accC1, f32x16& accO, int tid, int lane, int wave, unsigned (&pt)[8]) {
    typedef MxMap<MLSTM> MP;
    unsigned long long tp = PROBE_T ? PT_NOW() : 0ull;
    const int r = lane & 31, h5 = lane >> 5, blk = (lane >> 4) & 1, q4 = (lane & 15) >> 2, p4 = lane & 3, par = c & 1;
    const LAS float* TSC = (const LAS float*)(lds + MP::TSC);
    LAS unsigned char* qimg0 = lds + MP::QS + par * IMG_BYTES; LAS unsigned char* kimg0 = lds + MP::KS + par * IMG_BYTES; LAS unsigned char* vimg0 = lds + MP::V + par * 4096;
    if (c + 1 < NCH) mx_dma_issue<MLSTM>(lds, dm, U, c + 1, wave, tid);
    PT_ACC(6, tp);
    const float mc = MLSTM ? TSC[c] : 0.f;
    if (wave < 4) {
        const int st = wave >> 1, jt = (wave == 1 || wave == 2) ? 1 : 0;
#pragma unroll
        for (int i = 0; i < 16; ++i) accO[i] = 0.f;
        if (MLSTM && wave == 3) {
#pragma unroll
            for (int i = 0; i < 4; ++i) { const int id = lane + 64 * i, row = id >> 2, pc = id & 3;
                const float wr_ = __expf(((const LAS float*)(lds + MP::TWP))[c * 64 + row] - TSC[32 + c]); const v4u pv = *(const LAS v4u*)(vimg0 + row * 64 + pc * 16); v4u o;
                o.x = pk_bf16(bflo(pv.x) * wr_, bfhi(pv.x) * wr_); o.y = pk_bf16(bflo(pv.y) * wr_, bfhi(pv.y) * wr_); o.z = pk_bf16(bflo(pv.z) * wr_, bfhi(pv.z) * wr_); o.w = pk_bf16(bflo(pv.w) * wr_, bfhi(pv.w) * wr_);
                *(LAS v4u*)(lds + MP::VW + row * 64 + pc * 16) = o;
                if (pc == 0) *(LAS unsigned short*)(lds + MP::VWAUX + row * 64) = f2bf1(wr_); }
        }
        if (wave != 3) {
            LAS unsigned char* kimg = kimg0 + (32 * st + r) * IMG_PITCH + 16 * h5;
            LAS unsigned char* qimg = qimg0 + (32 * jt + r) * IMG_PITCH + 16 * h5;
#pragma unroll
            for (int ks = 0; ks < 8; ++ks) { const bf16x8 a = *(const LAS bf16x8*)(kimg + 32 * ks), bq = *(const LAS bf16x8*)(qimg + 32 * ks); accO = MFMA32(a, bq, accO); }
        }
        const int j = 32 * jt + r;
        if (wave == 3) {
#pragma unroll
            for (int g4 = 0; g4 < 4; ++g4) *(LAS v2u*)(lds + MP::PS + j * PS_PITCH + (32 * st + 8 * g4 + 4 * h5) * 2) = (v2u){0u, 0u};
        } else {
            float uj = 0.f;
            if (MLSTM) uj = -fmaxf(mc, ((const LAS float*)(lds + MP::TPM))[c * 64 + j]);
#pragma unroll
            for (int g4 = 0; g4 < 4; ++g4) { const int s0 = 32 * st + 8 * g4 + 4 * h5; f32x4 wps = {0.f, 0.f, 0.f, 0.f}; if (MLSTM) wps = *(const LAS f32x4*)((const LAS float*)(lds + MP::TWP) + c * 64 + s0);
                float v[4];
#pragma unroll
                for (int e = 0; e < 4; ++e) { float x = accO[4 * g4 + e]; if (MLSTM) x *= __expf(uj + wps[e]); v[e] = (s0 + e <= j) ? x : 0.f; }
                v2u o; o.x = pk_bf16(v[0], v[1]); o.y = pk_bf16(v[2], v[3]); *(LAS v2u*)(lds + MP::PS + j * PS_PITCH + s0 * 2) = o; }
        }
    } else {
        const int g = (wave - 4) >> 1, jt = wave & 1;
        if (MLSTM) {
            if (c > 0) mx_finalize_mlstm(lds, U, c - 1, tid - 256);
        }
        if (MLSTM || g == 0) {
#pragma unroll
            for (int i = 0; i < 16; ++i) accO[i] = 0.f;
#pragma unroll
            for (int ks = 0; ks < 8; ++ks) { const bf16x8 a = *(const LAS bf16x8*)(qimg0 + (32 * jt + r) * IMG_PITCH + 16 * h5 + 32 * ks), bc = *(const LAS bf16x8*)(lds + MP::CT + g * CT_BYTES + r * CT_PITCH + 32 * ks + 16 * h5); accO = MFMA32(a, bc, accO); }
            if (MLSTM) {
#pragma unroll
                for (int g4 = 0; g4 < 4; ++g4) { const f32x4 pm = *(const LAS f32x4*)((const LAS float*)(lds + MP::TPM) + c * 64 + 32 * jt + 8 * g4 + 4 * h5);
#pragma unroll
                    for (int e = 0; e < 4; ++e) accO[4 * g4 + e] *= __expf(mc - fmaxf(mc, pm[e])); }
            }
        }
    }
    PT_ACC(2, tp);
    MX_BAR();
    PT_ACC(3, tp);
    if (wave < 4) {
        if (MLSTM) { const float decay = __expf(mc - TSC[32 + c]); accC0 = accC0 * decay; accC1 = accC1 * decay; }
        LAS unsigned char* kimg = kimg0 + (8 * h5 + q4) * IMG_PITCH + 64 * wave + 32 * blk + 8 * p4;
        LAS unsigned char* vimg = (MLSTM ? lds + MP::VW : vimg0) + (8 * h5 + q4) * 64 + 32 * blk + 8 * p4;
        LAS unsigned char* vaux = lds + MP::VWAUX + (8 * h5 + q4) * 64 + 32 * blk + 8 * p4;
        { v2u xk[8], xv[8], xa[8];
          tr_issue4<IMG_PITCH>(xk, LDSA(kimg)); tr_issue4<64>(xv, LDSA(vimg)); if (MLSTM) tr_issue4<64>(xa, LDSA(vaux));
          tr_wait8(xk); tr_pin8(xv); if (MLSTM) tr_pin8(xa);
          __builtin_amdgcn_sched_barrier(0);
#pragma unroll
          for (int ks = 0; ks < 4; ++ks) { const bf16x8 a = mk8(xk[2 * ks], xk[2 * ks + 1]);
              accC0 = MFMA32(a, mk8(xv[2 * ks], xv[2 * ks + 1]), accC0);
              if (MLSTM) accC1 = MFMA32(a, mk8(xa[2 * ks], xa[2 * ks + 1]), accC1); } }
        if (!MLSTM) {
#pragma unroll
            for (int g4 = 0; g4 < 4; ++g4) { const f32x4 dc = *(const LAS f32x4*)((const LAS float*)(lds + MP::GDEC) + par * 128 + 32 * wave + 8 * g4 + 4 * h5);
#pragma unroll
                for (int e = 0; e < 4; ++e) accC0[4 * g4 + e] *= dc[e]; }
        }
#pragma unroll
        for (int g4 = 0; g4 < 4; ++g4) { const int d0 = 32 * wave + 8 * g4 + 4 * h5;
            v2u o; o.x = pk_bf16(accC0[4 * g4], accC0[4 * g4 + 1]); o.y = pk_bf16(accC0[4 * g4 + 2], accC0[4 * g4 + 3]); *(LAS v2u*)(lds + MP::CT + r * CT_PITCH + d0 * 2) = o;
            if (MLSTM) { v2u o1; o1.x = pk_bf16(accC1[4 * g4], accC1[4 * g4 + 1]); o1.y = pk_bf16(accC1[4 * g4 + 2], accC1[4 * g4 + 3]); *(LAS v2u*)(lds + MP::CT + CT_BYTES + r * CT_PITCH + d0 * 2) = o1; } }
    } else {
        const int g = (wave - 4) >> 1, jt = wave & 1;
        if (MLSTM || g == 0) {
            const bf16x8 ones = (r == 0) ? (bf16x8){0x3F80, 0x3F80, 0x3F80, 0x3F80, 0x3F80, 0x3F80, 0x3F80, 0x3F80} : (bf16x8){0, 0, 0, 0, 0, 0, 0, 0};
            LAS unsigned char* vimg = vimg0 + (8 * h5 + q4) * 64 + 32 * blk + 8 * p4;
            bf16x8 pa[4];
#pragma unroll
            for (int ks = 0; ks < 4; ++ks) pa[ks] = *(const LAS bf16x8*)(lds + MP::PS + (32 * jt + r) * PS_PITCH + 32 * ks + 16 * h5);
            if (g == 0) { v2u xv[8]; tr_issue4<64>(xv, LDSA(vimg)); tr_wait8(xv); __builtin_amdgcn_sched_barrier(0);
#pragma unroll
                for (int ks = 0; ks < 4; ++ks) accO = MFMA32(pa[ks], mk8(xv[2 * ks], xv[2 * ks + 1]), accO);
            } else {
#pragma unroll
                for (int ks = 0; ks < 4; ++ks) accO = MFMA32(pa[ks], ones, accO); }
            if (MLSTM && g == 0) {
#pragma unroll
                for (int i = 0; i < 16; ++i) ((LAS float*)(lds + MP::NUM))[(32 * jt + (i & 3) + 8 * (i >> 2) + 4 * h5) * NUM_PITCH + r] = accO[i];
            }
            if (MLSTM && g == 1 && r == 0) {
#pragma unroll
                for (int i = 0; i < 16; ++i) ((LAS float*)(lds + MP::DEN))[32 * jt + (i & 3) + 8 * (i >> 2) + 4 * h5] = accO[i];
            }
            if (!MLSTM) mx_store_tile(lds + MP::OUTT + jt * 2048, accO, U.Hg + (size_t)(U.b * SEQ + c * CH + 32 * jt) * D, lane, r, h5);
        }
    }
    PT_ACC(4, tp);
    MX_BAR_VM();
    PT_ACC(5, tp);
}

template <bool MLSTM>
__device__ __forceinline__ void mixer_phase(LAS unsigned char* lds, int tid, int lane, int wave, int vcu, int G, const MixArgs A) {
    typedef MxMap<MLSTM> MP;
    MixDma<MLSTM> dm; mx_dma_setup<MLSTM>(dm, wave, lane, A.qpitch);
    unsigned pt[8] = {0u, 0u, 0u, 0u, 0u, 0u, 0u, 0u}; unsigned long long tph = PROBE_T ? PT_NOW() : 0ull; unsigned long long tin = tph;
    for (int unit = vcu; unit < BATCH * NH * 8; unit += G) {
        const int slice = unit & 7, bh = unit >> 3;
        MixUnit U; U.b = bh >> 2; U.hh = bh & 3; U.qpitch = A.qpitch; U.gdec = A.gdec;
        U.Qg = A.q + (size_t)U.b * BBLK_E + U.hh * DK; U.Kg = A.k + (size_t)U.b * BBLK_E + U.hh * DK; U.Vg = A.proj + (size_t)U.b * BBLK_E + 1024 + U.hh * DV + 32 * slice; U.Hg = A.hun + U.hh * DV + 32 * slice;
        MX_BAR_VM();
        mx_dma_issue<MLSTM>(lds, dm, U, 0, wave, tid);
        for (int i = tid; i < 2 * CT_BYTES / 4; i += NTHREADS) ((LAS unsigned*)(lds + MP::CT))[i] = 0u;
        if (MLSTM) {
            for (int i = tid; i < 1024; i += NTHREADS) ((LAS unsigned*)(lds + MP::VWAUX))[i] = 0u;
            LAS float* TB = (LAS float*)(lds + MP::TB); LAS float* TWP = (LAS float*)(lds + MP::TWP); LAS float* TPM = (LAS float*)(lds + MP::TPM); LAS float* TSC = (LAS float*)(lds + MP::TSC);
            const float bgi = A.bgate[U.hh], bgf = A.bgate[4 + U.hh];
            float gi4[4], gf4[4];
#pragma unroll
            for (int cc = 0; cc < 4; ++cc) { const size_t tok = (size_t)U.b * SEQ + (wave + 8 * cc) * CH + lane; gi4[cc] = A.gates[tok * 16 + U.hh] + bgi; gf4[cc] = A.gates[tok * 16 + 4 + U.hh] + bgf; }
#pragma unroll
            for (int cc = 0; cc < 4; ++cc) { const int c = wave + 8 * cc;
                const float lf = fminf(gf4[cc], 0.f) - __logf(1.0f + __expf(-fabsf(gf4[cc])));
                float bsum = lf;
#pragma unroll
                for (int o = 1; o < 64; o <<= 1) { const float t = __shfl_up(bsum, o); if (lane >= o) bsum += t; }
                const float wp = gi4[cc] - bsum; float pm = wp;
#pragma unroll
                for (int o = 1; o < 64; o <<= 1) { const float t = __shfl_up(pm, o); if (lane >= o) pm = fmaxf(pm, t); }
                TB[c * 64 + lane] = bsum; TWP[c * 64 + lane] = wp; TPM[c * 64 + lane] = pm;
                if (lane == 63) { TSC[64 + c] = bsum; TSC[96 + c] = pm; } }
            MX_BAR();
            if (wave == 0) {
                const float gl = TSC[64 + (lane & 31)], pl = TSC[96 + (lane & 31)]; float m = 0.f, myM = 0.f, myX = 0.f;
#pragma clang loop unroll(disable)
                for (int c = 0; c < NCH; ++c) { const float gc = __uint_as_float(__builtin_amdgcn_readlane(__float_as_uint(gl), c)), pc = __uint_as_float(__builtin_amdgcn_readlane(__float_as_uint(pl), c));
                    const float mxe = fmaxf(m, pc); if (lane == c) { myM = m; myX = mxe; } m = gc + mxe; }
                if (lane < 32) { TSC[lane] = myM; TSC[32 + lane] = myX; }
            }
        }
        f32x16 accC0, accC1, accO;
#pragma unroll
        for (int i = 0; i < 16; ++i) { accC0[i] = 0.f; accC1[i] = 0.f; accO[i] = 0.f; }
        MX_BAR_VM();
        PT_ACC(1, tin);
#pragma clang loop unroll(disable)
        for (int c = 0; c < NCH; ++c) mx_step<MLSTM>(lds, dm, U, c, accC0, accC1, accO, tid, lane, wave, pt);
        if (MLSTM && wave >= 4) mx_finalize_mlstm(lds, U, NCH - 1, tid - 256);
    }
    MX_BAR_VM();
    if (PROBE_T && (PROBE_T_MLSTM != 0) == MLSTM && vcu == 0 && wave == PROBE_T_WAVE && lane == 0) { PT_ACC(0, tph); unsigned* pw = (unsigned*)A.probe; pw[0] = pt[PROBE_T_A]; pw[1] = pt[PROBE_T_B]; }
}

constexpr int N_PHASES = 15, RT_OFF = RING_BYTES;
template <int PH>
__device__ __forceinline__ void run_phase(const Args& args, LAS unsigned char* lds, int tid, int lane, int wave, int vcu, int G, int bx) {
    unsigned char* ws = args.ws;
    constexpr int layer = (PH >= 8) ? 1 : 0, k = (PH == 0) ? -1 : PH - 1 - 7 * layer;
    unsigned char* wl = ws + (size_t)layer * WS_WLAYER;
    bf16* AOP = (bf16*)(ws + WS_AOP); bf16* PROJ = (bf16*)(ws + WS_PROJ); bf16* HMID = (bf16*)(ws + WS_HMID); bf16* XRES = (bf16*)(ws + WS_XRES);
    float* GATES = (float*)(ws + WS_GATES); float* SUMSQ = (float*)(ws + WS_SUMSQ);
    LAS float* RT = (LAS float*)(lds + RT_OFF);
    if constexpr (k == -1) {
        PP_STAMP(30); convert_weights(lds, lane, wave, vcu, G, args, ws); PP_STAMP(31);
        rows_first(lds, tid, lane, wave, vcu, G, args.in[0], args.in[1], XRES, SUMSQ, args.in[4] + NPROJ, MLSTM_IN, 8, GATES);
    } else if constexpr (k == 0) {
        pg8::Gemm g{XRES, (const bf16*)(wl + WS_WIN), M, NPROJ, D}; pg8::StaticOrder S; S.init(M, NPROJ, G, bx);
        const RstdSlots rs = rstd_table(RT, SUMSQ, S, tid);
        pg8::EpiBf16S<0> E{PROJ, NPROJ, (const LAS float*)RT, rs.pm1, rs.pm2, rs.pm3, BBLK_E};
        pg8::gemm_phase<pg8::EpiBf16S<0>, pg8::StaticOrder, true, true>(lds, g, S, E);
    } else if constexpr (k == 1) {
        if (layer) gla_prep(lds, tid, lane, wave, vcu, G, PROJ, XRES, SUMSQ, args.in[8], args.in[1] + D, args.in[9], args.in[10], (bf16*)(ws + WS_PROJ + WS_QT_OFF), (bf16*)(ws + WS_PROJ + WS_KT_OFF), (float*)(ws + WS_GDEC));
    } else if constexpr (k == 2) {
        if (layer == 0) { const MixArgs A{PROJ, PROJ + QKW, PROJ, NPROJ, GATES, args.in[5], nullptr, AOP, ws + WS_CTL + 4 * CW_PROBE}; mixer_phase<true>(lds, tid, lane, wave, vcu, G, A); }
        else { const MixArgs A{(const bf16*)(ws + WS_PROJ + WS_QT_OFF), (const bf16*)(ws + WS_PROJ + WS_KT_OFF), PROJ, QKW, nullptr, nullptr, (const float*)(ws + WS_GDEC), AOP, ws + WS_CTL + 4 * CW_PROBE}; mixer_phase<false>(lds, tid, lane, wave, vcu, G, A); }
    } else if constexpr (k == 3) {
        head_norm_rows(lane, wave, vcu, G, AOP, args.in[layer ? 11 : 6], PROJ, AOP, layer != 0);
    } else if constexpr (k == 4) {
        pg8::Gemm g{AOP, (const bf16*)(wl + WS_WOUT), M, D, D}; pg8::StaticOrder S; S.init(M, D, G, bx);
        pg8::EpiResBf16Sq E{XRES, SUMSQ, D};
        pg8::gemm_phase<pg8::EpiResBf16Sq, pg8::StaticOrder, false, true>(lds, g, S, E);
    } else if constexpr (k == 5) {
        pg8::Gemm g{XRES, (const bf16*)(wl + WS_W1), M, FF, D}; pg8::StaticOrder S; S.init(M, FF, G, bx);
        const RstdSlots rs = rstd_table(RT, SUMSQ, S, tid);
        pg8::EpiBf16S<2> E{HMID, FF, (const LAS float*)RT, rs.pm1, rs.pm2, rs.pm3, (size_t)2048 * FF};
        pg8::gemm_phase<pg8::EpiBf16S<2>, pg8::StaticOrder, true, true>(lds, g, S, E);
    } else if constexpr (k == 6 && layer == 0) {
        pg8::Gemm g{HMID, (const bf16*)(wl + WS_W2), M, D, FF}; pg8::StaticOrder S; S.init(M, D, G, bx);
        pg8::EpiResBf16Sq E{XRES, SUMSQ, D};
        pg8::gemm_phase<pg8::EpiResBf16Sq, pg8::StaticOrder, false, true>(lds, g, S, E);
    } else if constexpr (k == 6) {
        pg8::Gemm g{HMID, (const bf16*)(wl + WS_W2), M, D, FF}; pg8::StaticOrder S; S.init(M, D, G, bx);
        pg8::EpiFinalNorm E{XRES, args.out, SUMSQ, (unsigned*)(ws + WS_CTL) + CW_FIN, args.in[3], D, EPS};
        pg8::gemm_phase<pg8::EpiFinalNorm, pg8::StaticOrder, false, true>(lds, g, S, E);
    }
}
__device__ __forceinline__ void group_sync(unsigned* ctl, volatile LAS unsigned* st, unsigned per_epoch) {
    asm volatile("s_waitcnt vmcnt(0)" ::: "memory");
    __syncthreads();
    if (threadIdx.x == 0) {
        unsigned* cnt = ctl + st[0]; const unsigned target = per_epoch * (st[1] + 1u); st[1] = st[1] + 1u;
        xb_add(cnt, 1u);
        unsigned sp = 0; while (xb_ld(cnt) < target && ++sp < (1u << 22)) __builtin_amdgcn_s_sleep(1);
        __builtin_amdgcn_fence(__ATOMIC_ACQUIRE, "agent");
        asm volatile("s_waitcnt vmcnt(0)" ::: "memory");
    }
    __syncthreads();
}
__global__ void __launch_bounds__(NTHREADS, 2) fwd_kernel(Args args) {
    extern __shared__ __attribute__((aligned(16))) unsigned char lds_raw[];
    LAS unsigned char* lds = (LAS unsigned char*)lds_raw;
    volatile LAS unsigned* MISC = (volatile LAS unsigned*)(lds + MISC_OFF);
    const int tid = threadIdx.x, lane = tid & 63, wave = __builtin_amdgcn_readfirstlane(tid >> 6);
    const int G = gridDim.x; int bx = blockIdx.x; int vcu = (G % 8 == 0) ? (bx % 8) * (G / 8) + bx / 8 : bx;
    for (int u = tid; u < (LDS_BYTES - LDSCTL_OFF) / 4; u += NTHREADS) ((LAS unsigned*)(lds + LDSCTL_OFF))[u] = 0u;
    __syncthreads();
    const int lo = args.ph_lo, hi = args.ph_hi;
    XcdBarrier bar; bar.bar = (unsigned*)(args.ws + WS_CTL) + CW_BAR; bar.x = 0; bar.st = nullptr;
    if (hi - lo > 1) { bar = xcd_barrier_post((unsigned*)(args.ws + WS_CTL) + CW_BAR, MISC + 8);
        if (tid == 0) { const unsigned xcc = xb_xcc_id(); MISC[16] = xcc; MISC[17] = xb_add((unsigned*)(args.ws + WS_CTL) + CW_XID + 64 * xcc, 1u); } }
#ifndef PROBE_PH
#define PROBE_PH (-1)
#endif
#ifndef PROBE_N
#define PROBE_N 0
#endif
#define PHASE(p) if (lo <= (p) && (p) < hi) { PP_STAMP(2 * (p)); run_phase<p>(args, lds, tid, lane, wave, vcu, G, bx); PP_STAMP(2 * (p) + 1); \
        if ((p) == PROBE_PH) { for (int rep_ = 0; rep_ < PROBE_N; ++rep_) { xcd_barrier(bar); if (PROBE_PH >= 0) run_phase<((p) == PROBE_PH ? (p) : 2)>(args, lds, tid, lane, wave, vcu, G, bx); } } \
        if ((p) + 1 < hi && (p) != 2) { if (MISC[20] != 0u && ((p) == 5 || (p) == 6 || (p) == 12 || (p) == 13)) { group_sync((unsigned*)(args.ws + WS_CTL), MISC + 22, 4u); } \
            else if (MISC[20] != 0u && (p) > 0) { group_sync((unsigned*)(args.ws + WS_CTL), MISC + 24, 32u); } else xcd_barrier(bar); } }
    PHASE(0)
    if (lo == 0 && hi > 1) {
        bool ok = (G == 256);
#pragma unroll
        for (unsigned j = 0; j < 16; ++j) { const unsigned cnt = xb_ld(&bar.bar[XB_XCNT(j)]); ok = ok && (cnt == (j < 8 ? 32u : 0u)); }
        const unsigned xcc = MISC[16], idx = MISC[17];
        if (ok && xcc < 8 && idx < 32) { vcu = (int)(xcc * 32 + idx); bx = (int)(idx * 8 + xcc);
            const unsigned pm = 8u * xcc + (idx & 7u);
            if (tid == 0) { MISC[22] = (unsigned)(CW_GRP + 16 * pm); MISC[24] = (unsigned)(CW_XCL + 64 * xcc); MISC[20] = 1u; } }
        __syncthreads();
    }
    PHASE(1) PHASE(2) PHASE(3) PHASE(4) PHASE(5) PHASE(6) PHASE(7) PHASE(8) PHASE(9) PHASE(10) PHASE(11) PHASE(12) PHASE(13) PHASE(14)
#undef PHASE
    if (PROBE_P && hi == N_PHASES && blockIdx.x == 0 && tid == 0) {
        const volatile LAS unsigned* w = (const volatile LAS unsigned*)(lds + LDSCTL_OFF + 512);
        const unsigned va = w[2 * PROBE_P_A + 1] - w[2 * PROBE_P_A];
        const unsigned vb = w[2 * PROBE_P_B + 1] - w[2 * PROBE_P_B];
        const unsigned long long ticks = (unsigned long long)(va / 100u) * 1000ull + (unsigned long long)(vb / 100u) * 100000ull;
        const unsigned long long t0 = PT_NOW(); while (PT_NOW() - t0 < ticks) __builtin_amdgcn_s_sleep(8);
    }
    if (PROBE_T && hi == N_PHASES && vcu == 0 && tid == 0) {
        const unsigned a = xb_ld((unsigned*)(args.ws + WS_CTL) + CW_PROBE), b = xb_ld((unsigned*)(args.ws + WS_CTL) + CW_PROBE + 1);
        const unsigned long long ticks = (unsigned long long)a * 5ull + (unsigned long long)(b / 50u) * 50000ull;
        const unsigned long long t0 = PT_NOW(); while (PT_NOW() - t0 < ticks) __builtin_amdgcn_s_sleep(8);
    }
}

extern "C" void kernel_launch(void* const* d_in, const int* in_sizes, int n_in, void* d_out, int out_size, void* d_ws, size_t ws_size, hipStream_t stream) {
    static int grid = 0;
    if (grid == 0) {
        if (n_in != 15 || in_sizes[0] != M * D || out_size != M * D || ws_size < WS_END) { fprintf(stderr, "kernel_launch: unexpected shapes (n_in %d, in0 %d, out %d, ws %zu); nothing launched\n", n_in, n_in > 0 ? in_sizes[0] : -1, out_size, ws_size); grid = -1; return; }
        int dev = 0, cus = 0, per_cu = 0;
        if (hipGetDevice(&dev) != hipSuccess || hipDeviceGetAttribute(&cus, hipDeviceAttributeMultiprocessorCount, dev) != hipSuccess) { grid = -1; return; }
        if (hipFuncSetAttribute((const void*)fwd_kernel, hipFuncAttributeMaxDynamicSharedMemorySize, LDS_BYTES) != hipSuccess) { fprintf(stderr, "kernel_launch: hipFuncSetAttribute failed\n"); grid = -1; return; }
        if (hipOccupancyMaxActiveBlocksPerMultiprocessor(&per_cu, (const void*)fwd_kernel, NTHREADS, LDS_BYTES) != hipSuccess || per_cu < 1) { fprintf(stderr, "kernel_launch: occupancy query says %d blocks per CU\n", per_cu); (void)hipGetLastError(); grid = -1; return; }
        grid = cus;
    }
    if (grid < 0) return;
    (void)hipMemsetAsync((char*)d_ws + WS_CTL, 0, CTL_ZERO_BYTES, stream);
    Args a{};
    for (int i = 0; i < 15; ++i) a.in[i] = (const float*)d_in[i];
    a.out = (float*)d_out; a.ws = (unsigned char*)d_ws;
    if (MK_N_LAUNCHES == 1) {
        a.ph_lo = 0; a.ph_hi = N_PHASES;
        void* kargs[] = {&a};
        const hipError_t e = hipLaunchCooperativeKernel((const void*)fwd_kernel, dim3(grid), dim3(NTHREADS), kargs, LDS_BYTES, stream);
        if (e != hipSuccess) fprintf(stderr, "kernel_launch: cooperative launch failed: %s (grid %d)\n", hipGetErrorString(e), grid);
    } else {
        for (int p = 0; p < N_PHASES; ++p) { a.ph_lo = p; a.ph_hi = p + 1; hipLaunchKernelGGL(fwd_kernel, dim3(grid), dim3(NTHREADS), LDS_BYTES, stream, a); }
    }
}
```

```cpp
#include <hip/hip_runtime.h>
#include <cstdio>
#include <cstdint>
namespace pg8 {
#define PG8_LAS __attribute__((address_space(3)))
typedef unsigned short bf16_t;
typedef short bf16x8 __attribute__((ext_vector_type(8)));
typedef float f32x4 __attribute__((ext_vector_type(4)));
typedef unsigned u32x4 __attribute__((ext_vector_type(4)));
constexpr int BM = 256, BK = 64, HALF = 128, HTB = HALF * BK * 2  , STAGE_BYTES = 8 * HTB, NXCD = 8, WGM = 8;

__host__ __device__ __forceinline__ int lds_byte(int r, int c) { const int st = (r >> 4) * 2 + (c >> 5), rr = r & 15, cc = c & 31, ob = rr * 64 + cc * 2; return st * 1024 + (ob ^ (((ob >> 9) & 1) << 5)); }
__host__ __device__ __forceinline__ void stage_rc(int b, int& R, int& C) { const int st = b / 1024, sb = b % 1024, swz = sb ^ (((sb >> 9) & 1) << 5); R = (st >> 1) * 16 + swz / 64; C = (st & 1) * 32 + (swz % 64) / 2; }
__host__ __device__ __forceinline__ int perm32(int rho) { const int n = rho >> 4, i = rho & 15; return 8 * (i >> 2) + 4 * n + (i & 3); }

struct Unit { int pm, pn; };
struct Gemm { const bf16_t* A; const bf16_t* Bt; int M, N, K; };

struct StaticOrder {
    int nM, nN, nwg, G, c;
    __host__ __device__ __forceinline__ void init(int M, int N, int G_, int c_) { nM = M / BM; nN = N / BM; nwg = nM * nN; G = G_; c = c_; }
    __host__ __device__ __forceinline__ bool next(int i, Unit& u) const {
        const long L = (long)i * G + c; if (L >= nwg) return false;
        int wgid = (int)L; { const int q = nwg / NXCD, r = nwg % NXCD, xcd = wgid % NXCD, off = wgid / NXCD; wgid = (xcd < r ? xcd * (q + 1) : r * (q + 1) + (xcd - r) * q) + off; }
        const int nig = WGM * nN, gid = wgid / nig, fm = gid * WGM, gsz = (nM - fm) < WGM ? (nM - fm) : WGM;
        u.pm = fm + ((wgid % nig) % gsz); u.pn = (wgid % nig) / gsz; return true;
    }
    __device__ __forceinline__ void a_ready(const Unit&) const {}
    __device__ __forceinline__ void done(const Unit&) const {}
};

__device__ __forceinline__ unsigned cvt_pk_bf16(float lo, float hi) { unsigned r; asm volatile("v_cvt_pk_bf16_f32 %0, %1, %2" : "=v"(r) : "v"(lo), "v"(hi)); return r; }
typedef float f32x2 __attribute__((ext_vector_type(2)));
typedef __bf16 bf16x2_t __attribute__((ext_vector_type(2)));
__device__ __forceinline__ unsigned pk_bf16(float lo, float hi) { f32x2 v = {lo, hi}; bf16x2_t r = __builtin_convertvector(v, bf16x2_t); return __builtin_bit_cast(unsigned, r); }
template <int ACT  > struct EpiBf16 {
    static constexpr bool PERM = true, AFTER_DRAIN = false;
    bf16_t* O; int ldc;
    __device__ __forceinline__ void operator()(const f32x4 (&acc)[2][2][4][2], const Unit& u, int wr, int wc, int fr, int fq) const {
        const int row0 = u.pm * BM + wr * 64 + fr, col0 = u.pn * BM + wc * 32 + 8 * fq;
#pragma unroll
        for (int ai = 0; ai < 2; ++ai)
#pragma unroll
            for (int m = 0; m < 4; ++m) { bf16_t* rowp = O + (size_t)(row0 + ai * HALF + m * 16) * ldc + col0;
#pragma unroll
                for (int bj = 0; bj < 2; ++bj) { f32x4 v0 = acc[ai][bj][m][0], v1 = acc[ai][bj][m][1];
                    if (ACT == 2) { const f32x4 z = {0.f, 0.f, 0.f, 0.f}; v0 = __builtin_elementwise_max(v0, z); v1 = __builtin_elementwise_max(v1, z); v0 = v0 * v0; v1 = v1 * v1; }
                    u32x4 w; w.x = pk_bf16(v0[0], v0[1]); w.y = pk_bf16(v0[2], v0[3]); w.z = pk_bf16(v1[0], v1[1]); w.w = pk_bf16(v1[2], v1[3]);
                    *(u32x4*)(rowp + bj * HALF) = w; } }
    }
};
struct EpiResF32 {
    static constexpr bool PERM = false, AFTER_DRAIN = true;
    const float* base; float* out; int ldc;
    __device__ __forceinline__ void fused(const f32x4 (&acc)[2][2][4][2], const Unit& u, int wr, int wc, int fr, int fq, PG8_LAS unsigned char*, int, int) const {
        const int col0 = u.pn * BM + wc * 32 + 4 * fq;
#pragma unroll
        for (int ai = 0; ai < 2; ++ai)
#pragma unroll
            for (int m = 0; m < 4; ++m) { const int r = ai * HALF + wr * 64 + m * 16 + fr; const size_t off = (size_t)(u.pm * BM + r) * ldc + col0;
#pragma unroll
                for (int bj = 0; bj < 2; ++bj) { const f32x4 b0 = *(const f32x4*)(base + off + bj * HALF), b1 = *(const f32x4*)(base + off + bj * HALF + 16);
                    *(f32x4*)(out + off + bj * HALF) = b0 + acc[ai][bj][m][0]; *(f32x4*)(out + off + bj * HALF + 16) = b1 + acc[ai][bj][m][1];
                    asm volatile("" ::: "memory"); } }
    }
};
typedef unsigned u32x2 __attribute__((ext_vector_type(2)));
__device__ __forceinline__ float bf_lo(unsigned w) { return __builtin_bit_cast(float, w << 16); }
__device__ __forceinline__ float bf_hi(unsigned w) { return __builtin_bit_cast(float, w & 0xffff0000u); }
template <int ACT  > struct EpiBf16S {
    static constexpr bool PERM = true, AFTER_DRAIN = false;
    bf16_t* O; int ldc; const PG8_LAS float* rt; int pm1, pm2, pm3; size_t bstride;
    __device__ __forceinline__ void operator()(const f32x4 (&acc)[2][2][4][2], const Unit& u, int wr, int wc, int fr, int fq) const {
        const int col0 = u.pn * BM + wc * 32 + 8 * fq;
        const PG8_LAS float* rtp = rt + ((u.pm == pm1) ? 256 : (u.pm == pm2) ? 512 : (u.pm == pm3) ? 768 : 0) + wr * 64 + fr;
#pragma unroll
        for (int ai = 0; ai < 2; ++ai)
#pragma unroll
            for (int m = 0; m < 4; ++m) { const float rs = rtp[ai * HALF + m * 16];
                bf16_t* rowp = O + (size_t)(u.pm >> 3) * bstride + (size_t)((u.pm & 7) * BM + ai * HALF + wr * 64 + m * 16 + fr) * ldc + col0;
#pragma unroll
                for (int bj = 0; bj < 2; ++bj) { f32x4 v0 = acc[ai][bj][m][0] * rs, v1 = acc[ai][bj][m][1] * rs;
                    if (ACT == 2) { const f32x4 z = {0.f, 0.f, 0.f, 0.f}; v0 = __builtin_elementwise_max(v0, z); v1 = __builtin_elementwise_max(v1, z); v0 = v0 * v0; v1 = v1 * v1; }
                    u32x4 w; w.x = pk_bf16(v0[0], v0[1]); w.y = pk_bf16(v0[2], v0[3]); w.z = pk_bf16(v1[0], v1[1]); w.w = pk_bf16(v1[2], v1[3]);
                    *(u32x4*)(rowp + bj * HALF) = w; } }
    }
};
struct EpiResBf16Sq {
    static constexpr bool PERM = false, AFTER_DRAIN = true;
    bf16_t* xres; float* sumsq; int ldc;
    __device__ __forceinline__ void fused(f32x4 (&acc)[2][2][4][2], const Unit& u, int wr, int wc, int fr, int fq, PG8_LAS unsigned char* lds, int wid, int lane) const {
        PG8_LAS float* P = (PG8_LAS float*)lds;
        const int col0 = u.pn * BM + wc * 32 + 4 * fq;
#pragma unroll
        for (int ai = 0; ai < 2; ++ai)
#pragma unroll
            for (int m = 0; m < 4; ++m) { const int r = ai * HALF + wr * 64 + m * 16 + fr; bf16_t* xp = xres + (size_t)(u.pm * BM + r) * ldc + col0; float ss = 0.f;
#pragma unroll
                for (int bj = 0; bj < 2; ++bj)
#pragma unroll
                    for (int n = 0; n < 2; ++n) { const u32x2 xb = *(const u32x2*)(xp + bj * HALF + n * 16); const f32x4 a = acc[ai][bj][m][n];
                        u32x2 w; w.x = pk_bf16(bf_lo(xb.x) + a[0], bf_hi(xb.x) + a[1]); w.y = pk_bf16(bf_lo(xb.y) + a[2], bf_hi(xb.y) + a[3]);
                        *(u32x2*)(xp + bj * HALF + n * 16) = w;
                        const float y0 = bf_lo(w.x), y1 = bf_hi(w.x), y2 = bf_lo(w.y), y3 = bf_hi(w.y); ss += (y0 * y0 + y1 * y1) + (y2 * y2 + y3 * y3); }
                ss += __shfl_xor(ss, 16); ss += __shfl_xor(ss, 32);
                if (fq == 0) P[r * 4 + wc] = ss;
                asm volatile("" ::: "memory"); }
        asm volatile("s_waitcnt lgkmcnt(0)" ::: "memory"); __builtin_amdgcn_s_barrier(); asm volatile("" ::: "memory");
        const int t = wid * 64 + lane;
        if (t < 256) { const f32x4 p = *(const PG8_LAS f32x4*)(P + t * 4); sumsq[(size_t)(u.pm * BM + t) * 4 + u.pn] = (p[0] + p[1]) + (p[2] + p[3]); }
    }
};
struct EpiFinalNorm {
    static constexpr bool PERM = false, AFTER_DRAIN = true;
    const bf16_t* xres; float* out; float* sumsq; unsigned* cnt; const float* gain; int ldc; float eps;
    __device__ __forceinline__ void fused(f32x4 (&acc)[2][2][4][2], const Unit& u, int wr, int wc, int fr, int fq, PG8_LAS unsigned char* lds, int wid, int lane) const {
        PG8_LAS float* P = (PG8_LAS float*)lds;
        PG8_LAS float* S = (PG8_LAS float*)(lds + 4096);
        const int col0 = u.pn * BM + wc * 32 + 4 * fq, t = wid * 64 + lane;
#pragma unroll
        for (int ai = 0; ai < 2; ++ai)
#pragma unroll
            for (int m = 0; m < 4; ++m) { const int r = ai * HALF + wr * 64 + m * 16 + fr; const bf16_t* xp = xres + (size_t)(u.pm * BM + r) * ldc + col0; float ss = 0.f;
#pragma unroll
                for (int bj = 0; bj < 2; ++bj)
#pragma unroll
                    for (int n = 0; n < 2; ++n) { const u32x2 xb = *(const u32x2*)(xp + bj * HALF + n * 16); f32x4 y = acc[ai][bj][m][n];
                        y[0] += bf_lo(xb.x); y[1] += bf_hi(xb.x); y[2] += bf_lo(xb.y); y[3] += bf_hi(xb.y); acc[ai][bj][m][n] = y; ss += (y[0] * y[0] + y[1] * y[1]) + (y[2] * y[2] + y[3] * y[3]); }
                ss += __shfl_xor(ss, 16); ss += __shfl_xor(ss, 32);
                if (fq == 0) P[r * 4 + wc] = ss;
                asm volatile("" ::: "memory"); }
        asm volatile("s_waitcnt lgkmcnt(0)" ::: "memory"); __builtin_amdgcn_s_barrier(); asm volatile("" ::: "memory");
        if (t < 256) { const f32x4 p = *(const PG8_LAS f32x4*)(P + t * 4); __hip_atomic_store(sumsq + (size_t)(u.pm * BM + t) * 4 + u.pn, (p[0] + p[1]) + (p[2] + p[3]), __ATOMIC_RELAXED, __HIP_MEMORY_SCOPE_AGENT); }
        asm volatile("s_waitcnt vmcnt(0)" ::: "memory"); __builtin_amdgcn_s_barrier(); asm volatile("" ::: "memory");
        if (t == 0) {
            __hip_atomic_fetch_add(cnt + 16 * u.pm, 1u, __ATOMIC_RELAXED, __HIP_MEMORY_SCOPE_AGENT);
            unsigned sp = 0;
            while (__hip_atomic_load(cnt + 16 * u.pm, __ATOMIC_RELAXED, __HIP_MEMORY_SCOPE_AGENT) < 4u && ++sp < (1u << 22)) __builtin_amdgcn_s_sleep(2);
            __builtin_amdgcn_fence(__ATOMIC_ACQUIRE, "agent");
        }
        asm volatile("s_waitcnt vmcnt(0) lgkmcnt(0)" ::: "memory"); __builtin_amdgcn_s_barrier(); asm volatile("" ::: "memory");
        if (t < 256) { float s4 = 0.f;
#pragma unroll
            for (int q = 0; q < 4; ++q) s4 += __hip_atomic_load(sumsq + (size_t)(u.pm * BM + t) * 4 + q, __ATOMIC_RELAXED, __HIP_MEMORY_SCOPE_AGENT);
            S[t] = 1.0f / sqrtf(s4 / (float)ldc + eps); }
        asm volatile("s_waitcnt lgkmcnt(0)" ::: "memory"); __builtin_amdgcn_s_barrier(); asm volatile("" ::: "memory");
        f32x4 gv[2][2];
#pragma unroll
        for (int bj = 0; bj < 2; ++bj)
#pragma unroll
            for (int n = 0; n < 2; ++n) gv[bj][n] = *(const f32x4*)(gain + col0 + bj * HALF + n * 16);
#pragma unroll
        for (int ai = 0; ai < 2; ++ai)
#pragma unroll
            for (int m = 0; m < 4; ++m) { const int r = ai * HALF + wr * 64 + m * 16 + fr; const float rs = S[r]; float* op = out + (size_t)(u.pm * BM + r) * ldc + col0;
#pragma unroll
                for (int bj = 0; bj < 2; ++bj)
#pragma unroll
                    for (int n = 0; n < 2; ++n) *(f32x4*)(op + bj * HALF + n * 16) = acc[ai][bj][m][n] * rs * gv[bj][n]; }
    }
};
template <class Epi, class Sched, bool ALIGN_EPI = false, bool SP2 = false>
__device__ __forceinline__ void gemm_phase(PG8_LAS unsigned char* lds, const Gemm g, const Sched& S, const Epi& E) {
    const int tid = threadIdx.x, wid = __builtin_amdgcn_readfirstlane(tid >> 6), lane = tid & 63, wr = wid >> 2, wc = wid & 3, fr = lane & 15, fq = lane >> 4;
    const int K = g.K, nt = K / BK;
    unsigned voffA[2], voffB[2];
#pragma unroll
    for (int i = 0; i < 2; ++i) { int R, C; stage_rc(tid * 16 + i * 8192, R, C); const int Rb = Epi::PERM ? ((R & ~31) + perm32(R & 31)) : R;
        voffA[i] = (unsigned)(R * K + C) * 2u; voffB[i] = (unsigned)(Rb * K + C) * 2u; }
    const size_t kstep = (size_t)(BK * 2);
    const size_t hstep = (size_t)HALF * K * 2;
    const size_t tstep = 2 * hstep;
    const unsigned ldsw = (unsigned)wid * 1024u;
    const int aoff = lds_byte(wr * 64 + fr, fq * 8), boff = lds_byte(wc * 32 + fr, fq * 8);
#define PG8_SA(b, h) (((b) * 2 + (h)) * HTB)
#define PG8_SB(b, h) ((4 + (b) * 2 + (h)) * HTB)
#define PG8_STAGE(bufoff, gbase, voff) do { _Pragma("unroll") for (int _i = 0; _i < 2; ++_i) \
        __builtin_amdgcn_global_load_lds((const unsigned*)((const char*)(gbase) + (voff)[_i]), (PG8_LAS unsigned*)(lds + (bufoff) + ldsw + _i * 8192), 16, 0, 0); } while (0)
#define PG8_LDA(dst, b, h) do { _Pragma("unroll") for (int m = 0; m < 4; ++m) _Pragma("unroll") for (int k = 0; k < 2; ++k) dst[m][k] = *(const PG8_LAS bf16x8*)(lds + PG8_SA(b, h) + aoff + m * 2048 + k * 1024); } while (0)
#define PG8_LDB(dst, b, h) do { _Pragma("unroll") for (int n = 0; n < 2; ++n) _Pragma("unroll") for (int k = 0; k < 2; ++k) dst[n][k] = *(const PG8_LAS bf16x8*)(lds + PG8_SB(b, h) + boff + n * 2048 + k * 1024); } while (0)
#define PG8_MMA(ai, bj, At, Bt) do { __builtin_amdgcn_s_setprio(1); _Pragma("unroll") for (int m = 0; m < 4; ++m) _Pragma("unroll") for (int n = 0; n < 2; ++n) _Pragma("unroll") for (int k = 0; k < 2; ++k) \
        acc[ai][bj][m][n] = __builtin_amdgcn_mfma_f32_16x16x32_bf16(Bt[n][k], At[m][k], acc[ai][bj][m][n], 0, 0, 0); __builtin_amdgcn_s_setprio(0); } while (0)
#define PG8_WAIT_V(n) asm volatile("s_waitcnt vmcnt(" #n ")" ::: "memory")
#define PG8_WAIT_L(n) asm volatile("s_waitcnt lgkmcnt(" #n ")" ::: "memory")
#define PG8_BAR __builtin_amdgcn_s_barrier()
#define PG8_SCHED __builtin_amdgcn_sched_barrier(0)
    Unit cur, nxt; int ui = 0;
    if (!S.next(0, cur)) return;
    f32x4 acc[2][2][4][2];
#pragma unroll
    for (int a = 0; a < 2; ++a)
#pragma unroll
        for (int b = 0; b < 2; ++b)
#pragma unroll
            for (int m = 0; m < 4; ++m)
#pragma unroll
                for (int n = 0; n < 2; ++n) acc[a][b][m][n] = (f32x4){0.f, 0.f, 0.f, 0.f};
    bf16x8 At[4][2], B0[2][2], B1[2][2];
    const char* cA = (const char*)g.A + (size_t)cur.pm * tstep; const char* cB = (const char*)g.Bt + (size_t)cur.pn * tstep;
    S.a_ready(cur);
    if constexpr (SP2) {
        PG8_STAGE(PG8_SB(0, 0), cB, voffB); PG8_STAGE(PG8_SB(0, 1), cB + hstep, voffB); PG8_STAGE(PG8_SA(0, 0), cA, voffA); PG8_STAGE(PG8_SA(0, 1), cA + hstep, voffA);
        if (wr == 1) PG8_BAR;
        PG8_WAIT_V(2); PG8_BAR;
        PG8_STAGE(PG8_SB(1, 0), cB + kstep, voffB); PG8_STAGE(PG8_SA(1, 0), cA + kstep, voffA); PG8_STAGE(PG8_SB(1, 1), cB + hstep + kstep, voffB);
        PG8_WAIT_V(6); PG8_BAR;
    } else {
        PG8_STAGE(PG8_SB(0, 0), cB, voffB); PG8_STAGE(PG8_SA(0, 0), cA, voffA); PG8_STAGE(PG8_SB(0, 1), cB + hstep, voffB); PG8_STAGE(PG8_SA(0, 1), cA + hstep, voffA);
        if (wr == 1) PG8_BAR;
        PG8_WAIT_V(4); PG8_BAR;
        PG8_STAGE(PG8_SB(1, 0), cB + kstep, voffB); PG8_STAGE(PG8_SA(1, 0), cA + kstep, voffA); PG8_STAGE(PG8_SB(1, 1), cB + hstep + kstep, voffB);
        PG8_WAIT_V(6); PG8_BAR;
    }
    for (;;) {
        const bool has_next = S.next(ui + 1, nxt);
        const char* nA = has_next ? (const char*)g.A + (size_t)nxt.pm * tstep : cA; const char* nB = has_next ? (const char*)g.Bt + (size_t)nxt.pn * tstep : cB;
        for (int t = 0; t < nt; t += 2) {
            const bool last = (t == nt - 2);
            const char* a1 = cA + (size_t)(t + 1) * kstep;
            const char* a2 = last ? nA : cA + (size_t)(t + 2) * kstep; const char* b2 = last ? nB : cB + (size_t)(t + 2) * kstep;
            const char* a3 = a2 + kstep; const char* b3 = b2 + kstep;
            if (last && has_next) S.a_ready(nxt);
            if constexpr (SP2) {
            PG8_LDB(B0, 0, 0); PG8_LDB(B1, 0, 1); PG8_SCHED; PG8_LDA(At, 0, 0); PG8_STAGE(PG8_SA(1, 1), a1 + hstep, voffA);
            PG8_WAIT_V(8); PG8_WAIT_L(0); PG8_BAR; PG8_MMA(0, 0, At, B0); PG8_MMA(0, 1, At, B1); PG8_BAR; PG8_SCHED;
            PG8_LDA(At, 0, 1); PG8_STAGE(PG8_SB(0, 0), b2, voffB); PG8_STAGE(PG8_SB(0, 1), b2 + hstep, voffB); PG8_STAGE(PG8_SA(0, 0), a2, voffA);
            PG8_WAIT_V(8); PG8_WAIT_L(0); PG8_BAR; PG8_MMA(1, 0, At, B0); PG8_MMA(1, 1, At, B1); PG8_BAR; PG8_SCHED;
            PG8_LDB(B0, 1, 0); PG8_LDB(B1, 1, 1); PG8_SCHED; PG8_LDA(At, 1, 0); PG8_STAGE(PG8_SA(0, 1), a2 + hstep, voffA);
            PG8_WAIT_V(8); PG8_WAIT_L(0); PG8_BAR; PG8_MMA(0, 0, At, B0); PG8_MMA(0, 1, At, B1); PG8_BAR; PG8_SCHED;
            PG8_LDA(At, 1, 1); PG8_STAGE(PG8_SB(1, 0), b3, voffB); PG8_STAGE(PG8_SB(1, 1), b3 + hstep, voffB); PG8_STAGE(PG8_SA(1, 0), a3, voffA);
            PG8_WAIT_V(8); PG8_WAIT_L(0); PG8_BAR; PG8_MMA(1, 0, At, B0); PG8_MMA(1, 1, At, B1); PG8_BAR; PG8_SCHED;
            } else {
            PG8_LDB(B0, 0, 0); PG8_SCHED; PG8_LDA(At, 0, 0); PG8_STAGE(PG8_SA(1, 1), a1 + hstep, voffA);
            PG8_WAIT_L(8); PG8_BAR; PG8_WAIT_L(0); PG8_MMA(0, 0, At, B0); PG8_BAR; PG8_SCHED;
            PG8_LDB(B1, 0, 1); PG8_STAGE(PG8_SB(0, 0), b2, voffB);
            PG8_BAR; PG8_WAIT_L(0); PG8_MMA(0, 1, At, B1); PG8_BAR;
            PG8_LDA(At, 0, 1); PG8_STAGE(PG8_SA(0, 0), a2, voffA);
            PG8_BAR; PG8_WAIT_L(0); PG8_MMA(1, 0, At, B0); PG8_BAR; PG8_SCHED;
            PG8_STAGE(PG8_SB(0, 1), b2 + hstep, voffB);
            PG8_WAIT_V(6); PG8_BAR; PG8_MMA(1, 1, At, B1); PG8_BAR;
            PG8_LDB(B0, 1, 0); PG8_SCHED; PG8_LDA(At, 1, 0); PG8_STAGE(PG8_SA(0, 1), a2 + hstep, voffA);
            PG8_WAIT_L(8); PG8_BAR; PG8_WAIT_L(0); PG8_MMA(0, 0, At, B0); PG8_BAR; PG8_SCHED;
            PG8_LDB(B1, 1, 1); PG8_STAGE(PG8_SB(1, 0), b3, voffB);
            PG8_BAR; PG8_WAIT_L(0); PG8_MMA(0, 1, At, B1); PG8_BAR;
            PG8_LDA(At, 1, 1); PG8_STAGE(PG8_SA(1, 0), a3, voffA);
            PG8_BAR; PG8_WAIT_L(0); PG8_MMA(1, 0, At, B0); PG8_BAR; PG8_SCHED;
            PG8_STAGE(PG8_SB(1, 1), b3 + hstep, voffB);
            PG8_WAIT_V(6); PG8_BAR; PG8_MMA(1, 1, At, B1); PG8_BAR;
            }
        }
        if constexpr (ALIGN_EPI) { if (wr == 0) PG8_BAR; }
        if constexpr (!Epi::AFTER_DRAIN) { E(acc, cur, wr, wc, fr, fq); S.done(cur); }
        if (!has_next) break;
#pragma unroll
        for (int a = 0; a < 2; ++a)
#pragma unroll
            for (int b = 0; b < 2; ++b)
#pragma unroll
                for (int m = 0; m < 4; ++m)
#pragma unroll
                    for (int n = 0; n < 2; ++n) acc[a][b][m][n] = (f32x4){0.f, 0.f, 0.f, 0.f};
        cur = nxt; cA = nA; cB = nB; ++ui;
        if constexpr (ALIGN_EPI) { if (wr == 1) PG8_BAR; }
    }
    PG8_WAIT_V(0);
    if constexpr (!ALIGN_EPI) { if (wr == 0) PG8_BAR; }
    PG8_BAR;
    if constexpr (Epi::AFTER_DRAIN) { E.fused(acc, cur, wr, wc, fr, fq, lds, wid, lane); S.done(cur); }
#undef PG8_SA
#undef PG8_SB
#undef PG8_STAGE
#undef PG8_LDA
#undef PG8_LDB
#undef PG8_MMA
#undef PG8_WAIT_V
#undef PG8_WAIT_L
#undef PG8_BAR
#undef PG8_SCHED
}
}

constexpr int NWAVES = 8, NTHREADS = 512;
#ifndef MK_N_LAUNCHES
#define MK_N_LAUNCHES 1
#endif
constexpr int BATCH = 8, SEQ = 2048, D = 1024, FF = 4096, NH = 4, DK = 128, DV = 256, QKW = 512, VW = 1024;
constexpr int M = BATCH * SEQ, NPROJ = 3072, CH = 64, NCH = SEQ / CH;
constexpr int MLSTM_IN = 3080, GLA_IN = 3088;
constexpr float EPS = 1e-6f, QK_SCALE = 0.08838834764831845f, INV_TAU = 1.0f / 16.0f;

constexpr size_t MiB = 1u << 20;
constexpr size_t WS_CTL = 0, CTL_ZERO_BYTES = 64 * 1024;
constexpr size_t WS_GATES = 1 * MiB;
constexpr size_t WS_GDEC = 2 * MiB;
constexpr size_t WS_SUMSQ = 2 * MiB + 512 * 1024;
constexpr size_t WS_WIN = 4 * MiB, WS_WOUT = 10 * MiB, WS_W1 = 12 * MiB, WS_W2 = 20 * MiB, WS_WLAYER = 56 * MiB;
constexpr size_t WS_AOP = 28 * MiB;
constexpr size_t WS_PROJ = 92 * MiB, WS_BBLK = 16 * MiB, WS_QT_OFF = 12 * MiB, WS_KT_OFF = 14 * MiB;
constexpr size_t BBLK_E = WS_BBLK / 2;
constexpr size_t WS_HMID = 92 * MiB;
constexpr size_t WS_XRES = 220 * MiB;
constexpr size_t WS_END = 252 * MiB;
constexpr int CW_BAR = 1024, CW_XID = 8192, CW_XCL = 9216, CW_FIN = 14336, CW_GRP = 15360;

constexpr int RING_BYTES = 131072, LDS_BYTES = 155648, LDSCTL_OFF = LDS_BYTES - 1024, MISC_OFF = LDSCTL_OFF + 320;

#define GAS __attribute__((address_space(1)))
#define LAS __attribute__((address_space(3)))
typedef unsigned short bf16;
typedef unsigned v4u __attribute__((ext_vector_type(4)));
typedef unsigned v2u __attribute__((ext_vector_type(2)));
typedef float f32x4 __attribute__((ext_vector_type(4)));
typedef float f32x16 __attribute__((ext_vector_type(16)));
typedef short bf16x8 __attribute__((ext_vector_type(8)));
typedef short s16x4 __attribute__((ext_vector_type(4)));
typedef GAS unsigned gu32;
#define RLX_AGENT __ATOMIC_RELAXED, __HIP_MEMORY_SCOPE_AGENT
#define LDS_WAIT() asm volatile("s_waitcnt lgkmcnt(0)" ::: "memory")
#define VM_WAIT() asm volatile("s_waitcnt vmcnt(0)" ::: "memory")
using pg8::pk_bf16;
__device__ __forceinline__ float bf2f(unsigned b) { return __uint_as_float(b << 16); }
__device__ __forceinline__ float bflo(unsigned w) { return __uint_as_float(w << 16); }
__device__ __forceinline__ float bfhi(unsigned w) { return __uint_as_float(w & 0xffff0000u); }
__device__ __forceinline__ unsigned short f2bf1(float f) { return (unsigned short)(pk_bf16(f, 0.f) & 0xffffu); }

struct Args { const float* in[15]; float* out; unsigned char* ws; int ph_lo, ph_hi; };
#define XB_TMO      128
#define XB_XCNT(j)  (256  + 64 * (j))
#define XB_XSUB(j)  (1280 + 64 * (j))
#define XB_XGEN(j)  (2304 + 64 * (j))
#define XB_TOP      3328
#define XB_TOPGEN   3392
#define XCD_BAR_WORDS 3456
#define XB_SPIN_CAP (1u << 18)
__device__ __forceinline__ unsigned xb_ld(unsigned* p)              { return __hip_atomic_load(p, __ATOMIC_RELAXED, __HIP_MEMORY_SCOPE_AGENT); }
__device__ __forceinline__ unsigned xb_add(unsigned* p, unsigned v) { return __hip_atomic_fetch_add(p, v, __ATOMIC_RELAXED, __HIP_MEMORY_SCOPE_AGENT); }
__device__ __forceinline__ unsigned xb_xcc_id() { return (unsigned)__builtin_amdgcn_s_getreg((3 << 11) | 20) & 0xFu; }
#define XB_SPIN(cond, bar) do { unsigned _sp = 0; while (cond) { __builtin_amdgcn_s_sleep(1); \
    if ((++_sp & 255u) == 0u) { if (xb_ld(&(bar)[XB_TMO])) break; if (_sp > XB_SPIN_CAP) { atomicAdd(&(bar)[XB_TMO], 1u); break; } } } } while (0)
struct XcdBarrier { unsigned* bar; unsigned x; volatile LAS unsigned* st; };
__device__ __forceinline__ XcdBarrier xcd_barrier_post(unsigned* bar, volatile LAS unsigned* st) {
    XcdBarrier b; b.bar = bar; b.x = xb_xcc_id(); b.st = st;
    if (threadIdx.x == 0) (void)xb_add(&bar[XB_XCNT(b.x)], 1u);
    return b;
}
__device__ __forceinline__ void xcd_barrier_complete(unsigned* bar, unsigned x, unsigned& nloc, unsigned& nx) {
    const unsigned G = gridDim.x * gridDim.y * gridDim.z;
    unsigned sum, cnt, mine, sp = 0u;
    for (;;) {
        sum = 0u; cnt = 0u; mine = 0u;
#pragma unroll
        for (unsigned j = 0; j < 16; ++j) { const unsigned c = xb_ld(&bar[XB_XCNT(j)]); sum += c; cnt += (c > 0u) ? 1u : 0u; mine = (j == x) ? c : mine; }
        if (sum == G) break;
        __builtin_amdgcn_s_sleep(1);
        if ((++sp & 255u) == 0u) { if (xb_ld(&bar[XB_TMO])) break; if (sp > XB_SPIN_CAP) { atomicAdd(&bar[XB_TMO], 1u); break; } }
    }
    nloc = mine > 0u ? mine : 1u; nx = cnt > 0u ? cnt : 1u;
}
__device__ __forceinline__ void xcd_barrier(const XcdBarrier& b) {
    asm volatile("s_waitcnt vmcnt(0)" ::: "memory");
    __syncthreads();
    if (threadIdx.x == 0) {
        unsigned* bar = b.bar;
        __builtin_amdgcn_s_waitcnt(0);
        unsigned nloc = b.st[0], nx = b.st[1];
        if (nloc == 0u) { xcd_barrier_complete(bar, b.x, nloc, nx); b.st[0] = nloc; b.st[1] = nx; }
        const unsigned old = xb_add(&bar[XB_XSUB(b.x)], 1u);
        const unsigned gen = old / nloc;
        if (old + 1u == (gen + 1u) * nloc) {
            __builtin_amdgcn_fence(__ATOMIC_RELEASE, "agent");
            asm volatile("s_waitcnt vmcnt(0)" ::: "memory");
            const unsigned og = xb_add(&bar[XB_TOP], 1u);
            const unsigned tg = og / nx;
            if (og + 1u == (tg + 1u) * nx) xb_add(&bar[XB_TOPGEN], 1u);
            else XB_SPIN(xb_ld(&bar[XB_TOPGEN]) == tg, bar);
            __builtin_amdgcn_fence(__ATOMIC_ACQUIRE, "agent");
            xb_add(&bar[XB_XGEN(b.x)], 1u);
            asm volatile("s_waitcnt vmcnt(0)" ::: "memory");
        } else {
            XB_SPIN(xb_ld(&bar[XB_XGEN(b.x)]) == gen, bar);
            __builtin_amdgcn_fence(__ATOMIC_ACQUIRE, "agent");
            asm volatile("s_waitcnt vmcnt(0)" ::: "memory");
        }
    }
    __syncthreads();
}

__device__ __forceinline__ float wave_sum(float v) {
#pragma unroll
    for (int o = 1; o < 64; o <<= 1) v += __shfl_xor(v, o);
    return v;
}
struct CvItem { const float* W; bf16* WT; const float* gain; int K, ldw, k0, n0; };
__device__ __forceinline__ CvItem cv_item(const Args& args, unsigned char* ws, int it) {
    constexpr int I_IN = (D / 64) * (NPROJ / 64), I_O = (D / 64) * (D / 64), I_1 = (D / 64) * (FF / 64), I_2 = (FF / 64) * (D / 64), NITEMS = I_IN + I_O + I_1 + I_2;
    const int layer = it >= NITEMS; int r = it - layer * NITEMS; unsigned char* wl = ws + (size_t)layer * WS_WLAYER;
    CvItem c; int N;
    if (r < I_IN) { c.W = args.in[layer ? 8 : 4]; c.K = D; N = NPROJ; c.ldw = layer ? GLA_IN : MLSTM_IN; c.WT = (bf16*)(wl + WS_WIN); c.gain = args.in[1] + layer * D; }
    else if ((r -= I_IN) < I_O) { c.W = args.in[layer ? 12 : 7]; c.K = D; N = D; c.ldw = D; c.WT = (bf16*)(wl + WS_WOUT); c.gain = nullptr; }
    else if ((r -= I_O) < I_1) { c.W = args.in[13] + (size_t)layer * D * FF; c.K = D; N = FF; c.ldw = FF; c.WT = (bf16*)(wl + WS_W1); c.gain = args.in[2] + layer * D; }
    else { r -= I_1; c.W = args.in[14] + (size_t)layer * D * FF; c.K = FF; N = D; c.ldw = D; c.WT = (bf16*)(wl + WS_W2); c.gain = nullptr; }
    const int nblk = N / 64; c.k0 = 64 * (r / nblk); c.n0 = 64 * (r % nblk);
    return c;
}
__device__ __forceinline__ void cv_load(f32x4 (&v)[16], const CvItem& c, int lane) {
    const int n4 = (lane & 15) * 4, krow = lane >> 4;
#pragma unroll
    for (int i = 0; i < 16; ++i) v[i] = *(const f32x4*)(c.W + (size_t)(c.k0 + 4 * i + krow) * c.ldw + c.n0 + n4);
}
__device__ __forceinline__ void cv_store(const f32x4 (&v)[16], const CvItem& c, LAS float* scr, int lane) {
    const int n4 = (lane & 15) * 4, krow = lane >> 4;
#pragma unroll
    for (int i = 0; i < 16; ++i) *(LAS f32x4*)(scr + (4 * i + krow) * 64 + (n4 ^ (((i >> 1) & 7) << 2))) = v[i];
    const int cc = lane & 7, nl = lane >> 3;
    f32x4 g0 = {1.f, 1.f, 1.f, 1.f}, g1 = {1.f, 1.f, 1.f, 1.f};
    if (c.gain) { g0 = *(const f32x4*)(c.gain + c.k0 + 8 * cc); g1 = *(const f32x4*)(c.gain + c.k0 + 8 * cc + 4); }
    LDS_WAIT(); asm volatile("" ::: "memory");
#pragma unroll
    for (int j = 0; j < 8; ++j) { const int n = 8 * j + nl; const LAS float* sp = scr + (8 * cc) * 64 + (n ^ (cc << 2));
        v4u o; o.x = pk_bf16(sp[0 * 64] * g0.x, sp[1 * 64] * g0.y); o.y = pk_bf16(sp[2 * 64] * g0.z, sp[3 * 64] * g0.w); o.z = pk_bf16(sp[4 * 64] * g1.x, sp[5 * 64] * g1.y); o.w = pk_bf16(sp[6 * 64] * g1.z, sp[7 * 64] * g1.w);
        *(GAS v4u*)(c.WT + (size_t)(c.n0 + n) * c.K + c.k0 + 8 * cc) = o; }
    LDS_WAIT(); asm volatile("" ::: "memory");
}
__device__ __forceinline__ void convert_weights(LAS unsigned char* lds, int lane, int wv, int nw, int vcu, int G, const Args& args, unsigned char* ws) {
    LAS float* scr = (LAS float*)(lds + wv * 16384);
    const int gw = vcu * nw + wv, NGW = G * nw;
    constexpr int NITEMS2 = 2 * ((D / 64) * (NPROJ / 64) + (D / 64) * (D / 64) + (D / 64) * (FF / 64) + (FF / 64) * (D / 64));
    f32x4 va[16], vb[16];
    int it = gw;
    if (it < NITEMS2) { const CvItem c0 = cv_item(args, ws, it); cv_load(va, c0, lane); }
    while (it < NITEMS2) {
        { const CvItem c = cv_item(args, ws, it); const int nx = it + NGW; if (nx < NITEMS2) { const CvItem cn = cv_item(args, ws, nx); cv_load(vb, cn, lane); } cv_store(va, c, scr, lane); it = nx; }
        if (it >= NITEMS2) break;
        { const CvItem c = cv_item(args, ws, it); const int nx = it + NGW; if (nx < NITEMS2) { const CvItem cn = cv_item(args, ws, nx); cv_load(va, cn, lane); } cv_store(vb, c, scr, lane); it = nx; }
    }
}

__device__ __forceinline__ void rows_first_stage(LAS float* WgT, int tid, const float* wg, int ldw, int ng) {
    { float wv[32];
#pragma unroll
      for (int n = 0; n < 32; ++n) { const int i = tid + NTHREADS * n, k = i >> 4, c = i & 15; wv[n] = (c < ng) ? wg[(size_t)k * ldw + c] : 0.f; }
#pragma unroll
      for (int n = 0; n < 32; ++n) { const int i = tid + NTHREADS * n, k = i >> 4, c = i & 15; WgT[c * D + k] = wv[n]; } }
}
__device__ __forceinline__ void rows_first(const LAS float* WgT, int lane, int wv, int nw, int vcu, int G, const float* xin, const float* gain, bf16* xres, float* sumsq, int ng, float* gates) {
    const int gw = vcu * nw + wv, NGW = G * nw;
    f32x4 gn[4];
#pragma unroll
    for (int j = 0; j < 4; ++j) gn[j] = *(const f32x4*)(gain + 4 * lane + 256 * j);
    f32x4 vn[4];
    if (gw < M) {
#pragma unroll
        for (int j = 0; j < 4; ++j) vn[j] = *(const f32x4*)(xin + (size_t)gw * D + 4 * lane + 256 * j); }
    for (int m = gw; m < M; m += NGW) {
        f32x4 v[4]; float s = 0.f;
#pragma unroll
        for (int j = 0; j < 4; ++j) { v[j] = vn[j]; s += (v[j].x * v[j].x + v[j].y * v[j].y) + (v[j].z * v[j].z + v[j].w * v[j].w); }
        if (m + NGW < M) {
#pragma unroll
            for (int j = 0; j < 4; ++j) vn[j] = *(const f32x4*)(xin + (size_t)(m + NGW) * D + 4 * lane + 256 * j); }
#pragma unroll
        for (int j = 0; j < 4; ++j) { v2u o; o.x = pk_bf16(v[j].x, v[j].y); o.y = pk_bf16(v[j].z, v[j].w); *(v2u*)(xres + (size_t)m * D + 4 * lane + 256 * j) = o; }
        const float ssum = wave_sum(s);
        if (lane == 0) *(f32x4*)(sumsq + (size_t)m * 4) = (f32x4){ssum, 0.f, 0.f, 0.f};
        const float rstd = 1.0f / sqrtf(ssum * (1.f / D) + EPS);
#pragma unroll
        for (int j = 0; j < 4; ++j) v[j] = v[j] * rstd * gn[j];
        float a[16];
#pragma unroll
        for (int c = 0; c < 16; ++c) a[c] = 0.f;
#pragma unroll
        for (int c = 0; c < 16; ++c) {
#pragma unroll
            for (int j = 0; j < 4; ++j) { const f32x4 w = *(const LAS f32x4*)(WgT + c * D + 4 * lane + 256 * j); a[c] += (v[j].x * w.x + v[j].y * w.y) + (v[j].z * w.z + v[j].w * w.w); }
            if (c & 1) asm volatile("" ::: "memory"); }
        const bool b5 = lane & 32, b4 = lane & 16, b3 = lane & 8, b2 = lane & 4;
#pragma unroll
        for (int i = 0; i < 8; ++i) { const float keep = b5 ? a[i + 8] : a[i], send = b5 ? a[i] : a[i + 8]; a[i] = keep + __shfl_xor(send, 32); }
#pragma unroll
        for (int i = 0; i < 4; ++i) { const float keep = b4 ? a[i + 4] : a[i], send = b4 ? a[i] : a[i + 4]; a[i] = keep + __shfl_xor(send, 16); }
#pragma unroll
        for (int i = 0; i < 2; ++i) { const float keep = b3 ? a[i + 2] : a[i], send = b3 ? a[i] : a[i + 2]; a[i] = keep + __shfl_xor(send, 8); }
        { const float keep = b2 ? a[1] : a[0], send = b2 ? a[0] : a[1]; a[0] = keep + __shfl_xor(send, 4); }
        a[0] += __shfl_xor(a[0], 2); a[0] += __shfl_xor(a[0], 1);
        const int c = (b5 ? 8 : 0) + (b4 ? 4 : 0) + (b3 ? 2 : 0) + (b2 ? 1 : 0);
        if ((lane & 3) == 0 && c < ng) gates[(size_t)m * 16 + c] = a[0];
    }
}
__device__ __forceinline__ void rows_final(int lane, int wave, int vcu, int G, const bf16* xres, const float* gain, float* out) {
    const int gw = vcu * NWAVES + wave, NGW = G * NWAVES;
    for (int m = gw; m < M; m += NGW) {
        float f[2][8]; float ss = 0.f;
#pragma unroll
        for (int j = 0; j < 2; ++j) { const v4u hv = *(const v4u*)(xres + (size_t)m * D + 8 * lane + 512 * j);
            f[j][0] = bflo(hv.x); f[j][1] = bfhi(hv.x); f[j][2] = bflo(hv.y); f[j][3] = bfhi(hv.y); f[j][4] = bflo(hv.z); f[j][5] = bfhi(hv.z); f[j][6] = bflo(hv.w); f[j][7] = bfhi(hv.w);
#pragma unroll
            for (int e = 0; e < 8; ++e) ss += f[j][e] * f[j][e]; }
        const float rstd = 1.0f / sqrtf(wave_sum(ss) * (1.f / D) + EPS);
#pragma unroll
        for (int j = 0; j < 2; ++j) { const int col = 8 * lane + 512 * j; const f32x4 g0 = *(const f32x4*)(gain + col), g1 = *(const f32x4*)(gain + col + 4);
            *(f32x4*)(out + (size_t)m * D + col) = (f32x4){f[j][0] * rstd * g0.x, f[j][1] * rstd * g0.y, f[j][2] * rstd * g0.z, f[j][3] * rstd * g0.w};
            *(f32x4*)(out + (size_t)m * D + col + 4) = (f32x4){f[j][4] * rstd * g1.x, f[j][5] * rstd * g1.y, f[j][6] * rstd * g1.z, f[j][7] * rstd * g1.w}; }
    }
}
struct RstdSlots { int pm0, pm1, pm2, pm3; };
__device__ __forceinline__ RstdSlots rstd_table(LAS float* rt, const float* sumsq, const pg8::StaticOrder& S, int tid) {
    int pmv[4] = {-1, -1, -1, -1}; int ns = 0;
    pg8::Unit u;
    for (int i = 0; S.next(i, u); ++i) { if (u.pm != pmv[0] && u.pm != pmv[1] && u.pm != pmv[2] && u.pm != pmv[3] && ns < 4) { if (ns == 0) pmv[0] = u.pm; else if (ns == 1) pmv[1] = u.pm; else if (ns == 2) pmv[2] = u.pm; else pmv[3] = u.pm; ++ns; } }
#pragma unroll
    for (int sl = 0; sl < 4; ++sl) { const int pm = sl == 0 ? pmv[0] : sl == 1 ? pmv[1] : sl == 2 ? pmv[2] : pmv[3];
        if (pm >= 0 && tid < 256) { const f32x4 s4 = *(const f32x4*)(sumsq + (size_t)(pm * 256 + tid) * 4); rt[sl * 256 + tid] = 1.0f / sqrtf(((s4.x + s4.y) + (s4.z + s4.w)) * (1.f / D) + EPS); } }
    __syncthreads();
    return RstdSlots{pmv[0], pmv[1], pmv[2], pmv[3]};
}

__device__ __forceinline__ void head_norm_rows(int lane, int wave, int vcu, int G, const bf16* hun, const float* gout, const bf16* proj, bf16* aop, const bool GLA) {
    const int rows_wg = M / G, rows_w = rows_wg / NWAVES;
    for (int i = 0; i < rows_w; ++i) {
        const int m = vcu * rows_wg + wave * rows_w + i;
#pragma unroll
        for (int j = 0; j < 2; ++j) {
            const int col = 8 * lane + 512 * j;
            const v4u hv = *(const v4u*)(hun + (size_t)m * D + col);
            const v4u rv = *(const v4u*)(proj + (size_t)(m >> 11) * BBLK_E + (size_t)(m & 2047) * NPROJ + 2048 + col);
            float f[8] = {bflo(hv.x), bfhi(hv.x), bflo(hv.y), bfhi(hv.y), bflo(hv.z), bfhi(hv.z), bflo(hv.w), bfhi(hv.w)};
            const float r[8] = {bflo(rv.x), bfhi(rv.x), bflo(rv.y), bfhi(rv.y), bflo(rv.z), bfhi(rv.z), bflo(rv.w), bfhi(rv.w)};
            float sg[8];
#pragma unroll
            for (int e = 0; e < 8; ++e) sg[e] = __builtin_amdgcn_rcpf(1.0f + __expf(-r[e]));
            if (!GLA) {
#pragma unroll
                for (int e = 0; e < 8; ++e) f[e] *= sg[e];
            }
            float ss = 0.f;
#pragma unroll
            for (int e = 0; e < 8; ++e) ss += f[e] * f[e];
#pragma unroll
            for (int o = 1; o < 32; o <<= 1) ss += __shfl_xor(ss, o);
            const float rs = 1.0f / sqrtf(ss * (1.f / DV) + EPS);
            const f32x4 g0 = *(const f32x4*)(gout + col), g1 = *(const f32x4*)(gout + col + 4);
            const float gg[8] = {g0.x, g0.y, g0.z, g0.w, g1.x, g1.y, g1.z, g1.w};
#pragma unroll
            for (int e = 0; e < 8; ++e) f[e] = f[e] * rs * gg[e];
            if (GLA) {
#pragma unroll
                for (int e = 0; e < 8; ++e) f[e] *= r[e] * sg[e];
            }
            v4u o; o.x = pk_bf16(f[0], f[1]); o.y = pk_bf16(f[2], f[3]); o.z = pk_bf16(f[4], f[5]); o.w = pk_bf16(f[6], f[7]);
            *(v4u*)(aop + (size_t)m * D + col) = o;
        }
    }
}

constexpr int GP_WGT = 0, GP_WGT_PITCH = 2064, GP_ZL = 33024, GP_TOT = 41216, GP_Q = 43264, GP_K = 59648;
__device__ __forceinline__ void gla_prep(LAS unsigned char* lds, int tid, int lane, int wave, int vcu, int G, const bf16* proj, const bf16* xres, const float* sumsq, const float* w_in, const float* gmix,
                                         const float* wup, const float* bgate, bf16* QT, bf16* KT, float* gdec) {
    LAS float* zl = (LAS float*)(lds + GP_ZL);
    LAS float* tot = (LAS float*)(lds + GP_TOT);
    LAS unsigned short* tq = (LAS unsigned short*)(lds + GP_Q);
    LAS unsigned short* tk = (LAS unsigned short*)(lds + GP_K);
    __syncthreads();
    { float wv[32];
#pragma unroll
      for (int n = 0; n < 32; ++n) { const int i = tid + NTHREADS * n, k = i >> 4, c = i & 15; wv[n] = gmix[k] * w_in[(size_t)k * GLA_IN + NPROJ + c]; }
#pragma unroll
      for (int n = 0; n < 32; ++n) { const int i = tid + NTHREADS * n, k = i >> 4, c = i & 15; *(LAS unsigned short*)(lds + GP_WGT + c * GP_WGT_PITCH + k * 2) = f2bf1(wv[n]); } }
    const int d = tid & 127, rg = tid >> 7;
    for (int unit = vcu; unit < BATCH * NCH; unit += G) {
        const int b = unit / NCH, c = unit % NCH, tok0 = b * SEQ + c * CH;
        const bf16* projb = proj + (size_t)b * BBLK_E + (size_t)(c * CH) * NPROJ; bf16* QTb = QT + (size_t)b * BBLK_E + (size_t)(c * CH) * QKW; bf16* KTb = KT + (size_t)b * BBLK_E + (size_t)(c * CH) * QKW;
        v4u pq[2], pk[2]; float wu[16]; float bg;
#define GP_LOAD(h_) do { _Pragma("unroll") for (int i_ = 0; i_ < 2; ++i_) { const int p_ = tid + NTHREADS * i_, row_ = p_ >> 4, ch_ = p_ & 15; \
            pq[i_] = *(const v4u*)(projb + (size_t)row_ * NPROJ + (h_) * DK + ch_ * 8); pk[i_] = *(const v4u*)(projb + (size_t)row_ * NPROJ + QKW + (h_) * DK + ch_ * 8); } \
            _Pragma("unroll") for (int cc_ = 0; cc_ < 16; ++cc_) wu[cc_] = wup[cc_ * QKW + (h_) * DK + d]; bg = bgate[(h_) * DK + d]; } while (0)
        GP_LOAD(0);
        __syncthreads();
        {
            const int rt = wave & 3, kh = wave >> 2, r16 = lane & 15, kq = lane >> 4;
            pg8::f32x4 acc = {0.f, 0.f, 0.f, 0.f};
            const bf16* xr = xres + (size_t)(tok0 + 16 * rt + r16) * D + kh * 512 + 8 * kq;
            LAS unsigned char* wr_ = lds + GP_WGT + r16 * GP_WGT_PITCH + (kh * 512 + 8 * kq) * 2;
#pragma unroll
            for (int ks = 0; ks < 16; ++ks) { const bf16x8 av = *(const bf16x8*)(xr + 32 * ks), bv = *(const LAS bf16x8*)(wr_ + 64 * ks); acc = __builtin_amdgcn_mfma_f32_16x16x32_bf16(av, bv, acc, 0, 0, 0); }
#pragma unroll
            for (int i = 0; i < 4; ++i) zl[kh * 1024 + (16 * rt + 4 * kq + i) * 16 + r16] = acc[i];
        }
        __syncthreads();
        { const int row = tid >> 3, c2 = (tid & 7) * 2;
          const f32x4 s4 = *(const f32x4*)(sumsq + (size_t)(tok0 + row) * 4); const float rstd = 1.0f / sqrtf(((s4.x + s4.y) + (s4.z + s4.w)) * (1.f / D) + EPS);
          const float z0 = (zl[row * 16 + c2] + zl[1024 + row * 16 + c2]) * rstd, z1 = (zl[row * 16 + c2 + 1] + zl[1024 + row * 16 + c2 + 1]) * rstd;
          __syncthreads();
          zl[row * 16 + c2] = z0; zl[row * 16 + c2 + 1] = z1; }
        __syncthreads();
#pragma unroll
        for (int h = 0; h < NH; ++h) {
#pragma unroll
            for (int i = 0; i < 2; ++i) { const int p = tid + NTHREADS * i; *(LAS v4u*)(lds + GP_Q + p * 16) = pq[i]; *(LAS v4u*)(lds + GP_K + p * 16) = pk[i]; }
            float wuh[16]; const float bgh = bg;
#pragma unroll
            for (int cc = 0; cc < 16; ++cc) wuh[cc] = wu[cc];
            if (h + 1 < NH) GP_LOAD(h + 1);
            float bcum[16]; float run = 0.f;
#pragma unroll
            for (int jj = 0; jj < 16; ++jj) {
                const int j = 16 * rg + jj; float z = bgh;
#pragma unroll
                for (int q4 = 0; q4 < 4; ++q4) { const f32x4 zz = *(const LAS f32x4*)(zl + j * 16 + 4 * q4); z += (zz.x * wuh[4 * q4] + zz.y * wuh[4 * q4 + 1]) + (zz.z * wuh[4 * q4 + 2] + zz.w * wuh[4 * q4 + 3]); }
                const float la = (fminf(z, 0.f) - __logf(1.0f + __expf(-fabsf(z)))) * INV_TAU;
                run += la; bcum[jj] = run;
            }
            tot[rg * 128 + d] = run;
            __syncthreads();
            float off = 0.f, g = 0.f;
#pragma unroll
            for (int r2 = 0; r2 < 4; ++r2) { const float t = tot[r2 * 128 + d]; g += t; off += (r2 < rg) ? t : 0.f; }
#pragma unroll
            for (int jj = 0; jj < 16; ++jj) {
                const int j = 16 * rg + jj; const float eb = __expf(bcum[jj] + off);
                const float q = bf2f(tq[j * 128 + d]), k = bf2f(tk[j * 128 + d]);
                tq[j * 128 + d] = f2bf1(q * QK_SCALE * eb); tk[j * 128 + d] = f2bf1(k * __builtin_amdgcn_rcpf(eb));
            }
            if (rg == 0) gdec[(size_t)(unit * NH + h) * DK + d] = __expf(g);
            __syncthreads();
#pragma unroll
            for (int i = 0; i < 2; ++i) { const int p = tid + NTHREADS * i, row = p >> 4, ch = p & 15;
                *(v4u*)(QTb + (size_t)row * QKW + h * DK + ch * 8) = *(const LAS v4u*)(lds + GP_Q + p * 16);
                *(v4u*)(KTb + (size_t)row * QKW + h * DK + ch * 8) = *(const LAS v4u*)(lds + GP_K + p * 16); }
            __syncthreads();
        }
#undef GP_LOAD
    }
    __syncthreads();
}

#ifndef PROBE_P
#define PROBE_P 0
#endif
#ifndef PROBE_P_A
#define PROBE_P_A 0
#endif
#ifndef PROBE_P_B
#define PROBE_P_B 1
#endif
#define PP_SEL(i, S_) ((S_) < 32 ? (i) / 2 == (S_) : ((i) == 2 * ((S_) - 32) + 1 || (i) == 2 * ((S_) - 32) + 2))
#define PP_STAMP(i) do { if (PROBE_P && (PP_SEL(i, PROBE_P_A) || PP_SEL(i, PROBE_P_B)) && tid == 0) ((volatile LAS unsigned*)(lds + LDSCTL_OFF + 512))[i] = (unsigned)__builtin_amdgcn_s_memrealtime(); } while (0)
#ifndef PROBE_T
#define PROBE_T 0
#endif
#ifndef PROBE_T_MLSTM
#define PROBE_T_MLSTM 0
#endif
#ifndef PROBE_T_WAVE
#define PROBE_T_WAVE 0
#endif
#ifndef PROBE_T_A
#define PROBE_T_A 5
#endif
#ifndef PROBE_T_B
#define PROBE_T_B 0
#endif
constexpr int CW_PROBE = 12288;
__device__ __forceinline__ unsigned long long pt_now() { unsigned long long t; __builtin_amdgcn_sched_barrier(0); asm volatile("s_memrealtime %0\n\ts_waitcnt lgkmcnt(0)" : "=s"(t) :: "memory"); __builtin_amdgcn_sched_barrier(0); return t; }
#define PT_NOW() pt_now()
#define PT_ACC(i, t0) do { if (PROBE_T) { const unsigned long long t1_ = PT_NOW(); pt[i] += (unsigned)(t1_ - (t0)); (t0) = t1_; } } while (0)
constexpr int PS_PITCH = 144, CT_PITCH = 272, CT_BYTES = 32 * CT_PITCH, IMG_PITCH = 272, IMG_BYTES = 64 * IMG_PITCH, NUM_PITCH = 36;
template <bool MLSTM> struct MxMap;
template <> struct MxMap<true>  { static constexpr int QS = 0, KS = 34816, V = 69632, VW = 77824, VWAUX = 81920, PS = 86016, CT = 95232, TB = 112640, TWP = 120832, TPM = 129024, TSC = 137216, DEN = 137728, NUM = 138240, WI = 147456, OUTT = 0, GDEC = 0, END = 147968; };
template <> struct MxMap<false> { static constexpr int QS = 0, KS = 34816, V = 69632, VW = 0, VWAUX = 0, PS = 77824, CT = 87040, TB = 0, TWP = 0, TPM = 0, TSC = 0, DEN = 0, NUM = 0, WI = 0, OUTT = 104448, GDEC = 108544, END = 109568; };
#define LDSA(p) ((unsigned)(size_t)(p))
__device__ __forceinline__ bf16x8 mk8(v2u lo, v2u hi) { v4u w; w.x = lo.x; w.y = lo.y; w.z = hi.x; w.w = hi.y; return __builtin_bit_cast(bf16x8, w); }
__device__ __forceinline__ void tr_read2(bf16x8& f0, bf16x8& f1, unsigned a0, unsigned a1, unsigned b0, unsigned b1) {
    v2u l0, h0, l1, h1;
    asm volatile("ds_read_b64_tr_b16 %0, %4\n\tds_read_b64_tr_b16 %1, %5\n\tds_read_b64_tr_b16 %2, %6\n\tds_read_b64_tr_b16 %3, %7\n\ts_waitcnt lgkmcnt(0)"
                 : "=&v"(l0), "=&v"(h0), "=&v"(l1), "=&v"(h1) : "v"(a0), "v"(a1), "v"(b0), "v"(b1) : "memory");
    f0 = mk8(l0, h0); f1 = mk8(l1, h1);
}
__device__ __forceinline__ void tr_read3(bf16x8& f0, bf16x8& f1, bf16x8& f2, unsigned a0, unsigned a1, unsigned b0, unsigned b1, unsigned c0, unsigned c1) {
    v2u l0, h0, l1, h1, l2, h2;
    asm volatile("ds_read_b64_tr_b16 %0, %6\n\tds_read_b64_tr_b16 %1, %7\n\tds_read_b64_tr_b16 %2, %8\n\tds_read_b64_tr_b16 %3, %9\n\tds_read_b64_tr_b16 %4, %10\n\tds_read_b64_tr_b16 %5, %11\n\ts_waitcnt lgkmcnt(0)"
                 : "=&v"(l0), "=&v"(h0), "=&v"(l1), "=&v"(h1), "=&v"(l2), "=&v"(h2) : "v"(a0), "v"(a1), "v"(b0), "v"(b1), "v"(c0), "v"(c1) : "memory");
    f0 = mk8(l0, h0); f1 = mk8(l1, h1); f2 = mk8(l2, h2);
}
template <int P> __device__ __forceinline__ void tr_issue4(v2u (&x)[8], unsigned base) {
    asm volatile("ds_read_b64_tr_b16 %0, %8 offset:%9\n\tds_read_b64_tr_b16 %1, %8 offset:%10\n\tds_read_b64_tr_b16 %2, %8 offset:%11\n\tds_read_b64_tr_b16 %3, %8 offset:%12\n\t"
                 "ds_read_b64_tr_b16 %4, %8 offset:%13\n\tds_read_b64_tr_b16 %5, %8 offset:%14\n\tds_read_b64_tr_b16 %6, %8 offset:%15\n\tds_read_b64_tr_b16 %7, %8 offset:%16"
                 : "=&v"(x[0]), "=&v"(x[1]), "=&v"(x[2]), "=&v"(x[3]), "=&v"(x[4]), "=&v"(x[5]), "=&v"(x[6]), "=&v"(x[7])
                 : "v"(base), "i"(0), "i"(4 * P), "i"(16 * P), "i"(20 * P), "i"(32 * P), "i"(36 * P), "i"(48 * P), "i"(52 * P) : "memory");
}
__device__ __forceinline__ void tr_wait8(v2u (&x)[8]) { asm volatile("s_waitcnt lgkmcnt(0)" : "+v"(x[0]), "+v"(x[1]), "+v"(x[2]), "+v"(x[3]), "+v"(x[4]), "+v"(x[5]), "+v"(x[6]), "+v"(x[7]) :: "memory"); }
__device__ __forceinline__ void tr_pin8(v2u (&x)[8]) { asm volatile("" : "+v"(x[0]), "+v"(x[1]), "+v"(x[2]), "+v"(x[3]), "+v"(x[4]), "+v"(x[5]), "+v"(x[6]), "+v"(x[7])); }
__device__ __forceinline__ bf16x8 tr_read1(unsigned a0, unsigned a1) {
    v2u l0, h0;
    asm volatile("ds_read_b64_tr_b16 %0, %2\n\tds_read_b64_tr_b16 %1, %3\n\ts_waitcnt lgkmcnt(0)" : "=&v"(l0), "=&v"(h0) : "v"(a0), "v"(a1) : "memory");
    return mk8(l0, h0);
}
#define MFMA32(a, b, c) __builtin_amdgcn_mfma_f32_32x32x16_bf16((a), (b), (c), 0, 0, 0)
#define MX_BAR() do { asm volatile("s_waitcnt lgkmcnt(0)" ::: "memory"); __builtin_amdgcn_s_barrier(); asm volatile("" ::: "memory"); } while (0)
#define MX_BAR_VM() do { asm volatile("s_waitcnt vmcnt(0) lgkmcnt(0)" ::: "memory"); __builtin_amdgcn_s_barrier(); asm volatile("" ::: "memory"); } while (0)
struct MixArgs { const bf16 *q, *k, *proj; int qpitch; const float *gates, *bgate, *gdec; bf16* hun; void* probe; };
struct MixUnit { const bf16 *Qg, *Kg, *Vg; bf16* Hg; const float* gdec; int qpitch, b, hh; };
constexpr int MX_NPIECE = 38, MX_PPW = 5;
template <bool MLSTM> struct MixDma { static constexpr int PPW = MX_PPW; unsigned voff[PPW]; };
template <bool MLSTM> __device__ __forceinline__ int mx_piece(int wave, int i) { return wave + 8 * i; }

template <bool MLSTM>
__device__ __forceinline__ void mx_dma_setup(MixDma<MLSTM>& dm, int wave, int lane, int qpitch) {
#pragma unroll
    for (int i = 0; i < MixDma<MLSTM>::PPW; ++i) { const int pi = mx_piece<MLSTM>(wave, i); unsigned v = 0;
        if (pi < 34) { const int ob = (pi < 17 ? pi : pi - 17) * 1024 + lane * 16, row = ob / IMG_PITCH; int cb = ob - row * IMG_PITCH; cb = cb < 256 ? cb : 240; v = (unsigned)(row * qpitch * 2 + cb); }
        else { const int ob = (pi - 34) * 1024 + lane * 16, row = ob >> 6, cb = ob & 63; v = (unsigned)(row * NPROJ * 2 + cb); }
        dm.voff[i] = v; }
}
template <bool MLSTM>
__device__ __forceinline__ void mx_dma_issue(LAS unsigned char* lds, const MixDma<MLSTM>& dm, const MixUnit& U, int c, int wave, int tid) {
    typedef MxMap<MLSTM> MP;
    const int par = c & 1; const size_t tok0 = (size_t)c * CH;
    const char* qb = (const char*)(U.Qg + tok0 * U.qpitch); const char* kb = (const char*)(U.Kg + tok0 * U.qpitch); const char* vb = (const char*)(U.Vg + tok0 * NPROJ);
#pragma unroll
    for (int i = 0; i < MixDma<MLSTM>::PPW; ++i) { const int pi = mx_piece<MLSTM>(wave, i);
        if (pi < MX_NPIECE) {
            const char* src; int dst;
            if (pi < 17) { src = qb; dst = MP::QS + par * IMG_BYTES + pi * 1024; }
            else if (pi < 34) { src = kb; dst = MP::KS + par * IMG_BYTES + (pi - 17) * 1024; }
            else { src = vb; dst = MP::V + par * 4096 + (pi - 34) * 1024; }
            __builtin_amdgcn_global_load_lds((const unsigned*)(src + dm.voff[i]), (LAS unsigned*)(lds + dst), 16, 0, 0);
        } }
    if (!MLSTM && wave == 7) {
        const float* gd = U.gdec + (size_t)(((U.b * NCH + c) * NH) + U.hh) * DK + (tid & 63);
        __builtin_amdgcn_global_load_lds((const unsigned*)gd, (LAS unsigned*)(lds + MP::GDEC + par * 512), 4, 0, 0);
        __builtin_amdgcn_global_load_lds((const unsigned*)(gd + 64), (LAS unsigned*)(lds + MP::GDEC + par * 512 + 256), 4, 0, 0);
    }
}
__device__ __forceinline__ void mx_store_tile(LAS unsigned char* outt, const f32x16& val, bf16* grow  , int lane, int r, int h5) {
#pragma unroll
    for (int i = 0; i < 16; ++i) *(LAS unsigned short*)(outt + ((i & 3) + 8 * (i >> 2) + 4 * h5) * 64 + r * 2) = f2bf1(val[i]);
#pragma unroll
    for (int i = 0; i < 2; ++i) { const int id = lane + 64 * i, row = id >> 2, pc = id & 3; const v4u w = *(const LAS v4u*)(outt + row * 64 + pc * 16); *(v4u*)(grow + (size_t)row * D + pc * 8) = w; }
}
__device__ __forceinline__ void mx_finalize_mlstm(LAS unsigned char* lds, const MixUnit& U, int cf, int fl) {
    typedef MxMap<true> MP;
    const int j = fl >> 2, sg = fl & 3; const float mc = ((const LAS float*)(lds + MP::TSC))[cf];
    const float dn = ((const LAS float*)(lds + MP::DEN))[j], bb = ((const LAS float*)(lds + MP::TB))[cf * 64 + j], pm = ((const LAS float*)(lds + MP::TPM))[cf * 64 + j];
    const float rden = QK_SCALE * __builtin_amdgcn_rcpf(fmaxf(fabsf(dn) * QK_SCALE, __expf(-bb - fmaxf(mc, pm))));
    const f32x4 n0 = *(const LAS f32x4*)((const LAS float*)(lds + MP::NUM) + j * NUM_PITCH + 8 * sg) * rden, n1 = *(const LAS f32x4*)((const LAS float*)(lds + MP::NUM) + j * NUM_PITCH + 8 * sg + 4) * rden;
    v4u w; w.x = pk_bf16(n0.x, n0.y); w.y = pk_bf16(n0.z, n0.w); w.z = pk_bf16(n1.x, n1.y); w.w = pk_bf16(n1.z, n1.w);
    *(v4u*)(U.Hg + (size_t)(U.b * SEQ + cf * CH + j) * D + 8 * sg) = w;
}

template <bool MLSTM>
__device__ __forceinline__ void mx_step(LAS unsigned char* lds, const MixDma<MLSTM>& dm, const MixUnit& U, int c, f32x16& accC0, f32x16& accC1, f32x16& accO, int tid, int lane, int wave, unsigned (&pt)[8]) {
    typedef MxMap<MLSTM> MP;
    unsigned long long tp = PROBE_T ? PT_NOW() : 0ull;
    const int r = lane & 31, h5 = lane >> 5, blk = (lane >> 4) & 1, q4 = (lane & 15) >> 2, p4 = lane & 3, par = c & 1;
    const LAS float* TSC = (const LAS float*)(lds + MP::TSC);
    LAS unsigned char* qimg0 = lds + MP::QS + par * IMG_BYTES; LAS unsigned char* kimg0 = lds + MP::KS + par * IMG_BYTES; LAS unsigned char* vimg0 = lds + MP::V + par * 4096;
    if (c + 1 < NCH) mx_dma_issue<MLSTM>(lds, dm, U, c + 1, wave, tid);
    PT_ACC(6, tp);
    const float mc = MLSTM ? TSC[c] : 0.f;
    if (wave < 4) {
        const int st = wave >> 1, jt = (wave == 1 || wave == 2) ? 1 : 0;
#pragma unroll
        for (int i = 0; i < 16; ++i) accO[i] = 0.f;
        if (MLSTM && wave == 3) {
#pragma unroll
            for (int i = 0; i < 4; ++i) { const int id = lane + 64 * i, row = id >> 2, pc = id & 3;
                const float wr_ = __expf(((const LAS float*)(lds + MP::TWP))[c * 64 + row] - TSC[32 + c]); const v4u pv = *(const LAS v4u*)(vimg0 + row * 64 + pc * 16); v4u o;
                o.x = pk_bf16(bflo(pv.x) * wr_, bfhi(pv.x) * wr_); o.y = pk_bf16(bflo(pv.y) * wr_, bfhi(pv.y) * wr_); o.z = pk_bf16(bflo(pv.z) * wr_, bfhi(pv.z) * wr_); o.w = pk_bf16(bflo(pv.w) * wr_, bfhi(pv.w) * wr_);
                *(LAS v4u*)(lds + MP::VW + row * 64 + pc * 16) = o;
                if (pc == 0) *(LAS unsigned short*)(lds + MP::VWAUX + row * 64) = f2bf1(wr_); }
        }
        if (wave != 3) {
            LAS unsigned char* kimg = kimg0 + (32 * st + r) * IMG_PITCH + 16 * h5;
            LAS unsigned char* qimg = qimg0 + (32 * jt + r) * IMG_PITCH + 16 * h5;
#pragma unroll
            for (int ks = 0; ks < 8; ++ks) { const bf16x8 a = *(const LAS bf16x8*)(kimg + 32 * ks), bq = *(const LAS bf16x8*)(qimg + 32 * ks); accO = MFMA32(a, bq, accO); }
        }
        const int j = 32 * jt + r;
        if (wave == 3) {
#pragma unroll
            for (int g4 = 0; g4 < 4; ++g4) *(LAS v2u*)(lds + MP::PS + j * PS_PITCH + (32 * st + 8 * g4 + 4 * h5) * 2) = (v2u){0u, 0u};
        } else {
            float uj = 0.f;
            if (MLSTM) uj = -fmaxf(mc, ((const LAS float*)(lds + MP::TPM))[c * 64 + j]);
#pragma unroll
            for (int g4 = 0; g4 < 4; ++g4) { const int s0 = 32 * st + 8 * g4 + 4 * h5; f32x4 wps = {0.f, 0.f, 0.f, 0.f}; if (MLSTM) wps = *(const LAS f32x4*)((const LAS float*)(lds + MP::TWP) + c * 64 + s0);
                float v[4];
#pragma unroll
                for (int e = 0; e < 4; ++e) { float x = accO[4 * g4 + e]; if (MLSTM) x *= __expf(uj + wps[e]); v[e] = (s0 + e <= j) ? x : 0.f; }
                v2u o; o.x = pk_bf16(v[0], v[1]); o.y = pk_bf16(v[2], v[3]); *(LAS v2u*)(lds + MP::PS + j * PS_PITCH + s0 * 2) = o; }
        }
    } else {
        const int g = (wave - 4) >> 1, jt = wave & 1;
        if (MLSTM) {
            if (c > 0) mx_finalize_mlstm(lds, U, c - 1, tid - 256);
        }
        if (MLSTM || g == 0) {
#pragma unroll
            for (int i = 0; i < 16; ++i) accO[i] = 0.f;
#pragma unroll
            for (int ks = 0; ks < 8; ++ks) { const bf16x8 a = *(const LAS bf16x8*)(qimg0 + (32 * jt + r) * IMG_PITCH + 16 * h5 + 32 * ks), bc = *(const LAS bf16x8*)(lds + MP::CT + g * CT_BYTES + r * CT_PITCH + 32 * ks + 16 * h5); accO = MFMA32(a, bc, accO); }
            if (MLSTM) {
#pragma unroll
                for (int g4 = 0; g4 < 4; ++g4) { const f32x4 wi = *(const LAS f32x4*)((const LAS float*)(lds + MP::WI) + par * 64 + 32 * jt + 8 * g4 + 4 * h5);
#pragma unroll
                    for (int e = 0; e < 4; ++e) accO[4 * g4 + e] *= wi[e]; }
            }
        }
    }
    PT_ACC(2, tp);
    MX_BAR();
    PT_ACC(3, tp);
    if (wave < 4) {
        if (MLSTM) { const float decay = __expf(mc - TSC[32 + c]); accC0 = accC0 * decay; accC1 = accC1 * decay; }
        LAS unsigned char* kimg = kimg0 + (8 * h5 + q4) * IMG_PITCH + 64 * wave + 32 * blk + 8 * p4;
        LAS unsigned char* vimg = (MLSTM ? lds + MP::VW : vimg0) + (8 * h5 + q4) * 64 + 32 * blk + 8 * p4;
        LAS unsigned char* vaux = lds + MP::VWAUX + (8 * h5 + q4) * 64 + 32 * blk + 8 * p4;
        { v2u xk[8], xv[8], xa[8];
          tr_issue4<IMG_PITCH>(xk, LDSA(kimg)); tr_issue4<64>(xv, LDSA(vimg)); if (MLSTM) tr_issue4<64>(xa, LDSA(vaux));
          tr_wait8(xk); tr_pin8(xv); if (MLSTM) tr_pin8(xa);
          __builtin_amdgcn_sched_barrier(0);
#pragma unroll
          for (int ks = 0; ks < 4; ++ks) { const bf16x8 a = mk8(xk[2 * ks], xk[2 * ks + 1]);
              accC0 = MFMA32(a, mk8(xv[2 * ks], xv[2 * ks + 1]), accC0);
              if (MLSTM) accC1 = MFMA32(a, mk8(xa[2 * ks], xa[2 * ks + 1]), accC1); } }
        if (!MLSTM) {
#pragma unroll
            for (int g4 = 0; g4 < 4; ++g4) { const f32x4 dc = *(const LAS f32x4*)((const LAS float*)(lds + MP::GDEC) + par * 128 + 32 * wave + 8 * g4 + 4 * h5);
#pragma unroll
                for (int e = 0; e < 4; ++e) accC0[4 * g4 + e] *= dc[e]; }
        }
#pragma unroll
        for (int g4 = 0; g4 < 4; ++g4) { const int d0 = 32 * wave + 8 * g4 + 4 * h5;
            v2u o; o.x = pk_bf16(accC0[4 * g4], accC0[4 * g4 + 1]); o.y = pk_bf16(accC0[4 * g4 + 2], accC0[4 * g4 + 3]); *(LAS v2u*)(lds + MP::CT + r * CT_PITCH + d0 * 2) = o;
            if (MLSTM) { v2u o1; o1.x = pk_bf16(accC1[4 * g4], accC1[4 * g4 + 1]); o1.y = pk_bf16(accC1[4 * g4 + 2], accC1[4 * g4 + 3]); *(LAS v2u*)(lds + MP::CT + CT_BYTES + r * CT_PITCH + d0 * 2) = o1; } }
    } else {
        const int g = (wave - 4) >> 1, jt = wave & 1;
        if (MLSTM || g == 0) {
            const bf16x8 ones = (r == 0) ? (bf16x8){0x3F80, 0x3F80, 0x3F80, 0x3F80, 0x3F80, 0x3F80, 0x3F80, 0x3F80} : (bf16x8){0, 0, 0, 0, 0, 0, 0, 0};
            LAS unsigned char* vimg = vimg0 + (8 * h5 + q4) * 64 + 32 * blk + 8 * p4;
            bf16x8 pa[4];
#pragma unroll
            for (int ks = 0; ks < 4; ++ks) pa[ks] = *(const LAS bf16x8*)(lds + MP::PS + (32 * jt + r) * PS_PITCH + 32 * ks + 16 * h5);
            if (g == 0) { v2u xv[8]; tr_issue4<64>(xv, LDSA(vimg)); tr_wait8(xv); __builtin_amdgcn_sched_barrier(0);
#pragma unroll
                for (int ks = 0; ks < 4; ++ks) accO = MFMA32(pa[ks], mk8(xv[2 * ks], xv[2 * ks + 1]), accO);
            } else {
#pragma unroll
                for (int ks = 0; ks < 4; ++ks) accO = MFMA32(pa[ks], ones, accO); }
            if (MLSTM && g == 0) {
#pragma unroll
                for (int i = 0; i < 16; ++i) ((LAS float*)(lds + MP::NUM))[(32 * jt + (i & 3) + 8 * (i >> 2) + 4 * h5) * NUM_PITCH + r] = accO[i];
            }
            if (MLSTM && wave == 7 && c + 1 < NCH) { const float m1 = TSC[c + 1]; ((LAS float*)(lds + MP::WI))[(par ^ 1) * 64 + lane] = __expf(m1 - fmaxf(m1, ((const LAS float*)(lds + MP::TPM))[(c + 1) * 64 + lane])); }
            if (MLSTM && g == 1 && r == 0) {
#pragma unroll
                for (int i = 0; i < 16; ++i) ((LAS float*)(lds + MP::DEN))[32 * jt + (i & 3) + 8 * (i >> 2) + 4 * h5] = accO[i];
            }
            if (!MLSTM) mx_store_tile(lds + MP::OUTT + jt * 2048, accO, U.Hg + (size_t)(U.b * SEQ + c * CH + 32 * jt) * D, lane, r, h5);
        }
    }
    PT_ACC(4, tp);
    MX_BAR_VM();
    PT_ACC(5, tp);
}

template <bool MLSTM>
__device__ __forceinline__ void mixer_phase(LAS unsigned char* lds, int tid, int lane, int wave, int vcu, int G, const MixArgs A) {
    typedef MxMap<MLSTM> MP;
    MixDma<MLSTM> dm; mx_dma_setup<MLSTM>(dm, wave, lane, A.qpitch);
    unsigned pt[8] = {0u, 0u, 0u, 0u, 0u, 0u, 0u, 0u}; unsigned long long tph = PROBE_T ? PT_NOW() : 0ull; unsigned long long tin = tph;
    for (int unit = vcu; unit < BATCH * NH * 8; unit += G) {
        const int slice = unit & 7, bh = unit >> 3;
        MixUnit U; U.b = bh >> 2; U.hh = bh & 3; U.qpitch = A.qpitch; U.gdec = A.gdec;
        U.Qg = A.q + (size_t)U.b * BBLK_E + U.hh * DK; U.Kg = A.k + (size_t)U.b * BBLK_E + U.hh * DK; U.Vg = A.proj + (size_t)U.b * BBLK_E + 1024 + U.hh * DV + 32 * slice; U.Hg = A.hun + U.hh * DV + 32 * slice;
        MX_BAR_VM();
        mx_dma_issue<MLSTM>(lds, dm, U, 0, wave, tid);
        for (int i = tid; i < 2 * CT_BYTES / 4; i += NTHREADS) ((LAS unsigned*)(lds + MP::CT))[i] = 0u;
        if (MLSTM) {
            for (int i = tid; i < 1024; i += NTHREADS) ((LAS unsigned*)(lds + MP::VWAUX))[i] = 0u;
            LAS float* TB = (LAS float*)(lds + MP::TB); LAS float* TWP = (LAS float*)(lds + MP::TWP); LAS float* TPM = (LAS float*)(lds + MP::TPM); LAS float* TSC = (LAS float*)(lds + MP::TSC);
            const float bgi = A.bgate[U.hh], bgf = A.bgate[4 + U.hh];
            float gi4[4], gf4[4];
#pragma unroll
            for (int cc = 0; cc < 4; ++cc) { const size_t tok = (size_t)U.b * SEQ + (wave + 8 * cc) * CH + lane; gi4[cc] = A.gates[tok * 16 + U.hh] + bgi; gf4[cc] = A.gates[tok * 16 + 4 + U.hh] + bgf; }
#pragma unroll
            for (int cc = 0; cc < 4; ++cc) { const int c = wave + 8 * cc;
                const float lf = fminf(gf4[cc], 0.f) - __logf(1.0f + __expf(-fabsf(gf4[cc])));
                float bsum = lf;
#pragma unroll
                for (int o = 1; o < 64; o <<= 1) { const float t = __shfl_up(bsum, o); if (lane >= o) bsum += t; }
                const float wp = gi4[cc] - bsum; float pm = wp;
#pragma unroll
                for (int o = 1; o < 64; o <<= 1) { const float t = __shfl_up(pm, o); if (lane >= o) pm = fmaxf(pm, t); }
                TB[c * 64 + lane] = bsum; TWP[c * 64 + lane] = wp; TPM[c * 64 + lane] = pm;
                if (lane == 63) { TSC[64 + c] = bsum; TSC[96 + c] = pm; } }
            MX_BAR();
            if (wave == 7) ((LAS float*)(lds + MP::WI))[lane] = __expf(-fmaxf(0.f, TPM[lane]));
            if (wave == 0) {
                const float gl = TSC[64 + (lane & 31)], pl = TSC[96 + (lane & 31)]; float m = 0.f, myM = 0.f, myX = 0.f;
#pragma clang loop unroll(disable)
                for (int c = 0; c < NCH; ++c) { const float gc = __uint_as_float(__builtin_amdgcn_readlane(__float_as_uint(gl), c)), pc = __uint_as_float(__builtin_amdgcn_readlane(__float_as_uint(pl), c));
                    const float mxe = fmaxf(m, pc); if (lane == c) { myM = m; myX = mxe; } m = gc + mxe; }
                if (lane < 32) { TSC[lane] = myM; TSC[32 + lane] = myX; }
            }
        }
        f32x16 accC0, accC1, accO;
#pragma unroll
        for (int i = 0; i < 16; ++i) { accC0[i] = 0.f; accC1[i] = 0.f; accO[i] = 0.f; }
        MX_BAR_VM();
        PT_ACC(1, tin);
#pragma clang loop unroll(disable)
        for (int c = 0; c < NCH; ++c) mx_step<MLSTM>(lds, dm, U, c, accC0, accC1, accO, tid, lane, wave, pt);
        if (MLSTM && wave >= 4) mx_finalize_mlstm(lds, U, NCH - 1, tid - 256);
    }
    MX_BAR_VM();
    if (PROBE_T && (PROBE_T_MLSTM != 0) == MLSTM && vcu == 0 && wave == PROBE_T_WAVE && lane == 0) { PT_ACC(0, tph); unsigned* pw = (unsigned*)A.probe; pw[0] = pt[PROBE_T_A]; pw[1] = pt[PROBE_T_B]; }
}

constexpr int N_PHASES = 15, RT_OFF = RING_BYTES;
template <int PH>
__device__ __forceinline__ void run_phase(const Args& args, LAS unsigned char* lds, int tid, int lane, int wave, int vcu, int G, int bx) {
    unsigned char* ws = args.ws;
    constexpr int layer = (PH >= 8) ? 1 : 0, k = (PH == 0) ? -1 : PH - 1 - 7 * layer;
    unsigned char* wl = ws + (size_t)layer * WS_WLAYER;
    bf16* AOP = (bf16*)(ws + WS_AOP); bf16* PROJ = (bf16*)(ws + WS_PROJ); bf16* HMID = (bf16*)(ws + WS_HMID); bf16* XRES = (bf16*)(ws + WS_XRES);
    float* GATES = (float*)(ws + WS_GATES); float* SUMSQ = (float*)(ws + WS_SUMSQ);
    LAS float* RT = (LAS float*)(lds + RT_OFF);
    if constexpr (k == -1) {
        LAS float* WgT = (LAS float*)(lds + 65536);
        rows_first_stage(WgT, tid, args.in[4] + NPROJ, MLSTM_IN, 8);
        __syncthreads();
        if (wave < 4) convert_weights(lds, lane, wave, 4, vcu, G, args, ws);
        else rows_first(WgT, lane, wave - 4, 4, vcu, G, args.in[0], args.in[1], XRES, SUMSQ, 8, GATES);
    } else if constexpr (k == 0) {
        pg8::Gemm g{XRES, (const bf16*)(wl + WS_WIN), M, NPROJ, D}; pg8::StaticOrder S; S.init(M, NPROJ, G, bx);
        const RstdSlots rs = rstd_table(RT, SUMSQ, S, tid);
        pg8::EpiBf16S<0> E{PROJ, NPROJ, (const LAS float*)RT, rs.pm1, rs.pm2, rs.pm3, BBLK_E};
        pg8::gemm_phase<pg8::EpiBf16S<0>, pg8::StaticOrder, true, true>(lds, g, S, E);
    } else if constexpr (k == 1) {
        if (layer) gla_prep(lds, tid, lane, wave, vcu, G, PROJ, XRES, SUMSQ, args.in[8], args.in[1] + D, args.in[9], args.in[10], (bf16*)(ws + WS_PROJ + WS_QT_OFF), (bf16*)(ws + WS_PROJ + WS_KT_OFF), (float*)(ws + WS_GDEC));
    } else if constexpr (k == 2) {
        if (layer == 0) { const MixArgs A{PROJ, PROJ + QKW, PROJ, NPROJ, GATES, args.in[5], nullptr, AOP, ws + WS_CTL + 4 * CW_PROBE}; mixer_phase<true>(lds, tid, lane, wave, vcu, G, A); }
        else { const MixArgs A{(const bf16*)(ws + WS_PROJ + WS_QT_OFF), (const bf16*)(ws + WS_PROJ + WS_KT_OFF), PROJ, QKW, nullptr, nullptr, (const float*)(ws + WS_GDEC), AOP, ws + WS_CTL + 4 * CW_PROBE}; mixer_phase<false>(lds, tid, lane, wave, vcu, G, A); }
    } else if constexpr (k == 3) {
        head_norm_rows(lane, wave, vcu, G, AOP, args.in[layer ? 11 : 6], PROJ, AOP, layer != 0);
    } else if constexpr (k == 4) {
        pg8::Gemm g{AOP, (const bf16*)(wl + WS_WOUT), M, D, D}; pg8::StaticOrder S; S.init(M, D, G, bx);
        pg8::EpiResBf16Sq E{XRES, SUMSQ, D};
        pg8::gemm_phase<pg8::EpiResBf16Sq, pg8::StaticOrder, false, true>(lds, g, S, E);
    } else if constexpr (k == 5) {
        pg8::Gemm g{XRES, (const bf16*)(wl + WS_W1), M, FF, D}; pg8::StaticOrder S; S.init(M, FF, G, bx);
        const RstdSlots rs = rstd_table(RT, SUMSQ, S, tid);
        pg8::EpiBf16S<2> E{HMID, FF, (const LAS float*)RT, rs.pm1, rs.pm2, rs.pm3, (size_t)2048 * FF};
        pg8::gemm_phase<pg8::EpiBf16S<2>, pg8::StaticOrder, true, true>(lds, g, S, E);
    } else if constexpr (k == 6 && layer == 0) {
        pg8::Gemm g{HMID, (const bf16*)(wl + WS_W2), M, D, FF}; pg8::StaticOrder S; S.init(M, D, G, bx);
        pg8::EpiResBf16Sq E{XRES, SUMSQ, D};
        pg8::gemm_phase<pg8::EpiResBf16Sq, pg8::StaticOrder, false, true>(lds, g, S, E);
    } else if constexpr (k == 6) {
        pg8::Gemm g{HMID, (const bf16*)(wl + WS_W2), M, D, FF}; pg8::StaticOrder S; S.init(M, D, G, bx);
        pg8::EpiFinalNorm E{XRES, args.out, SUMSQ, (unsigned*)(ws + WS_CTL) + CW_FIN, args.in[3], D, EPS};
        pg8::gemm_phase<pg8::EpiFinalNorm, pg8::StaticOrder, false, true>(lds, g, S, E);
    }
}
__device__ __forceinline__ void group_sync(unsigned* ctl, volatile LAS unsigned* st, unsigned per_epoch) {
    asm volatile("s_waitcnt vmcnt(0)" ::: "memory");
    __syncthreads();
    if (threadIdx.x == 0) {
        unsigned* cnt = ctl + st[0]; const unsigned target = per_epoch * (st[1] + 1u); st[1] = st[1] + 1u;
        xb_add(cnt, 1u);
        unsigned sp = 0; while (xb_ld(cnt) < target && ++sp < (1u << 22)) __builtin_amdgcn_s_sleep(1);
        __builtin_amdgcn_fence(__ATOMIC_ACQUIRE, "agent");
        asm volatile("s_waitcnt vmcnt(0)" ::: "memory");
    }
    __syncthreads();
}
__global__ void __launch_bounds__(NTHREADS, 2) fwd_kernel(Args args) {
    extern __shared__ __attribute__((aligned(16))) unsigned char lds_raw[];
    LAS unsigned char* lds = (LAS unsigned char*)lds_raw;
    volatile LAS unsigned* MISC = (volatile LAS unsigned*)(lds + MISC_OFF);
    const int tid = threadIdx.x, lane = tid & 63, wave = __builtin_amdgcn_readfirstlane(tid >> 6);
    const int G = gridDim.x; int bx = blockIdx.x; int vcu = (G % 8 == 0) ? (bx % 8) * (G / 8) + bx / 8 : bx;
    for (int u = tid; u < (LDS_BYTES - LDSCTL_OFF) / 4; u += NTHREADS) ((LAS unsigned*)(lds + LDSCTL_OFF))[u] = 0u;
    __syncthreads();
    const int lo = args.ph_lo, hi = args.ph_hi;
    XcdBarrier bar; bar.bar = (unsigned*)(args.ws + WS_CTL) + CW_BAR; bar.x = 0; bar.st = nullptr;
    if (hi - lo > 1) { bar = xcd_barrier_post((unsigned*)(args.ws + WS_CTL) + CW_BAR, MISC + 8);
        if (tid == 0) { const unsigned xcc = xb_xcc_id(); MISC[16] = xcc; MISC[17] = xb_add((unsigned*)(args.ws + WS_CTL) + CW_XID + 64 * xcc, 1u); } }
#ifndef PROBE_PH
#define PROBE_PH (-1)
#endif
#ifndef PROBE_N
#define PROBE_N 0
#endif
#define PHASE(p) if (lo <= (p) && (p) < hi) { PP_STAMP(2 * (p)); run_phase<p>(args, lds, tid, lane, wave, vcu, G, bx); PP_STAMP(2 * (p) + 1); \
        if ((p) == PROBE_PH) { for (int rep_ = 0; rep_ < PROBE_N; ++rep_) { xcd_barrier(bar); if (PROBE_PH >= 0) run_phase<((p) == PROBE_PH ? (p) : 2)>(args, lds, tid, lane, wave, vcu, G, bx); } } \
        if ((p) + 1 < hi && (p) != 2) { if (MISC[20] != 0u && ((p) == 5 || (p) == 6 || (p) == 12 || (p) == 13)) { group_sync((unsigned*)(args.ws + WS_CTL), MISC + 22, 4u); } \
            else if (MISC[20] != 0u && (p) > 0) { group_sync((unsigned*)(args.ws + WS_CTL), MISC + 24, 32u); } else xcd_barrier(bar); } }
    PHASE(0)
    if (lo == 0 && hi > 1) {
        if (tid == 0) {
            bool ok = (G == 256);
            unsigned cv[16];
#pragma unroll
            for (unsigned j = 0; j < 16; ++j) cv[j] = xb_ld(&bar.bar[XB_XCNT(j)]);
#pragma unroll
            for (unsigned j = 0; j < 16; ++j) ok = ok & (cv[j] == (j < 8 ? 32u : 0u));
            const unsigned xcc = MISC[16], idx = MISC[17];
            if (ok && xcc < 8 && idx < 32) { const unsigned pm = 8u * xcc + (idx & 7u);
                MISC[22] = (unsigned)(CW_GRP + 16 * pm); MISC[24] = (unsigned)(CW_XCL + 64 * xcc); MISC[20] = 1u; }
        }
        __syncthreads();
        if (MISC[20] != 0u) { const unsigned xcc = MISC[16], idx = MISC[17]; vcu = (int)(xcc * 32 + idx); bx = (int)(idx * 8 + xcc); }
    }
    PHASE(1) PHASE(2) PHASE(3) PHASE(4) PHASE(5) PHASE(6) PHASE(7) PHASE(8) PHASE(9) PHASE(10) PHASE(11) PHASE(12) PHASE(13) PHASE(14)
#undef PHASE
#ifndef PROBE_BLK
#define PROBE_BLK 0
#endif
    if (PROBE_P && hi == N_PHASES && blockIdx.x == PROBE_BLK && tid == 0) {
        const volatile LAS unsigned* w = (const volatile LAS unsigned*)(lds + LDSCTL_OFF + 512);
        const unsigned va = (PROBE_P_A < 32) ? w[2 * PROBE_P_A + 1] - w[2 * PROBE_P_A] : w[2 * (PROBE_P_A - 32) + 2] - w[2 * (PROBE_P_A - 32) + 1];
        const unsigned vb = (PROBE_P_B < 32) ? w[2 * PROBE_P_B + 1] - w[2 * PROBE_P_B] : w[2 * (PROBE_P_B - 32) + 2] - w[2 * (PROBE_P_B - 32) + 1];
        const unsigned long long ticks = (unsigned long long)(va / 100u) * 1000ull + (unsigned long long)(vb / 100u) * 100000ull;
        const unsigned long long t0 = PT_NOW(); while (PT_NOW() - t0 < ticks) __builtin_amdgcn_s_sleep(8);
    }
    if (PROBE_T && hi == N_PHASES && vcu == 0 && tid == 0) {
        const unsigned a = xb_ld((unsigned*)(args.ws + WS_CTL) + CW_PROBE), b = xb_ld((unsigned*)(args.ws + WS_CTL) + CW_PROBE + 1);
        const unsigned long long ticks = (unsigned long long)(a / 100u) * 1000ull + (unsigned long long)(b / 100u) * 100000ull;
        const unsigned long long t0 = PT_NOW(); while (PT_NOW() - t0 < ticks) __builtin_amdgcn_s_sleep(8);
    }
}

extern "C" void kernel_launch(void* const* d_in, const int* in_sizes, int n_in, void* d_out, int out_size, void* d_ws, size_t ws_size, hipStream_t stream) {
    static int grid = 0;
    if (grid == 0) {
        if (n_in != 15 || in_sizes[0] != M * D || out_size != M * D || ws_size < WS_END) { fprintf(stderr, "kernel_launch: unexpected shapes (n_in %d, in0 %d, out %d, ws %zu); nothing launched\n", n_in, n_in > 0 ? in_sizes[0] : -1, out_size, ws_size); grid = -1; return; }
        int dev = 0, cus = 0, per_cu = 0;
        if (hipGetDevice(&dev) != hipSuccess || hipDeviceGetAttribute(&cus, hipDeviceAttributeMultiprocessorCount, dev) != hipSuccess) { grid = -1; return; }
        if (hipFuncSetAttribute((const void*)fwd_kernel, hipFuncAttributeMaxDynamicSharedMemorySize, LDS_BYTES) != hipSuccess) { fprintf(stderr, "kernel_launch: hipFuncSetAttribute failed\n"); grid = -1; return; }
        if (hipOccupancyMaxActiveBlocksPerMultiprocessor(&per_cu, (const void*)fwd_kernel, NTHREADS, LDS_BYTES) != hipSuccess || per_cu < 1) { fprintf(stderr, "kernel_launch: occupancy query says %d blocks per CU\n", per_cu); (void)hipGetLastError(); grid = -1; return; }
        grid = cus;
    }
    if (grid < 0) return;
    (void)hipMemsetAsync((char*)d_ws + WS_CTL, 0, CTL_ZERO_BYTES, stream);
    Args a{};
    for (int i = 0; i < 15; ++i) a.in[i] = (const float*)d_in[i];
    a.out = (float*)d_out; a.ws = (unsigned char*)d_ws;
    if (MK_N_LAUNCHES == 1) {
        a.ph_lo = 0; a.ph_hi = N_PHASES;
        void* kargs[] = {&a};
        const hipError_t e = hipLaunchCooperativeKernel((const void*)fwd_kernel, dim3(grid), dim3(NTHREADS), kargs, LDS_BYTES, stream);
        if (e != hipSuccess) fprintf(stderr, "kernel_launch: cooperative launch failed: %s (grid %d)\n", hipGetErrorString(e), grid);
    } else {
        for (int p = 0; p < N_PHASES; ++p) { a.ph_lo = p; a.ph_hi = p + 1; hipLaunchKernelGGL(fwd_kernel, dim3(grid), dim3(NTHREADS), LDS_BYTES, stream, a); }
    }
}
```

```cpp
#include <hip/hip_runtime.h>
#include <cstdio>
#include <cstdint>
namespace pg8 {
#define PG8_LAS __attribute__((address_space(3)))
typedef unsigned short bf16_t;
typedef short bf16x8 __attribute__((ext_vector_type(8)));
typedef float f32x4 __attribute__((ext_vector_type(4)));
typedef unsigned u32x4 __attribute__((ext_vector_type(4)));
constexpr int BM = 256, BK = 64, HALF = 128, HTB = HALF * BK * 2  , STAGE_BYTES = 8 * HTB, NXCD = 8, WGM = 8;

__host__ __device__ __forceinline__ int lds_byte(int r, int c) { const int st = (r >> 4) * 2 + (c >> 5), rr = r & 15, cc = c & 31, ob = rr * 64 + cc * 2; return st * 1024 + (ob ^ (((ob >> 9) & 1) << 5)); }
__host__ __device__ __forceinline__ void stage_rc(int b, int& R, int& C) { const int st = b / 1024, sb = b % 1024, swz = sb ^ (((sb >> 9) & 1) << 5); R = (st >> 1) * 16 + swz / 64; C = (st & 1) * 32 + (swz % 64) / 2; }
__host__ __device__ __forceinline__ int perm32(int rho) { const int n = rho >> 4, i = rho & 15; return 8 * (i >> 2) + 4 * n + (i & 3); }

struct Unit { int pm, pn; };
struct Gemm { const bf16_t* A; const bf16_t* Bt; int M, N, K; };

struct StaticOrder {
    int nM, nN, nwg, G, c;
    __host__ __device__ __forceinline__ void init(int M, int N, int G_, int c_) { nM = M / BM; nN = N / BM; nwg = nM * nN; G = G_; c = c_; }
    __host__ __device__ __forceinline__ bool next(int i, Unit& u) const {
        const long L = (long)i * G + c; if (L >= nwg) return false;
        int wgid = (int)L; { const int q = nwg / NXCD, r = nwg % NXCD, xcd = wgid % NXCD, off = wgid / NXCD; wgid = (xcd < r ? xcd * (q + 1) : r * (q + 1) + (xcd - r) * q) + off; }
        const int nig = WGM * nN, gid = wgid / nig, fm = gid * WGM, gsz = (nM - fm) < WGM ? (nM - fm) : WGM;
        u.pm = fm + ((wgid % nig) % gsz); u.pn = (wgid % nig) / gsz; return true;
    }
    __device__ __forceinline__ void a_ready(const Unit&) const {}
    __device__ __forceinline__ void done(const Unit&) const {}
};

__device__ __forceinline__ unsigned cvt_pk_bf16(float lo, float hi) { unsigned r; asm volatile("v_cvt_pk_bf16_f32 %0, %1, %2" : "=v"(r) : "v"(lo), "v"(hi)); return r; }
typedef float f32x2 __attribute__((ext_vector_type(2)));
typedef __bf16 bf16x2_t __attribute__((ext_vector_type(2)));
__device__ __forceinline__ unsigned pk_bf16(float lo, float hi) { f32x2 v = {lo, hi}; bf16x2_t r = __builtin_convertvector(v, bf16x2_t); return __builtin_bit_cast(unsigned, r); }
template <int ACT  > struct EpiBf16 {
    static constexpr bool PERM = true, AFTER_DRAIN = false, KSCALE = false;
    bf16_t* O; int ldc;
    __device__ __forceinline__ void operator()(const f32x4 (&acc)[2][2][4][2], const Unit& u, int wr, int wc, int fr, int fq) const {
        const int row0 = u.pm * BM + wr * 64 + fr, col0 = u.pn * BM + wc * 32 + 8 * fq;
#pragma unroll
        for (int ai = 0; ai < 2; ++ai)
#pragma unroll
            for (int m = 0; m < 4; ++m) { bf16_t* rowp = O + (size_t)(row0 + ai * HALF + m * 16) * ldc + col0;
#pragma unroll
                for (int bj = 0; bj < 2; ++bj) { f32x4 v0 = acc[ai][bj][m][0], v1 = acc[ai][bj][m][1];
                    if (ACT == 2) { const f32x4 z = {0.f, 0.f, 0.f, 0.f}; v0 = __builtin_elementwise_max(v0, z); v1 = __builtin_elementwise_max(v1, z); v0 = v0 * v0; v1 = v1 * v1; }
                    u32x4 w; w.x = pk_bf16(v0[0], v0[1]); w.y = pk_bf16(v0[2], v0[3]); w.z = pk_bf16(v1[0], v1[1]); w.w = pk_bf16(v1[2], v1[3]);
                    *(u32x4*)(rowp + bj * HALF) = w; } }
    }
};
struct EpiResF32 {
    static constexpr bool PERM = false, AFTER_DRAIN = true, KSCALE = false;
    const float* base; float* out; int ldc;
    __device__ __forceinline__ void fused(const f32x4 (&acc)[2][2][4][2], const Unit& u, int wr, int wc, int fr, int fq, PG8_LAS unsigned char*, int, int) const {
        const int col0 = u.pn * BM + wc * 32 + 4 * fq;
#pragma unroll
        for (int ai = 0; ai < 2; ++ai)
#pragma unroll
            for (int m = 0; m < 4; ++m) { const int r = ai * HALF + wr * 64 + m * 16 + fr; const size_t off = (size_t)(u.pm * BM + r) * ldc + col0;
#pragma unroll
                for (int bj = 0; bj < 2; ++bj) { const f32x4 b0 = *(const f32x4*)(base + off + bj * HALF), b1 = *(const f32x4*)(base + off + bj * HALF + 16);
                    *(f32x4*)(out + off + bj * HALF) = b0 + acc[ai][bj][m][0]; *(f32x4*)(out + off + bj * HALF + 16) = b1 + acc[ai][bj][m][1];
                    asm volatile("" ::: "memory"); } }
    }
};
typedef unsigned u32x2 __attribute__((ext_vector_type(2)));
__device__ __forceinline__ float bf_lo(unsigned w) { return __builtin_bit_cast(float, w << 16); }
__device__ __forceinline__ float bf_hi(unsigned w) { return __builtin_bit_cast(float, w & 0xffff0000u); }
template <int ACT  > struct EpiBf16S {
    static constexpr bool PERM = true, AFTER_DRAIN = false, KSCALE = false;
    bf16_t* O; int ldc; const PG8_LAS float* rt; int pm1, pm2, pm3; size_t bstride;
    __device__ __forceinline__ void operator()(const f32x4 (&acc)[2][2][4][2], const Unit& u, int wr, int wc, int fr, int fq) const {
        const int col0 = u.pn * BM + wc * 32 + 8 * fq;
        const PG8_LAS float* rtp = rt + ((u.pm == pm1) ? 256 : (u.pm == pm2) ? 512 : (u.pm == pm3) ? 768 : 0) + wr * 64 + fr;
#pragma unroll
        for (int ai = 0; ai < 2; ++ai)
#pragma unroll
            for (int m = 0; m < 4; ++m) { const float rs = rtp[ai * HALF + m * 16];
                bf16_t* rowp = O + (size_t)(u.pm >> 3) * bstride + (size_t)((u.pm & 7) * BM + ai * HALF + wr * 64 + m * 16 + fr) * ldc + col0;
#pragma unroll
                for (int bj = 0; bj < 2; ++bj) { f32x4 v0 = acc[ai][bj][m][0] * rs, v1 = acc[ai][bj][m][1] * rs;
                    if (ACT == 2) { const f32x4 z = {0.f, 0.f, 0.f, 0.f}; v0 = __builtin_elementwise_max(v0, z); v1 = __builtin_elementwise_max(v1, z); v0 = v0 * v0; v1 = v1 * v1; }
                    u32x4 w; w.x = pk_bf16(v0[0], v0[1]); w.y = pk_bf16(v0[2], v0[3]); w.z = pk_bf16(v1[0], v1[1]); w.w = pk_bf16(v1[2], v1[3]);
                    *(u32x4*)(rowp + bj * HALF) = w; } }
    }
};
struct EpiResBf16Sq {
    static constexpr bool PERM = false, AFTER_DRAIN = true, KSCALE = false;
    bf16_t* xres; float* sumsq; int ldc;
    __device__ __forceinline__ void fused(f32x4 (&acc)[2][2][4][2], const Unit& u, int wr, int wc, int fr, int fq, PG8_LAS unsigned char* lds, int wid, int lane) const {
        PG8_LAS float* P = (PG8_LAS float*)lds;
        const int col0 = u.pn * BM + wc * 32 + 4 * fq;
#pragma unroll
        for (int ai = 0; ai < 2; ++ai)
#pragma unroll
            for (int m = 0; m < 4; ++m) { const int r = ai * HALF + wr * 64 + m * 16 + fr; bf16_t* xp = xres + (size_t)(u.pm * BM + r) * ldc + col0; float ss = 0.f;
#pragma unroll
                for (int bj = 0; bj < 2; ++bj)
#pragma unroll
                    for (int n = 0; n < 2; ++n) { const u32x2 xb = *(const u32x2*)(xp + bj * HALF + n * 16); const f32x4 a = acc[ai][bj][m][n];
                        u32x2 w; w.x = pk_bf16(bf_lo(xb.x) + a[0], bf_hi(xb.x) + a[1]); w.y = pk_bf16(bf_lo(xb.y) + a[2], bf_hi(xb.y) + a[3]);
                        *(u32x2*)(xp + bj * HALF + n * 16) = w;
                        const float y0 = bf_lo(w.x), y1 = bf_hi(w.x), y2 = bf_lo(w.y), y3 = bf_hi(w.y); ss += (y0 * y0 + y1 * y1) + (y2 * y2 + y3 * y3); }
                ss += __shfl_xor(ss, 16); ss += __shfl_xor(ss, 32);
                if (fq == 0) P[r * 4 + wc] = ss;
                asm volatile("" ::: "memory"); }
        asm volatile("s_waitcnt lgkmcnt(0)" ::: "memory"); __builtin_amdgcn_s_barrier(); asm volatile("" ::: "memory");
        const int t = wid * 64 + lane;
        if (t < 256) { const f32x4 p = *(const PG8_LAS f32x4*)(P + t * 4); sumsq[(size_t)(u.pm * BM + t) * 4 + u.pn] = (p[0] + p[1]) + (p[2] + p[3]); }
    }
};
struct EpiFinalNorm {
    static constexpr bool PERM = false, AFTER_DRAIN = true, KSCALE = false;
    const bf16_t* xres; float* out; float* sumsq; unsigned* cnt; const float* gain; int ldc; float eps;
    __device__ __forceinline__ void fused(f32x4 (&acc)[2][2][4][2], const Unit& u, int wr, int wc, int fr, int fq, PG8_LAS unsigned char* lds, int wid, int lane) const {
        PG8_LAS float* P = (PG8_LAS float*)lds;
        PG8_LAS float* S = (PG8_LAS float*)(lds + 4096);
        const int col0 = u.pn * BM + wc * 32 + 4 * fq, t = wid * 64 + lane;
#pragma unroll
        for (int ai = 0; ai < 2; ++ai)
#pragma unroll
            for (int m = 0; m < 4; ++m) { const int r = ai * HALF + wr * 64 + m * 16 + fr; const bf16_t* xp = xres + (size_t)(u.pm * BM + r) * ldc + col0; float ss = 0.f;
#pragma unroll
                for (int bj = 0; bj < 2; ++bj)
#pragma unroll
                    for (int n = 0; n < 2; ++n) { const u32x2 xb = *(const u32x2*)(xp + bj * HALF + n * 16); f32x4 y = acc[ai][bj][m][n];
                        y[0] += bf_lo(xb.x); y[1] += bf_hi(xb.x); y[2] += bf_lo(xb.y); y[3] += bf_hi(xb.y); acc[ai][bj][m][n] = y; ss += (y[0] * y[0] + y[1] * y[1]) + (y[2] * y[2] + y[3] * y[3]); }
                ss += __shfl_xor(ss, 16); ss += __shfl_xor(ss, 32);
                if (fq == 0) P[r * 4 + wc] = ss;
                asm volatile("" ::: "memory"); }
        asm volatile("s_waitcnt lgkmcnt(0)" ::: "memory"); __builtin_amdgcn_s_barrier(); asm volatile("" ::: "memory");
        if (t < 256) { const f32x4 p = *(const PG8_LAS f32x4*)(P + t * 4); __hip_atomic_store(sumsq + (size_t)(u.pm * BM + t) * 4 + u.pn, (p[0] + p[1]) + (p[2] + p[3]), __ATOMIC_RELAXED, __HIP_MEMORY_SCOPE_AGENT); }
        asm volatile("s_waitcnt vmcnt(0)" ::: "memory"); __builtin_amdgcn_s_barrier(); asm volatile("" ::: "memory");
        if (t == 0) {
            __hip_atomic_fetch_add(cnt + 16 * u.pm, 1u, __ATOMIC_RELAXED, __HIP_MEMORY_SCOPE_AGENT);
            unsigned sp = 0;
            while (__hip_atomic_load(cnt + 16 * u.pm, __ATOMIC_RELAXED, __HIP_MEMORY_SCOPE_AGENT) < 4u && ++sp < (1u << 22)) __builtin_amdgcn_s_sleep(2);
            __builtin_amdgcn_fence(__ATOMIC_ACQUIRE, "agent");
        }
        asm volatile("s_waitcnt vmcnt(0) lgkmcnt(0)" ::: "memory"); __builtin_amdgcn_s_barrier(); asm volatile("" ::: "memory");
        if (t < 256) { float s4 = 0.f;
#pragma unroll
            for (int q = 0; q < 4; ++q) s4 += __hip_atomic_load(sumsq + (size_t)(u.pm * BM + t) * 4 + q, __ATOMIC_RELAXED, __HIP_MEMORY_SCOPE_AGENT);
            S[t] = 1.0f / sqrtf(s4 / (float)ldc + eps); }
        asm volatile("s_waitcnt lgkmcnt(0)" ::: "memory"); __builtin_amdgcn_s_barrier(); asm volatile("" ::: "memory");
        f32x4 gv[2][2];
#pragma unroll
        for (int bj = 0; bj < 2; ++bj)
#pragma unroll
            for (int n = 0; n < 2; ++n) gv[bj][n] = *(const f32x4*)(gain + col0 + bj * HALF + n * 16);
#pragma unroll
        for (int ai = 0; ai < 2; ++ai)
#pragma unroll
            for (int m = 0; m < 4; ++m) { const int r = ai * HALF + wr * 64 + m * 16 + fr; const float rs = S[r]; float* op = out + (size_t)(u.pm * BM + r) * ldc + col0;
#pragma unroll
                for (int bj = 0; bj < 2; ++bj)
#pragma unroll
                    for (int n = 0; n < 2; ++n) *(f32x4*)(op + bj * HALF + n * 16) = acc[ai][bj][m][n] * rs * gv[bj][n]; }
    }
};
struct EpiResBf16SqH {
    static constexpr bool PERM = false, AFTER_DRAIN = true, KSCALE = true;
    bf16_t* xres; float* sumsq; int ldc; const PG8_LAS float* rt4;
    __device__ __forceinline__ void kscale(f32x4 (&acc)[2][2][4][2], int hb, int wr, int fr) const {
#pragma unroll
        for (int ai = 0; ai < 2; ++ai)
#pragma unroll
            for (int m = 0; m < 4; ++m) { const float rho = rt4[(ai * HALF + wr * 64 + m * 16 + fr) * 4 + hb - 1];
#pragma unroll
                for (int bj = 0; bj < 2; ++bj)
#pragma unroll
                    for (int n = 0; n < 2; ++n) acc[ai][bj][m][n] = acc[ai][bj][m][n] * rho; }
    }
    __device__ __forceinline__ void fused(f32x4 (&acc)[2][2][4][2], const Unit& u, int wr, int wc, int fr, int fq, PG8_LAS unsigned char* lds, int wid, int lane) const {
        PG8_LAS float* P = (PG8_LAS float*)lds;
        const int col0 = u.pn * BM + wc * 32 + 4 * fq;
#pragma unroll
        for (int ai = 0; ai < 2; ++ai)
#pragma unroll
            for (int m = 0; m < 4; ++m) { const int r = ai * HALF + wr * 64 + m * 16 + fr; bf16_t* xp = xres + (size_t)(u.pm * BM + r) * ldc + col0; float ss = 0.f; const float s3 = rt4[r * 4 + 3];
#pragma unroll
                for (int bj = 0; bj < 2; ++bj)
#pragma unroll
                    for (int n = 0; n < 2; ++n) { const u32x2 xb = *(const u32x2*)(xp + bj * HALF + n * 16); const f32x4 a = acc[ai][bj][m][n] * s3;
                        u32x2 w; w.x = pk_bf16(bf_lo(xb.x) + a[0], bf_hi(xb.x) + a[1]); w.y = pk_bf16(bf_lo(xb.y) + a[2], bf_hi(xb.y) + a[3]);
                        *(u32x2*)(xp + bj * HALF + n * 16) = w;
                        const float y0 = bf_lo(w.x), y1 = bf_hi(w.x), y2 = bf_lo(w.y), y3 = bf_hi(w.y); ss += (y0 * y0 + y1 * y1) + (y2 * y2 + y3 * y3); }
                ss += __shfl_xor(ss, 16); ss += __shfl_xor(ss, 32);
                if (fq == 0) P[r * 4 + wc] = ss;
                asm volatile("" ::: "memory"); }
        asm volatile("s_waitcnt lgkmcnt(0)" ::: "memory"); __builtin_amdgcn_s_barrier(); asm volatile("" ::: "memory");
        const int t = wid * 64 + lane;
        if (t < 256) { const f32x4 p = *(const PG8_LAS f32x4*)(P + t * 4); sumsq[(size_t)(u.pm * BM + t) * 4 + u.pn] = (p[0] + p[1]) + (p[2] + p[3]); }
    }
};
template <class Epi, class Sched, bool ALIGN_EPI = false, bool SP2 = false>
__device__ __forceinline__ void gemm_phase(PG8_LAS unsigned char* lds, const Gemm g, const Sched& S, const Epi& E) {
    const int tid = threadIdx.x, wid = __builtin_amdgcn_readfirstlane(tid >> 6), lane = tid & 63, wr = wid >> 2, wc = wid & 3, fr = lane & 15, fq = lane >> 4;
    const int K = g.K, nt = K / BK;
    unsigned voffA[2], voffB[2];
#pragma unroll
    for (int i = 0; i < 2; ++i) { int R, C; stage_rc(tid * 16 + i * 8192, R, C); const int Rb = Epi::PERM ? ((R & ~31) + perm32(R & 31)) : R;
        voffA[i] = (unsigned)(R * K + C) * 2u; voffB[i] = (unsigned)(Rb * K + C) * 2u; }
    const size_t kstep = (size_t)(BK * 2);
    const size_t hstep = (size_t)HALF * K * 2;
    const size_t tstep = 2 * hstep;
    const unsigned ldsw = (unsigned)wid * 1024u;
    const int aoff = lds_byte(wr * 64 + fr, fq * 8), boff = lds_byte(wc * 32 + fr, fq * 8);
#define PG8_SA(b, h) (((b) * 2 + (h)) * HTB)
#define PG8_SB(b, h) ((4 + (b) * 2 + (h)) * HTB)
#define PG8_STAGE(bufoff, gbase, voff) do { _Pragma("unroll") for (int _i = 0; _i < 2; ++_i) \
        __builtin_amdgcn_global_load_lds((const unsigned*)((const char*)(gbase) + (voff)[_i]), (PG8_LAS unsigned*)(lds + (bufoff) + ldsw + _i * 8192), 16, 0, 0); } while (0)
#define PG8_LDA(dst, b, h) do { _Pragma("unroll") for (int m = 0; m < 4; ++m) _Pragma("unroll") for (int k = 0; k < 2; ++k) dst[m][k] = *(const PG8_LAS bf16x8*)(lds + PG8_SA(b, h) + aoff + m * 2048 + k * 1024); } while (0)
#define PG8_LDB(dst, b, h) do { _Pragma("unroll") for (int n = 0; n < 2; ++n) _Pragma("unroll") for (int k = 0; k < 2; ++k) dst[n][k] = *(const PG8_LAS bf16x8*)(lds + PG8_SB(b, h) + boff + n * 2048 + k * 1024); } while (0)
#define PG8_MMA(ai, bj, At, Bt) do { __builtin_amdgcn_s_setprio(1); _Pragma("unroll") for (int m = 0; m < 4; ++m) _Pragma("unroll") for (int n = 0; n < 2; ++n) _Pragma("unroll") for (int k = 0; k < 2; ++k) \
        acc[ai][bj][m][n] = __builtin_amdgcn_mfma_f32_16x16x32_bf16(Bt[n][k], At[m][k], acc[ai][bj][m][n], 0, 0, 0); __builtin_amdgcn_s_setprio(0); } while (0)
#define PG8_WAIT_V(n) asm volatile("s_waitcnt vmcnt(" #n ")" ::: "memory")
#define PG8_WAIT_L(n) asm volatile("s_waitcnt lgkmcnt(" #n ")" ::: "memory")
#define PG8_BAR __builtin_amdgcn_s_barrier()
#define PG8_SCHED __builtin_amdgcn_sched_barrier(0)
    Unit cur, nxt; int ui = 0;
    if (!S.next(0, cur)) return;
    f32x4 acc[2][2][4][2];
#pragma unroll
    for (int a = 0; a < 2; ++a)
#pragma unroll
        for (int b = 0; b < 2; ++b)
#pragma unroll
            for (int m = 0; m < 4; ++m)
#pragma unroll
                for (int n = 0; n < 2; ++n) acc[a][b][m][n] = (f32x4){0.f, 0.f, 0.f, 0.f};
    bf16x8 At[4][2], B0[2][2], B1[2][2];
    const char* cA = (const char*)g.A + (size_t)cur.pm * tstep; const char* cB = (const char*)g.Bt + (size_t)cur.pn * tstep;
    S.a_ready(cur);
    if constexpr (SP2) {
        PG8_STAGE(PG8_SB(0, 0), cB, voffB); PG8_STAGE(PG8_SB(0, 1), cB + hstep, voffB); PG8_STAGE(PG8_SA(0, 0), cA, voffA); PG8_STAGE(PG8_SA(0, 1), cA + hstep, voffA);
        if (wr == 1) PG8_BAR;
        PG8_WAIT_V(2); PG8_BAR;
        PG8_STAGE(PG8_SB(1, 0), cB + kstep, voffB); PG8_STAGE(PG8_SA(1, 0), cA + kstep, voffA); PG8_STAGE(PG8_SB(1, 1), cB + hstep + kstep, voffB);
        PG8_WAIT_V(6); PG8_BAR;
    } else {
        PG8_STAGE(PG8_SB(0, 0), cB, voffB); PG8_STAGE(PG8_SA(0, 0), cA, voffA); PG8_STAGE(PG8_SB(0, 1), cB + hstep, voffB); PG8_STAGE(PG8_SA(0, 1), cA + hstep, voffA);
        if (wr == 1) PG8_BAR;
        PG8_WAIT_V(4); PG8_BAR;
        PG8_STAGE(PG8_SB(1, 0), cB + kstep, voffB); PG8_STAGE(PG8_SA(1, 0), cA + kstep, voffA); PG8_STAGE(PG8_SB(1, 1), cB + hstep + kstep, voffB);
        PG8_WAIT_V(6); PG8_BAR;
    }
    for (;;) {
        const bool has_next = S.next(ui + 1, nxt);
        const char* nA = has_next ? (const char*)g.A + (size_t)nxt.pm * tstep : cA; const char* nB = has_next ? (const char*)g.Bt + (size_t)nxt.pn * tstep : cB;
        for (int t = 0; t < nt; t += 2) {
            if constexpr (Epi::KSCALE) { if (t != 0 && (t & 3) == 0) E.kscale(acc, t >> 2, wr, fr); }
            const bool last = (t == nt - 2);
            const char* a1 = cA + (size_t)(t + 1) * kstep;
            const char* a2 = last ? nA : cA + (size_t)(t + 2) * kstep; const char* b2 = last ? nB : cB + (size_t)(t + 2) * kstep;
            const char* a3 = a2 + kstep; const char* b3 = b2 + kstep;
            if (last && has_next) S.a_ready(nxt);
            if constexpr (SP2) {
            PG8_LDB(B0, 0, 0); PG8_LDB(B1, 0, 1); PG8_SCHED; PG8_LDA(At, 0, 0); PG8_STAGE(PG8_SA(1, 1), a1 + hstep, voffA);
            PG8_WAIT_V(8); PG8_WAIT_L(0); PG8_BAR; PG8_MMA(0, 0, At, B0); PG8_MMA(0, 1, At, B1); PG8_BAR; PG8_SCHED;
            PG8_LDA(At, 0, 1); PG8_STAGE(PG8_SB(0, 0), b2, voffB); PG8_STAGE(PG8_SB(0, 1), b2 + hstep, voffB); PG8_STAGE(PG8_SA(0, 0), a2, voffA);
            PG8_WAIT_V(8); PG8_WAIT_L(0); PG8_BAR; PG8_MMA(1, 0, At, B0); PG8_MMA(1, 1, At, B1); PG8_BAR; PG8_SCHED;
            PG8_LDB(B0, 1, 0); PG8_LDB(B1, 1, 1); PG8_SCHED; PG8_LDA(At, 1, 0); PG8_STAGE(PG8_SA(0, 1), a2 + hstep, voffA);
            PG8_WAIT_V(8); PG8_WAIT_L(0); PG8_BAR; PG8_MMA(0, 0, At, B0); PG8_MMA(0, 1, At, B1); PG8_BAR; PG8_SCHED;
            PG8_LDA(At, 1, 1); PG8_STAGE(PG8_SB(1, 0), b3, voffB); PG8_STAGE(PG8_SB(1, 1), b3 + hstep, voffB); PG8_STAGE(PG8_SA(1, 0), a3, voffA);
            PG8_WAIT_V(8); PG8_WAIT_L(0); PG8_BAR; PG8_MMA(1, 0, At, B0); PG8_MMA(1, 1, At, B1); PG8_BAR; PG8_SCHED;
            } else {
            PG8_LDB(B0, 0, 0); PG8_SCHED; PG8_LDA(At, 0, 0); PG8_STAGE(PG8_SA(1, 1), a1 + hstep, voffA);
            PG8_WAIT_L(8); PG8_BAR; PG8_WAIT_L(0); PG8_MMA(0, 0, At, B0); PG8_BAR; PG8_SCHED;
            PG8_LDB(B1, 0, 1); PG8_STAGE(PG8_SB(0, 0), b2, voffB);
            PG8_BAR; PG8_WAIT_L(0); PG8_MMA(0, 1, At, B1); PG8_BAR;
            PG8_LDA(At, 0, 1); PG8_STAGE(PG8_SA(0, 0), a2, voffA);
            PG8_BAR; PG8_WAIT_L(0); PG8_MMA(1, 0, At, B0); PG8_BAR; PG8_SCHED;
            PG8_STAGE(PG8_SB(0, 1), b2 + hstep, voffB);
            PG8_WAIT_V(6); PG8_BAR; PG8_MMA(1, 1, At, B1); PG8_BAR;
            PG8_LDB(B0, 1, 0); PG8_SCHED; PG8_LDA(At, 1, 0); PG8_STAGE(PG8_SA(0, 1), a2 + hstep, voffA);
            PG8_WAIT_L(8); PG8_BAR; PG8_WAIT_L(0); PG8_MMA(0, 0, At, B0); PG8_BAR; PG8_SCHED;
            PG8_LDB(B1, 1, 1); PG8_STAGE(PG8_SB(1, 0), b3, voffB);
            PG8_BAR; PG8_WAIT_L(0); PG8_MMA(0, 1, At, B1); PG8_BAR;
            PG8_LDA(At, 1, 1); PG8_STAGE(PG8_SA(1, 0), a3, voffA);
            PG8_BAR; PG8_WAIT_L(0); PG8_MMA(1, 0, At, B0); PG8_BAR; PG8_SCHED;
            PG8_STAGE(PG8_SB(1, 1), b3 + hstep, voffB);
            PG8_WAIT_V(6); PG8_BAR; PG8_MMA(1, 1, At, B1); PG8_BAR;
            }
        }
        if constexpr (ALIGN_EPI) { if (wr == 0) PG8_BAR; }
        if constexpr (!Epi::AFTER_DRAIN) { E(acc, cur, wr, wc, fr, fq); S.done(cur); }
        if (!has_next) break;
#pragma unroll
        for (int a = 0; a < 2; ++a)
#pragma unroll
            for (int b = 0; b < 2; ++b)
#pragma unroll
                for (int m = 0; m < 4; ++m)
#pragma unroll
                    for (int n = 0; n < 2; ++n) acc[a][b][m][n] = (f32x4){0.f, 0.f, 0.f, 0.f};
        cur = nxt; cA = nA; cB = nB; ++ui;
        if constexpr (ALIGN_EPI) { if (wr == 1) PG8_BAR; }
    }
    PG8_WAIT_V(0);
    if constexpr (!ALIGN_EPI) { if (wr == 0) PG8_BAR; }
    PG8_BAR;
    if constexpr (Epi::AFTER_DRAIN) { E.fused(acc, cur, wr, wc, fr, fq, lds, wid, lane); S.done(cur); }
#undef PG8_SA
#undef PG8_SB
#undef PG8_STAGE
#undef PG8_LDA
#undef PG8_LDB
#undef PG8_MMA
#undef PG8_WAIT_V
#undef PG8_WAIT_L
#undef PG8_BAR
#undef PG8_SCHED
}
}

constexpr int NWAVES = 8, NTHREADS = 512;
#ifndef MK_N_LAUNCHES
#define MK_N_LAUNCHES 1
#endif
constexpr int BATCH = 8, SEQ = 2048, D = 1024, FF = 4096, NH = 4, DK = 128, DV = 256, QKW = 512, VW = 1024;
constexpr int M = BATCH * SEQ, NPROJ = 3072, CH = 64, NCH = SEQ / CH;
constexpr int MLSTM_IN = 3080, GLA_IN = 3088;
constexpr float EPS = 1e-6f, QK_SCALE = 0.08838834764831845f, INV_TAU = 1.0f / 16.0f;

constexpr size_t MiB = 1u << 20;
constexpr size_t WS_CTL = 0, CTL_ZERO_BYTES = 64 * 1024;
constexpr size_t WS_GATES = 1 * MiB;
constexpr size_t WS_GDEC = 2 * MiB;
constexpr size_t WS_SUMSQ = 2 * MiB + 512 * 1024;
constexpr size_t WS_WIN = 4 * MiB, WS_WOUT = 10 * MiB, WS_W1 = 12 * MiB, WS_W2 = 20 * MiB, WS_WLAYER = 56 * MiB;
constexpr size_t WS_SSQ = 84 * MiB;
constexpr size_t WS_AOP = 28 * MiB;
constexpr size_t WS_PROJ = 92 * MiB, WS_BBLK = 16 * MiB, WS_QT_OFF = 12 * MiB, WS_KT_OFF = 14 * MiB;
constexpr size_t BBLK_E = WS_BBLK / 2;
constexpr size_t WS_HMID = 92 * MiB;
constexpr size_t WS_XRES = 220 * MiB;
constexpr size_t WS_END = 252 * MiB;
constexpr int CW_BAR = 1024, CW_XID = 8192, CW_XCL = 9216, CW_FIN = 14336, CW_GRP = 15360;

constexpr int RING_BYTES = 131072, LDS_BYTES = 163840, LDSCTL_OFF = LDS_BYTES - 1024, MISC_OFF = LDSCTL_OFF + 320;

#define GAS __attribute__((address_space(1)))
#define LAS __attribute__((address_space(3)))
typedef unsigned short bf16;
typedef unsigned v4u __attribute__((ext_vector_type(4)));
typedef unsigned v2u __attribute__((ext_vector_type(2)));
typedef float f32x4 __attribute__((ext_vector_type(4)));
typedef float f32x16 __attribute__((ext_vector_type(16)));
typedef short bf16x8 __attribute__((ext_vector_type(8)));
typedef short s16x4 __attribute__((ext_vector_type(4)));
typedef GAS unsigned gu32;
#define RLX_AGENT __ATOMIC_RELAXED, __HIP_MEMORY_SCOPE_AGENT
#define LDS_WAIT() asm volatile("s_waitcnt lgkmcnt(0)" ::: "memory")
#define VM_WAIT() asm volatile("s_waitcnt vmcnt(0)" ::: "memory")
using pg8::pk_bf16;
__device__ __forceinline__ float bf2f(unsigned b) { return __uint_as_float(b << 16); }
__device__ __forceinline__ float bflo(unsigned w) { return __uint_as_float(w << 16); }
__device__ __forceinline__ float bfhi(unsigned w) { return __uint_as_float(w & 0xffff0000u); }
__device__ __forceinline__ unsigned short f2bf1(float f) { return (unsigned short)(pk_bf16(f, 0.f) & 0xffffu); }

struct Args { const float* in[15]; float* out; unsigned char* ws; int ph_lo, ph_hi; };
#define XB_TMO      128
#define XB_XCNT(j)  (256  + 64 * (j))
#define XB_XSUB(j)  (1280 + 64 * (j))
#define XB_XGEN(j)  (2304 + 64 * (j))
#define XB_TOP      3328
#define XB_TOPGEN   3392
#define XCD_BAR_WORDS 3456
#define XB_SPIN_CAP (1u << 18)
__device__ __forceinline__ unsigned xb_ld(unsigned* p)              { return __hip_atomic_load(p, __ATOMIC_RELAXED, __HIP_MEMORY_SCOPE_AGENT); }
__device__ __forceinline__ unsigned xb_add(unsigned* p, unsigned v) { return __hip_atomic_fetch_add(p, v, __ATOMIC_RELAXED, __HIP_MEMORY_SCOPE_AGENT); }
__device__ __forceinline__ unsigned xb_xcc_id() { return (unsigned)__builtin_amdgcn_s_getreg((3 << 11) | 20) & 0xFu; }
#define XB_SPIN(cond, bar) do { unsigned _sp = 0; while (cond) { __builtin_amdgcn_s_sleep(1); \
    if ((++_sp & 255u) == 0u) { if (xb_ld(&(bar)[XB_TMO])) break; if (_sp > XB_SPIN_CAP) { atomicAdd(&(bar)[XB_TMO], 1u); break; } } } } while (0)
struct XcdBarrier { unsigned* bar; unsigned x; volatile LAS unsigned* st; };
__device__ __forceinline__ XcdBarrier xcd_barrier_post(unsigned* bar, volatile LAS unsigned* st) {
    XcdBarrier b; b.bar = bar; b.x = xb_xcc_id(); b.st = st;
    if (threadIdx.x == 0) (void)xb_add(&bar[XB_XCNT(b.x)], 1u);
    return b;
}
__device__ __forceinline__ void xcd_barrier_complete(unsigned* bar, unsigned x, unsigned& nloc, unsigned& nx) {
    const unsigned G = gridDim.x * gridDim.y * gridDim.z;
    unsigned sum, cnt, mine, sp = 0u;
    for (;;) {
        sum = 0u; cnt = 0u; mine = 0u;
#pragma unroll
        for (unsigned j = 0; j < 16; ++j) { const unsigned c = xb_ld(&bar[XB_XCNT(j)]); sum += c; cnt += (c > 0u) ? 1u : 0u; mine = (j == x) ? c : mine; }
        if (sum == G) break;
        __builtin_amdgcn_s_sleep(1);
        if ((++sp & 255u) == 0u) { if (xb_ld(&bar[XB_TMO])) break; if (sp > XB_SPIN_CAP) { atomicAdd(&bar[XB_TMO], 1u); break; } }
    }
    nloc = mine > 0u ? mine : 1u; nx = cnt > 0u ? cnt : 1u;
}
__device__ __forceinline__ void xcd_barrier(const XcdBarrier& b) {
    asm volatile("s_waitcnt vmcnt(0)" ::: "memory");
    __syncthreads();
    if (threadIdx.x == 0) {
        unsigned* bar = b.bar;
        __builtin_amdgcn_s_waitcnt(0);
        unsigned nloc = b.st[0], nx = b.st[1];
        if (nloc == 0u) { xcd_barrier_complete(bar, b.x, nloc, nx); b.st[0] = nloc; b.st[1] = nx; }
        const unsigned old = xb_add(&bar[XB_XSUB(b.x)], 1u);
        const unsigned gen = old / nloc;
        if (old + 1u == (gen + 1u) * nloc) {
            __builtin_amdgcn_fence(__ATOMIC_RELEASE, "agent");
            asm volatile("s_waitcnt vmcnt(0)" ::: "memory");
            const unsigned og = xb_add(&bar[XB_TOP], 1u);
            const unsigned tg = og / nx;
            if (og + 1u == (tg + 1u) * nx) xb_add(&bar[XB_TOPGEN], 1u);
            else XB_SPIN(xb_ld(&bar[XB_TOPGEN]) == tg, bar);
            __builtin_amdgcn_fence(__ATOMIC_ACQUIRE, "agent");
            xb_add(&bar[XB_XGEN(b.x)], 1u);
            asm volatile("s_waitcnt vmcnt(0)" ::: "memory");
        } else {
            XB_SPIN(xb_ld(&bar[XB_XGEN(b.x)]) == gen, bar);
            __builtin_amdgcn_fence(__ATOMIC_ACQUIRE, "agent");
            asm volatile("s_waitcnt vmcnt(0)" ::: "memory");
        }
    }
    __syncthreads();
}

__device__ __forceinline__ float wave_sum(float v) {
#pragma unroll
    for (int o = 1; o < 64; o <<= 1) v += __shfl_xor(v, o);
    return v;
}
struct CvItem { const float* W; bf16* WT; const float* gain; int K, ldw, k0, n0; };
__device__ __forceinline__ CvItem cv_item(const Args& args, unsigned char* ws, int it) {
    constexpr int I_IN = (D / 64) * (NPROJ / 64), I_O = (D / 64) * (D / 64), I_1 = (D / 64) * (FF / 64), I_2 = (FF / 64) * (D / 64), NITEMS = I_IN + I_O + I_1 + I_2;
    const int layer = it >= NITEMS; int r = it - layer * NITEMS; unsigned char* wl = ws + (size_t)layer * WS_WLAYER;
    CvItem c; int N;
    if (r < I_IN) { c.W = args.in[layer ? 8 : 4]; c.K = D; N = NPROJ; c.ldw = layer ? GLA_IN : MLSTM_IN; c.WT = (bf16*)(wl + WS_WIN); c.gain = args.in[1] + layer * D; }
    else if ((r -= I_IN) < I_O) { c.W = args.in[layer ? 12 : 7]; c.K = D; N = D; c.ldw = D; c.WT = (bf16*)(wl + WS_WOUT); c.gain = nullptr; }
    else if ((r -= I_O) < I_1) { c.W = args.in[13] + (size_t)layer * D * FF; c.K = D; N = FF; c.ldw = FF; c.WT = (bf16*)(wl + WS_W1); c.gain = args.in[2] + layer * D; }
    else { r -= I_1; c.W = args.in[14] + (size_t)layer * D * FF; c.K = FF; N = D; c.ldw = D; c.WT = (bf16*)(wl + WS_W2); c.gain = nullptr; }
    const int nblk = N / 64; c.k0 = 64 * (r / nblk); c.n0 = 64 * (r % nblk);
    return c;
}
__device__ __forceinline__ void cv_load(f32x4 (&v)[16], const CvItem& c, int lane) {
    const int n4 = (lane & 15) * 4, krow = lane >> 4;
#pragma unroll
    for (int i = 0; i < 16; ++i) v[i] = *(const f32x4*)(c.W + (size_t)(c.k0 + 4 * i + krow) * c.ldw + c.n0 + n4);
}
__device__ __forceinline__ void cv_store(const f32x4 (&v)[16], const CvItem& c, LAS float* scr, int lane) {
    const int n4 = (lane & 15) * 4, krow = lane >> 4;
#pragma unroll
    for (int i = 0; i < 16; ++i) *(LAS f32x4*)(scr + (4 * i + krow) * 64 + (n4 ^ (((i >> 1) & 7) << 2))) = v[i];
    const int cc = lane & 7, nl = lane >> 3;
    f32x4 g0 = {1.f, 1.f, 1.f, 1.f}, g1 = {1.f, 1.f, 1.f, 1.f};
    if (c.gain) { g0 = *(const f32x4*)(c.gain + c.k0 + 8 * cc); g1 = *(const f32x4*)(c.gain + c.k0 + 8 * cc + 4); }
    LDS_WAIT(); asm volatile("" ::: "memory");
#pragma unroll
    for (int j = 0; j < 8; ++j) { const int n = 8 * j + nl; const LAS float* sp = scr + (8 * cc) * 64 + (n ^ (cc << 2));
        v4u o; o.x = pk_bf16(sp[0 * 64] * g0.x, sp[1 * 64] * g0.y); o.y = pk_bf16(sp[2 * 64] * g0.z, sp[3 * 64] * g0.w); o.z = pk_bf16(sp[4 * 64] * g1.x, sp[5 * 64] * g1.y); o.w = pk_bf16(sp[6 * 64] * g1.z, sp[7 * 64] * g1.w);
        *(GAS v4u*)(c.WT + (size_t)(c.n0 + n) * c.K + c.k0 + 8 * cc) = o; }
    LDS_WAIT(); asm volatile("" ::: "memory");
}
__device__ __forceinline__ void convert_weights(LAS unsigned char* lds, int lane, int wv, int nw, int vcu, int G, const Args& args, unsigned char* ws) {
    LAS float* scr = (LAS float*)(lds + wv * 16384);
    const int gw = vcu * nw + wv, NGW = G * nw;
    constexpr int NITEMS2 = 2 * ((D / 64) * (NPROJ / 64) + (D / 64) * (D / 64) + (D / 64) * (FF / 64) + (FF / 64) * (D / 64));
    f32x4 va[16], vb[16];
    int it = gw;
    if (it < NITEMS2) { const CvItem c0 = cv_item(args, ws, it); cv_load(va, c0, lane); }
    while (it < NITEMS2) {
        { const CvItem c = cv_item(args, ws, it); const int nx = it + NGW; if (nx < NITEMS2) { const CvItem cn = cv_item(args, ws, nx); cv_load(vb, cn, lane); } cv_store(va, c, scr, lane); it = nx; }
        if (it >= NITEMS2) break;
        { const CvItem c = cv_item(args, ws, it); const int nx = it + NGW; if (nx < NITEMS2) { const CvItem cn = cv_item(args, ws, nx); cv_load(va, cn, lane); } cv_store(vb, c, scr, lane); it = nx; }
    }
}

__device__ __forceinline__ void rows_first_stage(LAS float* WgT, int tid, const float* wg, int ldw, int ng) {
    { float wv[32];
#pragma unroll
      for (int n = 0; n < 32; ++n) { const int i = tid + NTHREADS * n, k = i >> 4, c = i & 15; wv[n] = (c < ng) ? wg[(size_t)k * ldw + c] : 0.f; }
#pragma unroll
      for (int n = 0; n < 32; ++n) { const int i = tid + NTHREADS * n, k = i >> 4, c = i & 15; WgT[c * D + k] = wv[n]; } }
}
__device__ __forceinline__ void rows_first(const LAS float* WgT, int lane, int wv, int nw, int vcu, int G, const float* xin, const float* gain, bf16* xres, float* sumsq, int ng, float* gates) {
    const int gw = vcu * nw + wv, NGW = G * nw;
    f32x4 gn[4];
#pragma unroll
    for (int j = 0; j < 4; ++j) gn[j] = *(const f32x4*)(gain + 4 * lane + 256 * j);
    f32x4 vn[4];
    if (gw < M) {
#pragma unroll
        for (int j = 0; j < 4; ++j) vn[j] = *(const f32x4*)(xin + (size_t)gw * D + 4 * lane + 256 * j); }
    for (int m = gw; m < M; m += NGW) {
        f32x4 v[4]; float s = 0.f;
#pragma unroll
        for (int j = 0; j < 4; ++j) { v[j] = vn[j]; s += (v[j].x * v[j].x + v[j].y * v[j].y) + (v[j].z * v[j].z + v[j].w * v[j].w); }
        if (m + NGW < M) {
#pragma unroll
            for (int j = 0; j < 4; ++j) vn[j] = *(const f32x4*)(xin + (size_t)(m + NGW) * D + 4 * lane + 256 * j); }
#pragma unroll
        for (int j = 0; j < 4; ++j) { v2u o; o.x = pk_bf16(v[j].x, v[j].y); o.y = pk_bf16(v[j].z, v[j].w); *(v2u*)(xres + (size_t)m * D + 4 * lane + 256 * j) = o; }
        const float ssum = wave_sum(s);
        if (lane == 0) *(f32x4*)(sumsq + (size_t)m * 4) = (f32x4){ssum, 0.f, 0.f, 0.f};
        const float rstd = 1.0f / sqrtf(ssum * (1.f / D) + EPS);
#pragma unroll
        for (int j = 0; j < 4; ++j) v[j] = v[j] * rstd * gn[j];
        float a[16];
#pragma unroll
        for (int c = 0; c < 16; ++c) a[c] = 0.f;
#pragma unroll
        for (int c = 0; c < 16; ++c) {
#pragma unroll
            for (int j = 0; j < 4; ++j) { const f32x4 w = *(const LAS f32x4*)(WgT + c * D + 4 * lane + 256 * j); a[c] += (v[j].x * w.x + v[j].y * w.y) + (v[j].z * w.z + v[j].w * w.w); }
            if (c & 1) asm volatile("" ::: "memory"); }
        const bool b5 = lane & 32, b4 = lane & 16, b3 = lane & 8, b2 = lane & 4;
#pragma unroll
        for (int i = 0; i < 8; ++i) { const float keep = b5 ? a[i + 8] : a[i], send = b5 ? a[i] : a[i + 8]; a[i] = keep + __shfl_xor(send, 32); }
#pragma unroll
        for (int i = 0; i < 4; ++i) { const float keep = b4 ? a[i + 4] : a[i], send = b4 ? a[i] : a[i + 4]; a[i] = keep + __shfl_xor(send, 16); }
#pragma unroll
        for (int i = 0; i < 2; ++i) { const float keep = b3 ? a[i + 2] : a[i], send = b3 ? a[i] : a[i + 2]; a[i] = keep + __shfl_xor(send, 8); }
        { const float keep = b2 ? a[1] : a[0], send = b2 ? a[0] : a[1]; a[0] = keep + __shfl_xor(send, 4); }
        a[0] += __shfl_xor(a[0], 2); a[0] += __shfl_xor(a[0], 1);
        const int c = (b5 ? 8 : 0) + (b4 ? 4 : 0) + (b3 ? 2 : 0) + (b2 ? 1 : 0);
        if ((lane & 3) == 0 && c < ng) gates[(size_t)m * 16 + c] = a[0];
    }
}
__device__ __forceinline__ void rows_final(int lane, int wave, int vcu, int G, const bf16* xres, const float* gain, float* out) {
    const int gw = vcu * NWAVES + wave, NGW = G * NWAVES;
    for (int m = gw; m < M; m += NGW) {
        float f[2][8]; float ss = 0.f;
#pragma unroll
        for (int j = 0; j < 2; ++j) { const v4u hv = *(const v4u*)(xres + (size_t)m * D + 8 * lane + 512 * j);
            f[j][0] = bflo(hv.x); f[j][1] = bfhi(hv.x); f[j][2] = bflo(hv.y); f[j][3] = bfhi(hv.y); f[j][4] = bflo(hv.z); f[j][5] = bfhi(hv.z); f[j][6] = bflo(hv.w); f[j][7] = bfhi(hv.w);
#pragma unroll
            for (int e = 0; e < 8; ++e) ss += f[j][e] * f[j][e]; }
        const float rstd = 1.0f / sqrtf(wave_sum(ss) * (1.f / D) + EPS);
#pragma unroll
        for (int j = 0; j < 2; ++j) { const int col = 8 * lane + 512 * j; const f32x4 g0 = *(const f32x4*)(gain + col), g1 = *(const f32x4*)(gain + col + 4);
            *(f32x4*)(out + (size_t)m * D + col) = (f32x4){f[j][0] * rstd * g0.x, f[j][1] * rstd * g0.y, f[j][2] * rstd * g0.z, f[j][3] * rstd * g0.w};
            *(f32x4*)(out + (size_t)m * D + col + 4) = (f32x4){f[j][4] * rstd * g1.x, f[j][5] * rstd * g1.y, f[j][6] * rstd * g1.z, f[j][7] * rstd * g1.w}; }
    }
}
struct RstdSlots { int pm0, pm1, pm2, pm3; };
__device__ __forceinline__ RstdSlots rstd_table(LAS float* rt, const float* sumsq, const pg8::StaticOrder& S, int tid) {
    int pmv[4] = {-1, -1, -1, -1}; int ns = 0;
    pg8::Unit u;
    for (int i = 0; S.next(i, u); ++i) { if (u.pm != pmv[0] && u.pm != pmv[1] && u.pm != pmv[2] && u.pm != pmv[3] && ns < 4) { if (ns == 0) pmv[0] = u.pm; else if (ns == 1) pmv[1] = u.pm; else if (ns == 2) pmv[2] = u.pm; else pmv[3] = u.pm; ++ns; } }
#pragma unroll
    for (int sl = 0; sl < 4; ++sl) { const int pm = sl == 0 ? pmv[0] : sl == 1 ? pmv[1] : sl == 2 ? pmv[2] : pmv[3];
        if (pm >= 0 && tid < 256) { const f32x4 s4 = *(const f32x4*)(sumsq + (size_t)(pm * 256 + tid) * 4); rt[sl * 256 + tid] = 1.0f / sqrtf(((s4.x + s4.y) + (s4.z + s4.w)) * (1.f / D) + EPS); } }
    __syncthreads();
    return RstdSlots{pmv[0], pmv[1], pmv[2], pmv[3]};
}

__device__ __forceinline__ void head_scale_table(LAS float* rt4, const float* ssq, int pm, int tid) {
    if (tid < 256) { const float* p = ssq + (size_t)(pm * 256 + tid) * 32; float sh[4];
#pragma unroll
        for (int h = 0; h < 4; ++h) { const f32x4 a = *(const f32x4*)(p + 8 * h), b = *(const f32x4*)(p + 8 * h + 4); sh[h] = 1.0f / sqrtf((((a.x + a.y) + (a.z + a.w)) + ((b.x + b.y) + (b.z + b.w))) * (1.f / DV) + EPS); }
        *(LAS f32x4*)(rt4 + 4 * tid) = (f32x4){sh[0] / sh[1], sh[1] / sh[2], sh[2] / sh[3], sh[3]}; }
    __syncthreads();
}
__device__ __forceinline__ void head_norm_rows(int lane, int wave, int vcu, int G, const bf16* hun, const float* gout, const bf16* proj, bf16* aop, const bool GLA) {
    const int rows_wg = M / G, rows_w = rows_wg / NWAVES;
    for (int i = 0; i < rows_w; ++i) {
        const int m = vcu * rows_wg + wave * rows_w + i;
#pragma unroll
        for (int j = 0; j < 2; ++j) {
            const int col = 8 * lane + 512 * j;
            const v4u hv = *(const v4u*)(hun + (size_t)m * D + col);
            const v4u rv = *(const v4u*)(proj + (size_t)(m >> 11) * BBLK_E + (size_t)(m & 2047) * NPROJ + 2048 + col);
            float f[8] = {bflo(hv.x), bfhi(hv.x), bflo(hv.y), bfhi(hv.y), bflo(hv.z), bfhi(hv.z), bflo(hv.w), bfhi(hv.w)};
            const float r[8] = {bflo(rv.x), bfhi(rv.x), bflo(rv.y), bfhi(rv.y), bflo(rv.z), bfhi(rv.z), bflo(rv.w), bfhi(rv.w)};
            float sg[8];
#pragma unroll
            for (int e = 0; e < 8; ++e) sg[e] = __builtin_amdgcn_rcpf(1.0f + __expf(-r[e]));
            if (!GLA) {
#pragma unroll
                for (int e = 0; e < 8; ++e) f[e] *= sg[e];
            }
            float ss = 0.f;
#pragma unroll
            for (int e = 0; e < 8; ++e) ss += f[e] * f[e];
#pragma unroll
            for (int o = 1; o < 32; o <<= 1) ss += __shfl_xor(ss, o);
            const float rs = 1.0f / sqrtf(ss * (1.f / DV) + EPS);
            const f32x4 g0 = *(const f32x4*)(gout + col), g1 = *(const f32x4*)(gout + col + 4);
            const float gg[8] = {g0.x, g0.y, g0.z, g0.w, g1.x, g1.y, g1.z, g1.w};
#pragma unroll
            for (int e = 0; e < 8; ++e) f[e] = f[e] * rs * gg[e];
            if (GLA) {
#pragma unroll
                for (int e = 0; e < 8; ++e) f[e] *= r[e] * sg[e];
            }
            v4u o; o.x = pk_bf16(f[0], f[1]); o.y = pk_bf16(f[2], f[3]); o.z = pk_bf16(f[4], f[5]); o.w = pk_bf16(f[6], f[7]);
            *(v4u*)(aop + (size_t)m * D + col) = o;
        }
    }
}

constexpr int GP_WGT = 0, GP_WGT_PITCH = 2064, GP_ZL = 33024, GP_TOT = 41216, GP_Q = 43264, GP_K = 59648;
__device__ __forceinline__ void gla_prep(LAS unsigned char* lds, int tid, int lane, int wave, int vcu, int G, const bf16* proj, const bf16* xres, const float* sumsq, const float* w_in, const float* gmix,
                                         const float* wup, const float* bgate, bf16* QT, bf16* KT, float* gdec) {
#define GP_BAR() do { asm volatile("s_waitcnt lgkmcnt(0)" ::: "memory"); __builtin_amdgcn_s_barrier(); asm volatile("" ::: "memory"); } while (0)
    LAS float* zl = (LAS float*)(lds + GP_ZL);
    LAS float* tot = (LAS float*)(lds + GP_TOT);
    LAS unsigned short* tq = (LAS unsigned short*)(lds + GP_Q);
    LAS unsigned short* tk = (LAS unsigned short*)(lds + GP_K);
    __syncthreads();
    { float wv[32];
#pragma unroll
      for (int n = 0; n < 32; ++n) { const int i = tid + NTHREADS * n, k = i >> 4, c = i & 15; wv[n] = gmix[k] * w_in[(size_t)k * GLA_IN + NPROJ + c]; }
#pragma unroll
      for (int n = 0; n < 32; ++n) { const int i = tid + NTHREADS * n, k = i >> 4, c = i & 15; *(LAS unsigned short*)(lds + GP_WGT + c * GP_WGT_PITCH + k * 2) = f2bf1(wv[n]); } }
    const int d = tid & 127, rg = tid >> 7;
    for (int unit = vcu; unit < BATCH * NCH; unit += G) {
        const int b = unit / NCH, c = unit % NCH, tok0 = b * SEQ + c * CH;
        const bf16* projb = proj + (size_t)b * BBLK_E + (size_t)(c * CH) * NPROJ; bf16* QTb = QT + (size_t)b * BBLK_E + (size_t)(c * CH) * QKW; bf16* KTb = KT + (size_t)b * BBLK_E + (size_t)(c * CH) * QKW;
        v4u pq[2], pk[2]; float wu[16]; float bg;
#define GP_LOAD(h_) do { _Pragma("unroll") for (int i_ = 0; i_ < 2; ++i_) { const int p_ = tid + NTHREADS * i_, row_ = p_ >> 4, ch_ = p_ & 15; \
            pq[i_] = *(const v4u*)(projb + (size_t)row_ * NPROJ + (h_) * DK + ch_ * 8); pk[i_] = *(const v4u*)(projb + (size_t)row_ * NPROJ + QKW + (h_) * DK + ch_ * 8); } \
            _Pragma("unroll") for (int cc_ = 0; cc_ < 16; ++cc_) wu[cc_] = wup[cc_ * QKW + (h_) * DK + d]; bg = bgate[(h_) * DK + d]; } while (0)
        GP_LOAD(0);
        const f32x4 s4pre = *(const f32x4*)(sumsq + (size_t)(tok0 + (tid >> 3)) * 4);
        GP_BAR();
        {
            const int rt = wave & 3, kh = wave >> 2, r16 = lane & 15, kq = lane >> 4;
            pg8::f32x4 acc = {0.f, 0.f, 0.f, 0.f};
            const bf16* xr = xres + (size_t)(tok0 + 16 * rt + r16) * D + kh * 512 + 8 * kq;
            LAS unsigned char* wr_ = lds + GP_WGT + r16 * GP_WGT_PITCH + (kh * 512 + 8 * kq) * 2;
#pragma unroll
            for (int ks = 0; ks < 16; ++ks) { const bf16x8 av = *(const bf16x8*)(xr + 32 * ks), bv = *(const LAS bf16x8*)(wr_ + 64 * ks); acc = __builtin_amdgcn_mfma_f32_16x16x32_bf16(av, bv, acc, 0, 0, 0); }
#pragma unroll
            for (int i = 0; i < 4; ++i) zl[kh * 1024 + (16 * rt + 4 * kq + i) * 16 + r16] = acc[i];
        }
        GP_BAR();
        { const int row = tid >> 3, c2 = (tid & 7) * 2;
          const f32x4 s4 = s4pre; const float rstd = 1.0f / sqrtf(((s4.x + s4.y) + (s4.z + s4.w)) * (1.f / D) + EPS);
          const float z0 = (zl[row * 16 + c2] + zl[1024 + row * 16 + c2]) * rstd, z1 = (zl[row * 16 + c2 + 1] + zl[1024 + row * 16 + c2 + 1]) * rstd;
          GP_BAR();
          zl[row * 16 + c2] = z0; zl[row * 16 + c2 + 1] = z1; }
        GP_BAR();
#pragma unroll
        for (int h = 0; h < NH; ++h) {
#pragma unroll
            for (int i = 0; i < 2; ++i) { const int p = tid + NTHREADS * i; *(LAS v4u*)(lds + GP_Q + p * 16) = pq[i]; *(LAS v4u*)(lds + GP_K + p * 16) = pk[i]; }
            float wuh[16]; const float bgh = bg;
#pragma unroll
            for (int cc = 0; cc < 16; ++cc) wuh[cc] = wu[cc];
            if (h + 1 < NH) GP_LOAD(h + 1);
            float bcum[16]; float run = 0.f;
#pragma unroll
            for (int jj = 0; jj < 16; ++jj) {
                const int j = 16 * rg + jj; float z = bgh;
#pragma unroll
                for (int q4 = 0; q4 < 4; ++q4) { const f32x4 zz = *(const LAS f32x4*)(zl + j * 16 + 4 * q4); z += (zz.x * wuh[4 * q4] + zz.y * wuh[4 * q4 + 1]) + (zz.z * wuh[4 * q4 + 2] + zz.w * wuh[4 * q4 + 3]); }
                const float la = (fminf(z, 0.f) - __logf(1.0f + __expf(-fabsf(z)))) * INV_TAU;
                run += la; bcum[jj] = run;
            }
            tot[rg * 128 + d] = run;
            GP_BAR();
            float off = 0.f, g = 0.f;
#pragma unroll
            for (int r2 = 0; r2 < 4; ++r2) { const float t = tot[r2 * 128 + d]; g += t; off += (r2 < rg) ? t : 0.f; }
#pragma unroll
            for (int jj = 0; jj < 16; ++jj) {
                const int j = 16 * rg + jj; const float eb = __expf(bcum[jj] + off);
                const float q = bf2f(tq[j * 128 + d]), k = bf2f(tk[j * 128 + d]);
                tq[j * 128 + d] = f2bf1(q * QK_SCALE * eb); tk[j * 128 + d] = f2bf1(k * __builtin_amdgcn_rcpf(eb));
            }
            if (rg == 0) gdec[(size_t)(unit * NH + h) * DK + d] = __expf(g);
            GP_BAR();
#pragma unroll
            for (int i = 0; i < 2; ++i) { const int p = tid + NTHREADS * i, row = p >> 4, ch = p & 15;
                *(v4u*)(QTb + (size_t)row * QKW + h * DK + ch * 8) = *(const LAS v4u*)(lds + GP_Q + p * 16);
                *(v4u*)(KTb + (size_t)row * QKW + h * DK + ch * 8) = *(const LAS v4u*)(lds + GP_K + p * 16); }
            GP_BAR();
        }
#undef GP_LOAD
    }
    __syncthreads();
}

#ifndef PROBE_P
#define PROBE_P 0
#endif
#ifndef PROBE_P_A
#define PROBE_P_A 0
#endif
#ifndef PROBE_P_B
#define PROBE_P_B 1
#endif
#define PP_SEL(i, S_) ((S_) < 32 ? (i) / 2 == (S_) : ((i) == 2 * ((S_) - 32) + 1 || (i) == 2 * ((S_) - 32) + 2))
#define PP_STAMP(i) do { if (PROBE_P && (PP_SEL(i, PROBE_P_A) || PP_SEL(i, PROBE_P_B)) && tid == 0) ((volatile LAS unsigned*)(lds + LDSCTL_OFF + 512))[i] = (unsigned)__builtin_amdgcn_s_memrealtime(); } while (0)
#ifndef PROBE_T
#define PROBE_T 0
#endif
#ifndef PROBE_T_MLSTM
#define PROBE_T_MLSTM 0
#endif
#ifndef PROBE_T_WAVE
#define PROBE_T_WAVE 0
#endif
#ifndef PROBE_T_A
#define PROBE_T_A 5
#endif
#ifndef PROBE_T_B
#define PROBE_T_B 0
#endif
constexpr int CW_PROBE = 12288;
__device__ __forceinline__ unsigned long long pt_now() { unsigned long long t; __builtin_amdgcn_sched_barrier(0); asm volatile("s_memrealtime %0\n\ts_waitcnt lgkmcnt(0)" : "=s"(t) :: "memory"); __builtin_amdgcn_sched_barrier(0); return t; }
#define PT_NOW() pt_now()
#define PT_ACC(i, t0) do { if (PROBE_T) { const unsigned long long t1_ = PT_NOW(); pt[i] += (unsigned)(t1_ - (t0)); (t0) = t1_; } } while (0)
constexpr int PS_PITCH = 144, CT_PITCH = 272, CT_BYTES = 32 * CT_PITCH, IMG_PITCH = 272, IMG_BYTES = 64 * IMG_PITCH, NUM_PITCH = 36;
template <bool MLSTM> struct MxMap;
template <> struct MxMap<true>  { static constexpr int QS = 0, KS = 34816, V = 69632, VW = 77824, VWAUX = 81920, PS = 86016, CT = 95232, TB = 112640, TWP = 120832, TPM = 129024, TSC = 137216, DEN = 137728, NUM = 138240, WI = 147456, GDEC = 0, END = 147968; };
template <> struct MxMap<false> { static constexpr int QS = 0, KS = 34816, V = 69632, VW = 0, VWAUX = 0, PS = 77824, CT = 87040, TB = 0, TWP = 0, TPM = 0, TSC = 0, DEN = 0, NUM = 104448, WI = 0, GDEC = 113664, END = 114688; };
#define LDSA(p) ((unsigned)(size_t)(p))
__device__ __forceinline__ bf16x8 mk8(v2u lo, v2u hi) { v4u w; w.x = lo.x; w.y = lo.y; w.z = hi.x; w.w = hi.y; return __builtin_bit_cast(bf16x8, w); }
__device__ __forceinline__ void tr_read2(bf16x8& f0, bf16x8& f1, unsigned a0, unsigned a1, unsigned b0, unsigned b1) {
    v2u l0, h0, l1, h1;
    asm volatile("ds_read_b64_tr_b16 %0, %4\n\tds_read_b64_tr_b16 %1, %5\n\tds_read_b64_tr_b16 %2, %6\n\tds_read_b64_tr_b16 %3, %7\n\ts_waitcnt lgkmcnt(0)"
                 : "=&v"(l0), "=&v"(h0), "=&v"(l1), "=&v"(h1) : "v"(a0), "v"(a1), "v"(b0), "v"(b1) : "memory");
    f0 = mk8(l0, h0); f1 = mk8(l1, h1);
}
__device__ __forceinline__ void tr_read3(bf16x8& f0, bf16x8& f1, bf16x8& f2, unsigned a0, unsigned a1, unsigned b0, unsigned b1, unsigned c0, unsigned c1) {
    v2u l0, h0, l1, h1, l2, h2;
    asm volatile("ds_read_b64_tr_b16 %0, %6\n\tds_read_b64_tr_b16 %1, %7\n\tds_read_b64_tr_b16 %2, %8\n\tds_read_b64_tr_b16 %3, %9\n\tds_read_b64_tr_b16 %4, %10\n\tds_read_b64_tr_b16 %5, %11\n\ts_waitcnt lgkmcnt(0)"
                 : "=&v"(l0), "=&v"(h0), "=&v"(l1), "=&v"(h1), "=&v"(l2), "=&v"(h2) : "v"(a0), "v"(a1), "v"(b0), "v"(b1), "v"(c0), "v"(c1) : "memory");
    f0 = mk8(l0, h0); f1 = mk8(l1, h1); f2 = mk8(l2, h2);
}
template <int P> __device__ __forceinline__ void tr_issue4(v2u (&x)[8], unsigned base) {
    asm volatile("ds_read_b64_tr_b16 %0, %8 offset:%9\n\tds_read_b64_tr_b16 %1, %8 offset:%10\n\tds_read_b64_tr_b16 %2, %8 offset:%11\n\tds_read_b64_tr_b16 %3, %8 offset:%12\n\t"
                 "ds_read_b64_tr_b16 %4, %8 offset:%13\n\tds_read_b64_tr_b16 %5, %8 offset:%14\n\tds_read_b64_tr_b16 %6, %8 offset:%15\n\tds_read_b64_tr_b16 %7, %8 offset:%16"
                 : "=&v"(x[0]), "=&v"(x[1]), "=&v"(x[2]), "=&v"(x[3]), "=&v"(x[4]), "=&v"(x[5]), "=&v"(x[6]), "=&v"(x[7])
                 : "v"(base), "i"(0), "i"(4 * P), "i"(16 * P), "i"(20 * P), "i"(32 * P), "i"(36 * P), "i"(48 * P), "i"(52 * P) : "memory");
}
__device__ __forceinline__ void tr_wait8(v2u (&x)[8]) { asm volatile("s_waitcnt lgkmcnt(0)" : "+v"(x[0]), "+v"(x[1]), "+v"(x[2]), "+v"(x[3]), "+v"(x[4]), "+v"(x[5]), "+v"(x[6]), "+v"(x[7]) :: "memory"); }
__device__ __forceinline__ void tr_pin8(v2u (&x)[8]) { asm volatile("" : "+v"(x[0]), "+v"(x[1]), "+v"(x[2]), "+v"(x[3]), "+v"(x[4]), "+v"(x[5]), "+v"(x[6]), "+v"(x[7])); }
__device__ __forceinline__ bf16x8 tr_read1(unsigned a0, unsigned a1) {
    v2u l0, h0;
    asm volatile("ds_read_b64_tr_b16 %0, %2\n\tds_read_b64_tr_b16 %1, %3\n\ts_waitcnt lgkmcnt(0)" : "=&v"(l0), "=&v"(h0) : "v"(a0), "v"(a1) : "memory");
    return mk8(l0, h0);
}
#define MFMA32(a, b, c) __builtin_amdgcn_mfma_f32_32x32x16_bf16((a), (b), (c), 0, 0, 0)
#define MX_BAR() do { asm volatile("s_waitcnt lgkmcnt(0)" ::: "memory"); __builtin_amdgcn_s_barrier(); asm volatile("" ::: "memory"); } while (0)
#define MX_BAR_VM() do { asm volatile("s_waitcnt vmcnt(0) lgkmcnt(0)" ::: "memory"); __builtin_amdgcn_s_barrier(); asm volatile("" ::: "memory"); } while (0)
struct MixArgs { const bf16 *q, *k, *proj; int qpitch; const float *gates, *bgate, *gdec; bf16* hun; void* probe; const float* gout; float* ssq; };
struct MixUnit { const bf16 *Qg, *Kg, *Vg, *Gg; bf16* Hg; const float* gdec; float* ssq; int qpitch, b, hh, slice; };
constexpr int MX_NPIECE = 38, MX_PPW = 5;
template <bool MLSTM> struct MixDma { static constexpr int PPW = MX_PPW; unsigned voff[PPW]; };
template <bool MLSTM> __device__ __forceinline__ int mx_piece(int wave, int i) { return wave + 8 * i; }

template <bool MLSTM>
__device__ __forceinline__ void mx_dma_setup(MixDma<MLSTM>& dm, int wave, int lane, int qpitch) {
#pragma unroll
    for (int i = 0; i < MixDma<MLSTM>::PPW; ++i) { const int pi = mx_piece<MLSTM>(wave, i); unsigned v = 0;
        if (pi < 34) { const int ob = (pi < 17 ? pi : pi - 17) * 1024 + lane * 16, row = ob / IMG_PITCH; int cb = ob - row * IMG_PITCH; cb = cb < 256 ? cb : 240; v = (unsigned)(row * qpitch * 2 + cb); }
        else { const int ob = (pi - 34) * 1024 + lane * 16, row = ob >> 6, cb = ob & 63; v = (unsigned)(row * NPROJ * 2 + cb); }
        dm.voff[i] = v; }
}
template <bool MLSTM>
__device__ __forceinline__ void mx_dma_issue(LAS unsigned char* lds, const MixDma<MLSTM>& dm, const MixUnit& U, int c, int wave, int tid) {
    typedef MxMap<MLSTM> MP;
    const int par = c & 1; const size_t tok0 = (size_t)c * CH;
    const char* qb = (const char*)(U.Qg + tok0 * U.qpitch); const char* kb = (const char*)(U.Kg + tok0 * U.qpitch); const char* vb = (const char*)(U.Vg + tok0 * NPROJ);
#pragma unroll
    for (int i = 0; i < MixDma<MLSTM>::PPW; ++i) { const int pi = mx_piece<MLSTM>(wave, i);
        if (pi < MX_NPIECE) {
            const char* src; int dst;
            if (pi < 17) { src = qb; dst = MP::QS + par * IMG_BYTES + pi * 1024; }
            else if (pi < 34) { src = kb; dst = MP::KS + par * IMG_BYTES + (pi - 17) * 1024; }
            else { src = vb; dst = MP::V + par * 4096 + (pi - 34) * 1024; }
            __builtin_amdgcn_global_load_lds((const unsigned*)(src + dm.voff[i]), (LAS unsigned*)(lds + dst), 16, 0, 0);
        } }
    if (!MLSTM && wave == 7) {
        const float* gd = U.gdec + (size_t)(((U.b * NCH + c) * NH) + U.hh) * DK + (tid & 63);
        __builtin_amdgcn_global_load_lds((const unsigned*)gd, (LAS unsigned*)(lds + MP::GDEC + par * 512), 4, 0, 0);
        __builtin_amdgcn_global_load_lds((const unsigned*)(gd + 64), (LAS unsigned*)(lds + MP::GDEC + par * 512 + 256), 4, 0, 0);
    }
}
__device__ __forceinline__ v4u mx_gate_load(const MixUnit& U, int c, int idx) { return *(const v4u*)(U.Gg + (size_t)(c * CH + (idx >> 2)) * NPROJ + 8 * (idx & 3)); }
template <bool MLSTM>
__device__ __forceinline__ void mx_finalize(LAS unsigned char* lds, const MixUnit& U, int cf, int idx, const float (&g8)[8], const v4u gv) {
    typedef MxMap<MLSTM> MP;
    const int j = idx >> 2, sg = idx & 3; float rden = 1.f;
    if (MLSTM) { const float mc = ((const LAS float*)(lds + MP::TSC))[cf];
        const float dn = ((const LAS float*)(lds + MP::DEN))[j], bb = ((const LAS float*)(lds + MP::TB))[cf * 64 + j], pm = ((const LAS float*)(lds + MP::TPM))[cf * 64 + j];
        rden = QK_SCALE * __builtin_amdgcn_rcpf(fmaxf(fabsf(dn) * QK_SCALE, __expf(-bb - fmaxf(mc, pm)))); }
    const f32x4 n0 = *(const LAS f32x4*)((const LAS float*)(lds + MP::NUM) + j * NUM_PITCH + 8 * sg), n1 = *(const LAS f32x4*)((const LAS float*)(lds + MP::NUM) + j * NUM_PITCH + 8 * sg + 4);
    const float nn[8] = {n0.x, n0.y, n0.z, n0.w, n1.x, n1.y, n1.z, n1.w};
    const float gt[8] = {bflo(gv.x), bfhi(gv.x), bflo(gv.y), bfhi(gv.y), bflo(gv.z), bfhi(gv.z), bflo(gv.w), bfhi(gv.w)};
    float y[8]; float ss = 0.f;
#pragma unroll
    for (int e = 0; e < 8; ++e) { const float sig = __builtin_amdgcn_rcpf(1.0f + __expf(-gt[e]));
        if (MLSTM) { const float v = nn[e] * rden * sig; ss += v * v; y[e] = v * g8[e]; }
        else { const float v = nn[e]; ss += v * v; y[e] = v * g8[e] * gt[e] * sig; } }
    ss += __shfl_xor(ss, 1); ss += __shfl_xor(ss, 2);
    const size_t row = (size_t)U.b * SEQ + cf * CH + j;
    if (sg == 0) U.ssq[row * 32 + U.hh * 8 + U.slice] = ss;
    v4u w; w.x = pk_bf16(y[0], y[1]); w.y = pk_bf16(y[2], y[3]); w.z = pk_bf16(y[4], y[5]); w.w = pk_bf16(y[6], y[7]);
    *(v4u*)(U.Hg + row * D + 8 * sg) = w;
}

template <bool MLSTM>
__device__ __forceinline__ void mx_step(LAS unsigned char* lds, const MixDma<MLSTM>& dm, const MixUnit& U, int c, f32x16& accC0, f32x16& accC1, f32x16& accO, int tid, int lane, int wave, unsigned (&pt)[8], const float (&g8)[8], v4u& gl0, v4u& gl1) {
    typedef MxMap<MLSTM> MP;
    const bool fin_wave = MLSTM ? (wave >= 4) : (wave >= 6);
    unsigned long long tp = PROBE_T ? PT_NOW() : 0ull;
    const int r = lane & 31, h5 = lane >> 5, blk = (lane >> 4) & 1, q4 = (lane & 15) >> 2, p4 = lane & 3, par = c & 1;
    const LAS float* TSC = (const LAS float*)(lds + MP::TSC);
    LAS unsigned char* qimg0 = lds + MP::QS + par * IMG_BYTES; LAS unsigned char* kimg0 = lds + MP::KS + par * IMG_BYTES; LAS unsigned char* vimg0 = lds + MP::V + par * 4096;
    if (!fin_wave && c + 1 < NCH) mx_dma_issue<MLSTM>(lds, dm, U, c + 1, wave, tid);
    PT_ACC(6, tp);
    const float mc = MLSTM ? TSC[c] : 0.f;
    if (wave < 4) {
        const int st = wave >> 1, jt = (wave == 1 || wave == 2) ? 1 : 0;
#pragma unroll
        for (int i = 0; i < 16; ++i) accO[i] = 0.f;
        if (MLSTM && wave == 3) {
#pragma unroll
            for (int i = 0; i < 4; ++i) { const int id = lane + 64 * i, row = id >> 2, pc = id & 3;
                const float wr_ = __expf(((const LAS float*)(lds + MP::TWP))[c * 64 + row] - TSC[32 + c]); const v4u pv = *(const LAS v4u*)(vimg0 + row * 64 + pc * 16); v4u o;
                o.x = pk_bf16(bflo(pv.x) * wr_, bfhi(pv.x) * wr_); o.y = pk_bf16(bflo(pv.y) * wr_, bfhi(pv.y) * wr_); o.z = pk_bf16(bflo(pv.z) * wr_, bfhi(pv.z) * wr_); o.w = pk_bf16(bflo(pv.w) * wr_, bfhi(pv.w) * wr_);
                *(LAS v4u*)(lds + MP::VW + row * 64 + pc * 16) = o;
                if (pc == 0) *(LAS unsigned short*)(lds + MP::VWAUX + row * 64) = f2bf1(wr_); }
        }
        if (wave != 3) {
            LAS unsigned char* kimg = kimg0 + (32 * st + r) * IMG_PITCH + 16 * h5;
            LAS unsigned char* qimg = qimg0 + (32 * jt + r) * IMG_PITCH + 16 * h5;
#pragma unroll
            for (int ks = 0; ks < 8; ++ks) { const bf16x8 a = *(const LAS bf16x8*)(kimg + 32 * ks), bq = *(const LAS bf16x8*)(qimg + 32 * ks); accO = MFMA32(a, bq, accO); }
        }
        const int j = 32 * jt + r;
        if (wave == 3) {
#pragma unroll
            for (int g4 = 0; g4 < 4; ++g4) *(LAS v2u*)(lds + MP::PS + j * PS_PITCH + (32 * st + 8 * g4 + 4 * h5) * 2) = (v2u){0u, 0u};
        } else {
            float uj = 0.f;
            if (MLSTM) uj = -fmaxf(mc, ((const LAS float*)(lds + MP::TPM))[c * 64 + j]);
#pragma unroll
            for (int g4 = 0; g4 < 4; ++g4) { const int s0 = 32 * st + 8 * g4 + 4 * h5; f32x4 wps = {0.f, 0.f, 0.f, 0.f}; if (MLSTM) wps = *(const LAS f32x4*)((const LAS float*)(lds + MP::TWP) + c * 64 + s0);
                float v[4];
#pragma unroll
                for (int e = 0; e < 4; ++e) { float x = accO[4 * g4 + e]; if (MLSTM) x *= __expf(uj + wps[e]); v[e] = (s0 + e <= j) ? x : 0.f; }
                v2u o; o.x = pk_bf16(v[0], v[1]); o.y = pk_bf16(v[2], v[3]); *(LAS v2u*)(lds + MP::PS + j * PS_PITCH + s0 * 2) = o; }
        }
    } else {
        const int g = (wave - 4) >> 1, jt = wave & 1;
        if (fin_wave) {
            const int fi = MLSTM ? tid - 256 : tid - 384;
            if (c > 0) { mx_finalize<MLSTM>(lds, U, c - 1, fi, g8, gl0); if (!MLSTM) mx_finalize<MLSTM>(lds, U, c - 1, fi + 128, g8, gl1); }
            if (c + 1 < NCH) mx_dma_issue<MLSTM>(lds, dm, U, c + 1, wave, tid);
        }
        if (MLSTM || g == 0) {
#pragma unroll
            for (int i = 0; i < 16; ++i) accO[i] = 0.f;
#pragma unroll
            for (int ks = 0; ks < 8; ++ks) { const bf16x8 a = *(const LAS bf16x8*)(qimg0 + (32 * jt + r) * IMG_PITCH + 16 * h5 + 32 * ks), bc = *(const LAS bf16x8*)(lds + MP::CT + g * CT_BYTES + r * CT_PITCH + 32 * ks + 16 * h5); accO = MFMA32(a, bc, accO); }
            if (MLSTM) {
#pragma unroll
                for (int g4 = 0; g4 < 4; ++g4) { const f32x4 wi = *(const LAS f32x4*)((const LAS float*)(lds + MP::WI) + par * 64 + 32 * jt + 8 * g4 + 4 * h5);
#pragma unroll
                    for (int e = 0; e < 4; ++e) accO[4 * g4 + e] *= wi[e]; }
            }
        }
    }
    PT_ACC(2, tp);
    MX_BAR();
    PT_ACC(3, tp);
    if (fin_wave) { const int fi = MLSTM ? tid - 256 : tid - 384; gl0 = mx_gate_load(U, c, fi); if (!MLSTM) gl1 = mx_gate_load(U, c, fi + 128); }
    if (wave < 4) {
        if (MLSTM) { const float decay = __expf(mc - TSC[32 + c]); accC0 = accC0 * decay; accC1 = accC1 * decay; }
        LAS unsigned char* kimg = kimg0 + (8 * h5 + q4) * IMG_PITCH + 64 * wave + 32 * blk + 8 * p4;
        LAS unsigned char* vimg = (MLSTM ? lds + MP::VW : vimg0) + (8 * h5 + q4) * 64 + 32 * blk + 8 * p4;
        LAS unsigned char* vaux = lds + MP::VWAUX + (8 * h5 + q4) * 64 + 32 * blk + 8 * p4;
        { v2u xk[8], xv[8], xa[8];
          tr_issue4<IMG_PITCH>(xk, LDSA(kimg)); tr_issue4<64>(xv, LDSA(vimg)); if (MLSTM) tr_issue4<64>(xa, LDSA(vaux));
          tr_wait8(xk); tr_pin8(xv); if (MLSTM) tr_pin8(xa);
          __builtin_amdgcn_sched_barrier(0);
#pragma unroll
          for (int ks = 0; ks < 4; ++ks) { const bf16x8 a = mk8(xk[2 * ks], xk[2 * ks + 1]);
              accC0 = MFMA32(a, mk8(xv[2 * ks], xv[2 * ks + 1]), accC0);
              if (MLSTM) accC1 = MFMA32(a, mk8(xa[2 * ks], xa[2 * ks + 1]), accC1); } }
        if (!MLSTM) {
#pragma unroll
            for (int g4 = 0; g4 < 4; ++g4) { const f32x4 dc = *(const LAS f32x4*)((const LAS float*)(lds + MP::GDEC) + par * 128 + 32 * wave + 8 * g4 + 4 * h5);
#pragma unroll
                for (int e = 0; e < 4; ++e) accC0[4 * g4 + e] *= dc[e]; }
        }
#pragma unroll
        for (int g4 = 0; g4 < 4; ++g4) { const int d0 = 32 * wave + 8 * g4 + 4 * h5;
            v2u o; o.x = pk_bf16(accC0[4 * g4], accC0[4 * g4 + 1]); o.y = pk_bf16(accC0[4 * g4 + 2], accC0[4 * g4 + 3]); *(LAS v2u*)(lds + MP::CT + r * CT_PITCH + d0 * 2) = o;
            if (MLSTM) { v2u o1; o1.x = pk_bf16(accC1[4 * g4], accC1[4 * g4 + 1]); o1.y = pk_bf16(accC1[4 * g4 + 2], accC1[4 * g4 + 3]); *(LAS v2u*)(lds + MP::CT + CT_BYTES + r * CT_PITCH + d0 * 2) = o1; } }
    } else {
        const int g = (wave - 4) >> 1, jt = wave & 1;
        if (MLSTM || g == 0) {
            const bf16x8 ones = (r == 0) ? (bf16x8){0x3F80, 0x3F80, 0x3F80, 0x3F80, 0x3F80, 0x3F80, 0x3F80, 0x3F80} : (bf16x8){0, 0, 0, 0, 0, 0, 0, 0};
            LAS unsigned char* vimg = vimg0 + (8 * h5 + q4) * 64 + 32 * blk + 8 * p4;
            bf16x8 pa[4];
#pragma unroll
            for (int ks = 0; ks < 4; ++ks) pa[ks] = *(const LAS bf16x8*)(lds + MP::PS + (32 * jt + r) * PS_PITCH + 32 * ks + 16 * h5);
            if (g == 0) { v2u xv[8]; tr_issue4<64>(xv, LDSA(vimg)); tr_wait8(xv); __builtin_amdgcn_sched_barrier(0);
#pragma unroll
                for (int ks = 0; ks < 4; ++ks) accO = MFMA32(pa[ks], mk8(xv[2 * ks], xv[2 * ks + 1]), accO);
            } else {
#pragma unroll
                for (int ks = 0; ks < 4; ++ks) accO = MFMA32(pa[ks], ones, accO); }
            if (g == 0) {
#pragma unroll
                for (int i = 0; i < 16; ++i) ((LAS float*)(lds + MP::NUM))[(32 * jt + (i & 3) + 8 * (i >> 2) + 4 * h5) * NUM_PITCH + r] = accO[i];
            }
            if (MLSTM && wave == 7 && c + 1 < NCH) { const float m1 = TSC[c + 1]; ((LAS float*)(lds + MP::WI))[(par ^ 1) * 64 + lane] = __expf(m1 - fmaxf(m1, ((const LAS float*)(lds + MP::TPM))[(c + 1) * 64 + lane])); }
            if (MLSTM && g == 1 && r == 0) {
#pragma unroll
                for (int i = 0; i < 16; ++i) ((LAS float*)(lds + MP::DEN))[32 * jt + (i & 3) + 8 * (i >> 2) + 4 * h5] = accO[i];
            }
        }
    }
    PT_ACC(4, tp);
    MX_BAR_VM();
    PT_ACC(5, tp);
}

template <bool MLSTM>
__device__ __forceinline__ void mixer_phase(LAS unsigned char* lds, int tid, int lane, int wave, int vcu, int G, const MixArgs A) {
    typedef MxMap<MLSTM> MP;
    MixDma<MLSTM> dm; mx_dma_setup<MLSTM>(dm, wave, lane, A.qpitch);
    unsigned pt[8] = {0u, 0u, 0u, 0u, 0u, 0u, 0u, 0u}; unsigned long long tph = PROBE_T ? PT_NOW() : 0ull; unsigned long long tin = tph;
    for (int unit = vcu; unit < BATCH * NH * 8; unit += G) {
        const int slice = unit & 7, bh = unit >> 3;
        MixUnit U; U.b = bh >> 2; U.hh = bh & 3; U.qpitch = A.qpitch; U.gdec = A.gdec;
        U.Qg = A.q + (size_t)U.b * BBLK_E + U.hh * DK; U.Kg = A.k + (size_t)U.b * BBLK_E + U.hh * DK; U.Vg = A.proj + (size_t)U.b * BBLK_E + 1024 + U.hh * DV + 32 * slice; U.Hg = A.hun + U.hh * DV + 32 * slice;
        U.Gg = A.proj + (size_t)U.b * BBLK_E + 2048 + U.hh * DV + 32 * slice; U.ssq = A.ssq; U.slice = slice;

        MX_BAR_VM();
        mx_dma_issue<MLSTM>(lds, dm, U, 0, wave, tid);
        float g8[8];
#pragma unroll
        for (int e = 0; e < 8; ++e) g8[e] = A.gout[U.hh * DV + 32 * slice + 8 * (tid & 3) + e];
        for (int i = tid; i < 2 * CT_BYTES / 4; i += NTHREADS) ((LAS unsigned*)(lds + MP::CT))[i] = 0u;
        if (MLSTM) {
            for (int i = tid; i < 1024; i += NTHREADS) ((LAS unsigned*)(lds + MP::VWAUX))[i] = 0u;
            LAS float* TB = (LAS float*)(lds + MP::TB); LAS float* TWP = (LAS float*)(lds + MP::TWP); LAS float* TPM = (LAS float*)(lds + MP::TPM); LAS float* TSC = (LAS float*)(lds + MP::TSC);
            const float bgi = A.bgate[U.hh], bgf = A.bgate[4 + U.hh];
            float gi4[4], gf4[4];
#pragma unroll
            for (int cc = 0; cc < 4; ++cc) { const size_t tok = (size_t)U.b * SEQ + (wave + 8 * cc) * CH + lane; gi4[cc] = A.gates[tok * 16 + U.hh] + bgi; gf4[cc] = A.gates[tok * 16 + 4 + U.hh] + bgf; }
#pragma unroll
            for (int cc = 0; cc < 4; ++cc) { const int c = wave + 8 * cc;
                const float lf = fminf(gf4[cc], 0.f) - __logf(1.0f + __expf(-fabsf(gf4[cc])));
                float bsum = lf;
#pragma unroll
                for (int o = 1; o < 64; o <<= 1) { const float t = __shfl_up(bsum, o); if (lane >= o) bsum += t; }
                const float wp = gi4[cc] - bsum; float pm = wp;
#pragma unroll
                for (int o = 1; o < 64; o <<= 1) { const float t = __shfl_up(pm, o); if (lane >= o) pm = fmaxf(pm, t); }
                TB[c * 64 + lane] = bsum; TWP[c * 64 + lane] = wp; TPM[c * 64 + lane] = pm;
                if (lane == 63) { TSC[64 + c] = bsum; TSC[96 + c] = pm; } }
            MX_BAR();
            if (wave == 7) ((LAS float*)(lds + MP::WI))[lane] = __expf(-fmaxf(0.f, TPM[lane]));
            if (wave == 0) {
                const float gl = TSC[64 + (lane & 31)], pl = TSC[96 + (lane & 31)]; float m = 0.f, myM = 0.f, myX = 0.f;
#pragma clang loop unroll(disable)
                for (int c = 0; c < NCH; ++c) { const float gc = __uint_as_float(__builtin_amdgcn_readlane(__float_as_uint(gl), c)), pc = __uint_as_float(__builtin_amdgcn_readlane(__float_as_uint(pl), c));
                    const float mxe = fmaxf(m, pc); if (lane == c) { myM = m; myX = mxe; } m = gc + mxe; }
                if (lane < 32) { TSC[lane] = myM; TSC[32 + lane] = myX; }
            }
        }
        f32x16 accC0, accC1, accO; v4u gl0 = {0u, 0u, 0u, 0u}, gl1 = {0u, 0u, 0u, 0u};
#pragma unroll
        for (int i = 0; i < 16; ++i) { accC0[i] = 0.f; accC1[i] = 0.f; accO[i] = 0.f; }
        MX_BAR_VM();
        PT_ACC(1, tin);
#pragma clang loop unroll(disable)
        for (int c = 0; c < NCH; ++c) mx_step<MLSTM>(lds, dm, U, c, accC0, accC1, accO, tid, lane, wave, pt, g8, gl0, gl1);
        if (MLSTM) { if (wave >= 4) mx_finalize<true>(lds, U, NCH - 1, tid - 256, g8, gl0); } else if (wave >= 6) { mx_finalize<false>(lds, U, NCH - 1, tid - 384, g8, gl0); mx_finalize<false>(lds, U, NCH - 1, tid - 384 + 128, g8, gl1); }
    }
    MX_BAR_VM();
    if (PROBE_T && (PROBE_T_MLSTM != 0) == MLSTM && vcu == 0 && wave == PROBE_T_WAVE && lane == 0) { PT_ACC(0, tph); unsigned* pw = (unsigned*)A.probe; pw[0] = pt[PROBE_T_A]; pw[1] = pt[PROBE_T_B]; }
}

constexpr int N_PHASES = 15, RT_OFF = RING_BYTES;
template <int PH>
__device__ __forceinline__ void run_phase(const Args& args, LAS unsigned char* lds, int tid, int lane, int wave, int vcu, int G, int bx) {
    unsigned char* ws = args.ws;
    constexpr int layer = (PH >= 8) ? 1 : 0, k = (PH == 0) ? -1 : PH - 1 - 7 * layer;
    unsigned char* wl = ws + (size_t)layer * WS_WLAYER;
    bf16* AOP = (bf16*)(ws + WS_AOP); bf16* PROJ = (bf16*)(ws + WS_PROJ); bf16* HMID = (bf16*)(ws + WS_HMID); bf16* XRES = (bf16*)(ws + WS_XRES);
    float* GATES = (float*)(ws + WS_GATES); float* SUMSQ = (float*)(ws + WS_SUMSQ);
    LAS float* RT = (LAS float*)(lds + RT_OFF);
    if constexpr (k == -1) {
        LAS float* WgT = (LAS float*)(lds + 65536);
        rows_first_stage(WgT, tid, args.in[4] + NPROJ, MLSTM_IN, 8);
        __syncthreads();
        if (wave < 4) convert_weights(lds, lane, wave, 4, vcu, G, args, ws);
        else rows_first(WgT, lane, wave - 4, 4, vcu, G, args.in[0], args.in[1], XRES, SUMSQ, 8, GATES);
    } else if constexpr (k == 0) {
        pg8::Gemm g{XRES, (const bf16*)(wl + WS_WIN), M, NPROJ, D}; pg8::StaticOrder S; S.init(M, NPROJ, G, bx);
        const RstdSlots rs = rstd_table(RT, SUMSQ, S, tid);
        pg8::EpiBf16S<0> E{PROJ, NPROJ, (const LAS float*)RT, rs.pm1, rs.pm2, rs.pm3, BBLK_E};
        pg8::gemm_phase<pg8::EpiBf16S<0>, pg8::StaticOrder, true, true>(lds, g, S, E);
    } else if constexpr (k == 1) {
        if (layer) gla_prep(lds, tid, lane, wave, vcu, G, PROJ, XRES, SUMSQ, args.in[8], args.in[1] + D, args.in[9], args.in[10], (bf16*)(ws + WS_PROJ + WS_QT_OFF), (bf16*)(ws + WS_PROJ + WS_KT_OFF), (float*)(ws + WS_GDEC));
    } else if constexpr (k == 2) {
        if (layer == 0) { const MixArgs A{PROJ, PROJ + QKW, PROJ, NPROJ, GATES, args.in[5], nullptr, AOP, ws + WS_CTL + 4 * CW_PROBE, args.in[6], (float*)(ws + WS_SSQ)}; mixer_phase<true>(lds, tid, lane, wave, vcu, G, A); }
        else { const MixArgs A{(const bf16*)(ws + WS_PROJ + WS_QT_OFF), (const bf16*)(ws + WS_PROJ + WS_KT_OFF), PROJ, QKW, nullptr, nullptr, (const float*)(ws + WS_GDEC), AOP, ws + WS_CTL + 4 * CW_PROBE, args.in[11], (float*)(ws + WS_SSQ)}; mixer_phase<false>(lds, tid, lane, wave, vcu, G, A); }
    } else if constexpr (k == 3) {
    } else if constexpr (k == 4) {
        pg8::Gemm g{AOP, (const bf16*)(wl + WS_WOUT), M, D, D}; pg8::StaticOrder S; S.init(M, D, G, bx);
        pg8::Unit u0; S.next(0, u0); head_scale_table(RT, (const float*)(ws + WS_SSQ), u0.pm, tid);
        pg8::EpiResBf16SqH E{XRES, SUMSQ, D, (const LAS float*)RT};
        pg8::gemm_phase<pg8::EpiResBf16SqH, pg8::StaticOrder, false, true>(lds, g, S, E);
    } else if constexpr (k == 5) {
        pg8::Gemm g{XRES, (const bf16*)(wl + WS_W1), M, FF, D}; pg8::StaticOrder S; S.init(M, FF, G, bx);
        const RstdSlots rs = rstd_table(RT, SUMSQ, S, tid);
        pg8::EpiBf16S<2> E{HMID, FF, (const LAS float*)RT, rs.pm1, rs.pm2, rs.pm3, (size_t)2048 * FF};
        pg8::gemm_phase<pg8::EpiBf16S<2>, pg8::StaticOrder, true, true>(lds, g, S, E);
    } else if constexpr (k == 6 && layer == 0) {
        pg8::Gemm g{HMID, (const bf16*)(wl + WS_W2), M, D, FF}; pg8::StaticOrder S; S.init(M, D, G, bx);
        pg8::EpiResBf16Sq E{XRES, SUMSQ, D};
        pg8::gemm_phase<pg8::EpiResBf16Sq, pg8::StaticOrder, false, true>(lds, g, S, E);
    } else if constexpr (k == 6) {
        pg8::Gemm g{HMID, (const bf16*)(wl + WS_W2), M, D, FF}; pg8::StaticOrder S; S.init(M, D, G, bx);
        pg8::EpiFinalNorm E{XRES, args.out, SUMSQ, (unsigned*)(ws + WS_CTL) + CW_FIN, args.in[3], D, EPS};
        pg8::gemm_phase<pg8::EpiFinalNorm, pg8::StaticOrder, false, true>(lds, g, S, E);
    }
}
__device__ __forceinline__ void group_sync(unsigned* ctl, volatile LAS unsigned* st, unsigned per_epoch) {
    asm volatile("s_waitcnt vmcnt(0)" ::: "memory");
    __syncthreads();
    if (threadIdx.x == 0) {
        unsigned* cnt = ctl + st[0]; const unsigned target = per_epoch * (st[1] + 1u); st[1] = st[1] + 1u;
        xb_add(cnt, 1u);
        unsigned sp = 0; while (xb_ld(cnt) < target && ++sp < (1u << 22)) __builtin_amdgcn_s_sleep(1);
        __builtin_amdgcn_fence(__ATOMIC_ACQUIRE, "agent");
        asm volatile("s_waitcnt vmcnt(0)" ::: "memory");
    }
    __syncthreads();
}
__global__ void __launch_bounds__(NTHREADS, 2) fwd_kernel(Args args) {
    extern __shared__ __attribute__((aligned(16))) unsigned char lds_raw[];
    LAS unsigned char* lds = (LAS unsigned char*)lds_raw;
    volatile LAS unsigned* MISC = (volatile LAS unsigned*)(lds + MISC_OFF);
    const int tid = threadIdx.x, lane = tid & 63, wave = __builtin_amdgcn_readfirstlane(tid >> 6);
    const int G = gridDim.x; int bx = blockIdx.x; int vcu = (G % 8 == 0) ? (bx % 8) * (G / 8) + bx / 8 : bx;
    for (int u = tid; u < (LDS_BYTES - LDSCTL_OFF) / 4; u += NTHREADS) ((LAS unsigned*)(lds + LDSCTL_OFF))[u] = 0u;
    __syncthreads();
    const int lo = args.ph_lo, hi = args.ph_hi;
    XcdBarrier bar; bar.bar = (unsigned*)(args.ws + WS_CTL) + CW_BAR; bar.x = 0; bar.st = nullptr;
    if (hi - lo > 1) { bar = xcd_barrier_post((unsigned*)(args.ws + WS_CTL) + CW_BAR, MISC + 8);
        if (tid == 0) { const unsigned xcc = xb_xcc_id(); MISC[16] = xcc; MISC[17] = xb_add((unsigned*)(args.ws + WS_CTL) + CW_XID + 64 * xcc, 1u); } }
#ifndef PROBE_PH
#define PROBE_PH (-1)
#endif
#ifndef PROBE_N
#define PROBE_N 0
#endif
#define PHASE(p) if (lo <= (p) && (p) < hi) { PP_STAMP(2 * (p)); run_phase<p>(args, lds, tid, lane, wave, vcu, G, bx); PP_STAMP(2 * (p) + 1); \
        if ((p) == PROBE_PH) { for (int rep_ = 0; rep_ < PROBE_N; ++rep_) { xcd_barrier(bar); if (PROBE_PH >= 0) run_phase<((p) == PROBE_PH ? (p) : 2)>(args, lds, tid, lane, wave, vcu, G, bx); } } \
        if ((p) + 1 < hi && (p) != 2 && (p) != 4 && (p) != 11) { if (MISC[20] != 0u && ((p) == 5 || (p) == 6 || (p) == 12 || (p) == 13)) { group_sync((unsigned*)(args.ws + WS_CTL), MISC + 22, 4u); } \
            else if (MISC[20] != 0u && (p) > 0) { group_sync((unsigned*)(args.ws + WS_CTL), MISC + 24, 32u); } else xcd_barrier(bar); } }
    PHASE(0)
    if (lo == 0 && hi > 1) {
        if (tid == 0) {
            bool ok = (G == 256);
            unsigned cv[16];
#pragma unroll
            for (unsigned j = 0; j < 16; ++j) cv[j] = xb_ld(&bar.bar[XB_XCNT(j)]);
#pragma unroll
            for (unsigned j = 0; j < 16; ++j) ok = ok & (cv[j] == (j < 8 ? 32u : 0u));
            const unsigned xcc = MISC[16], idx = MISC[17];
            if (ok && xcc < 8 && idx < 32) { const unsigned pm = 8u * xcc + (idx & 7u);
                MISC[22] = (unsigned)(CW_GRP + 16 * pm); MISC[24] = (unsigned)(CW_XCL + 64 * xcc); MISC[20] = 1u; }
        }
        __syncthreads();
        if (MISC[20] != 0u) { const unsigned xcc = MISC[16], idx = MISC[17]; vcu = (int)(xcc * 32 + idx); bx = (int)(idx * 8 + xcc); }
    }
    PHASE(1) PHASE(2) PHASE(3) PHASE(4) PHASE(5) PHASE(6) PHASE(7) PHASE(8) PHASE(9) PHASE(10) PHASE(11) PHASE(12) PHASE(13) PHASE(14)
#undef PHASE
#ifndef PROBE_BLK
#define PROBE_BLK 0
#endif
    if (PROBE_P && hi == N_PHASES && blockIdx.x == PROBE_BLK && tid == 0) {
        const volatile LAS unsigned* w = (const volatile LAS unsigned*)(lds + LDSCTL_OFF + 512);
        const unsigned va = (PROBE_P_A < 32) ? w[2 * PROBE_P_A + 1] - w[2 * PROBE_P_A] : w[2 * (PROBE_P_A - 32) + 2] - w[2 * (PROBE_P_A - 32) + 1];
        const unsigned vb = (PROBE_P_B < 32) ? w[2 * PROBE_P_B + 1] - w[2 * PROBE_P_B] : w[2 * (PROBE_P_B - 32) + 2] - w[2 * (PROBE_P_B - 32) + 1];
        const unsigned long long ticks = (unsigned long long)(va / 100u) * 1000ull + (unsigned long long)(vb / 100u) * 100000ull;
        const unsigned long long t0 = PT_NOW(); while (PT_NOW() - t0 < ticks) __builtin_amdgcn_s_sleep(8);
    }
    if (PROBE_T && hi == N_PHASES && vcu == 0 && tid == 0) {
        const unsigned a = xb_ld((unsigned*)(args.ws + WS_CTL) + CW_PROBE), b = xb_ld((unsigned*)(args.ws + WS_CTL) + CW_PROBE + 1);
        const unsigned long long ticks = (unsigned long long)(a / 100u) * 1000ull + (unsigned long long)(b / 100u) * 100000ull;
        const unsigned long long t0 = PT_NOW(); while (PT_NOW() - t0 < ticks) __builtin_amdgcn_s_sleep(8);
    }
}

extern "C" void kernel_launch(void* const* d_in, const int* in_sizes, int n_in, void* d_out, int out_size, void* d_ws, size_t ws_size, hipStream_t stream) {
    static int grid = 0;
    if (grid == 0) {
        if (n_in != 15 || in_sizes[0] != M * D || out_size != M * D || ws_size < WS_END) { fprintf(stderr, "kernel_launch: unexpected shapes (n_in %d, in0 %d, out %d, ws %zu); nothing launched\n", n_in, n_in > 0 ? in_sizes[0] : -1, out_size, ws_size); grid = -1; return; }
        int dev = 0, cus = 0, per_cu = 0;
        if (hipGetDevice(&dev) != hipSuccess || hipDeviceGetAttribute(&cus, hipDeviceAttributeMultiprocessorCount, dev) != hipSuccess) { grid = -1; return; }
        if (hipFuncSetAttribute((const void*)fwd_kernel, hipFuncAttributeMaxDynamicSharedMemorySize, LDS_BYTES) != hipSuccess) { fprintf(stderr, "kernel_launch: hipFuncSetAttribute failed\n"); grid = -1; return; }
        if (hipOccupancyMaxActiveBlocksPerMultiprocessor(&per_cu, (const void*)fwd_kernel, NTHREADS, LDS_BYTES) != hipSuccess || per_cu < 1) { fprintf(stderr, "kernel_launch: occupancy query says %d blocks per CU\n", per_cu); (void)hipGetLastError(); grid = -1; return; }
        grid = cus;
    }
    if (grid < 0) return;
    (void)hipMemsetAsync((char*)d_ws + WS_CTL, 0, CTL_ZERO_BYTES, stream);
    Args a{};
    for (int i = 0; i < 15; ++i) a.in[i] = (const float*)d_in[i];
    a.out = (float*)d_out; a.ws = (unsigned char*)d_ws;
    if (MK_N_LAUNCHES == 1) {
        a.ph_lo = 0; a.ph_hi = N_PHASES;
        void* kargs[] = {&a};
        const hipError_t e = hipLaunchCooperativeKernel((const void*)fwd_kernel, dim3(grid), dim3(NTHREADS), kargs, LDS_BYTES, stream);
        if (e != hipSuccess) fprintf(stderr, "kernel_launch: cooperative launch failed: %s (grid %d)\n", hipGetErrorString(e), grid);
    } else {
        for (int p = 0; p < N_PHASES; ++p) { a.ph_lo = p; a.ph_hi = p + 1; hipLaunchKernelGGL(fwd_kernel, dim3(grid), dim3(NTHREADS), LDS_BYTES, stream, a); }
    }
}
```

```cpp
#include <hip/hip_runtime.h>
#include <cstdio>
#include <cstdint>
namespace pg8 {
#define PG8_LAS __attribute__((address_space(3)))
typedef unsigned short bf16_t;
typedef short bf16x8 __attribute__((ext_vector_type(8)));
typedef float f32x4 __attribute__((ext_vector_type(4)));
typedef unsigned u32x4 __attribute__((ext_vector_type(4)));
constexpr int BM = 256, BK = 64, HALF = 128, HTB = HALF * BK * 2  , STAGE_BYTES = 8 * HTB, NXCD = 8, WGM = 8;

__host__ __device__ __forceinline__ int lds_byte(int r, int c) { const int st = (r >> 4) * 2 + (c >> 5), rr = r & 15, cc = c & 31, ob = rr * 64 + cc * 2; return st * 1024 + (ob ^ (((ob >> 9) & 1) << 5)); }
__host__ __device__ __forceinline__ void stage_rc(int b, int& R, int& C) { const int st = b / 1024, sb = b % 1024, swz = sb ^ (((sb >> 9) & 1) << 5); R = (st >> 1) * 16 + swz / 64; C = (st & 1) * 32 + (swz % 64) / 2; }
__host__ __device__ __forceinline__ int perm32(int rho) { const int n = rho >> 4, i = rho & 15; return 8 * (i >> 2) + 4 * n + (i & 3); }

struct Unit { int pm, pn; };
struct Gemm { const bf16_t* A; const bf16_t* Bt; int M, N, K; };

struct StaticOrder {
    int nM, nN, nwg, G, c;
    __host__ __device__ __forceinline__ void init(int M, int N, int G_, int c_) { nM = M / BM; nN = N / BM; nwg = nM * nN; G = G_; c = c_; }
    __host__ __device__ __forceinline__ bool next(int i, Unit& u) const {
        const long L = (long)i * G + c; if (L >= nwg) return false;
        int wgid = (int)L; { const int q = nwg / NXCD, r = nwg % NXCD, xcd = wgid % NXCD, off = wgid / NXCD; wgid = (xcd < r ? xcd * (q + 1) : r * (q + 1) + (xcd - r) * q) + off; }
        const int nig = WGM * nN, gid = wgid / nig, fm = gid * WGM, gsz = (nM - fm) < WGM ? (nM - fm) : WGM;
        u.pm = fm + ((wgid % nig) % gsz); u.pn = (wgid % nig) / gsz; return true;
    }
    __device__ __forceinline__ void a_ready(const Unit&) const {}
    __device__ __forceinline__ void done(const Unit&) const {}
};

__device__ __forceinline__ unsigned cvt_pk_bf16(float lo, float hi) { unsigned r; asm volatile("v_cvt_pk_bf16_f32 %0, %1, %2" : "=v"(r) : "v"(lo), "v"(hi)); return r; }
typedef float f32x2 __attribute__((ext_vector_type(2)));
typedef __bf16 bf16x2_t __attribute__((ext_vector_type(2)));
__device__ __forceinline__ unsigned pk_bf16(float lo, float hi) { f32x2 v = {lo, hi}; bf16x2_t r = __builtin_convertvector(v, bf16x2_t); return __builtin_bit_cast(unsigned, r); }
template <int ACT  > struct EpiBf16 {
    static constexpr bool PERM = true, AFTER_DRAIN = false, KSCALE = false;
    bf16_t* O; int ldc;
    __device__ __forceinline__ void operator()(const f32x4 (&acc)[2][2][4][2], const Unit& u, int wr, int wc, int fr, int fq) const {
        const int row0 = u.pm * BM + wr * 64 + fr, col0 = u.pn * BM + wc * 32 + 8 * fq;
#pragma unroll
        for (int ai = 0; ai < 2; ++ai)
#pragma unroll
            for (int m = 0; m < 4; ++m) { bf16_t* rowp = O + (size_t)(row0 + ai * HALF + m * 16) * ldc + col0;
#pragma unroll
                for (int bj = 0; bj < 2; ++bj) { f32x4 v0 = acc[ai][bj][m][0], v1 = acc[ai][bj][m][1];
                    if (ACT == 2) { const f32x4 z = {0.f, 0.f, 0.f, 0.f}; v0 = __builtin_elementwise_max(v0, z); v1 = __builtin_elementwise_max(v1, z); v0 = v0 * v0; v1 = v1 * v1; }
                    u32x4 w; w.x = pk_bf16(v0[0], v0[1]); w.y = pk_bf16(v0[2], v0[3]); w.z = pk_bf16(v1[0], v1[1]); w.w = pk_bf16(v1[2], v1[3]);
                    *(u32x4*)(rowp + bj * HALF) = w; } }
    }
};
struct EpiResF32 {
    static constexpr bool PERM = false, AFTER_DRAIN = true, KSCALE = false;
    const float* base; float* out; int ldc;
    __device__ __forceinline__ void fused(const f32x4 (&acc)[2][2][4][2], const Unit& u, int wr, int wc, int fr, int fq, PG8_LAS unsigned char*, int, int) const {
        const int col0 = u.pn * BM + wc * 32 + 4 * fq;
#pragma unroll
        for (int ai = 0; ai < 2; ++ai)
#pragma unroll
            for (int m = 0; m < 4; ++m) { const int r = ai * HALF + wr * 64 + m * 16 + fr; const size_t off = (size_t)(u.pm * BM + r) * ldc + col0;
#pragma unroll
                for (int bj = 0; bj < 2; ++bj) { const f32x4 b0 = *(const f32x4*)(base + off + bj * HALF), b1 = *(const f32x4*)(base + off + bj * HALF + 16);
                    *(f32x4*)(out + off + bj * HALF) = b0 + acc[ai][bj][m][0]; *(f32x4*)(out + off + bj * HALF + 16) = b1 + acc[ai][bj][m][1];
                    asm volatile("" ::: "memory"); } }
    }
};
typedef unsigned u32x2 __attribute__((ext_vector_type(2)));
__device__ __forceinline__ float bf_lo(unsigned w) { return __builtin_bit_cast(float, w << 16); }
__device__ __forceinline__ float bf_hi(unsigned w) { return __builtin_bit_cast(float, w & 0xffff0000u); }
template <int ACT  > struct EpiBf16S {
    static constexpr bool PERM = true, AFTER_DRAIN = false, KSCALE = false;
    bf16_t* O; int ldc; const PG8_LAS float* rt; int pm1, pm2, pm3; size_t bstride;
    __device__ __forceinline__ void operator()(const f32x4 (&acc)[2][2][4][2], const Unit& u, int wr, int wc, int fr, int fq) const {
        const int col0 = u.pn * BM + wc * 32 + 8 * fq;
        const PG8_LAS float* rtp = rt + ((u.pm == pm1) ? 256 : (u.pm == pm2) ? 512 : (u.pm == pm3) ? 768 : 0) + wr * 64 + fr;
#pragma unroll
        for (int ai = 0; ai < 2; ++ai)
#pragma unroll
            for (int m = 0; m < 4; ++m) { const float rs = rtp[ai * HALF + m * 16];
                bf16_t* rowp = O + (size_t)(u.pm >> 3) * bstride + (size_t)((u.pm & 7) * BM + ai * HALF + wr * 64 + m * 16 + fr) * ldc + col0;
#pragma unroll
                for (int bj = 0; bj < 2; ++bj) { f32x4 v0 = acc[ai][bj][m][0] * rs, v1 = acc[ai][bj][m][1] * rs;
                    if (ACT == 2) { const f32x4 z = {0.f, 0.f, 0.f, 0.f}; v0 = __builtin_elementwise_max(v0, z); v1 = __builtin_elementwise_max(v1, z); v0 = v0 * v0; v1 = v1 * v1; }
                    u32x4 w; w.x = pk_bf16(v0[0], v0[1]); w.y = pk_bf16(v0[2], v0[3]); w.z = pk_bf16(v1[0], v1[1]); w.w = pk_bf16(v1[2], v1[3]);
                    *(u32x4*)(rowp + bj * HALF) = w; } }
    }
};
struct EpiResBf16Sq {
    static constexpr bool PERM = false, AFTER_DRAIN = true, KSCALE = false;
    bf16_t* xres; float* sumsq; int ldc;
    __device__ __forceinline__ void fused(f32x4 (&acc)[2][2][4][2], const Unit& u, int wr, int wc, int fr, int fq, PG8_LAS unsigned char* lds, int wid, int lane) const {
        PG8_LAS float* P = (PG8_LAS float*)lds;
        const int col0 = u.pn * BM + wc * 32 + 4 * fq;
#pragma unroll
        for (int ai = 0; ai < 2; ++ai)
#pragma unroll
            for (int m = 0; m < 4; ++m) { const int r = ai * HALF + wr * 64 + m * 16 + fr; bf16_t* xp = xres + (size_t)(u.pm * BM + r) * ldc + col0; float ss = 0.f;
#pragma unroll
                for (int bj = 0; bj < 2; ++bj)
#pragma unroll
                    for (int n = 0; n < 2; ++n) { const u32x2 xb = *(const u32x2*)(xp + bj * HALF + n * 16); const f32x4 a = acc[ai][bj][m][n];
                        u32x2 w; w.x = pk_bf16(bf_lo(xb.x) + a[0], bf_hi(xb.x) + a[1]); w.y = pk_bf16(bf_lo(xb.y) + a[2], bf_hi(xb.y) + a[3]);
                        *(u32x2*)(xp + bj * HALF + n * 16) = w;
                        const float y0 = bf_lo(w.x), y1 = bf_hi(w.x), y2 = bf_lo(w.y), y3 = bf_hi(w.y); ss += (y0 * y0 + y1 * y1) + (y2 * y2 + y3 * y3); }
                ss += __shfl_xor(ss, 16); ss += __shfl_xor(ss, 32);
                if (fq == 0) P[r * 4 + wc] = ss;
                asm volatile("" ::: "memory"); }
        asm volatile("s_waitcnt lgkmcnt(0)" ::: "memory"); __builtin_amdgcn_s_barrier(); asm volatile("" ::: "memory");
        const int t = wid * 64 + lane;
        if (t < 256) { const f32x4 p = *(const PG8_LAS f32x4*)(P + t * 4); sumsq[(size_t)(u.pm * BM + t) * 4 + u.pn] = (p[0] + p[1]) + (p[2] + p[3]); }
    }
};
struct EpiFinalNorm {
    static constexpr bool PERM = false, AFTER_DRAIN = true, KSCALE = false;
    const bf16_t* xres; float* out; float* sumsq; unsigned* cnt; const float* gain; int ldc; float eps;
    __device__ __forceinline__ void fused(f32x4 (&acc)[2][2][4][2], const Unit& u, int wr, int wc, int fr, int fq, PG8_LAS unsigned char* lds, int wid, int lane) const {
        PG8_LAS float* P = (PG8_LAS float*)lds;
        PG8_LAS float* S = (PG8_LAS float*)(lds + 4096);
        const int col0 = u.pn * BM + wc * 32 + 4 * fq, t = wid * 64 + lane;
#pragma unroll
        for (int ai = 0; ai < 2; ++ai)
#pragma unroll
            for (int m = 0; m < 4; ++m) { const int r = ai * HALF + wr * 64 + m * 16 + fr; const bf16_t* xp = xres + (size_t)(u.pm * BM + r) * ldc + col0; float ss = 0.f;
#pragma unroll
                for (int bj = 0; bj < 2; ++bj)
#pragma unroll
                    for (int n = 0; n < 2; ++n) { const u32x2 xb = *(const u32x2*)(xp + bj * HALF + n * 16); f32x4 y = acc[ai][bj][m][n];
                        y[0] += bf_lo(xb.x); y[1] += bf_hi(xb.x); y[2] += bf_lo(xb.y); y[3] += bf_hi(xb.y); acc[ai][bj][m][n] = y; ss += (y[0] * y[0] + y[1] * y[1]) + (y[2] * y[2] + y[3] * y[3]); }
                ss += __shfl_xor(ss, 16); ss += __shfl_xor(ss, 32);
                if (fq == 0) P[r * 4 + wc] = ss;
                asm volatile("" ::: "memory"); }
        asm volatile("s_waitcnt lgkmcnt(0)" ::: "memory"); __builtin_amdgcn_s_barrier(); asm volatile("" ::: "memory");
        if (t < 256) { const f32x4 p = *(const PG8_LAS f32x4*)(P + t * 4); __hip_atomic_store(sumsq + (size_t)(u.pm * BM + t) * 4 + u.pn, (p[0] + p[1]) + (p[2] + p[3]), __ATOMIC_RELAXED, __HIP_MEMORY_SCOPE_AGENT); }
        asm volatile("s_waitcnt vmcnt(0)" ::: "memory"); __builtin_amdgcn_s_barrier(); asm volatile("" ::: "memory");
        if (t == 0) {
            __hip_atomic_fetch_add(cnt + 16 * u.pm, 1u, __ATOMIC_RELAXED, __HIP_MEMORY_SCOPE_AGENT);
            unsigned sp = 0;
            while (__hip_atomic_load(cnt + 16 * u.pm, __ATOMIC_RELAXED, __HIP_MEMORY_SCOPE_AGENT) < 4u && ++sp < (1u << 22)) __builtin_amdgcn_s_sleep(2);
            __builtin_amdgcn_fence(__ATOMIC_ACQUIRE, "agent");
        }
        asm volatile("s_waitcnt vmcnt(0) lgkmcnt(0)" ::: "memory"); __builtin_amdgcn_s_barrier(); asm volatile("" ::: "memory");
        if (t < 256) { float s4 = 0.f;
#pragma unroll
            for (int q = 0; q < 4; ++q) s4 += __hip_atomic_load(sumsq + (size_t)(u.pm * BM + t) * 4 + q, __ATOMIC_RELAXED, __HIP_MEMORY_SCOPE_AGENT);
            S[t] = 1.0f / sqrtf(s4 / (float)ldc + eps); }
        asm volatile("s_waitcnt lgkmcnt(0)" ::: "memory"); __builtin_amdgcn_s_barrier(); asm volatile("" ::: "memory");
        f32x4 gv[2][2];
#pragma unroll
        for (int bj = 0; bj < 2; ++bj)
#pragma unroll
            for (int n = 0; n < 2; ++n) gv[bj][n] = *(const f32x4*)(gain + col0 + bj * HALF + n * 16);
#pragma unroll
        for (int ai = 0; ai < 2; ++ai)
#pragma unroll
            for (int m = 0; m < 4; ++m) { const int r = ai * HALF + wr * 64 + m * 16 + fr; const float rs = S[r]; float* op = out + (size_t)(u.pm * BM + r) * ldc + col0;
#pragma unroll
                for (int bj = 0; bj < 2; ++bj)
#pragma unroll
                    for (int n = 0; n < 2; ++n) *(f32x4*)(op + bj * HALF + n * 16) = acc[ai][bj][m][n] * rs * gv[bj][n]; }
    }
};
struct EpiResBf16SqH {
    static constexpr bool PERM = false, AFTER_DRAIN = true, KSCALE = true;
    bf16_t* xres; float* sumsq; int ldc; const PG8_LAS float* rt4;
    __device__ __forceinline__ void kscale(f32x4 (&acc)[2][2][4][2], int hb, int wr, int fr) const {
#pragma unroll
        for (int ai = 0; ai < 2; ++ai)
#pragma unroll
            for (int m = 0; m < 4; ++m) { const float rho = rt4[(ai * HALF + wr * 64 + m * 16 + fr) * 4 + hb - 1];
#pragma unroll
                for (int bj = 0; bj < 2; ++bj)
#pragma unroll
                    for (int n = 0; n < 2; ++n) acc[ai][bj][m][n] = acc[ai][bj][m][n] * rho; }
    }
    __device__ __forceinline__ void fused(f32x4 (&acc)[2][2][4][2], const Unit& u, int wr, int wc, int fr, int fq, PG8_LAS unsigned char* lds, int wid, int lane) const {
        PG8_LAS float* P = (PG8_LAS float*)lds;
        const int col0 = u.pn * BM + wc * 32 + 4 * fq;
#pragma unroll
        for (int ai = 0; ai < 2; ++ai)
#pragma unroll
            for (int m = 0; m < 4; ++m) { const int r = ai * HALF + wr * 64 + m * 16 + fr; bf16_t* xp = xres + (size_t)(u.pm * BM + r) * ldc + col0; float ss = 0.f; const float s3 = rt4[r * 4 + 3];
#pragma unroll
                for (int bj = 0; bj < 2; ++bj)
#pragma unroll
                    for (int n = 0; n < 2; ++n) { const u32x2 xb = *(const u32x2*)(xp + bj * HALF + n * 16); const f32x4 a = acc[ai][bj][m][n] * s3;
                        u32x2 w; w.x = pk_bf16(bf_lo(xb.x) + a[0], bf_hi(xb.x) + a[1]); w.y = pk_bf16(bf_lo(xb.y) + a[2], bf_hi(xb.y) + a[3]);
                        *(u32x2*)(xp + bj * HALF + n * 16) = w;
                        const float y0 = bf_lo(w.x), y1 = bf_hi(w.x), y2 = bf_lo(w.y), y3 = bf_hi(w.y); ss += (y0 * y0 + y1 * y1) + (y2 * y2 + y3 * y3); }
                ss += __shfl_xor(ss, 16); ss += __shfl_xor(ss, 32);
                if (fq == 0) P[r * 4 + wc] = ss;
                asm volatile("" ::: "memory"); }
        asm volatile("s_waitcnt lgkmcnt(0)" ::: "memory"); __builtin_amdgcn_s_barrier(); asm volatile("" ::: "memory");
        const int t = wid * 64 + lane;
        if (t < 256) { const f32x4 p = *(const PG8_LAS f32x4*)(P + t * 4); sumsq[(size_t)(u.pm * BM + t) * 4 + u.pn] = (p[0] + p[1]) + (p[2] + p[3]); }
    }
};
template <class Epi, class Sched, bool ALIGN_EPI = false, bool SP2 = false>
__device__ __forceinline__ void gemm_phase(PG8_LAS unsigned char* lds, const Gemm g, const Sched& S, const Epi& E) {
    const int tid = threadIdx.x, wid = __builtin_amdgcn_readfirstlane(tid >> 6), lane = tid & 63, wr = wid >> 2, wc = wid & 3, fr = lane & 15, fq = lane >> 4;
    const int K = g.K, nt = K / BK;
    unsigned voffA[2], voffB[2];
#pragma unroll
    for (int i = 0; i < 2; ++i) { int R, C; stage_rc(tid * 16 + i * 8192, R, C); const int Rb = Epi::PERM ? ((R & ~31) + perm32(R & 31)) : R;
        voffA[i] = (unsigned)(R * K + C) * 2u; voffB[i] = (unsigned)(Rb * K + C) * 2u; }
    const size_t kstep = (size_t)(BK * 2);
    const size_t hstep = (size_t)HALF * K * 2;
    const size_t tstep = 2 * hstep;
    const unsigned ldsw = (unsigned)wid * 1024u;
    const int aoff = lds_byte(wr * 64 + fr, fq * 8), boff = lds_byte(wc * 32 + fr, fq * 8);
#define PG8_SA(b, h) (((b) * 2 + (h)) * HTB)
#define PG8_SB(b, h) ((4 + (b) * 2 + (h)) * HTB)
#define PG8_STAGE(bufoff, gbase, voff) do { _Pragma("unroll") for (int _i = 0; _i < 2; ++_i) \
        __builtin_amdgcn_global_load_lds((const unsigned*)((const char*)(gbase) + (voff)[_i]), (PG8_LAS unsigned*)(lds + (bufoff) + ldsw + _i * 8192), 16, 0, 0); } while (0)
#define PG8_LDA(dst, b, h) do { _Pragma("unroll") for (int m = 0; m < 4; ++m) _Pragma("unroll") for (int k = 0; k < 2; ++k) dst[m][k] = *(const PG8_LAS bf16x8*)(lds + PG8_SA(b, h) + aoff + m * 2048 + k * 1024); } while (0)
#define PG8_LDB(dst, b, h) do { _Pragma("unroll") for (int n = 0; n < 2; ++n) _Pragma("unroll") for (int k = 0; k < 2; ++k) dst[n][k] = *(const PG8_LAS bf16x8*)(lds + PG8_SB(b, h) + boff + n * 2048 + k * 1024); } while (0)
#define PG8_MMA(ai, bj, At, Bt) do { __builtin_amdgcn_s_setprio(1); _Pragma("unroll") for (int m = 0; m < 4; ++m) _Pragma("unroll") for (int n = 0; n < 2; ++n) _Pragma("unroll") for (int k = 0; k < 2; ++k) \
        acc[ai][bj][m][n] = __builtin_amdgcn_mfma_f32_16x16x32_bf16(Bt[n][k], At[m][k], acc[ai][bj][m][n], 0, 0, 0); __builtin_amdgcn_s_setprio(0); } while (0)
#define PG8_WAIT_V(n) asm volatile("s_waitcnt vmcnt(" #n ")" ::: "memory")
#define PG8_WAIT_L(n) asm volatile("s_waitcnt lgkmcnt(" #n ")" ::: "memory")
#define PG8_BAR __builtin_amdgcn_s_barrier()
#define PG8_SCHED __builtin_amdgcn_sched_barrier(0)
    Unit cur, nxt; int ui = 0;
    if (!S.next(0, cur)) return;
    f32x4 acc[2][2][4][2];
#pragma unroll
    for (int a = 0; a < 2; ++a)
#pragma unroll
        for (int b = 0; b < 2; ++b)
#pragma unroll
            for (int m = 0; m < 4; ++m)
#pragma unroll
                for (int n = 0; n < 2; ++n) acc[a][b][m][n] = (f32x4){0.f, 0.f, 0.f, 0.f};
    bf16x8 At[4][2], B0[2][2], B1[2][2];
    const char* cA = (const char*)g.A + (size_t)cur.pm * tstep; const char* cB = (const char*)g.Bt + (size_t)cur.pn * tstep;
    S.a_ready(cur);
    if constexpr (SP2) {
        PG8_STAGE(PG8_SB(0, 0), cB, voffB); PG8_STAGE(PG8_SB(0, 1), cB + hstep, voffB); PG8_STAGE(PG8_SA(0, 0), cA, voffA); PG8_STAGE(PG8_SA(0, 1), cA + hstep, voffA);
        if (wr == 1) PG8_BAR;
        PG8_WAIT_V(2); PG8_BAR;
        PG8_STAGE(PG8_SB(1, 0), cB + kstep, voffB); PG8_STAGE(PG8_SA(1, 0), cA + kstep, voffA); PG8_STAGE(PG8_SB(1, 1), cB + hstep + kstep, voffB);
        PG8_WAIT_V(6); PG8_BAR;
    } else {
        PG8_STAGE(PG8_SB(0, 0), cB, voffB); PG8_STAGE(PG8_SA(0, 0), cA, voffA); PG8_STAGE(PG8_SB(0, 1), cB + hstep, voffB); PG8_STAGE(PG8_SA(0, 1), cA + hstep, voffA);
        if (wr == 1) PG8_BAR;
        PG8_WAIT_V(4); PG8_BAR;
        PG8_STAGE(PG8_SB(1, 0), cB + kstep, voffB); PG8_STAGE(PG8_SA(1, 0), cA + kstep, voffA); PG8_STAGE(PG8_SB(1, 1), cB + hstep + kstep, voffB);
        PG8_WAIT_V(6); PG8_BAR;
    }
    for (;;) {
        const bool has_next = S.next(ui + 1, nxt);
        const char* nA = has_next ? (const char*)g.A + (size_t)nxt.pm * tstep : cA; const char* nB = has_next ? (const char*)g.Bt + (size_t)nxt.pn * tstep : cB;
        for (int t = 0; t < nt; t += 2) {
            if constexpr (Epi::KSCALE) { if (t != 0 && (t & 3) == 0) E.kscale(acc, t >> 2, wr, fr); }
            const bool last = (t == nt - 2);
            const char* a1 = cA + (size_t)(t + 1) * kstep;
            const char* a2 = last ? nA : cA + (size_t)(t + 2) * kstep; const char* b2 = last ? nB : cB + (size_t)(t + 2) * kstep;
            const char* a3 = a2 + kstep; const char* b3 = b2 + kstep;
            if (last && has_next) S.a_ready(nxt);
            if constexpr (SP2) {
            PG8_LDB(B0, 0, 0); PG8_LDB(B1, 0, 1); PG8_SCHED; PG8_LDA(At, 0, 0); PG8_STAGE(PG8_SA(1, 1), a1 + hstep, voffA);
            PG8_WAIT_V(8); PG8_WAIT_L(0); PG8_BAR; PG8_MMA(0, 0, At, B0); PG8_MMA(0, 1, At, B1); PG8_BAR; PG8_SCHED;
            PG8_LDA(At, 0, 1); PG8_STAGE(PG8_SB(0, 0), b2, voffB); PG8_STAGE(PG8_SB(0, 1), b2 + hstep, voffB); PG8_STAGE(PG8_SA(0, 0), a2, voffA);
            PG8_WAIT_V(8); PG8_WAIT_L(0); PG8_BAR; PG8_MMA(1, 0, At, B0); PG8_MMA(1, 1, At, B1); PG8_BAR; PG8_SCHED;
            PG8_LDB(B0, 1, 0); PG8_LDB(B1, 1, 1); PG8_SCHED; PG8_LDA(At, 1, 0); PG8_STAGE(PG8_SA(0, 1), a2 + hstep, voffA);
            PG8_WAIT_V(8); PG8_WAIT_L(0); PG8_BAR; PG8_MMA(0, 0, At, B0); PG8_MMA(0, 1, At, B1); PG8_BAR; PG8_SCHED;
            PG8_LDA(At, 1, 1); PG8_STAGE(PG8_SB(1, 0), b3, voffB); PG8_STAGE(PG8_SB(1, 1), b3 + hstep, voffB); PG8_STAGE(PG8_SA(1, 0), a3, voffA);
            PG8_WAIT_V(8); PG8_WAIT_L(0); PG8_BAR; PG8_MMA(1, 0, At, B0); PG8_MMA(1, 1, At, B1); PG8_BAR; PG8_SCHED;
            } else {
            PG8_LDB(B0, 0, 0); PG8_SCHED; PG8_LDA(At, 0, 0); PG8_STAGE(PG8_SA(1, 1), a1 + hstep, voffA);
            PG8_WAIT_L(8); PG8_BAR; PG8_WAIT_L(0); PG8_MMA(0, 0, At, B0); PG8_BAR; PG8_SCHED;
            PG8_LDB(B1, 0, 1); PG8_STAGE(PG8_SB(0, 0), b2, voffB);
            PG8_BAR; PG8_WAIT_L(0); PG8_MMA(0, 1, At, B1); PG8_BAR;
            PG8_LDA(At, 0, 1); PG8_STAGE(PG8_SA(0, 0), a2, voffA);
            PG8_BAR; PG8_WAIT_L(0); PG8_MMA(1, 0, At, B0); PG8_BAR; PG8_SCHED;
            PG8_STAGE(PG8_SB(0, 1), b2 + hstep, voffB);
            PG8_WAIT_V(6); PG8_BAR; PG8_MMA(1, 1, At, B1); PG8_BAR;
            PG8_LDB(B0, 1, 0); PG8_SCHED; PG8_LDA(At, 1, 0); PG8_STAGE(PG8_SA(0, 1), a2 + hstep, voffA);
            PG8_WAIT_L(8); PG8_BAR; PG8_WAIT_L(0); PG8_MMA(0, 0, At, B0); PG8_BAR; PG8_SCHED;
            PG8_LDB(B1, 1, 1); PG8_STAGE(PG8_SB(1, 0), b3, voffB);
            PG8_BAR; PG8_WAIT_L(0); PG8_MMA(0, 1, At, B1); PG8_BAR;
            PG8_LDA(At, 1, 1); PG8_STAGE(PG8_SA(1, 0), a3, voffA);
            PG8_BAR; PG8_WAIT_L(0); PG8_MMA(1, 0, At, B0); PG8_BAR; PG8_SCHED;
            PG8_STAGE(PG8_SB(1, 1), b3 + hstep, voffB);
            PG8_WAIT_V(6); PG8_BAR; PG8_MMA(1, 1, At, B1); PG8_BAR;
            }
        }
        if constexpr (ALIGN_EPI) { if (wr == 0) PG8_BAR; }
        if constexpr (!Epi::AFTER_DRAIN) { E(acc, cur, wr, wc, fr, fq); S.done(cur); }
        if (!has_next) break;
#pragma unroll
        for (int a = 0; a < 2; ++a)
#pragma unroll
            for (int b = 0; b < 2; ++b)
#pragma unroll
                for (int m = 0; m < 4; ++m)
#pragma unroll
                    for (int n = 0; n < 2; ++n) acc[a][b][m][n] = (f32x4){0.f, 0.f, 0.f, 0.f};
        cur = nxt; cA = nA; cB = nB; ++ui;
        if constexpr (ALIGN_EPI) { if (wr == 1) PG8_BAR; }
    }
    PG8_WAIT_V(0);
    if constexpr (!ALIGN_EPI) { if (wr == 0) PG8_BAR; }
    PG8_BAR;
    if constexpr (Epi::AFTER_DRAIN) { E.fused(acc, cur, wr, wc, fr, fq, lds, wid, lane); S.done(cur); }
#undef PG8_SA
#undef PG8_SB
#undef PG8_STAGE
#undef PG8_LDA
#undef PG8_LDB
#undef PG8_MMA
#undef PG8_WAIT_V
#undef PG8_WAIT_L
#undef PG8_BAR
#undef PG8_SCHED
}
}

constexpr int NWAVES = 8, NTHREADS = 512;
#ifndef MK_N_LAUNCHES
#define MK_N_LAUNCHES 1
#endif
constexpr int BATCH = 8, SEQ = 2048, D = 1024, FF = 4096, NH = 4, DK = 128, DV = 256, QKW = 512, VW = 1024;
constexpr int M = BATCH * SEQ, NPROJ = 3072, CH = 64, NCH = SEQ / CH;
constexpr int MLSTM_IN = 3080, GLA_IN = 3088;
constexpr float EPS = 1e-6f, QK_SCALE = 0.08838834764831845f, INV_TAU = 1.0f / 16.0f;

constexpr size_t MiB = 1u << 20;
constexpr size_t WS_CTL = 0, CTL_ZERO_BYTES = 64 * 1024;
constexpr size_t WS_GATES = 1 * MiB;
constexpr size_t WS_GDEC = 2 * MiB;
constexpr size_t WS_WGT = 2 * MiB + 768 * 1024;
constexpr size_t WS_SUMSQ = 2 * MiB + 512 * 1024;
constexpr size_t WS_WIN = 4 * MiB, WS_WOUT = 10 * MiB, WS_W1 = 12 * MiB, WS_W2 = 20 * MiB, WS_WLAYER = 56 * MiB;
constexpr size_t WS_SSQ = 84 * MiB;
constexpr size_t WS_AOP = 28 * MiB;
constexpr size_t WS_PROJ = 92 * MiB, WS_BBLK = 16 * MiB, WS_QT_OFF = 12 * MiB, WS_KT_OFF = 14 * MiB;
constexpr size_t BBLK_E = WS_BBLK / 2;
constexpr size_t WS_HMID = 92 * MiB;
constexpr size_t WS_XRES = 220 * MiB;
constexpr size_t WS_END = 252 * MiB;
constexpr int CW_BAR = 1024, CW_XID = 8192, CW_XCL = 9216, CW_FIN = 14336, CW_GRP = 15360;

constexpr int RING_BYTES = 131072, LDS_BYTES = 163840, LDSCTL_OFF = LDS_BYTES - 1024, MISC_OFF = LDSCTL_OFF + 320;

#define GAS __attribute__((address_space(1)))
#define LAS __attribute__((address_space(3)))
typedef unsigned short bf16;
typedef unsigned v4u __attribute__((ext_vector_type(4)));
typedef unsigned v2u __attribute__((ext_vector_type(2)));
typedef float f32x4 __attribute__((ext_vector_type(4)));
typedef float f32x16 __attribute__((ext_vector_type(16)));
typedef short bf16x8 __attribute__((ext_vector_type(8)));
typedef short s16x4 __attribute__((ext_vector_type(4)));
typedef GAS unsigned gu32;
#define RLX_AGENT __ATOMIC_RELAXED, __HIP_MEMORY_SCOPE_AGENT
#define LDS_WAIT() asm volatile("s_waitcnt lgkmcnt(0)" ::: "memory")
#define VM_WAIT() asm volatile("s_waitcnt vmcnt(0)" ::: "memory")
using pg8::pk_bf16;
__device__ __forceinline__ float bf2f(unsigned b) { return __uint_as_float(b << 16); }
__device__ __forceinline__ float bflo(unsigned w) { return __uint_as_float(w << 16); }
__device__ __forceinline__ float bfhi(unsigned w) { return __uint_as_float(w & 0xffff0000u); }
__device__ __forceinline__ unsigned short f2bf1(float f) { return (unsigned short)(pk_bf16(f, 0.f) & 0xffffu); }

struct Args { const float* in[15]; float* out; unsigned char* ws; int ph_lo, ph_hi; };
#define XB_TMO      128
#define XB_XCNT(j)  (256  + 64 * (j))
#define XB_XSUB(j)  (1280 + 64 * (j))
#define XB_XGEN(j)  (2304 + 64 * (j))
#define XB_TOP      3328
#define XB_TOPGEN   3392
#define XCD_BAR_WORDS 3456
#define XB_SPIN_CAP (1u << 18)
__device__ __forceinline__ unsigned xb_ld(unsigned* p)              { return __hip_atomic_load(p, __ATOMIC_RELAXED, __HIP_MEMORY_SCOPE_AGENT); }
__device__ __forceinline__ unsigned xb_add(unsigned* p, unsigned v) { return __hip_atomic_fetch_add(p, v, __ATOMIC_RELAXED, __HIP_MEMORY_SCOPE_AGENT); }
__device__ __forceinline__ unsigned xb_xcc_id() { return (unsigned)__builtin_amdgcn_s_getreg((3 << 11) | 20) & 0xFu; }
#define XB_SPIN(cond, bar) do { unsigned _sp = 0; while (cond) { __builtin_amdgcn_s_sleep(1); \
    if ((++_sp & 255u) == 0u) { if (xb_ld(&(bar)[XB_TMO])) break; if (_sp > XB_SPIN_CAP) { atomicAdd(&(bar)[XB_TMO], 1u); break; } } } } while (0)
struct XcdBarrier { unsigned* bar; unsigned x; volatile LAS unsigned* st; };
__device__ __forceinline__ XcdBarrier xcd_barrier_post(unsigned* bar, volatile LAS unsigned* st) {
    XcdBarrier b; b.bar = bar; b.x = xb_xcc_id(); b.st = st;
    if (threadIdx.x == 0) (void)xb_add(&bar[XB_XCNT(b.x)], 1u);
    return b;
}
__device__ __forceinline__ void xcd_barrier_complete(unsigned* bar, unsigned x, unsigned& nloc, unsigned& nx) {
    const unsigned G = gridDim.x * gridDim.y * gridDim.z;
    unsigned sum, cnt, mine, sp = 0u;
    for (;;) {
        sum = 0u; cnt = 0u; mine = 0u;
#pragma unroll
        for (unsigned j = 0; j < 16; ++j) { const unsigned c = xb_ld(&bar[XB_XCNT(j)]); sum += c; cnt += (c > 0u) ? 1u : 0u; mine = (j == x) ? c : mine; }
        if (sum == G) break;
        __builtin_amdgcn_s_sleep(1);
        if ((++sp & 255u) == 0u) { if (xb_ld(&bar[XB_TMO])) break; if (sp > XB_SPIN_CAP) { atomicAdd(&bar[XB_TMO], 1u); break; } }
    }
    nloc = mine > 0u ? mine : 1u; nx = cnt > 0u ? cnt : 1u;
}
__device__ __forceinline__ void xcd_barrier(const XcdBarrier& b) {
    asm volatile("s_waitcnt vmcnt(0)" ::: "memory");
    __syncthreads();
    if (threadIdx.x == 0) {
        unsigned* bar = b.bar;
        __builtin_amdgcn_s_waitcnt(0);
        unsigned nloc = b.st[0], nx = b.st[1];
        if (nloc == 0u) { xcd_barrier_complete(bar, b.x, nloc, nx); b.st[0] = nloc; b.st[1] = nx; }
        const unsigned old = xb_add(&bar[XB_XSUB(b.x)], 1u);
        const unsigned gen = old / nloc;
        if (old + 1u == (gen + 1u) * nloc) {
            __builtin_amdgcn_fence(__ATOMIC_RELEASE, "agent");
            asm volatile("s_waitcnt vmcnt(0)" ::: "memory");
            const unsigned og = xb_add(&bar[XB_TOP], 1u);
            const unsigned tg = og / nx;
            if (og + 1u == (tg + 1u) * nx) xb_add(&bar[XB_TOPGEN], 1u);
            else XB_SPIN(xb_ld(&bar[XB_TOPGEN]) == tg, bar);
            __builtin_amdgcn_fence(__ATOMIC_ACQUIRE, "agent");
            xb_add(&bar[XB_XGEN(b.x)], 1u);
            asm volatile("s_waitcnt vmcnt(0)" ::: "memory");
        } else {
            XB_SPIN(xb_ld(&bar[XB_XGEN(b.x)]) == gen, bar);
            __builtin_amdgcn_fence(__ATOMIC_ACQUIRE, "agent");
            asm volatile("s_waitcnt vmcnt(0)" ::: "memory");
        }
    }
    __syncthreads();
}

__device__ __forceinline__ float wave_sum(float v) {
#pragma unroll
    for (int o = 1; o < 64; o <<= 1) v += __shfl_xor(v, o);
    return v;
}
struct CvItem { const float* W; bf16* WT; const float* gain; int K, ldw, k0, n0; };
__device__ __forceinline__ CvItem cv_item(const Args& args, unsigned char* ws, int it) {
    constexpr int I_IN = (D / 64) * (NPROJ / 64), I_O = (D / 64) * (D / 64), I_1 = (D / 64) * (FF / 64), I_2 = (FF / 64) * (D / 64), NITEMS = I_IN + I_O + I_1 + I_2;
    const int layer = it >= NITEMS; int r = it - layer * NITEMS; unsigned char* wl = ws + (size_t)layer * WS_WLAYER;
    CvItem c; int N;
    if (r < I_IN) { c.W = args.in[layer ? 8 : 4]; c.K = D; N = NPROJ; c.ldw = layer ? GLA_IN : MLSTM_IN; c.WT = (bf16*)(wl + WS_WIN); c.gain = args.in[1] + layer * D; }
    else if ((r -= I_IN) < I_O) { c.W = args.in[layer ? 12 : 7]; c.K = D; N = D; c.ldw = D; c.WT = (bf16*)(wl + WS_WOUT); c.gain = nullptr; }
    else if ((r -= I_O) < I_1) { c.W = args.in[13] + (size_t)layer * D * FF; c.K = D; N = FF; c.ldw = FF; c.WT = (bf16*)(wl + WS_W1); c.gain = args.in[2] + layer * D; }
    else { r -= I_1; c.W = args.in[14] + (size_t)layer * D * FF; c.K = FF; N = D; c.ldw = D; c.WT = (bf16*)(wl + WS_W2); c.gain = nullptr; }
    const int nblk = N / 64; c.k0 = 64 * (r / nblk); c.n0 = 64 * (r % nblk);
    return c;
}
__device__ __forceinline__ void cv_load(f32x4 (&v)[16], const CvItem& c, int lane) {
    const int n4 = (lane & 15) * 4, krow = lane >> 4;
#pragma unroll
    for (int i = 0; i < 16; ++i) v[i] = *(const f32x4*)(c.W + (size_t)(c.k0 + 4 * i + krow) * c.ldw + c.n0 + n4);
}
__device__ __forceinline__ void cv_store(const f32x4 (&v)[16], const CvItem& c, LAS float* scr, int lane) {
    const int n4 = (lane & 15) * 4, krow = lane >> 4;
#pragma unroll
    for (int i = 0; i < 16; ++i) *(LAS f32x4*)(scr + (4 * i + krow) * 64 + (n4 ^ (((i >> 1) & 7) << 2))) = v[i];
    const int cc = lane & 7, nl = lane >> 3;
    f32x4 g0 = {1.f, 1.f, 1.f, 1.f}, g1 = {1.f, 1.f, 1.f, 1.f};
    if (c.gain) { g0 = *(const f32x4*)(c.gain + c.k0 + 8 * cc); g1 = *(const f32x4*)(c.gain + c.k0 + 8 * cc + 4); }
    LDS_WAIT(); asm volatile("" ::: "memory");
#pragma unroll
    for (int j = 0; j < 8; ++j) { const int n = 8 * j + nl; const LAS float* sp = scr + (8 * cc) * 64 + (n ^ (cc << 2));
        v4u o; o.x = pk_bf16(sp[0 * 64] * g0.x, sp[1 * 64] * g0.y); o.y = pk_bf16(sp[2 * 64] * g0.z, sp[3 * 64] * g0.w); o.z = pk_bf16(sp[4 * 64] * g1.x, sp[5 * 64] * g1.y); o.w = pk_bf16(sp[6 * 64] * g1.z, sp[7 * 64] * g1.w);
        *(GAS v4u*)(c.WT + (size_t)(c.n0 + n) * c.K + c.k0 + 8 * cc) = o; }
    LDS_WAIT(); asm volatile("" ::: "memory");
}
__device__ __forceinline__ void convert_weights(LAS unsigned char* lds, int lane, int wv, int nw, int vcu, int G, const Args& args, unsigned char* ws) {
    LAS float* scr = (LAS float*)(lds + wv * 16384);
    const int gw = vcu * nw + wv, NGW = G * nw;
    constexpr int NITEMS2 = 2 * ((D / 64) * (NPROJ / 64) + (D / 64) * (D / 64) + (D / 64) * (FF / 64) + (FF / 64) * (D / 64));
    f32x4 va[16], vb[16];
    int it = gw;
    if (it < NITEMS2) { const CvItem c0 = cv_item(args, ws, it); cv_load(va, c0, lane); }
    while (it < NITEMS2) {
        { const CvItem c = cv_item(args, ws, it); const int nx = it + NGW; if (nx < NITEMS2) { const CvItem cn = cv_item(args, ws, nx); cv_load(vb, cn, lane); } cv_store(va, c, scr, lane); it = nx; }
        if (it >= NITEMS2) break;
        { const CvItem c = cv_item(args, ws, it); const int nx = it + NGW; if (nx < NITEMS2) { const CvItem cn = cv_item(args, ws, nx); cv_load(va, cn, lane); } cv_store(vb, c, scr, lane); it = nx; }
    }
}

constexpr int WGB_PITCH = 2064;
#define ROWS_STAGE_LOAD() float wv_[16]; _Pragma("unroll") for (int n = 0; n < 16; ++n) { const int i = tid + NTHREADS * n, k = i >> 3, c = i & 7; wv_[n] = wg[(size_t)k * ldw + c] * gain[k]; }
#define ROWS_STAGE_WRITE() do { _Pragma("unroll") for (int n = 0; n < 16; ++n) { const int i = tid + NTHREADS * n, k = i >> 3, c = i & 7; const unsigned h = pk_bf16(wv_[n], 0.f) & 0xffffu; \
        *(LAS unsigned short*)(wgb + c * WGB_PITCH + 2 * k) = (unsigned short)h; *(LAS unsigned short*)(wgb + (c + 8) * WGB_PITCH + 2 * k) = f2bf1(wv_[n] - __uint_as_float(h << 16)); } } while (0)
__device__ __forceinline__ void rows_first(LAS unsigned char* wgb, LAS float* cmb, int tid, int lane, int wave, int vcu, int G, const float* wg, int ldw, const float* gain, const float* xin, bf16* xres, float* sumsq, float* gates) {
    const int r16 = lane & 15, kq = lane >> 4, kh = wave >> 2, bw = wave & 3;
    ROWS_STAGE_LOAD();
    bool staged = false;
    const LAS unsigned char* bp = wgb + r16 * WGB_PITCH + 1024 * kh + 16 * kq;
    for (int blk0 = vcu * 4; blk0 < M / 16; blk0 += G * 4) {
        const int m0 = (blk0 + bw) * 16;
        const float* xp = xin + (size_t)(m0 + r16) * D + 512 * kh + 8 * kq;
        bf16* xo = xres + (size_t)(m0 + r16) * D + 512 * kh + 8 * kq;
        f32x4 xa[8][2];
#pragma unroll
        for (int u = 0; u < 8; ++u) { xa[u][0] = *(const f32x4*)(xp + 32 * u); xa[u][1] = *(const f32x4*)(xp + 32 * u + 4); }
        if (!staged) { ROWS_STAGE_WRITE(); staged = true; __syncthreads(); }
        pg8::f32x4 acc = {0.f, 0.f, 0.f, 0.f}; float ss = 0.f;
#pragma unroll
        for (int s = 0; s < 16; ++s) { const int u = s & 7;
            const f32x4 a = xa[u][0], b = xa[u][1];
            if (s + 8 < 16) { xa[u][0] = *(const f32x4*)(xp + 32 * (s + 8)); xa[u][1] = *(const f32x4*)(xp + 32 * (s + 8) + 4); }
            v4u h, l; h.x = pk_bf16(a.x, a.y); h.y = pk_bf16(a.z, a.w); h.z = pk_bf16(b.x, b.y); h.w = pk_bf16(b.z, b.w);
            l.x = pk_bf16(a.x - bflo(h.x), a.y - bfhi(h.x)); l.y = pk_bf16(a.z - bflo(h.y), a.w - bfhi(h.y)); l.z = pk_bf16(b.x - bflo(h.z), b.y - bfhi(h.z)); l.w = pk_bf16(b.z - bflo(h.w), b.w - bfhi(h.w));
            ss += ((a.x * a.x + a.y * a.y) + (a.z * a.z + a.w * a.w)) + ((b.x * b.x + b.y * b.y) + (b.z * b.z + b.w * b.w));
            *(v4u*)(xo + 32 * s) = h;
            const bf16x8 bv = *(const LAS bf16x8*)(bp + 64 * s);
            acc = __builtin_amdgcn_mfma_f32_16x16x32_bf16(__builtin_bit_cast(bf16x8, h), bv, acc, 0, 0, 0);
            acc = __builtin_amdgcn_mfma_f32_16x16x32_bf16(__builtin_bit_cast(bf16x8, l), bv, acc, 0, 0, 0); }
        ss += __shfl_xor(ss, 16); ss += __shfl_xor(ss, 32);
        LAS float* cw = cmb + (bw * 64 + lane) * 5;
        if (kh == 1) { cw[0] = acc[0]; cw[1] = acc[1]; cw[2] = acc[2]; cw[3] = acc[3]; cw[4] = ss; }
        __syncthreads();
        if (kh == 0) {
            acc[0] += cw[0]; acc[1] += cw[1]; acc[2] += cw[2]; acc[3] += cw[3]; ss += cw[4];
            if (kq == 0) *(f32x4*)(sumsq + (size_t)(m0 + r16) * 4) = (f32x4){ss, 0.f, 0.f, 0.f};
            const float rstd = 1.0f / sqrtf(ss * (1.f / D) + EPS);
#pragma unroll
            for (int j = 0; j < 4; ++j) { const float g = acc[j] + __shfl_xor(acc[j], 8); const float rs = __shfl(rstd, 4 * kq + j);
                if (r16 < 8) gates[(size_t)(m0 + 4 * kq + j) * 16 + r16] = g * rs; }
        }
        __syncthreads();
    }
}
__device__ __forceinline__ void rows_final(int lane, int wave, int vcu, int G, const bf16* xres, const float* gain, float* out) {
    const int gw = vcu * NWAVES + wave, NGW = G * NWAVES;
    for (int m = gw; m < M; m += NGW) {
        float f[2][8]; float ss = 0.f;
#pragma unroll
        for (int j = 0; j < 2; ++j) { const v4u hv = *(const v4u*)(xres + (size_t)m * D + 8 * lane + 512 * j);
            f[j][0] = bflo(hv.x); f[j][1] = bfhi(hv.x); f[j][2] = bflo(hv.y); f[j][3] = bfhi(hv.y); f[j][4] = bflo(hv.z); f[j][5] = bfhi(hv.z); f[j][6] = bflo(hv.w); f[j][7] = bfhi(hv.w);
#pragma unroll
            for (int e = 0; e < 8; ++e) ss += f[j][e] * f[j][e]; }
        const float rstd = 1.0f / sqrtf(wave_sum(ss) * (1.f / D) + EPS);
#pragma unroll
        for (int j = 0; j < 2; ++j) { const int col = 8 * lane + 512 * j; const f32x4 g0 = *(const f32x4*)(gain + col), g1 = *(const f32x4*)(gain + col + 4);
            *(f32x4*)(out + (size_t)m * D + col) = (f32x4){f[j][0] * rstd * g0.x, f[j][1] * rstd * g0.y, f[j][2] * rstd * g0.z, f[j][3] * rstd * g0.w};
            *(f32x4*)(out + (size_t)m * D + col + 4) = (f32x4){f[j][4] * rstd * g1.x, f[j][5] * rstd * g1.y, f[j][6] * rstd * g1.z, f[j][7] * rstd * g1.w}; }
    }
}
struct RstdSlots { int pm0, pm1, pm2, pm3; };
__device__ __forceinline__ RstdSlots rstd_table(LAS float* rt, const float* sumsq, const pg8::StaticOrder& S, int tid) {
    int pmv[4] = {-1, -1, -1, -1}; int ns = 0;
    pg8::Unit u;
    for (int i = 0; S.next(i, u); ++i) { if (u.pm != pmv[0] && u.pm != pmv[1] && u.pm != pmv[2] && u.pm != pmv[3] && ns < 4) { if (ns == 0) pmv[0] = u.pm; else if (ns == 1) pmv[1] = u.pm; else if (ns == 2) pmv[2] = u.pm; else pmv[3] = u.pm; ++ns; } }
#pragma unroll
    for (int sl = 0; sl < 4; ++sl) { const int pm = sl == 0 ? pmv[0] : sl == 1 ? pmv[1] : sl == 2 ? pmv[2] : pmv[3];
        if (pm >= 0 && tid < 256) { const f32x4 s4 = *(const f32x4*)(sumsq + (size_t)(pm * 256 + tid) * 4); rt[sl * 256 + tid] = 1.0f / sqrtf(((s4.x + s4.y) + (s4.z + s4.w)) * (1.f / D) + EPS); } }
    __syncthreads();
    return RstdSlots{pmv[0], pmv[1], pmv[2], pmv[3]};
}

__device__ __forceinline__ void head_scale_table(LAS float* rt4, const float* ssq, int pm, int tid) {
    if (tid < 256) { const float* p = ssq + (size_t)(pm * 256 + tid) * 32; float sh[4];
#pragma unroll
        for (int h = 0; h < 4; ++h) { const f32x4 a = *(const f32x4*)(p + 8 * h), b = *(const f32x4*)(p + 8 * h + 4); sh[h] = 1.0f / sqrtf((((a.x + a.y) + (a.z + a.w)) + ((b.x + b.y) + (b.z + b.w))) * (1.f / DV) + EPS); }
        *(LAS f32x4*)(rt4 + 4 * tid) = (f32x4){sh[0] / sh[1], sh[1] / sh[2], sh[2] / sh[3], sh[3]}; }
    __syncthreads();
}
__device__ __forceinline__ void head_norm_rows(int lane, int wave, int vcu, int G, const bf16* hun, const float* gout, const bf16* proj, bf16* aop, const bool GLA) {
    const int rows_wg = M / G, rows_w = rows_wg / NWAVES;
    for (int i = 0; i < rows_w; ++i) {
        const int m = vcu * rows_wg + wave * rows_w + i;
#pragma unroll
        for (int j = 0; j < 2; ++j) {
            const int col = 8 * lane + 512 * j;
            const v4u hv = *(const v4u*)(hun + (size_t)m * D + col);
            const v4u rv = *(const v4u*)(proj + (size_t)(m >> 11) * BBLK_E + (size_t)(m & 2047) * NPROJ + 2048 + col);
            float f[8] = {bflo(hv.x), bfhi(hv.x), bflo(hv.y), bfhi(hv.y), bflo(hv.z), bfhi(hv.z), bflo(hv.w), bfhi(hv.w)};
            const float r[8] = {bflo(rv.x), bfhi(rv.x), bflo(rv.y), bfhi(rv.y), bflo(rv.z), bfhi(rv.z), bflo(rv.w), bfhi(rv.w)};
            float sg[8];
#pragma unroll
            for (int e = 0; e < 8; ++e) sg[e] = __builtin_amdgcn_rcpf(1.0f + __expf(-r[e]));
            if (!GLA) {
#pragma unroll
                for (int e = 0; e < 8; ++e) f[e] *= sg[e];
            }
            float ss = 0.f;
#pragma unroll
            for (int e = 0; e < 8; ++e) ss += f[e] * f[e];
#pragma unroll
            for (int o = 1; o < 32; o <<= 1) ss += __shfl_xor(ss, o);
            const float rs = 1.0f / sqrtf(ss * (1.f / DV) + EPS);
            const f32x4 g0 = *(const f32x4*)(gout + col), g1 = *(const f32x4*)(gout + col + 4);
            const float gg[8] = {g0.x, g0.y, g0.z, g0.w, g1.x, g1.y, g1.z, g1.w};
#pragma unroll
            for (int e = 0; e < 8; ++e) f[e] = f[e] * rs * gg[e];
            if (GLA) {
#pragma unroll
                for (int e = 0; e < 8; ++e) f[e] *= r[e] * sg[e];
            }
            v4u o; o.x = pk_bf16(f[0], f[1]); o.y = pk_bf16(f[2], f[3]); o.z = pk_bf16(f[4], f[5]); o.w = pk_bf16(f[6], f[7]);
            *(v4u*)(aop + (size_t)m * D + col) = o;
        }
    }
}

constexpr int GP_WGT = 0, GP_WGT_PITCH = 2064, GP_ZL = 33024, GP_TOT = 41216, GP_Q = 43264, GP_K = 59648;
__device__ __forceinline__ void gla_prep(LAS unsigned char* lds, int tid, int lane, int wave, int vcu, int G, const bf16* proj, const bf16* xres, const float* sumsq, const bf16* wgt,
                                         const float* wup, const float* bgate, bf16* QT, bf16* KT, float* gdec) {
#define GP_BAR() do { asm volatile("s_waitcnt lgkmcnt(0)" ::: "memory"); __builtin_amdgcn_s_barrier(); asm volatile("" ::: "memory"); } while (0)
    LAS float* zl = (LAS float*)(lds + GP_ZL);
    LAS float* tot = (LAS float*)(lds + GP_TOT);
    LAS unsigned short* tq = (LAS unsigned short*)(lds + GP_Q);
    LAS unsigned short* tk = (LAS unsigned short*)(lds + GP_K);
    __syncthreads();
    { v4u wv[5];
#pragma unroll
      for (int n = 0; n < 5; ++n) { const int i = tid + NTHREADS * n; if (i < 2064) wv[n] = *(const v4u*)(wgt + 8 * i); }
#pragma unroll
      for (int n = 0; n < 5; ++n) { const int i = tid + NTHREADS * n; if (i < 2064) *(LAS v4u*)(lds + GP_WGT + 16 * i) = wv[n]; } }
    const int d = tid & 127, rg = tid >> 7;
    for (int unit = vcu; unit < BATCH * NCH; unit += G) {
        const int b = unit / NCH, c = unit % NCH, tok0 = b * SEQ + c * CH;
        const bf16* projb = proj + (size_t)b * BBLK_E + (size_t)(c * CH) * NPROJ; bf16* QTb = QT + (size_t)b * BBLK_E + (size_t)(c * CH) * QKW; bf16* KTb = KT + (size_t)b * BBLK_E + (size_t)(c * CH) * QKW;
        v4u pq[2], pk[2]; float wu[16]; float bg;
#define GP_LOAD(h_) do { _Pragma("unroll") for (int i_ = 0; i_ < 2; ++i_) { const int p_ = tid + NTHREADS * i_, row_ = p_ >> 4, ch_ = p_ & 15; \
            pq[i_] = *(const v4u*)(projb + (size_t)row_ * NPROJ + (h_) * DK + ch_ * 8); pk[i_] = *(const v4u*)(projb + (size_t)row_ * NPROJ + QKW + (h_) * DK + ch_ * 8); } \
            _Pragma("unroll") for (int cc_ = 0; cc_ < 16; ++cc_) wu[cc_] = wup[cc_ * QKW + (h_) * DK + d]; bg = bgate[(h_) * DK + d]; } while (0)
        GP_LOAD(0);
        const f32x4 s4pre = *(const f32x4*)(sumsq + (size_t)(tok0 + (tid >> 3)) * 4);
        GP_BAR();
        {
            const int rt = wave & 3, kh = wave >> 2, r16 = lane & 15, kq = lane >> 4;
            pg8::f32x4 acc = {0.f, 0.f, 0.f, 0.f};
            const bf16* xr = xres + (size_t)(tok0 + 16 * rt + r16) * D + kh * 512 + 8 * kq;
            LAS unsigned char* wr_ = lds + GP_WGT + r16 * GP_WGT_PITCH + (kh * 512 + 8 * kq) * 2;
#pragma unroll
            for (int ks = 0; ks < 16; ++ks) { const bf16x8 av = *(const bf16x8*)(xr + 32 * ks), bv = *(const LAS bf16x8*)(wr_ + 64 * ks); acc = __builtin_amdgcn_mfma_f32_16x16x32_bf16(av, bv, acc, 0, 0, 0); }
#pragma unroll
            for (int i = 0; i < 4; ++i) zl[kh * 1024 + (16 * rt + 4 * kq + i) * 16 + r16] = acc[i];
        }
        GP_BAR();
        { const int row = tid >> 3, c2 = (tid & 7) * 2;
          const f32x4 s4 = s4pre; const float rstd = 1.0f / sqrtf(((s4.x + s4.y) + (s4.z + s4.w)) * (1.f / D) + EPS);
          const float z0 = (zl[row * 16 + c2] + zl[1024 + row * 16 + c2]) * rstd, z1 = (zl[row * 16 + c2 + 1] + zl[1024 + row * 16 + c2 + 1]) * rstd;
          GP_BAR();
          zl[row * 16 + c2] = z0; zl[row * 16 + c2 + 1] = z1; }
        GP_BAR();
#pragma unroll
        for (int h = 0; h < NH; ++h) {
#pragma unroll
            for (int i = 0; i < 2; ++i) { const int p = tid + NTHREADS * i; *(LAS v4u*)(lds + GP_Q + p * 16) = pq[i]; *(LAS v4u*)(lds + GP_K + p * 16) = pk[i]; }
            float wuh[16]; const float bgh = bg;
#pragma unroll
            for (int cc = 0; cc < 16; ++cc) wuh[cc] = wu[cc];
            if (h + 1 < NH) GP_LOAD(h + 1);
            float bcum[16]; float run = 0.f;
#pragma unroll
            for (int jj = 0; jj < 16; ++jj) {
                const int j = 16 * rg + jj; float z = bgh;
#pragma unroll
                for (int q4 = 0; q4 < 4; ++q4) { const f32x4 zz = *(const LAS f32x4*)(zl + j * 16 + 4 * q4); z += (zz.x * wuh[4 * q4] + zz.y * wuh[4 * q4 + 1]) + (zz.z * wuh[4 * q4 + 2] + zz.w * wuh[4 * q4 + 3]); }
                const float la = (fminf(z, 0.f) - __logf(1.0f + __expf(-fabsf(z)))) * INV_TAU;
                run += la; bcum[jj] = run;
            }
            tot[rg * 128 + d] = run;
            GP_BAR();
            float off = 0.f, g = 0.f;
#pragma unroll
            for (int r2 = 0; r2 < 4; ++r2) { const float t = tot[r2 * 128 + d]; g += t; off += (r2 < rg) ? t : 0.f; }
#pragma unroll
            for (int jj = 0; jj < 16; ++jj) {
                const int j = 16 * rg + jj; const float eb = __expf(bcum[jj] + off);
                const float q = bf2f(tq[j * 128 + d]), k = bf2f(tk[j * 128 + d]);
                tq[j * 128 + d] = f2bf1(q * QK_SCALE * eb); tk[j * 128 + d] = f2bf1(k * __builtin_amdgcn_rcpf(eb));
            }
            if (rg == 0) gdec[(size_t)(unit * NH + h) * DK + d] = __expf(g);
            GP_BAR();
#pragma unroll
            for (int i = 0; i < 2; ++i) { const int p = tid + NTHREADS * i, row = p >> 4, ch = p & 15;
                *(v4u*)(QTb + (size_t)row * QKW + h * DK + ch * 8) = *(const LAS v4u*)(lds + GP_Q + p * 16);
                *(v4u*)(KTb + (size_t)row * QKW + h * DK + ch * 8) = *(const LAS v4u*)(lds + GP_K + p * 16); }
            GP_BAR();
        }
#undef GP_LOAD
    }
    __syncthreads();
}

#ifndef PROBE_P
#define PROBE_P 0
#endif
#ifndef PROBE_P_A
#define PROBE_P_A 0
#endif
#ifndef PROBE_P_B
#define PROBE_P_B 1
#endif
#define PP_SEL(i, S_) ((S_) < 32 ? (i) / 2 == (S_) : ((i) == 2 * ((S_) - 32) + 1 || (i) == 2 * ((S_) - 32) + 2))
#define PP_STAMP(i) do { if (PROBE_P && (PP_SEL(i, PROBE_P_A) || PP_SEL(i, PROBE_P_B)) && tid == 0) ((volatile LAS unsigned*)(lds + LDSCTL_OFF + 512))[i] = (unsigned)__builtin_amdgcn_s_memrealtime(); } while (0)
#ifndef PROBE_T
#define PROBE_T 0
#endif
#ifndef PROBE_T_MLSTM
#define PROBE_T_MLSTM 0
#endif
#ifndef PROBE_T_WAVE
#define PROBE_T_WAVE 0
#endif
#ifndef PROBE_T_A
#define PROBE_T_A 5
#endif
#ifndef PROBE_T_B
#define PROBE_T_B 0
#endif
constexpr int CW_PROBE = 12288;
__device__ __forceinline__ unsigned long long pt_now() { unsigned long long t; __builtin_amdgcn_sched_barrier(0); asm volatile("s_memrealtime %0\n\ts_waitcnt lgkmcnt(0)" : "=s"(t) :: "memory"); __builtin_amdgcn_sched_barrier(0); return t; }
#define PT_NOW() pt_now()
#define PT_ACC(i, t0) do { if (PROBE_T) { const unsigned long long t1_ = PT_NOW(); pt[i] += (unsigned)(t1_ - (t0)); (t0) = t1_; } } while (0)
constexpr int PS_PITCH = 144, CT_PITCH = 272, CT_BYTES = 32 * CT_PITCH, IMG_PITCH = 272, IMG_BYTES = 64 * IMG_PITCH, NUM_PITCH = 36;
template <bool MLSTM> struct MxMap;
template <> struct MxMap<true>  { static constexpr int QS = 0, KS = 34816, V = 69632, VW = 77824, VWAUX = 81920, PS = 86016, CT = 95232, TB = 112640, TWP = 120832, TPM = 129024, TSC = 137216, DEN = 137728, NUM = 138240, WI = 147456, GDEC = 0, END = 147968; };
template <> struct MxMap<false> { static constexpr int QS = 0, KS = 34816, V = 69632, VW = 0, VWAUX = 0, PS = 77824, CT = 87040, TB = 0, TWP = 0, TPM = 0, TSC = 0, DEN = 0, NUM = 104448, WI = 0, GDEC = 113664, END = 114688; };
#define LDSA(p) ((unsigned)(size_t)(p))
__device__ __forceinline__ bf16x8 mk8(v2u lo, v2u hi) { v4u w; w.x = lo.x; w.y = lo.y; w.z = hi.x; w.w = hi.y; return __builtin_bit_cast(bf16x8, w); }
__device__ __forceinline__ void tr_read2(bf16x8& f0, bf16x8& f1, unsigned a0, unsigned a1, unsigned b0, unsigned b1) {
    v2u l0, h0, l1, h1;
    asm volatile("ds_read_b64_tr_b16 %0, %4\n\tds_read_b64_tr_b16 %1, %5\n\tds_read_b64_tr_b16 %2, %6\n\tds_read_b64_tr_b16 %3, %7\n\ts_waitcnt lgkmcnt(0)"
                 : "=&v"(l0), "=&v"(h0), "=&v"(l1), "=&v"(h1) : "v"(a0), "v"(a1), "v"(b0), "v"(b1) : "memory");
    f0 = mk8(l0, h0); f1 = mk8(l1, h1);
}
__device__ __forceinline__ void tr_read3(bf16x8& f0, bf16x8& f1, bf16x8& f2, unsigned a0, unsigned a1, unsigned b0, unsigned b1, unsigned c0, unsigned c1) {
    v2u l0, h0, l1, h1, l2, h2;
    asm volatile("ds_read_b64_tr_b16 %0, %6\n\tds_read_b64_tr_b16 %1, %7\n\tds_read_b64_tr_b16 %2, %8\n\tds_read_b64_tr_b16 %3, %9\n\tds_read_b64_tr_b16 %4, %10\n\tds_read_b64_tr_b16 %5, %11\n\ts_waitcnt lgkmcnt(0)"
                 : "=&v"(l0), "=&v"(h0), "=&v"(l1), "=&v"(h1), "=&v"(l2), "=&v"(h2) : "v"(a0), "v"(a1), "v"(b0), "v"(b1), "v"(c0), "v"(c1) : "memory");
    f0 = mk8(l0, h0); f1 = mk8(l1, h1); f2 = mk8(l2, h2);
}
template <int P> __device__ __forceinline__ void tr_issue4(v2u (&x)[8], unsigned base) {
    asm volatile("ds_read_b64_tr_b16 %0, %8 offset:%9\n\tds_read_b64_tr_b16 %1, %8 offset:%10\n\tds_read_b64_tr_b16 %2, %8 offset:%11\n\tds_read_b64_tr_b16 %3, %8 offset:%12\n\t"
                 "ds_read_b64_tr_b16 %4, %8 offset:%13\n\tds_read_b64_tr_b16 %5, %8 offset:%14\n\tds_read_b64_tr_b16 %6, %8 offset:%15\n\tds_read_b64_tr_b16 %7, %8 offset:%16"
                 : "=&v"(x[0]), "=&v"(x[1]), "=&v"(x[2]), "=&v"(x[3]), "=&v"(x[4]), "=&v"(x[5]), "=&v"(x[6]), "=&v"(x[7])
                 : "v"(base), "i"(0), "i"(4 * P), "i"(16 * P), "i"(20 * P), "i"(32 * P), "i"(36 * P), "i"(48 * P), "i"(52 * P) : "memory");
}
__device__ __forceinline__ void tr_wait8(v2u (&x)[8]) { asm volatile("s_waitcnt lgkmcnt(0)" : "+v"(x[0]), "+v"(x[1]), "+v"(x[2]), "+v"(x[3]), "+v"(x[4]), "+v"(x[5]), "+v"(x[6]), "+v"(x[7]) :: "memory"); }
__device__ __forceinline__ void tr_pin8(v2u (&x)[8]) { asm volatile("" : "+v"(x[0]), "+v"(x[1]), "+v"(x[2]), "+v"(x[3]), "+v"(x[4]), "+v"(x[5]), "+v"(x[6]), "+v"(x[7])); }
__device__ __forceinline__ bf16x8 tr_read1(unsigned a0, unsigned a1) {
    v2u l0, h0;
    asm volatile("ds_read_b64_tr_b16 %0, %2\n\tds_read_b64_tr_b16 %1, %3\n\ts_waitcnt lgkmcnt(0)" : "=&v"(l0), "=&v"(h0) : "v"(a0), "v"(a1) : "memory");
    return mk8(l0, h0);
}
#define MFMA32(a, b, c) __builtin_amdgcn_mfma_f32_32x32x16_bf16((a), (b), (c), 0, 0, 0)
#define MX_BAR() do { asm volatile("s_waitcnt lgkmcnt(0)" ::: "memory"); __builtin_amdgcn_s_barrier(); asm volatile("" ::: "memory"); } while (0)
#define MX_BAR_VM() do { asm volatile("s_waitcnt vmcnt(0) lgkmcnt(0)" ::: "memory"); __builtin_amdgcn_s_barrier(); asm volatile("" ::: "memory"); } while (0)
struct MixArgs { const bf16 *q, *k, *proj; int qpitch; const float *gates, *bgate, *gdec; bf16* hun; void* probe; const float* gout; float* ssq; };
struct MixUnit { const bf16 *Qg, *Kg, *Vg, *Gg; bf16* Hg; const float* gdec; float* ssq; int qpitch, b, hh, slice; };
constexpr int MX_NPIECE = 38, MX_PPW = 5;
template <bool MLSTM> struct MixDma { static constexpr int PPW = MX_PPW; unsigned voff[PPW]; };
template <bool MLSTM> __device__ __forceinline__ int mx_piece(int wave, int i) { return wave + 8 * i; }

template <bool MLSTM>
__device__ __forceinline__ void mx_dma_setup(MixDma<MLSTM>& dm, int wave, int lane, int qpitch) {
#pragma unroll
    for (int i = 0; i < MixDma<MLSTM>::PPW; ++i) { const int pi = mx_piece<MLSTM>(wave, i); unsigned v = 0;
        if (pi < 34) { const int ob = (pi < 17 ? pi : pi - 17) * 1024 + lane * 16, row = ob / IMG_PITCH; int cb = ob - row * IMG_PITCH; cb = cb < 256 ? cb : 240; v = (unsigned)(row * qpitch * 2 + cb); }
        else { const int ob = (pi - 34) * 1024 + lane * 16, row = ob >> 6, cb = ob & 63; v = (unsigned)(row * NPROJ * 2 + cb); }
        dm.voff[i] = v; }
}
template <bool MLSTM>
__device__ __forceinline__ void mx_dma_issue(LAS unsigned char* lds, const MixDma<MLSTM>& dm, const MixUnit& U, int c, int wave, int tid) {
    typedef MxMap<MLSTM> MP;
    const int par = c & 1; const size_t tok0 = (size_t)c * CH;
    const char* qb = (const char*)(U.Qg + tok0 * U.qpitch); const char* kb = (const char*)(U.Kg + tok0 * U.qpitch); const char* vb = (const char*)(U.Vg + tok0 * NPROJ);
#pragma unroll
    for (int i = 0; i < MixDma<MLSTM>::PPW; ++i) { const int pi = mx_piece<MLSTM>(wave, i);
        if (pi < MX_NPIECE) {
            const char* src; int dst;
            if (pi < 17) { src = qb; dst = MP::QS + par * IMG_BYTES + pi * 1024; }
            else if (pi < 34) { src = kb; dst = MP::KS + par * IMG_BYTES + (pi - 17) * 1024; }
            else { src = vb; dst = MP::V + par * 4096 + (pi - 34) * 1024; }
            __builtin_amdgcn_global_load_lds((const unsigned*)(src + dm.voff[i]), (LAS unsigned*)(lds + dst), 16, 0, 0);
        } }
    if (!MLSTM && wave == 7) {
        const float* gd = U.gdec + (size_t)(((U.b * NCH + c) * NH) + U.hh) * DK + (tid & 63);
        __builtin_amdgcn_global_load_lds((const unsigned*)gd, (LAS unsigned*)(lds + MP::GDEC + par * 512), 4, 0, 0);
        __builtin_amdgcn_global_load_lds((const unsigned*)(gd + 64), (LAS unsigned*)(lds + MP::GDEC + par * 512 + 256), 4, 0, 0);
    }
}
__device__ __forceinline__ v4u mx_gate_load(const MixUnit& U, int c, int idx) { return *(const v4u*)(U.Gg + (size_t)(c * CH + (idx >> 2)) * NPROJ + 8 * (idx & 3)); }
template <bool MLSTM>
__device__ __forceinline__ void mx_finalize(LAS unsigned char* lds, const MixUnit& U, int cf, int idx, const float (&g8)[8], const v4u gv) {
    typedef MxMap<MLSTM> MP;
    const int j = idx >> 2, sg = idx & 3; float rden = 1.f;
    if (MLSTM) { const float mc = ((const LAS float*)(lds + MP::TSC))[cf];
        const float dn = ((const LAS float*)(lds + MP::DEN))[j], bb = ((const LAS float*)(lds + MP::TB))[cf * 64 + j], pm = ((const LAS float*)(lds + MP::TPM))[cf * 64 + j];
        rden = QK_SCALE * __builtin_amdgcn_rcpf(fmaxf(fabsf(dn) * QK_SCALE, __expf(-bb - fmaxf(mc, pm)))); }
    const f32x4 n0 = *(const LAS f32x4*)((const LAS float*)(lds + MP::NUM) + j * NUM_PITCH + 8 * sg), n1 = *(const LAS f32x4*)((const LAS float*)(lds + MP::NUM) + j * NUM_PITCH + 8 * sg + 4);
    const float nn[8] = {n0.x, n0.y, n0.z, n0.w, n1.x, n1.y, n1.z, n1.w};
    const float gt[8] = {bflo(gv.x), bfhi(gv.x), bflo(gv.y), bfhi(gv.y), bflo(gv.z), bfhi(gv.z), bflo(gv.w), bfhi(gv.w)};
    float y[8]; float ss = 0.f;
#pragma unroll
    for (int e = 0; e < 8; ++e) { const float sig = __builtin_amdgcn_rcpf(1.0f + __expf(-gt[e]));
        if (MLSTM) { const float v = nn[e] * rden * sig; ss += v * v; y[e] = v * g8[e]; }
        else { const float v = nn[e]; ss += v * v; y[e] = v * g8[e] * gt[e] * sig; } }
    ss += __shfl_xor(ss, 1); ss += __shfl_xor(ss, 2);
    const size_t row = (size_t)U.b * SEQ + cf * CH + j;
    if (sg == 0) U.ssq[row * 32 + U.hh * 8 + U.slice] = ss;
    v4u w; w.x = pk_bf16(y[0], y[1]); w.y = pk_bf16(y[2], y[3]); w.z = pk_bf16(y[4], y[5]); w.w = pk_bf16(y[6], y[7]);
    *(v4u*)(U.Hg + row * D + 8 * sg) = w;
}

template <bool MLSTM>
__device__ __forceinline__ void mx_step(LAS unsigned char* lds, const MixDma<MLSTM>& dm, const MixUnit& U, int c, f32x16& accC0, f32x16& accC1, f32x16& accO, int tid, int lane, int wave, unsigned (&pt)[8], const float (&g8)[8], v4u& gl0, v4u& gl1) {
    typedef MxMap<MLSTM> MP;
    const bool fin_wave = MLSTM ? (wave >= 4) : (wave >= 6);
    unsigned long long tp = PROBE_T ? PT_NOW() : 0ull;
    const int r = lane & 31, h5 = lane >> 5, blk = (lane >> 4) & 1, q4 = (lane & 15) >> 2, p4 = lane & 3, par = c & 1;
    const LAS float* TSC = (const LAS float*)(lds + MP::TSC);
    LAS unsigned char* qimg0 = lds + MP::QS + par * IMG_BYTES; LAS unsigned char* kimg0 = lds + MP::KS + par * IMG_BYTES; LAS unsigned char* vimg0 = lds + MP::V + par * 4096;
    if (!fin_wave && c + 1 < NCH) mx_dma_issue<MLSTM>(lds, dm, U, c + 1, wave, tid);
    PT_ACC(6, tp);
    const float mc = MLSTM ? TSC[c] : 0.f;
    if (wave < 4) {
        const int st = wave >> 1, jt = (wave == 1 || wave == 2) ? 1 : 0;
#pragma unroll
        for (int i = 0; i < 16; ++i) accO[i] = 0.f;
        if (MLSTM && wave == 3) {
#pragma unroll
            for (int i = 0; i < 4; ++i) { const int id = lane + 64 * i, row = id >> 2, pc = id & 3;
                const float wr_ = __expf(((const LAS float*)(lds + MP::TWP))[c * 64 + row] - TSC[32 + c]); const v4u pv = *(const LAS v4u*)(vimg0 + row * 64 + pc * 16); v4u o;
                o.x = pk_bf16(bflo(pv.x) * wr_, bfhi(pv.x) * wr_); o.y = pk_bf16(bflo(pv.y) * wr_, bfhi(pv.y) * wr_); o.z = pk_bf16(bflo(pv.z) * wr_, bfhi(pv.z) * wr_); o.w = pk_bf16(bflo(pv.w) * wr_, bfhi(pv.w) * wr_);
                *(LAS v4u*)(lds + MP::VW + row * 64 + pc * 16) = o;
                if (pc == 0) *(LAS unsigned short*)(lds + MP::VWAUX + row * 64) = f2bf1(wr_); }
        }
        if (wave != 3) {
            LAS unsigned char* kimg = kimg0 + (32 * st + r) * IMG_PITCH + 16 * h5;
            LAS unsigned char* qimg = qimg0 + (32 * jt + r) * IMG_PITCH + 16 * h5;
#pragma unroll
            for (int ks = 0; ks < 8; ++ks) { const bf16x8 a = *(const LAS bf16x8*)(kimg + 32 * ks), bq = *(const LAS bf16x8*)(qimg + 32 * ks); accO = MFMA32(a, bq, accO); }
        }
        const int j = 32 * jt + r;
        if (wave == 3) {
#pragma unroll
            for (int g4 = 0; g4 < 4; ++g4) *(LAS v2u*)(lds + MP::PS + j * PS_PITCH + (32 * st + 8 * g4 + 4 * h5) * 2) = (v2u){0u, 0u};
        } else {
            float uj = 0.f;
            if (MLSTM) uj = -fmaxf(mc, ((const LAS float*)(lds + MP::TPM))[c * 64 + j]);
#pragma unroll
            for (int g4 = 0; g4 < 4; ++g4) { const int s0 = 32 * st + 8 * g4 + 4 * h5; f32x4 wps = {0.f, 0.f, 0.f, 0.f}; if (MLSTM) wps = *(const LAS f32x4*)((const LAS float*)(lds + MP::TWP) + c * 64 + s0);
                float v[4];
#pragma unroll
                for (int e = 0; e < 4; ++e) { float x = accO[4 * g4 + e]; if (MLSTM) x *= __expf(uj + wps[e]); v[e] = (s0 + e <= j) ? x : 0.f; }
                v2u o; o.x = pk_bf16(v[0], v[1]); o.y = pk_bf16(v[2], v[3]); *(LAS v2u*)(lds + MP::PS + j * PS_PITCH + s0 * 2) = o; }
        }
    } else {
        const int g = (wave - 4) >> 1, jt = wave & 1;
        if (fin_wave) {
            const int fi = MLSTM ? tid - 256 : tid - 384;
            if (c > 0) { mx_finalize<MLSTM>(lds, U, c - 1, fi, g8, gl0); if (!MLSTM) mx_finalize<MLSTM>(lds, U, c - 1, fi + 128, g8, gl1); }
            if (c + 1 < NCH) mx_dma_issue<MLSTM>(lds, dm, U, c + 1, wave, tid);
        }
        if (MLSTM || g == 0) {
#pragma unroll
            for (int i = 0; i < 16; ++i) accO[i] = 0.f;
#pragma unroll
            for (int ks = 0; ks < 8; ++ks) { const bf16x8 a = *(const LAS bf16x8*)(qimg0 + (32 * jt + r) * IMG_PITCH + 16 * h5 + 32 * ks), bc = *(const LAS bf16x8*)(lds + MP::CT + g * CT_BYTES + r * CT_PITCH + 32 * ks + 16 * h5); accO = MFMA32(a, bc, accO); }
            if (MLSTM) {
#pragma unroll
                for (int g4 = 0; g4 < 4; ++g4) { const f32x4 wi = *(const LAS f32x4*)((const LAS float*)(lds + MP::WI) + par * 64 + 32 * jt + 8 * g4 + 4 * h5);
#pragma unroll
                    for (int e = 0; e < 4; ++e) accO[4 * g4 + e] *= wi[e]; }
            }
        }
    }
    PT_ACC(2, tp);
    MX_BAR();
    PT_ACC(3, tp);
    if (fin_wave) { const int fi = MLSTM ? tid - 256 : tid - 384; gl0 = mx_gate_load(U, c, fi); if (!MLSTM) gl1 = mx_gate_load(U, c, fi + 128); }
    if (wave < 4) {
        if (MLSTM) { const float decay = __expf(mc - TSC[32 + c]); accC0 = accC0 * decay; accC1 = accC1 * decay; }
        LAS unsigned char* kimg = kimg0 + (8 * h5 + q4) * IMG_PITCH + 64 * wave + 32 * blk + 8 * p4;
        LAS unsigned char* vimg = (MLSTM ? lds + MP::VW : vimg0) + (8 * h5 + q4) * 64 + 32 * blk + 8 * p4;
        LAS unsigned char* vaux = lds + MP::VWAUX + (8 * h5 + q4) * 64 + 32 * blk + 8 * p4;
        { v2u xk[8], xv[8], xa[8];
          tr_issue4<IMG_PITCH>(xk, LDSA(kimg)); tr_issue4<64>(xv, LDSA(vimg)); if (MLSTM) tr_issue4<64>(xa, LDSA(vaux));
          tr_wait8(xk); tr_pin8(xv); if (MLSTM) tr_pin8(xa);
          __builtin_amdgcn_sched_barrier(0);
#pragma unroll
          for (int ks = 0; ks < 4; ++ks) { const bf16x8 a = mk8(xk[2 * ks], xk[2 * ks + 1]);
              accC0 = MFMA32(a, mk8(xv[2 * ks], xv[2 * ks + 1]), accC0);
              if (MLSTM) accC1 = MFMA32(a, mk8(xa[2 * ks], xa[2 * ks + 1]), accC1); } }
        if (!MLSTM) {
#pragma unroll
            for (int g4 = 0; g4 < 4; ++g4) { const f32x4 dc = *(const LAS f32x4*)((const LAS float*)(lds + MP::GDEC) + par * 128 + 32 * wave + 8 * g4 + 4 * h5);
#pragma unroll
                for (int e = 0; e < 4; ++e) accC0[4 * g4 + e] *= dc[e]; }
        }
#pragma unroll
        for (int g4 = 0; g4 < 4; ++g4) { const int d0 = 32 * wave + 8 * g4 + 4 * h5;
            v2u o; o.x = pk_bf16(accC0[4 * g4], accC0[4 * g4 + 1]); o.y = pk_bf16(accC0[4 * g4 + 2], accC0[4 * g4 + 3]); *(LAS v2u*)(lds + MP::CT + r * CT_PITCH + d0 * 2) = o;
            if (MLSTM) { v2u o1; o1.x = pk_bf16(accC1[4 * g4], accC1[4 * g4 + 1]); o1.y = pk_bf16(accC1[4 * g4 + 2], accC1[4 * g4 + 3]); *(LAS v2u*)(lds + MP::CT + CT_BYTES + r * CT_PITCH + d0 * 2) = o1; } }
    } else {
        const int g = (wave - 4) >> 1, jt = wave & 1;
        if (MLSTM || g == 0) {
            const bf16x8 ones = (r == 0) ? (bf16x8){0x3F80, 0x3F80, 0x3F80, 0x3F80, 0x3F80, 0x3F80, 0x3F80, 0x3F80} : (bf16x8){0, 0, 0, 0, 0, 0, 0, 0};
            LAS unsigned char* vimg = vimg0 + (8 * h5 + q4) * 64 + 32 * blk + 8 * p4;
            bf16x8 pa[4];
#pragma unroll
            for (int ks = 0; ks < 4; ++ks) pa[ks] = *(const LAS bf16x8*)(lds + MP::PS + (32 * jt + r) * PS_PITCH + 32 * ks + 16 * h5);
            if (g == 0) { v2u xv[8]; tr_issue4<64>(xv, LDSA(vimg)); tr_wait8(xv); __builtin_amdgcn_sched_barrier(0);
#pragma unroll
                for (int ks = 0; ks < 4; ++ks) accO = MFMA32(pa[ks], mk8(xv[2 * ks], xv[2 * ks + 1]), accO);
            } else {
#pragma unroll
                for (int ks = 0; ks < 4; ++ks) accO = MFMA32(pa[ks], ones, accO); }
            if (g == 0) {
#pragma unroll
                for (int i = 0; i < 16; ++i) ((LAS float*)(lds + MP::NUM))[(32 * jt + (i & 3) + 8 * (i >> 2) + 4 * h5) * NUM_PITCH + r] = accO[i];
            }
            if (MLSTM && wave == 7 && c + 1 < NCH) { const float m1 = TSC[c + 1]; ((LAS float*)(lds + MP::WI))[(par ^ 1) * 64 + lane] = __expf(m1 - fmaxf(m1, ((const LAS float*)(lds + MP::TPM))[(c + 1) * 64 + lane])); }
            if (MLSTM && g == 1 && r == 0) {
#pragma unroll
                for (int i = 0; i < 16; ++i) ((LAS float*)(lds + MP::DEN))[32 * jt + (i & 3) + 8 * (i >> 2) + 4 * h5] = accO[i];
            }
        }
    }
    PT_ACC(4, tp);
    MX_BAR_VM();
    PT_ACC(5, tp);
}

template <bool MLSTM>
__device__ __forceinline__ void mixer_phase(LAS unsigned char* lds, int tid, int lane, int wave, int vcu, int G, const MixArgs A) {
    typedef MxMap<MLSTM> MP;
    MixDma<MLSTM> dm; mx_dma_setup<MLSTM>(dm, wave, lane, A.qpitch);
    unsigned pt[8] = {0u, 0u, 0u, 0u, 0u, 0u, 0u, 0u}; unsigned long long tph = PROBE_T ? PT_NOW() : 0ull; unsigned long long tin = tph;
    for (int unit = vcu; unit < BATCH * NH * 8; unit += G) {
        const int slice = unit & 7, bh = unit >> 3;
        MixUnit U; U.b = bh >> 2; U.hh = bh & 3; U.qpitch = A.qpitch; U.gdec = A.gdec;
        U.Qg = A.q + (size_t)U.b * BBLK_E + U.hh * DK; U.Kg = A.k + (size_t)U.b * BBLK_E + U.hh * DK; U.Vg = A.proj + (size_t)U.b * BBLK_E + 1024 + U.hh * DV + 32 * slice; U.Hg = A.hun + U.hh * DV + 32 * slice;
        U.Gg = A.proj + (size_t)U.b * BBLK_E + 2048 + U.hh * DV + 32 * slice; U.ssq = A.ssq; U.slice = slice;

        MX_BAR_VM();
        mx_dma_issue<MLSTM>(lds, dm, U, 0, wave, tid);
        float g8[8];
#pragma unroll
        for (int e = 0; e < 8; ++e) g8[e] = A.gout[U.hh * DV + 32 * slice + 8 * (tid & 3) + e];
        for (int i = tid; i < 2 * CT_BYTES / 4; i += NTHREADS) ((LAS unsigned*)(lds + MP::CT))[i] = 0u;
        if (MLSTM) {
            for (int i = tid; i < 1024; i += NTHREADS) ((LAS unsigned*)(lds + MP::VWAUX))[i] = 0u;
            LAS float* TB = (LAS float*)(lds + MP::TB); LAS float* TWP = (LAS float*)(lds + MP::TWP); LAS float* TPM = (LAS float*)(lds + MP::TPM); LAS float* TSC = (LAS float*)(lds + MP::TSC);
            const float bgi = A.bgate[U.hh], bgf = A.bgate[4 + U.hh];
            float gi4[4], gf4[4];
#pragma unroll
            for (int cc = 0; cc < 4; ++cc) { const size_t tok = (size_t)U.b * SEQ + (wave + 8 * cc) * CH + lane; gi4[cc] = A.gates[tok * 16 + U.hh] + bgi; gf4[cc] = A.gates[tok * 16 + 4 + U.hh] + bgf; }
#pragma unroll
            for (int cc = 0; cc < 4; ++cc) { const int c = wave + 8 * cc;
                const float lf = fminf(gf4[cc], 0.f) - __logf(1.0f + __expf(-fabsf(gf4[cc])));
                float bsum = lf;
#pragma unroll
                for (int o = 1; o < 64; o <<= 1) { const float t = __shfl_up(bsum, o); if (lane >= o) bsum += t; }
                const float wp = gi4[cc] - bsum; float pm = wp;
#pragma unroll
                for (int o = 1; o < 64; o <<= 1) { const float t = __shfl_up(pm, o); if (lane >= o) pm = fmaxf(pm, t); }
                TB[c * 64 + lane] = bsum; TWP[c * 64 + lane] = wp; TPM[c * 64 + lane] = pm;
                if (lane == 63) { TSC[64 + c] = bsum; TSC[96 + c] = pm; } }
            MX_BAR();
            if (wave == 7) ((LAS float*)(lds + MP::WI))[lane] = __expf(-fmaxf(0.f, TPM[lane]));
            if (wave == 0) {
                const float gl = TSC[64 + (lane & 31)], pl = TSC[96 + (lane & 31)]; float m = 0.f, myM = 0.f, myX = 0.f;
#pragma clang loop unroll(disable)
                for (int c = 0; c < NCH; ++c) { const float gc = __uint_as_float(__builtin_amdgcn_readlane(__float_as_uint(gl), c)), pc = __uint_as_float(__builtin_amdgcn_readlane(__float_as_uint(pl), c));
                    const float mxe = fmaxf(m, pc); if (lane == c) { myM = m; myX = mxe; } m = gc + mxe; }
                if (lane < 32) { TSC[lane] = myM; TSC[32 + lane] = myX; }
            }
        }
        f32x16 accC0, accC1, accO; v4u gl0 = {0u, 0u, 0u, 0u}, gl1 = {0u, 0u, 0u, 0u};
#pragma unroll
        for (int i = 0; i < 16; ++i) { accC0[i] = 0.f; accC1[i] = 0.f; accO[i] = 0.f; }
        MX_BAR_VM();
        PT_ACC(1, tin);
#pragma clang loop unroll(disable)
        for (int c = 0; c < NCH; ++c) mx_step<MLSTM>(lds, dm, U, c, accC0, accC1, accO, tid, lane, wave, pt, g8, gl0, gl1);
        if (MLSTM) { if (wave >= 4) mx_finalize<true>(lds, U, NCH - 1, tid - 256, g8, gl0); } else if (wave >= 6) { mx_finalize<false>(lds, U, NCH - 1, tid - 384, g8, gl0); mx_finalize<false>(lds, U, NCH - 1, tid - 384 + 128, g8, gl1); }
    }
    MX_BAR_VM();
    if (PROBE_T && (PROBE_T_MLSTM != 0) == MLSTM && vcu == 0 && wave == PROBE_T_WAVE && lane == 0) { PT_ACC(0, tph); unsigned* pw = (unsigned*)A.probe; pw[0] = pt[PROBE_T_A]; pw[1] = pt[PROBE_T_B]; }
}

constexpr int N_PHASES = 15, RT_OFF = RING_BYTES;
template <int PH>
__device__ __forceinline__ void run_phase(const Args& args, LAS unsigned char* lds, int tid, int lane, int wave, int vcu, int G, int bx) {
    unsigned char* ws = args.ws;
    constexpr int layer = (PH >= 8) ? 1 : 0, k = (PH == 0) ? -1 : PH - 1 - 7 * layer;
    unsigned char* wl = ws + (size_t)layer * WS_WLAYER;
    bf16* AOP = (bf16*)(ws + WS_AOP); bf16* PROJ = (bf16*)(ws + WS_PROJ); bf16* HMID = (bf16*)(ws + WS_HMID); bf16* XRES = (bf16*)(ws + WS_XRES);
    float* GATES = (float*)(ws + WS_GATES); float* SUMSQ = (float*)(ws + WS_SUMSQ);
    LAS float* RT = (LAS float*)(lds + RT_OFF);
    if constexpr (k == -1) {
        LAS unsigned char* wgb = lds;
        rows_first(wgb, (LAS float*)(lds + 40960), tid, lane, wave, vcu, G, args.in[4] + NPROJ, MLSTM_IN, args.in[1], args.in[0], XRES, SUMSQ, GATES);
        if (tid >= 448) {
            for (int i = vcu * 64 + (tid - 448); i < D * 16; i += G * 64) { const int k = i >> 4, c = i & 15;
                ((bf16*)(ws + WS_WGT))[c * 1032 + k] = f2bf1(args.in[1][D + k] * args.in[8][(size_t)k * GLA_IN + NPROJ + c]); }
        }
        convert_weights(lds, lane, wave, NWAVES, vcu, G, args, ws);
    } else if constexpr (k == 0) {
        pg8::Gemm g{XRES, (const bf16*)(wl + WS_WIN), M, NPROJ, D}; pg8::StaticOrder S; S.init(M, NPROJ, G, bx);
        const RstdSlots rs = rstd_table(RT, SUMSQ, S, tid);
        pg8::EpiBf16S<0> E{PROJ, NPROJ, (const LAS float*)RT, rs.pm1, rs.pm2, rs.pm3, BBLK_E};
        pg8::gemm_phase<pg8::EpiBf16S<0>, pg8::StaticOrder, true, true>(lds, g, S, E);
    } else if constexpr (k == 1) {
        if (layer) gla_prep(lds, tid, lane, wave, vcu, G, PROJ, XRES, SUMSQ, (const bf16*)(ws + WS_WGT), args.in[9], args.in[10], (bf16*)(ws + WS_PROJ + WS_QT_OFF), (bf16*)(ws + WS_PROJ + WS_KT_OFF), (float*)(ws + WS_GDEC));
    } else if constexpr (k == 2) {
        if (layer == 0) { const MixArgs A{PROJ, PROJ + QKW, PROJ, NPROJ, GATES, args.in[5], nullptr, AOP, ws + WS_CTL + 4 * CW_PROBE, args.in[6], (float*)(ws + WS_SSQ)}; mixer_phase<true>(lds, tid, lane, wave, vcu, G, A); }
        else { const MixArgs A{(const bf16*)(ws + WS_PROJ + WS_QT_OFF), (const bf16*)(ws + WS_PROJ + WS_KT_OFF), PROJ, QKW, nullptr, nullptr, (const float*)(ws + WS_GDEC), AOP, ws + WS_CTL + 4 * CW_PROBE, args.in[11], (float*)(ws + WS_SSQ)}; mixer_phase<false>(lds, tid, lane, wave, vcu, G, A); }
    } else if constexpr (k == 3) {
    } else if constexpr (k == 4) {
        pg8::Gemm g{AOP, (const bf16*)(wl + WS_WOUT), M, D, D}; pg8::StaticOrder S; S.init(M, D, G, bx);
        pg8::Unit u0; S.next(0, u0); head_scale_table(RT, (const float*)(ws + WS_SSQ), u0.pm, tid);
        pg8::EpiResBf16SqH E{XRES, SUMSQ, D, (const LAS float*)RT};
        pg8::gemm_phase<pg8::EpiResBf16SqH, pg8::StaticOrder, false, true>(lds, g, S, E);
    } else if constexpr (k == 5) {
        pg8::Gemm g{XRES, (const bf16*)(wl + WS_W1), M, FF, D}; pg8::StaticOrder S; S.init(M, FF, G, bx);
        const RstdSlots rs = rstd_table(RT, SUMSQ, S, tid);
        pg8::EpiBf16S<2> E{HMID, FF, (const LAS float*)RT, rs.pm1, rs.pm2, rs.pm3, (size_t)2048 * FF};
        pg8::gemm_phase<pg8::EpiBf16S<2>, pg8::StaticOrder, true, true>(lds, g, S, E);
    } else if constexpr (k == 6 && layer == 0) {
        pg8::Gemm g{HMID, (const bf16*)(wl + WS_W2), M, D, FF}; pg8::StaticOrder S; S.init(M, D, G, bx);
        pg8::EpiResBf16Sq E{XRES, SUMSQ, D};
        pg8::gemm_phase<pg8::EpiResBf16Sq, pg8::StaticOrder, false, true>(lds, g, S, E);
    } else if constexpr (k == 6) {
        pg8::Gemm g{HMID, (const bf16*)(wl + WS_W2), M, D, FF}; pg8::StaticOrder S; S.init(M, D, G, bx);
        pg8::EpiFinalNorm E{XRES, args.out, SUMSQ, (unsigned*)(ws + WS_CTL) + CW_FIN, args.in[3], D, EPS};
        pg8::gemm_phase<pg8::EpiFinalNorm, pg8::StaticOrder, false, true>(lds, g, S, E);
    }
}
__device__ __forceinline__ void group_sync(unsigned* ctl, volatile LAS unsigned* st, unsigned per_epoch) {
    asm volatile("s_waitcnt vmcnt(0)" ::: "memory");
    __syncthreads();
    if (threadIdx.x == 0) {
        unsigned* cnt = ctl + st[0]; const unsigned target = per_epoch * (st[1] + 1u); st[1] = st[1] + 1u;
        xb_add(cnt, 1u);
        unsigned sp = 0; while (xb_ld(cnt) < target && ++sp < (1u << 22)) __builtin_amdgcn_s_sleep(1);
        __builtin_amdgcn_fence(__ATOMIC_ACQUIRE, "agent");
        asm volatile("s_waitcnt vmcnt(0)" ::: "memory");
    }
    __syncthreads();
}
__global__ void __launch_bounds__(NTHREADS, 2) fwd_kernel(Args args) {
    extern __shared__ __attribute__((aligned(16))) unsigned char lds_raw[];
    LAS unsigned char* lds = (LAS unsigned char*)lds_raw;
    volatile LAS unsigned* MISC = (volatile LAS unsigned*)(lds + MISC_OFF);
    const int tid = threadIdx.x, lane = tid & 63, wave = __builtin_amdgcn_readfirstlane(tid >> 6);
    const int G = gridDim.x; int bx = blockIdx.x; int vcu = (G % 8 == 0) ? (bx % 8) * (G / 8) + bx / 8 : bx;
    for (int u = tid; u < (LDS_BYTES - LDSCTL_OFF) / 4; u += NTHREADS) ((LAS unsigned*)(lds + LDSCTL_OFF))[u] = 0u;
    __syncthreads();
    const int lo = args.ph_lo, hi = args.ph_hi;
#ifndef PROBE_S
#define PROBE_S 0
#endif
    if (PROBE_S && tid == 0) { const unsigned t = (unsigned)__builtin_amdgcn_s_memrealtime(); unsigned* pw = (unsigned*)(args.ws + WS_CTL) + CW_PROBE;
        __hip_atomic_fetch_max(pw + 4, ~t, __ATOMIC_RELAXED, __HIP_MEMORY_SCOPE_AGENT); __hip_atomic_fetch_max(pw + 5, t, __ATOMIC_RELAXED, __HIP_MEMORY_SCOPE_AGENT); }
    XcdBarrier bar; bar.bar = (unsigned*)(args.ws + WS_CTL) + CW_BAR; bar.x = 0; bar.st = nullptr;
    if (hi - lo > 1) { bar = xcd_barrier_post((unsigned*)(args.ws + WS_CTL) + CW_BAR, MISC + 8);
        if (tid == 0) { const unsigned xcc = xb_xcc_id(); MISC[16] = xcc; MISC[17] = xb_add((unsigned*)(args.ws + WS_CTL) + CW_XID + 64 * xcc, 1u); } }
#ifndef PROBE_PH
#define PROBE_PH (-1)
#endif
#ifndef PROBE_N
#define PROBE_N 0
#endif
#define PHASE(p) if (lo <= (p) && (p) < hi) { PP_STAMP(2 * (p)); run_phase<p>(args, lds, tid, lane, wave, vcu, G, bx); PP_STAMP(2 * (p) + 1); \
        if (PROBE_S && (p) == 0 && tid == 0) { __hip_atomic_fetch_max((unsigned*)(args.ws + WS_CTL) + CW_PROBE + 6, (unsigned)__builtin_amdgcn_s_memrealtime(), __ATOMIC_RELAXED, __HIP_MEMORY_SCOPE_AGENT); } \
        if ((p) == PROBE_PH) { for (int rep_ = 0; rep_ < PROBE_N; ++rep_) { xcd_barrier(bar); if (PROBE_PH >= 0) run_phase<((p) == PROBE_PH ? (p) : 2)>(args, lds, tid, lane, wave, vcu, G, bx); } } \
        if ((p) + 1 < hi && (p) != 2 && (p) != 4 && (p) != 11) { if (MISC[20] != 0u && ((p) == 5 || (p) == 6 || (p) == 12 || (p) == 13)) { group_sync((unsigned*)(args.ws + WS_CTL), MISC + 22, 4u); } \
            else if (MISC[20] != 0u && (p) > 0) { group_sync((unsigned*)(args.ws + WS_CTL), MISC + 24, 32u); } else xcd_barrier(bar); } }
    PHASE(0)
    if (lo == 0 && hi > 1) {
        if (tid == 0) {
            bool ok = (G == 256);
            unsigned cv[16];
#pragma unroll
            for (unsigned j = 0; j < 16; ++j) cv[j] = xb_ld(&bar.bar[XB_XCNT(j)]);
#pragma unroll
            for (unsigned j = 0; j < 16; ++j) ok = ok & (cv[j] == (j < 8 ? 32u : 0u));
            const unsigned xcc = MISC[16], idx = MISC[17];
            if (ok && xcc < 8 && idx < 32) { const unsigned pm = 8u * xcc + (idx & 7u);
                MISC[22] = (unsigned)(CW_GRP + 16 * pm); MISC[24] = (unsigned)(CW_XCL + 64 * xcc); MISC[20] = 1u; }
        }
        __syncthreads();
        if (MISC[20] != 0u) { const unsigned xcc = MISC[16], idx = MISC[17]; vcu = (int)(xcc * 32 + idx); bx = (int)(idx * 8 + xcc); }
    }
    PHASE(1) PHASE(2) PHASE(3) PHASE(4) PHASE(5) PHASE(6) PHASE(7) PHASE(8) PHASE(9) PHASE(10) PHASE(11) PHASE(12) PHASE(13) PHASE(14)
#undef PHASE
#ifndef PROBE_BLK
#define PROBE_BLK 0
#endif
    if (PROBE_P && hi == N_PHASES && blockIdx.x == PROBE_BLK && tid == 0) {
        const volatile LAS unsigned* w = (const volatile LAS unsigned*)(lds + LDSCTL_OFF + 512);
        const unsigned va = (PROBE_P_A < 32) ? w[2 * PROBE_P_A + 1] - w[2 * PROBE_P_A] : w[2 * (PROBE_P_A - 32) + 2] - w[2 * (PROBE_P_A - 32) + 1];
        const unsigned vb = (PROBE_P_B < 32) ? w[2 * PROBE_P_B + 1] - w[2 * PROBE_P_B] : w[2 * (PROBE_P_B - 32) + 2] - w[2 * (PROBE_P_B - 32) + 1];
        const unsigned long long ticks = (unsigned long long)(va / 100u) * 1000ull + (unsigned long long)(vb / 100u) * 100000ull;
        const unsigned long long t0 = PT_NOW(); while (PT_NOW() - t0 < ticks) __builtin_amdgcn_s_sleep(8);
    }
    if (PROBE_S && hi == N_PHASES && blockIdx.x == 0 && tid == 0) {
        unsigned* pw = (unsigned*)(args.ws + WS_CTL) + CW_PROBE; const unsigned mn = ~xb_ld(pw + 4), mx = xb_ld(pw + 5), me = xb_ld(pw + 6);
        const unsigned v = (PROBE_S == 1) ? mx - mn : me - mn;
        const unsigned long long ticks = (unsigned long long)(v / 10u) * 1000ull;
        const unsigned long long t0 = PT_NOW(); while (PT_NOW() - t0 < ticks) __builtin_amdgcn_s_sleep(8);
    }
    if (PROBE_T && hi == N_PHASES && vcu == 0 && tid == 0) {
        const unsigned a = xb_ld((unsigned*)(args.ws + WS_CTL) + CW_PROBE), b = xb_ld((unsigned*)(args.ws + WS_CTL) + CW_PROBE + 1);
        const unsigned long long ticks = (unsigned long long)(a / 100u) * 1000ull + (unsigned long long)(b / 100u) * 100000ull;
        const unsigned long long t0 = PT_NOW(); while (PT_NOW() - t0 < ticks) __builtin_amdgcn_s_sleep(8);
    }
}

extern "C" void kernel_launch(void* const* d_in, const int* in_sizes, int n_in, void* d_out, int out_size, void* d_ws, size_t ws_size, hipStream_t stream) {
    static int grid = 0;
    if (grid == 0) {
        if (n_in != 15 || in_sizes[0] != M * D || out_size != M * D || ws_size < WS_END) { fprintf(stderr, "kernel_launch: unexpected shapes (n_in %d, in0 %d, out %d, ws %zu); nothing launched\n", n_in, n_in > 0 ? in_sizes[0] : -1, out_size, ws_size); grid = -1; return; }
        int dev = 0, cus = 0, per_cu = 0;
        if (hipGetDevice(&dev) != hipSuccess || hipDeviceGetAttribute(&cus, hipDeviceAttributeMultiprocessorCount, dev) != hipSuccess) { grid = -1; return; }
        if (hipFuncSetAttribute((const void*)fwd_kernel, hipFuncAttributeMaxDynamicSharedMemorySize, LDS_BYTES) != hipSuccess) { fprintf(stderr, "kernel_launch: hipFuncSetAttribute failed\n"); grid = -1; return; }
        if (hipOccupancyMaxActiveBlocksPerMultiprocessor(&per_cu, (const void*)fwd_kernel, NTHREADS, LDS_BYTES) != hipSuccess || per_cu < 1) { fprintf(stderr, "kernel_launch: occupancy query says %d blocks per CU\n", per_cu); (void)hipGetLastError(); grid = -1; return; }
        grid = cus;
    }
    if (grid < 0) return;
    (void)hipMemsetAsync((char*)d_ws + WS_CTL, 0, CTL_ZERO_BYTES, stream);
    Args a{};
    for (int i = 0; i < 15; ++i) a.in[i] = (const float*)d_in[i];
    a.out = (float*)d_out; a.ws = (unsigned char*)d_ws;
    if (MK_N_LAUNCHES == 1) {
        a.ph_lo = 0; a.ph_hi = N_PHASES;
        void* kargs[] = {&a};
        const hipError_t e = hipLaunchCooperativeKernel((const void*)fwd_kernel, dim3(grid), dim3(NTHREADS), kargs, LDS_BYTES, stream);
        if (e != hipSuccess) fprintf(stderr, "kernel_launch: cooperative launch failed: %s (grid %d)\n", hipGetErrorString(e), grid);
    } else {
        for (int p = 0; p < N_PHASES; ++p) { a.ph_lo = p; a.ph_hi = p + 1; hipLaunchKernelGGL(fwd_kernel, dim3(grid), dim3(NTHREADS), LDS_BYTES, stream, a); }
    }
}
```

```cpp
#include <hip/hip_runtime.h>
#include <cstdio>
#include <cstdint>
namespace pg8 {
#define PG8_LAS __attribute__((address_space(3)))
typedef unsigned short bf16_t;
typedef short bf16x8 __attribute__((ext_vector_type(8)));
typedef float f32x4 __attribute__((ext_vector_type(4)));
typedef unsigned u32x4 __attribute__((ext_vector_type(4)));
constexpr int BM = 256, BK = 64, HALF = 128, HTB = HALF * BK * 2  , STAGE_BYTES = 8 * HTB, NXCD = 8, WGM = 8;

__host__ __device__ __forceinline__ int lds_byte(int r, int c) { const int st = (r >> 4) * 2 + (c >> 5), rr = r & 15, cc = c & 31, ob = rr * 64 + cc * 2; return st * 1024 + (ob ^ (((ob >> 9) & 1) << 5)); }
__host__ __device__ __forceinline__ void stage_rc(int b, int& R, int& C) { const int st = b / 1024, sb = b % 1024, swz = sb ^ (((sb >> 9) & 1) << 5); R = (st >> 1) * 16 + swz / 64; C = (st & 1) * 32 + (swz % 64) / 2; }
__host__ __device__ __forceinline__ int perm32(int rho) { const int n = rho >> 4, i = rho & 15; return 8 * (i >> 2) + 4 * n + (i & 3); }

struct Unit { int pm, pn; };
struct Gemm { const bf16_t* A; const bf16_t* Bt; int M, N, K; };

struct StaticOrder {
    int nM, nN, nwg, G, c;
    __host__ __device__ __forceinline__ void init(int M, int N, int G_, int c_) { nM = M / BM; nN = N / BM; nwg = nM * nN; G = G_; c = c_; }
    __host__ __device__ __forceinline__ bool next(int i, Unit& u) const {
        const long L = (long)i * G + c; if (L >= nwg) return false;
        int wgid = (int)L; { const int q = nwg / NXCD, r = nwg % NXCD, xcd = wgid % NXCD, off = wgid / NXCD; wgid = (xcd < r ? xcd * (q + 1) : r * (q + 1) + (xcd - r) * q) + off; }
        const int nig = WGM * nN, gid = wgid / nig, fm = gid * WGM, gsz = (nM - fm) < WGM ? (nM - fm) : WGM;
        u.pm = fm + ((wgid % nig) % gsz); u.pn = (wgid % nig) / gsz; return true;
    }
    __device__ __forceinline__ void a_ready(const Unit&) const {}
    __device__ __forceinline__ void done(const Unit&) const {}
};

__device__ __forceinline__ unsigned cvt_pk_bf16(float lo, float hi) { unsigned r; asm volatile("v_cvt_pk_bf16_f32 %0, %1, %2" : "=v"(r) : "v"(lo), "v"(hi)); return r; }
typedef float f32x2 __attribute__((ext_vector_type(2)));
typedef __bf16 bf16x2_t __attribute__((ext_vector_type(2)));
__device__ __forceinline__ unsigned pk_bf16(float lo, float hi) { f32x2 v = {lo, hi}; bf16x2_t r = __builtin_convertvector(v, bf16x2_t); return __builtin_bit_cast(unsigned, r); }
template <int ACT  > struct EpiBf16 {
    static constexpr bool PERM = true, AFTER_DRAIN = false, KSCALE = false;
    bf16_t* O; int ldc;
    __device__ __forceinline__ void operator()(const f32x4 (&acc)[2][2][4][2], const Unit& u, int wr, int wc, int fr, int fq) const {
        const int row0 = u.pm * BM + wr * 64 + fr, col0 = u.pn * BM + wc * 32 + 8 * fq;
#pragma unroll
        for (int ai = 0; ai < 2; ++ai)
#pragma unroll
            for (int m = 0; m < 4; ++m) { bf16_t* rowp = O + (size_t)(row0 + ai * HALF + m * 16) * ldc + col0;
#pragma unroll
                for (int bj = 0; bj < 2; ++bj) { f32x4 v0 = acc[ai][bj][m][0], v1 = acc[ai][bj][m][1];
                    if (ACT == 2) { const f32x4 z = {0.f, 0.f, 0.f, 0.f}; v0 = __builtin_elementwise_max(v0, z); v1 = __builtin_elementwise_max(v1, z); v0 = v0 * v0; v1 = v1 * v1; }
                    u32x4 w; w.x = pk_bf16(v0[0], v0[1]); w.y = pk_bf16(v0[2], v0[3]); w.z = pk_bf16(v1[0], v1[1]); w.w = pk_bf16(v1[2], v1[3]);
                    *(u32x4*)(rowp + bj * HALF) = w; } }
    }
};
struct EpiResF32 {
    static constexpr bool PERM = false, AFTER_DRAIN = true, KSCALE = false;
    const float* base; float* out; int ldc;
    __device__ __forceinline__ void fused(const f32x4 (&acc)[2][2][4][2], const Unit& u, int wr, int wc, int fr, int fq, PG8_LAS unsigned char*, int, int) const {
        const int col0 = u.pn * BM + wc * 32 + 4 * fq;
#pragma unroll
        for (int ai = 0; ai < 2; ++ai)
#pragma unroll
            for (int m = 0; m < 4; ++m) { const int r = ai * HALF + wr * 64 + m * 16 + fr; const size_t off = (size_t)(u.pm * BM + r) * ldc + col0;
#pragma unroll
                for (int bj = 0; bj < 2; ++bj) { const f32x4 b0 = *(const f32x4*)(base + off + bj * HALF), b1 = *(const f32x4*)(base + off + bj * HALF + 16);
                    *(f32x4*)(out + off + bj * HALF) = b0 + acc[ai][bj][m][0]; *(f32x4*)(out + off + bj * HALF + 16) = b1 + acc[ai][bj][m][1];
                    asm volatile("" ::: "memory"); } }
    }
};
typedef unsigned u32x2 __attribute__((ext_vector_type(2)));
__device__ __forceinline__ float bf_lo(unsigned w) { return __builtin_bit_cast(float, w << 16); }
__device__ __forceinline__ float bf_hi(unsigned w) { return __builtin_bit_cast(float, w & 0xffff0000u); }
template <int ACT  > struct EpiBf16S {
    static constexpr bool PERM = true, AFTER_DRAIN = false, KSCALE = false;
    bf16_t* O; int ldc; const PG8_LAS float* rt; int pm1, pm2, pm3; size_t bstride;
    __device__ __forceinline__ void operator()(const f32x4 (&acc)[2][2][4][2], const Unit& u, int wr, int wc, int fr, int fq) const {
        const int col0 = u.pn * BM + wc * 32 + 8 * fq;
        const PG8_LAS float* rtp = rt + ((u.pm == pm1) ? 256 : (u.pm == pm2) ? 512 : (u.pm == pm3) ? 768 : 0) + wr * 64 + fr;
#pragma unroll
        for (int ai = 0; ai < 2; ++ai)
#pragma unroll
            for (int m = 0; m < 4; ++m) { const float rs = rtp[ai * HALF + m * 16];
                bf16_t* rowp = O + (size_t)(u.pm >> 3) * bstride + (size_t)((u.pm & 7) * BM + ai * HALF + wr * 64 + m * 16 + fr) * ldc + col0;
#pragma unroll
                for (int bj = 0; bj < 2; ++bj) { f32x4 v0 = acc[ai][bj][m][0] * rs, v1 = acc[ai][bj][m][1] * rs;
                    if (ACT == 2) { const f32x4 z = {0.f, 0.f, 0.f, 0.f}; v0 = __builtin_elementwise_max(v0, z); v1 = __builtin_elementwise_max(v1, z); v0 = v0 * v0; v1 = v1 * v1; }
                    u32x4 w; w.x = pk_bf16(v0[0], v0[1]); w.y = pk_bf16(v0[2], v0[3]); w.z = pk_bf16(v1[0], v1[1]); w.w = pk_bf16(v1[2], v1[3]);
                    *(u32x4*)(rowp + bj * HALF) = w; } }
    }
};
struct EpiResBf16Sq {
    static constexpr bool PERM = false, AFTER_DRAIN = true, KSCALE = false;
    bf16_t* xres; float* sumsq; int ldc;
    __device__ __forceinline__ void fused(f32x4 (&acc)[2][2][4][2], const Unit& u, int wr, int wc, int fr, int fq, PG8_LAS unsigned char* lds, int wid, int lane) const {
        PG8_LAS float* P = (PG8_LAS float*)lds;
        const int col0 = u.pn * BM + wc * 32 + 4 * fq;
#pragma unroll
        for (int ai = 0; ai < 2; ++ai)
#pragma unroll
            for (int m = 0; m < 4; ++m) { const int r = ai * HALF + wr * 64 + m * 16 + fr; bf16_t* xp = xres + (size_t)(u.pm * BM + r) * ldc + col0; float ss = 0.f;
#pragma unroll
                for (int bj = 0; bj < 2; ++bj)
#pragma unroll
                    for (int n = 0; n < 2; ++n) { const u32x2 xb = *(const u32x2*)(xp + bj * HALF + n * 16); const f32x4 a = acc[ai][bj][m][n];
                        u32x2 w; w.x = pk_bf16(bf_lo(xb.x) + a[0], bf_hi(xb.x) + a[1]); w.y = pk_bf16(bf_lo(xb.y) + a[2], bf_hi(xb.y) + a[3]);
                        *(u32x2*)(xp + bj * HALF + n * 16) = w;
                        const float y0 = bf_lo(w.x), y1 = bf_hi(w.x), y2 = bf_lo(w.y), y3 = bf_hi(w.y); ss += (y0 * y0 + y1 * y1) + (y2 * y2 + y3 * y3); }
                ss += __shfl_xor(ss, 16); ss += __shfl_xor(ss, 32);
                if (fq == 0) P[r * 4 + wc] = ss;
                asm volatile("" ::: "memory"); }
        asm volatile("s_waitcnt lgkmcnt(0)" ::: "memory"); __builtin_amdgcn_s_barrier(); asm volatile("" ::: "memory");
        const int t = wid * 64 + lane;
        if (t < 256) { const f32x4 p = *(const PG8_LAS f32x4*)(P + t * 4); sumsq[(size_t)(u.pm * BM + t) * 4 + u.pn] = (p[0] + p[1]) + (p[2] + p[3]); }
    }
};
struct EpiFinalNorm {
    static constexpr bool PERM = false, AFTER_DRAIN = true, KSCALE = false;
    const bf16_t* xres; float* out; float* sumsq; unsigned* cnt; const float* gain; int ldc; float eps;
    __device__ __forceinline__ void fused(f32x4 (&acc)[2][2][4][2], const Unit& u, int wr, int wc, int fr, int fq, PG8_LAS unsigned char* lds, int wid, int lane) const {
        PG8_LAS float* P = (PG8_LAS float*)lds;
        PG8_LAS float* S = (PG8_LAS float*)(lds + 4096);
        const int col0 = u.pn * BM + wc * 32 + 4 * fq, t = wid * 64 + lane;
#pragma unroll
        for (int ai = 0; ai < 2; ++ai)
#pragma unroll
            for (int m = 0; m < 4; ++m) { const int r = ai * HALF + wr * 64 + m * 16 + fr; const bf16_t* xp = xres + (size_t)(u.pm * BM + r) * ldc + col0; float ss = 0.f;
#pragma unroll
                for (int bj = 0; bj < 2; ++bj)
#pragma unroll
                    for (int n = 0; n < 2; ++n) { const u32x2 xb = *(const u32x2*)(xp + bj * HALF + n * 16); f32x4 y = acc[ai][bj][m][n];
                        y[0] += bf_lo(xb.x); y[1] += bf_hi(xb.x); y[2] += bf_lo(xb.y); y[3] += bf_hi(xb.y); acc[ai][bj][m][n] = y; ss += (y[0] * y[0] + y[1] * y[1]) + (y[2] * y[2] + y[3] * y[3]); }
                ss += __shfl_xor(ss, 16); ss += __shfl_xor(ss, 32);
                if (fq == 0) P[r * 4 + wc] = ss;
                asm volatile("" ::: "memory"); }
        asm volatile("s_waitcnt lgkmcnt(0)" ::: "memory"); __builtin_amdgcn_s_barrier(); asm volatile("" ::: "memory");
        if (t < 256) { const f32x4 p = *(const PG8_LAS f32x4*)(P + t * 4); __hip_atomic_store(sumsq + (size_t)(u.pm * BM + t) * 4 + u.pn, (p[0] + p[1]) + (p[2] + p[3]), __ATOMIC_RELAXED, __HIP_MEMORY_SCOPE_AGENT); }
        asm volatile("s_waitcnt vmcnt(0)" ::: "memory"); __builtin_amdgcn_s_barrier(); asm volatile("" ::: "memory");
        if (t == 0) {
            __hip_atomic_fetch_add(cnt + 16 * u.pm, 1u, __ATOMIC_RELAXED, __HIP_MEMORY_SCOPE_AGENT);
            unsigned sp = 0;
            while (__hip_atomic_load(cnt + 16 * u.pm, __ATOMIC_RELAXED, __HIP_MEMORY_SCOPE_AGENT) < 4u && ++sp < (1u << 22)) __builtin_amdgcn_s_sleep(2);
            __builtin_amdgcn_fence(__ATOMIC_ACQUIRE, "agent");
        }
        asm volatile("s_waitcnt vmcnt(0) lgkmcnt(0)" ::: "memory"); __builtin_amdgcn_s_barrier(); asm volatile("" ::: "memory");
        if (t < 256) { float s4 = 0.f;
#pragma unroll
            for (int q = 0; q < 4; ++q) s4 += __hip_atomic_load(sumsq + (size_t)(u.pm * BM + t) * 4 + q, __ATOMIC_RELAXED, __HIP_MEMORY_SCOPE_AGENT);
            S[t] = 1.0f / sqrtf(s4 / (float)ldc + eps); }
        asm volatile("s_waitcnt lgkmcnt(0)" ::: "memory"); __builtin_amdgcn_s_barrier(); asm volatile("" ::: "memory");
        f32x4 gv[2][2];
#pragma unroll
        for (int bj = 0; bj < 2; ++bj)
#pragma unroll
            for (int n = 0; n < 2; ++n) gv[bj][n] = *(const f32x4*)(gain + col0 + bj * HALF + n * 16);
#pragma unroll
        for (int ai = 0; ai < 2; ++ai)
#pragma unroll
            for (int m = 0; m < 4; ++m) { const int r = ai * HALF + wr * 64 + m * 16 + fr; const float rs = S[r]; float* op = out + (size_t)(u.pm * BM + r) * ldc + col0;
#pragma unroll
                for (int bj = 0; bj < 2; ++bj)
#pragma unroll
                    for (int n = 0; n < 2; ++n) *(f32x4*)(op + bj * HALF + n * 16) = acc[ai][bj][m][n] * rs * gv[bj][n]; }
    }
};
struct EpiResBf16SqH {
    static constexpr bool PERM = false, AFTER_DRAIN = true, KSCALE = true;
    bf16_t* xres; float* sumsq; int ldc; const PG8_LAS float* rt4;
    __device__ __forceinline__ void kscale(f32x4 (&acc)[2][2][4][2], int hb, int wr, int fr) const {
#pragma unroll
        for (int ai = 0; ai < 2; ++ai)
#pragma unroll
            for (int m = 0; m < 4; ++m) { const float rho = rt4[(ai * HALF + wr * 64 + m * 16 + fr) * 4 + hb - 1];
#pragma unroll
                for (int bj = 0; bj < 2; ++bj)
#pragma unroll
                    for (int n = 0; n < 2; ++n) acc[ai][bj][m][n] = acc[ai][bj][m][n] * rho; }
    }
    __device__ __forceinline__ void fused(f32x4 (&acc)[2][2][4][2], const Unit& u, int wr, int wc, int fr, int fq, PG8_LAS unsigned char* lds, int wid, int lane) const {
        PG8_LAS float* P = (PG8_LAS float*)lds;
        const int col0 = u.pn * BM + wc * 32 + 4 * fq;
#pragma unroll
        for (int ai = 0; ai < 2; ++ai)
#pragma unroll
            for (int m = 0; m < 4; ++m) { const int r = ai * HALF + wr * 64 + m * 16 + fr; bf16_t* xp = xres + (size_t)(u.pm * BM + r) * ldc + col0; float ss = 0.f; const float s3 = rt4[r * 4 + 3];
#pragma unroll
                for (int bj = 0; bj < 2; ++bj)
#pragma unroll
                    for (int n = 0; n < 2; ++n) { const u32x2 xb = *(const u32x2*)(xp + bj * HALF + n * 16); const f32x4 a = acc[ai][bj][m][n] * s3;
                        u32x2 w; w.x = pk_bf16(bf_lo(xb.x) + a[0], bf_hi(xb.x) + a[1]); w.y = pk_bf16(bf_lo(xb.y) + a[2], bf_hi(xb.y) + a[3]);
                        *(u32x2*)(xp + bj * HALF + n * 16) = w;
                        const float y0 = bf_lo(w.x), y1 = bf_hi(w.x), y2 = bf_lo(w.y), y3 = bf_hi(w.y); ss += (y0 * y0 + y1 * y1) + (y2 * y2 + y3 * y3); }
                ss += __shfl_xor(ss, 16); ss += __shfl_xor(ss, 32);
                if (fq == 0) P[r * 4 + wc] = ss;
                asm volatile("" ::: "memory"); }
        asm volatile("s_waitcnt lgkmcnt(0)" ::: "memory"); __builtin_amdgcn_s_barrier(); asm volatile("" ::: "memory");
        const int t = wid * 64 + lane;
        if (t < 256) { const f32x4 p = *(const PG8_LAS f32x4*)(P + t * 4); sumsq[(size_t)(u.pm * BM + t) * 4 + u.pn] = (p[0] + p[1]) + (p[2] + p[3]); }
    }
};
template <class Epi, class Sched, bool ALIGN_EPI = false, bool SP2 = false>
__device__ __forceinline__ void gemm_phase(PG8_LAS unsigned char* lds, const Gemm g, const Sched& S, const Epi& E) {
    const int tid = threadIdx.x, wid = __builtin_amdgcn_readfirstlane(tid >> 6), lane = tid & 63, wr = wid >> 2, wc = wid & 3, fr = lane & 15, fq = lane >> 4;
    const int K = g.K, nt = K / BK;
    unsigned voffA[2], voffB[2];
#pragma unroll
    for (int i = 0; i < 2; ++i) { int R, C; stage_rc(tid * 16 + i * 8192, R, C); const int Rb = Epi::PERM ? ((R & ~31) + perm32(R & 31)) : R;
        voffA[i] = (unsigned)(R * K + C) * 2u; voffB[i] = (unsigned)(Rb * K + C) * 2u; }
    const size_t kstep = (size_t)(BK * 2);
    const size_t hstep = (size_t)HALF * K * 2;
    const size_t tstep = 2 * hstep;
    const unsigned ldsw = (unsigned)wid * 1024u;
    const int aoff = lds_byte(wr * 64 + fr, fq * 8), boff = lds_byte(wc * 32 + fr, fq * 8);
#define PG8_SA(b, h) (((b) * 2 + (h)) * HTB)
#define PG8_SB(b, h) ((4 + (b) * 2 + (h)) * HTB)
#define PG8_STAGE(bufoff, gbase, voff) do { _Pragma("unroll") for (int _i = 0; _i < 2; ++_i) \
        __builtin_amdgcn_global_load_lds((const unsigned*)((const char*)(gbase) + (voff)[_i]), (PG8_LAS unsigned*)(lds + (bufoff) + ldsw + _i * 8192), 16, 0, 0); } while (0)
#define PG8_LDA(dst, b, h) do { _Pragma("unroll") for (int m = 0; m < 4; ++m) _Pragma("unroll") for (int k = 0; k < 2; ++k) dst[m][k] = *(const PG8_LAS bf16x8*)(lds + PG8_SA(b, h) + aoff + m * 2048 + k * 1024); } while (0)
#define PG8_LDB(dst, b, h) do { _Pragma("unroll") for (int n = 0; n < 2; ++n) _Pragma("unroll") for (int k = 0; k < 2; ++k) dst[n][k] = *(const PG8_LAS bf16x8*)(lds + PG8_SB(b, h) + boff + n * 2048 + k * 1024); } while (0)
#define PG8_MMA(ai, bj, At, Bt) do { __builtin_amdgcn_s_setprio(1); _Pragma("unroll") for (int m = 0; m < 4; ++m) _Pragma("unroll") for (int n = 0; n < 2; ++n) _Pragma("unroll") for (int k = 0; k < 2; ++k) \
        acc[ai][bj][m][n] = __builtin_amdgcn_mfma_f32_16x16x32_bf16(Bt[n][k], At[m][k], acc[ai][bj][m][n], 0, 0, 0); __builtin_amdgcn_s_setprio(0); } while (0)
#define PG8_WAIT_V(n) asm volatile("s_waitcnt vmcnt(" #n ")" ::: "memory")
#define PG8_WAIT_L(n) asm volatile("s_waitcnt lgkmcnt(" #n ")" ::: "memory")
#define PG8_BAR __builtin_amdgcn_s_barrier()
#define PG8_SCHED __builtin_amdgcn_sched_barrier(0)
    Unit cur, nxt; int ui = 0;
    if (!S.next(0, cur)) return;
    f32x4 acc[2][2][4][2];
#pragma unroll
    for (int a = 0; a < 2; ++a)
#pragma unroll
        for (int b = 0; b < 2; ++b)
#pragma unroll
            for (int m = 0; m < 4; ++m)
#pragma unroll
                for (int n = 0; n < 2; ++n) acc[a][b][m][n] = (f32x4){0.f, 0.f, 0.f, 0.f};
    bf16x8 At[4][2], B0[2][2], B1[2][2];
    const char* cA = (const char*)g.A + (size_t)cur.pm * tstep; const char* cB = (const char*)g.Bt + (size_t)cur.pn * tstep;
    S.a_ready(cur);
    if constexpr (SP2) {
        PG8_STAGE(PG8_SB(0, 0), cB, voffB); PG8_STAGE(PG8_SB(0, 1), cB + hstep, voffB); PG8_STAGE(PG8_SA(0, 0), cA, voffA); PG8_STAGE(PG8_SA(0, 1), cA + hstep, voffA);
        if (wr == 1) PG8_BAR;
        PG8_WAIT_V(2); PG8_BAR;
        PG8_STAGE(PG8_SB(1, 0), cB + kstep, voffB); PG8_STAGE(PG8_SA(1, 0), cA + kstep, voffA); PG8_STAGE(PG8_SB(1, 1), cB + hstep + kstep, voffB);
        PG8_WAIT_V(6); PG8_BAR;
    } else {
        PG8_STAGE(PG8_SB(0, 0), cB, voffB); PG8_STAGE(PG8_SA(0, 0), cA, voffA); PG8_STAGE(PG8_SB(0, 1), cB + hstep, voffB); PG8_STAGE(PG8_SA(0, 1), cA + hstep, voffA);
        if (wr == 1) PG8_BAR;
        PG8_WAIT_V(4); PG8_BAR;
        PG8_STAGE(PG8_SB(1, 0), cB + kstep, voffB); PG8_STAGE(PG8_SA(1, 0), cA + kstep, voffA); PG8_STAGE(PG8_SB(1, 1), cB + hstep + kstep, voffB);
        PG8_WAIT_V(6); PG8_BAR;
    }
    for (;;) {
        const bool has_next = S.next(ui + 1, nxt);
        const char* nA = has_next ? (const char*)g.A + (size_t)nxt.pm * tstep : cA; const char* nB = has_next ? (const char*)g.Bt + (size_t)nxt.pn * tstep : cB;
        for (int t = 0; t < nt; t += 2) {
            if constexpr (Epi::KSCALE) { if (t != 0 && (t & 3) == 0) E.kscale(acc, t >> 2, wr, fr); }
            const bool last = (t == nt - 2);
            const char* a1 = cA + (size_t)(t + 1) * kstep;
            const char* a2 = last ? nA : cA + (size_t)(t + 2) * kstep; const char* b2 = last ? nB : cB + (size_t)(t + 2) * kstep;
            const char* a3 = a2 + kstep; const char* b3 = b2 + kstep;
            if (last && has_next) S.a_ready(nxt);
            if constexpr (SP2) {
            PG8_LDB(B0, 0, 0); PG8_LDB(B1, 0, 1); PG8_SCHED; PG8_LDA(At, 0, 0); PG8_STAGE(PG8_SA(1, 1), a1 + hstep, voffA);
            PG8_WAIT_V(8); PG8_WAIT_L(0); PG8_BAR; PG8_MMA(0, 0, At, B0); PG8_MMA(0, 1, At, B1); PG8_BAR; PG8_SCHED;
            PG8_LDA(At, 0, 1); PG8_STAGE(PG8_SB(0, 0), b2, voffB); PG8_STAGE(PG8_SB(0, 1), b2 + hstep, voffB); PG8_STAGE(PG8_SA(0, 0), a2, voffA);
            PG8_WAIT_V(8); PG8_WAIT_L(0); PG8_BAR; PG8_MMA(1, 0, At, B0); PG8_MMA(1, 1, At, B1); PG8_BAR; PG8_SCHED;
            PG8_LDB(B0, 1, 0); PG8_LDB(B1, 1, 1); PG8_SCHED; PG8_LDA(At, 1, 0); PG8_STAGE(PG8_SA(0, 1), a2 + hstep, voffA);
            PG8_WAIT_V(8); PG8_WAIT_L(0); PG8_BAR; PG8_MMA(0, 0, At, B0); PG8_MMA(0, 1, At, B1); PG8_BAR; PG8_SCHED;
            PG8_LDA(At, 1, 1); PG8_STAGE(PG8_SB(1, 0), b3, voffB); PG8_STAGE(PG8_SB(1, 1), b3 + hstep, voffB); PG8_STAGE(PG8_SA(1, 0), a3, voffA);
            PG8_WAIT_V(8); PG8_WAIT_L(0); PG8_BAR; PG8_MMA(1, 0, At, B0); PG8_MMA(1, 1, At, B1); PG8_BAR; PG8_SCHED;
            } else {
            PG8_LDB(B0, 0, 0); PG8_SCHED; PG8_LDA(At, 0, 0); PG8_STAGE(PG8_SA(1, 1), a1 + hstep, voffA);
            PG8_WAIT_L(8); PG8_BAR; PG8_WAIT_L(0); PG8_MMA(0, 0, At, B0); PG8_BAR; PG8_SCHED;
            PG8_LDB(B1, 0, 1); PG8_STAGE(PG8_SB(0, 0), b2, voffB);
            PG8_BAR; PG8_WAIT_L(0); PG8_MMA(0, 1, At, B1); PG8_BAR;
            PG8_LDA(At, 0, 1); PG8_STAGE(PG8_SA(0, 0), a2, voffA);
            PG8_BAR; PG8_WAIT_L(0); PG8_MMA(1, 0, At, B0); PG8_BAR; PG8_SCHED;
            PG8_STAGE(PG8_SB(0, 1), b2 + hstep, voffB);
            PG8_WAIT_V(6); PG8_BAR; PG8_MMA(1, 1, At, B1); PG8_BAR;
            PG8_LDB(B0, 1, 0); PG8_SCHED; PG8_LDA(At, 1, 0); PG8_STAGE(PG8_SA(0, 1), a2 + hstep, voffA);
            PG8_WAIT_L(8); PG8_BAR; PG8_WAIT_L(0); PG8_MMA(0, 0, At, B0); PG8_BAR; PG8_SCHED;
            PG8_LDB(B1, 1, 1); PG8_STAGE(PG8_SB(1, 0), b3, voffB);
            PG8_BAR; PG8_WAIT_L(0); PG8_MMA(0, 1, At, B1); PG8_BAR;
            PG8_LDA(At, 1, 1); PG8_STAGE(PG8_SA(1, 0), a3, voffA);
            PG8_BAR; PG8_WAIT_L(0); PG8_MMA(1, 0, At, B0); PG8_BAR; PG8_SCHED;
            PG8_STAGE(PG8_SB(1, 1), b3 + hstep, voffB);
            PG8_WAIT_V(6); PG8_BAR; PG8_MMA(1, 1, At, B1); PG8_BAR;
            }
        }
        if constexpr (ALIGN_EPI) { if (wr == 0) PG8_BAR; }
        if constexpr (!Epi::AFTER_DRAIN) { E(acc, cur, wr, wc, fr, fq); S.done(cur); }
        if (!has_next) break;
#pragma unroll
        for (int a = 0; a < 2; ++a)
#pragma unroll
            for (int b = 0; b < 2; ++b)
#pragma unroll
                for (int m = 0; m < 4; ++m)
#pragma unroll
                    for (int n = 0; n < 2; ++n) acc[a][b][m][n] = (f32x4){0.f, 0.f, 0.f, 0.f};
        cur = nxt; cA = nA; cB = nB; ++ui;
        if constexpr (ALIGN_EPI) { if (wr == 1) PG8_BAR; }
    }
    PG8_WAIT_V(0);
    if constexpr (!ALIGN_EPI) { if (wr == 0) PG8_BAR; }
    PG8_BAR;
    if constexpr (Epi::AFTER_DRAIN) { E.fused(acc, cur, wr, wc, fr, fq, lds, wid, lane); S.done(cur); }
#undef PG8_SA
#undef PG8_SB
#undef PG8_STAGE
#undef PG8_LDA
#undef PG8_LDB
#undef PG8_MMA
#undef PG8_WAIT_V
#undef PG8_WAIT_L
#undef PG8_BAR
#undef PG8_SCHED
}
}

constexpr int NWAVES = 8, NTHREADS = 512;
#ifndef MK_N_LAUNCHES
#define MK_N_LAUNCHES 1
#endif
constexpr int BATCH = 8, SEQ = 2048, D = 1024, FF = 4096, NH = 4, DK = 128, DV = 256, QKW = 512, VW = 1024;
constexpr int M = BATCH * SEQ, NPROJ = 3072, CH = 64, NCH = SEQ / CH;
constexpr int MLSTM_IN = 3080, GLA_IN = 3088;
constexpr float EPS = 1e-6f, QK_SCALE = 0.08838834764831845f, INV_TAU = 1.0f / 16.0f;

constexpr size_t MiB = 1u << 20;
constexpr size_t WS_CTL = 0, CTL_ZERO_BYTES = 64 * 1024;
constexpr size_t WS_GATES = 1 * MiB;
constexpr size_t WS_GDEC = 2 * MiB;
constexpr size_t WS_WGT = 2 * MiB + 768 * 1024;
constexpr size_t WS_SUMSQ = 2 * MiB + 512 * 1024;
constexpr size_t WS_WIN = 4 * MiB, WS_WOUT = 10 * MiB, WS_W1 = 12 * MiB, WS_W2 = 20 * MiB, WS_WLAYER = 56 * MiB;
constexpr size_t WS_SSQ = 84 * MiB;
constexpr size_t WS_AOP = 28 * MiB;
constexpr size_t WS_PROJ = 92 * MiB, WS_BBLK = 16 * MiB, WS_QT_OFF = 12 * MiB, WS_KT_OFF = 14 * MiB;
constexpr size_t BBLK_E = WS_BBLK / 2;
constexpr size_t WS_HMID = 92 * MiB;
constexpr size_t WS_XRES = 220 * MiB;
constexpr size_t WS_END = 252 * MiB;
constexpr int CW_BAR = 1024, CW_XID = 8192, CW_XCL = 9216, CW_FIN = 14336, CW_GRP = 15360;

constexpr int RING_BYTES = 131072, LDS_BYTES = 163840, LDSCTL_OFF = LDS_BYTES - 1024, MISC_OFF = LDSCTL_OFF + 320;

#define GAS __attribute__((address_space(1)))
#define LAS __attribute__((address_space(3)))
typedef unsigned short bf16;
typedef unsigned v4u __attribute__((ext_vector_type(4)));
typedef unsigned v2u __attribute__((ext_vector_type(2)));
typedef float f32x4 __attribute__((ext_vector_type(4)));
typedef float f32x16 __attribute__((ext_vector_type(16)));
typedef short bf16x8 __attribute__((ext_vector_type(8)));
typedef short s16x4 __attribute__((ext_vector_type(4)));
typedef GAS unsigned gu32;
#define RLX_AGENT __ATOMIC_RELAXED, __HIP_MEMORY_SCOPE_AGENT
#define LDS_WAIT() asm volatile("s_waitcnt lgkmcnt(0)" ::: "memory")
#define VM_WAIT() asm volatile("s_waitcnt vmcnt(0)" ::: "memory")
using pg8::pk_bf16;
__device__ __forceinline__ float bf2f(unsigned b) { return __uint_as_float(b << 16); }
__device__ __forceinline__ float bflo(unsigned w) { return __uint_as_float(w << 16); }
__device__ __forceinline__ float bfhi(unsigned w) { return __uint_as_float(w & 0xffff0000u); }
__device__ __forceinline__ unsigned short f2bf1(float f) { return (unsigned short)(pk_bf16(f, 0.f) & 0xffffu); }

struct Args { const float* in[15]; float* out; unsigned char* ws; int ph_lo, ph_hi; };
#define XB_TMO      128
#define XB_XCNT(j)  (256  + 64 * (j))
#define XB_XSUB(j)  (1280 + 64 * (j))
#define XB_XGEN(j)  (2304 + 64 * (j))
#define XB_TOP      3328
#define XB_TOPGEN   3392
#define XCD_BAR_WORDS 3456
#define XB_SPIN_CAP (1u << 18)
__device__ __forceinline__ unsigned xb_ld(unsigned* p)              { return __hip_atomic_load(p, __ATOMIC_RELAXED, __HIP_MEMORY_SCOPE_AGENT); }
__device__ __forceinline__ unsigned xb_add(unsigned* p, unsigned v) { return __hip_atomic_fetch_add(p, v, __ATOMIC_RELAXED, __HIP_MEMORY_SCOPE_AGENT); }
__device__ __forceinline__ unsigned xb_xcc_id() { return (unsigned)__builtin_amdgcn_s_getreg((3 << 11) | 20) & 0xFu; }
#define XB_SPIN(cond, bar) do { unsigned _sp = 0; while (cond) { __builtin_amdgcn_s_sleep(1); \
    if ((++_sp & 255u) == 0u) { if (xb_ld(&(bar)[XB_TMO])) break; if (_sp > XB_SPIN_CAP) { atomicAdd(&(bar)[XB_TMO], 1u); break; } } } } while (0)
struct XcdBarrier { unsigned* bar; unsigned x; volatile LAS unsigned* st; };
__device__ __forceinline__ XcdBarrier xcd_barrier_post(unsigned* bar, volatile LAS unsigned* st) {
    XcdBarrier b; b.bar = bar; b.x = xb_xcc_id(); b.st = st;
    if (threadIdx.x == 0) (void)xb_add(&bar[XB_XCNT(b.x)], 1u);
    return b;
}
__device__ __forceinline__ void xcd_barrier_complete(unsigned* bar, unsigned x, unsigned& nloc, unsigned& nx) {
    const unsigned G = gridDim.x * gridDim.y * gridDim.z;
    unsigned sum, cnt, mine, sp = 0u;
    for (;;) {
        sum = 0u; cnt = 0u; mine = 0u;
#pragma unroll
        for (unsigned j = 0; j < 16; ++j) { const unsigned c = xb_ld(&bar[XB_XCNT(j)]); sum += c; cnt += (c > 0u) ? 1u : 0u; mine = (j == x) ? c : mine; }
        if (sum == G) break;
        __builtin_amdgcn_s_sleep(1);
        if ((++sp & 255u) == 0u) { if (xb_ld(&bar[XB_TMO])) break; if (sp > XB_SPIN_CAP) { atomicAdd(&bar[XB_TMO], 1u); break; } }
    }
    nloc = mine > 0u ? mine : 1u; nx = cnt > 0u ? cnt : 1u;
}
__device__ __forceinline__ void xcd_barrier(const XcdBarrier& b) {
    asm volatile("s_waitcnt vmcnt(0)" ::: "memory");
    __syncthreads();
    if (threadIdx.x == 0) {
        unsigned* bar = b.bar;
        __builtin_amdgcn_s_waitcnt(0);
        unsigned nloc = b.st[0], nx = b.st[1];
        if (nloc == 0u) { xcd_barrier_complete(bar, b.x, nloc, nx); b.st[0] = nloc; b.st[1] = nx; }
        const unsigned old = xb_add(&bar[XB_XSUB(b.x)], 1u);
        const unsigned gen = old / nloc;
        if (old + 1u == (gen + 1u) * nloc) {
            __builtin_amdgcn_fence(__ATOMIC_RELEASE, "agent");
            asm volatile("s_waitcnt vmcnt(0)" ::: "memory");
            const unsigned og = xb_add(&bar[XB_TOP], 1u);
            const unsigned tg = og / nx;
            if (og + 1u == (tg + 1u) * nx) xb_add(&bar[XB_TOPGEN], 1u);
            else XB_SPIN(xb_ld(&bar[XB_TOPGEN]) == tg, bar);
            __builtin_amdgcn_fence(__ATOMIC_ACQUIRE, "agent");
            xb_add(&bar[XB_XGEN(b.x)], 1u);
            asm volatile("s_waitcnt vmcnt(0)" ::: "memory");
        } else {
            XB_SPIN(xb_ld(&bar[XB_XGEN(b.x)]) == gen, bar);
            __builtin_amdgcn_fence(__ATOMIC_ACQUIRE, "agent");
            asm volatile("s_waitcnt vmcnt(0)" ::: "memory");
        }
    }
    __syncthreads();
}

__device__ __forceinline__ float wave_sum(float v) {
#pragma unroll
    for (int o = 1; o < 64; o <<= 1) v += __shfl_xor(v, o);
    return v;
}
struct CvItem { const float* W; bf16* WT; const float* gain; int K, ldw, k0, n0; };
__device__ __forceinline__ CvItem cv_item(const Args& args, unsigned char* ws, int it) {
    constexpr int I_IN = (D / 64) * (NPROJ / 64), I_O = (D / 64) * (D / 64), I_1 = (D / 64) * (FF / 64), I_2 = (FF / 64) * (D / 64), NITEMS = I_IN + I_O + I_1 + I_2;
    const int layer = it >= NITEMS; int r = it - layer * NITEMS; unsigned char* wl = ws + (size_t)layer * WS_WLAYER;
    CvItem c; int N;
    if (r < I_IN) { c.W = args.in[layer ? 8 : 4]; c.K = D; N = NPROJ; c.ldw = layer ? GLA_IN : MLSTM_IN; c.WT = (bf16*)(wl + WS_WIN); c.gain = args.in[1] + layer * D; }
    else if ((r -= I_IN) < I_O) { c.W = args.in[layer ? 12 : 7]; c.K = D; N = D; c.ldw = D; c.WT = (bf16*)(wl + WS_WOUT); c.gain = nullptr; }
    else if ((r -= I_O) < I_1) { c.W = args.in[13] + (size_t)layer * D * FF; c.K = D; N = FF; c.ldw = FF; c.WT = (bf16*)(wl + WS_W1); c.gain = args.in[2] + layer * D; }
    else { r -= I_1; c.W = args.in[14] + (size_t)layer * D * FF; c.K = FF; N = D; c.ldw = D; c.WT = (bf16*)(wl + WS_W2); c.gain = nullptr; }
    const int nblk = N / 64; c.k0 = 64 * (r / nblk); c.n0 = 64 * (r % nblk);
    return c;
}
__device__ __forceinline__ void cv_load(f32x4 (&v)[16], const CvItem& c, int lane) {
    const int n4 = (lane & 15) * 4, krow = lane >> 4;
#pragma unroll
    for (int i = 0; i < 16; ++i) v[i] = __builtin_nontemporal_load((const f32x4*)(c.W + (size_t)(c.k0 + 4 * i + krow) * c.ldw + c.n0 + n4));
}
__device__ __forceinline__ void cv_store(const f32x4 (&v)[16], const CvItem& c, LAS float* scr, int lane) {
    const int n4 = (lane & 15) * 4, krow = lane >> 4;
#pragma unroll
    for (int i = 0; i < 16; ++i) *(LAS f32x4*)(scr + (4 * i + krow) * 64 + (n4 ^ (((i >> 1) & 7) << 2))) = v[i];
    const int cc = lane & 7, nl = lane >> 3;
    f32x4 g0 = {1.f, 1.f, 1.f, 1.f}, g1 = {1.f, 1.f, 1.f, 1.f};
    if (c.gain) { g0 = *(const f32x4*)(c.gain + c.k0 + 8 * cc); g1 = *(const f32x4*)(c.gain + c.k0 + 8 * cc + 4); }
    LDS_WAIT(); asm volatile("" ::: "memory");
#pragma unroll
    for (int j = 0; j < 8; ++j) { const int n = 8 * j + nl; const LAS float* sp = scr + (8 * cc) * 64 + (n ^ (cc << 2));
        v4u o; o.x = pk_bf16(sp[0 * 64] * g0.x, sp[1 * 64] * g0.y); o.y = pk_bf16(sp[2 * 64] * g0.z, sp[3 * 64] * g0.w); o.z = pk_bf16(sp[4 * 64] * g1.x, sp[5 * 64] * g1.y); o.w = pk_bf16(sp[6 * 64] * g1.z, sp[7 * 64] * g1.w);
        *(GAS v4u*)(c.WT + (size_t)(c.n0 + n) * c.K + c.k0 + 8 * cc) = o; }
    LDS_WAIT(); asm volatile("" ::: "memory");
}
__device__ __forceinline__ void convert_weights(LAS unsigned char* lds, int lane, int wv, int nw, int vcu, int G, const Args& args, unsigned char* ws) {
    LAS float* scr = (LAS float*)(lds + wv * 16384);
    const int gw = vcu * nw + wv, NGW = G * nw;
    constexpr int NITEMS2 = 2 * ((D / 64) * (NPROJ / 64) + (D / 64) * (D / 64) + (D / 64) * (FF / 64) + (FF / 64) * (D / 64));
    f32x4 va[16], vb[16];
    int it = gw;
    if (it < NITEMS2) { const CvItem c0 = cv_item(args, ws, it); cv_load(va, c0, lane); }
    while (it < NITEMS2) {
        { const CvItem c = cv_item(args, ws, it); const int nx = it + NGW; if (nx < NITEMS2) { const CvItem cn = cv_item(args, ws, nx); cv_load(vb, cn, lane); } cv_store(va, c, scr, lane); it = nx; }
        if (it >= NITEMS2) break;
        { const CvItem c = cv_item(args, ws, it); const int nx = it + NGW; if (nx < NITEMS2) { const CvItem cn = cv_item(args, ws, nx); cv_load(va, cn, lane); } cv_store(vb, c, scr, lane); it = nx; }
    }
}

constexpr int WGB_PITCH = 2064;
#define ROWS_STAGE_LOAD() float wv_[16]; _Pragma("unroll") for (int n = 0; n < 16; ++n) { const int i = tid + NTHREADS * n, k = i >> 3, c = i & 7; wv_[n] = wg[(size_t)k * ldw + c] * gain[k]; }
#define ROWS_STAGE_WRITE() do { _Pragma("unroll") for (int n = 0; n < 16; ++n) { const int i = tid + NTHREADS * n, k = i >> 3, c = i & 7; const unsigned h = pk_bf16(wv_[n], 0.f) & 0xffffu; \
        *(LAS unsigned short*)(wgb + c * WGB_PITCH + 2 * k) = (unsigned short)h; *(LAS unsigned short*)(wgb + (c + 8) * WGB_PITCH + 2 * k) = f2bf1(wv_[n] - __uint_as_float(h << 16)); } } while (0)
__device__ __forceinline__ void rows_first(LAS unsigned char* wgb, LAS float* cmb, int tid, int lane, int wave, int vcu, int G, const float* wg, int ldw, const float* gain, const float* xin, bf16* xres, float* sumsq, float* gates) {
    const int r16 = lane & 15, kq = lane >> 4, kh = wave >> 2, bw = wave & 3;
    ROWS_STAGE_LOAD();
    bool staged = false;
    const LAS unsigned char* bp = wgb + r16 * WGB_PITCH + 1024 * kh + 16 * kq;
    for (int blk0 = vcu * 4; blk0 < M / 16; blk0 += G * 4) {
        const int m0 = (blk0 + bw) * 16;
        const float* xp = xin + (size_t)(m0 + r16) * D + 512 * kh + 8 * kq;
        bf16* xo = xres + (size_t)(m0 + r16) * D + 512 * kh + 8 * kq;
        f32x4 xa[8][2];
#pragma unroll
        for (int u = 0; u < 8; ++u) { xa[u][0] = __builtin_nontemporal_load((const f32x4*)(xp + 32 * u)); xa[u][1] = __builtin_nontemporal_load((const f32x4*)(xp + 32 * u + 4)); }
        if (!staged) { ROWS_STAGE_WRITE(); staged = true; __syncthreads(); }
        pg8::f32x4 acc = {0.f, 0.f, 0.f, 0.f}; float ss = 0.f;
#pragma unroll
        for (int s = 0; s < 16; ++s) { const int u = s & 7;
            const f32x4 a = xa[u][0], b = xa[u][1];
            if (s + 8 < 16) { xa[u][0] = __builtin_nontemporal_load((const f32x4*)(xp + 32 * (s + 8))); xa[u][1] = __builtin_nontemporal_load((const f32x4*)(xp + 32 * (s + 8) + 4)); }
            v4u h, l; h.x = pk_bf16(a.x, a.y); h.y = pk_bf16(a.z, a.w); h.z = pk_bf16(b.x, b.y); h.w = pk_bf16(b.z, b.w);
            l.x = pk_bf16(a.x - bflo(h.x), a.y - bfhi(h.x)); l.y = pk_bf16(a.z - bflo(h.y), a.w - bfhi(h.y)); l.z = pk_bf16(b.x - bflo(h.z), b.y - bfhi(h.z)); l.w = pk_bf16(b.z - bflo(h.w), b.w - bfhi(h.w));
            ss += ((a.x * a.x + a.y * a.y) + (a.z * a.z + a.w * a.w)) + ((b.x * b.x + b.y * b.y) + (b.z * b.z + b.w * b.w));
            *(v4u*)(xo + 32 * s) = h;
            const bf16x8 bv = *(const LAS bf16x8*)(bp + 64 * s);
            acc = __builtin_amdgcn_mfma_f32_16x16x32_bf16(__builtin_bit_cast(bf16x8, h), bv, acc, 0, 0, 0);
            acc = __builtin_amdgcn_mfma_f32_16x16x32_bf16(__builtin_bit_cast(bf16x8, l), bv, acc, 0, 0, 0); }
        ss += __shfl_xor(ss, 16); ss += __shfl_xor(ss, 32);
        LAS float* cw = cmb + (bw * 64 + lane) * 5;
        if (kh == 1) { cw[0] = acc[0]; cw[1] = acc[1]; cw[2] = acc[2]; cw[3] = acc[3]; cw[4] = ss; }
        __syncthreads();
        if (kh == 0) {
            acc[0] += cw[0]; acc[1] += cw[1]; acc[2] += cw[2]; acc[3] += cw[3]; ss += cw[4];
            if (kq == 0) *(f32x4*)(sumsq + (size_t)(m0 + r16) * 4) = (f32x4){ss, 0.f, 0.f, 0.f};
            const float rstd = 1.0f / sqrtf(ss * (1.f / D) + EPS);
#pragma unroll
            for (int j = 0; j < 4; ++j) { const float g = acc[j] + __shfl_xor(acc[j], 8); const float rs = __shfl(rstd, 4 * kq + j);
                if (r16 < 8) gates[(size_t)(m0 + 4 * kq + j) * 16 + r16] = g * rs; }
        }
        __syncthreads();
    }
}
__device__ __forceinline__ void rows_final(int lane, int wave, int vcu, int G, const bf16* xres, const float* gain, float* out) {
    const int gw = vcu * NWAVES + wave, NGW = G * NWAVES;
    for (int m = gw; m < M; m += NGW) {
        float f[2][8]; float ss = 0.f;
#pragma unroll
        for (int j = 0; j < 2; ++j) { const v4u hv = *(const v4u*)(xres + (size_t)m * D + 8 * lane + 512 * j);
            f[j][0] = bflo(hv.x); f[j][1] = bfhi(hv.x); f[j][2] = bflo(hv.y); f[j][3] = bfhi(hv.y); f[j][4] = bflo(hv.z); f[j][5] = bfhi(hv.z); f[j][6] = bflo(hv.w); f[j][7] = bfhi(hv.w);
#pragma unroll
            for (int e = 0; e < 8; ++e) ss += f[j][e] * f[j][e]; }
        const float rstd = 1.0f / sqrtf(wave_sum(ss) * (1.f / D) + EPS);
#pragma unroll
        for (int j = 0; j < 2; ++j) { const int col = 8 * lane + 512 * j; const f32x4 g0 = *(const f32x4*)(gain + col), g1 = *(const f32x4*)(gain + col + 4);
            *(f32x4*)(out + (size_t)m * D + col) = (f32x4){f[j][0] * rstd * g0.x, f[j][1] * rstd * g0.y, f[j][2] * rstd * g0.z, f[j][3] * rstd * g0.w};
            *(f32x4*)(out + (size_t)m * D + col + 4) = (f32x4){f[j][4] * rstd * g1.x, f[j][5] * rstd * g1.y, f[j][6] * rstd * g1.z, f[j][7] * rstd * g1.w}; }
    }
}
struct RstdSlots { int pm0, pm1, pm2, pm3; };
__device__ __forceinline__ RstdSlots rstd_table(LAS float* rt, const float* sumsq, const pg8::StaticOrder& S, int tid) {
    int pmv[4] = {-1, -1, -1, -1}; int ns = 0;
    pg8::Unit u;
    for (int i = 0; S.next(i, u); ++i) { if (u.pm != pmv[0] && u.pm != pmv[1] && u.pm != pmv[2] && u.pm != pmv[3] && ns < 4) { if (ns == 0) pmv[0] = u.pm; else if (ns == 1) pmv[1] = u.pm; else if (ns == 2) pmv[2] = u.pm; else pmv[3] = u.pm; ++ns; } }
#pragma unroll
    for (int sl = 0; sl < 4; ++sl) { const int pm = sl == 0 ? pmv[0] : sl == 1 ? pmv[1] : sl == 2 ? pmv[2] : pmv[3];
        if (pm >= 0 && tid < 256) { const f32x4 s4 = *(const f32x4*)(sumsq + (size_t)(pm * 256 + tid) * 4); rt[sl * 256 + tid] = 1.0f / sqrtf(((s4.x + s4.y) + (s4.z + s4.w)) * (1.f / D) + EPS); } }
    __syncthreads();
    return RstdSlots{pmv[0], pmv[1], pmv[2], pmv[3]};
}

__device__ __forceinline__ void head_scale_table(LAS float* rt4, const float* ssq, int pm, int tid) {
    if (tid < 256) { const float* p = ssq + (size_t)(pm * 256 + tid) * 32; float sh[4];
#pragma unroll
        for (int h = 0; h < 4; ++h) { const f32x4 a = *(const f32x4*)(p + 8 * h), b = *(const f32x4*)(p + 8 * h + 4); sh[h] = 1.0f / sqrtf((((a.x + a.y) + (a.z + a.w)) + ((b.x + b.y) + (b.z + b.w))) * (1.f / DV) + EPS); }
        *(LAS f32x4*)(rt4 + 4 * tid) = (f32x4){sh[0] / sh[1], sh[1] / sh[2], sh[2] / sh[3], sh[3]}; }
    __syncthreads();
}
__device__ __forceinline__ void head_norm_rows(int lane, int wave, int vcu, int G, const bf16* hun, const float* gout, const bf16* proj, bf16* aop, const bool GLA) {
    const int rows_wg = M / G, rows_w = rows_wg / NWAVES;
    for (int i = 0; i < rows_w; ++i) {
        const int m = vcu * rows_wg + wave * rows_w + i;
#pragma unroll
        for (int j = 0; j < 2; ++j) {
            const int col = 8 * lane + 512 * j;
            const v4u hv = *(const v4u*)(hun + (size_t)m * D + col);
            const v4u rv = *(const v4u*)(proj + (size_t)(m >> 11) * BBLK_E + (size_t)(m & 2047) * NPROJ + 2048 + col);
            float f[8] = {bflo(hv.x), bfhi(hv.x), bflo(hv.y), bfhi(hv.y), bflo(hv.z), bfhi(hv.z), bflo(hv.w), bfhi(hv.w)};
            const float r[8] = {bflo(rv.x), bfhi(rv.x), bflo(rv.y), bfhi(rv.y), bflo(rv.z), bfhi(rv.z), bflo(rv.w), bfhi(rv.w)};
            float sg[8];
#pragma unroll
            for (int e = 0; e < 8; ++e) sg[e] = __builtin_amdgcn_rcpf(1.0f + __expf(-r[e]));
            if (!GLA) {
#pragma unroll
                for (int e = 0; e < 8; ++e) f[e] *= sg[e];
            }
            float ss = 0.f;
#pragma unroll
            for (int e = 0; e < 8; ++e) ss += f[e] * f[e];
#pragma unroll
            for (int o = 1; o < 32; o <<= 1) ss += __shfl_xor(ss, o);
            const float rs = 1.0f / sqrtf(ss * (1.f / DV) + EPS);
            const f32x4 g0 = *(const f32x4*)(gout + col), g1 = *(const f32x4*)(gout + col + 4);
            const float gg[8] = {g0.x, g0.y, g0.z, g0.w, g1.x, g1.y, g1.z, g1.w};
#pragma unroll
            for (int e = 0; e < 8; ++e) f[e] = f[e] * rs * gg[e];
            if (GLA) {
#pragma unroll
                for (int e = 0; e < 8; ++e) f[e] *= r[e] * sg[e];
            }
            v4u o; o.x = pk_bf16(f[0], f[1]); o.y = pk_bf16(f[2], f[3]); o.z = pk_bf16(f[4], f[5]); o.w = pk_bf16(f[6], f[7]);
            *(v4u*)(aop + (size_t)m * D + col) = o;
        }
    }
}

constexpr int GP_WGT = 0, GP_WGT_PITCH = 2064, GP_ZL = 33024, GP_TOT = 41216, GP_Q = 43264, GP_K = 59648;
__device__ __forceinline__ void gla_prep(LAS unsigned char* lds, int tid, int lane, int wave, int vcu, int G, const bf16* proj, const bf16* xres, const float* sumsq, const bf16* wgt,
                                         const float* wup, const float* bgate, bf16* QT, bf16* KT, float* gdec) {
#define GP_BAR() do { asm volatile("s_waitcnt lgkmcnt(0)" ::: "memory"); __builtin_amdgcn_s_barrier(); asm volatile("" ::: "memory"); } while (0)
    LAS float* zl = (LAS float*)(lds + GP_ZL);
    LAS float* tot = (LAS float*)(lds + GP_TOT);
    LAS unsigned short* tq = (LAS unsigned short*)(lds + GP_Q);
    LAS unsigned short* tk = (LAS unsigned short*)(lds + GP_K);
    __syncthreads();
    { v4u wv[5];
#pragma unroll
      for (int n = 0; n < 5; ++n) { const int i = tid + NTHREADS * n; if (i < 2064) wv[n] = *(const v4u*)(wgt + 8 * i); }
#pragma unroll
      for (int n = 0; n < 5; ++n) { const int i = tid + NTHREADS * n; if (i < 2064) *(LAS v4u*)(lds + GP_WGT + 16 * i) = wv[n]; } }
    const int d = tid & 127, rg = tid >> 7;
    for (int unit = vcu; unit < BATCH * NCH; unit += G) {
        const int b = unit / NCH, c = unit % NCH, tok0 = b * SEQ + c * CH;
        const bf16* projb = proj + (size_t)b * BBLK_E + (size_t)(c * CH) * NPROJ; bf16* QTb = QT + (size_t)b * BBLK_E + (size_t)(c * CH) * QKW; bf16* KTb = KT + (size_t)b * BBLK_E + (size_t)(c * CH) * QKW;
        v4u pq[2], pk[2]; float wu[16]; float bg;
#define GP_LOAD(h_) do { _Pragma("unroll") for (int i_ = 0; i_ < 2; ++i_) { const int p_ = tid + NTHREADS * i_, row_ = p_ >> 4, ch_ = p_ & 15; \
            pq[i_] = *(const v4u*)(projb + (size_t)row_ * NPROJ + (h_) * DK + ch_ * 8); pk[i_] = *(const v4u*)(projb + (size_t)row_ * NPROJ + QKW + (h_) * DK + ch_ * 8); } \
            _Pragma("unroll") for (int cc_ = 0; cc_ < 16; ++cc_) wu[cc_] = wup[cc_ * QKW + (h_) * DK + d]; bg = bgate[(h_) * DK + d]; } while (0)
        GP_LOAD(0);
        const f32x4 s4pre = *(const f32x4*)(sumsq + (size_t)(tok0 + (tid >> 3)) * 4);
        GP_BAR();
        {
            const int rt = wave & 3, kh = wave >> 2, r16 = lane & 15, kq = lane >> 4;
            pg8::f32x4 acc = {0.f, 0.f, 0.f, 0.f};
            const bf16* xr = xres + (size_t)(tok0 + 16 * rt + r16) * D + kh * 512 + 8 * kq;
            LAS unsigned char* wr_ = lds + GP_WGT + r16 * GP_WGT_PITCH + (kh * 512 + 8 * kq) * 2;
#pragma unroll
            for (int ks = 0; ks < 16; ++ks) { const bf16x8 av = *(const bf16x8*)(xr + 32 * ks), bv = *(const LAS bf16x8*)(wr_ + 64 * ks); acc = __builtin_amdgcn_mfma_f32_16x16x32_bf16(av, bv, acc, 0, 0, 0); }
#pragma unroll
            for (int i = 0; i < 4; ++i) zl[kh * 1024 + (16 * rt + 4 * kq + i) * 16 + r16] = acc[i];
        }
        GP_BAR();
        { const int row = tid >> 3, c2 = (tid & 7) * 2;
          const f32x4 s4 = s4pre; const float rstd = 1.0f / sqrtf(((s4.x + s4.y) + (s4.z + s4.w)) * (1.f / D) + EPS);
          const float z0 = (zl[row * 16 + c2] + zl[1024 + row * 16 + c2]) * rstd, z1 = (zl[row * 16 + c2 + 1] + zl[1024 + row * 16 + c2 + 1]) * rstd;
          GP_BAR();
          zl[row * 16 + c2] = z0; zl[row * 16 + c2 + 1] = z1; }
        GP_BAR();
#pragma unroll
        for (int h = 0; h < NH; ++h) {
#pragma unroll
            for (int i = 0; i < 2; ++i) { const int p = tid + NTHREADS * i; *(LAS v4u*)(lds + GP_Q + p * 16) = pq[i]; *(LAS v4u*)(lds + GP_K + p * 16) = pk[i]; }
            float wuh[16]; const float bgh = bg;
#pragma unroll
            for (int cc = 0; cc < 16; ++cc) wuh[cc] = wu[cc];
            if (h + 1 < NH) GP_LOAD(h + 1);
            float bcum[16]; float run = 0.f;
#pragma unroll
            for (int jj = 0; jj < 16; ++jj) {
                const int j = 16 * rg + jj; float z = bgh;
#pragma unroll
                for (int q4 = 0; q4 < 4; ++q4) { const f32x4 zz = *(const LAS f32x4*)(zl + j * 16 + 4 * q4); z += (zz.x * wuh[4 * q4] + zz.y * wuh[4 * q4 + 1]) + (zz.z * wuh[4 * q4 + 2] + zz.w * wuh[4 * q4 + 3]); }
                const float la = (fminf(z, 0.f) - __logf(1.0f + __expf(-fabsf(z)))) * INV_TAU;
                run += la; bcum[jj] = run;
            }
            tot[rg * 128 + d] = run;
            GP_BAR();
            float off = 0.f, g = 0.f;
#pragma unroll
            for (int r2 = 0; r2 < 4; ++r2) { const float t = tot[r2 * 128 + d]; g += t; off += (r2 < rg) ? t : 0.f; }
#pragma unroll
            for (int jj = 0; jj < 16; ++jj) {
                const int j = 16 * rg + jj; const float eb = __expf(bcum[jj] + off);
                const float q = bf2f(tq[j * 128 + d]), k = bf2f(tk[j * 128 + d]);
                tq[j * 128 + d] = f2bf1(q * QK_SCALE * eb); tk[j * 128 + d] = f2bf1(k * __builtin_amdgcn_rcpf(eb));
            }
            if (rg == 0) gdec[(size_t)(unit * NH + h) * DK + d] = __expf(g);
            GP_BAR();
#pragma unroll
            for (int i = 0; i < 2; ++i) { const int p = tid + NTHREADS * i, row = p >> 4, ch = p & 15;
                *(v4u*)(QTb + (size_t)row * QKW + h * DK + ch * 8) = *(const LAS v4u*)(lds + GP_Q + p * 16);
                *(v4u*)(KTb + (size_t)row * QKW + h * DK + ch * 8) = *(const LAS v4u*)(lds + GP_K + p * 16); }
            GP_BAR();
        }
#undef GP_LOAD
    }
    __syncthreads();
}

#ifndef PROBE_P
#define PROBE_P 0
#endif
#ifndef PROBE_P_A
#define PROBE_P_A 0
#endif
#ifndef PROBE_P_B
#define PROBE_P_B 1
#endif
#define PP_SEL(i, S_) ((S_) < 32 ? (i) / 2 == (S_) : ((i) == 2 * ((S_) - 32) + 1 || (i) == 2 * ((S_) - 32) + 2))
#define PP_STAMP(i) do { if (PROBE_P && (PP_SEL(i, PROBE_P_A) || PP_SEL(i, PROBE_P_B)) && tid == 0) ((volatile LAS unsigned*)(lds + LDSCTL_OFF + 512))[i] = (unsigned)__builtin_amdgcn_s_memrealtime(); } while (0)
#ifndef PROBE_T
#define PROBE_T 0
#endif
#ifndef PROBE_T_MLSTM
#define PROBE_T_MLSTM 0
#endif
#ifndef PROBE_T_WAVE
#define PROBE_T_WAVE 0
#endif
#ifndef PROBE_T_A
#define PROBE_T_A 5
#endif
#ifndef PROBE_T_B
#define PROBE_T_B 0
#endif
constexpr int CW_PROBE = 12288;
__device__ __forceinline__ unsigned long long pt_now() { unsigned long long t; __builtin_amdgcn_sched_barrier(0); asm volatile("s_memrealtime %0\n\ts_waitcnt lgkmcnt(0)" : "=s"(t) :: "memory"); __builtin_amdgcn_sched_barrier(0); return t; }
#define PT_NOW() pt_now()
#define PT_ACC(i, t0) do { if (PROBE_T) { const unsigned long long t1_ = PT_NOW(); pt[i] += (unsigned)(t1_ - (t0)); (t0) = t1_; } } while (0)
constexpr int PS_PITCH = 144, CT_PITCH = 272, CT_BYTES = 32 * CT_PITCH, IMG_PITCH = 272, IMG_BYTES = 64 * IMG_PITCH, NUM_PITCH = 36;
template <bool MLSTM> struct MxMap;
template <> struct MxMap<true>  { static constexpr int QS = 0, KS = 34816, V = 69632, VW = 77824, VWAUX = 81920, PS = 86016, CT = 95232, TB = 112640, TWP = 120832, TPM = 129024, TSC = 137216, DEN = 137728, NUM = 138240, WI = 147456, GDEC = 0, END = 147968; };
template <> struct MxMap<false> { static constexpr int QS = 0, KS = 34816, V = 69632, VW = 0, VWAUX = 0, PS = 77824, CT = 87040, TB = 0, TWP = 0, TPM = 0, TSC = 0, DEN = 0, NUM = 104448, WI = 0, GDEC = 113664, END = 114688; };
#define LDSA(p) ((unsigned)(size_t)(p))
__device__ __forceinline__ bf16x8 mk8(v2u lo, v2u hi) { v4u w; w.x = lo.x; w.y = lo.y; w.z = hi.x; w.w = hi.y; return __builtin_bit_cast(bf16x8, w); }
__device__ __forceinline__ void tr_read2(bf16x8& f0, bf16x8& f1, unsigned a0, unsigned a1, unsigned b0, unsigned b1) {
    v2u l0, h0, l1, h1;
    asm volatile("ds_read_b64_tr_b16 %0, %4\n\tds_read_b64_tr_b16 %1, %5\n\tds_read_b64_tr_b16 %2, %6\n\tds_read_b64_tr_b16 %3, %7\n\ts_waitcnt lgkmcnt(0)"
                 : "=&v"(l0), "=&v"(h0), "=&v"(l1), "=&v"(h1) : "v"(a0), "v"(a1), "v"(b0), "v"(b1) : "memory");
    f0 = mk8(l0, h0); f1 = mk8(l1, h1);
}
__device__ __forceinline__ void tr_read3(bf16x8& f0, bf16x8& f1, bf16x8& f2, unsigned a0, unsigned a1, unsigned b0, unsigned b1, unsigned c0, unsigned c1) {
    v2u l0, h0, l1, h1, l2, h2;
    asm volatile("ds_read_b64_tr_b16 %0, %6\n\tds_read_b64_tr_b16 %1, %7\n\tds_read_b64_tr_b16 %2, %8\n\tds_read_b64_tr_b16 %3, %9\n\tds_read_b64_tr_b16 %4, %10\n\tds_read_b64_tr_b16 %5, %11\n\ts_waitcnt lgkmcnt(0)"
                 : "=&v"(l0), "=&v"(h0), "=&v"(l1), "=&v"(h1), "=&v"(l2), "=&v"(h2) : "v"(a0), "v"(a1), "v"(b0), "v"(b1), "v"(c0), "v"(c1) : "memory");
    f0 = mk8(l0, h0); f1 = mk8(l1, h1); f2 = mk8(l2, h2);
}
template <int P> __device__ __forceinline__ void tr_issue4(v2u (&x)[8], unsigned base) {
    asm volatile("ds_read_b64_tr_b16 %0, %8 offset:%9\n\tds_read_b64_tr_b16 %1, %8 offset:%10\n\tds_read_b64_tr_b16 %2, %8 offset:%11\n\tds_read_b64_tr_b16 %3, %8 offset:%12\n\t"
                 "ds_read_b64_tr_b16 %4, %8 offset:%13\n\tds_read_b64_tr_b16 %5, %8 offset:%14\n\tds_read_b64_tr_b16 %6, %8 offset:%15\n\tds_read_b64_tr_b16 %7, %8 offset:%16"
                 : "=&v"(x[0]), "=&v"(x[1]), "=&v"(x[2]), "=&v"(x[3]), "=&v"(x[4]), "=&v"(x[5]), "=&v"(x[6]), "=&v"(x[7])
                 : "v"(base), "i"(0), "i"(4 * P), "i"(16 * P), "i"(20 * P), "i"(32 * P), "i"(36 * P), "i"(48 * P), "i"(52 * P) : "memory");
}
__device__ __forceinline__ void tr_wait8(v2u (&x)[8]) { asm volatile("s_waitcnt lgkmcnt(0)" : "+v"(x[0]), "+v"(x[1]), "+v"(x[2]), "+v"(x[3]), "+v"(x[4]), "+v"(x[5]), "+v"(x[6]), "+v"(x[7]) :: "memory"); }
__device__ __forceinline__ void tr_pin8(v2u (&x)[8]) { asm volatile("" : "+v"(x[0]), "+v"(x[1]), "+v"(x[2]), "+v"(x[3]), "+v"(x[4]), "+v"(x[5]), "+v"(x[6]), "+v"(x[7])); }
__device__ __forceinline__ bf16x8 tr_read1(unsigned a0, unsigned a1) {
    v2u l0, h0;
    asm volatile("ds_read_b64_tr_b16 %0, %2\n\tds_read_b64_tr_b16 %1, %3\n\ts_waitcnt lgkmcnt(0)" : "=&v"(l0), "=&v"(h0) : "v"(a0), "v"(a1) : "memory");
    return mk8(l0, h0);
}
#define MFMA32(a, b, c) __builtin_amdgcn_mfma_f32_32x32x16_bf16((a), (b), (c), 0, 0, 0)
#define MX_BAR() do { asm volatile("s_waitcnt lgkmcnt(0)" ::: "memory"); __builtin_amdgcn_s_barrier(); asm volatile("" ::: "memory"); } while (0)
#define MX_BAR_VM() do { asm volatile("s_waitcnt vmcnt(0) lgkmcnt(0)" ::: "memory"); __builtin_amdgcn_s_barrier(); asm volatile("" ::: "memory"); } while (0)
struct MixArgs { const bf16 *q, *k, *proj; int qpitch; const float *gates, *bgate, *gdec; bf16* hun; void* probe; const float* gout; float* ssq; };
struct MixUnit { const bf16 *Qg, *Kg, *Vg, *Gg; bf16* Hg; const float* gdec; float* ssq; int qpitch, b, hh, slice; };
constexpr int MX_NPIECE = 38, MX_PPW = 5;
template <bool MLSTM> struct MixDma { static constexpr int PPW = MX_PPW; unsigned voff[PPW]; };
template <bool MLSTM> __device__ __forceinline__ int mx_piece(int wave, int i) { return wave + 8 * i; }

template <bool MLSTM>
__device__ __forceinline__ void mx_dma_setup(MixDma<MLSTM>& dm, int wave, int lane, int qpitch) {
#pragma unroll
    for (int i = 0; i < MixDma<MLSTM>::PPW; ++i) { const int pi = mx_piece<MLSTM>(wave, i); unsigned v = 0;
        if (pi < 34) { const int ob = (pi < 17 ? pi : pi - 17) * 1024 + lane * 16, row = ob / IMG_PITCH; int cb = ob - row * IMG_PITCH; cb = cb < 256 ? cb : 240; v = (unsigned)(row * qpitch * 2 + cb); }
        else { const int ob = (pi - 34) * 1024 + lane * 16, row = ob >> 6, cb = ob & 63; v = (unsigned)(row * NPROJ * 2 + cb); }
        dm.voff[i] = v; }
}
template <bool MLSTM>
__device__ __forceinline__ void mx_dma_issue(LAS unsigned char* lds, const MixDma<MLSTM>& dm, const MixUnit& U, int c, int wave, int tid) {
    typedef MxMap<MLSTM> MP;
    const int par = c & 1; const size_t tok0 = (size_t)c * CH;
    const char* qb = (const char*)(U.Qg + tok0 * U.qpitch); const char* kb = (const char*)(U.Kg + tok0 * U.qpitch); const char* vb = (const char*)(U.Vg + tok0 * NPROJ);
#pragma unroll
    for (int i = 0; i < MixDma<MLSTM>::PPW; ++i) { const int pi = mx_piece<MLSTM>(wave, i);
        if (pi < MX_NPIECE) {
            const char* src; int dst;
            if (pi < 17) { src = qb; dst = MP::QS + par * IMG_BYTES + pi * 1024; }
            else if (pi < 34) { src = kb; dst = MP::KS + par * IMG_BYTES + (pi - 17) * 1024; }
            else { src = vb; dst = MP::V + par * 4096 + (pi - 34) * 1024; }
            __builtin_amdgcn_global_load_lds((const unsigned*)(src + dm.voff[i]), (LAS unsigned*)(lds + dst), 16, 0, 0);
        } }
    if (!MLSTM && wave == 7) {
        const float* gd = U.gdec + (size_t)(((U.b * NCH + c) * NH) + U.hh) * DK + (tid & 63);
        __builtin_amdgcn_global_load_lds((const unsigned*)gd, (LAS unsigned*)(lds + MP::GDEC + par * 512), 4, 0, 0);
        __builtin_amdgcn_global_load_lds((const unsigned*)(gd + 64), (LAS unsigned*)(lds + MP::GDEC + par * 512 + 256), 4, 0, 0);
    }
}
__device__ __forceinline__ v4u mx_gate_load(const MixUnit& U, int c, int idx) { return *(const v4u*)(U.Gg + (size_t)(c * CH + (idx >> 2)) * NPROJ + 8 * (idx & 3)); }
template <bool MLSTM>
__device__ __forceinline__ void mx_finalize(LAS unsigned char* lds, const MixUnit& U, int cf, int idx, const float (&g8)[8], const v4u gv) {
    typedef MxMap<MLSTM> MP;
    const int j = idx >> 2, sg = idx & 3; float rden = 1.f;
    if (MLSTM) { const float mc = ((const LAS float*)(lds + MP::TSC))[cf];
        const float dn = ((const LAS float*)(lds + MP::DEN))[j], bb = ((const LAS float*)(lds + MP::TB))[cf * 64 + j], pm = ((const LAS float*)(lds + MP::TPM))[cf * 64 + j];
        rden = QK_SCALE * __builtin_amdgcn_rcpf(fmaxf(fabsf(dn) * QK_SCALE, __expf(-bb - fmaxf(mc, pm)))); }
    const f32x4 n0 = *(const LAS f32x4*)((const LAS float*)(lds + MP::NUM) + j * NUM_PITCH + 8 * sg), n1 = *(const LAS f32x4*)((const LAS float*)(lds + MP::NUM) + j * NUM_PITCH + 8 * sg + 4);
    const float nn[8] = {n0.x, n0.y, n0.z, n0.w, n1.x, n1.y, n1.z, n1.w};
    const float gt[8] = {bflo(gv.x), bfhi(gv.x), bflo(gv.y), bfhi(gv.y), bflo(gv.z), bfhi(gv.z), bflo(gv.w), bfhi(gv.w)};
    float y[8]; float ss = 0.f;
#pragma unroll
    for (int e = 0; e < 8; ++e) { const float sig = __builtin_amdgcn_rcpf(1.0f + __expf(-gt[e]));
        if (MLSTM) { const float v = nn[e] * rden * sig; ss += v * v; y[e] = v * g8[e]; }
        else { const float v = nn[e]; ss += v * v; y[e] = v * g8[e] * gt[e] * sig; } }
    ss += __shfl_xor(ss, 1); ss += __shfl_xor(ss, 2);
    const size_t row = (size_t)U.b * SEQ + cf * CH + j;
    if (sg == 0) U.ssq[row * 32 + U.hh * 8 + U.slice] = ss;
    v4u w; w.x = pk_bf16(y[0], y[1]); w.y = pk_bf16(y[2], y[3]); w.z = pk_bf16(y[4], y[5]); w.w = pk_bf16(y[6], y[7]);
    *(v4u*)(U.Hg + row * D + 8 * sg) = w;
}

template <bool MLSTM>
__device__ __forceinline__ void mx_step(LAS unsigned char* lds, const MixDma<MLSTM>& dm, const MixUnit& U, int c, f32x16& accC0, f32x16& accC1, f32x16& accO, int tid, int lane, int wave, unsigned (&pt)[8], const float (&g8)[8], v4u& gl0, v4u& gl1) {
    typedef MxMap<MLSTM> MP;
    const bool fin_wave = MLSTM ? (wave >= 4) : (wave >= 6);
    unsigned long long tp = PROBE_T ? PT_NOW() : 0ull;
    const int r = lane & 31, h5 = lane >> 5, blk = (lane >> 4) & 1, q4 = (lane & 15) >> 2, p4 = lane & 3, par = c & 1;
    const LAS float* TSC = (const LAS float*)(lds + MP::TSC);
    LAS unsigned char* qimg0 = lds + MP::QS + par * IMG_BYTES; LAS unsigned char* kimg0 = lds + MP::KS + par * IMG_BYTES; LAS unsigned char* vimg0 = lds + MP::V + par * 4096;
    if (!fin_wave && c + 1 < NCH) mx_dma_issue<MLSTM>(lds, dm, U, c + 1, wave, tid);
    PT_ACC(6, tp);
    const float mc = MLSTM ? TSC[c] : 0.f;
    if (wave < 4) {
        const int st = wave >> 1, jt = (wave == 1 || wave == 2) ? 1 : 0;
#pragma unroll
        for (int i = 0; i < 16; ++i) accO[i] = 0.f;
        if (MLSTM && wave == 3) {
#pragma unroll
            for (int i = 0; i < 4; ++i) { const int id = lane + 64 * i, row = id >> 2, pc = id & 3;
                const float wr_ = __expf(((const LAS float*)(lds + MP::TWP))[c * 64 + row] - TSC[32 + c]); const v4u pv = *(const LAS v4u*)(vimg0 + row * 64 + pc * 16); v4u o;
                o.x = pk_bf16(bflo(pv.x) * wr_, bfhi(pv.x) * wr_); o.y = pk_bf16(bflo(pv.y) * wr_, bfhi(pv.y) * wr_); o.z = pk_bf16(bflo(pv.z) * wr_, bfhi(pv.z) * wr_); o.w = pk_bf16(bflo(pv.w) * wr_, bfhi(pv.w) * wr_);
                *(LAS v4u*)(lds + MP::VW + row * 64 + pc * 16) = o;
                if (pc == 0) *(LAS unsigned short*)(lds + MP::VWAUX + row * 64) = f2bf1(wr_); }
        }
        if (wave != 3) {
            LAS unsigned char* kimg = kimg0 + (32 * st + r) * IMG_PITCH + 16 * h5;
            LAS unsigned char* qimg = qimg0 + (32 * jt + r) * IMG_PITCH + 16 * h5;
#pragma unroll
            for (int ks = 0; ks < 8; ++ks) { const bf16x8 a = *(const LAS bf16x8*)(kimg + 32 * ks), bq = *(const LAS bf16x8*)(qimg + 32 * ks); accO = MFMA32(a, bq, accO); }
        }
        const int j = 32 * jt + r;
        if (wave == 3) {
#pragma unroll
            for (int g4 = 0; g4 < 4; ++g4) *(LAS v2u*)(lds + MP::PS + j * PS_PITCH + (32 * st + 8 * g4 + 4 * h5) * 2) = (v2u){0u, 0u};
        } else {
            float uj = 0.f;
            if (MLSTM) uj = -fmaxf(mc, ((const LAS float*)(lds + MP::TPM))[c * 64 + j]);
#pragma unroll
            for (int g4 = 0; g4 < 4; ++g4) { const int s0 = 32 * st + 8 * g4 + 4 * h5; f32x4 wps = {0.f, 0.f, 0.f, 0.f}; if (MLSTM) wps = *(const LAS f32x4*)((const LAS float*)(lds + MP::TWP) + c * 64 + s0);
                float v[4];
#pragma unroll
                for (int e = 0; e < 4; ++e) { float x = accO[4 * g4 + e]; if (MLSTM) x *= __expf(uj + wps[e]); v[e] = (s0 + e <= j) ? x : 0.f; }
                v2u o; o.x = pk_bf16(v[0], v[1]); o.y = pk_bf16(v[2], v[3]); *(LAS v2u*)(lds + MP::PS + j * PS_PITCH + s0 * 2) = o; }
        }
    } else {
        const int g = (wave - 4) >> 1, jt = wave & 1;
        if (fin_wave) {
            const int fi = MLSTM ? tid - 256 : tid - 384;
            if (c > 0) { mx_finalize<MLSTM>(lds, U, c - 1, fi, g8, gl0); if (!MLSTM) mx_finalize<MLSTM>(lds, U, c - 1, fi + 128, g8, gl1); }
            if (c + 1 < NCH) mx_dma_issue<MLSTM>(lds, dm, U, c + 1, wave, tid);
        }
        if (MLSTM || g == 0) {
#pragma unroll
            for (int i = 0; i < 16; ++i) accO[i] = 0.f;
#pragma unroll
            for (int ks = 0; ks < 8; ++ks) { const bf16x8 a = *(const LAS bf16x8*)(qimg0 + (32 * jt + r) * IMG_PITCH + 16 * h5 + 32 * ks), bc = *(const LAS bf16x8*)(lds + MP::CT + g * CT_BYTES + r * CT_PITCH + 32 * ks + 16 * h5); accO = MFMA32(a, bc, accO); }
            if (MLSTM) {
#pragma unroll
                for (int g4 = 0; g4 < 4; ++g4) { const f32x4 wi = *(const LAS f32x4*)((const LAS float*)(lds + MP::WI) + par * 64 + 32 * jt + 8 * g4 + 4 * h5);
#pragma unroll
                    for (int e = 0; e < 4; ++e) accO[4 * g4 + e] *= wi[e]; }
            }
        }
    }
    PT_ACC(2, tp);
    MX_BAR();
    PT_ACC(3, tp);
    if (fin_wave) { const int fi = MLSTM ? tid - 256 : tid - 384; gl0 = mx_gate_load(U, c, fi); if (!MLSTM) gl1 = mx_gate_load(U, c, fi + 128); }
    if (wave < 4) {
        if (MLSTM) { const float decay = __expf(mc - TSC[32 + c]); accC0 = accC0 * decay; accC1 = accC1 * decay; }
        LAS unsigned char* kimg = kimg0 + (8 * h5 + q4) * IMG_PITCH + 64 * wave + 32 * blk + 8 * p4;
        LAS unsigned char* vimg = (MLSTM ? lds + MP::VW : vimg0) + (8 * h5 + q4) * 64 + 32 * blk + 8 * p4;
        LAS unsigned char* vaux = lds + MP::VWAUX + (8 * h5 + q4) * 64 + 32 * blk + 8 * p4;
        { v2u xk[8], xv[8], xa[8];
          tr_issue4<IMG_PITCH>(xk, LDSA(kimg)); tr_issue4<64>(xv, LDSA(vimg)); if (MLSTM) tr_issue4<64>(xa, LDSA(vaux));
          tr_wait8(xk); tr_pin8(xv); if (MLSTM) tr_pin8(xa);
          __builtin_amdgcn_sched_barrier(0);
#pragma unroll
          for (int ks = 0; ks < 4; ++ks) { const bf16x8 a = mk8(xk[2 * ks], xk[2 * ks + 1]);
              accC0 = MFMA32(a, mk8(xv[2 * ks], xv[2 * ks + 1]), accC0);
              if (MLSTM) accC1 = MFMA32(a, mk8(xa[2 * ks], xa[2 * ks + 1]), accC1); } }
        if (!MLSTM) {
#pragma unroll
            for (int g4 = 0; g4 < 4; ++g4) { const f32x4 dc = *(const LAS f32x4*)((const LAS float*)(lds + MP::GDEC) + par * 128 + 32 * wave + 8 * g4 + 4 * h5);
#pragma unroll
                for (int e = 0; e < 4; ++e) accC0[4 * g4 + e] *= dc[e]; }
        }
#pragma unroll
        for (int g4 = 0; g4 < 4; ++g4) { const int d0 = 32 * wave + 8 * g4 + 4 * h5;
            v2u o; o.x = pk_bf16(accC0[4 * g4], accC0[4 * g4 + 1]); o.y = pk_bf16(accC0[4 * g4 + 2], accC0[4 * g4 + 3]); *(LAS v2u*)(lds + MP::CT + r * CT_PITCH + d0 * 2) = o;
            if (MLSTM) { v2u o1; o1.x = pk_bf16(accC1[4 * g4], accC1[4 * g4 + 1]); o1.y = pk_bf16(accC1[4 * g4 + 2], accC1[4 * g4 + 3]); *(LAS v2u*)(lds + MP::CT + CT_BYTES + r * CT_PITCH + d0 * 2) = o1; } }
    } else {
        const int g = (wave - 4) >> 1, jt = wave & 1;
        if (MLSTM || g == 0) {
            const bf16x8 ones = (r == 0) ? (bf16x8){0x3F80, 0x3F80, 0x3F80, 0x3F80, 0x3F80, 0x3F80, 0x3F80, 0x3F80} : (bf16x8){0, 0, 0, 0, 0, 0, 0, 0};
            LAS unsigned char* vimg = vimg0 + (8 * h5 + q4) * 64 + 32 * blk + 8 * p4;
            bf16x8 pa[4];
#pragma unroll
            for (int ks = 0; ks < 4; ++ks) pa[ks] = *(const LAS bf16x8*)(lds + MP::PS + (32 * jt + r) * PS_PITCH + 32 * ks + 16 * h5);
            if (g == 0) { v2u xv[8]; tr_issue4<64>(xv, LDSA(vimg)); tr_wait8(xv); __builtin_amdgcn_sched_barrier(0);
#pragma unroll
                for (int ks = 0; ks < 4; ++ks) accO = MFMA32(pa[ks], mk8(xv[2 * ks], xv[2 * ks + 1]), accO);
            } else {
#pragma unroll
                for (int ks = 0; ks < 4; ++ks) accO = MFMA32(pa[ks], ones, accO); }
            if (g == 0) {
#pragma unroll
                for (int i = 0; i < 16; ++i) ((LAS float*)(lds + MP::NUM))[(32 * jt + (i & 3) + 8 * (i >> 2) + 4 * h5) * NUM_PITCH + r] = accO[i];
            }
            if (MLSTM && wave == 7 && c + 1 < NCH) { const float m1 = TSC[c + 1]; ((LAS float*)(lds + MP::WI))[(par ^ 1) * 64 + lane] = __expf(m1 - fmaxf(m1, ((const LAS float*)(lds + MP::TPM))[(c + 1) * 64 + lane])); }
            if (MLSTM && g == 1 && r == 0) {
#pragma unroll
                for (int i = 0; i < 16; ++i) ((LAS float*)(lds + MP::DEN))[32 * jt + (i & 3) + 8 * (i >> 2) + 4 * h5] = accO[i];
            }
        }
    }
    PT_ACC(4, tp);
    MX_BAR_VM();
    PT_ACC(5, tp);
}

template <bool MLSTM>
__device__ __forceinline__ void mixer_phase(LAS unsigned char* lds, int tid, int lane, int wave, int vcu, int G, const MixArgs A) {
    typedef MxMap<MLSTM> MP;
    MixDma<MLSTM> dm; mx_dma_setup<MLSTM>(dm, wave, lane, A.qpitch);
    unsigned pt[8] = {0u, 0u, 0u, 0u, 0u, 0u, 0u, 0u}; unsigned long long tph = PROBE_T ? PT_NOW() : 0ull; unsigned long long tin = tph;
    for (int unit = vcu; unit < BATCH * NH * 8; unit += G) {
        const int slice = unit & 7, bh = unit >> 3;
        MixUnit U; U.b = bh >> 2; U.hh = bh & 3; U.qpitch = A.qpitch; U.gdec = A.gdec;
        U.Qg = A.q + (size_t)U.b * BBLK_E + U.hh * DK; U.Kg = A.k + (size_t)U.b * BBLK_E + U.hh * DK; U.Vg = A.proj + (size_t)U.b * BBLK_E + 1024 + U.hh * DV + 32 * slice; U.Hg = A.hun + U.hh * DV + 32 * slice;
        U.Gg = A.proj + (size_t)U.b * BBLK_E + 2048 + U.hh * DV + 32 * slice; U.ssq = A.ssq; U.slice = slice;

        MX_BAR_VM();
        mx_dma_issue<MLSTM>(lds, dm, U, 0, wave, tid);
        float g8[8];
#pragma unroll
        for (int e = 0; e < 8; ++e) g8[e] = A.gout[U.hh * DV + 32 * slice + 8 * (tid & 3) + e];
        for (int i = tid; i < 2 * CT_BYTES / 4; i += NTHREADS) ((LAS unsigned*)(lds + MP::CT))[i] = 0u;
        if (MLSTM) {
            for (int i = tid; i < 1024; i += NTHREADS) ((LAS unsigned*)(lds + MP::VWAUX))[i] = 0u;
            LAS float* TB = (LAS float*)(lds + MP::TB); LAS float* TWP = (LAS float*)(lds + MP::TWP); LAS float* TPM = (LAS float*)(lds + MP::TPM); LAS float* TSC = (LAS float*)(lds + MP::TSC);
            const float bgi = A.bgate[U.hh], bgf = A.bgate[4 + U.hh];
            float gi4[4], gf4[4];
#pragma unroll
            for (int cc = 0; cc < 4; ++cc) { const size_t tok = (size_t)U.b * SEQ + (wave + 8 * cc) * CH + lane; gi4[cc] = A.gates[tok * 16 + U.hh] + bgi; gf4[cc] = A.gates[tok * 16 + 4 + U.hh] + bgf; }
#pragma unroll
            for (int cc = 0; cc < 4; ++cc) { const int c = wave + 8 * cc;
                const float lf = fminf(gf4[cc], 0.f) - __logf(1.0f + __expf(-fabsf(gf4[cc])));
                float bsum = lf;
#pragma unroll
                for (int o = 1; o < 64; o <<= 1) { const float t = __shfl_up(bsum, o); if (lane >= o) bsum += t; }
                const float wp = gi4[cc] - bsum; float pm = wp;
#pragma unroll
                for (int o = 1; o < 64; o <<= 1) { const float t = __shfl_up(pm, o); if (lane >= o) pm = fmaxf(pm, t); }
                TB[c * 64 + lane] = bsum; TWP[c * 64 + lane] = wp; TPM[c * 64 + lane] = pm;
                if (lane == 63) { TSC[64 + c] = bsum; TSC[96 + c] = pm; } }
            MX_BAR();
            if (wave == 7) ((LAS float*)(lds + MP::WI))[lane] = __expf(-fmaxf(0.f, TPM[lane]));
            if (wave == 0) {
                const float gl = TSC[64 + (lane & 31)], pl = TSC[96 + (lane & 31)]; float m = 0.f, myM = 0.f, myX = 0.f;
#pragma clang loop unroll(disable)
                for (int c = 0; c < NCH; ++c) { const float gc = __uint_as_float(__builtin_amdgcn_readlane(__float_as_uint(gl), c)), pc = __uint_as_float(__builtin_amdgcn_readlane(__float_as_uint(pl), c));
                    const float mxe = fmaxf(m, pc); if (lane == c) { myM = m; myX = mxe; } m = gc + mxe; }
                if (lane < 32) { TSC[lane] = myM; TSC[32 + lane] = myX; }
            }
        }
        f32x16 accC0, accC1, accO; v4u gl0 = {0u, 0u, 0u, 0u}, gl1 = {0u, 0u, 0u, 0u};
#pragma unroll
        for (int i = 0; i < 16; ++i) { accC0[i] = 0.f; accC1[i] = 0.f; accO[i] = 0.f; }
        MX_BAR_VM();
        PT_ACC(1, tin);
#pragma clang loop unroll(disable)
        for (int c = 0; c < NCH; ++c) mx_step<MLSTM>(lds, dm, U, c, accC0, accC1, accO, tid, lane, wave, pt, g8, gl0, gl1);
        if (MLSTM) { if (wave >= 4) mx_finalize<true>(lds, U, NCH - 1, tid - 256, g8, gl0); } else if (wave >= 6) { mx_finalize<false>(lds, U, NCH - 1, tid - 384, g8, gl0); mx_finalize<false>(lds, U, NCH - 1, tid - 384 + 128, g8, gl1); }
    }
    MX_BAR_VM();
    if (PROBE_T && (PROBE_T_MLSTM != 0) == MLSTM && vcu == 0 && wave == PROBE_T_WAVE && lane == 0) { PT_ACC(0, tph); unsigned* pw = (unsigned*)A.probe; pw[0] = pt[PROBE_T_A]; pw[1] = pt[PROBE_T_B]; }
}

constexpr int N_PHASES = 15, RT_OFF = RING_BYTES;
template <int PH>
__device__ __forceinline__ void run_phase(const Args& args, LAS unsigned char* lds, int tid, int lane, int wave, int vcu, int G, int bx) {
    unsigned char* ws = args.ws;
    constexpr int layer = (PH >= 8) ? 1 : 0, k = (PH == 0) ? -1 : PH - 1 - 7 * layer;
    unsigned char* wl = ws + (size_t)layer * WS_WLAYER;
    bf16* AOP = (bf16*)(ws + WS_AOP); bf16* PROJ = (bf16*)(ws + WS_PROJ); bf16* HMID = (bf16*)(ws + WS_HMID); bf16* XRES = (bf16*)(ws + WS_XRES);
    float* GATES = (float*)(ws + WS_GATES); float* SUMSQ = (float*)(ws + WS_SUMSQ);
    LAS float* RT = (LAS float*)(lds + RT_OFF);
    if constexpr (k == -1) {
        LAS unsigned char* wgb = lds;
        rows_first(wgb, (LAS float*)(lds + 40960), tid, lane, wave, vcu, G, args.in[4] + NPROJ, MLSTM_IN, args.in[1], args.in[0], XRES, SUMSQ, GATES);
        if (tid >= 448) {
            for (int i = vcu * 64 + (tid - 448); i < D * 16; i += G * 64) { const int k = i >> 4, c = i & 15;
                ((bf16*)(ws + WS_WGT))[c * 1032 + k] = f2bf1(args.in[1][D + k] * args.in[8][(size_t)k * GLA_IN + NPROJ + c]); }
        }
        convert_weights(lds, lane, wave, NWAVES, vcu, G, args, ws);
    } else if constexpr (k == 0) {
        pg8::Gemm g{XRES, (const bf16*)(wl + WS_WIN), M, NPROJ, D}; pg8::StaticOrder S; S.init(M, NPROJ, G, bx);
        const RstdSlots rs = rstd_table(RT, SUMSQ, S, tid);
        pg8::EpiBf16S<0> E{PROJ, NPROJ, (const LAS float*)RT, rs.pm1, rs.pm2, rs.pm3, BBLK_E};
        pg8::gemm_phase<pg8::EpiBf16S<0>, pg8::StaticOrder, true, true>(lds, g, S, E);
    } else if constexpr (k == 1) {
        if (layer) gla_prep(lds, tid, lane, wave, vcu, G, PROJ, XRES, SUMSQ, (const bf16*)(ws + WS_WGT), args.in[9], args.in[10], (bf16*)(ws + WS_PROJ + WS_QT_OFF), (bf16*)(ws + WS_PROJ + WS_KT_OFF), (float*)(ws + WS_GDEC));
    } else if constexpr (k == 2) {
        if (layer == 0) { const MixArgs A{PROJ, PROJ + QKW, PROJ, NPROJ, GATES, args.in[5], nullptr, AOP, ws + WS_CTL + 4 * CW_PROBE, args.in[6], (float*)(ws + WS_SSQ)}; mixer_phase<true>(lds, tid, lane, wave, vcu, G, A); }
        else { const MixArgs A{(const bf16*)(ws + WS_PROJ + WS_QT_OFF), (const bf16*)(ws + WS_PROJ + WS_KT_OFF), PROJ, QKW, nullptr, nullptr, (const float*)(ws + WS_GDEC), AOP, ws + WS_CTL + 4 * CW_PROBE, args.in[11], (float*)(ws + WS_SSQ)}; mixer_phase<false>(lds, tid, lane, wave, vcu, G, A); }
    } else if constexpr (k == 3) {
    } else if constexpr (k == 4) {
        pg8::Gemm g{AOP, (const bf16*)(wl + WS_WOUT), M, D, D}; pg8::StaticOrder S; S.init(M, D, G, bx);
        pg8::Unit u0; S.next(0, u0); head_scale_table(RT, (const float*)(ws + WS_SSQ), u0.pm, tid);
        pg8::EpiResBf16SqH E{XRES, SUMSQ, D, (const LAS float*)RT};
        pg8::gemm_phase<pg8::EpiResBf16SqH, pg8::StaticOrder, false, true>(lds, g, S, E);
    } else if constexpr (k == 5) {
        pg8::Gemm g{XRES, (const bf16*)(wl + WS_W1), M, FF, D}; pg8::StaticOrder S; S.init(M, FF, G, bx);
        const RstdSlots rs = rstd_table(RT, SUMSQ, S, tid);
        pg8::EpiBf16S<2> E{HMID, FF, (const LAS float*)RT, rs.pm1, rs.pm2, rs.pm3, (size_t)2048 * FF};
        pg8::gemm_phase<pg8::EpiBf16S<2>, pg8::StaticOrder, true, true>(lds, g, S, E);
    } else if constexpr (k == 6 && layer == 0) {
        pg8::Gemm g{HMID, (const bf16*)(wl + WS_W2), M, D, FF}; pg8::StaticOrder S; S.init(M, D, G, bx);
        pg8::EpiResBf16Sq E{XRES, SUMSQ, D};
        pg8::gemm_phase<pg8::EpiResBf16Sq, pg8::StaticOrder, false, true>(lds, g, S, E);
    } else if constexpr (k == 6) {
        pg8::Gemm g{HMID, (const bf16*)(wl + WS_W2), M, D, FF}; pg8::StaticOrder S; S.init(M, D, G, bx);
        pg8::EpiFinalNorm E{XRES, args.out, SUMSQ, (unsigned*)(ws + WS_CTL) + CW_FIN, args.in[3], D, EPS};
        pg8::gemm_phase<pg8::EpiFinalNorm, pg8::StaticOrder, false, true>(lds, g, S, E);
    }
}
__device__ __forceinline__ void group_sync(unsigned* ctl, volatile LAS unsigned* st, unsigned per_epoch) {
    asm volatile("s_waitcnt vmcnt(0)" ::: "memory");
    __syncthreads();
    if (threadIdx.x == 0) {
        unsigned* cnt = ctl + st[0]; const unsigned target = per_epoch * (st[1] + 1u); st[1] = st[1] + 1u;
        xb_add(cnt, 1u);
        unsigned sp = 0; while (xb_ld(cnt) < target && ++sp < (1u << 22)) __builtin_amdgcn_s_sleep(1);
        __builtin_amdgcn_fence(__ATOMIC_ACQUIRE, "agent");
        asm volatile("s_waitcnt vmcnt(0)" ::: "memory");
    }
    __syncthreads();
}
__global__ void __launch_bounds__(NTHREADS, 2) fwd_kernel(Args args) {
    extern __shared__ __attribute__((aligned(16))) unsigned char lds_raw[];
    LAS unsigned char* lds = (LAS unsigned char*)lds_raw;
    volatile LAS unsigned* MISC = (volatile LAS unsigned*)(lds + MISC_OFF);
    const int tid = threadIdx.x, lane = tid & 63, wave = __builtin_amdgcn_readfirstlane(tid >> 6);
    const int G = gridDim.x; int bx = blockIdx.x; int vcu = (G % 8 == 0) ? (bx % 8) * (G / 8) + bx / 8 : bx;
    for (int u = tid; u < (LDS_BYTES - LDSCTL_OFF) / 4; u += NTHREADS) ((LAS unsigned*)(lds + LDSCTL_OFF))[u] = 0u;
    __syncthreads();
    const int lo = args.ph_lo, hi = args.ph_hi;
#ifndef PROBE_S
#define PROBE_S 0
#endif
    if (PROBE_S && tid == 0) { const unsigned t = (unsigned)__builtin_amdgcn_s_memrealtime(); unsigned* pw = (unsigned*)(args.ws + WS_CTL) + CW_PROBE;
        __hip_atomic_fetch_max(pw + 4, ~t, __ATOMIC_RELAXED, __HIP_MEMORY_SCOPE_AGENT); __hip_atomic_fetch_max(pw + 5, t, __ATOMIC_RELAXED, __HIP_MEMORY_SCOPE_AGENT); }
    XcdBarrier bar; bar.bar = (unsigned*)(args.ws + WS_CTL) + CW_BAR; bar.x = 0; bar.st = nullptr;
    if (hi - lo > 1) { bar = xcd_barrier_post((unsigned*)(args.ws + WS_CTL) + CW_BAR, MISC + 8);
        if (tid == 0) { const unsigned xcc = xb_xcc_id(); MISC[16] = xcc; MISC[17] = xb_add((unsigned*)(args.ws + WS_CTL) + CW_XID + 64 * xcc, 1u); } }
#ifndef PROBE_PH
#define PROBE_PH (-1)
#endif
#ifndef PROBE_N
#define PROBE_N 0
#endif
#define PHASE(p) if (lo <= (p) && (p) < hi) { PP_STAMP(2 * (p)); run_phase<p>(args, lds, tid, lane, wave, vcu, G, bx); PP_STAMP(2 * (p) + 1); \
        if (PROBE_S && (p) == 0 && tid == 0) { __hip_atomic_fetch_max((unsigned*)(args.ws + WS_CTL) + CW_PROBE + 6, (unsigned)__builtin_amdgcn_s_memrealtime(), __ATOMIC_RELAXED, __HIP_MEMORY_SCOPE_AGENT); } \
        if ((p) == PROBE_PH) { for (int rep_ = 0; rep_ < PROBE_N; ++rep_) { xcd_barrier(bar); if (PROBE_PH >= 0) run_phase<((p) == PROBE_PH ? (p) : 2)>(args, lds, tid, lane, wave, vcu, G, bx); } } \
        if ((p) + 1 < hi && (p) != 2 && (p) != 4 && (p) != 11) { if (MISC[20] != 0u && ((p) == 5 || (p) == 6 || (p) == 12 || (p) == 13)) { group_sync((unsigned*)(args.ws + WS_CTL), MISC + 22, 4u); } \
            else if (MISC[20] != 0u && (p) > 0) { group_sync((unsigned*)(args.ws + WS_CTL), MISC + 24, 32u); } else xcd_barrier(bar); } }
    PHASE(0)
    if (lo == 0 && hi > 1) {
        if (tid == 0) {
            bool ok = (G == 256);
            unsigned cv[16];
#pragma unroll
            for (unsigned j = 0; j < 16; ++j) cv[j] = xb_ld(&bar.bar[XB_XCNT(j)]);
#pragma unroll
            for (unsigned j = 0; j < 16; ++j) ok = ok & (cv[j] == (j < 8 ? 32u : 0u));
            const unsigned xcc = MISC[16], idx = MISC[17];
            if (ok && xcc < 8 && idx < 32) { const unsigned pm = 8u * xcc + (idx & 7u);
                MISC[22] = (unsigned)(CW_GRP + 16 * pm); MISC[24] = (unsigned)(CW_XCL + 64 * xcc); MISC[20] = 1u; }
        }
        __syncthreads();
        if (MISC[20] != 0u) { const unsigned xcc = MISC[16], idx = MISC[17]; vcu = (int)(xcc * 32 + idx); bx = (int)(idx * 8 + xcc); }
    }
    PHASE(1) PHASE(2) PHASE(3) PHASE(4) PHASE(5) PHASE(6) PHASE(7) PHASE(8) PHASE(9) PHASE(10) PHASE(11) PHASE(12) PHASE(13) PHASE(14)
#undef PHASE
#ifndef PROBE_BLK
#define PROBE_BLK 0
#endif
    if (PROBE_P && hi == N_PHASES && blockIdx.x == PROBE_BLK && tid == 0) {
        const volatile LAS unsigned* w = (const volatile LAS unsigned*)(lds + LDSCTL_OFF + 512);
        const unsigned va = (PROBE_P_A < 32) ? w[2 * PROBE_P_A + 1] - w[2 * PROBE_P_A] : w[2 * (PROBE_P_A - 32) + 2] - w[2 * (PROBE_P_A - 32) + 1];
        const unsigned vb = (PROBE_P_B < 32) ? w[2 * PROBE_P_B + 1] - w[2 * PROBE_P_B] : w[2 * (PROBE_P_B - 32) + 2] - w[2 * (PROBE_P_B - 32) + 1];
        const unsigned long long ticks = (unsigned long long)(va / 100u) * 1000ull + (unsigned long long)(vb / 100u) * 100000ull;
        const unsigned long long t0 = PT_NOW(); while (PT_NOW() - t0 < ticks) __builtin_amdgcn_s_sleep(8);
    }
    if (PROBE_S && hi == N_PHASES && blockIdx.x == 0 && tid == 0) {
        unsigned* pw = (unsigned*)(args.ws + WS_CTL) + CW_PROBE; const unsigned mn = ~xb_ld(pw + 4), mx = xb_ld(pw + 5), me = xb_ld(pw + 6);
        const unsigned v = (PROBE_S == 1) ? mx - mn : me - mn;
        const unsigned long long ticks = (unsigned long long)(v / 10u) * 1000ull;
        const unsigned long long t0 = PT_NOW(); while (PT_NOW() - t0 < ticks) __builtin_amdgcn_s_sleep(8);
    }
    if (PROBE_T && hi == N_PHASES && vcu == 0 && tid == 0) {
        const unsigned a = xb_ld((unsigned*)(args.ws + WS_CTL) + CW_PROBE), b = xb_ld((unsigned*)(args.ws + WS_CTL) + CW_PROBE + 1);
        const unsigned long long ticks = (unsigned long long)(a / 100u) * 1000ull + (unsigned long long)(b / 100u) * 100000ull;
        const unsigned long long t0 = PT_NOW(); while (PT_NOW() - t0 < ticks) __builtin_amdgcn_s_sleep(8);
    }
}

extern "C" void kernel_launch(void* const* d_in, const int* in_sizes, int n_in, void* d_out, int out_size, void* d_ws, size_t ws_size, hipStream_t stream) {
    static int grid = 0;
    if (grid == 0) {
        if (n_in != 15 || in_sizes[0] != M * D || out_size != M * D || ws_size < WS_END) { fprintf(stderr, "kernel_launch: unexpected shapes (n_in %d, in0 %d, out %d, ws %zu); nothing launched\n", n_in, n_in > 0 ? in_sizes[0] : -1, out_size, ws_size); grid = -1; return; }
        int dev = 0, cus = 0, per_cu = 0;
        if (hipGetDevice(&dev) != hipSuccess || hipDeviceGetAttribute(&cus, hipDeviceAttributeMultiprocessorCount, dev) != hipSuccess) { grid = -1; return; }
        if (hipFuncSetAttribute((const void*)fwd_kernel, hipFuncAttributeMaxDynamicSharedMemorySize, LDS_BYTES) != hipSuccess) { fprintf(stderr, "kernel_launch: hipFuncSetAttribute failed\n"); grid = -1; return; }
        if (hipOccupancyMaxActiveBlocksPerMultiprocessor(&per_cu, (const void*)fwd_kernel, NTHREADS, LDS_BYTES) != hipSuccess || per_cu < 1) { fprintf(stderr, "kernel_launch: occupancy query says %d blocks per CU\n", per_cu); (void)hipGetLastError(); grid = -1; return; }
        grid = cus;
    }
    if (grid < 0) return;
    (void)hipMemsetAsync((char*)d_ws + WS_CTL, 0, CTL_ZERO_BYTES, stream);
    Args a{};
    for (int i = 0; i < 15; ++i) a.in[i] = (const float*)d_in[i];
    a.out = (float*)d_out; a.ws = (unsigned char*)d_ws;
    if (MK_N_LAUNCHES == 1) {
        a.ph_lo = 0; a.ph_hi = N_PHASES;
        void* kargs[] = {&a};
        const hipError_t e = hipLaunchCooperativeKernel((const void*)fwd_kernel, dim3(grid), dim3(NTHREADS), kargs, LDS_BYTES, stream);
        if (e != hipSuccess) fprintf(stderr, "kernel_launch: cooperative launch failed: %s (grid %d)\n", hipGetErrorString(e), grid);
    } else {
        for (int p = 0; p < N_PHASES; ++p) { a.ph_lo = p; a.ph_hi = p + 1; hipLaunchKernelGGL(fwd_kernel, dim3(grid), dim3(NTHREADS), LDS_BYTES, stream, a); }
    }
}
```

```cpp
#include <hip/hip_runtime.h>
#include <cstdio>
#include <cstdint>
namespace pg8 {
#define PG8_LAS __attribute__((address_space(3)))
typedef unsigned short bf16_t;
typedef short bf16x8 __attribute__((ext_vector_type(8)));
typedef float f32x4 __attribute__((ext_vector_type(4)));
typedef unsigned u32x4 __attribute__((ext_vector_type(4)));
constexpr int BM = 256, BK = 64, HALF = 128, HTB = HALF * BK * 2  , STAGE_BYTES = 8 * HTB, NXCD = 8, WGM = 8;

__host__ __device__ __forceinline__ int lds_byte(int r, int c) { const int st = (r >> 4) * 2 + (c >> 5), rr = r & 15, cc = c & 31, ob = rr * 64 + cc * 2; return st * 1024 + (ob ^ (((ob >> 9) & 1) << 5)); }
__host__ __device__ __forceinline__ void stage_rc(int b, int& R, int& C) { const int st = b / 1024, sb = b % 1024, swz = sb ^ (((sb >> 9) & 1) << 5); R = (st >> 1) * 16 + swz / 64; C = (st & 1) * 32 + (swz % 64) / 2; }
__host__ __device__ __forceinline__ int perm32(int rho) { const int n = rho >> 4, i = rho & 15; return 8 * (i >> 2) + 4 * n + (i & 3); }

struct Unit { int pm, pn; };
struct Gemm { const bf16_t* A; const bf16_t* Bt; int M, N, K; };

struct StaticOrder {
    int nM, nN, nwg, G, c;
    __host__ __device__ __forceinline__ void init(int M, int N, int G_, int c_) { nM = M / BM; nN = N / BM; nwg = nM * nN; G = G_; c = c_; }
    __host__ __device__ __forceinline__ bool next(int i, Unit& u) const {
        const long L = (long)i * G + c; if (L >= nwg) return false;
        int wgid = (int)L; { const int q = nwg / NXCD, r = nwg % NXCD, xcd = wgid % NXCD, off = wgid / NXCD; wgid = (xcd < r ? xcd * (q + 1) : r * (q + 1) + (xcd - r) * q) + off; }
        const int nig = WGM * nN, gid = wgid / nig, fm = gid * WGM, gsz = (nM - fm) < WGM ? (nM - fm) : WGM;
        u.pm = fm + ((wgid % nig) % gsz); u.pn = (wgid % nig) / gsz; return true;
    }
    __device__ __forceinline__ void a_ready(const Unit&) const {}
    __device__ __forceinline__ void done(const Unit&) const {}
};

__device__ __forceinline__ unsigned cvt_pk_bf16(float lo, float hi) { unsigned r; asm volatile("v_cvt_pk_bf16_f32 %0, %1, %2" : "=v"(r) : "v"(lo), "v"(hi)); return r; }
typedef float f32x2 __attribute__((ext_vector_type(2)));
typedef __bf16 bf16x2_t __attribute__((ext_vector_type(2)));
__device__ __forceinline__ unsigned pk_bf16(float lo, float hi) { f32x2 v = {lo, hi}; bf16x2_t r = __builtin_convertvector(v, bf16x2_t); return __builtin_bit_cast(unsigned, r); }
template <int ACT  > struct EpiBf16 {
    static constexpr bool PERM = true, AFTER_DRAIN = false, KSCALE = false; static constexpr int AUX_A = 0; static constexpr bool PREP = false;
    bf16_t* O; int ldc;
    __device__ __forceinline__ void operator()(const f32x4 (&acc)[2][2][4][2], const Unit& u, int wr, int wc, int fr, int fq) const {
        const int row0 = u.pm * BM + wr * 64 + fr, col0 = u.pn * BM + wc * 32 + 8 * fq;
#pragma unroll
        for (int ai = 0; ai < 2; ++ai)
#pragma unroll
            for (int m = 0; m < 4; ++m) { bf16_t* rowp = O + (size_t)(row0 + ai * HALF + m * 16) * ldc + col0;
#pragma unroll
                for (int bj = 0; bj < 2; ++bj) { f32x4 v0 = acc[ai][bj][m][0], v1 = acc[ai][bj][m][1];
                    if (ACT == 2) { const f32x4 z = {0.f, 0.f, 0.f, 0.f}; v0 = __builtin_elementwise_max(v0, z); v1 = __builtin_elementwise_max(v1, z); v0 = v0 * v0; v1 = v1 * v1; }
                    u32x4 w; w.x = pk_bf16(v0[0], v0[1]); w.y = pk_bf16(v0[2], v0[3]); w.z = pk_bf16(v1[0], v1[1]); w.w = pk_bf16(v1[2], v1[3]);
                    *(u32x4*)(rowp + bj * HALF) = w; } }
    }
};
struct EpiResF32 {
    static constexpr bool PERM = false, AFTER_DRAIN = true, KSCALE = false; static constexpr int AUX_A = 0; static constexpr bool PREP = false;
    const float* base; float* out; int ldc;
    __device__ __forceinline__ void fused(const f32x4 (&acc)[2][2][4][2], const Unit& u, int wr, int wc, int fr, int fq, PG8_LAS unsigned char*, int, int) const {
        const int col0 = u.pn * BM + wc * 32 + 4 * fq;
#pragma unroll
        for (int ai = 0; ai < 2; ++ai)
#pragma unroll
            for (int m = 0; m < 4; ++m) { const int r = ai * HALF + wr * 64 + m * 16 + fr; const size_t off = (size_t)(u.pm * BM + r) * ldc + col0;
#pragma unroll
                for (int bj = 0; bj < 2; ++bj) { const f32x4 b0 = *(const f32x4*)(base + off + bj * HALF), b1 = *(const f32x4*)(base + off + bj * HALF + 16);
                    *(f32x4*)(out + off + bj * HALF) = b0 + acc[ai][bj][m][0]; *(f32x4*)(out + off + bj * HALF + 16) = b1 + acc[ai][bj][m][1];
                    asm volatile("" ::: "memory"); } }
    }
};
typedef unsigned u32x2 __attribute__((ext_vector_type(2)));
__device__ __forceinline__ float bf_lo(unsigned w) { return __builtin_bit_cast(float, w << 16); }
__device__ __forceinline__ float bf_hi(unsigned w) { return __builtin_bit_cast(float, w & 0xffff0000u); }
template <int ACT  > struct EpiBf16S {
    static constexpr bool PERM = true, AFTER_DRAIN = false, KSCALE = false; static constexpr int AUX_A = 0; static constexpr bool PREP = true;
    bf16_t* O; int ldc; const PG8_LAS float* rt; int pm1, pm2, pm3; size_t bstride; const float* sumsq; int pm0; float inv_k, eps;
    __device__ __forceinline__ void prepare(int tid) const {
        PG8_LAS float* w = (PG8_LAS float*)rt;
#pragma unroll
        for (int sl = 0; sl < 4; ++sl) { const int pm = sl == 0 ? pm0 : sl == 1 ? pm1 : sl == 2 ? pm2 : pm3;
            if (pm >= 0 && tid < 256) { const f32x4 s4 = *(const f32x4*)(sumsq + (size_t)(pm * 256 + tid) * 4); w[sl * 256 + tid] = 1.0f / sqrtf(((s4[0] + s4[1]) + (s4[2] + s4[3])) * inv_k + eps); } }
    }
    __device__ __forceinline__ void operator()(const f32x4 (&acc)[2][2][4][2], const Unit& u, int wr, int wc, int fr, int fq) const {
        const int col0 = u.pn * BM + wc * 32 + 8 * fq;
        const PG8_LAS float* rtp = rt + ((u.pm == pm1) ? 256 : (u.pm == pm2) ? 512 : (u.pm == pm3) ? 768 : 0) + wr * 64 + fr;
#pragma unroll
        for (int ai = 0; ai < 2; ++ai)
#pragma unroll
            for (int m = 0; m < 4; ++m) { const float rs = rtp[ai * HALF + m * 16];
                bf16_t* rowp = O + (size_t)(u.pm >> 3) * bstride + (size_t)((u.pm & 7) * BM + ai * HALF + wr * 64 + m * 16 + fr) * ldc + col0;
#pragma unroll
                for (int bj = 0; bj < 2; ++bj) { f32x4 v0 = acc[ai][bj][m][0] * rs, v1 = acc[ai][bj][m][1] * rs;
                    if (ACT == 2) { const f32x4 z = {0.f, 0.f, 0.f, 0.f}; v0 = __builtin_elementwise_max(v0, z); v1 = __builtin_elementwise_max(v1, z); v0 = v0 * v0; v1 = v1 * v1; }
                    u32x4 w; w.x = pk_bf16(v0[0], v0[1]); w.y = pk_bf16(v0[2], v0[3]); w.z = pk_bf16(v1[0], v1[1]); w.w = pk_bf16(v1[2], v1[3]);
                    *(u32x4*)(rowp + bj * HALF) = w; } }
    }
};
struct EpiResBf16Sq {
    static constexpr bool PERM = true, AFTER_DRAIN = true, KSCALE = false; static constexpr int AUX_A = 0; static constexpr bool PREP = false;
    bf16_t* xres; float* sumsq; int ldc;
    __device__ __forceinline__ void fused(f32x4 (&acc)[2][2][4][2], const Unit& u, int wr, int wc, int fr, int fq, PG8_LAS unsigned char* lds, int wid, int lane) const {
        PG8_LAS float* P = (PG8_LAS float*)lds;
        const int col0 = u.pn * BM + wc * 32 + 8 * fq;
#pragma unroll
        for (int ai = 0; ai < 2; ++ai)
#pragma unroll
            for (int m = 0; m < 4; ++m) { const int r = ai * HALF + wr * 64 + m * 16 + fr; bf16_t* xp = xres + (size_t)(u.pm * BM + r) * ldc + col0; float ss = 0.f;
#pragma unroll
                for (int bj = 0; bj < 2; ++bj) { const u32x4 xb = *(const u32x4*)(xp + bj * HALF); const f32x4 a0 = acc[ai][bj][m][0], a1 = acc[ai][bj][m][1];
                        u32x4 w; w.x = pk_bf16(bf_lo(xb.x) + a0[0], bf_hi(xb.x) + a0[1]); w.y = pk_bf16(bf_lo(xb.y) + a0[2], bf_hi(xb.y) + a0[3]); w.z = pk_bf16(bf_lo(xb.z) + a1[0], bf_hi(xb.z) + a1[1]); w.w = pk_bf16(bf_lo(xb.w) + a1[2], bf_hi(xb.w) + a1[3]);
                        *(u32x4*)(xp + bj * HALF) = w;
                        const float y0 = bf_lo(w.x), y1 = bf_hi(w.x), y2 = bf_lo(w.y), y3 = bf_hi(w.y), y4 = bf_lo(w.z), y5 = bf_hi(w.z), y6 = bf_lo(w.w), y7 = bf_hi(w.w);
                        ss += ((y0 * y0 + y1 * y1) + (y2 * y2 + y3 * y3)) + ((y4 * y4 + y5 * y5) + (y6 * y6 + y7 * y7)); }
                ss += __shfl_xor(ss, 16); ss += __shfl_xor(ss, 32);
                if (fq == 0) P[r * 4 + wc] = ss;
                asm volatile("" ::: "memory"); }
        asm volatile("s_waitcnt lgkmcnt(0)" ::: "memory"); __builtin_amdgcn_s_barrier(); asm volatile("" ::: "memory");
        const int t = wid * 64 + lane;
        if (t < 256) { const f32x4 p = *(const PG8_LAS f32x4*)(P + t * 4); sumsq[(size_t)(u.pm * BM + t) * 4 + u.pn] = (p[0] + p[1]) + (p[2] + p[3]); }
    }
};
struct EpiFinalNorm {
    static constexpr bool PERM = true, AFTER_DRAIN = true, KSCALE = false; static constexpr int AUX_A = 0; static constexpr bool PREP = false;
    const bf16_t* xres; float* out; float* sumsq; unsigned* cnt; const float* gain; int ldc; float eps;
    __device__ __forceinline__ void fused(f32x4 (&acc)[2][2][4][2], const Unit& u, int wr, int wc, int fr, int fq, PG8_LAS unsigned char* lds, int wid, int lane) const {
        PG8_LAS float* P = (PG8_LAS float*)lds;
        PG8_LAS float* S = (PG8_LAS float*)(lds + 4096);
        const int col0 = u.pn * BM + wc * 32 + 8 * fq, t = wid * 64 + lane;
#pragma unroll
        for (int ai = 0; ai < 2; ++ai)
#pragma unroll
            for (int m = 0; m < 4; ++m) { const int r = ai * HALF + wr * 64 + m * 16 + fr; const bf16_t* xp = xres + (size_t)(u.pm * BM + r) * ldc + col0; float ss = 0.f;
#pragma unroll
                for (int bj = 0; bj < 2; ++bj) { const u32x4 xb = *(const u32x4*)(xp + bj * HALF); f32x4 y0 = acc[ai][bj][m][0], y1 = acc[ai][bj][m][1];
                        y0[0] += bf_lo(xb.x); y0[1] += bf_hi(xb.x); y0[2] += bf_lo(xb.y); y0[3] += bf_hi(xb.y); y1[0] += bf_lo(xb.z); y1[1] += bf_hi(xb.z); y1[2] += bf_lo(xb.w); y1[3] += bf_hi(xb.w);
                        acc[ai][bj][m][0] = y0; acc[ai][bj][m][1] = y1;
                        ss += ((y0[0] * y0[0] + y0[1] * y0[1]) + (y0[2] * y0[2] + y0[3] * y0[3])) + ((y1[0] * y1[0] + y1[1] * y1[1]) + (y1[2] * y1[2] + y1[3] * y1[3])); }
                ss += __shfl_xor(ss, 16); ss += __shfl_xor(ss, 32);
                if (fq == 0) P[r * 4 + wc] = ss;
                asm volatile("" ::: "memory"); }
        asm volatile("s_waitcnt lgkmcnt(0)" ::: "memory"); __builtin_amdgcn_s_barrier(); asm volatile("" ::: "memory");
        if (t < 256) { const f32x4 p = *(const PG8_LAS f32x4*)(P + t * 4); __hip_atomic_store(sumsq + (size_t)(u.pm * BM + t) * 4 + u.pn, (p[0] + p[1]) + (p[2] + p[3]), __ATOMIC_RELAXED, __HIP_MEMORY_SCOPE_AGENT); }
        asm volatile("s_waitcnt vmcnt(0)" ::: "memory"); __builtin_amdgcn_s_barrier(); asm volatile("" ::: "memory");
        if (t == 0) {
            __hip_atomic_fetch_add(cnt + 16 * u.pm, 1u, __ATOMIC_RELAXED, __HIP_MEMORY_SCOPE_AGENT);
            unsigned sp = 0;
            while (__hip_atomic_load(cnt + 16 * u.pm, __ATOMIC_RELAXED, __HIP_MEMORY_SCOPE_AGENT) < 4u && ++sp < (1u << 22)) __builtin_amdgcn_s_sleep(2);
            __builtin_amdgcn_fence(__ATOMIC_ACQUIRE, "agent");
        }
        asm volatile("s_waitcnt vmcnt(0) lgkmcnt(0)" ::: "memory"); __builtin_amdgcn_s_barrier(); asm volatile("" ::: "memory");
        if (t < 256) { float s4 = 0.f;
#pragma unroll
            for (int q = 0; q < 4; ++q) s4 += __hip_atomic_load(sumsq + (size_t)(u.pm * BM + t) * 4 + q, __ATOMIC_RELAXED, __HIP_MEMORY_SCOPE_AGENT);
            S[t] = 1.0f / sqrtf(s4 / (float)ldc + eps); }
        asm volatile("s_waitcnt lgkmcnt(0)" ::: "memory"); __builtin_amdgcn_s_barrier(); asm volatile("" ::: "memory");
        f32x4 gv[2][2];
#pragma unroll
        for (int bj = 0; bj < 2; ++bj)
#pragma unroll
            for (int n = 0; n < 2; ++n) gv[bj][n] = *(const f32x4*)(gain + col0 + bj * HALF + n * 4);
#pragma unroll
        for (int ai = 0; ai < 2; ++ai)
#pragma unroll
            for (int m = 0; m < 4; ++m) { const int r = ai * HALF + wr * 64 + m * 16 + fr; const float rs = S[r]; float* op = out + (size_t)(u.pm * BM + r) * ldc + col0;
#pragma unroll
                for (int bj = 0; bj < 2; ++bj)
#pragma unroll
                    for (int n = 0; n < 2; ++n) *(f32x4*)(op + bj * HALF + n * 4) = acc[ai][bj][m][n] * rs * gv[bj][n]; }
    }
};
struct EpiResBf16SqH {
    static constexpr bool PERM = true, AFTER_DRAIN = true, KSCALE = true; static constexpr int AUX_A = 0; static constexpr bool PREP = true;
    bf16_t* xres; float* sumsq; int ldc; const PG8_LAS float* rt4; const float* ssq; int pm0; float inv_dv, eps;
    __device__ __forceinline__ void prepare(int tid) const {
        if (tid < 256) { const float* p = ssq + (size_t)(pm0 * 256 + tid) * 32; float sh[4];
#pragma unroll
            for (int h = 0; h < 4; ++h) { const f32x4 a = *(const f32x4*)(p + 8 * h), b = *(const f32x4*)(p + 8 * h + 4); sh[h] = 1.0f / sqrtf((((a[0] + a[1]) + (a[2] + a[3])) + ((b[0] + b[1]) + (b[2] + b[3]))) * inv_dv + eps); }
            *(PG8_LAS f32x4*)((PG8_LAS float*)rt4 + 4 * tid) = (f32x4){sh[0] / sh[1], sh[1] / sh[2], sh[2] / sh[3], sh[3]}; }
    }
    __device__ __forceinline__ void kscale(f32x4 (&acc)[2][2][4][2], int hb, int wr, int fr) const {
#pragma unroll
        for (int ai = 0; ai < 2; ++ai)
#pragma unroll
            for (int m = 0; m < 4; ++m) { const float rho = rt4[(ai * HALF + wr * 64 + m * 16 + fr) * 4 + hb - 1];
#pragma unroll
                for (int bj = 0; bj < 2; ++bj)
#pragma unroll
                    for (int n = 0; n < 2; ++n) acc[ai][bj][m][n] = acc[ai][bj][m][n] * rho; }
    }
    __device__ __forceinline__ void fused(f32x4 (&acc)[2][2][4][2], const Unit& u, int wr, int wc, int fr, int fq, PG8_LAS unsigned char* lds, int wid, int lane) const {
        PG8_LAS float* P = (PG8_LAS float*)lds;
        const int col0 = u.pn * BM + wc * 32 + 8 * fq;
#pragma unroll
        for (int ai = 0; ai < 2; ++ai)
#pragma unroll
            for (int m = 0; m < 4; ++m) { const int r = ai * HALF + wr * 64 + m * 16 + fr; bf16_t* xp = xres + (size_t)(u.pm * BM + r) * ldc + col0; float ss = 0.f; const float s3 = rt4[r * 4 + 3];
#pragma unroll
                for (int bj = 0; bj < 2; ++bj) { const u32x4 xb = *(const u32x4*)(xp + bj * HALF); const f32x4 a0 = acc[ai][bj][m][0] * s3, a1 = acc[ai][bj][m][1] * s3;
                        u32x4 w; w.x = pk_bf16(bf_lo(xb.x) + a0[0], bf_hi(xb.x) + a0[1]); w.y = pk_bf16(bf_lo(xb.y) + a0[2], bf_hi(xb.y) + a0[3]); w.z = pk_bf16(bf_lo(xb.z) + a1[0], bf_hi(xb.z) + a1[1]); w.w = pk_bf16(bf_lo(xb.w) + a1[2], bf_hi(xb.w) + a1[3]);
                        *(u32x4*)(xp + bj * HALF) = w;
                        const float y0 = bf_lo(w.x), y1 = bf_hi(w.x), y2 = bf_lo(w.y), y3 = bf_hi(w.y), y4 = bf_lo(w.z), y5 = bf_hi(w.z), y6 = bf_lo(w.w), y7 = bf_hi(w.w);
                        ss += ((y0 * y0 + y1 * y1) + (y2 * y2 + y3 * y3)) + ((y4 * y4 + y5 * y5) + (y6 * y6 + y7 * y7)); }
                ss += __shfl_xor(ss, 16); ss += __shfl_xor(ss, 32);
                if (fq == 0) P[r * 4 + wc] = ss;
                asm volatile("" ::: "memory"); }
        asm volatile("s_waitcnt lgkmcnt(0)" ::: "memory"); __builtin_amdgcn_s_barrier(); asm volatile("" ::: "memory");
        const int t = wid * 64 + lane;
        if (t < 256) { const f32x4 p = *(const PG8_LAS f32x4*)(P + t * 4); sumsq[(size_t)(u.pm * BM + t) * 4 + u.pn] = (p[0] + p[1]) + (p[2] + p[3]); }
    }
};
template <class Epi, class Sched, bool ALIGN_EPI = false, bool SP2 = false>
__device__ __forceinline__ void gemm_phase(PG8_LAS unsigned char* lds, const Gemm g, const Sched& S, const Epi& E) {
    const int tid = threadIdx.x, wid = __builtin_amdgcn_readfirstlane(tid >> 6), lane = tid & 63, wr = wid >> 2, wc = wid & 3, fr = lane & 15, fq = lane >> 4;
    const int K = g.K, nt = K / BK;
    unsigned voffA[2], voffB[2];
#pragma unroll
    for (int i = 0; i < 2; ++i) { int R, C; stage_rc(tid * 16 + i * 8192, R, C); const int Rb = Epi::PERM ? ((R & ~31) + perm32(R & 31)) : R;
        voffA[i] = (unsigned)(R * K + C) * 2u; voffB[i] = (unsigned)(Rb * K + C) * 2u; }
    const size_t kstep = (size_t)(BK * 2);
    const size_t hstep = (size_t)HALF * K * 2;
    const size_t tstep = 2 * hstep;
    const unsigned ldsw = (unsigned)wid * 1024u;
    const int aoff = lds_byte(wr * 64 + fr, fq * 8), boff = lds_byte(wc * 32 + fr, fq * 8);
#define PG8_SA(b, h) (((b) * 2 + (h)) * HTB)
#define PG8_SB(b, h) ((4 + (b) * 2 + (h)) * HTB)
#define PG8_STAGE_X(bufoff, gbase, voff, aux) do { _Pragma("unroll") for (int _i = 0; _i < 2; ++_i) \
        __builtin_amdgcn_global_load_lds((const unsigned*)((const char*)(gbase) + (voff)[_i]), (PG8_LAS unsigned*)(lds + (bufoff) + ldsw + _i * 8192), 16, 0, aux); } while (0)
#define PG8_STAGE(bufoff, gbase, voff) PG8_STAGE_X(bufoff, gbase, voff, 0)
#define PG8_STAGEA(bufoff, gbase, voff) PG8_STAGE_X(bufoff, gbase, voff, Epi::AUX_A)
#define PG8_LDA(dst, b, h) do { _Pragma("unroll") for (int m = 0; m < 4; ++m) _Pragma("unroll") for (int k = 0; k < 2; ++k) dst[m][k] = *(const PG8_LAS bf16x8*)(lds + PG8_SA(b, h) + aoff + m * 2048 + k * 1024); } while (0)
#define PG8_LDB(dst, b, h) do { _Pragma("unroll") for (int n = 0; n < 2; ++n) _Pragma("unroll") for (int k = 0; k < 2; ++k) dst[n][k] = *(const PG8_LAS bf16x8*)(lds + PG8_SB(b, h) + boff + n * 2048 + k * 1024); } while (0)
#define PG8_MMA(ai, bj, At, Bt) do { __builtin_amdgcn_s_setprio(1); _Pragma("unroll") for (int m = 0; m < 4; ++m) _Pragma("unroll") for (int n = 0; n < 2; ++n) _Pragma("unroll") for (int k = 0; k < 2; ++k) \
        acc[ai][bj][m][n] = __builtin_amdgcn_mfma_f32_16x16x32_bf16(Bt[n][k], At[m][k], acc[ai][bj][m][n], 0, 0, 0); __builtin_amdgcn_s_setprio(0); } while (0)
#define PG8_WAIT_V(n) asm volatile("s_waitcnt vmcnt(" #n ")" ::: "memory")
#define PG8_WAIT_L(n) asm volatile("s_waitcnt lgkmcnt(" #n ")" ::: "memory")
#define PG8_BAR __builtin_amdgcn_s_barrier()
#define PG8_SCHED __builtin_amdgcn_sched_barrier(0)
    Unit cur, nxt; int ui = 0;
    if (!S.next(0, cur)) return;
    f32x4 acc[2][2][4][2];
#pragma unroll
    for (int a = 0; a < 2; ++a)
#pragma unroll
        for (int b = 0; b < 2; ++b)
#pragma unroll
            for (int m = 0; m < 4; ++m)
#pragma unroll
                for (int n = 0; n < 2; ++n) acc[a][b][m][n] = (f32x4){0.f, 0.f, 0.f, 0.f};
    bf16x8 At[4][2], B0[2][2], B1[2][2];
    const char* cA = (const char*)g.A + (size_t)cur.pm * tstep; const char* cB = (const char*)g.Bt + (size_t)cur.pn * tstep;
    S.a_ready(cur);
    if constexpr (SP2) {
        PG8_STAGE(PG8_SB(0, 0), cB, voffB); PG8_STAGE(PG8_SB(0, 1), cB + hstep, voffB); PG8_STAGEA(PG8_SA(0, 0), cA, voffA); PG8_STAGEA(PG8_SA(0, 1), cA + hstep, voffA);
        if constexpr (Epi::PREP) E.prepare(tid);
        if (wr == 1) PG8_BAR;
        PG8_WAIT_V(2); PG8_BAR;
        PG8_STAGE(PG8_SB(1, 0), cB + kstep, voffB); PG8_STAGEA(PG8_SA(1, 0), cA + kstep, voffA); PG8_STAGE(PG8_SB(1, 1), cB + hstep + kstep, voffB);
        PG8_WAIT_V(6); PG8_BAR;
    } else {
        PG8_STAGE(PG8_SB(0, 0), cB, voffB); PG8_STAGEA(PG8_SA(0, 0), cA, voffA); PG8_STAGE(PG8_SB(0, 1), cB + hstep, voffB); PG8_STAGEA(PG8_SA(0, 1), cA + hstep, voffA);
        if constexpr (Epi::PREP) E.prepare(tid);
        if (wr == 1) PG8_BAR;
        PG8_WAIT_V(4); PG8_BAR;
        PG8_STAGE(PG8_SB(1, 0), cB + kstep, voffB); PG8_STAGEA(PG8_SA(1, 0), cA + kstep, voffA); PG8_STAGE(PG8_SB(1, 1), cB + hstep + kstep, voffB);
        PG8_WAIT_V(6); PG8_BAR;
    }
    for (;;) {
        const bool has_next = S.next(ui + 1, nxt);
        const char* nA = has_next ? (const char*)g.A + (size_t)nxt.pm * tstep : cA; const char* nB = has_next ? (const char*)g.Bt + (size_t)nxt.pn * tstep : cB;
        for (int t = 0; t < nt; t += 2) {
            if constexpr (Epi::KSCALE) { if (t != 0 && (t & 3) == 0) E.kscale(acc, t >> 2, wr, fr); }
            const bool last = (t == nt - 2);
            const char* a1 = cA + (size_t)(t + 1) * kstep;
            const char* a2 = last ? nA : cA + (size_t)(t + 2) * kstep; const char* b2 = last ? nB : cB + (size_t)(t + 2) * kstep;
            const char* a3 = a2 + kstep; const char* b3 = b2 + kstep;
            if (last && has_next) S.a_ready(nxt);
            if constexpr (SP2) {
            PG8_LDB(B0, 0, 0); PG8_LDB(B1, 0, 1); PG8_SCHED; PG8_LDA(At, 0, 0); PG8_STAGEA(PG8_SA(1, 1), a1 + hstep, voffA);
            PG8_WAIT_V(8); PG8_WAIT_L(0); PG8_BAR; PG8_MMA(0, 0, At, B0); PG8_MMA(0, 1, At, B1); PG8_BAR; PG8_SCHED;
            PG8_LDA(At, 0, 1); PG8_STAGE(PG8_SB(0, 0), b2, voffB); PG8_STAGE(PG8_SB(0, 1), b2 + hstep, voffB); PG8_STAGEA(PG8_SA(0, 0), a2, voffA);
            PG8_WAIT_V(8); PG8_WAIT_L(0); PG8_BAR; PG8_MMA(1, 0, At, B0); PG8_MMA(1, 1, At, B1); PG8_BAR; PG8_SCHED;
            PG8_LDB(B0, 1, 0); PG8_LDB(B1, 1, 1); PG8_SCHED; PG8_LDA(At, 1, 0); PG8_STAGEA(PG8_SA(0, 1), a2 + hstep, voffA);
            PG8_WAIT_V(8); PG8_WAIT_L(0); PG8_BAR; PG8_MMA(0, 0, At, B0); PG8_MMA(0, 1, At, B1); PG8_BAR; PG8_SCHED;
            PG8_LDA(At, 1, 1); PG8_STAGE(PG8_SB(1, 0), b3, voffB); PG8_STAGE(PG8_SB(1, 1), b3 + hstep, voffB); PG8_STAGEA(PG8_SA(1, 0), a3, voffA);
            PG8_WAIT_V(8); PG8_WAIT_L(0); PG8_BAR; PG8_MMA(1, 0, At, B0); PG8_MMA(1, 1, At, B1); PG8_BAR; PG8_SCHED;
            } else {
            PG8_LDB(B0, 0, 0); PG8_SCHED; PG8_LDA(At, 0, 0); PG8_STAGEA(PG8_SA(1, 1), a1 + hstep, voffA);
            PG8_WAIT_L(8); PG8_BAR; PG8_WAIT_L(0); PG8_MMA(0, 0, At, B0); PG8_BAR; PG8_SCHED;
            PG8_LDB(B1, 0, 1); PG8_STAGE(PG8_SB(0, 0), b2, voffB);
            PG8_BAR; PG8_WAIT_L(0); PG8_MMA(0, 1, At, B1); PG8_BAR;
            PG8_LDA(At, 0, 1); PG8_STAGEA(PG8_SA(0, 0), a2, voffA);
            PG8_BAR; PG8_WAIT_L(0); PG8_MMA(1, 0, At, B0); PG8_BAR; PG8_SCHED;
            PG8_STAGE(PG8_SB(0, 1), b2 + hstep, voffB);
            PG8_WAIT_V(6); PG8_BAR; PG8_MMA(1, 1, At, B1); PG8_BAR;
            PG8_LDB(B0, 1, 0); PG8_SCHED; PG8_LDA(At, 1, 0); PG8_STAGEA(PG8_SA(0, 1), a2 + hstep, voffA);
            PG8_WAIT_L(8); PG8_BAR; PG8_WAIT_L(0); PG8_MMA(0, 0, At, B0); PG8_BAR; PG8_SCHED;
            PG8_LDB(B1, 1, 1); PG8_STAGE(PG8_SB(1, 0), b3, voffB);
            PG8_BAR; PG8_WAIT_L(0); PG8_MMA(0, 1, At, B1); PG8_BAR;
            PG8_LDA(At, 1, 1); PG8_STAGEA(PG8_SA(1, 0), a3, voffA);
            PG8_BAR; PG8_WAIT_L(0); PG8_MMA(1, 0, At, B0); PG8_BAR; PG8_SCHED;
            PG8_STAGE(PG8_SB(1, 1), b3 + hstep, voffB);
            PG8_WAIT_V(6); PG8_BAR; PG8_MMA(1, 1, At, B1); PG8_BAR;
            }
        }
        if constexpr (ALIGN_EPI) { if (wr == 0) PG8_BAR; }
        if constexpr (!Epi::AFTER_DRAIN) { E(acc, cur, wr, wc, fr, fq); S.done(cur); }
        if (!has_next) break;
#pragma unroll
        for (int a = 0; a < 2; ++a)
#pragma unroll
            for (int b = 0; b < 2; ++b)
#pragma unroll
                for (int m = 0; m < 4; ++m)
#pragma unroll
                    for (int n = 0; n < 2; ++n) acc[a][b][m][n] = (f32x4){0.f, 0.f, 0.f, 0.f};
        cur = nxt; cA = nA; cB = nB; ++ui;
        if constexpr (ALIGN_EPI) { if (wr == 1) PG8_BAR; }
    }
    PG8_WAIT_V(0);
    if constexpr (!ALIGN_EPI) { if (wr == 0) PG8_BAR; }
    PG8_BAR;
    if constexpr (Epi::AFTER_DRAIN) { E.fused(acc, cur, wr, wc, fr, fq, lds, wid, lane); S.done(cur); }
#undef PG8_SA
#undef PG8_SB
#undef PG8_STAGE
#undef PG8_STAGEA
#undef PG8_STAGE_X
#undef PG8_LDA
#undef PG8_LDB
#undef PG8_MMA
#undef PG8_WAIT_V
#undef PG8_WAIT_L
#undef PG8_BAR
#undef PG8_SCHED
}
}

constexpr int NWAVES = 8, NTHREADS = 512;
#ifndef MK_N_LAUNCHES
#define MK_N_LAUNCHES 1
#endif
constexpr int BATCH = 8, SEQ = 2048, D = 1024, FF = 4096, NH = 4, DK = 128, DV = 256, QKW = 512, VW = 1024;
constexpr int M = BATCH * SEQ, NPROJ = 3072, CH = 64, NCH = SEQ / CH;
constexpr int MLSTM_IN = 3080, GLA_IN = 3088;
constexpr float EPS = 1e-6f, QK_SCALE = 0.08838834764831845f, INV_TAU = 1.0f / 16.0f;

constexpr size_t MiB = 1u << 20;
constexpr size_t WS_CTL = 0, CTL_ZERO_BYTES = 64 * 1024;
constexpr size_t WS_GATES = 1 * MiB;
constexpr size_t WS_GDEC = 2 * MiB;
constexpr size_t WS_WGT = 2 * MiB + 768 * 1024;
constexpr size_t WS_SUMSQ = 2 * MiB + 512 * 1024;
constexpr size_t WS_WIN = 4 * MiB, WS_WOUT = 10 * MiB, WS_W1 = 12 * MiB, WS_W2 = 20 * MiB, WS_WLAYER = 56 * MiB;
constexpr size_t WS_SSQ = 84 * MiB;
constexpr size_t WS_AOP = 28 * MiB;
constexpr size_t WS_PROJ = 92 * MiB, WS_BBLK = 16 * MiB, WS_QT_OFF = 12 * MiB, WS_KT_OFF = 14 * MiB;
constexpr size_t BBLK_E = WS_BBLK / 2;
constexpr size_t WS_HMID = 92 * MiB;
constexpr size_t WS_XRES = 220 * MiB;
constexpr size_t WS_END = 252 * MiB;
constexpr int CW_BAR = 1024, CW_XID = 8192, CW_XCL = 9216, CW_FIN = 14336, CW_GRP = 15360;

constexpr int RING_BYTES = 131072, LDS_BYTES = 163840, LDSCTL_OFF = LDS_BYTES - 1024, MISC_OFF = LDSCTL_OFF + 320;

#define GAS __attribute__((address_space(1)))
#define LAS __attribute__((address_space(3)))
typedef unsigned short bf16;
typedef unsigned v4u __attribute__((ext_vector_type(4)));
typedef unsigned v2u __attribute__((ext_vector_type(2)));
typedef float f32x4 __attribute__((ext_vector_type(4)));
typedef float v2f __attribute__((ext_vector_type(2)));
typedef float f32x16 __attribute__((ext_vector_type(16)));
typedef short bf16x8 __attribute__((ext_vector_type(8)));
typedef short s16x4 __attribute__((ext_vector_type(4)));
typedef GAS unsigned gu32;
#define RLX_AGENT __ATOMIC_RELAXED, __HIP_MEMORY_SCOPE_AGENT
#define LDS_WAIT() asm volatile("s_waitcnt lgkmcnt(0)" ::: "memory")
#define VM_WAIT() asm volatile("s_waitcnt vmcnt(0)" ::: "memory")
using pg8::pk_bf16;
__device__ __forceinline__ float bf2f(unsigned b) { return __uint_as_float(b << 16); }
__device__ __forceinline__ float bflo(unsigned w) { return __uint_as_float(w << 16); }
__device__ __forceinline__ float bfhi(unsigned w) { return __uint_as_float(w & 0xffff0000u); }
__device__ __forceinline__ unsigned short f2bf1(float f) { return (unsigned short)(pk_bf16(f, 0.f) & 0xffffu); }

struct Args { const float* in[15]; float* out; unsigned char* ws; int ph_lo, ph_hi; };
#define XB_TMO      128
#define XB_XCNT(j)  (256  + 64 * (j))
#define XB_XSUB(j)  (1280 + 64 * (j))
#define XB_XGEN(j)  (2304 + 64 * (j))
#define XB_TOP      3328
#define XB_TOPGEN   3392
#define XCD_BAR_WORDS 3456
#define XB_SPIN_CAP (1u << 18)
__device__ __forceinline__ unsigned xb_ld(unsigned* p)              { return __hip_atomic_load(p, __ATOMIC_RELAXED, __HIP_MEMORY_SCOPE_AGENT); }
__device__ __forceinline__ unsigned xb_add(unsigned* p, unsigned v) { return __hip_atomic_fetch_add(p, v, __ATOMIC_RELAXED, __HIP_MEMORY_SCOPE_AGENT); }
__device__ __forceinline__ unsigned xb_xcc_id() { return (unsigned)__builtin_amdgcn_s_getreg((3 << 11) | 20) & 0xFu; }
#define XB_SPIN(cond, bar) do { unsigned _sp = 0; while (cond) { __builtin_amdgcn_s_sleep(1); \
    if ((++_sp & 255u) == 0u) { if (xb_ld(&(bar)[XB_TMO])) break; if (_sp > XB_SPIN_CAP) { atomicAdd(&(bar)[XB_TMO], 1u); break; } } } } while (0)
struct XcdBarrier { unsigned* bar; unsigned x; volatile LAS unsigned* st; };
__device__ __forceinline__ XcdBarrier xcd_barrier_post(unsigned* bar, volatile LAS unsigned* st) {
    XcdBarrier b; b.bar = bar; b.x = xb_xcc_id(); b.st = st;
    if (threadIdx.x == 0) (void)xb_add(&bar[XB_XCNT(b.x)], 1u);
    return b;
}
__device__ __forceinline__ void xcd_barrier_complete(unsigned* bar, unsigned x, unsigned& nloc, unsigned& nx) {
    const unsigned G = gridDim.x * gridDim.y * gridDim.z;
    unsigned sum, cnt, mine, sp = 0u;
    for (;;) {
        sum = 0u; cnt = 0u; mine = 0u;
#pragma unroll
        for (unsigned j = 0; j < 16; ++j) { const unsigned c = xb_ld(&bar[XB_XCNT(j)]); sum += c; cnt += (c > 0u) ? 1u : 0u; mine = (j == x) ? c : mine; }
        if (sum == G) break;
        __builtin_amdgcn_s_sleep(1);
        if ((++sp & 255u) == 0u) { if (xb_ld(&bar[XB_TMO])) break; if (sp > XB_SPIN_CAP) { atomicAdd(&bar[XB_TMO], 1u); break; } }
    }
    nloc = mine > 0u ? mine : 1u; nx = cnt > 0u ? cnt : 1u;
}
__device__ __forceinline__ void xcd_barrier(const XcdBarrier& b) {
    asm volatile("s_waitcnt vmcnt(0)" ::: "memory");
    __syncthreads();
    if (threadIdx.x == 0) {
        unsigned* bar = b.bar;
        __builtin_amdgcn_s_waitcnt(0);
        unsigned nloc = b.st[0], nx = b.st[1];
        if (nloc == 0u) { xcd_barrier_complete(bar, b.x, nloc, nx); b.st[0] = nloc; b.st[1] = nx; }
        const unsigned old = xb_add(&bar[XB_XSUB(b.x)], 1u);
        const unsigned gen = old / nloc;
        if (old + 1u == (gen + 1u) * nloc) {
            __builtin_amdgcn_fence(__ATOMIC_RELEASE, "agent");
            asm volatile("s_waitcnt vmcnt(0)" ::: "memory");
            const unsigned og = xb_add(&bar[XB_TOP], 1u);
            const unsigned tg = og / nx;
            if (og + 1u == (tg + 1u) * nx) xb_add(&bar[XB_TOPGEN], 1u);
            else XB_SPIN(xb_ld(&bar[XB_TOPGEN]) == tg, bar);
            __builtin_amdgcn_fence(__ATOMIC_ACQUIRE, "agent");
            xb_add(&bar[XB_XGEN(b.x)], 1u);
            asm volatile("s_waitcnt vmcnt(0)" ::: "memory");
        } else {
            XB_SPIN(xb_ld(&bar[XB_XGEN(b.x)]) == gen, bar);
            __builtin_amdgcn_fence(__ATOMIC_ACQUIRE, "agent");
            asm volatile("s_waitcnt vmcnt(0)" ::: "memory");
        }
    }
    __syncthreads();
}

__device__ __forceinline__ float wave_sum(float v) {
#pragma unroll
    for (int o = 1; o < 64; o <<= 1) v += __shfl_xor(v, o);
    return v;
}
struct CvItem { const float* W; bf16* WT; const float* gain; int K, ldw, k0, n0; };
__device__ __forceinline__ CvItem cv_item(const Args& args, unsigned char* ws, int it) {
    constexpr int I_IN = (D / 64) * (NPROJ / 64), I_O = (D / 64) * (D / 64), I_1 = (D / 64) * (FF / 64), I_2 = (FF / 64) * (D / 64), NITEMS = I_IN + I_O + I_1 + I_2;
    const int layer = it >= NITEMS; int r = it - layer * NITEMS; unsigned char* wl = ws + (size_t)layer * WS_WLAYER;
    CvItem c; int N;
    if (r < I_IN) { c.W = args.in[layer ? 8 : 4]; c.K = D; N = NPROJ; c.ldw = layer ? GLA_IN : MLSTM_IN; c.WT = (bf16*)(wl + WS_WIN); c.gain = args.in[1] + layer * D; }
    else if ((r -= I_IN) < I_O) { c.W = args.in[layer ? 12 : 7]; c.K = D; N = D; c.ldw = D; c.WT = (bf16*)(wl + WS_WOUT); c.gain = nullptr; }
    else if ((r -= I_O) < I_1) { c.W = args.in[13] + (size_t)layer * D * FF; c.K = D; N = FF; c.ldw = FF; c.WT = (bf16*)(wl + WS_W1); c.gain = args.in[2] + layer * D; }
    else { r -= I_1; c.W = args.in[14] + (size_t)layer * D * FF; c.K = FF; N = D; c.ldw = D; c.WT = (bf16*)(wl + WS_W2); c.gain = nullptr; }
    const int nblk = N / 64; c.k0 = 64 * (r / nblk); c.n0 = 64 * (r % nblk);
    return c;
}
__device__ __forceinline__ void cv_load(f32x4 (&v)[16], const CvItem& c, int lane) {
    const int n4 = (lane & 15) * 4, krow = lane >> 4;
#pragma unroll
    for (int i = 0; i < 16; ++i) v[i] = __builtin_nontemporal_load((const f32x4*)(c.W + (size_t)(c.k0 + 4 * i + krow) * c.ldw + c.n0 + n4));
}
__device__ __forceinline__ void cv_store(const f32x4 (&v)[16], const CvItem& c, LAS float* scr, int lane) {
    const int n4 = (lane & 15) * 4, krow = lane >> 4;
#pragma unroll
    for (int i = 0; i < 16; ++i) *(LAS f32x4*)(scr + (4 * i + krow) * 64 + (n4 ^ (((i >> 1) & 7) << 2))) = v[i];
    const int cc = lane & 7, nl = lane >> 3;
    f32x4 g0 = {1.f, 1.f, 1.f, 1.f}, g1 = {1.f, 1.f, 1.f, 1.f};
    if (c.gain) { g0 = *(const f32x4*)(c.gain + c.k0 + 8 * cc); g1 = *(const f32x4*)(c.gain + c.k0 + 8 * cc + 4); }
    LDS_WAIT(); asm volatile("" ::: "memory");
#pragma unroll
    for (int j = 0; j < 8; ++j) { const int n = 8 * j + nl; const LAS float* sp = scr + (8 * cc) * 64 + (n ^ (cc << 2));
        v4u o; o.x = pk_bf16(sp[0 * 64] * g0.x, sp[1 * 64] * g0.y); o.y = pk_bf16(sp[2 * 64] * g0.z, sp[3 * 64] * g0.w); o.z = pk_bf16(sp[4 * 64] * g1.x, sp[5 * 64] * g1.y); o.w = pk_bf16(sp[6 * 64] * g1.z, sp[7 * 64] * g1.w);
        *(GAS v4u*)(c.WT + (size_t)(c.n0 + n) * c.K + c.k0 + 8 * cc) = o; }
    LDS_WAIT(); asm volatile("" ::: "memory");
}
__device__ __forceinline__ void convert_weights(LAS unsigned char* lds, int lane, int wv, int nw, int vcu, int G, const Args& args, unsigned char* ws) {
    LAS float* scr = (LAS float*)(lds + wv * 16384);
    const int gw = vcu * nw + wv, NGW = G * nw;
    constexpr int NITEMS2 = 2 * ((D / 64) * (NPROJ / 64) + (D / 64) * (D / 64) + (D / 64) * (FF / 64) + (FF / 64) * (D / 64));
    f32x4 va[16], vb[16];
    int it = gw;
    if (it < NITEMS2) { const CvItem c0 = cv_item(args, ws, it); cv_load(va, c0, lane); }
    while (it < NITEMS2) {
        { const CvItem c = cv_item(args, ws, it); const int nx = it + NGW; if (nx < NITEMS2) { const CvItem cn = cv_item(args, ws, nx); cv_load(vb, cn, lane); } cv_store(va, c, scr, lane); it = nx; }
        if (it >= NITEMS2) break;
        { const CvItem c = cv_item(args, ws, it); const int nx = it + NGW; if (nx < NITEMS2) { const CvItem cn = cv_item(args, ws, nx); cv_load(va, cn, lane); } cv_store(vb, c, scr, lane); it = nx; }
    }
}

constexpr int WGB_PITCH = 2064;
#define ROWS_STAGE_LOAD() float wv_[16]; _Pragma("unroll") for (int n = 0; n < 16; ++n) { const int i = tid + NTHREADS * n, k = i >> 3, c = i & 7; wv_[n] = wg[(size_t)k * ldw + c] * gain[k]; }
#define ROWS_STAGE_WRITE() do { _Pragma("unroll") for (int n = 0; n < 16; ++n) { const int i = tid + NTHREADS * n, k = i >> 3, c = i & 7; const unsigned h = pk_bf16(wv_[n], 0.f) & 0xffffu; \
        *(LAS unsigned short*)(wgb + c * WGB_PITCH + 2 * k) = (unsigned short)h; *(LAS unsigned short*)(wgb + (c + 8) * WGB_PITCH + 2 * k) = f2bf1(wv_[n] - __uint_as_float(h << 16)); } } while (0)
__device__ __forceinline__ void rows_first(LAS unsigned char* wgb, LAS float* cmb, int tid, int lane, int wave, int vcu, int G, const float* wg, int ldw, const float* gain, const float* xin, bf16* xres, float* sumsq, float* gates) {
    const int r16 = lane & 15, kq = lane >> 4, kh = wave >> 2, bw = wave & 3;
    ROWS_STAGE_LOAD();
    bool staged = false;
    const LAS unsigned char* bp = wgb + r16 * WGB_PITCH + 1024 * kh + 16 * kq;
    for (int blk0 = vcu * 4; blk0 < M / 16; blk0 += G * 4) {
        const int m0 = (blk0 + bw) * 16;
        const float* xp = xin + (size_t)(m0 + r16) * D + 512 * kh + 8 * kq;
        bf16* xo = xres + (size_t)(m0 + r16) * D + 512 * kh + 8 * kq;
        f32x4 xa[8][2];
#pragma unroll
        for (int u = 0; u < 8; ++u) { xa[u][0] = __builtin_nontemporal_load((const f32x4*)(xp + 32 * u)); xa[u][1] = __builtin_nontemporal_load((const f32x4*)(xp + 32 * u + 4)); }
        if (!staged) { ROWS_STAGE_WRITE(); staged = true; __syncthreads(); }
        pg8::f32x4 acc = {0.f, 0.f, 0.f, 0.f}; float ss = 0.f;
#pragma unroll
        for (int s = 0; s < 16; ++s) { const int u = s & 7;
            const f32x4 a = xa[u][0], b = xa[u][1];
            if (s + 8 < 16) { xa[u][0] = __builtin_nontemporal_load((const f32x4*)(xp + 32 * (s + 8))); xa[u][1] = __builtin_nontemporal_load((const f32x4*)(xp + 32 * (s + 8) + 4)); }
            v4u h, l; h.x = pk_bf16(a.x, a.y); h.y = pk_bf16(a.z, a.w); h.z = pk_bf16(b.x, b.y); h.w = pk_bf16(b.z, b.w);
            l.x = pk_bf16(a.x - bflo(h.x), a.y - bfhi(h.x)); l.y = pk_bf16(a.z - bflo(h.y), a.w - bfhi(h.y)); l.z = pk_bf16(b.x - bflo(h.z), b.y - bfhi(h.z)); l.w = pk_bf16(b.z - bflo(h.w), b.w - bfhi(h.w));
            ss += ((a.x * a.x + a.y * a.y) + (a.z * a.z + a.w * a.w)) + ((b.x * b.x + b.y * b.y) + (b.z * b.z + b.w * b.w));
            *(v4u*)(xo + 32 * s) = h;
            const bf16x8 bv = *(const LAS bf16x8*)(bp + 64 * s);
            acc = __builtin_amdgcn_mfma_f32_16x16x32_bf16(__builtin_bit_cast(bf16x8, h), bv, acc, 0, 0, 0);
            acc = __builtin_amdgcn_mfma_f32_16x16x32_bf16(__builtin_bit_cast(bf16x8, l), bv, acc, 0, 0, 0); }
        ss += __shfl_xor(ss, 16); ss += __shfl_xor(ss, 32);
        LAS float* cw = cmb + (bw * 64 + lane) * 5;
        if (kh == 1) { cw[0] = acc[0]; cw[1] = acc[1]; cw[2] = acc[2]; cw[3] = acc[3]; cw[4] = ss; }
        __syncthreads();
        if (kh == 0) {
            acc[0] += cw[0]; acc[1] += cw[1]; acc[2] += cw[2]; acc[3] += cw[3]; ss += cw[4];
            if (kq == 0) *(f32x4*)(sumsq + (size_t)(m0 + r16) * 4) = (f32x4){ss, 0.f, 0.f, 0.f};
            const float rstd = 1.0f / sqrtf(ss * (1.f / D) + EPS);
#pragma unroll
            for (int j = 0; j < 4; ++j) { const float g = acc[j] + __shfl_xor(acc[j], 8); const float rs = __shfl(rstd, 4 * kq + j);
                if (r16 < 8) gates[(size_t)(m0 + 4 * kq + j) * 16 + r16] = g * rs; }
        }
        __syncthreads();
    }
}
__device__ __forceinline__ void rows_final(int lane, int wave, int vcu, int G, const bf16* xres, const float* gain, float* out) {
    const int gw = vcu * NWAVES + wave, NGW = G * NWAVES;
    for (int m = gw; m < M; m += NGW) {
        float f[2][8]; float ss = 0.f;
#pragma unroll
        for (int j = 0; j < 2; ++j) { const v4u hv = *(const v4u*)(xres + (size_t)m * D + 8 * lane + 512 * j);
            f[j][0] = bflo(hv.x); f[j][1] = bfhi(hv.x); f[j][2] = bflo(hv.y); f[j][3] = bfhi(hv.y); f[j][4] = bflo(hv.z); f[j][5] = bfhi(hv.z); f[j][6] = bflo(hv.w); f[j][7] = bfhi(hv.w);
#pragma unroll
            for (int e = 0; e < 8; ++e) ss += f[j][e] * f[j][e]; }
        const float rstd = 1.0f / sqrtf(wave_sum(ss) * (1.f / D) + EPS);
#pragma unroll
        for (int j = 0; j < 2; ++j) { const int col = 8 * lane + 512 * j; const f32x4 g0 = *(const f32x4*)(gain + col), g1 = *(const f32x4*)(gain + col + 4);
            *(f32x4*)(out + (size_t)m * D + col) = (f32x4){f[j][0] * rstd * g0.x, f[j][1] * rstd * g0.y, f[j][2] * rstd * g0.z, f[j][3] * rstd * g0.w};
            *(f32x4*)(out + (size_t)m * D + col + 4) = (f32x4){f[j][4] * rstd * g1.x, f[j][5] * rstd * g1.y, f[j][6] * rstd * g1.z, f[j][7] * rstd * g1.w}; }
    }
}
struct RstdSlots { int pm0, pm1, pm2, pm3; };
__device__ __forceinline__ RstdSlots rstd_slots(const pg8::StaticOrder& S) {
    int pmv[4] = {-1, -1, -1, -1}; int ns = 0;
    pg8::Unit u;
    for (int i = 0; S.next(i, u); ++i) { if (u.pm != pmv[0] && u.pm != pmv[1] && u.pm != pmv[2] && u.pm != pmv[3] && ns < 4) { if (ns == 0) pmv[0] = u.pm; else if (ns == 1) pmv[1] = u.pm; else if (ns == 2) pmv[2] = u.pm; else pmv[3] = u.pm; ++ns; } }
    return RstdSlots{pmv[0], pmv[1], pmv[2], pmv[3]};
}

__device__ __forceinline__ void head_scale_table(LAS float* rt4, const float* ssq, int pm, int tid) {
    if (tid < 256) { const float* p = ssq + (size_t)(pm * 256 + tid) * 32; float sh[4];
#pragma unroll
        for (int h = 0; h < 4; ++h) { const f32x4 a = *(const f32x4*)(p + 8 * h), b = *(const f32x4*)(p + 8 * h + 4); sh[h] = 1.0f / sqrtf((((a.x + a.y) + (a.z + a.w)) + ((b.x + b.y) + (b.z + b.w))) * (1.f / DV) + EPS); }
        *(LAS f32x4*)(rt4 + 4 * tid) = (f32x4){sh[0] / sh[1], sh[1] / sh[2], sh[2] / sh[3], sh[3]}; }
    __syncthreads();
}
__device__ __forceinline__ void head_norm_rows(int lane, int wave, int vcu, int G, const bf16* hun, const float* gout, const bf16* proj, bf16* aop, const bool GLA) {
    const int rows_wg = M / G, rows_w = rows_wg / NWAVES;
    for (int i = 0; i < rows_w; ++i) {
        const int m = vcu * rows_wg + wave * rows_w + i;
#pragma unroll
        for (int j = 0; j < 2; ++j) {
            const int col = 8 * lane + 512 * j;
            const v4u hv = *(const v4u*)(hun + (size_t)m * D + col);
            const v4u rv = *(const v4u*)(proj + (size_t)(m >> 11) * BBLK_E + (size_t)(m & 2047) * NPROJ + 2048 + col);
            float f[8] = {bflo(hv.x), bfhi(hv.x), bflo(hv.y), bfhi(hv.y), bflo(hv.z), bfhi(hv.z), bflo(hv.w), bfhi(hv.w)};
            const float r[8] = {bflo(rv.x), bfhi(rv.x), bflo(rv.y), bfhi(rv.y), bflo(rv.z), bfhi(rv.z), bflo(rv.w), bfhi(rv.w)};
            float sg[8];
#pragma unroll
            for (int e = 0; e < 8; ++e) sg[e] = __builtin_amdgcn_rcpf(1.0f + __expf(-r[e]));
            if (!GLA) {
#pragma unroll
                for (int e = 0; e < 8; ++e) f[e] *= sg[e];
            }
            float ss = 0.f;
#pragma unroll
            for (int e = 0; e < 8; ++e) ss += f[e] * f[e];
#pragma unroll
            for (int o = 1; o < 32; o <<= 1) ss += __shfl_xor(ss, o);
            const float rs = 1.0f / sqrtf(ss * (1.f / DV) + EPS);
            const f32x4 g0 = *(const f32x4*)(gout + col), g1 = *(const f32x4*)(gout + col + 4);
            const float gg[8] = {g0.x, g0.y, g0.z, g0.w, g1.x, g1.y, g1.z, g1.w};
#pragma unroll
            for (int e = 0; e < 8; ++e) f[e] = f[e] * rs * gg[e];
            if (GLA) {
#pragma unroll
                for (int e = 0; e < 8; ++e) f[e] *= r[e] * sg[e];
            }
            v4u o; o.x = pk_bf16(f[0], f[1]); o.y = pk_bf16(f[2], f[3]); o.z = pk_bf16(f[4], f[5]); o.w = pk_bf16(f[6], f[7]);
            *(v4u*)(aop + (size_t)m * D + col) = o;
        }
    }
}

constexpr int GP_WGT = 0, GP_WGT_PITCH = 2064, GP_ZL = 33024, GP_Q = 43264, GP_K = 59648, GP_TOT = 76032;
__device__ __forceinline__ void gla_prep(LAS unsigned char* lds, int tid, int lane, int wave, int vcu, int G, const bf16* proj, const bf16* xres, const float* sumsq, const bf16* wgt,
                                         const float* wup, const float* bgate, bf16* QT, bf16* KT, float* gdec) {
#define GP_BAR() do { asm volatile("s_waitcnt lgkmcnt(0)" ::: "memory"); __builtin_amdgcn_s_barrier(); asm volatile("" ::: "memory"); } while (0)
    LAS float* zl = (LAS float*)(lds + GP_ZL);
    LAS float* tot = (LAS float*)(lds + GP_TOT);
    LAS unsigned short* tq = (LAS unsigned short*)(lds + GP_Q);
    LAS unsigned short* tk = (LAS unsigned short*)(lds + GP_K);
    __syncthreads();
    { v4u wv[5];
#pragma unroll
      for (int n = 0; n < 5; ++n) { const int i = tid + NTHREADS * n; if (i < 2064) wv[n] = *(const v4u*)(wgt + 8 * i); }
#pragma unroll
      for (int n = 0; n < 5; ++n) { const int i = tid + NTHREADS * n; if (i < 2064) *(LAS v4u*)(lds + GP_WGT + 16 * i) = wv[n]; } }
    const int d = 2 * (tid & 63), rg = tid >> 6;
    for (int unit = vcu; unit < BATCH * NCH; unit += G) {
        const int b = unit / NCH, c = unit % NCH, tok0 = b * SEQ + c * CH;
        const bf16* projb = proj + (size_t)b * BBLK_E + (size_t)(c * CH) * NPROJ; bf16* QTb = QT + (size_t)b * BBLK_E + (size_t)(c * CH) * QKW; bf16* KTb = KT + (size_t)b * BBLK_E + (size_t)(c * CH) * QKW;
        v4u pq[2], pk[2]; v2f wu[16]; v2f bg;
#define GP_LOAD(h_) do { _Pragma("unroll") for (int i_ = 0; i_ < 2; ++i_) { const int p_ = tid + NTHREADS * i_, row_ = p_ >> 4, ch_ = p_ & 15; \
            pq[i_] = __builtin_nontemporal_load((const v4u*)(projb + (size_t)row_ * NPROJ + (h_) * DK + ch_ * 8)); pk[i_] = __builtin_nontemporal_load((const v4u*)(projb + (size_t)row_ * NPROJ + QKW + (h_) * DK + ch_ * 8)); } \
            } while (0)
#define GP_LOADW(h_) do { _Pragma("unroll") for (int cc_ = 0; cc_ < 16; ++cc_) wu[cc_] = *(const v2f*)(wup + cc_ * QKW + (h_) * DK + d); bg = *(const v2f*)(bgate + (h_) * DK + d); } while (0)
        GP_LOAD(0); GP_LOADW(0);
        const f32x4 s4pre = *(const f32x4*)(sumsq + (size_t)(tok0 + (tid >> 3)) * 4);
        GP_BAR();
        {
            const int rt = wave & 3, kh = wave >> 2, r16 = lane & 15, kq = lane >> 4;
            pg8::f32x4 acc = {0.f, 0.f, 0.f, 0.f};
            const bf16* xr = xres + (size_t)(tok0 + 16 * rt + r16) * D + kh * 512 + 8 * kq;
            LAS unsigned char* wr_ = lds + GP_WGT + r16 * GP_WGT_PITCH + (kh * 512 + 8 * kq) * 2;
#pragma unroll
            for (int ks = 0; ks < 16; ++ks) { const bf16x8 av = __builtin_nontemporal_load((const bf16x8*)(xr + 32 * ks)), bv = *(const LAS bf16x8*)(wr_ + 64 * ks); acc = __builtin_amdgcn_mfma_f32_16x16x32_bf16(av, bv, acc, 0, 0, 0); }
#pragma unroll
            for (int i = 0; i < 4; ++i) zl[kh * 1024 + (16 * rt + 4 * kq + i) * 16 + r16] = acc[i];
        }
        GP_BAR();
        { const int row = tid >> 3, c2 = (tid & 7) * 2;
          const f32x4 s4 = s4pre; const float rstd = 1.0f / sqrtf(((s4.x + s4.y) + (s4.z + s4.w)) * (1.f / D) + EPS);
          const float z0 = (zl[row * 16 + c2] + zl[1024 + row * 16 + c2]) * rstd, z1 = (zl[row * 16 + c2 + 1] + zl[1024 + row * 16 + c2 + 1]) * rstd;
          GP_BAR();
          zl[row * 16 + c2] = z0; zl[row * 16 + c2 + 1] = z1; }
        GP_BAR();
#pragma clang loop unroll(disable)
        for (int h = 0; h < NH; ++h) {
#pragma unroll
            for (int i = 0; i < 2; ++i) { const int p = tid + NTHREADS * i; *(LAS v4u*)(lds + GP_Q + p * 16) = pq[i]; *(LAS v4u*)(lds + GP_K + p * 16) = pk[i]; }
            if (h + 1 < NH) GP_LOAD(h + 1);
            v2f bcum[8]; v2f run = {0.f, 0.f};
#pragma unroll
            for (int jj = 0; jj < 8; ++jj) {
                const int j = 8 * rg + jj; v2f z = bg;
#pragma unroll
                for (int q4 = 0; q4 < 4; ++q4) { const f32x4 zz = *(const LAS f32x4*)(zl + j * 16 + 4 * q4);
                    z += (wu[4 * q4] * zz.x + wu[4 * q4 + 1] * zz.y) + (wu[4 * q4 + 2] * zz.z + wu[4 * q4 + 3] * zz.w); }
                v2f la; la.x = (fminf(z.x, 0.f) - __logf(1.0f + __expf(-fabsf(z.x)))) * INV_TAU; la.y = (fminf(z.y, 0.f) - __logf(1.0f + __expf(-fabsf(z.y)))) * INV_TAU;
                run += la; bcum[jj] = run;
                if (jj & 1) asm volatile("" ::: "memory");
            }
            *(LAS v2f*)(tot + rg * 128 + d) = run;
            if (h + 1 < NH) GP_LOADW(h + 1);
            GP_BAR();
            v2f off = {0.f, 0.f}, g = {0.f, 0.f};
#pragma unroll
            for (int r2 = 0; r2 < 8; ++r2) { const v2f t = *(const LAS v2f*)(tot + r2 * 128 + d); g += t; if (r2 < rg) off += t; }
#pragma unroll
            for (int jj = 0; jj < 8; ++jj) {
                const int j = 8 * rg + jj; const float eb0 = __expf(bcum[jj].x + off.x), eb1 = __expf(bcum[jj].y + off.y);
                LAS unsigned* pq2 = (LAS unsigned*)(tq + j * 128 + d); LAS unsigned* pk2 = (LAS unsigned*)(tk + j * 128 + d);
                const unsigned qw = *pq2, kw = *pk2;
                *pq2 = pk_bf16(bflo(qw) * QK_SCALE * eb0, bfhi(qw) * QK_SCALE * eb1); *pk2 = pk_bf16(bflo(kw) * __builtin_amdgcn_rcpf(eb0), bfhi(kw) * __builtin_amdgcn_rcpf(eb1));
            }
            if (rg == 0) *(v2f*)(gdec + (size_t)(unit * NH + h) * DK + d) = (v2f){__expf(g.x), __expf(g.y)};
            GP_BAR();
#pragma unroll
            for (int i = 0; i < 2; ++i) { const int p = tid + NTHREADS * i, row = p >> 4, ch = p & 15;
                *(v4u*)(QTb + (size_t)row * QKW + h * DK + ch * 8) = *(const LAS v4u*)(lds + GP_Q + p * 16);
                *(v4u*)(KTb + (size_t)row * QKW + h * DK + ch * 8) = *(const LAS v4u*)(lds + GP_K + p * 16); }
            GP_BAR();
        }
#undef GP_LOAD
#undef GP_LOADW
    }
    __syncthreads();
}

#ifndef PROBE_P
#define PROBE_P 0
#endif
#ifndef PROBE_P_A
#define PROBE_P_A 0
#endif
#ifndef PROBE_P_B
#define PROBE_P_B 1
#endif
#define PP_SEL(i, S_) ((S_) < 32 ? (i) / 2 == (S_) : ((i) == 2 * ((S_) - 32) + 1 || (i) == 2 * ((S_) - 32) + 2))
#define PP_STAMP(i) do { if (PROBE_P && (PP_SEL(i, PROBE_P_A) || PP_SEL(i, PROBE_P_B)) && tid == 0) ((volatile LAS unsigned*)(lds + LDSCTL_OFF + 512))[i] = (unsigned)__builtin_amdgcn_s_memrealtime(); } while (0)
#ifndef PROBE_T
#define PROBE_T 0
#endif
#ifndef PROBE_T_MLSTM
#define PROBE_T_MLSTM 0
#endif
#ifndef PROBE_T_WAVE
#define PROBE_T_WAVE 0
#endif
#ifndef PROBE_T_A
#define PROBE_T_A 5
#endif
#ifndef PROBE_T_B
#define PROBE_T_B 0
#endif
constexpr int CW_PROBE = 12288;
__device__ __forceinline__ unsigned long long pt_now() { unsigned long long t; __builtin_amdgcn_sched_barrier(0); asm volatile("s_memrealtime %0\n\ts_waitcnt lgkmcnt(0)" : "=s"(t) :: "memory"); __builtin_amdgcn_sched_barrier(0); return t; }
#define PT_NOW() pt_now()
#define PT_ACC(i, t0) do { if (PROBE_T) { const unsigned long long t1_ = PT_NOW(); pt[i] += (unsigned)(t1_ - (t0)); (t0) = t1_; } } while (0)
constexpr int PS_PITCH = 144, CT_PITCH = 272, CT_BYTES = 32 * CT_PITCH, IMG_PITCH = 272, IMG_BYTES = 64 * IMG_PITCH, NUM_PITCH = 36;
template <bool MLSTM> struct MxMap;
template <> struct MxMap<true>  { static constexpr int QS = 0, KS = 34816, V = 69632, VW = 77824, VWAUX = 81920, PS = 86016, CT = 95232, TB = 112640, TWP = 120832, TPM = 129024, TSC = 137216, DEN = 137728, NUM = 138240, WI = 147456, GDEC = 0, END = 147968; };
template <> struct MxMap<false> { static constexpr int QS = 0, KS = 34816, V = 69632, VW = 0, VWAUX = 0, PS = 77824, CT = 87040, TB = 0, TWP = 0, TPM = 0, TSC = 0, DEN = 0, NUM = 104448, WI = 0, GDEC = 113664, END = 114688; };
#define LDSA(p) ((unsigned)(size_t)(p))
__device__ __forceinline__ bf16x8 mk8(v2u lo, v2u hi) { v4u w; w.x = lo.x; w.y = lo.y; w.z = hi.x; w.w = hi.y; return __builtin_bit_cast(bf16x8, w); }
__device__ __forceinline__ void tr_read2(bf16x8& f0, bf16x8& f1, unsigned a0, unsigned a1, unsigned b0, unsigned b1) {
    v2u l0, h0, l1, h1;
    asm volatile("ds_read_b64_tr_b16 %0, %4\n\tds_read_b64_tr_b16 %1, %5\n\tds_read_b64_tr_b16 %2, %6\n\tds_read_b64_tr_b16 %3, %7\n\ts_waitcnt lgkmcnt(0)"
                 : "=&v"(l0), "=&v"(h0), "=&v"(l1), "=&v"(h1) : "v"(a0), "v"(a1), "v"(b0), "v"(b1) : "memory");
    f0 = mk8(l0, h0); f1 = mk8(l1, h1);
}
__device__ __forceinline__ void tr_read3(bf16x8& f0, bf16x8& f1, bf16x8& f2, unsigned a0, unsigned a1, unsigned b0, unsigned b1, unsigned c0, unsigned c1) {
    v2u l0, h0, l1, h1, l2, h2;
    asm volatile("ds_read_b64_tr_b16 %0, %6\n\tds_read_b64_tr_b16 %1, %7\n\tds_read_b64_tr_b16 %2, %8\n\tds_read_b64_tr_b16 %3, %9\n\tds_read_b64_tr_b16 %4, %10\n\tds_read_b64_tr_b16 %5, %11\n\ts_waitcnt lgkmcnt(0)"
                 : "=&v"(l0), "=&v"(h0), "=&v"(l1), "=&v"(h1), "=&v"(l2), "=&v"(h2) : "v"(a0), "v"(a1), "v"(b0), "v"(b1), "v"(c0), "v"(c1) : "memory");
    f0 = mk8(l0, h0); f1 = mk8(l1, h1); f2 = mk8(l2, h2);
}
template <int P> __device__ __forceinline__ void tr_issue4(v2u (&x)[8], unsigned base) {
    asm volatile("ds_read_b64_tr_b16 %0, %8 offset:%9\n\tds_read_b64_tr_b16 %1, %8 offset:%10\n\tds_read_b64_tr_b16 %2, %8 offset:%11\n\tds_read_b64_tr_b16 %3, %8 offset:%12\n\t"
                 "ds_read_b64_tr_b16 %4, %8 offset:%13\n\tds_read_b64_tr_b16 %5, %8 offset:%14\n\tds_read_b64_tr_b16 %6, %8 offset:%15\n\tds_read_b64_tr_b16 %7, %8 offset:%16"
                 : "=&v"(x[0]), "=&v"(x[1]), "=&v"(x[2]), "=&v"(x[3]), "=&v"(x[4]), "=&v"(x[5]), "=&v"(x[6]), "=&v"(x[7])
                 : "v"(base), "i"(0), "i"(4 * P), "i"(16 * P), "i"(20 * P), "i"(32 * P), "i"(36 * P), "i"(48 * P), "i"(52 * P) : "memory");
}
__device__ __forceinline__ void tr_wait8(v2u (&x)[8]) { asm volatile("s_waitcnt lgkmcnt(0)" : "+v"(x[0]), "+v"(x[1]), "+v"(x[2]), "+v"(x[3]), "+v"(x[4]), "+v"(x[5]), "+v"(x[6]), "+v"(x[7]) :: "memory"); }
__device__ __forceinline__ void tr_pin8(v2u (&x)[8]) { asm volatile("" : "+v"(x[0]), "+v"(x[1]), "+v"(x[2]), "+v"(x[3]), "+v"(x[4]), "+v"(x[5]), "+v"(x[6]), "+v"(x[7])); }
__device__ __forceinline__ bf16x8 tr_read1(unsigned a0, unsigned a1) {
    v2u l0, h0;
    asm volatile("ds_read_b64_tr_b16 %0, %2\n\tds_read_b64_tr_b16 %1, %3\n\ts_waitcnt lgkmcnt(0)" : "=&v"(l0), "=&v"(h0) : "v"(a0), "v"(a1) : "memory");
    return mk8(l0, h0);
}
#define MFMA32(a, b, c) __builtin_amdgcn_mfma_f32_32x32x16_bf16((a), (b), (c), 0, 0, 0)
#define MX_BAR() do { asm volatile("s_waitcnt lgkmcnt(0)" ::: "memory"); __builtin_amdgcn_s_barrier(); asm volatile("" ::: "memory"); } while (0)
#define MX_BAR_VM() do { asm volatile("s_waitcnt vmcnt(0) lgkmcnt(0)" ::: "memory"); __builtin_amdgcn_s_barrier(); asm volatile("" ::: "memory"); } while (0)
struct MixArgs { const bf16 *q, *k, *proj; int qpitch; const float *gates, *bgate, *gdec; bf16* hun; void* probe; const float* gout; float* ssq; };
struct MixUnit { const bf16 *Qg, *Kg, *Vg, *Gg; bf16* Hg; const float* gdec; float* ssq; int qpitch, b, hh, slice; };
constexpr int MX_NPIECE = 38, MX_PPW = 5;
template <bool MLSTM> struct MixDma { static constexpr int PPW = MLSTM ? MX_PPW : 7; unsigned voff[PPW]; };
template <bool MLSTM> __device__ __forceinline__ int mx_piece(int wave, int i) { return MLSTM ? wave + 8 * i : (wave < 6 ? wave + 6 * i : MX_NPIECE); }

template <bool MLSTM>
__device__ __forceinline__ void mx_dma_setup(MixDma<MLSTM>& dm, int wave, int lane, int qpitch) {
#pragma unroll
    for (int i = 0; i < MixDma<MLSTM>::PPW; ++i) { const int pi = mx_piece<MLSTM>(wave, i); unsigned v = 0;
        if (pi < 34) { const int ob = (pi < 17 ? pi : pi - 17) * 1024 + lane * 16, row = ob / IMG_PITCH; int cb = ob - row * IMG_PITCH; cb = cb < 256 ? cb : 240; v = (unsigned)(row * qpitch * 2 + cb); }
        else { const int ob = (pi - 34) * 1024 + lane * 16, row = ob >> 6, cb = ob & 63; v = (unsigned)(row * NPROJ * 2 + cb); }
        dm.voff[i] = v; }
}
template <bool MLSTM>
__device__ __forceinline__ void mx_dma_issue(LAS unsigned char* lds, const MixDma<MLSTM>& dm, const MixUnit& U, int c, int wave, int tid) {
    typedef MxMap<MLSTM> MP;
    const int par = c & 1; const size_t tok0 = (size_t)c * CH;
    const char* qb = (const char*)(U.Qg + tok0 * U.qpitch); const char* kb = (const char*)(U.Kg + tok0 * U.qpitch); const char* vb = (const char*)(U.Vg + tok0 * NPROJ);
#pragma unroll
    for (int i = 0; i < MixDma<MLSTM>::PPW; ++i) { const int pi = mx_piece<MLSTM>(wave, i);
        if (pi < MX_NPIECE) {
            const char* src; int dst;
            if (pi < 17) { src = qb; dst = MP::QS + par * IMG_BYTES + pi * 1024; }
            else if (pi < 34) { src = kb; dst = MP::KS + par * IMG_BYTES + (pi - 17) * 1024; }
            else { src = vb; dst = MP::V + par * 4096 + (pi - 34) * 1024; }
            __builtin_amdgcn_global_load_lds((const unsigned*)(src + dm.voff[i]), (LAS unsigned*)(lds + dst), 16, 0, 0);
        } }
    if (!MLSTM && wave == 3) {
        const float* gd = U.gdec + (size_t)(((U.b * NCH + c) * NH) + U.hh) * DK + (tid & 63);
        __builtin_amdgcn_global_load_lds((const unsigned*)gd, (LAS unsigned*)(lds + MP::GDEC + par * 512), 4, 0, 0);
        __builtin_amdgcn_global_load_lds((const unsigned*)(gd + 64), (LAS unsigned*)(lds + MP::GDEC + par * 512 + 256), 4, 0, 0);
    }
}
__device__ __forceinline__ void mx_gate_pin(v4u& a, v4u& b) { asm volatile("" : "+v"(a), "+v"(b)); }
__device__ __forceinline__ v4u mx_gate_load(const MixUnit& U, int c, int idx) { return *(const v4u*)(U.Gg + (size_t)(c * CH + (idx >> 2)) * NPROJ + 8 * (idx & 3)); }
struct FinIn { f32x4 n0, n1; float rden; };
template <bool MLSTM>
__device__ __forceinline__ FinIn mx_fin_load(LAS unsigned char* lds, int cf, int idx) {
    typedef MxMap<MLSTM> MP;
    const int j = idx >> 2, sg = idx & 3; FinIn f; f.rden = 1.f;
    if (MLSTM) { const float mc = ((const LAS float*)(lds + MP::TSC))[cf];
        const float dn = ((const LAS float*)(lds + MP::DEN))[j], bb = ((const LAS float*)(lds + MP::TB))[cf * 64 + j], pm = ((const LAS float*)(lds + MP::TPM))[cf * 64 + j];
        f.rden = QK_SCALE * __builtin_amdgcn_rcpf(fmaxf(fabsf(dn) * QK_SCALE, __expf(-bb - fmaxf(mc, pm)))); }
    f.n0 = *(const LAS f32x4*)((const LAS float*)(lds + MP::NUM) + j * NUM_PITCH + 8 * sg); f.n1 = *(const LAS f32x4*)((const LAS float*)(lds + MP::NUM) + j * NUM_PITCH + 8 * sg + 4);
    return f;
}
template <bool MLSTM>
__device__ __forceinline__ void mx_fin_compute(const MixUnit& U, int cf, int idx, const float (&g8)[8], const v4u gv, const FinIn f) {
    const int j = idx >> 2, sg = idx & 3; const float rden = f.rden;
    const float nn[8] = {f.n0.x, f.n0.y, f.n0.z, f.n0.w, f.n1.x, f.n1.y, f.n1.z, f.n1.w};
    const float gt[8] = {bflo(gv.x), bfhi(gv.x), bflo(gv.y), bfhi(gv.y), bflo(gv.z), bfhi(gv.z), bflo(gv.w), bfhi(gv.w)};
    float y[8]; float ss = 0.f;
#pragma unroll
    for (int e = 0; e < 8; ++e) { const float sig = __builtin_amdgcn_rcpf(1.0f + __expf(-gt[e]));
        if (MLSTM) { const float v = nn[e] * rden * sig; ss += v * v; y[e] = v * g8[e]; }
        else { const float v = nn[e]; ss += v * v; y[e] = v * g8[e] * gt[e] * sig; } }
    ss += __int_as_float(__builtin_amdgcn_update_dpp(0, __float_as_int(ss), 0xB1, 0xf, 0xf, false));
    ss += __int_as_float(__builtin_amdgcn_update_dpp(0, __float_as_int(ss), 0x4E, 0xf, 0xf, false));
    const size_t row = (size_t)U.b * SEQ + cf * CH + j;
    if (sg == 0) U.ssq[row * 32 + U.hh * 8 + U.slice] = ss;
    v4u w; w.x = pk_bf16(y[0], y[1]); w.y = pk_bf16(y[2], y[3]); w.z = pk_bf16(y[4], y[5]); w.w = pk_bf16(y[6], y[7]);
    *(v4u*)(U.Hg + row * D + 8 * sg) = w;
}
template <bool MLSTM>
__device__ __forceinline__ void mx_finalize(LAS unsigned char* lds, const MixUnit& U, int cf, int idx, const float (&g8)[8], const v4u gv) { mx_fin_compute<MLSTM>(U, cf, idx, g8, gv, mx_fin_load<MLSTM>(lds, cf, idx)); }

template <bool MLSTM>
__device__ __forceinline__ void mx_step(LAS unsigned char* lds, const MixDma<MLSTM>& dm, const MixUnit& U, int c, f32x16& accC0, f32x16& accC1, f32x16& accO, int tid, int lane, int wave, unsigned (&pt)[8], const float (&g8)[8], v4u& gl0, v4u& gl1, v4u& gl0n, v4u& gl1n) {
    typedef MxMap<MLSTM> MP;
    FinIn fin1; fin1.n0 = (f32x4){0.f, 0.f, 0.f, 0.f}; fin1.n1 = fin1.n0; fin1.rden = 1.f;
    const bool fin_wave = MLSTM ? (wave >= 4) : (wave >= 6);
    unsigned long long tp = PROBE_T ? PT_NOW() : 0ull;
    const int r = lane & 31, h5 = lane >> 5, blk = (lane >> 4) & 1, q4 = (lane & 15) >> 2, p4 = lane & 3, par = c & 1;
    const LAS float* TSC = (const LAS float*)(lds + MP::TSC);
    LAS unsigned char* qimg0 = lds + MP::QS + par * IMG_BYTES; LAS unsigned char* kimg0 = lds + MP::KS + par * IMG_BYTES; LAS unsigned char* vimg0 = lds + MP::V + par * 4096;
    if (!fin_wave && c + 1 < NCH) mx_dma_issue<MLSTM>(lds, dm, U, c + 1, wave, tid);
    if (!MLSTM && fin_wave) { gl0n = mx_gate_load(U, c, tid - 384); gl1n = mx_gate_load(U, c, tid - 384 + 128); }
    PT_ACC(6, tp);
    const float mc = MLSTM ? TSC[c] : 0.f;
    if (wave < 4) {
        const int st = wave >> 1, jt = (wave == 1 || wave == 2) ? 1 : 0;
#pragma unroll
        for (int i = 0; i < 16; ++i) accO[i] = 0.f;
        if (MLSTM && wave == 3) {
#pragma unroll
            for (int i = 0; i < 4; ++i) { const int id = lane + 64 * i, row = id >> 2, pc = id & 3;
                const float wr_ = __expf(((const LAS float*)(lds + MP::TWP))[c * 64 + row] - TSC[32 + c]); const v4u pv = *(const LAS v4u*)(vimg0 + row * 64 + pc * 16); v4u o;
                o.x = pk_bf16(bflo(pv.x) * wr_, bfhi(pv.x) * wr_); o.y = pk_bf16(bflo(pv.y) * wr_, bfhi(pv.y) * wr_); o.z = pk_bf16(bflo(pv.z) * wr_, bfhi(pv.z) * wr_); o.w = pk_bf16(bflo(pv.w) * wr_, bfhi(pv.w) * wr_);
                *(LAS v4u*)(lds + MP::VW + row * 64 + pc * 16) = o;
                if (pc == 0) *(LAS unsigned short*)(lds + MP::VWAUX + row * 64) = f2bf1(wr_); }
        }
        if (wave != 3) {
            LAS unsigned char* kimg = kimg0 + (32 * st + r) * IMG_PITCH + 16 * h5;
            LAS unsigned char* qimg = qimg0 + (32 * jt + r) * IMG_PITCH + 16 * h5;
#pragma unroll
            for (int ks = 0; ks < 8; ++ks) { const bf16x8 a = *(const LAS bf16x8*)(kimg + 32 * ks), bq = *(const LAS bf16x8*)(qimg + 32 * ks); accO = MFMA32(a, bq, accO); }
        }
        const int j = 32 * jt + r;
        if (wave == 3) {
#pragma unroll
            for (int g4 = 0; g4 < 4; ++g4) *(LAS v2u*)(lds + MP::PS + j * PS_PITCH + (32 * st + 8 * g4 + 4 * h5) * 2) = (v2u){0u, 0u};
        } else {
            float uj = 0.f;
            if (MLSTM) uj = -fmaxf(mc, ((const LAS float*)(lds + MP::TPM))[c * 64 + j]);
#pragma unroll
            for (int g4 = 0; g4 < 4; ++g4) { const int s0 = 32 * st + 8 * g4 + 4 * h5; f32x4 wps = {0.f, 0.f, 0.f, 0.f}; if (MLSTM) wps = *(const LAS f32x4*)((const LAS float*)(lds + MP::TWP) + c * 64 + s0);
                float v[4];
#pragma unroll
                for (int e = 0; e < 4; ++e) { float x = accO[4 * g4 + e]; if (MLSTM) x *= __expf(uj + wps[e]); v[e] = (s0 + e <= j) ? x : 0.f; }
                v2u o; o.x = pk_bf16(v[0], v[1]); o.y = pk_bf16(v[2], v[3]); *(LAS v2u*)(lds + MP::PS + j * PS_PITCH + s0 * 2) = o; }
        }
    } else {
        const int g = (wave - 4) >> 1, jt = wave & 1;
        if (fin_wave) {
            const int fi = MLSTM ? tid - 256 : tid - 384;
            if (c > 0) { mx_finalize<MLSTM>(lds, U, c - 1, fi, g8, gl0); if (!MLSTM) fin1 = mx_fin_load<MLSTM>(lds, c - 1, fi + 128); }
            if (c + 1 < NCH) mx_dma_issue<MLSTM>(lds, dm, U, c + 1, wave, tid);
        }
        if (MLSTM || g == 0) {
#pragma unroll
            for (int i = 0; i < 16; ++i) accO[i] = 0.f;
#pragma unroll
            for (int ks = 0; ks < 8; ++ks) { const bf16x8 a = *(const LAS bf16x8*)(qimg0 + (32 * jt + r) * IMG_PITCH + 16 * h5 + 32 * ks), bc = *(const LAS bf16x8*)(lds + MP::CT + g * CT_BYTES + r * CT_PITCH + 32 * ks + 16 * h5); accO = MFMA32(a, bc, accO); }
            if (MLSTM) {
#pragma unroll
                for (int g4 = 0; g4 < 4; ++g4) { const f32x4 wi = *(const LAS f32x4*)((const LAS float*)(lds + MP::WI) + par * 64 + 32 * jt + 8 * g4 + 4 * h5);
#pragma unroll
                    for (int e = 0; e < 4; ++e) accO[4 * g4 + e] *= wi[e]; }
            }
        }
    }
    PT_ACC(2, tp);
    MX_BAR();
    PT_ACC(3, tp);
    if (fin_wave) { if (MLSTM) gl0 = mx_gate_load(U, c, tid - 256); else if (c > 0) mx_fin_compute<MLSTM>(U, c - 1, tid - 384 + 128, g8, gl1, fin1); }
    if (wave < 4) {
        if (MLSTM) { const float decay = __expf(mc - TSC[32 + c]); accC0 = accC0 * decay; accC1 = accC1 * decay; }
        LAS unsigned char* kimg = kimg0 + (8 * h5 + q4) * IMG_PITCH + 64 * wave + 32 * blk + 8 * p4;
        LAS unsigned char* vimg = (MLSTM ? lds + MP::VW : vimg0) + (8 * h5 + q4) * 64 + 32 * blk + 8 * p4;
        LAS unsigned char* vaux = lds + MP::VWAUX + (8 * h5 + q4) * 64 + 32 * blk + 8 * p4;
        { v2u xk[8], xv[8], xa[8];
          tr_issue4<IMG_PITCH>(xk, LDSA(kimg)); tr_issue4<64>(xv, LDSA(vimg)); if (MLSTM) tr_issue4<64>(xa, LDSA(vaux));
          tr_wait8(xk); tr_pin8(xv); if (MLSTM) tr_pin8(xa);
          __builtin_amdgcn_sched_barrier(0);
#pragma unroll
          for (int ks = 0; ks < 4; ++ks) { const bf16x8 a = mk8(xk[2 * ks], xk[2 * ks + 1]);
              accC0 = MFMA32(a, mk8(xv[2 * ks], xv[2 * ks + 1]), accC0);
              if (MLSTM) accC1 = MFMA32(a, mk8(xa[2 * ks], xa[2 * ks + 1]), accC1); } }
        if (!MLSTM) {
#pragma unroll
            for (int g4 = 0; g4 < 4; ++g4) { const f32x4 dc = *(const LAS f32x4*)((const LAS float*)(lds + MP::GDEC) + par * 128 + 32 * wave + 8 * g4 + 4 * h5);
#pragma unroll
                for (int e = 0; e < 4; ++e) accC0[4 * g4 + e] *= dc[e]; }
        }
#pragma unroll
        for (int g4 = 0; g4 < 4; ++g4) { const int d0 = 32 * wave + 8 * g4 + 4 * h5;
            v2u o; o.x = pk_bf16(accC0[4 * g4], accC0[4 * g4 + 1]); o.y = pk_bf16(accC0[4 * g4 + 2], accC0[4 * g4 + 3]); *(LAS v2u*)(lds + MP::CT + r * CT_PITCH + d0 * 2) = o;
            if (MLSTM) { v2u o1; o1.x = pk_bf16(accC1[4 * g4], accC1[4 * g4 + 1]); o1.y = pk_bf16(accC1[4 * g4 + 2], accC1[4 * g4 + 3]); *(LAS v2u*)(lds + MP::CT + CT_BYTES + r * CT_PITCH + d0 * 2) = o1; } }
    } else {
        const int g = (wave - 4) >> 1, jt = wave & 1;
        if (MLSTM || g == 0) {
            const bf16x8 ones = (r == 0) ? (bf16x8){0x3F80, 0x3F80, 0x3F80, 0x3F80, 0x3F80, 0x3F80, 0x3F80, 0x3F80} : (bf16x8){0, 0, 0, 0, 0, 0, 0, 0};
            LAS unsigned char* vimg = vimg0 + (8 * h5 + q4) * 64 + 32 * blk + 8 * p4;
            bf16x8 pa[4];
#pragma unroll
            for (int ks = 0; ks < 4; ++ks) pa[ks] = *(const LAS bf16x8*)(lds + MP::PS + (32 * jt + r) * PS_PITCH + 32 * ks + 16 * h5);
            if (g == 0) { v2u xv[8]; tr_issue4<64>(xv, LDSA(vimg)); tr_wait8(xv); __builtin_amdgcn_sched_barrier(0);
#pragma unroll
                for (int ks = 0; ks < 4; ++ks) accO = MFMA32(pa[ks], mk8(xv[2 * ks], xv[2 * ks + 1]), accO);
            } else {
#pragma unroll
                for (int ks = 0; ks < 4; ++ks) accO = MFMA32(pa[ks], ones, accO); }
            if (g == 0) {
#pragma unroll
                for (int i = 0; i < 16; ++i) ((LAS float*)(lds + MP::NUM))[(32 * jt + (i & 3) + 8 * (i >> 2) + 4 * h5) * NUM_PITCH + r] = accO[i];
            }
            if (MLSTM && wave == 7 && c + 1 < NCH) { const float m1 = TSC[c + 1]; ((LAS float*)(lds + MP::WI))[(par ^ 1) * 64 + lane] = __expf(m1 - fmaxf(m1, ((const LAS float*)(lds + MP::TPM))[(c + 1) * 64 + lane])); }
            if (MLSTM && g == 1 && r == 0) {
#pragma unroll
                for (int i = 0; i < 16; ++i) ((LAS float*)(lds + MP::DEN))[32 * jt + (i & 3) + 8 * (i >> 2) + 4 * h5] = accO[i];
            }
        }
    }
    PT_ACC(4, tp);
    MX_BAR_VM();
    if (!MLSTM && fin_wave) { mx_gate_pin(gl0n, gl1n); gl0 = gl0n; gl1 = gl1n; }
    PT_ACC(5, tp);
}

template <int CTRL, int ROW_MASK> __device__ __forceinline__ float dpp_f(float old, float v) { return __int_as_float(__builtin_amdgcn_update_dpp(__float_as_int(old), __float_as_int(v), CTRL, ROW_MASK, 0xf, false)); }
__device__ __forceinline__ float wave_scan_sum(float v) {
    v += dpp_f<0x111, 0xf>(0.f, v); v += dpp_f<0x112, 0xf>(0.f, v); v += dpp_f<0x114, 0xf>(0.f, v); v += dpp_f<0x118, 0xf>(0.f, v);
    v += dpp_f<0x142, 0xa>(0.f, v); v += dpp_f<0x143, 0xc>(0.f, v); return v; }
__device__ __forceinline__ float wave_scan_max(float v) { const float ninf = -__builtin_inff();
    v = fmaxf(v, dpp_f<0x111, 0xf>(ninf, v)); v = fmaxf(v, dpp_f<0x112, 0xf>(ninf, v)); v = fmaxf(v, dpp_f<0x114, 0xf>(ninf, v)); v = fmaxf(v, dpp_f<0x118, 0xf>(ninf, v));
    v = fmaxf(v, dpp_f<0x142, 0xa>(ninf, v)); v = fmaxf(v, dpp_f<0x143, 0xc>(ninf, v)); return v; }
template <bool MLSTM>
__device__ __forceinline__ void mixer_phase(LAS unsigned char* lds, int tid, int lane, int wave, int vcu, int G, const MixArgs A) {
    typedef MxMap<MLSTM> MP;
    MixDma<MLSTM> dm; mx_dma_setup<MLSTM>(dm, wave, lane, A.qpitch);
    unsigned pt[8] = {0u, 0u, 0u, 0u, 0u, 0u, 0u, 0u}; unsigned long long tph = PROBE_T ? PT_NOW() : 0ull; unsigned long long tin = tph;
    for (int unit = vcu; unit < BATCH * NH * 8; unit += G) {
        const int slice = unit & 7, bh = unit >> 3;
        MixUnit U; U.b = bh >> 2; U.hh = bh & 3; U.qpitch = A.qpitch; U.gdec = A.gdec;
        U.Qg = A.q + (size_t)U.b * BBLK_E + U.hh * DK; U.Kg = A.k + (size_t)U.b * BBLK_E + U.hh * DK; U.Vg = A.proj + (size_t)U.b * BBLK_E + 1024 + U.hh * DV + 32 * slice; U.Hg = A.hun + U.hh * DV + 32 * slice;
        U.Gg = A.proj + (size_t)U.b * BBLK_E + 2048 + U.hh * DV + 32 * slice; U.ssq = A.ssq; U.slice = slice;

        MX_BAR_VM();
        mx_dma_issue<MLSTM>(lds, dm, U, 0, wave, tid);
        float g8[8];
#pragma unroll
        for (int e = 0; e < 8; ++e) g8[e] = A.gout[U.hh * DV + 32 * slice + 8 * (tid & 3) + e];
        for (int i = tid; i < 2 * CT_BYTES / 4; i += NTHREADS) ((LAS unsigned*)(lds + MP::CT))[i] = 0u;
        if (MLSTM) {
            for (int i = tid; i < 1024; i += NTHREADS) ((LAS unsigned*)(lds + MP::VWAUX))[i] = 0u;
            LAS float* TB = (LAS float*)(lds + MP::TB); LAS float* TWP = (LAS float*)(lds + MP::TWP); LAS float* TPM = (LAS float*)(lds + MP::TPM); LAS float* TSC = (LAS float*)(lds + MP::TSC);
            const float bgi = A.bgate[U.hh], bgf = A.bgate[4 + U.hh];
            float gi4[4], gf4[4];
#pragma unroll
            for (int cc = 0; cc < 4; ++cc) { const size_t tok = (size_t)U.b * SEQ + (wave + 8 * cc) * CH + lane; gi4[cc] = A.gates[tok * 16 + U.hh] + bgi; gf4[cc] = A.gates[tok * 16 + 4 + U.hh] + bgf; }
#pragma unroll
            for (int cc = 0; cc < 4; ++cc) { const int c = wave + 8 * cc;
                const float lf = fminf(gf4[cc], 0.f) - __logf(1.0f + __expf(-fabsf(gf4[cc])));
                const float bsum = wave_scan_sum(lf);
                const float wp = gi4[cc] - bsum; const float pm = wave_scan_max(wp);
                TB[c * 64 + lane] = bsum; TWP[c * 64 + lane] = wp; TPM[c * 64 + lane] = pm;
                if (lane == 63) { TSC[64 + c] = bsum; TSC[96 + c] = pm; } }
            MX_BAR();
            if (wave == 7) ((LAS float*)(lds + MP::WI))[lane] = __expf(-fmaxf(0.f, TPM[lane]));
            if (wave == 0) {
                const float gl = TSC[64 + (lane & 31)], pl = TSC[96 + (lane & 31)]; float m = 0.f, myM = 0.f, myX = 0.f;
#pragma clang loop unroll(disable)
                for (int c = 0; c < NCH; ++c) { const float gc = __uint_as_float(__builtin_amdgcn_readlane(__float_as_uint(gl), c)), pc = __uint_as_float(__builtin_amdgcn_readlane(__float_as_uint(pl), c));
                    const float mxe = fmaxf(m, pc); if (lane == c) { myM = m; myX = mxe; } m = gc + mxe; }
                if (lane < 32) { TSC[lane] = myM; TSC[32 + lane] = myX; }
            }
        }
        f32x16 accC0, accC1, accO; v4u gl0 = {0u, 0u, 0u, 0u}, gl1 = {0u, 0u, 0u, 0u}, gl0n = {0u, 0u, 0u, 0u}, gl1n = {0u, 0u, 0u, 0u};
#pragma unroll
        for (int i = 0; i < 16; ++i) { accC0[i] = 0.f; accC1[i] = 0.f; accO[i] = 0.f; }
        MX_BAR_VM();
        PT_ACC(1, tin);
#pragma clang loop unroll(disable)
        for (int c = 0; c < NCH; ++c) mx_step<MLSTM>(lds, dm, U, c, accC0, accC1, accO, tid, lane, wave, pt, g8, gl0, gl1, gl0n, gl1n);
        if (MLSTM) { if (wave >= 4) mx_finalize<true>(lds, U, NCH - 1, tid - 256, g8, gl0); } else if (wave >= 6) { mx_finalize<false>(lds, U, NCH - 1, tid - 384, g8, gl0); mx_finalize<false>(lds, U, NCH - 1, tid - 384 + 128, g8, gl1); }
    }
    MX_BAR_VM();
    if (PROBE_T && (PROBE_T_MLSTM != 0) == MLSTM && vcu == 0 && wave == PROBE_T_WAVE && lane == 0) { PT_ACC(0, tph); unsigned* pw = (unsigned*)A.probe; pw[0] = pt[PROBE_T_A]; pw[1] = pt[PROBE_T_B]; }
}

constexpr int N_PHASES = 15, RT_OFF = RING_BYTES;
template <int PH>
__device__ __forceinline__ void run_phase(const Args& args, LAS unsigned char* lds, int tid, int lane, int wave, int vcu, int G, int bx) {
    unsigned char* ws = args.ws;
    constexpr int layer = (PH >= 8) ? 1 : 0, k = (PH == 0) ? -1 : PH - 1 - 7 * layer;
    unsigned char* wl = ws + (size_t)layer * WS_WLAYER;
    bf16* AOP = (bf16*)(ws + WS_AOP); bf16* PROJ = (bf16*)(ws + WS_PROJ); bf16* HMID = (bf16*)(ws + WS_HMID); bf16* XRES = (bf16*)(ws + WS_XRES);
    float* GATES = (float*)(ws + WS_GATES); float* SUMSQ = (float*)(ws + WS_SUMSQ);
    LAS float* RT = (LAS float*)(lds + RT_OFF);
    if constexpr (k == -1) {
        LAS unsigned char* wgb = lds;
        rows_first(wgb, (LAS float*)(lds + 40960), tid, lane, wave, vcu, G, args.in[4] + NPROJ, MLSTM_IN, args.in[1], args.in[0], XRES, SUMSQ, GATES);
        if (tid >= 448) {
            for (int i = vcu * 64 + (tid - 448); i < D * 16; i += G * 64) { const int k = i >> 4, c = i & 15;
                ((bf16*)(ws + WS_WGT))[c * 1032 + k] = f2bf1(args.in[1][D + k] * args.in[8][(size_t)k * GLA_IN + NPROJ + c]); }
        }
        convert_weights(lds, lane, wave, NWAVES, vcu, G, args, ws);
    } else if constexpr (k == 0) {
        pg8::Gemm g{XRES, (const bf16*)(wl + WS_WIN), M, NPROJ, D}; pg8::StaticOrder S; S.init(M, NPROJ, G, bx);
        const RstdSlots rs = rstd_slots(S);
        pg8::EpiBf16S<0> E{PROJ, NPROJ, (const LAS float*)RT, rs.pm1, rs.pm2, rs.pm3, BBLK_E, SUMSQ, rs.pm0, 1.f / D, EPS};
        pg8::gemm_phase<pg8::EpiBf16S<0>, pg8::StaticOrder, true, true>(lds, g, S, E);
    } else if constexpr (k == 1) {
        if (layer) gla_prep(lds, tid, lane, wave, vcu, G, PROJ, XRES, SUMSQ, (const bf16*)(ws + WS_WGT), args.in[9], args.in[10], (bf16*)(ws + WS_PROJ + WS_QT_OFF), (bf16*)(ws + WS_PROJ + WS_KT_OFF), (float*)(ws + WS_GDEC));
    } else if constexpr (k == 2) {
        if (layer == 0) { const MixArgs A{PROJ, PROJ + QKW, PROJ, NPROJ, GATES, args.in[5], nullptr, AOP, ws + WS_CTL + 4 * CW_PROBE, args.in[6], (float*)(ws + WS_SSQ)}; mixer_phase<true>(lds, tid, lane, wave, vcu, G, A); }
        else { const MixArgs A{(const bf16*)(ws + WS_PROJ + WS_QT_OFF), (const bf16*)(ws + WS_PROJ + WS_KT_OFF), PROJ, QKW, nullptr, nullptr, (const float*)(ws + WS_GDEC), AOP, ws + WS_CTL + 4 * CW_PROBE, args.in[11], (float*)(ws + WS_SSQ)}; mixer_phase<false>(lds, tid, lane, wave, vcu, G, A); }
    } else if constexpr (k == 3) {
    } else if constexpr (k == 4) {
        pg8::Gemm g{AOP, (const bf16*)(wl + WS_WOUT), M, D, D}; pg8::StaticOrder S; S.init(M, D, G, bx);
        pg8::Unit u0; S.next(0, u0);
        pg8::EpiResBf16SqH E{XRES, SUMSQ, D, (const LAS float*)RT, (const float*)(ws + WS_SSQ), u0.pm, 1.f / DV, EPS};
        pg8::gemm_phase<pg8::EpiResBf16SqH, pg8::StaticOrder, false, true>(lds, g, S, E);
    } else if constexpr (k == 5) {
        pg8::Gemm g{XRES, (const bf16*)(wl + WS_W1), M, FF, D}; pg8::StaticOrder S; S.init(M, FF, G, bx);
        const RstdSlots rs = rstd_slots(S);
        pg8::EpiBf16S<2> E{HMID, FF, (const LAS float*)RT, rs.pm1, rs.pm2, rs.pm3, (size_t)2048 * FF, SUMSQ, rs.pm0, 1.f / D, EPS};
        pg8::gemm_phase<pg8::EpiBf16S<2>, pg8::StaticOrder, true, true>(lds, g, S, E);
    } else if constexpr (k == 6 && layer == 0) {
        pg8::Gemm g{HMID, (const bf16*)(wl + WS_W2), M, D, FF}; pg8::StaticOrder S; S.init(M, D, G, bx);
        pg8::EpiResBf16Sq E{XRES, SUMSQ, D};
        pg8::gemm_phase<pg8::EpiResBf16Sq, pg8::StaticOrder, false, true>(lds, g, S, E);
    } else if constexpr (k == 6) {
        pg8::Gemm g{HMID, (const bf16*)(wl + WS_W2), M, D, FF}; pg8::StaticOrder S; S.init(M, D, G, bx);
        pg8::EpiFinalNorm E{XRES, args.out, SUMSQ, (unsigned*)(ws + WS_CTL) + CW_FIN, args.in[3], D, EPS};
        pg8::gemm_phase<pg8::EpiFinalNorm, pg8::StaticOrder, false, true>(lds, g, S, E);
    }
}
__device__ __forceinline__ void group_sync(unsigned* ctl, volatile LAS unsigned* st, unsigned per_epoch) {
    asm volatile("s_waitcnt vmcnt(0)" ::: "memory");
    __syncthreads();
    if (threadIdx.x == 64) { __builtin_amdgcn_fence(__ATOMIC_ACQUIRE, "agent"); asm volatile("s_waitcnt vmcnt(0)" ::: "memory"); }
    if (threadIdx.x == 0) {
        unsigned* cnt = ctl + st[0]; const unsigned target = per_epoch * (st[1] + 1u); st[1] = st[1] + 1u;
        (void)xb_add(cnt, 1u);
        unsigned sp = 0; while (xb_ld(cnt) < target && ++sp < (1u << 22)) __builtin_amdgcn_s_sleep(1);
        asm volatile("s_waitcnt vmcnt(0)" ::: "memory");
    }
    __syncthreads();
}
__global__ void __launch_bounds__(NTHREADS, 2) fwd_kernel(Args args) {
    extern __shared__ __attribute__((aligned(16))) unsigned char lds_raw[];
    LAS unsigned char* lds = (LAS unsigned char*)lds_raw;
    volatile LAS unsigned* MISC = (volatile LAS unsigned*)(lds + MISC_OFF);
    const int tid = threadIdx.x, lane = tid & 63, wave = __builtin_amdgcn_readfirstlane(tid >> 6);
    const int G = gridDim.x; int bx = blockIdx.x; int vcu = (G % 8 == 0) ? (bx % 8) * (G / 8) + bx / 8 : bx;
    for (int u = tid; u < (LDS_BYTES - LDSCTL_OFF) / 4; u += NTHREADS) ((LAS unsigned*)(lds + LDSCTL_OFF))[u] = 0u;
    __syncthreads();
    const int lo = args.ph_lo, hi = args.ph_hi;
#ifndef PROBE_S
#define PROBE_S 0
#endif
    if (PROBE_S && tid == 0) { const unsigned t = (unsigned)__builtin_amdgcn_s_memrealtime(); unsigned* pw = (unsigned*)(args.ws + WS_CTL) + CW_PROBE;
        __hip_atomic_fetch_max(pw + 4, ~t, __ATOMIC_RELAXED, __HIP_MEMORY_SCOPE_AGENT); __hip_atomic_fetch_max(pw + 5, t, __ATOMIC_RELAXED, __HIP_MEMORY_SCOPE_AGENT); }
    XcdBarrier bar; bar.bar = (unsigned*)(args.ws + WS_CTL) + CW_BAR; bar.x = 0; bar.st = nullptr;
    if (hi - lo > 1) { bar = xcd_barrier_post((unsigned*)(args.ws + WS_CTL) + CW_BAR, MISC + 8);
        if (tid == 0) { const unsigned xcc = xb_xcc_id(); MISC[16] = xcc; MISC[17] = xb_add((unsigned*)(args.ws + WS_CTL) + CW_XID + 64 * xcc, 1u); } }
#ifndef PROBE_PH
#define PROBE_PH (-1)
#endif
#ifndef PROBE_N
#define PROBE_N 0
#endif
#define PHASE(p) if (lo <= (p) && (p) < hi) { PP_STAMP(2 * (p)); run_phase<p>(args, lds, tid, lane, wave, vcu, G, bx); PP_STAMP(2 * (p) + 1); \
        if (PROBE_S && (p) == 0 && tid == 0) { __hip_atomic_fetch_max((unsigned*)(args.ws + WS_CTL) + CW_PROBE + 6, (unsigned)__builtin_amdgcn_s_memrealtime(), __ATOMIC_RELAXED, __HIP_MEMORY_SCOPE_AGENT); } \
        if ((p) == PROBE_PH) { for (int rep_ = 0; rep_ < PROBE_N; ++rep_) { xcd_barrier(bar); if (PROBE_PH >= 0) run_phase<((p) == PROBE_PH ? (p) : 2)>(args, lds, tid, lane, wave, vcu, G, bx); } } \
        if ((p) + 1 < hi && (p) != 2 && (p) != 4 && (p) != 11) { if (MISC[20] != 0u && ((p) == 5 || (p) == 6 || (p) == 12 || (p) == 13)) { group_sync((unsigned*)(args.ws + WS_CTL), MISC + 22, 4u); } \
            else if (MISC[20] != 0u && (p) > 0) { group_sync((unsigned*)(args.ws + WS_CTL), MISC + 24, 32u); } else xcd_barrier(bar); } }
    PHASE(0)
    if (lo == 0 && hi > 1) {
        if (tid == 0) {
            bool ok = (G == 256);
            unsigned cv[16];
#pragma unroll
            for (unsigned j = 0; j < 16; ++j) cv[j] = xb_ld(&bar.bar[XB_XCNT(j)]);
#pragma unroll
            for (unsigned j = 0; j < 16; ++j) ok = ok & (cv[j] == (j < 8 ? 32u : 0u));
            const unsigned xcc = MISC[16], idx = MISC[17];
            if (ok && xcc < 8 && idx < 32) { const unsigned pm = 8u * xcc + (idx & 7u);
                MISC[22] = (unsigned)(CW_GRP + 16 * pm); MISC[24] = (unsigned)(CW_XCL + 64 * xcc); MISC[20] = 1u; }
        }
        __syncthreads();
        if (MISC[20] != 0u) { const unsigned xcc = MISC[16], idx = MISC[17]; vcu = (int)(xcc * 32 + idx); bx = (int)(idx * 8 + xcc); }
    }
    PHASE(1) PHASE(2) PHASE(3) PHASE(4) PHASE(5) PHASE(6) PHASE(7) PHASE(8) PHASE(9) PHASE(10) PHASE(11) PHASE(12) PHASE(13) PHASE(14)
#undef PHASE
#ifndef PROBE_BLK
#define PROBE_BLK 0
#endif
    if (PROBE_P && hi == N_PHASES && blockIdx.x == PROBE_BLK && tid == 0) {
        const volatile LAS unsigned* w = (const volatile LAS unsigned*)(lds + LDSCTL_OFF + 512);
        const unsigned va = (PROBE_P_A < 32) ? w[2 * PROBE_P_A + 1] - w[2 * PROBE_P_A] : w[2 * (PROBE_P_A - 32) + 2] - w[2 * (PROBE_P_A - 32) + 1];
        const unsigned vb = (PROBE_P_B < 32) ? w[2 * PROBE_P_B + 1] - w[2 * PROBE_P_B] : w[2 * (PROBE_P_B - 32) + 2] - w[2 * (PROBE_P_B - 32) + 1];
        const unsigned long long ticks = (unsigned long long)(va / 100u) * 1000ull + (unsigned long long)(vb / 100u) * 100000ull;
        const unsigned long long t0 = PT_NOW(); while (PT_NOW() - t0 < ticks) __builtin_amdgcn_s_sleep(8);
    }
    if (PROBE_S && hi == N_PHASES && blockIdx.x == 0 && tid == 0) {
        unsigned* pw = (unsigned*)(args.ws + WS_CTL) + CW_PROBE; const unsigned mn = ~xb_ld(pw + 4), mx = xb_ld(pw + 5), me = xb_ld(pw + 6);
        const unsigned v = (PROBE_S == 1) ? mx - mn : me - mn;
        const unsigned long long ticks = (unsigned long long)(v / 10u) * 1000ull;
        const unsigned long long t0 = PT_NOW(); while (PT_NOW() - t0 < ticks) __builtin_amdgcn_s_sleep(8);
    }
    if (PROBE_T && hi == N_PHASES && vcu == 0 && tid == 0) {
        const unsigned a = xb_ld((unsigned*)(args.ws + WS_CTL) + CW_PROBE), b = xb_ld((unsigned*)(args.ws + WS_CTL) + CW_PROBE + 1);
        const unsigned long long ticks = (unsigned long long)(a / 100u) * 1000ull + (unsigned long long)(b / 100u) * 100000ull;
        const unsigned long long t0 = PT_NOW(); while (PT_NOW() - t0 < ticks) __builtin_amdgcn_s_sleep(8);
    }
}

extern "C" void kernel_launch(void* const* d_in, const int* in_sizes, int n_in, void* d_out, int out_size, void* d_ws, size_t ws_size, hipStream_t stream) {
    static int grid = 0;
    if (grid == 0) {
        if (n_in != 15 || in_sizes[0] != M * D || out_size != M * D || ws_size < WS_END) { fprintf(stderr, "kernel_launch: unexpected shapes (n_in %d, in0 %d, out %d, ws %zu); nothing launched\n", n_in, n_in > 0 ? in_sizes[0] : -1, out_size, ws_size); grid = -1; return; }
        int dev = 0, cus = 0, per_cu = 0;
        if (hipGetDevice(&dev) != hipSuccess || hipDeviceGetAttribute(&cus, hipDeviceAttributeMultiprocessorCount, dev) != hipSuccess) { grid = -1; return; }
        if (hipFuncSetAttribute((const void*)fwd_kernel, hipFuncAttributeMaxDynamicSharedMemorySize, LDS_BYTES) != hipSuccess) { fprintf(stderr, "kernel_launch: hipFuncSetAttribute failed\n"); grid = -1; return; }
        if (hipOccupancyMaxActiveBlocksPerMultiprocessor(&per_cu, (const void*)fwd_kernel, NTHREADS, LDS_BYTES) != hipSuccess || per_cu < 1) { fprintf(stderr, "kernel_launch: occupancy query says %d blocks per CU\n", per_cu); (void)hipGetLastError(); grid = -1; return; }
        grid = cus;
    }
    if (grid < 0) return;
    (void)hipMemsetAsync((char*)d_ws + WS_CTL, 0, CTL_ZERO_BYTES, stream);
    Args a{};
    for (int i = 0; i < 15; ++i) a.in[i] = (const float*)d_in[i];
    a.out = (float*)d_out; a.ws = (unsigned char*)d_ws;
    if (MK_N_LAUNCHES == 1) {
        a.ph_lo = 0; a.ph_hi = N_PHASES;
        void* kargs[] = {&a};
        const hipError_t e = hipLaunchCooperativeKernel((const void*)fwd_kernel, dim3(grid), dim3(NTHREADS), kargs, LDS_BYTES, stream);
        if (e != hipSuccess) fprintf(stderr, "kernel_launch: cooperative launch failed: %s (grid %d)\n", hipGetErrorString(e), grid);
    } else {
        for (int p = 0; p < N_PHASES; ++p) { a.ph_lo = p; a.ph_hi = p + 1; hipLaunchKernelGGL(fwd_kernel, dim3(grid), dim3(NTHREADS), LDS_BYTES, stream, a); }
    }
}
```
